# Optimizing an MI355X kernel written in HIP

```python
import math
import jax
import jax.numpy as jnp
from jax import lax
import numpy as np

D_MODEL = 1024
BATCH = 2
SEQ = 8192
DEPTH = 2

GRID_W = 64
CTX_LEN = 256
EPS = 1e-6
CHUNK = 128
Q_BLOCK = 128

MLA_HEADS = 4
MLA_Q_LORA = 256
MLA_KV_LORA = 128
MLA_NOPE = 64
MLA_ROPE = 32
MLA_V = 64
MLA_SCALE = (MLA_NOPE + MLA_ROPE) ** -0.5
ROPE_AXIS_DIM = MLA_ROPE // 2
ROPE_BASE = 10000.0

RET_HEADS = 4
RET_QK = 64
RET_V = 64

SSD_HEADS = 8
SSD_HEADDIM = 64
SSD_GROUPS = 2
SSD_STATE = 64
SSD_CONV = 3
SSD_INNER = SSD_HEADS * SSD_HEADDIM
SSD_CONV_CH = SSD_INNER + 2 * SSD_GROUPS * SSD_STATE

IN_SIZES = (MLA_Q_LORA, MLA_KV_LORA, MLA_ROPE,
            RET_HEADS * RET_QK, RET_HEADS * RET_QK, RET_HEADS * RET_V, RET_HEADS * RET_V,
            SSD_INNER, SSD_CONV_CH, SSD_HEADS, SSD_HEADS)
IN_WIDTH = sum(IN_SIZES)
MIX_WIDTH = MLA_HEADS * MLA_V + RET_HEADS * RET_V + SSD_INNER

D_FF = 2816
N_EXPERTS = 8
TOP_K = 2
D_FF_EXPERT = 1408
N_DENSE = (DEPTH + 1) // 2
N_MOE = DEPTH // 2

kernel_name = "hybrid_mla_retention_ssd_dit_block"


def rmsnorm(x, w):
    xf = x.astype(jnp.float32)
    y = xf * lax.rsqrt(jnp.mean(xf * xf, axis=-1, keepdims=True) + EPS)
    return (y * w.astype(jnp.float32)).astype(x.dtype)


def modulate(h, shift, scale):
    return h * (1.0 + scale) + shift


def axial_rope_tables(rows, dtype):
    f32 = jnp.float32
    row = jnp.repeat(jnp.arange(rows, dtype=f32), GRID_W)
    col = jnp.tile(jnp.arange(GRID_W, dtype=f32), rows)
    inv_freq = ROPE_BASE ** (-jnp.arange(0, ROPE_AXIS_DIM, 2, dtype=f32) / ROPE_AXIS_DIM)
    ang_r = row[:, None] * inv_freq
    ang_c = col[:, None] * inv_freq
    ang = jnp.concatenate([ang_r, ang_r, ang_c, ang_c], axis=-1)
    return jnp.cos(ang).astype(dtype), jnp.sin(ang).astype(dtype)


def apply_axial_rope(x, cos, sin):
    x1, x2, x3, x4 = jnp.split(x, 4, axis=-1)
    rot = jnp.concatenate([-x2, x1, -x4, x3], axis=-1)
    return x * cos + rot * sin


def split_in(proj):
    offs = np.cumsum(IN_SIZES)[:-1].tolist()
    return jnp.split(proj, offs, axis=-1)


def block_attention(q, k, v):
    b, l, h, d = q.shape
    nb = l // Q_BLOCK
    qb = jnp.moveaxis(q.reshape(b, nb, Q_BLOCK, h, d), 1, 0)

    def one(q_blk):
        s = jnp.einsum('bqhd,bkhd->bhqk', q_blk, k).astype(jnp.float32) * MLA_SCALE
        p = jax.nn.softmax(s, axis=-1).astype(v.dtype)
        return jnp.einsum('bhqk,bkhd->bqhd', p, v)

    out = lax.map(one, qb)
    return jnp.moveaxis(out, 0, 1).reshape(b, l, h, v.shape[-1])


def mla_qkv(cq, ckv, kpe, q_norm_w, w_qb, kv_norm_w, w_kb, w_vb, cos, sin):
    b, l, _ = cq.shape
    q = (rmsnorm(cq, q_norm_w) @ w_qb).reshape(b, l, MLA_HEADS, MLA_NOPE + MLA_ROPE)
    q_nope, q_pe = q[..., :MLA_NOPE], q[..., MLA_NOPE:]
    ckv = rmsnorm(ckv, kv_norm_w)
    k_nope = (ckv @ w_kb).reshape(b, l, MLA_HEADS, MLA_NOPE)
    v = (ckv @ w_vb).reshape(b, l, MLA_HEADS, MLA_V)
    kpe = kpe[:, :, None, :]
    if cos is not None:
        q_pe = apply_axial_rope(q_pe, cos[:, None, :], sin[:, None, :])
        kpe = apply_axial_rope(kpe, cos[:, None, :], sin[:, None, :])
    q = jnp.concatenate([q_nope, q_pe], axis=-1)
    k = jnp.concatenate([k_nope, jnp.broadcast_to(kpe, (b, l, MLA_HEADS, MLA_ROPE))], axis=-1)
    return q, k, v


def chunked_scan(q, k, v, log_a, state0, include_diag):
    f32 = jnp.float32
    b, l, h, n = q.shape
    p = v.shape[-1]
    nc = l // CHUNK
    qc = q.astype(f32).reshape(b, nc, CHUNK, h, n)
    kc = k.astype(f32).reshape(b, nc, CHUNK, h, n)
    vc = v.astype(f32).reshape(b, nc, CHUNK, h, p)
    acum = jnp.cumsum(log_a.astype(f32).reshape(b, nc, CHUNK, h), axis=2)
    acum_h = jnp.swapaxes(acum, 2, 3)
    idx = jnp.arange(CHUNK)
    mask = (idx[:, None] >= idx[None, :]) if include_diag else (idx[:, None] > idx[None, :])
    seg = acum_h[..., :, None] - acum_h[..., None, :]
    decay = jnp.exp(jnp.where(mask, seg, -jnp.inf))
    scores = jnp.einsum('bcihn,bcjhn->bchij', qc, kc) * decay
    y = jnp.einsum('bchij,bcjhp->bcihp', scores, vc)
    w_end = jnp.exp(acum[:, :, -1:, :] - acum)
    chunk_states = jnp.einsum('bcjhn,bcjhp->bchnp', kc * w_end[..., None], vc)
    chunk_decay = jnp.exp(acum[:, :, -1, :])

    def step(state, inp):
        s_c, d_c = inp
        return state * d_c[:, :, None, None] + s_c, state

    final, states_in = lax.scan(step, state0,
                                (jnp.moveaxis(chunk_states, 1, 0), jnp.moveaxis(chunk_decay, 1, 0)))
    states_in = jnp.moveaxis(states_in, 0, 1)
    y = y + jnp.einsum('bcihn,bchnp->bcihp', qc * jnp.exp(acum)[..., None], states_in)
    return y.reshape(b, l, h, p), final


def bidir_scan(ctx_in, lat_in, bwd_diag):
    q_c, k_c, v_cf, v_cb, la_cf, la_cb = ctx_in
    q_x, k_x, v_xf, v_xb, la_xf, la_xb = lat_in
    b, _, h, n = q_c.shape
    s0 = jnp.zeros((b, h, n, v_cf.shape[-1]), jnp.float32)
    flip = lambda t: jnp.flip(t, axis=1)
    y_cf, s_cf = chunked_scan(q_c, k_c, v_cf, la_cf, s0, True)
    y_cb, s_cb = chunked_scan(flip(q_c), flip(k_c), flip(v_cb), flip(la_cb), s0, bwd_diag)
    y_xf, _ = chunked_scan(q_x, k_x, v_xf, la_xf, s_cf, True)
    y_xb, _ = chunked_scan(flip(q_x), flip(k_x), flip(v_xb), flip(la_xb), s_cb, bwd_diag)
    return y_cf + flip(y_cb), y_xf + flip(y_xb)


def retention_inputs(rq, rk, rv, log_gamma):
    b, l, _ = rq.shape
    q = rq.reshape(b, l, RET_HEADS, RET_QK) * (RET_QK ** -0.5)
    k = rk.reshape(b, l, RET_HEADS, RET_QK)
    v = rv.reshape(b, l, RET_HEADS, RET_V)
    la_f = jnp.broadcast_to(log_gamma[0], (b, l, RET_HEADS))
    la_b = jnp.broadcast_to(log_gamma[1], (b, l, RET_HEADS))
    return (q, k, v, v, la_f, la_b)


def retention_output(y, g):
    b, l = y.shape[:2]
    mu = jnp.mean(y, axis=-1, keepdims=True)
    var = jnp.mean(jnp.square(y - mu), axis=-1, keepdims=True)
    yn = ((y - mu) * lax.rsqrt(var + EPS)).reshape(b, l, RET_HEADS * RET_V)
    return yn.astype(g.dtype) * jax.nn.silu(g)


def depthwise_conv(x, w, bias):
    y = lax.conv_general_dilated(x, w[:, None, :].astype(x.dtype), window_strides=(1,),
                                 padding=[(SSD_CONV // 2, SSD_CONV // 2)],
                                 dimension_numbers=('NWC', 'WIO', 'NWC'),
                                 feature_group_count=x.shape[-1])
    return y + bias


def ssd_inputs(xbc, dt_f_raw, dt_b_raw, conv_w, conv_b, dt_bias, a_log):
    f32 = jnp.float32
    b, l, _ = xbc.shape
    xbc = jax.nn.silu(depthwise_conv(xbc, conv_w, conv_b))
    xs, bm, cm = jnp.split(xbc, [SSD_INNER, SSD_INNER + SSD_GROUPS * SSD_STATE], axis=-1)
    xs = xs.reshape(b, l, SSD_HEADS, SSD_HEADDIM)
    rep = SSD_HEADS // SSD_GROUPS
    bm = jnp.repeat(bm.reshape(b, l, SSD_GROUPS, SSD_STATE), rep, axis=2)
    cm = jnp.repeat(cm.reshape(b, l, SSD_GROUPS, SSD_STATE), rep, axis=2)
    a = -jnp.exp(a_log.astype(f32))
    dt_bias = dt_bias.astype(f32)
    dt_f = jax.nn.softplus(dt_f_raw.astype(f32) + dt_bias[0])
    dt_b = jax.nn.softplus(dt_b_raw.astype(f32) + dt_bias[1])
    scan_in = (cm, bm, xs * dt_f[..., None], xs * dt_b[..., None], dt_f * a[0], dt_b * a[1])
    return scan_in, xs


def ssd_output(y, xs, z, d_skip, norm_w):
    b, l = y.shape[:2]
    y = y + xs.astype(jnp.float32) * d_skip.astype(jnp.float32)[:, None]
    y = y.reshape(b, l, SSD_INNER) * jax.nn.silu(z.astype(jnp.float32))
    return rmsnorm(y, norm_w).astype(z.dtype)


def hybrid_mixer(hx, hc, cos, sin, w_in, w_out, mla_q_norm_w, mla_w_qb, mla_kv_norm_w, mla_w_kb,
                 mla_w_vb, ret_decay_logit, ssd_conv_w, ssd_conv_b, ssd_dt_bias, ssd_a_log, ssd_d,
                 ssd_norm_w, with_ctx_out):
    px = split_in(hx @ w_in)
    pc = split_in(hc @ w_in)

    q_x, k_x, v_x = mla_qkv(px[0], px[1], px[2], mla_q_norm_w, mla_w_qb, mla_kv_norm_w, mla_w_kb, mla_w_vb, cos, sin)
    q_c, k_c, v_c = mla_qkv(pc[0], pc[1], pc[2], mla_q_norm_w, mla_w_qb, mla_kv_norm_w, mla_w_kb, mla_w_vb, None, None)
    k_all = jnp.concatenate([k_c, k_x], axis=1)
    v_all = jnp.concatenate([v_c, v_x], axis=1)
    b, l = hx.shape[:2]
    att_x = block_attention(q_x, k_all, v_all).reshape(b, l, MLA_HEADS * MLA_V)

    log_gamma = jax.nn.log_sigmoid(ret_decay_logit.astype(jnp.float32))
    ret_yc, ret_yx = bidir_scan(retention_inputs(pc[3], pc[4], pc[5], log_gamma),
                                retention_inputs(px[3], px[4], px[5], log_gamma), False)
    ret_x = retention_output(ret_yx, px[6])

    ssd_in_c, xs_c = ssd_inputs(pc[8], pc[9], pc[10], ssd_conv_w, ssd_conv_b, ssd_dt_bias, ssd_a_log)
    ssd_in_x, xs_x = ssd_inputs(px[8], px[9], px[10], ssd_conv_w, ssd_conv_b, ssd_dt_bias, ssd_a_log)
    ssd_yc, ssd_yx = bidir_scan(ssd_in_c, ssd_in_x, True)
    ssd_x = ssd_output(ssd_yx, xs_x, px[7], ssd_d, ssd_norm_w)

    out_x = jnp.concatenate([att_x, ret_x, ssd_x], axis=-1) @ w_out
    if not with_ctx_out:
        return out_x, None
    lc = hc.shape[1]
    att_c = block_attention(q_c, k_c, v_c).reshape(b, lc, MLA_HEADS * MLA_V)
    ret_c = retention_output(ret_yc, pc[6])
    ssd_c = ssd_output(ssd_yc, xs_c, pc[7], ssd_d, ssd_norm_w)
    out_c = jnp.concatenate([att_c, ret_c, ssd_c], axis=-1) @ w_out
    return out_x, out_c


def swiglu(h, w_gate, w_up, w_down):
    return (jax.nn.silu(h @ w_gate) * (h @ w_up)) @ w_down


def moe_swiglu(h, router, w_gate, w_up, w_down):
    b, l, d = h.shape
    t = h.reshape(b * l, d)
    logits = (t @ router).astype(jnp.float32)
    top_v, top_i = lax.top_k(logits, TOP_K)
    gates = jax.nn.softmax(top_v, axis=-1)
    dense_gate = jnp.einsum('tk,tke->te', gates,
                            jax.nn.one_hot(top_i, N_EXPERTS, dtype=jnp.float32)).astype(t.dtype)
    out = jnp.zeros_like(t)
    for e in range(N_EXPERTS):
        out = out + dense_gate[:, e:e + 1] * swiglu(t, w_gate[e], w_up[e], w_down[e])
    return out.reshape(b, l, d)


def channel_mix(h, layer, ffn_w_gate, ffn_w_up, ffn_w_down, moe_router, moe_w_gate, moe_w_up, moe_w_down):
    j = layer // 2
    if layer % 2 == 0:
        return swiglu(h, ffn_w_gate[j], ffn_w_up[j], ffn_w_down[j])
    return moe_swiglu(h, moe_router[j], moe_w_gate[j], moe_w_up[j], moe_w_down[j])


def setup_inputs(seed: int = 0) -> dict:
    key = jax.random.key(seed)
    ks = iter(jax.random.split(key, 40))
    f32 = jnp.float32
    D = D_MODEL

    def nrm(shape, scale):
        return jax.random.normal(next(ks), shape, f32) * scale

    def gain(shape):
        return 1.0 + 0.05 * jax.random.normal(next(ks), shape, f32)

    gamma0 = 1.0 - 2.0 ** (-5.0 - np.arange(RET_HEADS))
    ret_base = jnp.asarray(np.log(gamma0 / (1.0 - gamma0)).astype(np.float32))
    u = jax.random.uniform(next(ks), (DEPTH, 2, SSD_HEADS), f32)
    dt0 = jnp.exp(u * (math.log(0.1) - math.log(0.001)) + math.log(0.001))

    return {
        "x": nrm((BATCH, SEQ, D), 1.0),
        "c": nrm((BATCH, D), 1.0),
        "ctx": nrm((BATCH, CTX_LEN, D), 1.0),
        "c_ctx": nrm((D,), 1.0),
        "mod_w": nrm((DEPTH, D, 6 * D), 0.5 * D ** -0.5),
        "mod_b": nrm((DEPTH, 6 * D), 0.01),
        "norm1_w": gain((DEPTH, D)),
        "norm2_w": gain((DEPTH, D)),
        "w_in": nrm((DEPTH, D, IN_WIDTH), D ** -0.5),
        "w_out": nrm((DEPTH, MIX_WIDTH, D), MIX_WIDTH ** -0.5),
        "mla_q_norm_w": gain((DEPTH, MLA_Q_LORA)),
        "mla_w_qb": nrm((DEPTH, MLA_Q_LORA, MLA_HEADS * (MLA_NOPE + MLA_ROPE)), MLA_Q_LORA ** -0.5),
        "mla_kv_norm_w": gain((DEPTH, MLA_KV_LORA)),
        "mla_w_kb": nrm((DEPTH, MLA_KV_LORA, MLA_HEADS * MLA_NOPE), MLA_KV_LORA ** -0.5),
        "mla_w_vb": nrm((DEPTH, MLA_KV_LORA, MLA_HEADS * MLA_V), MLA_KV_LORA ** -0.5),
        "ret_decay_logit": ret_base + nrm((DEPTH, 2, RET_HEADS), 0.1),
        "ssd_conv_w": nrm((DEPTH, SSD_CONV, SSD_CONV_CH), SSD_CONV ** -0.5),
        "ssd_conv_b": nrm((DEPTH, SSD_CONV_CH), 0.01),
        "ssd_dt_bias": dt0 + jnp.log(-jnp.expm1(-dt0)),
        "ssd_a_log": jnp.log(jax.random.uniform(next(ks), (DEPTH, 2, SSD_HEADS), f32, 1.0, 16.0)),
        "ssd_d": gain((DEPTH, SSD_HEADS)),
        "ssd_norm_w": gain((DEPTH, SSD_INNER)),
        "ffn_w_gate": nrm((N_DENSE, D, D_FF), D ** -0.5),
        "ffn_w_up": nrm((N_DENSE, D, D_FF), D ** -0.5),
        "ffn_w_down": nrm((N_DENSE, D_FF, D), D_FF ** -0.5),
        "moe_router": nrm((N_MOE, D, N_EXPERTS), D ** -0.5),
        "moe_w_gate": nrm((N_MOE, N_EXPERTS, D, D_FF_EXPERT), D ** -0.5),
        "moe_w_up": nrm((N_MOE, N_EXPERTS, D, D_FF_EXPERT), D ** -0.5),
        "moe_w_down": nrm((N_MOE, N_EXPERTS, D_FF_EXPERT, D), D_FF_EXPERT ** -0.5),
        "final_norm_w": gain((D,)),
    }


def reference(x, c, ctx, c_ctx, mod_w, mod_b, norm1_w, norm2_w, w_in, w_out, mla_q_norm_w, mla_w_qb,
              mla_kv_norm_w, mla_w_kb, mla_w_vb, ret_decay_logit, ssd_conv_w, ssd_conv_b, ssd_dt_bias,
              ssd_a_log, ssd_d, ssd_norm_w, ffn_w_gate, ffn_w_up, ffn_w_down, moe_router, moe_w_gate,
              moe_w_up, moe_w_down, final_norm_w):
    n_lat = x.shape[1]
    rows = n_lat // GRID_W
    cos, sin = axial_rope_tables(rows, x.dtype)
    silu_c = jax.nn.silu(c)
    silu_cc = jax.nn.silu(c_ctx)
    h_ctx = ctx
    for i in range(DEPTH):
        last = i == DEPTH - 1
        mx = jnp.split((silu_c @ mod_w[i] + mod_b[i])[:, None, :], 6, axis=-1)
        mc = jnp.split(silu_cc @ mod_w[i] + mod_b[i], 6, axis=-1)
        hx = modulate(rmsnorm(x, norm1_w[i]), mx[0], mx[1])
        hc = modulate(rmsnorm(h_ctx, norm1_w[i]), mc[0], mc[1])
        out_x, out_c = hybrid_mixer(hx, hc, cos, sin, w_in[i], w_out[i], mla_q_norm_w[i], mla_w_qb[i],
                                    mla_kv_norm_w[i], mla_w_kb[i], mla_w_vb[i], ret_decay_logit[i],
                                    ssd_conv_w[i], ssd_conv_b[i], ssd_dt_bias[i], ssd_a_log[i], ssd_d[i],
                                    ssd_norm_w[i], not last)
        x = x + mx[2] * out_x
        hx = modulate(rmsnorm(x, norm2_w[i]), mx[3], mx[4])
        x = x + mx[5] * channel_mix(hx, i, ffn_w_gate, ffn_w_up, ffn_w_down,
                                    moe_router, moe_w_gate, moe_w_up, moe_w_down)
        if not last:
            h_ctx = h_ctx + mc[2] * out_c
            hc = modulate(rmsnorm(h_ctx, norm2_w[i]), mc[3], mc[4])
            h_ctx = h_ctx + mc[5] * channel_mix(hc, i, ffn_w_gate, ffn_w_up, ffn_w_down,
                                                moe_router, moe_w_gate, moe_w_up, moe_w_down)
    return rmsnorm(x, final_norm_w)
```

```cpp
#include <hip/hip_runtime.h>
#include <hip/hip_cooperative_groups.h>
#include <cstdio>
#include <cstdint>
namespace cg = cooperative_groups;

#define DEVI __device__ __forceinline__
typedef unsigned short bf16;
typedef short bf16x8 __attribute__((ext_vector_type(8)));
typedef float f32x4 __attribute__((ext_vector_type(4)));
typedef float f32x2 __attribute__((ext_vector_type(2)));
typedef float f32x16 __attribute__((ext_vector_type(16)));
typedef unsigned u32x4 __attribute__((ext_vector_type(4)));
typedef unsigned u32x2 __attribute__((ext_vector_type(2)));
typedef __bf16 bf16x2_t __attribute__((ext_vector_type(2)));

constexpr int D = 1024, NB = 2, SEQ = 8192, NLAT = NB * SEQ, CL = 256, NCTX = NB * CL, T = NLAT + NCTX;
constexpr int INW = 2736, INWP = 2816;
constexpr int C_CQ = 0, C_CKV = 256, C_KPE = 384, C_RQ = 416, C_RK = 672, C_RV = 928, C_RG = 1184, C_Z = 1440, C_XBC = 1952, C_DTF = 2720, C_DTB = 2728;
constexpr int DFF = 2816, DFE = 1408, NEXP = 8;
constexpr float EPS = 1e-6f;
constexpr int MOE_MAXROWS = 34816;

constexpr size_t MiB = 1u << 20;
constexpr size_t WS_CTL = 0;
constexpr size_t WS_MODV = 1 * MiB;
constexpr size_t WS_ROPE = WS_MODV + 256 * 1024;
constexpr size_t WS_RQ = WS_MODV + 512 * 1024;
constexpr size_t WS_RKV = WS_MODV + 640 * 1024;
constexpr size_t WS_WIN = 2 * MiB;
constexpr size_t WS_WQKV = 13 * MiB;
constexpr size_t WS_WOUT = 15 * MiB;
constexpr size_t WS_WGU = 19 * MiB;
constexpr size_t WS_WD = 30 * MiB;
constexpr size_t WS_XC = 36 * MiB;
constexpr size_t WS_RT = 38 * MiB;
constexpr size_t WS_DT = 39 * MiB;
constexpr size_t DYN = 42 * MiB;
constexpr size_t WS_HM = DYN;
constexpr size_t WS_PROJ = DYN + 33 * MiB;
constexpr size_t WS_XBC = DYN + 124 * MiB;
constexpr size_t WS_Q = DYN + 149 * MiB;
constexpr size_t WS_K = DYN + 161 * MiB + 512 * 1024;
constexpr size_t WS_V = DYN + 174 * MiB;
constexpr size_t WS_YT = DYN + 182 * MiB + 512 * 1024;
constexpr size_t WS_WGUE = DYN + 33 * MiB;
constexpr size_t WS_WDE = DYN + 77 * MiB;
constexpr size_t WS_HS = DYN + 99 * MiB;
constexpr size_t WS_ACTS = DYN + 167 * MiB;
constexpr size_t WS_END = DYN + 261 * MiB;
static_assert(WS_HM + (size_t)T * 1024 * 2 <= WS_PROJ && WS_PROJ + (size_t)T * 2816 * 2 <= WS_XBC && WS_XBC + (size_t)T * 768 * 2 <= WS_Q &&
              WS_Q + (size_t)T * 384 * 2 <= WS_K && WS_K + (size_t)T * 384 * 2 <= WS_V && WS_V + (size_t)T * 256 * 2 <= WS_YT && WS_YT + (size_t)T * 768 * 4 <= WS_END, "ws map (mixer)");
static_assert(WS_WGUE + (size_t)8 * 2816 * 1024 * 2 <= WS_WDE && WS_WDE + (size_t)8 * 1024 * 1408 * 2 <= WS_HS && WS_HS + (size_t)MOE_MAXROWS * 1024 * 2 <= WS_ACTS &&
              WS_ACTS + (size_t)MOE_MAXROWS * 1408 * 2 <= WS_END, "ws map (moe)");
static_assert(WS_DT + (size_t)T * 32 * 4 <= DYN && WS_WD + (size_t)1024 * 2816 * 2 <= WS_XC && WS_WIN + (size_t)2 * 2816 * 1024 * 2 <= WS_WQKV, "ws map (static)");

constexpr int NTHREADS = 512, NWAVES = 8;
constexpr int LDS_BYTES = 147456;

struct P { const float* in[30]; float* out; unsigned char* ws; int ph_lo, ph_hi; };
constexpr int LDS_PTRS = 131072 + 1024;
typedef __attribute__((address_space(3))) unsigned long long lds_u64;
DEVI const float* inptr(int i) {
    const unsigned long long v = ((lds_u64*)(uintptr_t)LDS_PTRS)[i];
    const unsigned lo = __builtin_amdgcn_readfirstlane((unsigned)v), hi = __builtin_amdgcn_readfirstlane((unsigned)(v >> 32));
    return (const float*)(((unsigned long long)hi << 32) | lo);
}
#define IN(i) inptr(i)
DEVI int otid() { int t = threadIdx.x; asm volatile("" : "+v"(t)); return t; }

DEVI float bf2f(bf16 x) { return __uint_as_float(((unsigned)x) << 16); }
DEVI unsigned pk2(float lo, float hi) { f32x2 v = {lo, hi}; bf16x2_t b = __builtin_convertvector(v, bf16x2_t); return __builtin_bit_cast(unsigned, b); }
DEVI bf16 f2bf(float x) { return (bf16)(pk2(x, 0.f) & 0xffffu); }
DEVI float wave_sum(float v) {
#pragma unroll
    for (int o = 1; o < 64; o <<= 1) v += __shfl_xor(v, o);
    return v;
}
DEVI float siluf(float x) { return x / (1.f + __expf(-x)); }
DEVI float softplusf(float x) { return fmaxf(x, 0.f) + log1pf(__expf(-fabsf(x))); }
DEVI int rope_src(int p) { const int q = p & 15, s = (q & 1) ? 8 + (q >> 1) : (q >> 1); return (p & 16) + s; }

struct Unit { int pm, pn, e; };
struct Gemm { const bf16* A; const bf16* Bt; size_t bstride; };
struct DenseSched {
    int nM, nN, G, c;
    DEVI bool next(int i, Unit& u) const { const int id = i * G + c; if (id >= nM * nN) return false; u.pm = id / nN; u.pn = id % nN; u.e = 0; return true; }
};
struct MoeSched {
    const int* tab; int nN, G, c;
    DEVI bool next(int i, Unit& u) const { const int id = i * G + c; const int nmt = tab[0]; if (id >= nmt * nN) return false; u.pm = id / nN; u.pn = id % nN; u.e = tab[1 + u.pm]; return true; }
};
template <int LDA, int LDB, int KK, class Epi, class Sched>
DEVI void gemm_phase(const Gemm g, const Sched& S, const Epi& E) {
    const int tid = otid(), wid = __builtin_amdgcn_readfirstlane(tid >> 6), lane = tid & 63, wr = wid >> 2, wc = wid & 3, fr = lane & 15, fq = lane >> 4;
    Unit u;
    for (int i = 0; S.next(i, u); ++i) {
        f32x4 acc[2][2][4][2];
#pragma unroll
        for (int a = 0; a < 2; ++a)
#pragma unroll
            for (int b = 0; b < 2; ++b)
#pragma unroll
                for (int m = 0; m < 4; ++m)
#pragma unroll
                    for (int n = 0; n < 2; ++n) acc[a][b][m][n] = (f32x4){0.f, 0.f, 0.f, 0.f};
        const char* Au = (const char*)(g.A + (size_t)(u.pm * 256 + wr * 64) * LDA);
        const char* Bu = (const char*)(g.Bt + (size_t)u.e * g.bstride + (size_t)(u.pn * 256 + wc * 32) * LDB);
        const unsigned aoff = (unsigned)(fr * LDA + fq * 8) * 2u, boff = (unsigned)(fr * LDB + fq * 8) * 2u;
        for (int k0 = 0; k0 < KK; k0 += 32) {
            bf16x8 b[2][2];
#pragma unroll
            for (int bj = 0; bj < 2; ++bj)
#pragma unroll
                for (int n = 0; n < 2; ++n) b[bj][n] = *(const bf16x8*)(Bu + (size_t)((bj * 128 + n * 16) * LDB) * 2 + (size_t)k0 * 2 + boff);
#pragma unroll
            for (int ai = 0; ai < 2; ++ai) {
                bf16x8 a[4];
#pragma unroll
                for (int m = 0; m < 4; ++m) a[m] = *(const bf16x8*)(Au + (size_t)((ai * 128 + m * 16) * LDA) * 2 + (size_t)k0 * 2 + aoff);
#pragma unroll
                for (int bj = 0; bj < 2; ++bj)
#pragma unroll
                    for (int m = 0; m < 4; ++m)
#pragma unroll
                        for (int n = 0; n < 2; ++n) acc[ai][bj][m][n] = __builtin_amdgcn_mfma_f32_16x16x32_bf16(b[bj][n], a[m], acc[ai][bj][m][n], 0, 0, 0);
            }
        }
        E(acc, u, wr, wc, fr, fq);
    }
}
#define EPI_LOOP_ROWS _Pragma("unroll") for (int ai = 0; ai < 2; ++ai) _Pragma("unroll") for (int m = 0; m < 4; ++m)
#define EPI_ROW (u.pm * 256 + ai * 128 + wr * 64 + m * 16 + fr)
#define EPI_COL(bj, n) (u.pn * 256 + (bj) * 128 + wc * 32 + (n) * 16 + fq * 4)

DEVI void st_bf16x4(bf16* p, f32x4 v) { u32x2 w; w.x = pk2(v[0], v[1]); w.y = pk2(v[2], v[3]); *(u32x2*)p = w; }

struct EpiInProj {
    bf16* proj; float* dt; const float* dt_bias; const float* a_log;
    DEVI void operator()(const f32x4 (&acc)[2][2][4][2], const Unit& u, int wr, int wc, int fr, int fq) const {
        EPI_LOOP_ROWS { const int row = EPI_ROW;
#pragma unroll
            for (int bj = 0; bj < 2; ++bj)
#pragma unroll
                for (int n = 0; n < 2; ++n) { const int col = EPI_COL(bj, n); const f32x4 v = acc[ai][bj][m][n];
                    if (col < C_DTF) st_bf16x4(proj + (size_t)row * INWP + col, v);
                    else if (col < INW) { const int j0 = col - C_DTF; f32x4 dv, lv;
#pragma unroll
                        for (int i = 0; i < 4; ++i) { const float d_ = softplusf(v[i] + dt_bias[j0 + i]); dv[i] = d_; lv[i] = -d_ * __expf(a_log[j0 + i]); }
                        *(f32x4*)(dt + (size_t)row * 32 + j0) = dv; *(f32x4*)(dt + (size_t)row * 32 + 16 + j0) = lv; } } }
    }
};
struct EpiMla {
    bf16 *Q, *K, *V; const float *rq, *rkv; const float* rope;
    DEVI void operator()(const f32x4 (&acc)[2][2][4][2], const Unit& u, int wr, int wc, int fr, int fq) const {
        EPI_LOOP_ROWS { const int row = EPI_ROW; const float sq = rq[row], skv = rkv[row];
#pragma unroll
            for (int bj = 0; bj < 2; ++bj)
#pragma unroll
                for (int n = 0; n < 2; ++n) { const int col = EPI_COL(bj, n); f32x4 v = acc[ai][bj][m][n];
                    if (col < 384) { v = v * sq; const int d = col % 96;
                        if (d >= 64 && row < NLAT) { const int pos = row & (SEQ - 1), gr = pos >> 6, gc = pos & 63, pp = (d - 64) >> 1;
#pragma unroll
                            for (int i = 0; i < 2; ++i) { const int pi = pp + i; const float* tb = (pi < 8) ? rope + (gr * 8 + pi) * 2 : rope + 2048 + (gc * 8 + (pi - 8)) * 2;
                                const float c = tb[0], s = tb[1], x0 = v[2 * i], x1 = v[2 * i + 1]; v[2 * i] = x0 * c - x1 * s; v[2 * i + 1] = x1 * c + x0 * s; } }
                        st_bf16x4(Q + (size_t)row * 384 + col, v); }
                    else if (col >= 512 && col < 768) { const int c = col - 512; st_bf16x4(K + (size_t)row * 384 + (c >> 6) * 96 + (c & 63), v * skv); }
                    else if (col >= 768) { st_bf16x4(V + (size_t)row * 256 + (col - 768), v * skv); } } }
    }
};
struct EpiResid {
    const float* src_lat; const float* src_ctx; float* dst_lat; float* dst_ctx; const float* modv_l; int gidx;
    DEVI void operator()(const f32x4 (&acc)[2][2][4][2], const Unit& u, int wr, int wc, int fr, int fq) const {
        EPI_LOOP_ROWS { const int row = EPI_ROW; const bool lat = row < NLAT; const int r = lat ? (row >> 13) : 2;
            const float* s = lat ? src_lat + (size_t)row * D : src_ctx + (size_t)(row - NLAT) * D; float* d = lat ? dst_lat + (size_t)row * D : dst_ctx + (size_t)(row - NLAT) * D;
            const float* gp = modv_l + r * 6144 + gidx * 1024;
#pragma unroll
            for (int bj = 0; bj < 2; ++bj)
#pragma unroll
                for (int n = 0; n < 2; ++n) { const int col = EPI_COL(bj, n); const f32x4 gv = *(const f32x4*)(gp + col), sv = *(const f32x4*)(s + col);
                    *(f32x4*)(d + col) = sv + gv * acc[ai][bj][m][n]; } }
    }
};
struct EpiSwiglu {
    bf16* act; int ldc;
    DEVI void operator()(const f32x4 (&acc)[2][2][4][2], const Unit& u, int wr, int wc, int fr, int fq) const {
        EPI_LOOP_ROWS { const int row = EPI_ROW;
#pragma unroll
            for (int n = 0; n < 2; ++n) { const f32x4 gt = acc[ai][0][m][n], up = acc[ai][1][m][n]; f32x4 o;
#pragma unroll
                for (int i = 0; i < 4; ++i) o[i] = siluf(gt[i]) * up[i];
                st_bf16x4(act + (size_t)row * ldc + u.pn * 128 + wc * 32 + n * 16 + fq * 4, o); } }
    }
};
struct EpiStore {
    bf16* o; int ldc;
    DEVI void operator()(const f32x4 (&acc)[2][2][4][2], const Unit& u, int wr, int wc, int fr, int fq) const {
        EPI_LOOP_ROWS { const int row = EPI_ROW;
#pragma unroll
            for (int bj = 0; bj < 2; ++bj)
#pragma unroll
                for (int n = 0; n < 2; ++n) st_bf16x4(o + (size_t)row * ldc + EPI_COL(bj, n), acc[ai][bj][m][n]); }
    }
};

template <class F>
DEVI void cvt_job(bf16* dst, int Nd, int Kd, F f, long gtid, long gthreads) {
    const int kch = Kd >> 3; const long nitems = (long)Nd * kch;
    for (long it = gtid; it < nitems; it += gthreads) {
        const int n = (int)(it % Nd), k0 = (int)(it / Nd) * 8;
        u32x4 o; o.x = pk2(f(n, k0), f(n, k0 + 1)); o.y = pk2(f(n, k0 + 2), f(n, k0 + 3)); o.z = pk2(f(n, k0 + 4), f(n, k0 + 5)); o.w = pk2(f(n, k0 + 6), f(n, k0 + 7));
        *(u32x4*)(dst + (size_t)n * Kd + k0) = o;
    }
}
DEVI void ph_pro(const P& p, unsigned char* lds) {
    const int tid = otid(), wid = tid >> 6, lane = tid & 63;
    float* modv = (float*)(p.ws + WS_MODV);
    float* red = (float*)lds;
    for (int item = blockIdx.x; item < 192; item += gridDim.x) {
        const int l = item / 96, n = (item % 96) * 64 + lane;
        const float* W = IN(4) + (size_t)l * 1024 * 6144;
        float a0 = 0.f, a1 = 0.f, a2 = 0.f;
        for (int k = wid * 128; k < wid * 128 + 128; ++k) {
            const float w = W[(size_t)k * 6144 + n];
            a0 += siluf(IN(1)[k]) * w; a1 += siluf(IN(1)[1024 + k]) * w; a2 += siluf(IN(3)[k]) * w;
        }
        red[(wid * 3 + 0) * 64 + lane] = a0; red[(wid * 3 + 1) * 64 + lane] = a1; red[(wid * 3 + 2) * 64 + lane] = a2;
        __syncthreads();
        if (tid < 192) { const int r = tid >> 6, ln = tid & 63; float s = 0.f;
            for (int w = 0; w < 8; ++w) s += red[(w * 3 + r) * 64 + ln];
            const int nn = (item % 96) * 64 + ln; modv[(l * 3 + r) * 6144 + nn] = s + IN(5)[l * 6144 + nn]; }
        __syncthreads();
    }
    if (blockIdx.x == gridDim.x - 1) {
        float* rope = (float*)(p.ws + WS_ROPE);
        for (int idx = tid; idx < 1536; idx += NTHREADS) {
            const int i = idx & 7, pos = (idx < 1024) ? (idx >> 3) : ((idx - 1024) >> 3);
            const float invf = (i == 0) ? 1.f : (i == 1) ? 0.31622776601683794f : (i == 2) ? 0.1f : (i == 3) ? 0.03162277660168379f : (i == 4) ? 0.01f : (i == 5) ? 0.003162277660168379f : (i == 6) ? 0.001f : 0.00031622776601683794f;
            const float ang = (float)pos * invf;
            double rev = (double)ang * 0.15915494309189535; rev -= __builtin_rint(rev);
            const float fr = (float)rev;
            rope[idx * 2] = __builtin_amdgcn_cosf(fr); rope[idx * 2 + 1] = __builtin_amdgcn_sinf(fr);
        }
    }
    const long gtid = (long)blockIdx.x * NTHREADS + tid, gth = (long)gridDim.x * NTHREADS;
    for (int l = 0; l < 2; ++l) {
        { const float* W = IN(8) + (size_t)l * 1024 * INW;
          cvt_job((bf16*)(p.ws + WS_WIN) + (size_t)l * INWP * 1024, INWP, 1024, [=](int n, int k) -> float {
              if (n >= INW) return 0.f; const int sc = (n >= C_KPE && n < C_KPE + 32) ? C_KPE + rope_src(n - C_KPE) : n; return W[(size_t)k * INW + sc]; }, gtid, gth); }
        { const float* Wq = IN(11) + (size_t)l * 256 * 384; const float* qn = IN(10) + l * 256; const float* Wk = IN(13) + (size_t)l * 128 * 256; const float* Wv = IN(14) + (size_t)l * 128 * 256; const float* kn = IN(12) + l * 128;
          const float QS = 0.10206207261596577f * 1.4426950408889634f;
          cvt_job((bf16*)(p.ws + WS_WQKV) + (size_t)l * 1024 * 384, 1024, 384, [=](int n, int k) -> float {
              if (n < 384) { if (k >= 256) return 0.f; const int h = n / 96, d = n % 96; const int sc = (d >= 64) ? h * 96 + 64 + rope_src(d - 64) : n; return Wq[(size_t)k * 384 + sc] * qn[k] * QS; }
              if (n < 512) return 0.f;
              if (k < 256) return 0.f;
              if (n < 768) return Wk[(size_t)(k - 256) * 256 + (n - 512)] * kn[k - 256];
              return Wv[(size_t)(k - 256) * 256 + (n - 768)] * kn[k - 256]; }, gtid, gth); }
        { const float* W = IN(9) + (size_t)l * 1024 * 1024;
          cvt_job((bf16*)(p.ws + WS_WOUT) + (size_t)l * 1024 * 1024, 1024, 1024, [=](int n, int k) -> float { return W[(size_t)k * 1024 + n]; }, gtid, gth); }
    }
    { const float* Wg = IN(22); const float* Wu = IN(23);
      cvt_job((bf16*)(p.ws + WS_WGU), 2 * DFF, 1024, [=](int n, int k) -> float { const int t = n >> 8, r = n & 255; return (r < 128) ? Wg[(size_t)k * DFF + t * 128 + r] : Wu[(size_t)k * DFF + t * 128 + r - 128]; }, gtid, gth); }
    { const float* W = IN(24);
      cvt_job((bf16*)(p.ws + WS_WD), 1024, DFF, [=](int n, int k) -> float { return W[(size_t)k * 1024 + n]; }, gtid, gth); }
}
DEVI void ph_moew(const P& p) {
    const long gtid = (long)blockIdx.x * NTHREADS + otid(), gth = (long)gridDim.x * NTHREADS;
    for (int e = 0; e < NEXP; ++e) {
        { const float* Wg = IN(26) + (size_t)e * 1024 * DFE; const float* Wu = IN(27) + (size_t)e * 1024 * DFE;
          cvt_job((bf16*)(p.ws + WS_WGUE) + (size_t)e * 2 * DFE * 1024, 2 * DFE, 1024, [=](int n, int k) -> float { const int t = n >> 8, r = n & 255; return (r < 128) ? Wg[(size_t)k * DFE + t * 128 + r] : Wu[(size_t)k * DFE + t * 128 + r - 128]; }, gtid, gth); }
        { const float* W = IN(28) + (size_t)e * DFE * 1024;
          cvt_job((bf16*)(p.ws + WS_WDE) + (size_t)e * 1024 * DFE, 1024, DFE, [=](int n, int k) -> float { return W[(size_t)k * 1024 + n]; }, gtid, gth); }
    }
}

DEVI void ph_norm(const P& p, int l, int which, int nrows, bool route) {
    const int tid = otid(), wid = tid >> 6, lane = tid & 63;
    const bool first = (l == 0 && which == 0);
    const float* src_lat = first ? IN(0) : p.out; const float* src_ctx = first ? IN(2) : (const float*)(p.ws + WS_XC);
    const float* w = IN(6 + which) + l * 1024; const float* modv = (const float*)(p.ws + WS_MODV) + (size_t)l * 3 * 6144;
    bf16* H = (bf16*)(p.ws + WS_HM);
    const float* router = IN(25);
    int* rt_e = (int*)(p.ws + WS_RT); float* rt_g = (float*)(p.ws + WS_RT + 128 * 1024);
    for (int row = blockIdx.x * NWAVES + wid; row < nrows; row += gridDim.x * NWAVES) {
        const bool lat = row < NLAT; const int r = lat ? (row >> 13) : 2;
        const float* x = lat ? src_lat + (size_t)row * D : src_ctx + (size_t)(row - NLAT) * D;
        const float* sh = modv + r * 6144 + (which * 3 + 0) * 1024; const float* sc = modv + r * 6144 + (which * 3 + 1) * 1024;
        f32x4 v[4]; float ss = 0.f;
#pragma unroll
        for (int j = 0; j < 4; ++j) { v[j] = *(const f32x4*)(x + (j * 64 + lane) * 4); ss += v[j][0] * v[j][0] + v[j][1] * v[j][1] + v[j][2] * v[j][2] + v[j][3] * v[j][3]; }
        ss = wave_sum(ss); const float rstd = 1.0f / sqrtf(ss * (1.f / D) + EPS);
        float lg[8];
#pragma unroll
        for (int e = 0; e < 8; ++e) lg[e] = 0.f;
#pragma unroll
        for (int j = 0; j < 4; ++j) { const int c0 = (j * 64 + lane) * 4; const f32x4 wv = *(const f32x4*)(w + c0), sv = *(const f32x4*)(sh + c0), cv = *(const f32x4*)(sc + c0);
            f32x4 h;
#pragma unroll
            for (int i = 0; i < 4; ++i) h[i] = (v[j][i] * rstd * wv[i]) * (1.f + cv[i]) + sv[i];
            st_bf16x4(H + (size_t)row * D + c0, h);
            if (route) {
#pragma unroll
                for (int i = 0; i < 4; ++i) { const f32x4 r0 = *(const f32x4*)(router + (size_t)(c0 + i) * 8), r1 = *(const f32x4*)(router + (size_t)(c0 + i) * 8 + 4);
                    lg[0] += h[i] * r0[0]; lg[1] += h[i] * r0[1]; lg[2] += h[i] * r0[2]; lg[3] += h[i] * r0[3]; lg[4] += h[i] * r1[0]; lg[5] += h[i] * r1[1]; lg[6] += h[i] * r1[2]; lg[7] += h[i] * r1[3]; } } }
        if (route) {
#pragma unroll
            for (int e = 0; e < 8; ++e) lg[e] = wave_sum(lg[e]);
            int i1 = 0; float v1 = lg[0];
#pragma unroll
            for (int e = 1; e < 8; ++e) if (lg[e] > v1) { v1 = lg[e]; i1 = e; }
            int i2 = -1; float v2 = -3.0e38f;
#pragma unroll
            for (int e = 0; e < 8; ++e) if (e != i1 && lg[e] > v2) { v2 = lg[e]; i2 = e; }
            const float e2 = __expf(v2 - v1), g1 = 1.f / (1.f + e2), g2 = e2 / (1.f + e2);
            if (lane == 0) { rt_e[row * 2] = i1; rt_e[row * 2 + 1] = i2; rt_g[row * 2] = g1; rt_g[row * 2 + 1] = g2; }
        }
    }
}

DEVI void ph_conv(const P& p, int l) {
    const int tid = otid(), wid = tid >> 6, lane = tid & 63;
    const bf16* proj = (const bf16*)(p.ws + WS_PROJ); bf16* xbc = (bf16*)(p.ws + WS_XBC); bf16* Kb = (bf16*)(p.ws + WS_K);
    float* rq = (float*)(p.ws + WS_RQ); float* rkv = (float*)(p.ws + WS_RKV); const float* rope = (const float*)(p.ws + WS_ROPE);
    const float* cw = IN(16) + (size_t)l * 3 * 768; const float* cb = IN(17) + l * 768;
    for (int row = blockIdx.x * NWAVES + wid; row < T; row += gridDim.x * NWAVES) {
        const bool lat = row < NLAT; const int pos = lat ? (row & (SEQ - 1)) : ((row - NLAT) & (CL - 1)); const int L = lat ? SEQ : CL;
        const bf16* pr = proj + (size_t)row * INWP;
        { const u32x2 a = *(const u32x2*)(pr + lane * 4); const unsigned b = *(const unsigned*)(pr + C_CKV + lane * 2);
          const float q0 = bf2f(a.x & 0xffff), q1 = bf2f(a.x >> 16), q2 = bf2f(a.y & 0xffff), q3 = bf2f(a.y >> 16), k0 = bf2f(b & 0xffff), k1 = bf2f(b >> 16);
          const float sq = wave_sum(q0 * q0 + q1 * q1 + q2 * q2 + q3 * q3), sk = wave_sum(k0 * k0 + k1 * k1);
          if (lane == 0) { rq[row] = 1.0f / sqrtf(sq * (1.f / 256.f) + EPS); rkv[row] = 1.0f / sqrtf(sk * (1.f / 128.f) + EPS); } }
        if (lane < 16) { const unsigned a = *(const unsigned*)(pr + C_KPE + lane * 2); float x0 = bf2f(a & 0xffff), x1 = bf2f(a >> 16);
            if (lat) { const int gr = pos >> 6, gc = pos & 63; const float* tb = (lane < 8) ? rope + (gr * 8 + lane) * 2 : rope + 2048 + (gc * 8 + (lane - 8)) * 2;
                const float c = tb[0], s = tb[1], y0 = x0 * c - x1 * s, y1 = x1 * c + x0 * s; x0 = y0; x1 = y1; }
            const unsigned o = pk2(x0, x1);
#pragma unroll
            for (int h = 0; h < 4; ++h) *(unsigned*)(Kb + (size_t)row * 384 + h * 96 + 64 + lane * 2) = o; }
#pragma unroll
        for (int j = 0; j < 3; ++j) { const int c0 = (j * 64 + lane) * 4;
            const u32x2 xm = (pos > 0) ? *(const u32x2*)(pr - INWP + C_XBC + c0) : (u32x2){0u, 0u}; const u32x2 x0 = *(const u32x2*)(pr + C_XBC + c0);
            const u32x2 xp = (pos < L - 1) ? *(const u32x2*)(pr + INWP + C_XBC + c0) : (u32x2){0u, 0u};
            const f32x4 w0 = *(const f32x4*)(cw + c0), w1 = *(const f32x4*)(cw + 768 + c0), w2 = *(const f32x4*)(cw + 1536 + c0), bb = *(const f32x4*)(cb + c0);
            f32x4 am = {bf2f(xm.x & 0xffff), bf2f(xm.x >> 16), bf2f(xm.y & 0xffff), bf2f(xm.y >> 16)}, a0 = {bf2f(x0.x & 0xffff), bf2f(x0.x >> 16), bf2f(x0.y & 0xffff), bf2f(x0.y >> 16)},
                  ap = {bf2f(xp.x & 0xffff), bf2f(xp.x >> 16), bf2f(xp.y & 0xffff), bf2f(xp.y >> 16)};
            f32x4 y = w0 * am + w1 * a0 + w2 * ap + bb;
#pragma unroll
            for (int i = 0; i < 4; ++i) y[i] = siluf(y[i]);
            st_bf16x4(xbc + (size_t)row * 768 + c0, y); }
    }
}

DEVI void attn_unit(const P& p, int uidx, unsigned char* lds) {
    const int tid = otid(), wid = __builtin_amdgcn_readfirstlane(tid >> 6), lane = tid & 63, r32 = lane & 31, hi = lane >> 5;
    const bf16* Q = (const bf16*)(p.ws + WS_Q); const bf16* K = (const bf16*)(p.ws + WS_K); const bf16* V = (const bf16*)(p.ws + WS_V); bf16* MIX = (bf16*)(p.ws + WS_HM);
    int b, h, qrow0, nseg;
    if (uidx < 256) { b = uidx >> 7; h = (uidx >> 5) & 3; qrow0 = b * SEQ + (uidx & 31) * 256; nseg = 2; }
    else { const int j = uidx - 256; b = j >> 2; h = j & 3; qrow0 = NLAT + b * CL; nseg = 1; }
    bf16* Vt = (bf16*)lds;
    const int qrow = qrow0 + wid * 32 + r32;
    bf16x8 qf[6];
#pragma unroll
    for (int s = 0; s < 6; ++s) qf[s] = *(const bf16x8*)(Q + (size_t)qrow * 384 + h * 96 + s * 16 + hi * 8);
    f32x16 o0, o1;
#pragma unroll
    for (int r = 0; r < 16; ++r) { o0[r] = 0.f; o1[r] = 0.f; }
    float mrun = -1.0e30f, lsum = 0.f;
    for (int seg = 0; seg < nseg; ++seg) {
        const int kbase = (seg == 0) ? NLAT + b * CL : b * SEQ; const int ntile = (seg == 0) ? CL / 32 : SEQ / 32;
        for (int kt = 0; kt < ntile; ++kt) {
            const int krow0 = kbase + kt * 32;
            __syncthreads();
            { const int key = tid >> 4, d0 = (tid & 15) * 4; const u32x2 vv = *(const u32x2*)(V + (size_t)(krow0 + key) * 256 + h * 64 + d0);
              Vt[(d0 + 0) * 40 + key] = (bf16)(vv.x & 0xffff); Vt[(d0 + 1) * 40 + key] = (bf16)(vv.x >> 16); Vt[(d0 + 2) * 40 + key] = (bf16)(vv.y & 0xffff); Vt[(d0 + 3) * 40 + key] = (bf16)(vv.y >> 16); }
            __syncthreads();
            f32x16 st;
#pragma unroll
            for (int r = 0; r < 16; ++r) st[r] = 0.f;
#pragma unroll
            for (int s = 0; s < 6; ++s) { const bf16x8 kf = *(const bf16x8*)(K + (size_t)(krow0 + r32) * 384 + h * 96 + s * 16 + hi * 8); st = __builtin_amdgcn_mfma_f32_32x32x16_bf16(kf, qf[s], st, 0, 0, 0); }
            float mx = st[0];
#pragma unroll
            for (int r = 1; r < 16; ++r) mx = fmaxf(mx, st[r]);
            mx = fmaxf(mx, __shfl_xor(mx, 32));
            const float mnew = fmaxf(mrun, mx), alpha = __builtin_amdgcn_exp2f(mrun - mnew); mrun = mnew;
            float rs = 0.f;
#pragma unroll
            for (int r = 0; r < 16; ++r) { st[r] = __builtin_amdgcn_exp2f(st[r] - mnew); rs += st[r]; }
            lsum = lsum * alpha + rs;
#pragma unroll
            for (int r = 0; r < 16; ++r) { o0[r] *= alpha; o1[r] *= alpha; }
#pragma unroll
            for (int s2 = 0; s2 < 2; ++s2) {
                u32x4 pw; pw.x = pk2(st[8 * s2 + 0], st[8 * s2 + 1]); pw.y = pk2(st[8 * s2 + 2], st[8 * s2 + 3]); pw.z = pk2(st[8 * s2 + 4], st[8 * s2 + 5]); pw.w = pk2(st[8 * s2 + 6], st[8 * s2 + 7]);
                const bf16x8 pb = __builtin_bit_cast(bf16x8, pw);
#pragma unroll
                for (int dh = 0; dh < 2; ++dh) { const bf16* vp = Vt + (dh * 32 + r32) * 40 + 16 * s2 + 4 * hi;
                    const u32x2 lo = *(const u32x2*)vp, hi2 = *(const u32x2*)(vp + 8); u32x4 vw; vw.x = lo.x; vw.y = lo.y; vw.z = hi2.x; vw.w = hi2.y;
                    const bf16x8 va = __builtin_bit_cast(bf16x8, vw);
                    if (dh == 0) o0 = __builtin_amdgcn_mfma_f32_32x32x16_bf16(va, pb, o0, 0, 0, 0); else o1 = __builtin_amdgcn_mfma_f32_32x32x16_bf16(va, pb, o1, 0, 0, 0); }
            }
        }
    }
    lsum += __shfl_xor(lsum, 32);
    const float inv = 1.f / lsum;
    bf16* orow = MIX + (size_t)qrow * D + h * 64;
#pragma unroll
    for (int g = 0; g < 4; ++g) {
        st_bf16x4(orow + 8 * g + 4 * hi, (f32x4){o0[4 * g] * inv, o0[4 * g + 1] * inv, o0[4 * g + 2] * inv, o0[4 * g + 3] * inv});
        st_bf16x4(orow + 32 + 8 * g + 4 * hi, (f32x4){o1[4 * g] * inv, o1[4 * g + 1] * inv, o1[4 * g + 2] * inv, o1[4 * g + 3] * inv});
    }
    __syncthreads();
}

constexpr int SCH = 16;
struct ScanItem { bool ret; int h, b; float qscale, af_c, ab_c; };
template <bool FWD>
DEVI void scan_pass(const P& p, const ScanItem it, int pq, int lane, unsigned char* wl  , float (&H)[16]) {
    const bf16* proj = (const bf16*)(p.ws + WS_PROJ); const bf16* xbc = (const bf16*)(p.ws + WS_XBC); const float* dt = (const float*)(p.ws + WS_DT); float* YT = (float*)(p.ws + WS_YT);
    bf16* qs = (bf16*)wl; bf16* ks = (bf16*)(wl + 2048); float* vs = (float*)(wl + 4096); float* as = (float*)(wl + 5120);
    const int pi = lane >> 2, nq = lane & 3;
    const int ycol = it.ret ? it.h * 64 + pq * 16 + pi : 256 + it.h * 64 + pq * 16 + pi;
    const bool diag = FWD || !it.ret;
#pragma unroll
    for (int i = 0; i < 16; ++i) H[i] = 0.f;
    for (int seg = 0; seg < 2; ++seg) {
        const int rbase = (seg == 0) ? NLAT + it.b * CL : it.b * SEQ; const int L = (seg == 0) ? CL : SEQ; const int nch = L / SCH;
        for (int c = 0; c < nch; ++c) {
            const int t0 = FWD ? c * SCH : L - (c + 1) * SCH;
            asm volatile("s_waitcnt lgkmcnt(0)" ::: "memory");
#pragma unroll
            for (int i = 0; i < 2; ++i) { const int piece = lane + 64 * i, srow = piece >> 3, part = piece & 7; const size_t r = (size_t)(rbase + t0 + srow);
                const bf16* qp = it.ret ? proj + r * INWP + C_RQ + it.h * 64 : xbc + r * 768 + 640 + (it.h >> 2) * 64;
                const bf16* kp = it.ret ? proj + r * INWP + C_RK + it.h * 64 : xbc + r * 768 + 512 + (it.h >> 2) * 64;
                *(u32x4*)(qs + srow * 64 + part * 8) = *(const u32x4*)(qp + part * 8); *(u32x4*)(ks + srow * 64 + part * 8) = *(const u32x4*)(kp + part * 8); }
            { const int srow = lane >> 2, p0 = (lane & 3) * 4; const size_t r = (size_t)(rbase + t0 + srow);
              const bf16* vp = it.ret ? proj + r * INWP + C_RV + it.h * 64 + pq * 16 + p0 : xbc + r * 768 + it.h * 64 + pq * 16 + p0;
              const u32x2 vv = *(const u32x2*)vp; const float sc = it.ret ? 1.f : dt[r * 32 + (FWD ? 0 : 8) + it.h];
              *(f32x4*)(vs + srow * 16 + p0) = (f32x4){bf2f(vv.x & 0xffff) * sc, bf2f(vv.x >> 16) * sc, bf2f(vv.y & 0xffff) * sc, bf2f(vv.y >> 16) * sc}; }
            if (lane < 16) { const size_t r = (size_t)(rbase + t0 + lane); as[lane] = it.ret ? (FWD ? it.af_c : it.ab_c) : __expf(dt[r * 32 + (FWD ? 16 : 24) + it.h]); }
            asm volatile("s_waitcnt vmcnt(0) lgkmcnt(0)" ::: "memory");
            for (int s_ = 0; s_ < SCH; ++s_) {
                const int s = FWD ? s_ : SCH - 1 - s_;
                const float a = as[s], v = vs[s * 16 + pi];
                float qv[16], kv[16];
#pragma unroll
                for (int j = 0; j < 2; ++j) { const u32x4 qa = *(const u32x4*)(qs + s * 64 + nq * 16 + j * 8), ka = *(const u32x4*)(ks + s * 64 + nq * 16 + j * 8);
                    qv[8 * j + 0] = bf2f(qa.x & 0xffff); qv[8 * j + 1] = bf2f(qa.x >> 16); qv[8 * j + 2] = bf2f(qa.y & 0xffff); qv[8 * j + 3] = bf2f(qa.y >> 16);
                    qv[8 * j + 4] = bf2f(qa.z & 0xffff); qv[8 * j + 5] = bf2f(qa.z >> 16); qv[8 * j + 6] = bf2f(qa.w & 0xffff); qv[8 * j + 7] = bf2f(qa.w >> 16);
                    kv[8 * j + 0] = bf2f(ka.x & 0xffff); kv[8 * j + 1] = bf2f(ka.x >> 16); kv[8 * j + 2] = bf2f(ka.y & 0xffff); kv[8 * j + 3] = bf2f(ka.y >> 16);
                    kv[8 * j + 4] = bf2f(ka.z & 0xffff); kv[8 * j + 5] = bf2f(ka.z >> 16); kv[8 * j + 6] = bf2f(ka.w & 0xffff); kv[8 * j + 7] = bf2f(ka.w >> 16); }
                float y = 0.f;
#pragma unroll
                for (int i = 0; i < 16; ++i) { const float hd = a * H[i], hn = hd + kv[i] * v; y += qv[i] * (diag ? hn : hd); H[i] = hn; }
                y += __shfl_xor(y, 1); y += __shfl_xor(y, 2);
                y *= it.qscale;
                if (nq == 0) { float* yp = YT + (size_t)(rbase + t0 + s) * 768 + ycol; if (FWD) *yp += y; else *yp = y; }
            }
        }
    }
}
DEVI void scan_unit(const P& p, int l, int uidx, unsigned char* lds) {
    const int tid = otid(), wid = __builtin_amdgcn_readfirstlane(tid >> 6), lane = tid & 63;
    const int item = uidx * 2 + (wid >> 2), pq = wid & 3;
    ScanItem it; it.b = item / 12; const int hh = item % 12; it.ret = hh < 4; it.h = it.ret ? hh : hh - 4; it.qscale = it.ret ? 0.125f : 1.f;
    it.af_c = 0.f; it.ab_c = 0.f;
    if (it.ret) { const float lf = IN(15)[l * 8 + it.h], lb = IN(15)[l * 8 + 4 + it.h]; it.af_c = 1.f / (1.f + __expf(-lf)); it.ab_c = 1.f / (1.f + __expf(-lb)); }
    unsigned char* wl = lds + wid * 6144;
    float H[16];
    scan_pass<false>(p, it, pq, lane, wl, H);
    scan_pass<true>(p, it, pq, lane, wl, H);
    __syncthreads();
    const bf16* proj = (const bf16*)(p.ws + WS_PROJ); const bf16* xbc = (const bf16*)(p.ws + WS_XBC); float* YT = (float*)(p.ws + WS_YT); bf16* MIX = (bf16*)(p.ws + WS_HM);
    const float dskip = it.ret ? 0.f : IN(20)[l * 8 + it.h];
    for (int tt = pq; tt < CL + SEQ; tt += 4) {
        const size_t r = (tt < CL) ? (size_t)(NLAT + it.b * CL + tt) : (size_t)(it.b * SEQ + tt - CL);
        if (it.ret) { const float y = YT[r * 768 + it.h * 64 + lane]; const float mu = wave_sum(y) * (1.f / 64.f); const float dlt = y - mu; const float var = wave_sum(dlt * dlt) * (1.f / 64.f);
            const float yn = dlt * (1.0f / sqrtf(var + EPS)); const float g = bf2f(proj[r * INWP + C_RG + it.h * 64 + lane]);
            MIX[r * D + 256 + it.h * 64 + lane] = f2bf(yn * siluf(g)); }
        else { float y = YT[r * 768 + 256 + it.h * 64 + lane]; y += bf2f(xbc[r * 768 + it.h * 64 + lane]) * dskip; const float z = bf2f(proj[r * INWP + C_Z + it.h * 64 + lane]);
            YT[r * 768 + 256 + it.h * 64 + lane] = y * siluf(z); }
    }
    __syncthreads();
}
DEVI void ph_mixer(const P& p, int l, unsigned char* lds) {
    const int nattn = (l == 0) ? 256 + 8 : 256; const int nunits = 12 + nattn;
    for (int u = blockIdx.x; u < nunits; u += gridDim.x) { if (u < 12) scan_unit(p, l, u, lds); else attn_unit(p, u - 12, lds); }
}
DEVI void ph_scanfin(const P& p, int l) {
    const int tid = otid(), wid = tid >> 6, lane = tid & 63;
    const float* YT = (const float*)(p.ws + WS_YT); bf16* MIX = (bf16*)(p.ws + WS_HM); const float* nw = IN(21) + l * 512;
    for (int row = blockIdx.x * NWAVES + wid; row < T; row += gridDim.x * NWAVES) {
        const f32x4 a = *(const f32x4*)(YT + (size_t)row * 768 + 256 + lane * 4), b = *(const f32x4*)(YT + (size_t)row * 768 + 512 + lane * 4);
        float ss = a[0] * a[0] + a[1] * a[1] + a[2] * a[2] + a[3] * a[3] + b[0] * b[0] + b[1] * b[1] + b[2] * b[2] + b[3] * b[3];
        ss = wave_sum(ss); const float rstd = 1.0f / sqrtf(ss * (1.f / 512.f) + EPS);
        const f32x4 wa = *(const f32x4*)(nw + lane * 4), wb = *(const f32x4*)(nw + 256 + lane * 4);
        st_bf16x4(MIX + (size_t)row * D + 512 + lane * 4, a * rstd * wa); st_bf16x4(MIX + (size_t)row * D + 768 + lane * 4, b * rstd * wb);
    }
}

DEVI void ph_sort(const P& p, unsigned char* lds) {
    const int tid = otid(), wid = tid >> 6, lane = tid & 63;
    const int* rt_e = (const int*)(p.ws + WS_RT); int* rt_pos = (int*)(p.ws + WS_RT + 256 * 1024); int* tab = (int*)(p.ws + WS_RT + 384 * 1024);
    const bf16* H = (const bf16*)(p.ws + WS_HM); bf16* HS = (bf16*)(p.ws + WS_HS);
    int* sh = (int*)lds;
    const int G = gridDim.x, R = (NLAT + G - 1) / G;
    for (int blk = blockIdx.x; blk * R < NLAT; blk += G) {
        const int r0 = blk * R, r1 = (r0 + R < NLAT) ? r0 + R : NLAT;
        int ct[8], cb[8];
#pragma unroll
        for (int e = 0; e < 8; ++e) { ct[e] = 0; cb[e] = 0; }
        for (int i = tid; i < NLAT * 2; i += NTHREADS) { const int e = rt_e[i]; const bool bef = (i >> 1) < r0;
#pragma unroll
            for (int x = 0; x < 8; ++x) { const int hit = (e == x) ? 1 : 0; ct[x] += hit; cb[x] += bef ? hit : 0; } }
#pragma unroll
        for (int e = 0; e < 8; ++e) {
#pragma unroll
            for (int o = 1; o < 64; o <<= 1) { ct[e] += __shfl_xor(ct[e], o); cb[e] += __shfl_xor(cb[e], o); }
        }
        __syncthreads();
        if (lane == 0) {
#pragma unroll
            for (int e = 0; e < 8; ++e) { sh[wid * 8 + e] = ct[e]; sh[64 + wid * 8 + e] = cb[e]; } }
        __syncthreads();
        if (tid == 0) { int start = 0, nt = 0;
            for (int e = 0; e < 8; ++e) { int tot = 0, bef = 0; for (int w = 0; w < 8; ++w) { tot += sh[w * 8 + e]; bef += sh[64 + w * 8 + e]; }
                sh[128 + e] = start; sh[136 + e] = start + bef; const int ntile = (tot + 255) >> 8;
                if (blk == 0) { for (int t = 0; t < ntile; ++t) tab[1 + nt + t] = e; }
                nt += ntile; start += ntile * 256; }
            if (blk == 0) tab[0] = nt; }
        __syncthreads();
        if (tid < 8) { int run = sh[136 + tid]; for (int i = r0 * 2; i < r1 * 2; ++i) if (rt_e[i] == tid) { sh[256 + i - r0 * 2] = run; rt_pos[i] = run; ++run; } }
        __syncthreads();
        for (int i = wid; i < (r1 - r0) * 2; i += NWAVES) { const int row = r0 + (i >> 1), pos = sh[256 + i];
            const u32x4* s = (const u32x4*)(H + (size_t)row * D); u32x4* d = (u32x4*)(HS + (size_t)pos * D); d[lane] = s[lane]; d[lane + 64] = s[lane + 64]; }
        __syncthreads();
    }
}
DEVI void ph_final(const P& p) {
    const int tid = otid(), wid = tid >> 6, lane = tid & 63;
    const float* rt_g = (const float*)(p.ws + WS_RT + 128 * 1024); const int* rt_pos = (const int*)(p.ws + WS_RT + 256 * 1024);
    const bf16* YS = (const bf16*)(p.ws + WS_HS); const float* modv = (const float*)(p.ws + WS_MODV) + (size_t)1 * 3 * 6144; const float* fw = IN(29);
    for (int row = blockIdx.x * NWAVES + wid; row < NLAT; row += gridDim.x * NWAVES) {
        const int b = row >> 13; const float* gp = modv + b * 6144 + 5 * 1024; float* x = p.out + (size_t)row * D;
        const float g0 = rt_g[row * 2], g1 = rt_g[row * 2 + 1]; const bf16* y0 = YS + (size_t)rt_pos[row * 2] * D; const bf16* y1 = YS + (size_t)rt_pos[row * 2 + 1] * D;
        f32x4 v[4]; float ss = 0.f;
#pragma unroll
        for (int j = 0; j < 4; ++j) { const int c0 = (j * 64 + lane) * 4; const f32x4 xv = *(const f32x4*)(x + c0), gv = *(const f32x4*)(gp + c0); const u32x2 a = *(const u32x2*)(y0 + c0), c = *(const u32x2*)(y1 + c0);
            const f32x4 ya = {bf2f(a.x & 0xffff), bf2f(a.x >> 16), bf2f(a.y & 0xffff), bf2f(a.y >> 16)}, yb = {bf2f(c.x & 0xffff), bf2f(c.x >> 16), bf2f(c.y & 0xffff), bf2f(c.y >> 16)};
            v[j] = xv + gv * (ya * g0 + yb * g1); ss += v[j][0] * v[j][0] + v[j][1] * v[j][1] + v[j][2] * v[j][2] + v[j][3] * v[j][3]; }
        ss = wave_sum(ss); const float rstd = 1.0f / sqrtf(ss * (1.f / D) + EPS);
#pragma unroll
        for (int j = 0; j < 4; ++j) { const int c0 = (j * 64 + lane) * 4; const f32x4 wv = *(const f32x4*)(fw + c0); *(f32x4*)(x + c0) = v[j] * rstd * wv; }
    }
}

constexpr int NPHASES = 24;
__global__ void __launch_bounds__(NTHREADS, 2) mk_fwd(P p) {
    extern __shared__ __attribute__((aligned(16))) unsigned char lds[];
    cg::grid_group grid = cg::this_grid();
    const int G = gridDim.x, c = blockIdx.x;
    if (threadIdx.x < 30) ((lds_u64*)(uintptr_t)LDS_PTRS)[threadIdx.x] = (unsigned long long)p.in[threadIdx.x];
    __syncthreads();
    int ph = 0;
#define RUN(...) do { if (ph >= p.ph_lo && ph < p.ph_hi) { __VA_ARGS__; if (ph + 1 < p.ph_hi) grid.sync(); } ++ph; } while (0)
    RUN(ph_pro(p, lds));
#define LAYER(l) \
        RUN(ph_norm(p, l, 0, T, false)); \
        RUN({ Gemm g{(const bf16*)(p.ws + WS_HM), (const bf16*)(p.ws + WS_WIN) + (size_t)l * INWP * 1024, 0}; DenseSched S{T / 256, INWP / 256, G, c}; \
            EpiInProj E{(bf16*)(p.ws + WS_PROJ), (float*)(p.ws + WS_DT), IN(18) + l * 16, IN(19) + l * 16}; gemm_phase<D, 1024, 1024>(g, S, E); }); \
        RUN(ph_conv(p, l)); \
        RUN({ Gemm g{(const bf16*)(p.ws + WS_PROJ), (const bf16*)(p.ws + WS_WQKV) + (size_t)l * 1024 * 384, 0}; DenseSched S{T / 256, 4, G, c}; \
            EpiMla E{(bf16*)(p.ws + WS_Q), (bf16*)(p.ws + WS_K), (bf16*)(p.ws + WS_V), (const float*)(p.ws + WS_RQ), (const float*)(p.ws + WS_RKV), (const float*)(p.ws + WS_ROPE)}; gemm_phase<INWP, 384, 384>(g, S, E); }); \
        RUN(ph_mixer(p, l, lds)); \
        RUN(ph_scanfin(p, l)); \
        if (l == 1) RUN(ph_moew(p)); \
        RUN({ Gemm g{(const bf16*)(p.ws + WS_HM), (const bf16*)(p.ws + WS_WOUT) + (size_t)l * 1024 * 1024, 0}; DenseSched S{(l == 0 ? T : NLAT) / 256, 4, G, c}; \
            EpiResid E{l == 0 ? IN(0) : p.out, l == 0 ? IN(2) : (const float*)(p.ws + WS_XC), p.out, (float*)(p.ws + WS_XC), (const float*)(p.ws + WS_MODV) + (size_t)l * 3 * 6144, 2}; gemm_phase<D, 1024, 1024>(g, S, E); }); \
        RUN(ph_norm(p, l, 1, l == 0 ? T : NLAT, l == 1)); \
        if (l == 0) { \
            RUN({ Gemm g{(const bf16*)(p.ws + WS_HM), (const bf16*)(p.ws + WS_WGU), 0}; DenseSched S{T / 256, 2 * DFF / 256, G, c}; \
                EpiSwiglu E{(bf16*)(p.ws + WS_PROJ), DFF}; gemm_phase<D, 1024, 1024>(g, S, E); }); \
            RUN({ Gemm g{(const bf16*)(p.ws + WS_PROJ), (const bf16*)(p.ws + WS_WD), 0}; DenseSched S{T / 256, 4, G, c}; \
                EpiResid E{p.out, (const float*)(p.ws + WS_XC), p.out, (float*)(p.ws + WS_XC), (const float*)(p.ws + WS_MODV), 5}; gemm_phase<DFF, DFF, DFF>(g, S, E); }); \
        } else { \
            RUN(ph_sort(p, lds)); \
            RUN({ Gemm g{(const bf16*)(p.ws + WS_HS), (const bf16*)(p.ws + WS_WGUE), (size_t)2 * DFE * 1024}; MoeSched S{(const int*)(p.ws + WS_RT + 384 * 1024), 2 * DFE / 256, G, c}; \
                EpiSwiglu E{(bf16*)(p.ws + WS_ACTS), DFE}; gemm_phase<D, 1024, 1024>(g, S, E); }); \
            RUN({ Gemm g{(const bf16*)(p.ws + WS_ACTS), (const bf16*)(p.ws + WS_WDE), (size_t)1024 * DFE}; MoeSched S{(const int*)(p.ws + WS_RT + 384 * 1024), 4, G, c}; \
                EpiStore E{(bf16*)(p.ws + WS_HS), D}; gemm_phase<DFE, DFE, DFE>(g, S, E); }); \
            RUN(ph_final(p)); \
        }
    LAYER(0)
    LAYER(1)
#undef LAYER
#undef RUN
}

#ifndef MK_ONE_LAUNCH
#define MK_ONE_LAUNCH 0
#endif
extern "C" void kernel_launch(void* const* d_in, const int* in_sizes, int n_in, void* d_out, int out_size, void* d_ws, size_t ws_size, hipStream_t stream) {
    static int grid = 0;
    if (grid == 0) {
        if (n_in != 30 || out_size != NLAT * D || ws_size < WS_END) { fprintf(stderr, "kernel_launch: unexpected problem (n_in %d out %d ws %zu, need %zu)\n", n_in, out_size, ws_size, (size_t)WS_END); grid = -1; return; }
        int dev = 0, cus = 0, per_cu = 0;
        hipGetDevice(&dev); hipDeviceGetAttribute(&cus, hipDeviceAttributeMultiprocessorCount, dev);
        if (hipFuncSetAttribute((const void*)mk_fwd, hipFuncAttributeMaxDynamicSharedMemorySize, LDS_BYTES) != hipSuccess) { fprintf(stderr, "kernel_launch: hipFuncSetAttribute failed\n"); grid = -1; return; }
        if (hipOccupancyMaxActiveBlocksPerMultiprocessor(&per_cu, (const void*)mk_fwd, NTHREADS, LDS_BYTES) != hipSuccess || per_cu < 1) { fprintf(stderr, "kernel_launch: occupancy query failed (%d)\n", per_cu); grid = -1; return; }
        grid = cus;
        fprintf(stderr, "kernel_launch: grid %d (cus %d, per_cu %d)\n", grid, cus, per_cu);
    }
    if (grid < 0) return;
    P p{};
    for (int i = 0; i < 30; ++i) p.in[i] = (const float*)d_in[i];
    p.out = (float*)d_out; p.ws = (unsigned char*)d_ws;
#if MK_ONE_LAUNCH
    p.ph_lo = 0; p.ph_hi = NPHASES;
    { void* args[] = {&p}; hipError_t e = hipLaunchCooperativeKernel((const void*)mk_fwd, dim3(grid), dim3(NTHREADS), args, LDS_BYTES, stream);
      if (e != hipSuccess) fprintf(stderr, "cooperative launch failed: %s\n", hipGetErrorString(e)); }
#else
    for (int ph = 0; ph < NPHASES; ++ph) {
        p.ph_lo = ph; p.ph_hi = ph + 1;
        void* args[] = {&p}; hipError_t e = hipLaunchCooperativeKernel((const void*)mk_fwd, dim3(grid), dim3(NTHREADS), args, LDS_BYTES, stream);
        if (e != hipSuccess) { fprintf(stderr, "cooperative launch %d failed: %s\n", ph, hipGetErrorString(e)); break; }
    }
#endif
}
```

```cpp
#include <hip/hip_runtime.h>
#include <hip/hip_cooperative_groups.h>
#include <cstdio>
#include <cstdint>
namespace cg = cooperative_groups;

#define DEVI __device__ __forceinline__
typedef unsigned short bf16;
typedef short bf16x8 __attribute__((ext_vector_type(8)));
typedef float f32x4 __attribute__((ext_vector_type(4)));
typedef float f32x2 __attribute__((ext_vector_type(2)));
typedef float f32x16 __attribute__((ext_vector_type(16)));
typedef unsigned u32x4 __attribute__((ext_vector_type(4)));
typedef unsigned u32x2 __attribute__((ext_vector_type(2)));
typedef __bf16 bf16x2_t __attribute__((ext_vector_type(2)));

constexpr int D = 1024, NB = 2, SEQ = 8192, NLAT = NB * SEQ, CL = 256, NCTX = NB * CL, T = NLAT + NCTX;
constexpr int INW = 2736, INWP = 2816;
constexpr int C_CQ = 0, C_CKV = 256, C_KPE = 384, C_RQ = 416, C_RK = 672, C_RV = 928, C_RG = 1184, C_Z = 1440, C_XBC = 1952, C_DTF = 2720, C_DTB = 2728;
constexpr int DFF = 2816, DFE = 1408, NEXP = 8;
constexpr float EPS = 1e-6f;
constexpr int MOE_MAXROWS = 34816;

constexpr size_t MiB = 1u << 20;
constexpr size_t WS_CTL = 0;
constexpr size_t WS_MODV = 1 * MiB;
constexpr size_t WS_ROPE = WS_MODV + 256 * 1024;
constexpr size_t WS_RQ = WS_MODV + 512 * 1024;
constexpr size_t WS_RKV = WS_MODV + 640 * 1024;
constexpr size_t WS_WIN = 2 * MiB;
constexpr size_t WS_WQKV = 13 * MiB;
constexpr size_t WS_WOUT = 15 * MiB;
constexpr size_t WS_WGU = 19 * MiB;
constexpr size_t WS_WD = 30 * MiB;
constexpr size_t WS_XC = 36 * MiB;
constexpr size_t WS_RT = 38 * MiB;
constexpr size_t WS_DT = 39 * MiB;
constexpr size_t DYN = 42 * MiB;
constexpr size_t WS_HM = DYN;
constexpr size_t WS_PROJ = DYN + 33 * MiB;
constexpr size_t WS_XBC = DYN + 124 * MiB;
constexpr size_t WS_Q = DYN + 149 * MiB;
constexpr size_t WS_K = DYN + 161 * MiB + 512 * 1024;
constexpr size_t WS_V = DYN + 174 * MiB;
constexpr size_t WS_ST = DYN + 182 * MiB + 512 * 1024;
constexpr size_t WS_HT = WS_ST + (size_t)1584 * 2 * 4096 * 4;
constexpr size_t WS_CD = WS_RT + 512 * 1024;
constexpr size_t WS_WGUE = DYN + 33 * MiB;
constexpr size_t WS_WDE = DYN + 77 * MiB;
constexpr size_t WS_HS = DYN + 99 * MiB;
constexpr size_t WS_ACTS = DYN + 167 * MiB;
constexpr size_t WS_END = DYN + 261 * MiB;
static_assert(WS_HM + (size_t)T * 1024 * 2 <= WS_PROJ && WS_PROJ + (size_t)T * 2816 * 2 <= WS_XBC && WS_XBC + (size_t)T * 768 * 2 <= WS_Q &&
              WS_Q + (size_t)T * 384 * 2 <= WS_K && WS_K + (size_t)T * 384 * 2 <= WS_V && WS_V + (size_t)T * 256 * 2 <= WS_ST && WS_HT + (size_t)1584 * 2 * 4096 * 2 <= WS_END, "ws map (mixer)");
static_assert(WS_WGUE + (size_t)8 * 2816 * 1024 * 2 <= WS_WDE && WS_WDE + (size_t)8 * 1024 * 1408 * 2 <= WS_HS && WS_HS + (size_t)MOE_MAXROWS * 1024 * 2 <= WS_ACTS &&
              WS_ACTS + (size_t)MOE_MAXROWS * 1408 * 2 <= WS_END, "ws map (moe)");
static_assert(WS_DT + (size_t)T * 32 * 4 <= DYN && WS_WD + (size_t)1024 * 2816 * 2 <= WS_XC && WS_WIN + (size_t)2 * 2816 * 1024 * 2 <= WS_WQKV, "ws map (static)");

constexpr int NTHREADS = 512, NWAVES = 8;
constexpr int LDS_BYTES = 147456;

struct P { const float* in[30]; float* out; unsigned char* ws; int ph_lo, ph_hi; };
constexpr int LDS_PTRS = 131072 + 1024;
typedef __attribute__((address_space(3))) unsigned long long lds_u64;
DEVI const float* inptr(int i) {
    const unsigned long long v = ((lds_u64*)(uintptr_t)LDS_PTRS)[i];
    const unsigned lo = __builtin_amdgcn_readfirstlane((unsigned)v), hi = __builtin_amdgcn_readfirstlane((unsigned)(v >> 32));
    return (const float*)(((unsigned long long)hi << 32) | lo);
}
#define IN(i) inptr(i)
DEVI int otid() { int t = threadIdx.x; asm volatile("" : "+v"(t)); return t; }

DEVI float bf2f(bf16 x) { return __uint_as_float(((unsigned)x) << 16); }
DEVI unsigned pk2(float lo, float hi) { f32x2 v = {lo, hi}; bf16x2_t b = __builtin_convertvector(v, bf16x2_t); return __builtin_bit_cast(unsigned, b); }
DEVI bf16 f2bf(float x) { return (bf16)(pk2(x, 0.f) & 0xffffu); }
DEVI float wave_sum(float v) {
#pragma unroll
    for (int o = 1; o < 64; o <<= 1) v += __shfl_xor(v, o);
    return v;
}
DEVI float siluf(float x) { return x / (1.f + __expf(-x)); }
DEVI float softplusf(float x) { return fmaxf(x, 0.f) + log1pf(__expf(-fabsf(x))); }
DEVI int rope_src(int p) { const int q = p & 15, s = (q & 1) ? 8 + (q >> 1) : (q >> 1); return (p & 16) + s; }

struct Unit { int pm, pn, e; };
struct Gemm { const bf16* A; const bf16* Bt; size_t bstride; };
struct DenseSched {
    int nM, nN, G, c;
    DEVI bool next(int i, Unit& u) const { const int id = i * G + c; if (id >= nM * nN) return false; u.pm = id / nN; u.pn = id % nN; u.e = 0; return true; }
};
struct MoeSched {
    const int* tab; int nN, G, c;
    DEVI bool next(int i, Unit& u) const { const int id = i * G + c; const int nmt = tab[0]; if (id >= nmt * nN) return false; u.pm = id / nN; u.pn = id % nN; u.e = tab[1 + u.pm]; return true; }
};
template <int LDA, int LDB, int KK, class Epi, class Sched>
DEVI void gemm_phase(const Gemm g, const Sched& S, const Epi& E) {
    const int tid = otid(), wid = __builtin_amdgcn_readfirstlane(tid >> 6), lane = tid & 63, wr = wid >> 2, wc = wid & 3, fr = lane & 15, fq = lane >> 4;
    Unit u;
    for (int i = 0; S.next(i, u); ++i) {
        f32x4 acc[2][2][4][2];
#pragma unroll
        for (int a = 0; a < 2; ++a)
#pragma unroll
            for (int b = 0; b < 2; ++b)
#pragma unroll
                for (int m = 0; m < 4; ++m)
#pragma unroll
                    for (int n = 0; n < 2; ++n) acc[a][b][m][n] = (f32x4){0.f, 0.f, 0.f, 0.f};
        const char* Au = (const char*)(g.A + (size_t)(u.pm * 256 + wr * 64) * LDA);
        const char* Bu = (const char*)(g.Bt + (size_t)u.e * g.bstride + (size_t)(u.pn * 256 + wc * 32) * LDB);
        const unsigned aoff = (unsigned)(fr * LDA + fq * 8) * 2u, boff = (unsigned)(fr * LDB + fq * 8) * 2u;
        for (int k0 = 0; k0 < KK; k0 += 32) {
            bf16x8 b[2][2];
#pragma unroll
            for (int bj = 0; bj < 2; ++bj)
#pragma unroll
                for (int n = 0; n < 2; ++n) b[bj][n] = *(const bf16x8*)(Bu + (size_t)((bj * 128 + n * 16) * LDB) * 2 + (size_t)k0 * 2 + boff);
#pragma unroll
            for (int ai = 0; ai < 2; ++ai) {
                bf16x8 a[4];
#pragma unroll
                for (int m = 0; m < 4; ++m) a[m] = *(const bf16x8*)(Au + (size_t)((ai * 128 + m * 16) * LDA) * 2 + (size_t)k0 * 2 + aoff);
#pragma unroll
                for (int bj = 0; bj < 2; ++bj)
#pragma unroll
                    for (int m = 0; m < 4; ++m)
#pragma unroll
                        for (int n = 0; n < 2; ++n) acc[ai][bj][m][n] = __builtin_amdgcn_mfma_f32_16x16x32_bf16(b[bj][n], a[m], acc[ai][bj][m][n], 0, 0, 0);
            }
        }
        E(acc, u, wr, wc, fr, fq);
    }
}
#define EPI_LOOP_ROWS _Pragma("unroll") for (int ai = 0; ai < 2; ++ai) _Pragma("unroll") for (int m = 0; m < 4; ++m)
#define EPI_ROW (u.pm * 256 + ai * 128 + wr * 64 + m * 16 + fr)
#define EPI_COL(bj, n) (u.pn * 256 + (bj) * 128 + wc * 32 + (n) * 16 + fq * 4)

DEVI void st_bf16x4(bf16* p, f32x4 v) { u32x2 w; w.x = pk2(v[0], v[1]); w.y = pk2(v[2], v[3]); *(u32x2*)p = w; }

struct EpiInProj {
    bf16* proj; float* dt; const float* dt_bias; const float* a_log;
    DEVI void operator()(const f32x4 (&acc)[2][2][4][2], const Unit& u, int wr, int wc, int fr, int fq) const {
        EPI_LOOP_ROWS { const int row = EPI_ROW;
#pragma unroll
            for (int bj = 0; bj < 2; ++bj)
#pragma unroll
                for (int n = 0; n < 2; ++n) { const int col = EPI_COL(bj, n); const f32x4 v = acc[ai][bj][m][n];
                    if (col < C_DTF) st_bf16x4(proj + (size_t)row * INWP + col, v);
                    else if (col < INW) { const int j0 = col - C_DTF; f32x4 dv, lv;
#pragma unroll
                        for (int i = 0; i < 4; ++i) { const float d_ = softplusf(v[i] + dt_bias[j0 + i]); dv[i] = d_; lv[i] = -d_ * __expf(a_log[j0 + i]); }
                        *(f32x4*)(dt + (size_t)row * 32 + j0) = dv; *(f32x4*)(dt + (size_t)row * 32 + 16 + j0) = lv; } } }
    }
};
struct EpiMla {
    bf16 *Q, *K, *V; const float *rq, *rkv; const float* rope;
    DEVI void operator()(const f32x4 (&acc)[2][2][4][2], const Unit& u, int wr, int wc, int fr, int fq) const {
        EPI_LOOP_ROWS { const int row = EPI_ROW; const float sq = rq[row], skv = rkv[row];
#pragma unroll
            for (int bj = 0; bj < 2; ++bj)
#pragma unroll
                for (int n = 0; n < 2; ++n) { const int col = EPI_COL(bj, n); f32x4 v = acc[ai][bj][m][n];
                    if (col < 384) { v = v * sq; const int d = col % 96;
                        if (d >= 64 && row < NLAT) { const int pos = row & (SEQ - 1), gr = pos >> 6, gc = pos & 63, pp = (d - 64) >> 1;
#pragma unroll
                            for (int i = 0; i < 2; ++i) { const int pi = pp + i; const float* tb = (pi < 8) ? rope + (gr * 8 + pi) * 2 : rope + 2048 + (gc * 8 + (pi - 8)) * 2;
                                const float c = tb[0], s = tb[1], x0 = v[2 * i], x1 = v[2 * i + 1]; v[2 * i] = x0 * c - x1 * s; v[2 * i + 1] = x1 * c + x0 * s; } }
                        st_bf16x4(Q + (size_t)row * 384 + col, v); }
                    else if (col >= 512 && col < 768) { const int c = col - 512; st_bf16x4(K + (size_t)row * 384 + (c >> 6) * 96 + (c & 63), v * skv); }
                    else if (col >= 768) { st_bf16x4(V + (size_t)row * 256 + (col - 768), v * skv); } } }
    }
};
struct EpiResid {
    const float* src_lat; const float* src_ctx; float* dst_lat; float* dst_ctx; const float* modv_l; int gidx;
    DEVI void operator()(const f32x4 (&acc)[2][2][4][2], const Unit& u, int wr, int wc, int fr, int fq) const {
        EPI_LOOP_ROWS { const int row = EPI_ROW; const bool lat = row < NLAT; const int r = lat ? (row >> 13) : 2;
            const float* s = lat ? src_lat + (size_t)row * D : src_ctx + (size_t)(row - NLAT) * D; float* d = lat ? dst_lat + (size_t)row * D : dst_ctx + (size_t)(row - NLAT) * D;
            const float* gp = modv_l + r * 6144 + gidx * 1024;
#pragma unroll
            for (int bj = 0; bj < 2; ++bj)
#pragma unroll
                for (int n = 0; n < 2; ++n) { const int col = EPI_COL(bj, n); const f32x4 gv = *(const f32x4*)(gp + col), sv = *(const f32x4*)(s + col);
                    *(f32x4*)(d + col) = sv + gv * acc[ai][bj][m][n]; } }
    }
};
struct EpiSwiglu {
    bf16* act; int ldc;
    DEVI void operator()(const f32x4 (&acc)[2][2][4][2], const Unit& u, int wr, int wc, int fr, int fq) const {
        EPI_LOOP_ROWS { const int row = EPI_ROW;
#pragma unroll
            for (int n = 0; n < 2; ++n) { const f32x4 gt = acc[ai][0][m][n], up = acc[ai][1][m][n]; f32x4 o;
#pragma unroll
                for (int i = 0; i < 4; ++i) o[i] = siluf(gt[i]) * up[i];
                st_bf16x4(act + (size_t)row * ldc + u.pn * 128 + wc * 32 + n * 16 + fq * 4, o); } }
    }
};
struct EpiStore {
    bf16* o; int ldc;
    DEVI void operator()(const f32x4 (&acc)[2][2][4][2], const Unit& u, int wr, int wc, int fr, int fq) const {
        EPI_LOOP_ROWS { const int row = EPI_ROW;
#pragma unroll
            for (int bj = 0; bj < 2; ++bj)
#pragma unroll
                for (int n = 0; n < 2; ++n) st_bf16x4(o + (size_t)row * ldc + EPI_COL(bj, n), acc[ai][bj][m][n]); }
    }
};

template <class F>
DEVI void cvt_job(bf16* dst, int Nd, int Kd, F f, long gtid, long gthreads) {
    const int kch = Kd >> 3; const long nitems = (long)Nd * kch;
    for (long it = gtid; it < nitems; it += gthreads) {
        const int n = (int)(it % Nd), k0 = (int)(it / Nd) * 8;
        u32x4 o; o.x = pk2(f(n, k0), f(n, k0 + 1)); o.y = pk2(f(n, k0 + 2), f(n, k0 + 3)); o.z = pk2(f(n, k0 + 4), f(n, k0 + 5)); o.w = pk2(f(n, k0 + 6), f(n, k0 + 7));
        *(u32x4*)(dst + (size_t)n * Kd + k0) = o;
    }
}
DEVI void ph_pro(const P& p, unsigned char* lds) {
    const int tid = otid(), wid = tid >> 6, lane = tid & 63;
    float* modv = (float*)(p.ws + WS_MODV);
    float* red = (float*)lds;
    for (int item = blockIdx.x; item < 192; item += gridDim.x) {
        const int l = item / 96, n = (item % 96) * 64 + lane;
        const float* W = IN(4) + (size_t)l * 1024 * 6144;
        float a0 = 0.f, a1 = 0.f, a2 = 0.f;
        for (int k = wid * 128; k < wid * 128 + 128; ++k) {
            const float w = W[(size_t)k * 6144 + n];
            a0 += siluf(IN(1)[k]) * w; a1 += siluf(IN(1)[1024 + k]) * w; a2 += siluf(IN(3)[k]) * w;
        }
        red[(wid * 3 + 0) * 64 + lane] = a0; red[(wid * 3 + 1) * 64 + lane] = a1; red[(wid * 3 + 2) * 64 + lane] = a2;
        __syncthreads();
        if (tid < 192) { const int r = tid >> 6, ln = tid & 63; float s = 0.f;
            for (int w = 0; w < 8; ++w) s += red[(w * 3 + r) * 64 + ln];
            const int nn = (item % 96) * 64 + ln; modv[(l * 3 + r) * 6144 + nn] = s + IN(5)[l * 6144 + nn]; }
        __syncthreads();
    }
    if (blockIdx.x == gridDim.x - 1) {
        float* rope = (float*)(p.ws + WS_ROPE);
        for (int idx = tid; idx < 1536; idx += NTHREADS) {
            const int i = idx & 7, pos = (idx < 1024) ? (idx >> 3) : ((idx - 1024) >> 3);
            const float invf = (i == 0) ? 1.f : (i == 1) ? 0.31622776601683794f : (i == 2) ? 0.1f : (i == 3) ? 0.03162277660168379f : (i == 4) ? 0.01f : (i == 5) ? 0.003162277660168379f : (i == 6) ? 0.001f : 0.00031622776601683794f;
            const float ang = (float)pos * invf;
            double rev = (double)ang * 0.15915494309189535; rev -= __builtin_rint(rev);
            const float fr = (float)rev;
            rope[idx * 2] = __builtin_amdgcn_cosf(fr); rope[idx * 2 + 1] = __builtin_amdgcn_sinf(fr);
        }
    }
    const long gtid = (long)blockIdx.x * NTHREADS + tid, gth = (long)gridDim.x * NTHREADS;
    for (int l = 0; l < 2; ++l) {
        { const float* W = IN(8) + (size_t)l * 1024 * INW;
          cvt_job((bf16*)(p.ws + WS_WIN) + (size_t)l * INWP * 1024, INWP, 1024, [=](int n, int k) -> float {
              if (n >= INW) return 0.f; const int sc = (n >= C_KPE && n < C_KPE + 32) ? C_KPE + rope_src(n - C_KPE) : n; return W[(size_t)k * INW + sc]; }, gtid, gth); }
        { const float* Wq = IN(11) + (size_t)l * 256 * 384; const float* qn = IN(10) + l * 256; const float* Wk = IN(13) + (size_t)l * 128 * 256; const float* Wv = IN(14) + (size_t)l * 128 * 256; const float* kn = IN(12) + l * 128;
          const float QS = 0.10206207261596577f * 1.4426950408889634f;
          cvt_job((bf16*)(p.ws + WS_WQKV) + (size_t)l * 1024 * 384, 1024, 384, [=](int n, int k) -> float {
              if (n < 384) { if (k >= 256) return 0.f; const int h = n / 96, d = n % 96; const int sc = (d >= 64) ? h * 96 + 64 + rope_src(d - 64) : n; return Wq[(size_t)k * 384 + sc] * qn[k] * QS; }
              if (n < 512) return 0.f;
              if (k < 256) return 0.f;
              if (n < 768) return Wk[(size_t)(k - 256) * 256 + (n - 512)] * kn[k - 256];
              return Wv[(size_t)(k - 256) * 256 + (n - 768)] * kn[k - 256]; }, gtid, gth); }
        { const float* W = IN(9) + (size_t)l * 1024 * 1024;
          cvt_job((bf16*)(p.ws + WS_WOUT) + (size_t)l * 1024 * 1024, 1024, 1024, [=](int n, int k) -> float { return W[(size_t)k * 1024 + n]; }, gtid, gth); }
    }
    { const float* Wg = IN(22); const float* Wu = IN(23);
      cvt_job((bf16*)(p.ws + WS_WGU), 2 * DFF, 1024, [=](int n, int k) -> float { const int t = n >> 8, r = n & 255; return (r < 128) ? Wg[(size_t)k * DFF + t * 128 + r] : Wu[(size_t)k * DFF + t * 128 + r - 128]; }, gtid, gth); }
    { const float* W = IN(24);
      cvt_job((bf16*)(p.ws + WS_WD), 1024, DFF, [=](int n, int k) -> float { return W[(size_t)k * 1024 + n]; }, gtid, gth); }
}
DEVI void ph_moew(const P& p) {
    const long gtid = (long)blockIdx.x * NTHREADS + otid(), gth = (long)gridDim.x * NTHREADS;
    for (int e = 0; e < NEXP; ++e) {
        { const float* Wg = IN(26) + (size_t)e * 1024 * DFE; const float* Wu = IN(27) + (size_t)e * 1024 * DFE;
          cvt_job((bf16*)(p.ws + WS_WGUE) + (size_t)e * 2 * DFE * 1024, 2 * DFE, 1024, [=](int n, int k) -> float { const int t = n >> 8, r = n & 255; return (r < 128) ? Wg[(size_t)k * DFE + t * 128 + r] : Wu[(size_t)k * DFE + t * 128 + r - 128]; }, gtid, gth); }
        { const float* W = IN(28) + (size_t)e * DFE * 1024;
          cvt_job((bf16*)(p.ws + WS_WDE) + (size_t)e * 1024 * DFE, 1024, DFE, [=](int n, int k) -> float { return W[(size_t)k * 1024 + n]; }, gtid, gth); }
    }
}

DEVI void ph_norm(const P& p, int l, int which, int nrows, bool route) {
    const int tid = otid(), wid = tid >> 6, lane = tid & 63;
    const bool first = (l == 0 && which == 0);
    const float* src_lat = first ? IN(0) : p.out; const float* src_ctx = first ? IN(2) : (const float*)(p.ws + WS_XC);
    const float* w = IN(6 + which) + l * 1024; const float* modv = (const float*)(p.ws + WS_MODV) + (size_t)l * 3 * 6144;
    bf16* H = (bf16*)(p.ws + WS_HM);
    const float* router = IN(25);
    int* rt_e = (int*)(p.ws + WS_RT); float* rt_g = (float*)(p.ws + WS_RT + 128 * 1024);
    for (int row = blockIdx.x * NWAVES + wid; row < nrows; row += gridDim.x * NWAVES) {
        const bool lat = row < NLAT; const int r = lat ? (row >> 13) : 2;
        const float* x = lat ? src_lat + (size_t)row * D : src_ctx + (size_t)(row - NLAT) * D;
        const float* sh = modv + r * 6144 + (which * 3 + 0) * 1024; const float* sc = modv + r * 6144 + (which * 3 + 1) * 1024;
        f32x4 v[4]; float ss = 0.f;
#pragma unroll
        for (int j = 0; j < 4; ++j) { v[j] = *(const f32x4*)(x + (j * 64 + lane) * 4); ss += v[j][0] * v[j][0] + v[j][1] * v[j][1] + v[j][2] * v[j][2] + v[j][3] * v[j][3]; }
        ss = wave_sum(ss); const float rstd = 1.0f / sqrtf(ss * (1.f / D) + EPS);
        float lg[8];
#pragma unroll
        for (int e = 0; e < 8; ++e) lg[e] = 0.f;
#pragma unroll
        for (int j = 0; j < 4; ++j) { const int c0 = (j * 64 + lane) * 4; const f32x4 wv = *(const f32x4*)(w + c0), sv = *(const f32x4*)(sh + c0), cv = *(const f32x4*)(sc + c0);
            f32x4 h;
#pragma unroll
            for (int i = 0; i < 4; ++i) h[i] = (v[j][i] * rstd * wv[i]) * (1.f + cv[i]) + sv[i];
            st_bf16x4(H + (size_t)row * D + c0, h);
            if (route) {
#pragma unroll
                for (int i = 0; i < 4; ++i) { const f32x4 r0 = *(const f32x4*)(router + (size_t)(c0 + i) * 8), r1 = *(const f32x4*)(router + (size_t)(c0 + i) * 8 + 4);
                    lg[0] += h[i] * r0[0]; lg[1] += h[i] * r0[1]; lg[2] += h[i] * r0[2]; lg[3] += h[i] * r0[3]; lg[4] += h[i] * r1[0]; lg[5] += h[i] * r1[1]; lg[6] += h[i] * r1[2]; lg[7] += h[i] * r1[3]; } } }
        if (route) {
#pragma unroll
            for (int e = 0; e < 8; ++e) lg[e] = wave_sum(lg[e]);
            int i1 = 0; float v1 = lg[0];
#pragma unroll
            for (int e = 1; e < 8; ++e) if (lg[e] > v1) { v1 = lg[e]; i1 = e; }
            int i2 = -1; float v2 = -3.0e38f;
#pragma unroll
            for (int e = 0; e < 8; ++e) if (e != i1 && lg[e] > v2) { v2 = lg[e]; i2 = e; }
            const float e2 = __expf(v2 - v1), g1 = 1.f / (1.f + e2), g2 = e2 / (1.f + e2);
            if (lane == 0) { rt_e[row * 2] = i1; rt_e[row * 2 + 1] = i2; rt_g[row * 2] = g1; rt_g[row * 2 + 1] = g2; }
        }
    }
}

DEVI void ph_conv(const P& p, int l) {
    const int tid = otid(), wid = tid >> 6, lane = tid & 63;
    const bf16* proj = (const bf16*)(p.ws + WS_PROJ); bf16* xbc = (bf16*)(p.ws + WS_XBC); bf16* Kb = (bf16*)(p.ws + WS_K);
    float* rq = (float*)(p.ws + WS_RQ); float* rkv = (float*)(p.ws + WS_RKV); const float* rope = (const float*)(p.ws + WS_ROPE);
    const float* cw = IN(16) + (size_t)l * 3 * 768; const float* cb = IN(17) + l * 768;
    for (int row = blockIdx.x * NWAVES + wid; row < T; row += gridDim.x * NWAVES) {
        const bool lat = row < NLAT; const int pos = lat ? (row & (SEQ - 1)) : ((row - NLAT) & (CL - 1)); const int L = lat ? SEQ : CL;
        const bf16* pr = proj + (size_t)row * INWP;
        { const u32x2 a = *(const u32x2*)(pr + lane * 4); const unsigned b = *(const unsigned*)(pr + C_CKV + lane * 2);
          const float q0 = bf2f(a.x & 0xffff), q1 = bf2f(a.x >> 16), q2 = bf2f(a.y & 0xffff), q3 = bf2f(a.y >> 16), k0 = bf2f(b & 0xffff), k1 = bf2f(b >> 16);
          const float sq = wave_sum(q0 * q0 + q1 * q1 + q2 * q2 + q3 * q3), sk = wave_sum(k0 * k0 + k1 * k1);
          if (lane == 0) { rq[row] = 1.0f / sqrtf(sq * (1.f / 256.f) + EPS); rkv[row] = 1.0f / sqrtf(sk * (1.f / 128.f) + EPS); } }
        if (lane < 16) { const unsigned a = *(const unsigned*)(pr + C_KPE + lane * 2); float x0 = bf2f(a & 0xffff), x1 = bf2f(a >> 16);
            if (lat) { const int gr = pos >> 6, gc = pos & 63; const float* tb = (lane < 8) ? rope + (gr * 8 + lane) * 2 : rope + 2048 + (gc * 8 + (lane - 8)) * 2;
                const float c = tb[0], s = tb[1], y0 = x0 * c - x1 * s, y1 = x1 * c + x0 * s; x0 = y0; x1 = y1; }
            const unsigned o = pk2(x0, x1);
#pragma unroll
            for (int h = 0; h < 4; ++h) *(unsigned*)(Kb + (size_t)row * 384 + h * 96 + 64 + lane * 2) = o; }
#pragma unroll
        for (int j = 0; j < 3; ++j) { const int c0 = (j * 64 + lane) * 4;
            const u32x2 xm = (pos > 0) ? *(const u32x2*)(pr - INWP + C_XBC + c0) : (u32x2){0u, 0u}; const u32x2 x0 = *(const u32x2*)(pr + C_XBC + c0);
            const u32x2 xp = (pos < L - 1) ? *(const u32x2*)(pr + INWP + C_XBC + c0) : (u32x2){0u, 0u};
            const f32x4 w0 = *(const f32x4*)(cw + c0), w1 = *(const f32x4*)(cw + 768 + c0), w2 = *(const f32x4*)(cw + 1536 + c0), bb = *(const f32x4*)(cb + c0);
            f32x4 am = {bf2f(xm.x & 0xffff), bf2f(xm.x >> 16), bf2f(xm.y & 0xffff), bf2f(xm.y >> 16)}, a0 = {bf2f(x0.x & 0xffff), bf2f(x0.x >> 16), bf2f(x0.y & 0xffff), bf2f(x0.y >> 16)},
                  ap = {bf2f(xp.x & 0xffff), bf2f(xp.x >> 16), bf2f(xp.y & 0xffff), bf2f(xp.y >> 16)};
            f32x4 y = w0 * am + w1 * a0 + w2 * ap + bb;
#pragma unroll
            for (int i = 0; i < 4; ++i) y[i] = siluf(y[i]);
            st_bf16x4(xbc + (size_t)row * 768 + c0, y); }
    }
}

DEVI void attn_unit(const P& p, int uidx, unsigned char* lds) {
    const int tid = otid(), wid = __builtin_amdgcn_readfirstlane(tid >> 6), lane = tid & 63, r32 = lane & 31, hi = lane >> 5;
    const bf16* Q = (const bf16*)(p.ws + WS_Q); const bf16* K = (const bf16*)(p.ws + WS_K); const bf16* V = (const bf16*)(p.ws + WS_V); bf16* MIX = (bf16*)(p.ws + WS_HM);
    int b, h, qrow0, nseg;
    if (uidx < 256) { b = uidx >> 7; h = (uidx >> 5) & 3; qrow0 = b * SEQ + (uidx & 31) * 256; nseg = 2; }
    else { const int j = uidx - 256; b = j >> 2; h = j & 3; qrow0 = NLAT + b * CL; nseg = 1; }
    bf16* Vt = (bf16*)lds;
    const int qrow = qrow0 + wid * 32 + r32;
    bf16x8 qf[6];
#pragma unroll
    for (int s = 0; s < 6; ++s) qf[s] = *(const bf16x8*)(Q + (size_t)qrow * 384 + h * 96 + s * 16 + hi * 8);
    f32x16 o0, o1;
#pragma unroll
    for (int r = 0; r < 16; ++r) { o0[r] = 0.f; o1[r] = 0.f; }
    float mrun = -1.0e30f, lsum = 0.f;
    for (int seg = 0; seg < nseg; ++seg) {
        const int kbase = (seg == 0) ? NLAT + b * CL : b * SEQ; const int ntile = (seg == 0) ? CL / 32 : SEQ / 32;
        for (int kt = 0; kt < ntile; ++kt) {
            const int krow0 = kbase + kt * 32;
            __syncthreads();
            { const int key = tid >> 4, d0 = (tid & 15) * 4; const u32x2 vv = *(const u32x2*)(V + (size_t)(krow0 + key) * 256 + h * 64 + d0);
              Vt[(d0 + 0) * 40 + key] = (bf16)(vv.x & 0xffff); Vt[(d0 + 1) * 40 + key] = (bf16)(vv.x >> 16); Vt[(d0 + 2) * 40 + key] = (bf16)(vv.y & 0xffff); Vt[(d0 + 3) * 40 + key] = (bf16)(vv.y >> 16); }
            __syncthreads();
            f32x16 st;
#pragma unroll
            for (int r = 0; r < 16; ++r) st[r] = 0.f;
#pragma unroll
            for (int s = 0; s < 6; ++s) { const bf16x8 kf = *(const bf16x8*)(K + (size_t)(krow0 + r32) * 384 + h * 96 + s * 16 + hi * 8); st = __builtin_amdgcn_mfma_f32_32x32x16_bf16(kf, qf[s], st, 0, 0, 0); }
            float mx = st[0];
#pragma unroll
            for (int r = 1; r < 16; ++r) mx = fmaxf(mx, st[r]);
            mx = fmaxf(mx, __shfl_xor(mx, 32));
            const float mnew = fmaxf(mrun, mx), alpha = __builtin_amdgcn_exp2f(mrun - mnew); mrun = mnew;
            float rs = 0.f;
#pragma unroll
            for (int r = 0; r < 16; ++r) { st[r] = __builtin_amdgcn_exp2f(st[r] - mnew); rs += st[r]; }
            lsum = lsum * alpha + rs;
#pragma unroll
            for (int r = 0; r < 16; ++r) { o0[r] *= alpha; o1[r] *= alpha; }
#pragma unroll
            for (int s2 = 0; s2 < 2; ++s2) {
                u32x4 pw; pw.x = pk2(st[8 * s2 + 0], st[8 * s2 + 1]); pw.y = pk2(st[8 * s2 + 2], st[8 * s2 + 3]); pw.z = pk2(st[8 * s2 + 4], st[8 * s2 + 5]); pw.w = pk2(st[8 * s2 + 6], st[8 * s2 + 7]);
                const bf16x8 pb = __builtin_bit_cast(bf16x8, pw);
#pragma unroll
                for (int dh = 0; dh < 2; ++dh) { const bf16* vp = Vt + (dh * 32 + r32) * 40 + 16 * s2 + 4 * hi;
                    const u32x2 lo = *(const u32x2*)vp, hi2 = *(const u32x2*)(vp + 8); u32x4 vw; vw.x = lo.x; vw.y = lo.y; vw.z = hi2.x; vw.w = hi2.y;
                    const bf16x8 va = __builtin_bit_cast(bf16x8, vw);
                    if (dh == 0) o0 = __builtin_amdgcn_mfma_f32_32x32x16_bf16(va, pb, o0, 0, 0, 0); else o1 = __builtin_amdgcn_mfma_f32_32x32x16_bf16(va, pb, o1, 0, 0, 0); }
            }
        }
    }
    lsum += __shfl_xor(lsum, 32);
    const float inv = 1.f / lsum;
    bf16* orow = MIX + (size_t)qrow * D + h * 64;
#pragma unroll
    for (int g = 0; g < 4; ++g) {
        st_bf16x4(orow + 8 * g + 4 * hi, (f32x4){o0[4 * g] * inv, o0[4 * g + 1] * inv, o0[4 * g + 2] * inv, o0[4 * g + 3] * inv});
        st_bf16x4(orow + 32 + 8 * g + 4 * hi, (f32x4){o1[4 * g] * inv, o1[4 * g + 1] * inv, o1[4 * g + 2] * inv, o1[4 * g + 3] * inv});
    }
    __syncthreads();
}

constexpr int NCC = 66;
DEVI int chunk_row0(int b, int cc) { return cc < 2 ? NLAT + b * CL + cc * 128 : b * SEQ + (cc - 2) * 128; }
constexpr int SC_VEC = 0;
constexpr int SC_KT = 2048;
constexpr int SC_VF = SC_KT + 64 * 136 * 2;
constexpr int SC_VB = SC_VF + 64 * 136 * 2;
constexpr int SC_X = SC_VB + 64 * 136 * 2;
constexpr int SC_SSQ = SC_X + 2048;
constexpr int SC_END = SC_SSQ + 8192;
constexpr int TS = 136;

DEVI void scan_vectors(const P& p, int l, bool ret, int h, int row0, float* vec, int wid, int lane) {
    const float* dt = (const float*)(p.ws + WS_DT);
    if (ret) {
        if (wid == 0) { const float lf = IN(15)[l * 8 + h], lb = IN(15)[l * 8 + 4 + h];
            const float laf = -log1pf(__expf(-lf)), lab = -log1pf(__expf(-lb));
#pragma unroll
            for (int e = 0; e < 2; ++e) { const int j = lane * 2 + e; vec[j] = (float)(j + 1) * laf; vec[128 + j] = (float)(128 - j) * lab; vec[256 + j] = 1.f; vec[384 + j] = 1.f; } }
    } else if (wid < 2) {
        const int dir = wid; const size_t r = (size_t)(row0 + lane * 2);
        const float x0 = dt[r * 32 + 16 + dir * 8 + h], x1 = dt[(r + 1) * 32 + 16 + dir * 8 + h];
        vec[256 + dir * 128 + lane * 2] = dt[r * 32 + dir * 8 + h]; vec[256 + dir * 128 + lane * 2 + 1] = dt[(r + 1) * 32 + dir * 8 + h];
        float s = x0 + x1;
#pragma unroll
        for (int o = 1; o < 64; o <<= 1) { const float t = __shfl_up(s, o); if (lane >= o) s += t; }
        if (dir == 0) { vec[lane * 2] = s - x1; vec[lane * 2 + 1] = s; }
        else { const float tot = __shfl(s, 63); vec[128 + lane * 2] = tot - (s - x1) + x0; vec[128 + lane * 2 + 1] = tot - s + x1; }
    }
}
DEVI void scan_ptrs(const P& p, bool ret, int h, const bf16*& qb, const bf16*& kb, const bf16*& vb, int& ld) {
    if (ret) { const bf16* proj = (const bf16*)(p.ws + WS_PROJ); qb = proj + C_RQ + h * 64; kb = proj + C_RK + h * 64; vb = proj + C_RV + h * 64; ld = INWP; }
    else { const bf16* xbc = (const bf16*)(p.ws + WS_XBC); qb = xbc + 640 + (h >> 2) * 64; kb = xbc + 512 + (h >> 2) * 64; vb = xbc + h * 64; ld = 768; }
}
template <bool SCALED>
DEVI void stage_T(const bf16* src, int ld, int row0, bf16* d0, bf16* d1, const float* vec, int tid) {
#pragma unroll
    for (int i = 0; i < 2; ++i) { const int piece = tid + NTHREADS * i, j = piece >> 3, n0 = (piece & 7) * 8;
        const u32x4 v = *(const u32x4*)(src + (size_t)(row0 + j) * ld + n0);
        const unsigned w[4] = {v.x, v.y, v.z, v.w};
        if (!SCALED) {
#pragma unroll
            for (int e = 0; e < 4; ++e) { d0[(n0 + 2 * e) * TS + j] = (bf16)(w[e] & 0xffff); d0[(n0 + 2 * e + 1) * TS + j] = (bf16)(w[e] >> 16); }
        } else {
            const float sf = __expf(vec[127] - vec[j]) * vec[256 + j], sb = __expf(vec[128] - vec[128 + j]) * vec[384 + j];
#pragma unroll
            for (int e = 0; e < 4; ++e) { const float a = bf2f(w[e] & 0xffff), b = bf2f(w[e] >> 16);
                d0[(n0 + 2 * e) * TS + j] = f2bf(a * sf); d0[(n0 + 2 * e + 1) * TS + j] = f2bf(b * sf); d1[(n0 + 2 * e) * TS + j] = f2bf(a * sb); d1[(n0 + 2 * e + 1) * TS + j] = f2bf(b * sb); }
        } }
}
DEVI void scanA_unit(const P& p, int l, int uidx, unsigned char* lds) {
    const int tid = otid(), wid = __builtin_amdgcn_readfirstlane(tid >> 6), lane = tid & 63, r32 = lane & 31, hi = lane >> 5;
    const int g4 = uidx % 3, bc = uidx / 3, b = bc / NCC, cc = bc % NCC, row0 = chunk_row0(b, cc);
    const bool ret = (g4 == 0);
    float* vec = (float*)(lds + SC_VEC); bf16* Kt = (bf16*)(lds + SC_KT); bf16* Vf = (bf16*)(lds + SC_VF); bf16* Vb = (bf16*)(lds + SC_VB);
    float* ST = (float*)(p.ws + WS_ST); float* CDp = (float*)(p.ws + WS_CD);
    for (int hq = 0; hq < 4; ++hq) {
        const int h = ret ? hq : (g4 - 1) * 4 + hq, hh = ret ? hq : 4 + h; const size_t item = (size_t)(b * NCC + cc) * 12 + hh;
        const bf16 *qb, *kb, *vb; int ld; scan_ptrs(p, ret, h, qb, kb, vb, ld);
        __syncthreads();
        scan_vectors(p, l, ret, h, row0, vec, wid, lane);
        __syncthreads();
        if (ret || hq == 0) stage_T<false>(kb, ld, row0, Kt, nullptr, vec, tid);
        stage_T<true>(vb, ld, row0, Vf, Vb, vec, tid);
        if (tid == 0) { CDp[item * 2] = __expf(vec[127]); CDp[item * 2 + 1] = __expf(vec[128]); }
        __syncthreads();
        const int dir = wid >> 2, nt = (wid >> 1) & 1, pt = wid & 1; const bf16* Vd = dir ? Vb : Vf;
        f32x16 acc;
#pragma unroll
        for (int r = 0; r < 16; ++r) acc[r] = 0.f;
#pragma unroll
        for (int s = 0; s < 8; ++s) { const bf16x8 a = *(const bf16x8*)(Kt + (nt * 32 + r32) * TS + s * 16 + hi * 8), bb = *(const bf16x8*)(Vd + (pt * 32 + r32) * TS + s * 16 + hi * 8);
            acc = __builtin_amdgcn_mfma_f32_32x32x16_bf16(a, bb, acc, 0, 0, 0); }
        float* o = ST + (item * 2 + dir) * 4096 + (size_t)(pt * 32 + r32) * 64 + nt * 32 + 4 * hi;
#pragma unroll
        for (int g = 0; g < 4; ++g) *(f32x4*)(o + 8 * g) = (f32x4){acc[4 * g], acc[4 * g + 1], acc[4 * g + 2], acc[4 * g + 3]};
    }
    __syncthreads();
}
DEVI void scanB_unit(const P& p, int uidx) {
    const int tid = otid(); const int bhd = uidx >> 2, dir = bhd & 1, bh = bhd >> 1, b = bh / 12, hh = bh % 12; const int e = (uidx & 3) * 1024 + tid * 2;
    const float* ST = (const float*)(p.ws + WS_ST); const float* CDp = (const float*)(p.ws + WS_CD); bf16* HT = (bf16*)(p.ws + WS_HT);
    f32x2 H = {0.f, 0.f};
    for (int base = 0; base < NCC; base += 6) {
        f32x2 s[6]; float d[6]; size_t off[6];
#pragma unroll
        for (int i = 0; i < 6; ++i) { const int step = base + i; const int cc = dir == 0 ? step : (step < 2 ? 1 - step : 67 - step);
            const size_t item = (size_t)(b * NCC + cc) * 12 + hh; off[i] = (item * 2 + dir) * 4096 + e; s[i] = *(const f32x2*)(ST + off[i]); d[i] = CDp[item * 2 + dir]; }
#pragma unroll
        for (int i = 0; i < 6; ++i) { *(unsigned*)(HT + off[i]) = pk2(H[0], H[1]); H = H * d[i] + s[i]; }
    }
}
DEVI void scanC_unit(const P& p, int l, int uidx, unsigned char* lds) {
    const int tid = otid(), wid = __builtin_amdgcn_readfirstlane(tid >> 6), lane = tid & 63, r32 = lane & 31, hi = lane >> 5;
    const int kind = uidx & 1, bc = uidx >> 1, b = bc / NCC, cc = bc % NCC, row0 = chunk_row0(b, cc);
    const bool ret = (kind == 0); const int nh = ret ? 4 : 8;
    float* vec = (float*)(lds + SC_VEC); bf16* Vt = (bf16*)(lds + SC_KT); float* X = (float*)(lds + SC_X); float* SSQ = (float*)(lds + SC_SSQ);
    const bf16* HT = (const bf16*)(p.ws + WS_HT); const bf16* proj = (const bf16*)(p.ws + WS_PROJ); const bf16* xbc = (const bf16*)(p.ws + WS_XBC); bf16* MIX = (bf16*)(p.ws + WS_HM);
    const int it_ = wid >> 1, pt = wid & 1, i = it_ * 32 + r32; const size_t rowi = (size_t)(row0 + i);
    for (int h = 0; h < nh; ++h) {
        const int hh = ret ? h : 4 + h; const size_t item = (size_t)(b * NCC + cc) * 12 + hh;
        const bf16 *qb, *kb, *vb; int ld; scan_ptrs(p, ret, h, qb, kb, vb, ld);
        __syncthreads();
        scan_vectors(p, l, ret, h, row0, vec, wid, lane);
        stage_T<false>(vb, ld, row0, Vt, nullptr, vec, tid);
        __syncthreads();
        bf16x8 qf[4];
#pragma unroll
        for (int s = 0; s < 4; ++s) qf[s] = *(const bf16x8*)(qb + rowi * ld + s * 16 + hi * 8);
        const float Afi = vec[i], Bbi = vec[128 + i];
        f32x16 y;
#pragma unroll
        for (int r = 0; r < 16; ++r) y[r] = 0.f;
#pragma unroll
        for (int jt = 0; jt < 4; ++jt) {
            f32x16 st;
#pragma unroll
            for (int r = 0; r < 16; ++r) st[r] = 0.f;
#pragma unroll
            for (int s = 0; s < 4; ++s) { const bf16x8 kf = *(const bf16x8*)(kb + (size_t)(row0 + jt * 32 + r32) * ld + s * 16 + hi * 8); st = __builtin_amdgcn_mfma_f32_32x32x16_bf16(kf, qf[s], st, 0, 0, 0); }
#pragma unroll
            for (int g = 0; g < 4; ++g) { const int j0 = jt * 32 + 8 * g + 4 * hi;
                const f32x4 afj = *(const f32x4*)(vec + j0), bbj = *(const f32x4*)(vec + 128 + j0), wfj = *(const f32x4*)(vec + 256 + j0), wbj = *(const f32x4*)(vec + 384 + j0);
#pragma unroll
                for (int e = 0; e < 4; ++e) { const int j = j0 + e; float f;
                    if (jt < it_) f = __expf(Afi - afj[e]) * wfj[e];
                    else if (jt > it_) f = __expf(Bbi - bbj[e]) * wbj[e];
                    else { const float ff = (j <= i) ? __expf(Afi - afj[e]) * wfj[e] : 0.f; const bool bm = ret ? (j > i) : (j >= i); const float fb = bm ? __expf(Bbi - bbj[e]) * wbj[e] : 0.f; f = ff + fb; }
                    st[4 * g + e] *= f; } }
#pragma unroll
            for (int s2 = 0; s2 < 2; ++s2) {
                u32x4 pw; pw.x = pk2(st[8 * s2 + 0], st[8 * s2 + 1]); pw.y = pk2(st[8 * s2 + 2], st[8 * s2 + 3]); pw.z = pk2(st[8 * s2 + 4], st[8 * s2 + 5]); pw.w = pk2(st[8 * s2 + 6], st[8 * s2 + 7]);
                const bf16* vp = Vt + (pt * 32 + r32) * TS + jt * 32 + 16 * s2 + 4 * hi;
                const u32x2 lo = *(const u32x2*)vp, hi2 = *(const u32x2*)(vp + 8); u32x4 vw; vw.x = lo.x; vw.y = lo.y; vw.z = hi2.x; vw.w = hi2.y;
                y = __builtin_amdgcn_mfma_f32_32x32x16_bf16(__builtin_bit_cast(bf16x8, vw), __builtin_bit_cast(bf16x8, pw), y, 0, 0, 0);
            }
        }
        { f32x16 tf, tb;
#pragma unroll
          for (int r = 0; r < 16; ++r) { tf[r] = 0.f; tb[r] = 0.f; }
          const bf16* hf = HT + (item * 2) * 4096 + (size_t)(pt * 32 + r32) * 64 + hi * 8;
#pragma unroll
          for (int s = 0; s < 4; ++s) { tf = __builtin_amdgcn_mfma_f32_32x32x16_bf16(*(const bf16x8*)(hf + s * 16), qf[s], tf, 0, 0, 0); tb = __builtin_amdgcn_mfma_f32_32x32x16_bf16(*(const bf16x8*)(hf + 4096 + s * 16), qf[s], tb, 0, 0, 0); }
          const float ef = __expf(Afi), eb = __expf(Bbi);
#pragma unroll
          for (int r = 0; r < 16; ++r) y[r] += ef * tf[r] + eb * tb[r]; }
        if (ret) {
            float s1 = 0.f, s2 = 0.f;
#pragma unroll
            for (int r = 0; r < 16; ++r) { y[r] *= 0.125f; s1 += y[r]; s2 += y[r] * y[r]; }
            s1 += __shfl_xor(s1, 32); s2 += __shfl_xor(s2, 32);
            if (hi == 0) { X[(pt * 128 + i) * 2] = s1; X[(pt * 128 + i) * 2 + 1] = s2; }
            __syncthreads();
            const float o1 = X[((pt ^ 1) * 128 + i) * 2], o2 = X[((pt ^ 1) * 128 + i) * 2 + 1];
            const float mu = (s1 + o1) * (1.f / 64.f), var = fmaxf((s2 + o2) * (1.f / 64.f) - mu * mu, 0.f), rs = 1.0f / sqrtf(var + EPS);
#pragma unroll
            for (int g = 0; g < 4; ++g) { const int p0 = pt * 32 + 8 * g + 4 * hi; const u32x2 gg = *(const u32x2*)(proj + rowi * INWP + C_RG + h * 64 + p0);
                const f32x4 gv = {bf2f(gg.x & 0xffff), bf2f(gg.x >> 16), bf2f(gg.y & 0xffff), bf2f(gg.y >> 16)}; f32x4 o;
#pragma unroll
                for (int e = 0; e < 4; ++e) o[e] = (y[4 * g + e] - mu) * rs * siluf(gv[e]);
                st_bf16x4(MIX + rowi * D + 256 + h * 64 + p0, o); }
        } else {
            const float dsk = IN(20)[l * 8 + h]; float s2 = 0.f;
#pragma unroll
            for (int g = 0; g < 4; ++g) { const int p0 = pt * 32 + 8 * g + 4 * hi; const u32x2 xx = *(const u32x2*)(xbc + rowi * 768 + h * 64 + p0), zz = *(const u32x2*)(proj + rowi * INWP + C_Z + h * 64 + p0);
                const f32x4 xv = {bf2f(xx.x & 0xffff), bf2f(xx.x >> 16), bf2f(xx.y & 0xffff), bf2f(xx.y >> 16)}, zv = {bf2f(zz.x & 0xffff), bf2f(zz.x >> 16), bf2f(zz.y & 0xffff), bf2f(zz.y >> 16)}; f32x4 o;
#pragma unroll
                for (int e = 0; e < 4; ++e) { o[e] = (y[4 * g + e] + xv[e] * dsk) * siluf(zv[e]); s2 += o[e] * o[e]; }
                st_bf16x4(MIX + rowi * D + 512 + h * 64 + p0, o); }
            s2 += __shfl_xor(s2, 32);
            if (hi == 0) SSQ[(h * 2 + pt) * 128 + i] = s2;
        }
    }
    if (!ret) {
        __syncthreads();
        const float* nw = IN(21) + l * 512; const int tok = tid >> 2, cq = tid & 3; float ss = 0.f;
#pragma unroll
        for (int k = 0; k < 16; ++k) ss += SSQ[k * 128 + tok];
        const float rstd = 1.0f / sqrtf(ss * (1.f / 512.f) + EPS);
        bf16* mp = MIX + (size_t)(row0 + tok) * D + 512 + cq * 128;
#pragma unroll 4
        for (int k = 0; k < 16; ++k) { const u32x4 v = *(const u32x4*)(mp + k * 8); const f32x4 w0 = *(const f32x4*)(nw + cq * 128 + k * 8), w1 = *(const f32x4*)(nw + cq * 128 + k * 8 + 4); u32x4 o;
            o.x = pk2(bf2f(v.x & 0xffff) * rstd * w0[0], bf2f(v.x >> 16) * rstd * w0[1]); o.y = pk2(bf2f(v.y & 0xffff) * rstd * w0[2], bf2f(v.y >> 16) * rstd * w0[3]);
            o.z = pk2(bf2f(v.z & 0xffff) * rstd * w1[0], bf2f(v.z >> 16) * rstd * w1[1]); o.w = pk2(bf2f(v.w & 0xffff) * rstd * w1[2], bf2f(v.w >> 16) * rstd * w1[3]);
            *(u32x4*)(mp + k * 8) = o; }
    }
    __syncthreads();
}
DEVI void ph_scanA(const P& p, int l, unsigned char* lds) { for (int u = blockIdx.x; u < 2 * NCC * 3; u += gridDim.x) scanA_unit(p, l, u, lds); }
DEVI void ph_mixer(const P& p, int l, unsigned char* lds) {
    const int nattn = (l == 0) ? 256 + 8 : 256; const int nunits = 192 + nattn;
    for (int u = blockIdx.x; u < nunits; u += gridDim.x) { if (u < 192) scanB_unit(p, u); else attn_unit(p, u - 192, lds); }
}
DEVI void ph_scanC(const P& p, int l, unsigned char* lds) { for (int u = blockIdx.x; u < 2 * NCC * 2; u += gridDim.x) scanC_unit(p, l, u, lds); }

DEVI void ph_sort(const P& p, unsigned char* lds) {
    const int tid = otid(), wid = tid >> 6, lane = tid & 63;
    const int* rt_e = (const int*)(p.ws + WS_RT); int* rt_pos = (int*)(p.ws + WS_RT + 256 * 1024); int* tab = (int*)(p.ws + WS_RT + 384 * 1024);
    const bf16* H = (const bf16*)(p.ws + WS_HM); bf16* HS = (bf16*)(p.ws + WS_HS);
    int* sh = (int*)lds;
    const int G = gridDim.x, R = (NLAT + G - 1) / G;
    for (int blk = blockIdx.x; blk * R < NLAT; blk += G) {
        const int r0 = blk * R, r1 = (r0 + R < NLAT) ? r0 + R : NLAT;
        int ct[8], cb[8];
#pragma unroll
        for (int e = 0; e < 8; ++e) { ct[e] = 0; cb[e] = 0; }
        for (int i = tid; i < NLAT * 2; i += NTHREADS) { const int e = rt_e[i]; const bool bef = (i >> 1) < r0;
#pragma unroll
            for (int x = 0; x < 8; ++x) { const int hit = (e == x) ? 1 : 0; ct[x] += hit; cb[x] += bef ? hit : 0; } }
#pragma unroll
        for (int e = 0; e < 8; ++e) {
#pragma unroll
            for (int o = 1; o < 64; o <<= 1) { ct[e] += __shfl_xor(ct[e], o); cb[e] += __shfl_xor(cb[e], o); }
        }
        __syncthreads();
        if (lane == 0) {
#pragma unroll
            for (int e = 0; e < 8; ++e) { sh[wid * 8 + e] = ct[e]; sh[64 + wid * 8 + e] = cb[e]; } }
        __syncthreads();
        if (tid == 0) { int start = 0, nt = 0;
            for (int e = 0; e < 8; ++e) { int tot = 0, bef = 0; for (int w = 0; w < 8; ++w) { tot += sh[w * 8 + e]; bef += sh[64 + w * 8 + e]; }
                sh[128 + e] = start; sh[136 + e] = start + bef; const int ntile = (tot + 255) >> 8;
                if (blk == 0) { for (int t = 0; t < ntile; ++t) tab[1 + nt + t] = e; }
                nt += ntile; start += ntile * 256; }
            if (blk == 0) tab[0] = nt; }
        __syncthreads();
        if (tid < 8) { int run = sh[136 + tid]; for (int i = r0 * 2; i < r1 * 2; ++i) if (rt_e[i] == tid) { sh[256 + i - r0 * 2] = run; rt_pos[i] = run; ++run; } }
        __syncthreads();
        for (int i = wid; i < (r1 - r0) * 2; i += NWAVES) { const int row = r0 + (i >> 1), pos = sh[256 + i];
            const u32x4* s = (const u32x4*)(H + (size_t)row * D); u32x4* d = (u32x4*)(HS + (size_t)pos * D); d[lane] = s[lane]; d[lane + 64] = s[lane + 64]; }
        __syncthreads();
    }
}
DEVI void ph_final(const P& p) {
    const int tid = otid(), wid = tid >> 6, lane = tid & 63;
    const float* rt_g = (const float*)(p.ws + WS_RT + 128 * 1024); const int* rt_pos = (const int*)(p.ws + WS_RT + 256 * 1024);
    const bf16* YS = (const bf16*)(p.ws + WS_HS); const float* modv = (const float*)(p.ws + WS_MODV) + (size_t)1 * 3 * 6144; const float* fw = IN(29);
    for (int row = blockIdx.x * NWAVES + wid; row < NLAT; row += gridDim.x * NWAVES) {
        const int b = row >> 13; const float* gp = modv + b * 6144 + 5 * 1024; float* x = p.out + (size_t)row * D;
        const float g0 = rt_g[row * 2], g1 = rt_g[row * 2 + 1]; const bf16* y0 = YS + (size_t)rt_pos[row * 2] * D; const bf16* y1 = YS + (size_t)rt_pos[row * 2 + 1] * D;
        f32x4 v[4]; float ss = 0.f;
#pragma unroll
        for (int j = 0; j < 4; ++j) { const int c0 = (j * 64 + lane) * 4; const f32x4 xv = *(const f32x4*)(x + c0), gv = *(const f32x4*)(gp + c0); const u32x2 a = *(const u32x2*)(y0 + c0), c = *(const u32x2*)(y1 + c0);
            const f32x4 ya = {bf2f(a.x & 0xffff), bf2f(a.x >> 16), bf2f(a.y & 0xffff), bf2f(a.y >> 16)}, yb = {bf2f(c.x & 0xffff), bf2f(c.x >> 16), bf2f(c.y & 0xffff), bf2f(c.y >> 16)};
            v[j] = xv + gv * (ya * g0 + yb * g1); ss += v[j][0] * v[j][0] + v[j][1] * v[j][1] + v[j][2] * v[j][2] + v[j][3] * v[j][3]; }
        ss = wave_sum(ss); const float rstd = 1.0f / sqrtf(ss * (1.f / D) + EPS);
#pragma unroll
        for (int j = 0; j < 4; ++j) { const int c0 = (j * 64 + lane) * 4; const f32x4 wv = *(const f32x4*)(fw + c0); *(f32x4*)(x + c0) = v[j] * rstd * wv; }
    }
}

constexpr int NPHASES = 24;
__global__ void __launch_bounds__(NTHREADS, 2) mk_fwd(P p) {
    extern __shared__ __attribute__((aligned(16))) unsigned char lds[];
    cg::grid_group grid = cg::this_grid();
    const int G = gridDim.x, c = blockIdx.x;
    if (threadIdx.x < 30) ((lds_u64*)(uintptr_t)LDS_PTRS)[threadIdx.x] = (unsigned long long)p.in[threadIdx.x];
    __syncthreads();
    int ph = 0;
#define RUN(...) do { if (ph >= p.ph_lo && ph < p.ph_hi) { __VA_ARGS__; if (ph + 1 < p.ph_hi) grid.sync(); } ++ph; } while (0)
    RUN(ph_pro(p, lds));
#define LAYER(l) \
        RUN(ph_norm(p, l, 0, T, false)); \
        RUN({ Gemm g{(const bf16*)(p.ws + WS_HM), (const bf16*)(p.ws + WS_WIN) + (size_t)l * INWP * 1024, 0}; DenseSched S{T / 256, INWP / 256, G, c}; \
            EpiInProj E{(bf16*)(p.ws + WS_PROJ), (float*)(p.ws + WS_DT), IN(18) + l * 16, IN(19) + l * 16}; gemm_phase<D, 1024, 1024>(g, S, E); }); \
        RUN(ph_conv(p, l)); \
        RUN({ Gemm g{(const bf16*)(p.ws + WS_PROJ), (const bf16*)(p.ws + WS_WQKV) + (size_t)l * 1024 * 384, 0}; DenseSched S{T / 256, 4, G, c}; \
            EpiMla E{(bf16*)(p.ws + WS_Q), (bf16*)(p.ws + WS_K), (bf16*)(p.ws + WS_V), (const float*)(p.ws + WS_RQ), (const float*)(p.ws + WS_RKV), (const float*)(p.ws + WS_ROPE)}; gemm_phase<INWP, 384, 384>(g, S, E); ph_scanA(p, l, lds); }); \
        RUN(ph_mixer(p, l, lds)); \
        RUN(ph_scanC(p, l, lds)); \
        if (l == 1) RUN(ph_moew(p)); \
        RUN({ Gemm g{(const bf16*)(p.ws + WS_HM), (const bf16*)(p.ws + WS_WOUT) + (size_t)l * 1024 * 1024, 0}; DenseSched S{(l == 0 ? T : NLAT) / 256, 4, G, c}; \
            EpiResid E{l == 0 ? IN(0) : p.out, l == 0 ? IN(2) : (const float*)(p.ws + WS_XC), p.out, (float*)(p.ws + WS_XC), (const float*)(p.ws + WS_MODV) + (size_t)l * 3 * 6144, 2}; gemm_phase<D, 1024, 1024>(g, S, E); }); \
        RUN(ph_norm(p, l, 1, l == 0 ? T : NLAT, l == 1)); \
        if (l == 0) { \
            RUN({ Gemm g{(const bf16*)(p.ws + WS_HM), (const bf16*)(p.ws + WS_WGU), 0}; DenseSched S{T / 256, 2 * DFF / 256, G, c}; \
                EpiSwiglu E{(bf16*)(p.ws + WS_PROJ), DFF}; gemm_phase<D, 1024, 1024>(g, S, E); }); \
            RUN({ Gemm g{(const bf16*)(p.ws + WS_PROJ), (const bf16*)(p.ws + WS_WD), 0}; DenseSched S{T / 256, 4, G, c}; \
                EpiResid E{p.out, (const float*)(p.ws + WS_XC), p.out, (float*)(p.ws + WS_XC), (const float*)(p.ws + WS_MODV), 5}; gemm_phase<DFF, DFF, DFF>(g, S, E); }); \
        } else { \
            RUN(ph_sort(p, lds)); \
            RUN({ Gemm g{(const bf16*)(p.ws + WS_HS), (const bf16*)(p.ws + WS_WGUE), (size_t)2 * DFE * 1024}; MoeSched S{(const int*)(p.ws + WS_RT + 384 * 1024), 2 * DFE / 256, G, c}; \
                EpiSwiglu E{(bf16*)(p.ws + WS_ACTS), DFE}; gemm_phase<D, 1024, 1024>(g, S, E); }); \
            RUN({ Gemm g{(const bf16*)(p.ws + WS_ACTS), (const bf16*)(p.ws + WS_WDE), (size_t)1024 * DFE}; MoeSched S{(const int*)(p.ws + WS_RT + 384 * 1024), 4, G, c}; \
                EpiStore E{(bf16*)(p.ws + WS_HS), D}; gemm_phase<DFE, DFE, DFE>(g, S, E); }); \
            RUN(ph_final(p)); \
        }
    LAYER(0)
    LAYER(1)
#undef LAYER
#undef RUN
}

#ifndef MK_ONE_LAUNCH
#define MK_ONE_LAUNCH 1
#endif
extern "C" void kernel_launch(void* const* d_in, const int* in_sizes, int n_in, void* d_out, int out_size, void* d_ws, size_t ws_size, hipStream_t stream) {
    static int grid = 0;
    if (grid == 0) {
        if (n_in != 30 || out_size != NLAT * D || ws_size < WS_END) { fprintf(stderr, "kernel_launch: unexpected problem (n_in %d out %d ws %zu, need %zu)\n", n_in, out_size, ws_size, (size_t)WS_END); grid = -1; return; }
        int dev = 0, cus = 0, per_cu = 0;
        hipGetDevice(&dev); hipDeviceGetAttribute(&cus, hipDeviceAttributeMultiprocessorCount, dev);
        if (hipFuncSetAttribute((const void*)mk_fwd, hipFuncAttributeMaxDynamicSharedMemorySize, LDS_BYTES) != hipSuccess) { fprintf(stderr, "kernel_launch: hipFuncSetAttribute failed\n"); grid = -1; return; }
        if (hipOccupancyMaxActiveBlocksPerMultiprocessor(&per_cu, (const void*)mk_fwd, NTHREADS, LDS_BYTES) != hipSuccess || per_cu < 1) { fprintf(stderr, "kernel_launch: occupancy query failed (%d)\n", per_cu); grid = -1; return; }
        grid = cus;
        fprintf(stderr, "kernel_launch: grid %d (cus %d, per_cu %d)\n", grid, cus, per_cu);
    }
    if (grid < 0) return;
    P p{};
    for (int i = 0; i < 30; ++i) p.in[i] = (const float*)d_in[i];
    p.out = (float*)d_out; p.ws = (unsigned char*)d_ws;
#if MK_ONE_LAUNCH
    p.ph_lo = 0; p.ph_hi = NPHASES;
    { void* args[] = {&p}; hipError_t e = hipLaunchCooperativeKernel((const void*)mk_fwd, dim3(grid), dim3(NTHREADS), args, LDS_BYTES, stream);
      if (e != hipSuccess) fprintf(stderr, "cooperative launch failed: %s\n", hipGetErrorString(e)); }
#else
    for (int ph = 0; ph < NPHASES; ++ph) {
        p.ph_lo = ph; p.ph_hi = ph + 1;
        void* args[] = {&p}; hipError_t e = hipLaunchCooperativeKernel((const void*)mk_fwd, dim3(grid), dim3(NTHREADS), args, LDS_BYTES, stream);
        if (e != hipSuccess) { fprintf(stderr, "cooperative launch %d failed: %s\n", ph, hipGetErrorString(e)); break; }
    }
#endif
}
```

```cpp
#include <hip/hip_runtime.h>
#include <hip/hip_cooperative_groups.h>
#include <cstdio>
#include <cstdint>
namespace cg = cooperative_groups;

#define DEVI __device__ __forceinline__
typedef unsigned short bf16;
typedef short bf16x8 __attribute__((ext_vector_type(8)));
typedef float f32x4 __attribute__((ext_vector_type(4)));
typedef float f32x2 __attribute__((ext_vector_type(2)));
typedef float f32x16 __attribute__((ext_vector_type(16)));
typedef unsigned u32x4 __attribute__((ext_vector_type(4)));
typedef unsigned u32x2 __attribute__((ext_vector_type(2)));
typedef __bf16 bf16x2_t __attribute__((ext_vector_type(2)));

constexpr int D = 1024, NB = 2, SEQ = 8192, NLAT = NB * SEQ, CL = 256, NCTX = NB * CL, T = NLAT + NCTX;
constexpr int INW = 2736, INWP = 2816;
constexpr int C_CQ = 0, C_CKV = 256, C_KPE = 384, C_RQ = 416, C_RK = 672, C_RV = 928, C_RG = 1184, C_Z = 1440, C_XBC = 1952, C_DTF = 2720, C_DTB = 2728;
constexpr int DFF = 2816, DFE = 1408, NEXP = 8;
constexpr float EPS = 1e-6f;
constexpr int MOE_MAXROWS = 34816;

constexpr size_t MiB = 1u << 20;
constexpr size_t WS_CTL = 0;
constexpr size_t WS_MODV = 1 * MiB;
constexpr size_t WS_ROPE = WS_MODV + 256 * 1024;
constexpr size_t WS_RQ = WS_MODV + 512 * 1024;
constexpr size_t WS_RKV = WS_MODV + 640 * 1024;
constexpr size_t WS_WIN = 2 * MiB;
constexpr size_t WS_WQKV = 13 * MiB;
constexpr size_t WS_WOUT = 15 * MiB;
constexpr size_t WS_WGU = 19 * MiB;
constexpr size_t WS_WD = 30 * MiB;
constexpr size_t WS_XC = 36 * MiB;
constexpr size_t WS_RT = 38 * MiB;
constexpr size_t WS_DT = 39 * MiB;
constexpr size_t DYN = 42 * MiB;
constexpr size_t WS_HM = DYN;
constexpr size_t WS_PROJ = DYN + 33 * MiB;
constexpr size_t WS_XBC = DYN + 124 * MiB;
constexpr size_t WS_Q = DYN + 149 * MiB;
constexpr size_t WS_K = DYN + 161 * MiB + 512 * 1024;
constexpr size_t WS_V = DYN + 174 * MiB;
constexpr size_t WS_ST = DYN + 182 * MiB + 512 * 1024;
constexpr size_t WS_HT = WS_ST + (size_t)1584 * 2 * 4096 * 4;
constexpr size_t WS_CD = WS_RT + 512 * 1024;
constexpr size_t WS_WGUE = DYN + 33 * MiB;
constexpr size_t WS_WDE = DYN + 77 * MiB;
constexpr size_t WS_HS = DYN + 99 * MiB;
constexpr size_t WS_ACTS = DYN + 167 * MiB;
constexpr size_t WS_END = DYN + 261 * MiB;
static_assert(WS_HM + (size_t)T * 1024 * 2 <= WS_PROJ && WS_PROJ + (size_t)T * 2816 * 2 <= WS_XBC && WS_XBC + (size_t)T * 768 * 2 <= WS_Q &&
              WS_Q + (size_t)T * 384 * 2 <= WS_K && WS_K + (size_t)T * 384 * 2 <= WS_V && WS_V + (size_t)T * 256 * 2 <= WS_ST && WS_HT + (size_t)1584 * 2 * 4096 * 2 <= WS_END, "ws map (mixer)");
static_assert(WS_WGUE + (size_t)8 * 2816 * 1024 * 2 <= WS_WDE && WS_WDE + (size_t)8 * 1024 * 1408 * 2 <= WS_HS && WS_HS + (size_t)MOE_MAXROWS * 1024 * 2 <= WS_ACTS &&
              WS_ACTS + (size_t)MOE_MAXROWS * 1408 * 2 <= WS_END, "ws map (moe)");
static_assert(WS_DT + (size_t)T * 32 * 4 <= DYN && WS_WD + (size_t)1024 * 2816 * 2 <= WS_XC && WS_WIN + (size_t)2 * 2816 * 1024 * 2 <= WS_WQKV, "ws map (static)");

constexpr int NTHREADS = 512, NWAVES = 8;
constexpr int LDS_BYTES = 147456;

struct P { const float* in[30]; float* out; unsigned char* ws; int ph_lo, ph_hi; };
constexpr int LDS_MISC = 131072 + 512;
constexpr int LDS_PTRS = 131072 + 1024;
typedef __attribute__((address_space(3))) unsigned long long lds_u64;
DEVI const float* inptr(int i) {
    const unsigned long long v = ((lds_u64*)(uintptr_t)LDS_PTRS)[i];
    const unsigned lo = __builtin_amdgcn_readfirstlane((unsigned)v), hi = __builtin_amdgcn_readfirstlane((unsigned)(v >> 32));
    return (const float*)(((unsigned long long)hi << 32) | lo);
}
#define IN(i) inptr(i)
DEVI int otid() { int t = threadIdx.x; asm volatile("" : "+v"(t)); return t; }

DEVI float bf2f(bf16 x) { return __uint_as_float(((unsigned)x) << 16); }
DEVI unsigned pk2(float lo, float hi) { f32x2 v = {lo, hi}; bf16x2_t b = __builtin_convertvector(v, bf16x2_t); return __builtin_bit_cast(unsigned, b); }
DEVI bf16 f2bf(float x) { return (bf16)(pk2(x, 0.f) & 0xffffu); }
DEVI float wave_sum(float v) {
#pragma unroll
    for (int o = 1; o < 64; o <<= 1) v += __shfl_xor(v, o);
    return v;
}
DEVI float siluf(float x) { return x / (1.f + __expf(-x)); }
DEVI float softplusf(float x) { return fmaxf(x, 0.f) + log1pf(__expf(-fabsf(x))); }
DEVI int rope_src(int p) { const int q = p & 15, s = (q & 1) ? 8 + (q >> 1) : (q >> 1); return (p & 16) + s; }

#define LAS __attribute__((address_space(3)))
struct Unit { int pm, pn, e; };
struct Gemm { const bf16* A; const bf16* Bt; size_t bstride; };
constexpr int BM = 256, BK = 64, HALF = 128, HTB = HALF * BK * 2, STAGE_BYTES = 8 * HTB, NXCD = 8, WGM = 8;
__host__ __device__ __forceinline__ int lds_byte(int r, int c) { const int st = (r >> 4) * 2 + (c >> 5), rr = r & 15, cc = c & 31, ob = rr * 64 + cc * 2; return st * 1024 + (ob ^ (((ob >> 9) & 1) << 5)); }
__host__ __device__ __forceinline__ void stage_rc(int b, int& R, int& C) { const int st = b / 1024, sb = b % 1024, swz = sb ^ (((sb >> 9) & 1) << 5); R = (st >> 1) * 16 + swz / 64; C = (st & 1) * 32 + (swz % 64) / 2; }
struct DenseSched {
    int nM, nN, G, c;
    DEVI bool next(int i, Unit& u) const {
        const int nwg = nM * nN; const long L = (long)i * G + c; if (L >= nwg) return false;
        int wgid = (int)L; { const int q = nwg / NXCD, r = nwg % NXCD, xcd = wgid % NXCD, off = wgid / NXCD; wgid = (xcd < r ? xcd * (q + 1) : r * (q + 1) + (xcd - r) * q) + off; }
        const int nig = WGM * nN, gid = wgid / nig, fm = gid * WGM, gsz = (nM - fm) < WGM ? (nM - fm) : WGM;
        u.pm = fm + ((wgid % nig) % gsz); u.pn = (wgid % nig) / gsz; u.e = 0; return true;
    }
};
struct MoeSched {
    const int* tab; int nN, G, c;
    DEVI bool next(int i, Unit& u) const { DenseSched d{tab[0], nN, G, c}; if (!d.next(i, u)) return false; u.e = tab[1 + u.pm]; return true; }
};
template <int LDA, int LDB, int KK, class Epi, class Sched>
DEVI void gemm_phase(unsigned char* lds_generic, const Gemm g, const Sched& S, const Epi& E) {
    LAS unsigned char* lds = (LAS unsigned char*)lds_generic;
    const int tid = otid(), wid = __builtin_amdgcn_readfirstlane(tid >> 6), lane = tid & 63, wr = wid >> 2, wc = wid & 3, fr = lane & 15, fq = lane >> 4;
    constexpr int nt = KK / BK; static_assert(KK % 128 == 0, "K must be a multiple of 128");
    unsigned voffA[2], voffB[2];
#pragma unroll
    for (int i = 0; i < 2; ++i) { int R, C; stage_rc(tid * 16 + i * 8192, R, C); voffA[i] = (unsigned)(R * LDA + C) * 2u; voffB[i] = (unsigned)(R * LDB + C) * 2u; }
    constexpr size_t kstep = (size_t)(BK * 2), hstepA = (size_t)HALF * LDA * 2, hstepB = (size_t)HALF * LDB * 2, tstepA = 2 * hstepA, tstepB = 2 * hstepB;
    const unsigned ldsw = (unsigned)wid * 1024u;
    const int aoff = lds_byte(wr * 64 + fr, fq * 8), boff = lds_byte(wc * 32 + fr, fq * 8);
#define PG8_SA(b, h) (((b) * 2 + (h)) * HTB)
#define PG8_SB(b, h) ((4 + (b) * 2 + (h)) * HTB)
#define PG8_STAGE(bufoff, gbase, voff) do { _Pragma("unroll") for (int _i = 0; _i < 2; ++_i) \
        __builtin_amdgcn_global_load_lds((const unsigned*)((const char*)(gbase) + (voff)[_i]), (LAS unsigned*)(lds + (bufoff) + ldsw + _i * 8192), 16, 0, 0); } while (0)
#define PG8_LDA(dst, b, h) do { _Pragma("unroll") for (int m = 0; m < 4; ++m) _Pragma("unroll") for (int k = 0; k < 2; ++k) dst[m][k] = *(const LAS bf16x8*)(lds + PG8_SA(b, h) + aoff + m * 2048 + k * 1024); } while (0)
#define PG8_LDB(dst, b, h) do { _Pragma("unroll") for (int n = 0; n < 2; ++n) _Pragma("unroll") for (int k = 0; k < 2; ++k) dst[n][k] = *(const LAS bf16x8*)(lds + PG8_SB(b, h) + boff + n * 2048 + k * 1024); } while (0)
#define PG8_MMA(ai, bj, At, Bt) do { __builtin_amdgcn_s_setprio(1); _Pragma("unroll") for (int m = 0; m < 4; ++m) _Pragma("unroll") for (int n = 0; n < 2; ++n) _Pragma("unroll") for (int k = 0; k < 2; ++k) \
        acc[ai][bj][m][n] = __builtin_amdgcn_mfma_f32_16x16x32_bf16(Bt[n][k], At[m][k], acc[ai][bj][m][n], 0, 0, 0); __builtin_amdgcn_s_setprio(0); } while (0)
#define PG8_WAIT_V(n) asm volatile("s_waitcnt vmcnt(" #n ")" ::: "memory")
#define PG8_WAIT_L(n) asm volatile("s_waitcnt lgkmcnt(" #n ")" ::: "memory")
#define PG8_BAR __builtin_amdgcn_s_barrier()
#define PG8_SCHED __builtin_amdgcn_sched_barrier(0)
    Unit cur, nxt; int ui = 0;
    if (!S.next(0, cur)) return;
    f32x4 acc[2][2][4][2];
#pragma unroll
    for (int a = 0; a < 2; ++a)
#pragma unroll
        for (int b = 0; b < 2; ++b)
#pragma unroll
            for (int m = 0; m < 4; ++m)
#pragma unroll
                for (int n = 0; n < 2; ++n) acc[a][b][m][n] = (f32x4){0.f, 0.f, 0.f, 0.f};
    bf16x8 At[4][2], B0[2][2], B1[2][2];
    const char* cA = (const char*)g.A + (size_t)cur.pm * tstepA; const char* cB = (const char*)(g.Bt + (size_t)cur.e * g.bstride) + (size_t)cur.pn * tstepB;
    PG8_WAIT_V(0); PG8_WAIT_L(0); __syncthreads();
    PG8_STAGE(PG8_SB(0, 0), cB, voffB); PG8_STAGE(PG8_SB(0, 1), cB + hstepB, voffB); PG8_STAGE(PG8_SA(0, 0), cA, voffA); PG8_STAGE(PG8_SA(0, 1), cA + hstepA, voffA);
    if (wr == 1) PG8_BAR;
    PG8_WAIT_V(2); PG8_BAR;
    PG8_STAGE(PG8_SB(1, 0), cB + kstep, voffB); PG8_STAGE(PG8_SA(1, 0), cA + kstep, voffA); PG8_STAGE(PG8_SB(1, 1), cB + hstepB + kstep, voffB);
    PG8_WAIT_V(6); PG8_BAR;
    for (;;) {
        const bool has_next = S.next(ui + 1, nxt);
        const char* nA = has_next ? (const char*)g.A + (size_t)nxt.pm * tstepA : cA; const char* nB = has_next ? (const char*)(g.Bt + (size_t)nxt.e * g.bstride) + (size_t)nxt.pn * tstepB : cB;
#pragma unroll 1
        for (int t = 0; t < nt; t += 2) {
            const bool last = (t == nt - 2);
            const char* a1 = cA + (size_t)(t + 1) * kstep;
            const char* a2 = last ? nA : cA + (size_t)(t + 2) * kstep; const char* b2 = last ? nB : cB + (size_t)(t + 2) * kstep;
            const char* a3 = a2 + kstep; const char* b3 = b2 + kstep;
            PG8_LDB(B0, 0, 0); PG8_LDB(B1, 0, 1); PG8_SCHED; PG8_LDA(At, 0, 0); PG8_STAGE(PG8_SA(1, 1), a1 + hstepA, voffA);
            PG8_WAIT_V(8); PG8_WAIT_L(0); PG8_BAR; PG8_MMA(0, 0, At, B0); PG8_MMA(0, 1, At, B1); PG8_BAR; PG8_SCHED;
            PG8_LDA(At, 0, 1); PG8_STAGE(PG8_SB(0, 0), b2, voffB); PG8_STAGE(PG8_SB(0, 1), b2 + hstepB, voffB); PG8_STAGE(PG8_SA(0, 0), a2, voffA);
            PG8_WAIT_V(8); PG8_WAIT_L(0); PG8_BAR; PG8_MMA(1, 0, At, B0); PG8_MMA(1, 1, At, B1); PG8_BAR; PG8_SCHED;
            PG8_LDB(B0, 1, 0); PG8_LDB(B1, 1, 1); PG8_SCHED; PG8_LDA(At, 1, 0); PG8_STAGE(PG8_SA(0, 1), a2 + hstepA, voffA);
            PG8_WAIT_V(8); PG8_WAIT_L(0); PG8_BAR; PG8_MMA(0, 0, At, B0); PG8_MMA(0, 1, At, B1); PG8_BAR; PG8_SCHED;
            PG8_LDA(At, 1, 1); PG8_STAGE(PG8_SB(1, 0), b3, voffB); PG8_STAGE(PG8_SB(1, 1), b3 + hstepB, voffB); PG8_STAGE(PG8_SA(1, 0), a3, voffA);
            PG8_WAIT_V(8); PG8_WAIT_L(0); PG8_BAR; PG8_MMA(1, 0, At, B0); PG8_MMA(1, 1, At, B1); PG8_BAR; PG8_SCHED;
        }
        if (wr == 0) PG8_BAR;
        E(acc, cur, wr, wc, fr, fq);
        if (!has_next) break;
#pragma unroll
        for (int a = 0; a < 2; ++a)
#pragma unroll
            for (int b = 0; b < 2; ++b)
#pragma unroll
                for (int m = 0; m < 4; ++m)
#pragma unroll
                    for (int n = 0; n < 2; ++n) acc[a][b][m][n] = (f32x4){0.f, 0.f, 0.f, 0.f};
        cur = nxt; cA = nA; cB = nB; ++ui;
        if (wr == 1) PG8_BAR;
    }
    PG8_WAIT_V(0);
    PG8_BAR;
#undef PG8_SA
#undef PG8_SB
#undef PG8_STAGE
#undef PG8_LDA
#undef PG8_LDB
#undef PG8_MMA
#undef PG8_WAIT_V
#undef PG8_WAIT_L
#undef PG8_BAR
#undef PG8_SCHED
}
#define EPI_LOOP_ROWS _Pragma("unroll") for (int ai = 0; ai < 2; ++ai) _Pragma("unroll") for (int m = 0; m < 4; ++m)
#define EPI_ROW (u.pm * 256 + ai * 128 + wr * 64 + m * 16 + fr)
#define EPI_COL(bj, n) (u.pn * 256 + (bj) * 128 + wc * 32 + (n) * 16 + fq * 4)

DEVI void st_bf16x4(bf16* p, f32x4 v) { u32x2 w; w.x = pk2(v[0], v[1]); w.y = pk2(v[2], v[3]); *(u32x2*)p = w; }

struct EpiInProj {
    bf16* proj; float* dt; const float* dt_bias; const float* a_log;
    DEVI void operator()(const f32x4 (&acc)[2][2][4][2], const Unit& u, int wr, int wc, int fr, int fq) const {
        EPI_LOOP_ROWS { const int row = EPI_ROW;
#pragma unroll
            for (int bj = 0; bj < 2; ++bj)
#pragma unroll
                for (int n = 0; n < 2; ++n) { const int col = EPI_COL(bj, n); const f32x4 v = acc[ai][bj][m][n];
                    if (col < C_DTF) st_bf16x4(proj + (size_t)row * INWP + col, v);
                    else if (col < INW) { const int j0 = col - C_DTF; f32x4 dv, lv;
#pragma unroll
                        for (int i = 0; i < 4; ++i) { const float d_ = softplusf(v[i] + dt_bias[j0 + i]); dv[i] = d_; lv[i] = -d_ * __expf(a_log[j0 + i]); }
                        *(f32x4*)(dt + (size_t)row * 32 + j0) = dv; *(f32x4*)(dt + (size_t)row * 32 + 16 + j0) = lv; } } }
    }
};
struct EpiMla {
    bf16 *Q, *K, *V; const float *rq, *rkv; const float* rope;
    DEVI void operator()(const f32x4 (&acc)[2][2][4][2], const Unit& u, int wr, int wc, int fr, int fq) const {
        EPI_LOOP_ROWS { const int row = EPI_ROW; const float sq = rq[row], skv = rkv[row];
#pragma unroll
            for (int bj = 0; bj < 2; ++bj)
#pragma unroll
                for (int n = 0; n < 2; ++n) { const int col = EPI_COL(bj, n); f32x4 v = acc[ai][bj][m][n];
                    if (col < 384) { v = v * sq; const int d = col % 96;
                        if (d >= 64 && row < NLAT) { const int pos = row & (SEQ - 1), gr = pos >> 6, gc = pos & 63, pp = (d - 64) >> 1;
#pragma unroll
                            for (int i = 0; i < 2; ++i) { const int pi = pp + i; const float* tb = (pi < 8) ? rope + (gr * 8 + pi) * 2 : rope + 2048 + (gc * 8 + (pi - 8)) * 2;
                                const float c = tb[0], s = tb[1], x0 = v[2 * i], x1 = v[2 * i + 1]; v[2 * i] = x0 * c - x1 * s; v[2 * i + 1] = x1 * c + x0 * s; } }
                        st_bf16x4(Q + (size_t)row * 384 + col, v); }
                    else if (col >= 512 && col < 768) { const int c = col - 512; st_bf16x4(K + (size_t)row * 384 + (c >> 6) * 96 + (c & 63), v * skv); }
                    else if (col >= 768) { st_bf16x4(V + (size_t)row * 256 + (col - 768), v * skv); } }
            asm volatile("" ::: "memory"); }
    }
};
struct EpiResid {
    const float* src_lat; const float* src_ctx; float* dst_lat; float* dst_ctx; const float* modv_l; int gidx;
    DEVI void operator()(const f32x4 (&acc)[2][2][4][2], const Unit& u, int wr, int wc, int fr, int fq) const {
        EPI_LOOP_ROWS { const int row = EPI_ROW; const bool lat = row < NLAT; const int r = lat ? (row >> 13) : 2;
            const float* s = lat ? src_lat + (size_t)row * D : src_ctx + (size_t)(row - NLAT) * D; float* d = lat ? dst_lat + (size_t)row * D : dst_ctx + (size_t)(row - NLAT) * D;
            const float* gp = modv_l + r * 6144 + gidx * 1024;
#pragma unroll
            for (int bj = 0; bj < 2; ++bj)
#pragma unroll
                for (int n = 0; n < 2; ++n) { const int col = EPI_COL(bj, n); const f32x4 gv = *(const f32x4*)(gp + col), sv = *(const f32x4*)(s + col);
                    *(f32x4*)(d + col) = sv + gv * acc[ai][bj][m][n]; } }
    }
};
struct EpiSwiglu {
    bf16* act; int ldc;
    DEVI void operator()(const f32x4 (&acc)[2][2][4][2], const Unit& u, int wr, int wc, int fr, int fq) const {
        EPI_LOOP_ROWS { const int row = EPI_ROW;
#pragma unroll
            for (int n = 0; n < 2; ++n) { const f32x4 gt = acc[ai][0][m][n], up = acc[ai][1][m][n]; f32x4 o;
#pragma unroll
                for (int i = 0; i < 4; ++i) o[i] = siluf(gt[i]) * up[i];
                st_bf16x4(act + (size_t)row * ldc + u.pn * 128 + wc * 32 + n * 16 + fq * 4, o); } }
    }
};
struct EpiStore {
    bf16* o; int ldc;
    DEVI void operator()(const f32x4 (&acc)[2][2][4][2], const Unit& u, int wr, int wc, int fr, int fq) const {
        EPI_LOOP_ROWS { const int row = EPI_ROW;
#pragma unroll
            for (int bj = 0; bj < 2; ++bj)
#pragma unroll
                for (int n = 0; n < 2; ++n) st_bf16x4(o + (size_t)row * ldc + EPI_COL(bj, n), acc[ai][bj][m][n]); }
    }
};

template <class F>
DEVI void cvt_job(bf16* dst, int Nd, int Kd, F f, long gtid, long gthreads) {
    const int kch = Kd >> 3; const long nitems = (long)Nd * kch;
    for (long it = gtid; it < nitems; it += gthreads) {
        const int n = (int)(it % Nd), k0 = (int)(it / Nd) * 8;
        u32x4 o; o.x = pk2(f(n, k0), f(n, k0 + 1)); o.y = pk2(f(n, k0 + 2), f(n, k0 + 3)); o.z = pk2(f(n, k0 + 4), f(n, k0 + 5)); o.w = pk2(f(n, k0 + 6), f(n, k0 + 7));
        *(u32x4*)(dst + (size_t)n * Kd + k0) = o;
    }
}
DEVI void ph_pro(const P& p, unsigned char* lds) {
    const int tid = otid(), wid = tid >> 6, lane = tid & 63;
    float* modv = (float*)(p.ws + WS_MODV);
    float* red = (float*)lds;
    for (int item = blockIdx.x; item < 192; item += gridDim.x) {
        const int l = item / 96, n = (item % 96) * 64 + lane;
        const float* W = IN(4) + (size_t)l * 1024 * 6144;
        float a0 = 0.f, a1 = 0.f, a2 = 0.f;
        for (int k = wid * 128; k < wid * 128 + 128; ++k) {
            const float w = W[(size_t)k * 6144 + n];
            a0 += siluf(IN(1)[k]) * w; a1 += siluf(IN(1)[1024 + k]) * w; a2 += siluf(IN(3)[k]) * w;
        }
        red[(wid * 3 + 0) * 64 + lane] = a0; red[(wid * 3 + 1) * 64 + lane] = a1; red[(wid * 3 + 2) * 64 + lane] = a2;
        __syncthreads();
        if (tid < 192) { const int r = tid >> 6, ln = tid & 63; float s = 0.f;
            for (int w = 0; w < 8; ++w) s += red[(w * 3 + r) * 64 + ln];
            const int nn = (item % 96) * 64 + ln; modv[(l * 3 + r) * 6144 + nn] = s + IN(5)[l * 6144 + nn]; }
        __syncthreads();
    }
    if (blockIdx.x == gridDim.x - 1) {
        float* rope = (float*)(p.ws + WS_ROPE);
        for (int idx = tid; idx < 1536; idx += NTHREADS) {
            const int i = idx & 7, pos = (idx < 1024) ? (idx >> 3) : ((idx - 1024) >> 3);
            const float invf = (i == 0) ? 1.f : (i == 1) ? 0.31622776601683794f : (i == 2) ? 0.1f : (i == 3) ? 0.03162277660168379f : (i == 4) ? 0.01f : (i == 5) ? 0.003162277660168379f : (i == 6) ? 0.001f : 0.00031622776601683794f;
            const float ang = (float)pos * invf;
            double rev = (double)ang * 0.15915494309189535; rev -= __builtin_rint(rev);
            const float fr = (float)rev;
            rope[idx * 2] = __builtin_amdgcn_cosf(fr); rope[idx * 2 + 1] = __builtin_amdgcn_sinf(fr);
        }
    }
    const long gtid = (long)blockIdx.x * NTHREADS + tid, gth = (long)gridDim.x * NTHREADS;
    for (int l = 0; l < 2; ++l) {
        { const float* W = IN(8) + (size_t)l * 1024 * INW;
          cvt_job((bf16*)(p.ws + WS_WIN) + (size_t)l * INWP * 1024, INWP, 1024, [=](int n, int k) -> float {
              if (n >= INW) return 0.f; const int sc = (n >= C_KPE && n < C_KPE + 32) ? C_KPE + rope_src(n - C_KPE) : n; return W[(size_t)k * INW + sc]; }, gtid, gth); }
        { const float* Wq = IN(11) + (size_t)l * 256 * 384; const float* qn = IN(10) + l * 256; const float* Wk = IN(13) + (size_t)l * 128 * 256; const float* Wv = IN(14) + (size_t)l * 128 * 256; const float* kn = IN(12) + l * 128;
          const float QS = 0.10206207261596577f * 1.4426950408889634f;
          cvt_job((bf16*)(p.ws + WS_WQKV) + (size_t)l * 1024 * 384, 1024, 384, [=](int n, int k) -> float {
              if (n < 384) { if (k >= 256) return 0.f; const int h = n / 96, d = n % 96; const int sc = (d >= 64) ? h * 96 + 64 + rope_src(d - 64) : n; return Wq[(size_t)k * 384 + sc] * qn[k] * QS; }
              if (n < 512) return 0.f;
              if (k < 256) return 0.f;
              if (n < 768) return Wk[(size_t)(k - 256) * 256 + (n - 512)] * kn[k - 256];
              return Wv[(size_t)(k - 256) * 256 + (n - 768)] * kn[k - 256]; }, gtid, gth); }
        { const float* W = IN(9) + (size_t)l * 1024 * 1024;
          cvt_job((bf16*)(p.ws + WS_WOUT) + (size_t)l * 1024 * 1024, 1024, 1024, [=](int n, int k) -> float { return W[(size_t)k * 1024 + n]; }, gtid, gth); }
    }
    { const float* Wg = IN(22); const float* Wu = IN(23);
      cvt_job((bf16*)(p.ws + WS_WGU), 2 * DFF, 1024, [=](int n, int k) -> float { const int t = n >> 8, r = n & 255; return (r < 128) ? Wg[(size_t)k * DFF + t * 128 + r] : Wu[(size_t)k * DFF + t * 128 + r - 128]; }, gtid, gth); }
    { const float* W = IN(24);
      cvt_job((bf16*)(p.ws + WS_WD), 1024, DFF, [=](int n, int k) -> float { return W[(size_t)k * 1024 + n]; }, gtid, gth); }
}
DEVI void ph_moew(const P& p) {
    const long gtid = (long)blockIdx.x * NTHREADS + otid(), gth = (long)gridDim.x * NTHREADS;
    for (int e = 0; e < NEXP; ++e) {
        { const float* Wg = IN(26) + (size_t)e * 1024 * DFE; const float* Wu = IN(27) + (size_t)e * 1024 * DFE;
          cvt_job((bf16*)(p.ws + WS_WGUE) + (size_t)e * 2 * DFE * 1024, 2 * DFE, 1024, [=](int n, int k) -> float { const int t = n >> 8, r = n & 255; return (r < 128) ? Wg[(size_t)k * DFE + t * 128 + r] : Wu[(size_t)k * DFE + t * 128 + r - 128]; }, gtid, gth); }
        { const float* W = IN(28) + (size_t)e * DFE * 1024;
          cvt_job((bf16*)(p.ws + WS_WDE) + (size_t)e * 1024 * DFE, 1024, DFE, [=](int n, int k) -> float { return W[(size_t)k * 1024 + n]; }, gtid, gth); }
    }
}

DEVI void ph_norm(const P& p, int l, int which, int nrows, bool route) {
    const int tid = otid(), wid = tid >> 6, lane = tid & 63;
    const bool first = (l == 0 && which == 0);
    const float* src_lat = first ? IN(0) : p.out; const float* src_ctx = first ? IN(2) : (const float*)(p.ws + WS_XC);
    const float* w = IN(6 + which) + l * 1024; const float* modv = (const float*)(p.ws + WS_MODV) + (size_t)l * 3 * 6144;
    bf16* H = (bf16*)(p.ws + WS_HM);
    const float* router = IN(25);
    int* rt_e = (int*)(p.ws + WS_RT); float* rt_g = (float*)(p.ws + WS_RT + 128 * 1024);
    for (int row = blockIdx.x * NWAVES + wid; row < nrows; row += gridDim.x * NWAVES) {
        const bool lat = row < NLAT; const int r = lat ? (row >> 13) : 2;
        const float* x = lat ? src_lat + (size_t)row * D : src_ctx + (size_t)(row - NLAT) * D;
        const float* sh = modv + r * 6144 + (which * 3 + 0) * 1024; const float* sc = modv + r * 6144 + (which * 3 + 1) * 1024;
        f32x4 v[4]; float ss = 0.f;
#pragma unroll
        for (int j = 0; j < 4; ++j) { v[j] = *(const f32x4*)(x + (j * 64 + lane) * 4); ss += v[j][0] * v[j][0] + v[j][1] * v[j][1] + v[j][2] * v[j][2] + v[j][3] * v[j][3]; }
        ss = wave_sum(ss); const float rstd = 1.0f / sqrtf(ss * (1.f / D) + EPS);
        float lg[8];
#pragma unroll
        for (int e = 0; e < 8; ++e) lg[e] = 0.f;
#pragma unroll
        for (int j = 0; j < 4; ++j) { const int c0 = (j * 64 + lane) * 4; const f32x4 wv = *(const f32x4*)(w + c0), sv = *(const f32x4*)(sh + c0), cv = *(const f32x4*)(sc + c0);
            f32x4 h;
#pragma unroll
            for (int i = 0; i < 4; ++i) h[i] = (v[j][i] * rstd * wv[i]) * (1.f + cv[i]) + sv[i];
            st_bf16x4(H + (size_t)row * D + c0, h);
            if (route) {
#pragma unroll
                for (int i = 0; i < 4; ++i) { const f32x4 r0 = *(const f32x4*)(router + (size_t)(c0 + i) * 8), r1 = *(const f32x4*)(router + (size_t)(c0 + i) * 8 + 4);
                    lg[0] += h[i] * r0[0]; lg[1] += h[i] * r0[1]; lg[2] += h[i] * r0[2]; lg[3] += h[i] * r0[3]; lg[4] += h[i] * r1[0]; lg[5] += h[i] * r1[1]; lg[6] += h[i] * r1[2]; lg[7] += h[i] * r1[3]; } } }
        if (route) {
#pragma unroll
            for (int e = 0; e < 8; ++e) lg[e] = wave_sum(lg[e]);
            int i1 = 0; float v1 = lg[0];
#pragma unroll
            for (int e = 1; e < 8; ++e) if (lg[e] > v1) { v1 = lg[e]; i1 = e; }
            int i2 = -1; float v2 = -3.0e38f;
#pragma unroll
            for (int e = 0; e < 8; ++e) if (e != i1 && lg[e] > v2) { v2 = lg[e]; i2 = e; }
            const float e2 = __expf(v2 - v1), g1 = 1.f / (1.f + e2), g2 = e2 / (1.f + e2);
            if (lane == 0) { rt_e[row * 2] = i1; rt_e[row * 2 + 1] = i2; rt_g[row * 2] = g1; rt_g[row * 2 + 1] = g2; }
        }
    }
}

DEVI void ph_conv(const P& p, int l) {
    const int tid = otid(), wid = tid >> 6, lane = tid & 63;
    const bf16* proj = (const bf16*)(p.ws + WS_PROJ); bf16* xbc = (bf16*)(p.ws + WS_XBC); bf16* Kb = (bf16*)(p.ws + WS_K);
    float* rq = (float*)(p.ws + WS_RQ); float* rkv = (float*)(p.ws + WS_RKV); const float* rope = (const float*)(p.ws + WS_ROPE);
    const float* cw = IN(16) + (size_t)l * 3 * 768; const float* cb = IN(17) + l * 768;
    for (int row = blockIdx.x * NWAVES + wid; row < T; row += gridDim.x * NWAVES) {
        const bool lat = row < NLAT; const int pos = lat ? (row & (SEQ - 1)) : ((row - NLAT) & (CL - 1)); const int L = lat ? SEQ : CL;
        const bf16* pr = proj + (size_t)row * INWP;
        { const u32x2 a = *(const u32x2*)(pr + lane * 4); const unsigned b = *(const unsigned*)(pr + C_CKV + lane * 2);
          const float q0 = bf2f(a.x & 0xffff), q1 = bf2f(a.x >> 16), q2 = bf2f(a.y & 0xffff), q3 = bf2f(a.y >> 16), k0 = bf2f(b & 0xffff), k1 = bf2f(b >> 16);
          const float sq = wave_sum(q0 * q0 + q1 * q1 + q2 * q2 + q3 * q3), sk = wave_sum(k0 * k0 + k1 * k1);
          if (lane == 0) { rq[row] = 1.0f / sqrtf(sq * (1.f / 256.f) + EPS); rkv[row] = 1.0f / sqrtf(sk * (1.f / 128.f) + EPS); } }
        if (lane < 16) { const unsigned a = *(const unsigned*)(pr + C_KPE + lane * 2); float x0 = bf2f(a & 0xffff), x1 = bf2f(a >> 16);
            if (lat) { const int gr = pos >> 6, gc = pos & 63; const float* tb = (lane < 8) ? rope + (gr * 8 + lane) * 2 : rope + 2048 + (gc * 8 + (lane - 8)) * 2;
                const float c = tb[0], s = tb[1], y0 = x0 * c - x1 * s, y1 = x1 * c + x0 * s; x0 = y0; x1 = y1; }
            const unsigned o = pk2(x0, x1);
#pragma unroll
            for (int h = 0; h < 4; ++h) *(unsigned*)(Kb + (size_t)row * 384 + h * 96 + 64 + lane * 2) = o; }
#pragma unroll
        for (int j = 0; j < 3; ++j) { const int c0 = (j * 64 + lane) * 4;
            const u32x2 xm = (pos > 0) ? *(const u32x2*)(pr - INWP + C_XBC + c0) : (u32x2){0u, 0u}; const u32x2 x0 = *(const u32x2*)(pr + C_XBC + c0);
            const u32x2 xp = (pos < L - 1) ? *(const u32x2*)(pr + INWP + C_XBC + c0) : (u32x2){0u, 0u};
            const f32x4 w0 = *(const f32x4*)(cw + c0), w1 = *(const f32x4*)(cw + 768 + c0), w2 = *(const f32x4*)(cw + 1536 + c0), bb = *(const f32x4*)(cb + c0);
            f32x4 am = {bf2f(xm.x & 0xffff), bf2f(xm.x >> 16), bf2f(xm.y & 0xffff), bf2f(xm.y >> 16)}, a0 = {bf2f(x0.x & 0xffff), bf2f(x0.x >> 16), bf2f(x0.y & 0xffff), bf2f(x0.y >> 16)},
                  ap = {bf2f(xp.x & 0xffff), bf2f(xp.x >> 16), bf2f(xp.y & 0xffff), bf2f(xp.y >> 16)};
            f32x4 y = w0 * am + w1 * a0 + w2 * ap + bb;
#pragma unroll
            for (int i = 0; i < 4; ++i) y[i] = siluf(y[i]);
            st_bf16x4(xbc + (size_t)row * 768 + c0, y); }
    }
}

constexpr int AT_KLD = 104, AT_VLD = 68, AT_VOFF = 64 * AT_KLD * 2, AT_BUF = AT_VOFF + 64 * AT_VLD * 2;
DEVI void attn_unit(const P& p, int uidx, unsigned char* lds) {
    const int tid = otid(), wid = __builtin_amdgcn_readfirstlane(tid >> 6), lane = tid & 63, r32 = lane & 31, hi = lane >> 5;
    const bf16* Q = (const bf16*)(p.ws + WS_Q); const bf16* K = (const bf16*)(p.ws + WS_K); const bf16* V = (const bf16*)(p.ws + WS_V); bf16* MIX = (bf16*)(p.ws + WS_HM);
    int b, h, qrow0, NT;
    if (uidx < 256) { b = uidx >> 7; h = (uidx >> 5) & 3; qrow0 = b * SEQ + (uidx & 31) * 256; NT = 4 + SEQ / 64; }
    else { const int j = uidx - 256; b = j >> 2; h = j & 3; qrow0 = NLAT + b * CL; NT = 4; }
    const int qrow = qrow0 + wid * 32 + r32;
    bf16x8 qf[6];
#pragma unroll
    for (int s = 0; s < 6; ++s) qf[s] = *(const bf16x8*)(Q + (size_t)qrow * 384 + h * 96 + s * 16 + hi * 8);
    const int kp0 = tid, kp1 = 512 + tid; const int kk0 = kp0 / 12, kq0 = kp0 % 12, kk1 = kp1 / 12, kq1 = kp1 % 12;
    const bf16* Kh = K + h * 96; const bf16* Vh = V + h * 64 + wid * 8;
    const int ctx0 = NLAT + b * CL, lat0 = b * SEQ;
    u32x4 kr0, kr1 = {0u, 0u, 0u, 0u}, vr;
#define AT_LOAD(t) do { const int kr_ = ((t) < 4) ? ctx0 + (t) * 64 : lat0 + ((t) - 4) * 64; \
        kr0 = *(const u32x4*)(Kh + (size_t)(kr_ + kk0) * 384 + kq0 * 8); if (tid < 256) kr1 = *(const u32x4*)(Kh + (size_t)(kr_ + kk1) * 384 + kq1 * 8); \
        vr = *(const u32x4*)(Vh + (size_t)(kr_ + lane) * 256); } while (0)
#define AT_STORE(bufp) do { bf16* Kl_ = (bf16*)(bufp); bf16* Vl_ = (bf16*)((bufp) + AT_VOFF); \
        *(u32x4*)(Kl_ + kk0 * AT_KLD + kq0 * 8) = kr0; if (tid < 256) *(u32x4*)(Kl_ + kk1 * AT_KLD + kq1 * 8) = kr1; \
        bf16* vd_ = Vl_ + (wid * 8) * AT_VLD + lane; \
        vd_[0] = (bf16)(vr.x & 0xffff); vd_[AT_VLD] = (bf16)(vr.x >> 16); vd_[2 * AT_VLD] = (bf16)(vr.y & 0xffff); vd_[3 * AT_VLD] = (bf16)(vr.y >> 16); \
        vd_[4 * AT_VLD] = (bf16)(vr.z & 0xffff); vd_[5 * AT_VLD] = (bf16)(vr.z >> 16); vd_[6 * AT_VLD] = (bf16)(vr.w & 0xffff); vd_[7 * AT_VLD] = (bf16)(vr.w >> 16); } while (0)
    f32x16 o0, o1, negm;
#pragma unroll
    for (int r = 0; r < 16; ++r) { o0[r] = 0.f; o1[r] = 0.f; negm[r] = 0.f; }
    float mhat = 0.f, lsum = 0.f;
    __syncthreads();
    AT_LOAD(0); AT_STORE(lds);
    __syncthreads();
    for (int t = 0; t < NT; ++t) {
        unsigned char* buf = lds + (t & 1) * AT_BUF;
        if (t + 1 < NT) AT_LOAD(t + 1);
        const bf16* Kl = (const bf16*)buf; const bf16* Vl = (const bf16*)(buf + AT_VOFF);
        f32x16 st0, st1;
#pragma unroll
        for (int s = 0; s < 6; ++s) { const bf16x8 k0 = *(const bf16x8*)(Kl + r32 * AT_KLD + s * 16 + hi * 8), k1 = *(const bf16x8*)(Kl + (32 + r32) * AT_KLD + s * 16 + hi * 8);
            st0 = __builtin_amdgcn_mfma_f32_32x32x16_bf16(k0, qf[s], s == 0 ? negm : st0, 0, 0, 0); st1 = __builtin_amdgcn_mfma_f32_32x32x16_bf16(k1, qf[s], s == 0 ? negm : st1, 0, 0, 0); }
        float mx = fmaxf(st0[0], st1[0]);
#pragma unroll
        for (int r = 1; r < 16; ++r) mx = fmaxf(mx, fmaxf(st0[r], st1[r]));
        mx = fmaxf(mx, __shfl_xor(mx, 32));
        if (t == 0 || __any(mx > 8.0f)) {
            const float dl = (t == 0) ? mx : fmaxf(mx, 0.f); mhat += dl;
#pragma unroll
            for (int r = 0; r < 16; ++r) { st0[r] -= dl; st1[r] -= dl; negm[r] = -mhat; }
            if (t != 0) { const float f = __builtin_amdgcn_exp2f(-dl); lsum *= f;
#pragma unroll
                for (int r = 0; r < 16; ++r) { o0[r] *= f; o1[r] *= f; } }
        }
        float rs = 0.f;
#pragma unroll
        for (int r = 0; r < 16; ++r) { st0[r] = __builtin_amdgcn_exp2f(st0[r]); st1[r] = __builtin_amdgcn_exp2f(st1[r]); rs += st0[r] + st1[r]; }
        lsum += rs;
#pragma unroll
        for (int kt2 = 0; kt2 < 2; ++kt2)
#pragma unroll
            for (int s2 = 0; s2 < 2; ++s2) {
                const f32x16& st = kt2 ? st1 : st0;
                u32x4 pw; pw.x = pk2(st[8 * s2 + 0], st[8 * s2 + 1]); pw.y = pk2(st[8 * s2 + 2], st[8 * s2 + 3]); pw.z = pk2(st[8 * s2 + 4], st[8 * s2 + 5]); pw.w = pk2(st[8 * s2 + 6], st[8 * s2 + 7]);
                const bf16x8 pb = __builtin_bit_cast(bf16x8, pw);
#pragma unroll
                for (int dh = 0; dh < 2; ++dh) { const bf16* vp = Vl + (dh * 32 + r32) * AT_VLD + kt2 * 32 + 16 * s2 + 4 * hi;
                    const u32x2 lo = *(const u32x2*)vp, hi2 = *(const u32x2*)(vp + 8); u32x4 vw; vw.x = lo.x; vw.y = lo.y; vw.z = hi2.x; vw.w = hi2.y;
                    const bf16x8 va = __builtin_bit_cast(bf16x8, vw);
                    if (dh == 0) o0 = __builtin_amdgcn_mfma_f32_32x32x16_bf16(va, pb, o0, 0, 0, 0); else o1 = __builtin_amdgcn_mfma_f32_32x32x16_bf16(va, pb, o1, 0, 0, 0); }
            }
        if (t + 1 < NT) AT_STORE(lds + ((t + 1) & 1) * AT_BUF);
        __syncthreads();
    }
#undef AT_LOAD
#undef AT_STORE
    lsum += __shfl_xor(lsum, 32);
    const float inv = 1.f / lsum;
    bf16* orow = MIX + (size_t)qrow * D + h * 64;
#pragma unroll
    for (int g = 0; g < 4; ++g) {
        st_bf16x4(orow + 8 * g + 4 * hi, (f32x4){o0[4 * g] * inv, o0[4 * g + 1] * inv, o0[4 * g + 2] * inv, o0[4 * g + 3] * inv});
        st_bf16x4(orow + 32 + 8 * g + 4 * hi, (f32x4){o1[4 * g] * inv, o1[4 * g + 1] * inv, o1[4 * g + 2] * inv, o1[4 * g + 3] * inv});
    }
}

constexpr int NCC = 66;
DEVI int chunk_row0(int b, int cc) { return cc < 2 ? NLAT + b * CL + cc * 128 : b * SEQ + (cc - 2) * 128; }
constexpr int SC_VEC = 0;
constexpr int SC_KT = 2048;
constexpr int SC_VF = SC_KT + 64 * 136 * 2;
constexpr int SC_VB = SC_VF + 64 * 136 * 2;
constexpr int SC_X = SC_VB + 64 * 136 * 2;
constexpr int SC_SSQ = SC_X + 2048;
constexpr int SC_END = SC_SSQ + 8192;
constexpr int TS = 136;

DEVI void scan_vectors(const P& p, int l, bool ret, int h, int row0, float* vec, int wid, int lane) {
    const float* dt = (const float*)(p.ws + WS_DT);
    if (ret) {
        if (wid == 0) { const float lf = IN(15)[l * 8 + h], lb = IN(15)[l * 8 + 4 + h];
            const float laf = -log1pf(__expf(-lf)), lab = -log1pf(__expf(-lb));
#pragma unroll
            for (int e = 0; e < 2; ++e) { const int j = lane * 2 + e; vec[j] = (float)(j + 1) * laf; vec[128 + j] = (float)(128 - j) * lab; vec[256 + j] = 1.f; vec[384 + j] = 1.f; } }
    } else if (wid < 2) {
        const int dir = wid; const size_t r = (size_t)(row0 + lane * 2);
        const float x0 = dt[r * 32 + 16 + dir * 8 + h], x1 = dt[(r + 1) * 32 + 16 + dir * 8 + h];
        vec[256 + dir * 128 + lane * 2] = dt[r * 32 + dir * 8 + h]; vec[256 + dir * 128 + lane * 2 + 1] = dt[(r + 1) * 32 + dir * 8 + h];
        float s = x0 + x1;
#pragma unroll
        for (int o = 1; o < 64; o <<= 1) { const float t = __shfl_up(s, o); if (lane >= o) s += t; }
        if (dir == 0) { vec[lane * 2] = s - x1; vec[lane * 2 + 1] = s; }
        else { const float tot = __shfl(s, 63); vec[128 + lane * 2] = tot - (s - x1) + x0; vec[128 + lane * 2 + 1] = tot - s + x1; }
    }
}
DEVI void scan_ptrs(const P& p, bool ret, int h, const bf16*& qb, const bf16*& kb, const bf16*& vb, int& ld) {
    if (ret) { const bf16* proj = (const bf16*)(p.ws + WS_PROJ); qb = proj + C_RQ + h * 64; kb = proj + C_RK + h * 64; vb = proj + C_RV + h * 64; ld = INWP; }
    else { const bf16* xbc = (const bf16*)(p.ws + WS_XBC); qb = xbc + 640 + (h >> 2) * 64; kb = xbc + 512 + (h >> 2) * 64; vb = xbc + h * 64; ld = 768; }
}
template <bool SCALED>
DEVI void stage_T(const bf16* src, int ld, int row0, bf16* d0, bf16* d1, const float* vec, int tid) {
#pragma unroll
    for (int i = 0; i < 2; ++i) { const int piece = tid + NTHREADS * i, j = piece >> 3, n0 = (piece & 7) * 8;
        const u32x4 v = *(const u32x4*)(src + (size_t)(row0 + j) * ld + n0);
        const unsigned w[4] = {v.x, v.y, v.z, v.w};
        if (!SCALED) {
#pragma unroll
            for (int e = 0; e < 4; ++e) { d0[(n0 + 2 * e) * TS + j] = (bf16)(w[e] & 0xffff); d0[(n0 + 2 * e + 1) * TS + j] = (bf16)(w[e] >> 16); }
        } else {
            const float sf = __expf(vec[127] - vec[j]) * vec[256 + j], sb = __expf(vec[128] - vec[128 + j]) * vec[384 + j];
#pragma unroll
            for (int e = 0; e < 4; ++e) { const float a = bf2f(w[e] & 0xffff), b = bf2f(w[e] >> 16);
                d0[(n0 + 2 * e) * TS + j] = f2bf(a * sf); d0[(n0 + 2 * e + 1) * TS + j] = f2bf(b * sf); d1[(n0 + 2 * e) * TS + j] = f2bf(a * sb); d1[(n0 + 2 * e + 1) * TS + j] = f2bf(b * sb); }
        } }
}
DEVI void scanA_unit(const P& p, int l, int uidx, unsigned char* lds) {
    const int tid = otid(), wid = __builtin_amdgcn_readfirstlane(tid >> 6), lane = tid & 63, r32 = lane & 31, hi = lane >> 5;
    const int g4 = uidx % 3, bc = uidx / 3, b = bc / NCC, cc = bc % NCC, row0 = chunk_row0(b, cc);
    const bool ret = (g4 == 0);
    float* vec = (float*)(lds + SC_VEC); bf16* Kt = (bf16*)(lds + SC_KT); bf16* Vf = (bf16*)(lds + SC_VF); bf16* Vb = (bf16*)(lds + SC_VB);
    float* ST = (float*)(p.ws + WS_ST); float* CDp = (float*)(p.ws + WS_CD);
    for (int hq = 0; hq < 4; ++hq) {
        const int h = ret ? hq : (g4 - 1) * 4 + hq, hh = ret ? hq : 4 + h; const size_t item = (size_t)(b * NCC + cc) * 12 + hh;
        const bf16 *qb, *kb, *vb; int ld; scan_ptrs(p, ret, h, qb, kb, vb, ld);
        __syncthreads();
        scan_vectors(p, l, ret, h, row0, vec, wid, lane);
        __syncthreads();
        if (ret || hq == 0) stage_T<false>(kb, ld, row0, Kt, nullptr, vec, tid);
        stage_T<true>(vb, ld, row0, Vf, Vb, vec, tid);
        if (tid == 0) { CDp[item * 2] = __expf(vec[127]); CDp[item * 2 + 1] = __expf(vec[128]); }
        __syncthreads();
        const int dir = wid >> 2, nt = (wid >> 1) & 1, pt = wid & 1; const bf16* Vd = dir ? Vb : Vf;
        f32x16 acc;
#pragma unroll
        for (int r = 0; r < 16; ++r) acc[r] = 0.f;
#pragma unroll
        for (int s = 0; s < 8; ++s) { const bf16x8 a = *(const bf16x8*)(Kt + (nt * 32 + r32) * TS + s * 16 + hi * 8), bb = *(const bf16x8*)(Vd + (pt * 32 + r32) * TS + s * 16 + hi * 8);
            acc = __builtin_amdgcn_mfma_f32_32x32x16_bf16(a, bb, acc, 0, 0, 0); }
        float* o = ST + (item * 2 + dir) * 4096 + (size_t)(pt * 32 + r32) * 64 + nt * 32 + 4 * hi;
#pragma unroll
        for (int g = 0; g < 4; ++g) *(f32x4*)(o + 8 * g) = (f32x4){acc[4 * g], acc[4 * g + 1], acc[4 * g + 2], acc[4 * g + 3]};
    }
    __syncthreads();
}
DEVI void scanB_unit(const P& p, int uidx) {
    const int tid = otid(); const int bhd = uidx >> 2, dir = bhd & 1, bh = bhd >> 1, b = bh / 12, hh = bh % 12; const int e = (uidx & 3) * 1024 + tid * 2;
    const float* ST = (const float*)(p.ws + WS_ST); const float* CDp = (const float*)(p.ws + WS_CD); bf16* HT = (bf16*)(p.ws + WS_HT);
    f32x2 H = {0.f, 0.f};
    for (int base = 0; base < NCC; base += 6) {
        f32x2 s[6]; float d[6]; size_t off[6];
#pragma unroll
        for (int i = 0; i < 6; ++i) { const int step = base + i; const int cc = dir == 0 ? step : (step < 2 ? 1 - step : 67 - step);
            const size_t item = (size_t)(b * NCC + cc) * 12 + hh; off[i] = (item * 2 + dir) * 4096 + e; s[i] = *(const f32x2*)(ST + off[i]); d[i] = CDp[item * 2 + dir]; }
#pragma unroll
        for (int i = 0; i < 6; ++i) { *(unsigned*)(HT + off[i]) = pk2(H[0], H[1]); H = H * d[i] + s[i]; }
    }
}
DEVI void scanC_unit(const P& p, int l, int uidx, unsigned char* lds) {
    const int tid = otid(), wid = __builtin_amdgcn_readfirstlane(tid >> 6), lane = tid & 63, r32 = lane & 31, hi = lane >> 5;
    const int kind = uidx & 1, bc = uidx >> 1, b = bc / NCC, cc = bc % NCC, row0 = chunk_row0(b, cc);
    const bool ret = (kind == 0); const int nh = ret ? 4 : 8;
    float* vec = (float*)(lds + SC_VEC); bf16* Vt = (bf16*)(lds + SC_KT); float* X = (float*)(lds + SC_X); float* SSQ = (float*)(lds + SC_SSQ);
    const bf16* HT = (const bf16*)(p.ws + WS_HT); const bf16* proj = (const bf16*)(p.ws + WS_PROJ); const bf16* xbc = (const bf16*)(p.ws + WS_XBC); bf16* MIX = (bf16*)(p.ws + WS_HM);
    const int it_ = wid >> 1, pt = wid & 1, i = it_ * 32 + r32; const size_t rowi = (size_t)(row0 + i);
    for (int h = 0; h < nh; ++h) {
        const int hh = ret ? h : 4 + h; const size_t item = (size_t)(b * NCC + cc) * 12 + hh;
        const bf16 *qb, *kb, *vb; int ld; scan_ptrs(p, ret, h, qb, kb, vb, ld);
        __syncthreads();
        scan_vectors(p, l, ret, h, row0, vec, wid, lane);
        stage_T<false>(vb, ld, row0, Vt, nullptr, vec, tid);
        __syncthreads();
        bf16x8 qf[4];
#pragma unroll
        for (int s = 0; s < 4; ++s) qf[s] = *(const bf16x8*)(qb + rowi * ld + s * 16 + hi * 8);
        const float Afi = vec[i], Bbi = vec[128 + i];
        f32x16 y;
#pragma unroll
        for (int r = 0; r < 16; ++r) y[r] = 0.f;
#pragma unroll
        for (int jt = 0; jt < 4; ++jt) {
            f32x16 st;
#pragma unroll
            for (int r = 0; r < 16; ++r) st[r] = 0.f;
#pragma unroll
            for (int s = 0; s < 4; ++s) { const bf16x8 kf = *(const bf16x8*)(kb + (size_t)(row0 + jt * 32 + r32) * ld + s * 16 + hi * 8); st = __builtin_amdgcn_mfma_f32_32x32x16_bf16(kf, qf[s], st, 0, 0, 0); }
#pragma unroll
            for (int g = 0; g < 4; ++g) { const int j0 = jt * 32 + 8 * g + 4 * hi;
                const f32x4 afj = *(const f32x4*)(vec + j0), bbj = *(const f32x4*)(vec + 128 + j0), wfj = *(const f32x4*)(vec + 256 + j0), wbj = *(const f32x4*)(vec + 384 + j0);
#pragma unroll
                for (int e = 0; e < 4; ++e) { const int j = j0 + e; float f;
                    if (jt < it_) f = __expf(Afi - afj[e]) * wfj[e];
                    else if (jt > it_) f = __expf(Bbi - bbj[e]) * wbj[e];
                    else { const float ff = (j <= i) ? __expf(Afi - afj[e]) * wfj[e] : 0.f; const bool bm = ret ? (j > i) : (j >= i); const float fb = bm ? __expf(Bbi - bbj[e]) * wbj[e] : 0.f; f = ff + fb; }
                    st[4 * g + e] *= f; } }
#pragma unroll
            for (int s2 = 0; s2 < 2; ++s2) {
                u32x4 pw; pw.x = pk2(st[8 * s2 + 0], st[8 * s2 + 1]); pw.y = pk2(st[8 * s2 + 2], st[8 * s2 + 3]); pw.z = pk2(st[8 * s2 + 4], st[8 * s2 + 5]); pw.w = pk2(st[8 * s2 + 6], st[8 * s2 + 7]);
                const bf16* vp = Vt + (pt * 32 + r32) * TS + jt * 32 + 16 * s2 + 4 * hi;
                const u32x2 lo = *(const u32x2*)vp, hi2 = *(const u32x2*)(vp + 8); u32x4 vw; vw.x = lo.x; vw.y = lo.y; vw.z = hi2.x; vw.w = hi2.y;
                y = __builtin_amdgcn_mfma_f32_32x32x16_bf16(__builtin_bit_cast(bf16x8, vw), __builtin_bit_cast(bf16x8, pw), y, 0, 0, 0);
            }
        }
        { f32x16 tf, tb;
#pragma unroll
          for (int r = 0; r < 16; ++r) { tf[r] = 0.f; tb[r] = 0.f; }
          const bf16* hf = HT + (item * 2) * 4096 + (size_t)(pt * 32 + r32) * 64 + hi * 8;
#pragma unroll
          for (int s = 0; s < 4; ++s) { tf = __builtin_amdgcn_mfma_f32_32x32x16_bf16(*(const bf16x8*)(hf + s * 16), qf[s], tf, 0, 0, 0); tb = __builtin_amdgcn_mfma_f32_32x32x16_bf16(*(const bf16x8*)(hf + 4096 + s * 16), qf[s], tb, 0, 0, 0); }
          const float ef = __expf(Afi), eb = __expf(Bbi);
#pragma unroll
          for (int r = 0; r < 16; ++r) y[r] += ef * tf[r] + eb * tb[r]; }
        if (ret) {
            float s1 = 0.f, s2 = 0.f;
#pragma unroll
            for (int r = 0; r < 16; ++r) { y[r] *= 0.125f; s1 += y[r]; s2 += y[r] * y[r]; }
            s1 += __shfl_xor(s1, 32); s2 += __shfl_xor(s2, 32);
            if (hi == 0) { X[(pt * 128 + i) * 2] = s1; X[(pt * 128 + i) * 2 + 1] = s2; }
            __syncthreads();
            const float o1 = X[((pt ^ 1) * 128 + i) * 2], o2 = X[((pt ^ 1) * 128 + i) * 2 + 1];
            const float mu = (s1 + o1) * (1.f / 64.f), var = fmaxf((s2 + o2) * (1.f / 64.f) - mu * mu, 0.f), rs = 1.0f / sqrtf(var + EPS);
#pragma unroll
            for (int g = 0; g < 4; ++g) { const int p0 = pt * 32 + 8 * g + 4 * hi; const u32x2 gg = *(const u32x2*)(proj + rowi * INWP + C_RG + h * 64 + p0);
                const f32x4 gv = {bf2f(gg.x & 0xffff), bf2f(gg.x >> 16), bf2f(gg.y & 0xffff), bf2f(gg.y >> 16)}; f32x4 o;
#pragma unroll
                for (int e = 0; e < 4; ++e) o[e] = (y[4 * g + e] - mu) * rs * siluf(gv[e]);
                st_bf16x4(MIX + rowi * D + 256 + h * 64 + p0, o); }
        } else {
            const float dsk = IN(20)[l * 8 + h]; float s2 = 0.f;
#pragma unroll
            for (int g = 0; g < 4; ++g) { const int p0 = pt * 32 + 8 * g + 4 * hi; const u32x2 xx = *(const u32x2*)(xbc + rowi * 768 + h * 64 + p0), zz = *(const u32x2*)(proj + rowi * INWP + C_Z + h * 64 + p0);
                const f32x4 xv = {bf2f(xx.x & 0xffff), bf2f(xx.x >> 16), bf2f(xx.y & 0xffff), bf2f(xx.y >> 16)}, zv = {bf2f(zz.x & 0xffff), bf2f(zz.x >> 16), bf2f(zz.y & 0xffff), bf2f(zz.y >> 16)}; f32x4 o;
#pragma unroll
                for (int e = 0; e < 4; ++e) { o[e] = (y[4 * g + e] + xv[e] * dsk) * siluf(zv[e]); s2 += o[e] * o[e]; }
                st_bf16x4(MIX + rowi * D + 512 + h * 64 + p0, o); }
            s2 += __shfl_xor(s2, 32);
            if (hi == 0) SSQ[(h * 2 + pt) * 128 + i] = s2;
        }
    }
    if (!ret) {
        __syncthreads();
        const float* nw = IN(21) + l * 512; const int tok = tid >> 2, cq = tid & 3; float ss = 0.f;
#pragma unroll
        for (int k = 0; k < 16; ++k) ss += SSQ[k * 128 + tok];
        const float rstd = 1.0f / sqrtf(ss * (1.f / 512.f) + EPS);
        bf16* mp = MIX + (size_t)(row0 + tok) * D + 512 + cq * 128;
#pragma unroll 4
        for (int k = 0; k < 16; ++k) { const u32x4 v = *(const u32x4*)(mp + k * 8); const f32x4 w0 = *(const f32x4*)(nw + cq * 128 + k * 8), w1 = *(const f32x4*)(nw + cq * 128 + k * 8 + 4); u32x4 o;
            o.x = pk2(bf2f(v.x & 0xffff) * rstd * w0[0], bf2f(v.x >> 16) * rstd * w0[1]); o.y = pk2(bf2f(v.y & 0xffff) * rstd * w0[2], bf2f(v.y >> 16) * rstd * w0[3]);
            o.z = pk2(bf2f(v.z & 0xffff) * rstd * w1[0], bf2f(v.z >> 16) * rstd * w1[1]); o.w = pk2(bf2f(v.w & 0xffff) * rstd * w1[2], bf2f(v.w >> 16) * rstd * w1[3]);
            *(u32x4*)(mp + k * 8) = o; }
    }
    __syncthreads();
}
DEVI void ph_scanA(const P& p, int l, unsigned char* lds) { for (int u = blockIdx.x; u < 2 * NCC * 3; u += gridDim.x) scanA_unit(p, l, u, lds); }
DEVI void ph_mixer(const P& p, int l, unsigned char* lds) {
    const int nattn = (l == 0) ? 256 + 8 : 256; const int nunits = 192 + nattn;
    for (int u = blockIdx.x; u < nunits; u += gridDim.x) { if (u < 192) scanB_unit(p, u); else attn_unit(p, u - 192, lds); }
}
DEVI void ph_scanC(const P& p, int l, unsigned char* lds) { for (int u = blockIdx.x; u < 2 * NCC * 2; u += gridDim.x) scanC_unit(p, l, u, lds); }

DEVI void ph_sort(const P& p, unsigned char* lds) {
    const int tid = otid(), wid = tid >> 6, lane = tid & 63;
    const int* rt_e = (const int*)(p.ws + WS_RT); int* rt_pos = (int*)(p.ws + WS_RT + 256 * 1024); int* tab = (int*)(p.ws + WS_RT + 384 * 1024);
    const bf16* H = (const bf16*)(p.ws + WS_HM); bf16* HS = (bf16*)(p.ws + WS_HS);
    int* sh = (int*)lds;
    const int G = gridDim.x, R = (NLAT + G - 1) / G;
    for (int blk = blockIdx.x; blk * R < NLAT; blk += G) {
        const int r0 = blk * R, r1 = (r0 + R < NLAT) ? r0 + R : NLAT;
        int ct[8], cb[8];
#pragma unroll
        for (int e = 0; e < 8; ++e) { ct[e] = 0; cb[e] = 0; }
        for (int i = tid; i < NLAT * 2; i += NTHREADS) { const int e = rt_e[i]; const bool bef = (i >> 1) < r0;
#pragma unroll
            for (int x = 0; x < 8; ++x) { const int hit = (e == x) ? 1 : 0; ct[x] += hit; cb[x] += bef ? hit : 0; } }
#pragma unroll
        for (int e = 0; e < 8; ++e) {
#pragma unroll
            for (int o = 1; o < 64; o <<= 1) { ct[e] += __shfl_xor(ct[e], o); cb[e] += __shfl_xor(cb[e], o); }
        }
        __syncthreads();
        if (lane == 0) {
#pragma unroll
            for (int e = 0; e < 8; ++e) { sh[wid * 8 + e] = ct[e]; sh[64 + wid * 8 + e] = cb[e]; } }
        __syncthreads();
        if (tid == 0) { int start = 0, nt = 0;
            for (int e = 0; e < 8; ++e) { int tot = 0, bef = 0; for (int w = 0; w < 8; ++w) { tot += sh[w * 8 + e]; bef += sh[64 + w * 8 + e]; }
                sh[128 + e] = start; sh[136 + e] = start + bef; const int ntile = (tot + 255) >> 8;
                if (blk == 0) { for (int t = 0; t < ntile; ++t) tab[1 + nt + t] = e; }
                nt += ntile; start += ntile * 256; }
            if (blk == 0) tab[0] = nt; }
        __syncthreads();
        if (tid < 8) { int run = sh[136 + tid]; for (int i = r0 * 2; i < r1 * 2; ++i) if (rt_e[i] == tid) { sh[256 + i - r0 * 2] = run; rt_pos[i] = run; ++run; } }
        __syncthreads();
        for (int i = wid; i < (r1 - r0) * 2; i += NWAVES) { const int row = r0 + (i >> 1), pos = sh[256 + i];
            const u32x4* s = (const u32x4*)(H + (size_t)row * D); u32x4* d = (u32x4*)(HS + (size_t)pos * D); d[lane] = s[lane]; d[lane + 64] = s[lane + 64]; }
        __syncthreads();
    }
}
DEVI void ph_final(const P& p) {
    const int tid = otid(), wid = tid >> 6, lane = tid & 63;
    const float* rt_g = (const float*)(p.ws + WS_RT + 128 * 1024); const int* rt_pos = (const int*)(p.ws + WS_RT + 256 * 1024);
    const bf16* YS = (const bf16*)(p.ws + WS_HS); const float* modv = (const float*)(p.ws + WS_MODV) + (size_t)1 * 3 * 6144; const float* fw = IN(29);
    for (int row = blockIdx.x * NWAVES + wid; row < NLAT; row += gridDim.x * NWAVES) {
        const int b = row >> 13; const float* gp = modv + b * 6144 + 5 * 1024; float* x = p.out + (size_t)row * D;
        const float g0 = rt_g[row * 2], g1 = rt_g[row * 2 + 1]; const bf16* y0 = YS + (size_t)rt_pos[row * 2] * D; const bf16* y1 = YS + (size_t)rt_pos[row * 2 + 1] * D;
        f32x4 v[4]; float ss = 0.f;
#pragma unroll
        for (int j = 0; j < 4; ++j) { const int c0 = (j * 64 + lane) * 4; const f32x4 xv = *(const f32x4*)(x + c0), gv = *(const f32x4*)(gp + c0); const u32x2 a = *(const u32x2*)(y0 + c0), c = *(const u32x2*)(y1 + c0);
            const f32x4 ya = {bf2f(a.x & 0xffff), bf2f(a.x >> 16), bf2f(a.y & 0xffff), bf2f(a.y >> 16)}, yb = {bf2f(c.x & 0xffff), bf2f(c.x >> 16), bf2f(c.y & 0xffff), bf2f(c.y >> 16)};
            v[j] = xv + gv * (ya * g0 + yb * g1); ss += v[j][0] * v[j][0] + v[j][1] * v[j][1] + v[j][2] * v[j][2] + v[j][3] * v[j][3]; }
        ss = wave_sum(ss); const float rstd = 1.0f / sqrtf(ss * (1.f / D) + EPS);
#pragma unroll
        for (int j = 0; j < 4; ++j) { const int c0 = (j * 64 + lane) * 4; const f32x4 wv = *(const f32x4*)(fw + c0); *(f32x4*)(x + c0) = v[j] * rstd * wv; }
    }
}

#define XB_TMO      128
#define XB_XCNT(j)  (256  + 64 * (j))
#define XB_XSUB(j)  (1280 + 64 * (j))
#define XB_XGEN(j)  (2304 + 64 * (j))
#define XB_TOP      3328
#define XB_TOPGEN   3392
#define XCD_BAR_WORDS 3456
#define XB_SPIN_CAP (1u << 22)
DEVI unsigned xb_ld(unsigned* p)              { return __hip_atomic_load(p, __ATOMIC_RELAXED, __HIP_MEMORY_SCOPE_AGENT); }
DEVI unsigned xb_add(unsigned* p, unsigned v) { return __hip_atomic_fetch_add(p, v, __ATOMIC_RELAXED, __HIP_MEMORY_SCOPE_AGENT); }
DEVI unsigned xb_xcc_id() { return (unsigned)__builtin_amdgcn_s_getreg((3 << 11) | 20) & 0xFu; }
#define XB_SPIN(cond, bar) do { unsigned _sp = 0; while (cond) { __builtin_amdgcn_s_sleep(1); \
    if ((++_sp & 255u) == 0u) { if (xb_ld(&(bar)[XB_TMO])) break; if (_sp > XB_SPIN_CAP) { atomicAdd(&(bar)[XB_TMO], 1u); break; } } } } while (0)
struct XcdBarrier { unsigned* bar; unsigned x; volatile LAS unsigned* st; };
DEVI XcdBarrier xcd_barrier_post(unsigned* bar, volatile LAS unsigned* st) {
    XcdBarrier b; b.bar = bar; b.x = xb_xcc_id(); b.st = st;
    if (threadIdx.x == 0) (void)xb_add(&bar[XB_XCNT(b.x)], 1u);
    return b;
}
DEVI void xcd_barrier_complete(unsigned* bar, unsigned x, unsigned& nloc, unsigned& nx) {
    const unsigned G = gridDim.x * gridDim.y * gridDim.z;
    unsigned sum, cnt, mine, sp = 0u;
    for (;;) {
        sum = 0u; cnt = 0u; mine = 0u;
#pragma unroll
        for (unsigned j = 0; j < 16; ++j) { const unsigned c = xb_ld(&bar[XB_XCNT(j)]); sum += c; cnt += (c > 0u) ? 1u : 0u; mine = (j == x) ? c : mine; }
        if (sum == G) break;
        __builtin_amdgcn_s_sleep(1);
        if ((++sp & 255u) == 0u) { if (xb_ld(&bar[XB_TMO])) break; if (sp > XB_SPIN_CAP) { atomicAdd(&bar[XB_TMO], 1u); break; } }
    }
    nloc = mine > 0u ? mine : 1u; nx = cnt > 0u ? cnt : 1u;
}
DEVI void xcd_barrier(const XcdBarrier& b) {
    asm volatile("s_waitcnt vmcnt(0)" ::: "memory");
    __syncthreads();
    if (threadIdx.x == 0) {
        unsigned* bar = b.bar;
        __builtin_amdgcn_s_waitcnt(0);
        unsigned nloc = b.st[0], nx = b.st[1];
        if (nloc == 0u) { xcd_barrier_complete(bar, b.x, nloc, nx); b.st[0] = nloc; b.st[1] = nx; }
        const unsigned old = xb_add(&bar[XB_XSUB(b.x)], 1u);
        const unsigned gen = old / nloc;
        if (old + 1u == (gen + 1u) * nloc) {
            __builtin_amdgcn_fence(__ATOMIC_RELEASE, "agent");
            asm volatile("s_waitcnt vmcnt(0)" ::: "memory");
            const unsigned og = xb_add(&bar[XB_TOP], 1u);
            const unsigned tg = og / nx;
            if (og + 1u == (tg + 1u) * nx) xb_add(&bar[XB_TOPGEN], 1u);
            else XB_SPIN(xb_ld(&bar[XB_TOPGEN]) == tg, bar);
            __builtin_amdgcn_fence(__ATOMIC_ACQUIRE, "agent");
            xb_add(&bar[XB_XGEN(b.x)], 1u);
            asm volatile("s_waitcnt vmcnt(0)" ::: "memory");
        } else {
            XB_SPIN(xb_ld(&bar[XB_XGEN(b.x)]) == gen, bar);
            __builtin_amdgcn_fence(__ATOMIC_ACQUIRE, "agent");
            asm volatile("s_waitcnt vmcnt(0)" ::: "memory");
        }
    }
    __syncthreads();
}

constexpr int NPHASES = 24;
#ifndef XSYNC
#define XSYNC 0
#endif
#ifndef REP_MASK
#define REP_MASK 0u
#endif
#ifndef PH_MASK
#define PH_MASK 0xffffu
#endif
__global__ void __launch_bounds__(NTHREADS, 2) mk_fwd(P p) {
    extern __shared__ __attribute__((aligned(16))) unsigned char lds[];
    cg::grid_group grid = cg::this_grid();
    const int G = gridDim.x, c = blockIdx.x;
    if (threadIdx.x < 30) ((lds_u64*)(uintptr_t)LDS_PTRS)[threadIdx.x] = (unsigned long long)p.in[threadIdx.x];
    if (threadIdx.x < 2) ((volatile LAS unsigned*)(uintptr_t)LDS_MISC)[threadIdx.x] = 0u;
    __syncthreads();
    XcdBarrier xbar = xcd_barrier_post((unsigned*)(p.ws + WS_CTL) + 1024, (volatile LAS unsigned*)(uintptr_t)LDS_MISC);
    int nsync = 0;
#define GRID_BAR() do { if (nsync == 0) grid.sync(); else xcd_barrier(xbar); ++nsync; } while (0)
    int ph = 0;
#define RUN(kid, ...) do { if (((PH_MASK >> (kid)) & 1u) && ph >= p.ph_lo && ph < p.ph_hi) { __VA_ARGS__; if ((REP_MASK >> (kid)) & 1u) { __VA_ARGS__; } if (ph + 1 < p.ph_hi) { GRID_BAR(); for (int xs_ = 0; xs_ < XSYNC; ++xs_) GRID_BAR(); } } ++ph; } while (0)
    RUN(0, ph_pro(p, lds));
#define LAYER(l) \
        RUN(1, ph_norm(p, l, 0, T, false)); \
        RUN(2, { Gemm g{(const bf16*)(p.ws + WS_HM), (const bf16*)(p.ws + WS_WIN) + (size_t)l * INWP * 1024, 0}; DenseSched S{T / 256, INWP / 256, G, c}; \
            EpiInProj E{(bf16*)(p.ws + WS_PROJ), (float*)(p.ws + WS_DT), IN(18) + l * 16, IN(19) + l * 16}; gemm_phase<D, 1024, 1024>(lds, g, S, E); }); \
        RUN(3, ph_conv(p, l)); \
        RUN(4, { Gemm g{(const bf16*)(p.ws + WS_PROJ), (const bf16*)(p.ws + WS_WQKV) + (size_t)l * 1024 * 384, 0}; DenseSched S{T / 256, 4, G, c}; \
            EpiMla E{(bf16*)(p.ws + WS_Q), (bf16*)(p.ws + WS_K), (bf16*)(p.ws + WS_V), (const float*)(p.ws + WS_RQ), (const float*)(p.ws + WS_RKV), (const float*)(p.ws + WS_ROPE)}; gemm_phase<INWP, 384, 384>(lds, g, S, E); ph_scanA(p, l, lds); }); \
        RUN(5, ph_mixer(p, l, lds)); \
        RUN(6, ph_scanC(p, l, lds)); \
        if (l == 1) RUN(7, ph_moew(p)); \
        RUN(8, { Gemm g{(const bf16*)(p.ws + WS_HM), (const bf16*)(p.ws + WS_WOUT) + (size_t)l * 1024 * 1024, 0}; DenseSched S{(l == 0 ? T : NLAT) / 256, 4, G, c}; \
            EpiResid E{l == 0 ? IN(0) : p.out, l == 0 ? IN(2) : (const float*)(p.ws + WS_XC), p.out, (float*)(p.ws + WS_XC), (const float*)(p.ws + WS_MODV) + (size_t)l * 3 * 6144, 2}; gemm_phase<D, 1024, 1024>(lds, g, S, E); }); \
        RUN(9, ph_norm(p, l, 1, l == 0 ? T : NLAT, l == 1)); \
        if (l == 0) { \
            RUN(10, { Gemm g{(const bf16*)(p.ws + WS_HM), (const bf16*)(p.ws + WS_WGU), 0}; DenseSched S{T / 256, 2 * DFF / 256, G, c}; \
                EpiSwiglu E{(bf16*)(p.ws + WS_PROJ), DFF}; gemm_phase<D, 1024, 1024>(lds, g, S, E); }); \
            RUN(11, { Gemm g{(const bf16*)(p.ws + WS_PROJ), (const bf16*)(p.ws + WS_WD), 0}; DenseSched S{T / 256, 4, G, c}; \
                EpiResid E{p.out, (const float*)(p.ws + WS_XC), p.out, (float*)(p.ws + WS_XC), (const float*)(p.ws + WS_MODV), 5}; gemm_phase<DFF, DFF, DFF>(lds, g, S, E); }); \
        } else { \
            RUN(12, ph_sort(p, lds)); \
            RUN(13, { Gemm g{(const bf16*)(p.ws + WS_HS), (const bf16*)(p.ws + WS_WGUE), (size_t)2 * DFE * 1024}; MoeSched S{(const int*)(p.ws + WS_RT + 384 * 1024), 2 * DFE / 256, G, c}; \
                EpiSwiglu E{(bf16*)(p.ws + WS_ACTS), DFE}; gemm_phase<D, 1024, 1024>(lds, g, S, E); }); \
            RUN(14, { Gemm g{(const bf16*)(p.ws + WS_ACTS), (const bf16*)(p.ws + WS_WDE), (size_t)1024 * DFE}; MoeSched S{(const int*)(p.ws + WS_RT + 384 * 1024), 4, G, c}; \
                EpiStore E{(bf16*)(p.ws + WS_HS), D}; gemm_phase<DFE, DFE, DFE>(lds, g, S, E); }); \
            RUN(15, ph_final(p)); \
        }
    LAYER(0)
    LAYER(1)
#undef LAYER
#undef RUN
}

#ifndef MK_ONE_LAUNCH
#define MK_ONE_LAUNCH 1
#endif
extern "C" void kernel_launch(void* const* d_in, const int* in_sizes, int n_in, void* d_out, int out_size, void* d_ws, size_t ws_size, hipStream_t stream) {
    static int grid = 0;
    if (grid == 0) {
        if (n_in != 30 || out_size != NLAT * D || ws_size < WS_END) { fprintf(stderr, "kernel_launch: unexpected problem (n_in %d out %d ws %zu, need %zu)\n", n_in, out_size, ws_size, (size_t)WS_END); grid = -1; return; }
        int dev = 0, cus = 0, per_cu = 0;
        hipGetDevice(&dev); hipDeviceGetAttribute(&cus, hipDeviceAttributeMultiprocessorCount, dev);
        if (hipFuncSetAttribute((const void*)mk_fwd, hipFuncAttributeMaxDynamicSharedMemorySize, LDS_BYTES) != hipSuccess) { fprintf(stderr, "kernel_launch: hipFuncSetAttribute failed\n"); grid = -1; return; }
        if (hipOccupancyMaxActiveBlocksPerMultiprocessor(&per_cu, (const void*)mk_fwd, NTHREADS, LDS_BYTES) != hipSuccess || per_cu < 1) { fprintf(stderr, "kernel_launch: occupancy query failed (%d)\n", per_cu); grid = -1; return; }
        grid = cus;
        fprintf(stderr, "kernel_launch: grid %d (cus %d, per_cu %d)\n", grid, cus, per_cu);
    }
    if (grid < 0) return;
    if (hipMemsetAsync((char*)d_ws + WS_CTL, 0, 65536, stream) != hipSuccess) { fprintf(stderr, "kernel_launch: memset failed\n"); return; }
    P p{};
    for (int i = 0; i < 30; ++i) p.in[i] = (const float*)d_in[i];
    p.out = (float*)d_out; p.ws = (unsigned char*)d_ws;
#if MK_ONE_LAUNCH
    p.ph_lo = 0; p.ph_hi = NPHASES;
    { void* args[] = {&p}; hipError_t e = hipLaunchCooperativeKernel((const void*)mk_fwd, dim3(grid), dim3(NTHREADS), args, LDS_BYTES, stream);
      if (e != hipSuccess) fprintf(stderr, "cooperative launch failed: %s\n", hipGetErrorString(e)); }
#else
    for (int ph = 0; ph < NPHASES; ++ph) {
        p.ph_lo = ph; p.ph_hi = ph + 1;
        void* args[] = {&p}; hipError_t e = hipLaunchCooperativeKernel((const void*)mk_fwd, dim3(grid), dim3(NTHREADS), args, LDS_BYTES, stream);
        if (e != hipSuccess) { fprintf(stderr, "cooperative launch %d failed: %s\n", ph, hipGetErrorString(e)); break; }
    }
#endif
}
```

```cpp
#include <hip/hip_runtime.h>
#include <hip/hip_cooperative_groups.h>
#include <cstdio>
#include <cstdint>
namespace cg = cooperative_groups;

#define DEVI __device__ __forceinline__
typedef unsigned short bf16;
typedef short bf16x8 __attribute__((ext_vector_type(8)));
typedef float f32x4 __attribute__((ext_vector_type(4)));
typedef float f32x2 __attribute__((ext_vector_type(2)));
typedef float f32x16 __attribute__((ext_vector_type(16)));
typedef unsigned u32x4 __attribute__((ext_vector_type(4)));
typedef unsigned u32x2 __attribute__((ext_vector_type(2)));
typedef __bf16 bf16x2_t __attribute__((ext_vector_type(2)));

constexpr int D = 1024, NB = 2, SEQ = 8192, NLAT = NB * SEQ, CL = 256, NCTX = NB * CL, T = NLAT + NCTX;
constexpr int INW = 2736, INWP = 2816;
constexpr int C_CQ = 0, C_CKV = 256, C_KPE = 384, C_RQ = 416, C_RK = 672, C_RV = 928, C_RG = 1184, C_Z = 1440, C_XBC = 1952, C_DTF = 2720, C_DTB = 2728;
constexpr int DFF = 2816, DFE = 1408, NEXP = 8;
constexpr float EPS = 1e-6f;
constexpr int MOE_MAXROWS = 34816;

constexpr size_t MiB = 1u << 20;
constexpr size_t WS_CTL = 0;
constexpr size_t WS_MODV = 1 * MiB;
constexpr size_t WS_ROPE = WS_MODV + 256 * 1024;
constexpr size_t WS_RQ = WS_MODV + 512 * 1024;
constexpr size_t WS_RKV = WS_MODV + 640 * 1024;
constexpr size_t WS_WIN = 2 * MiB;
constexpr size_t WS_WQKV = 13 * MiB;
constexpr size_t WS_WOUT = 15 * MiB;
constexpr size_t WS_WGU = 19 * MiB;
constexpr size_t WS_WD = 30 * MiB;
constexpr size_t WS_XC = 36 * MiB;
constexpr size_t WS_RT = 38 * MiB;
constexpr size_t WS_DT = 39 * MiB;
constexpr size_t DYN = 42 * MiB;
constexpr size_t WS_HM = DYN;
constexpr size_t WS_PROJ = DYN + 33 * MiB;
constexpr size_t WS_XBC = DYN + 124 * MiB;
constexpr size_t WS_Q = DYN + 149 * MiB;
constexpr size_t WS_K = DYN + 161 * MiB + 512 * 1024;
constexpr size_t WS_V = DYN + 174 * MiB;
constexpr size_t WS_ST = DYN + 182 * MiB + 512 * 1024;
constexpr size_t WS_HT = WS_ST + (size_t)1584 * 2 * 4096 * 4;
constexpr size_t WS_CD = WS_RT + 512 * 1024;
constexpr size_t WS_VEC = WS_HT + (size_t)1584 * 2 * 4096 * 2;
constexpr size_t WS_WGUE = DYN + 33 * MiB;
constexpr size_t WS_WDE = DYN + 77 * MiB;
constexpr size_t WS_HS = DYN + 99 * MiB;
constexpr size_t WS_ACTS = DYN + 167 * MiB;
constexpr size_t WS_END = DYN + 261 * MiB;
static_assert(WS_HM + (size_t)T * 1024 * 2 <= WS_PROJ && WS_PROJ + (size_t)T * 2816 * 2 <= WS_XBC && WS_XBC + (size_t)T * 768 * 2 <= WS_Q &&
              WS_Q + (size_t)T * 384 * 2 <= WS_K && WS_K + (size_t)T * 384 * 2 <= WS_V && WS_V + (size_t)T * 256 * 2 <= WS_ST && WS_VEC + (size_t)1584 * 512 * 4 <= WS_END, "ws map (mixer)");
static_assert(WS_WGUE + (size_t)8 * 2816 * 1024 * 2 <= WS_WDE && WS_WDE + (size_t)8 * 1024 * 1408 * 2 <= WS_HS && WS_HS + (size_t)MOE_MAXROWS * 1024 * 2 <= WS_ACTS &&
              WS_ACTS + (size_t)MOE_MAXROWS * 1408 * 2 <= WS_END, "ws map (moe)");
static_assert(WS_DT + (size_t)T * 32 * 4 <= DYN && WS_WD + (size_t)1024 * 2816 * 2 <= WS_XC && WS_WIN + (size_t)2 * 2816 * 1024 * 2 <= WS_WQKV, "ws map (static)");

constexpr int NTHREADS = 512, NWAVES = 8;
constexpr int LDS_BYTES = 147456;

struct P { const float* in[30]; float* out; unsigned char* ws; int ph_lo, ph_hi; };
constexpr int LDS_MISC = 147456 - 512;
constexpr int LDS_PTRS = 147456 - 256;
typedef __attribute__((address_space(3))) unsigned long long lds_u64;
DEVI const float* inptr(int i) {
    const unsigned long long v = ((lds_u64*)(uintptr_t)LDS_PTRS)[i];
    const unsigned lo = __builtin_amdgcn_readfirstlane((unsigned)v), hi = __builtin_amdgcn_readfirstlane((unsigned)(v >> 32));
    return (const float*)(((unsigned long long)hi << 32) | lo);
}
#define IN(i) inptr(i)
DEVI int otid() { int t = threadIdx.x; asm volatile("" : "+v"(t)); return t; }

DEVI float bf2f(bf16 x) { return __uint_as_float(((unsigned)x) << 16); }
DEVI unsigned pk2(float lo, float hi) { f32x2 v = {lo, hi}; bf16x2_t b = __builtin_convertvector(v, bf16x2_t); return __builtin_bit_cast(unsigned, b); }
DEVI bf16 f2bf(float x) { return (bf16)(pk2(x, 0.f) & 0xffffu); }
DEVI float wave_sum(float v) {
#pragma unroll
    for (int o = 1; o < 64; o <<= 1) v += __shfl_xor(v, o);
    return v;
}
DEVI float siluf(float x) { return x / (1.f + __expf(-x)); }
DEVI float softplusf(float x) { return fmaxf(x, 0.f) + log1pf(__expf(-fabsf(x))); }
DEVI int rope_src(int p) { const int q = p & 15, s = (q & 1) ? 8 + (q >> 1) : (q >> 1); return (p & 16) + s; }

#define LAS __attribute__((address_space(3)))
struct Unit { int pm, pn, e, koff; };
struct Gemm { const bf16* A; const bf16* Bt; size_t bstride; };
constexpr int BM = 256, BK = 64, HALF = 128, HTB = HALF * BK * 2, STAGE_BYTES = 8 * HTB, NXCD = 8, WGM = 8;
__host__ __device__ __forceinline__ int lds_byte(int r, int c) { const int st = (r >> 4) * 2 + (c >> 5), rr = r & 15, cc = c & 31, ob = rr * 64 + cc * 2; return st * 1024 + (ob ^ (((ob >> 9) & 1) << 5)); }
__host__ __device__ __forceinline__ void stage_rc(int b, int& R, int& C) { const int st = b / 1024, sb = b % 1024, swz = sb ^ (((sb >> 9) & 1) << 5); R = (st >> 1) * 16 + swz / 64; C = (st & 1) * 32 + (swz % 64) / 2; }
struct DenseSched {
    int nM, nN, G, c;
    DEVI bool next(int i, Unit& u) const {
        const int nwg = nM * nN; const long L = (long)i * G + c; if (L >= nwg) return false;
        int wgid = (int)L; { const int q = nwg / NXCD, r = nwg % NXCD, xcd = wgid % NXCD, off = wgid / NXCD; wgid = (xcd < r ? xcd * (q + 1) : r * (q + 1) + (xcd - r) * q) + off; }
        const int nig = WGM * nN, gid = wgid / nig, fm = gid * WGM, gsz = (nM - fm) < WGM ? (nM - fm) : WGM;
        u.pm = fm + ((wgid % nig) % gsz); u.pn = (wgid % nig) / gsz; u.e = 0; u.koff = 0; return true;
    }
};
struct CtxSplitSched {
    int nsplit, kbytes, G, c;
    DEVI bool next(int i, Unit& u) const { const int id = i * G + c; if (id >= 8 * nsplit) return false; const int tile = id & 7, ks = id >> 3; u.pm = 64 + (tile >> 2); u.pn = tile & 3; u.e = ks; u.koff = ks * kbytes; return true; }
};
struct MoeSched {
    const int* tab; int nN, G, c;
    DEVI bool next(int i, Unit& u) const { DenseSched d{tab[0], nN, G, c}; if (!d.next(i, u)) return false; u.e = tab[1 + u.pm]; return true; }
};
template <int LDA, int LDB, int KK, class Epi, class Sched>
DEVI void gemm_phase(unsigned char* lds_generic, const Gemm g, const Sched& S, const Epi& E) {
    LAS unsigned char* lds = (LAS unsigned char*)lds_generic;
    const int tid = otid(), wid = __builtin_amdgcn_readfirstlane(tid >> 6), lane = tid & 63, wr = wid >> 2, wc = wid & 3, fr = lane & 15, fq = lane >> 4;
    constexpr int nt = KK / BK; static_assert(KK % 128 == 0, "K must be a multiple of 128");
    unsigned voffA[2], voffB[2];
#pragma unroll
    for (int i = 0; i < 2; ++i) { int R, C; stage_rc(tid * 16 + i * 8192, R, C); voffA[i] = (unsigned)(R * LDA + C) * 2u; voffB[i] = (unsigned)(R * LDB + C) * 2u; }
    constexpr size_t kstep = (size_t)(BK * 2), hstepA = (size_t)HALF * LDA * 2, hstepB = (size_t)HALF * LDB * 2, tstepA = 2 * hstepA, tstepB = 2 * hstepB;
    const unsigned ldsw = (unsigned)wid * 1024u;
    const int aoff = lds_byte(wr * 64 + fr, fq * 8), boff = lds_byte(wc * 32 + fr, fq * 8);
#define PG8_SA(b, h) (((b) * 2 + (h)) * HTB)
#define PG8_SB(b, h) ((4 + (b) * 2 + (h)) * HTB)
#define PG8_STAGE(bufoff, gbase, voff) do { _Pragma("unroll") for (int _i = 0; _i < 2; ++_i) \
        __builtin_amdgcn_global_load_lds((const unsigned*)((const char*)(gbase) + (voff)[_i]), (LAS unsigned*)(lds + (bufoff) + ldsw + _i * 8192), 16, 0, 0); } while (0)
#define PG8_LDA(dst, b, h) do { _Pragma("unroll") for (int m = 0; m < 4; ++m) _Pragma("unroll") for (int k = 0; k < 2; ++k) dst[m][k] = *(const LAS bf16x8*)(lds + PG8_SA(b, h) + aoff + m * 2048 + k * 1024); } while (0)
#define PG8_LDB(dst, b, h) do { _Pragma("unroll") for (int n = 0; n < 2; ++n) _Pragma("unroll") for (int k = 0; k < 2; ++k) dst[n][k] = *(const LAS bf16x8*)(lds + PG8_SB(b, h) + boff + n * 2048 + k * 1024); } while (0)
#define PG8_MMA(ai, bj, At, Bt) do { __builtin_amdgcn_s_setprio(1); _Pragma("unroll") for (int m = 0; m < 4; ++m) _Pragma("unroll") for (int n = 0; n < 2; ++n) _Pragma("unroll") for (int k = 0; k < 2; ++k) \
        acc[ai][bj][m][n] = __builtin_amdgcn_mfma_f32_16x16x32_bf16(Bt[n][k], At[m][k], acc[ai][bj][m][n], 0, 0, 0); __builtin_amdgcn_s_setprio(0); } while (0)
#define PG8_WAIT_V(n) asm volatile("s_waitcnt vmcnt(" #n ")" ::: "memory")
#define PG8_WAIT_L(n) asm volatile("s_waitcnt lgkmcnt(" #n ")" ::: "memory")
#define PG8_BAR __builtin_amdgcn_s_barrier()
#define PG8_SCHED __builtin_amdgcn_sched_barrier(0)
    Unit cur, nxt; int ui = 0;
    if (!S.next(0, cur)) return;
    f32x4 acc[2][2][4][2];
#pragma unroll
    for (int a = 0; a < 2; ++a)
#pragma unroll
        for (int b = 0; b < 2; ++b)
#pragma unroll
            for (int m = 0; m < 4; ++m)
#pragma unroll
                for (int n = 0; n < 2; ++n) acc[a][b][m][n] = (f32x4){0.f, 0.f, 0.f, 0.f};
    bf16x8 At[4][2], B0[2][2], B1[2][2];
    const char* cA = (const char*)g.A + (size_t)cur.pm * tstepA + cur.koff; const char* cB = (const char*)(g.Bt + (size_t)cur.e * g.bstride) + (size_t)cur.pn * tstepB + cur.koff;
    PG8_WAIT_V(0); PG8_WAIT_L(0); __syncthreads();
    PG8_STAGE(PG8_SB(0, 0), cB, voffB); PG8_STAGE(PG8_SB(0, 1), cB + hstepB, voffB); PG8_STAGE(PG8_SA(0, 0), cA, voffA); PG8_STAGE(PG8_SA(0, 1), cA + hstepA, voffA);
    if (wr == 1) PG8_BAR;
    PG8_WAIT_V(2); PG8_BAR;
    PG8_STAGE(PG8_SB(1, 0), cB + kstep, voffB); PG8_STAGE(PG8_SA(1, 0), cA + kstep, voffA); PG8_STAGE(PG8_SB(1, 1), cB + hstepB + kstep, voffB);
    PG8_WAIT_V(6); PG8_BAR;
    for (;;) {
        const bool has_next = S.next(ui + 1, nxt);
        const char* nA = has_next ? (const char*)g.A + (size_t)nxt.pm * tstepA + nxt.koff : cA; const char* nB = has_next ? (const char*)(g.Bt + (size_t)nxt.e * g.bstride) + (size_t)nxt.pn * tstepB + nxt.koff : cB;
#pragma unroll 1
        for (int t = 0; t < nt; t += 2) {
            const bool last = (t == nt - 2);
            const char* a1 = cA + (size_t)(t + 1) * kstep;
            const char* a2 = last ? nA : cA + (size_t)(t + 2) * kstep; const char* b2 = last ? nB : cB + (size_t)(t + 2) * kstep;
            const char* a3 = a2 + kstep; const char* b3 = b2 + kstep;
            PG8_LDB(B0, 0, 0); PG8_LDB(B1, 0, 1); PG8_SCHED; PG8_LDA(At, 0, 0); PG8_STAGE(PG8_SA(1, 1), a1 + hstepA, voffA);
            PG8_WAIT_V(8); PG8_WAIT_L(0); PG8_BAR; PG8_MMA(0, 0, At, B0); PG8_MMA(0, 1, At, B1); PG8_BAR; PG8_SCHED;
            PG8_LDA(At, 0, 1); PG8_STAGE(PG8_SB(0, 0), b2, voffB); PG8_STAGE(PG8_SB(0, 1), b2 + hstepB, voffB); PG8_STAGE(PG8_SA(0, 0), a2, voffA);
            PG8_WAIT_V(8); PG8_WAIT_L(0); PG8_BAR; PG8_MMA(1, 0, At, B0); PG8_MMA(1, 1, At, B1); PG8_BAR; PG8_SCHED;
            PG8_LDB(B0, 1, 0); PG8_LDB(B1, 1, 1); PG8_SCHED; PG8_LDA(At, 1, 0); PG8_STAGE(PG8_SA(0, 1), a2 + hstepA, voffA);
            PG8_WAIT_V(8); PG8_WAIT_L(0); PG8_BAR; PG8_MMA(0, 0, At, B0); PG8_MMA(0, 1, At, B1); PG8_BAR; PG8_SCHED;
            PG8_LDA(At, 1, 1); PG8_STAGE(PG8_SB(1, 0), b3, voffB); PG8_STAGE(PG8_SB(1, 1), b3 + hstepB, voffB); PG8_STAGE(PG8_SA(1, 0), a3, voffA);
            PG8_WAIT_V(8); PG8_WAIT_L(0); PG8_BAR; PG8_MMA(1, 0, At, B0); PG8_MMA(1, 1, At, B1); PG8_BAR; PG8_SCHED;
        }
        if (wr == 0) PG8_BAR;
        E(acc, cur, wr, wc, fr, fq);
        if (!has_next) break;
#pragma unroll
        for (int a = 0; a < 2; ++a)
#pragma unroll
            for (int b = 0; b < 2; ++b)
#pragma unroll
                for (int m = 0; m < 4; ++m)
#pragma unroll
                    for (int n = 0; n < 2; ++n) acc[a][b][m][n] = (f32x4){0.f, 0.f, 0.f, 0.f};
        cur = nxt; cA = nA; cB = nB; ++ui;
        if (wr == 1) PG8_BAR;
    }
    PG8_WAIT_V(0);
    PG8_BAR;
#undef PG8_SA
#undef PG8_SB
#undef PG8_STAGE
#undef PG8_LDA
#undef PG8_LDB
#undef PG8_MMA
#undef PG8_WAIT_V
#undef PG8_WAIT_L
#undef PG8_BAR
#undef PG8_SCHED
}
#define EPI_LOOP_ROWS _Pragma("unroll") for (int ai = 0; ai < 2; ++ai) _Pragma("unroll") for (int m = 0; m < 4; ++m)
#define EPI_ROW (u.pm * 256 + ai * 128 + wr * 64 + m * 16 + fr)
#define EPI_COL(bj, n) (u.pn * 256 + (bj) * 128 + wc * 32 + (n) * 16 + fq * 4)

DEVI void st_bf16x4(bf16* p, f32x4 v) { u32x2 w; w.x = pk2(v[0], v[1]); w.y = pk2(v[2], v[3]); *(u32x2*)p = w; }

struct EpiInProj {
    bf16* proj; float* dt; const float* dt_bias; const float* a_log;
    DEVI void operator()(const f32x4 (&acc)[2][2][4][2], const Unit& u, int wr, int wc, int fr, int fq) const {
        EPI_LOOP_ROWS { const int row = EPI_ROW;
#pragma unroll
            for (int bj = 0; bj < 2; ++bj)
#pragma unroll
                for (int n = 0; n < 2; ++n) { const int col = EPI_COL(bj, n); const f32x4 v = acc[ai][bj][m][n];
                    if (col < C_DTF) st_bf16x4(proj + (size_t)row * INWP + col, v);
                    else if (col < INW) { const int j0 = col - C_DTF; f32x4 dv, lv;
#pragma unroll
                        for (int i = 0; i < 4; ++i) { const float d_ = softplusf(v[i] + dt_bias[j0 + i]); dv[i] = d_; lv[i] = -d_ * __expf(a_log[j0 + i]); }
                        *(f32x4*)(dt + (size_t)row * 32 + j0) = dv; *(f32x4*)(dt + (size_t)row * 32 + 16 + j0) = lv; } } }
    }
};
struct EpiMla {
    bf16 *Q, *K, *V; const float *rq, *rkv; const float* rope;
    DEVI void operator()(const f32x4 (&acc)[2][2][4][2], const Unit& u, int wr, int wc, int fr, int fq) const {
        EPI_LOOP_ROWS { const int row = EPI_ROW; const float sq = rq[row], skv = rkv[row];
#pragma unroll
            for (int bj = 0; bj < 2; ++bj)
#pragma unroll
                for (int n = 0; n < 2; ++n) { const int col = EPI_COL(bj, n); f32x4 v = acc[ai][bj][m][n];
                    if (col < 384) { v = v * sq; const int d = col % 96;
                        if (d >= 64 && row < NLAT) { const int pos = row & (SEQ - 1), gr = pos >> 6, gc = pos & 63, pp = (d - 64) >> 1;
#pragma unroll
                            for (int i = 0; i < 2; ++i) { const int pi = pp + i; const float* tb = (pi < 8) ? rope + (gr * 8 + pi) * 2 : rope + 2048 + (gc * 8 + (pi - 8)) * 2;
                                const float c = tb[0], s = tb[1], x0 = v[2 * i], x1 = v[2 * i + 1]; v[2 * i] = x0 * c - x1 * s; v[2 * i + 1] = x1 * c + x0 * s; } }
                        st_bf16x4(Q + (size_t)row * 384 + col, v); }
                    else if (col >= 512 && col < 768) { const int c = col - 512; st_bf16x4(K + (size_t)row * 384 + (c >> 6) * 96 + (c & 63), v * skv); }
                    else if (col >= 768) { st_bf16x4(V + (size_t)row * 256 + (col - 768), v * skv); } }
            asm volatile("" ::: "memory"); }
    }
};
struct EpiResid {
    const float* src_lat; const float* src_ctx; float* dst_lat; float* dst_ctx; const float* modv_l; int gidx;
    DEVI void operator()(const f32x4 (&acc)[2][2][4][2], const Unit& u, int wr, int wc, int fr, int fq) const {
        EPI_LOOP_ROWS { const int row = EPI_ROW; const bool lat = row < NLAT; const int r = lat ? (row >> 13) : 2;
            const float* s = lat ? src_lat + (size_t)row * D : src_ctx + (size_t)(row - NLAT) * D; float* d = lat ? dst_lat + (size_t)row * D : dst_ctx + (size_t)(row - NLAT) * D;
            const float* gp = modv_l + r * 6144 + gidx * 1024;
#pragma unroll
            for (int bj = 0; bj < 2; ++bj)
#pragma unroll
                for (int n = 0; n < 2; ++n) { const int col = EPI_COL(bj, n); const f32x4 gv = *(const f32x4*)(gp + col), sv = *(const f32x4*)(s + col);
                    *(f32x4*)(d + col) = sv + gv * acc[ai][bj][m][n]; } }
    }
};
struct EpiPart {
    float* part;
    DEVI void operator()(const f32x4 (&acc)[2][2][4][2], const Unit& u, int wr, int wc, int fr, int fq) const {
        EPI_LOOP_ROWS { const int row = EPI_ROW; float* d = part + ((size_t)u.e * NCTX + (row - NLAT)) * D;
#pragma unroll
            for (int bj = 0; bj < 2; ++bj)
#pragma unroll
                for (int n = 0; n < 2; ++n) *(f32x4*)(d + EPI_COL(bj, n)) = acc[ai][bj][m][n]; }
    }
};
struct EpiSwiglu {
    bf16* act; int ldc;
    DEVI void operator()(const f32x4 (&acc)[2][2][4][2], const Unit& u, int wr, int wc, int fr, int fq) const {
        EPI_LOOP_ROWS { const int row = EPI_ROW;
#pragma unroll
            for (int n = 0; n < 2; ++n) { const f32x4 gt = acc[ai][0][m][n], up = acc[ai][1][m][n]; f32x4 o;
#pragma unroll
                for (int i = 0; i < 4; ++i) o[i] = siluf(gt[i]) * up[i];
                st_bf16x4(act + (size_t)row * ldc + u.pn * 128 + wc * 32 + n * 16 + fq * 4, o); } }
    }
};
struct EpiStore {
    bf16* o; int ldc;
    DEVI void operator()(const f32x4 (&acc)[2][2][4][2], const Unit& u, int wr, int wc, int fr, int fq) const {
        EPI_LOOP_ROWS { const int row = EPI_ROW;
#pragma unroll
            for (int bj = 0; bj < 2; ++bj)
#pragma unroll
                for (int n = 0; n < 2; ++n) st_bf16x4(o + (size_t)row * ldc + EPI_COL(bj, n), acc[ai][bj][m][n]); }
    }
};

struct CvtSrc { const float* src; int ld; int ncols; bool perm; const float* ks; float sc; };
DEVI void cvt_tile(const CvtSrc t, bf16* dst, int Kd, int nd0, int kd0, LAS float* scr, int lane) {
    const int n = lane & 31;
    if (t.src) {
        const int nc = (n < t.ncols) ? n : t.ncols - 1; const float msk = (n < t.ncols) ? t.sc : 0.f;
        const float* sp0 = t.src + (size_t)(lane >> 5) * t.ld + nc;
        float v[32];
#pragma unroll
        for (int i = 0; i < 32; ++i) v[i] = sp0[(size_t)(2 * i) * t.ld];
        if (t.ks) {
#pragma unroll
            for (int i = 0; i < 32; ++i) v[i] *= t.ks[2 * i + (lane >> 5)];
        }
#pragma unroll
        for (int i = 0; i < 32; ++i) scr[(2 * i + (lane >> 5)) * 33 + n] = v[i] * msk;
    } else {
#pragma unroll 8
        for (int i = 0; i < 32; ++i) scr[(2 * i + (lane >> 5)) * 33 + n] = 0.f;
    }
    asm volatile("s_waitcnt lgkmcnt(0)" ::: "memory");
    const int c = lane & 7;
#pragma unroll
    for (int j = 0; j < 4; ++j) { const int nn = (lane >> 3) + 8 * j; const LAS float* sp = scr + (8 * c) * 33 + (t.perm ? rope_src(nn) : nn);
        u32x4 o; o.x = pk2(sp[0 * 33], sp[1 * 33]); o.y = pk2(sp[2 * 33], sp[3 * 33]); o.z = pk2(sp[4 * 33], sp[5 * 33]); o.w = pk2(sp[6 * 33], sp[7 * 33]);
        *(u32x4*)(dst + (size_t)(nd0 + nn) * Kd + kd0 + 8 * c) = o; }
    asm volatile("s_waitcnt lgkmcnt(0)" ::: "memory");
}
template <class F>
DEVI void cvt_job(bf16* dst, int Nd, int Kd, F f, LAS float* scr, int gw, int ngw, int lane) {
    const int ntn = Nd >> 5, ntk = Kd >> 6;
    for (int it = gw; it < ntn * ntk; it += ngw) { const int nt = it % ntn, kt = it / ntn; cvt_tile(f(nt, kt), dst, Kd, nt * 32, kt * 64, scr, lane); }
}
DEVI void ph_pro(const P& p, unsigned char* lds) {
    const int tid = otid(), wid = tid >> 6, lane = tid & 63;
    __syncthreads();
    float* modv = (float*)(p.ws + WS_MODV);
    float* red = (float*)lds;
    for (int item = blockIdx.x; item < 192; item += gridDim.x) {
        const int l = item / 96, n = (item % 96) * 64 + lane;
        const float* W = IN(4) + (size_t)l * 1024 * 6144;
        float a0 = 0.f, a1 = 0.f, a2 = 0.f;
        for (int k = wid * 128; k < wid * 128 + 128; ++k) {
            const float w = W[(size_t)k * 6144 + n];
            a0 += siluf(IN(1)[k]) * w; a1 += siluf(IN(1)[1024 + k]) * w; a2 += siluf(IN(3)[k]) * w;
        }
        red[(wid * 3 + 0) * 64 + lane] = a0; red[(wid * 3 + 1) * 64 + lane] = a1; red[(wid * 3 + 2) * 64 + lane] = a2;
        __syncthreads();
        if (tid < 192) { const int r = tid >> 6, ln = tid & 63; float s = 0.f;
            for (int w = 0; w < 8; ++w) s += red[(w * 3 + r) * 64 + ln];
            const int nn = (item % 96) * 64 + ln; modv[(l * 3 + r) * 6144 + nn] = s + IN(5)[l * 6144 + nn]; }
        __syncthreads();
    }
    if (blockIdx.x == gridDim.x - 1) {
        float* rope = (float*)(p.ws + WS_ROPE);
        for (int idx = tid; idx < 1536; idx += NTHREADS) {
            const int i = idx & 7, pos = (idx < 1024) ? (idx >> 3) : ((idx - 1024) >> 3);
            const float invf = (i == 0) ? 1.f : (i == 1) ? 0.31622776601683794f : (i == 2) ? 0.1f : (i == 3) ? 0.03162277660168379f : (i == 4) ? 0.01f : (i == 5) ? 0.003162277660168379f : (i == 6) ? 0.001f : 0.00031622776601683794f;
            const float ang = (float)pos * invf;
            double rev = (double)ang * 0.15915494309189535; rev -= __builtin_rint(rev);
            const float fr = (float)rev;
            rope[idx * 2] = __builtin_amdgcn_cosf(fr); rope[idx * 2 + 1] = __builtin_amdgcn_sinf(fr);
        }
    }
    __syncthreads();
    LAS float* scr = (LAS float*)(LAS unsigned char*)lds + wid * (64 * 33);
    const int gw = blockIdx.x * NWAVES + wid, ngw = gridDim.x * NWAVES;
    for (int l = 0; l < 2; ++l) {
        { const float* W = IN(8) + (size_t)l * 1024 * INW;
          cvt_job((bf16*)(p.ws + WS_WIN) + (size_t)l * INWP * 1024, INWP, 1024, [=](int nt, int kt) -> CvtSrc {
              const int n0 = nt * 32; if (n0 >= INW) return CvtSrc{nullptr, 0, 0, false, nullptr, 1.f};
              return CvtSrc{W + (size_t)(kt * 64) * INW + n0, INW, (INW - n0 < 32) ? INW - n0 : 32, n0 == C_KPE, nullptr, 1.f}; }, scr, gw, ngw, lane); }
        { const float* Wq = IN(11) + (size_t)l * 256 * 384; const float* qn = IN(10) + l * 256; const float* Wk = IN(13) + (size_t)l * 128 * 256; const float* Wv = IN(14) + (size_t)l * 128 * 256; const float* kn = IN(12) + l * 128;
          const float QS = 0.10206207261596577f * 1.4426950408889634f;
          cvt_job((bf16*)(p.ws + WS_WQKV) + (size_t)l * 1024 * 384, 1024, 384, [=](int nt, int kt) -> CvtSrc {
              const int n0 = nt * 32, k0 = kt * 64;
              if (n0 < 384) { if (k0 >= 256) return CvtSrc{nullptr, 0, 0, false, nullptr, 1.f}; return CvtSrc{Wq + (size_t)k0 * 384 + n0, 384, 32, (n0 % 96) == 64, qn + k0, QS}; }
              if (n0 < 512 || k0 < 256) return CvtSrc{nullptr, 0, 0, false, nullptr, 1.f};
              if (n0 < 768) return CvtSrc{Wk + (size_t)(k0 - 256) * 256 + (n0 - 512), 256, 32, false, kn + k0 - 256, 1.f};
              return CvtSrc{Wv + (size_t)(k0 - 256) * 256 + (n0 - 768), 256, 32, false, kn + k0 - 256, 1.f}; }, scr, gw, ngw, lane); }
        { const float* W = IN(9) + (size_t)l * 1024 * 1024;
          cvt_job((bf16*)(p.ws + WS_WOUT) + (size_t)l * 1024 * 1024, 1024, 1024, [=](int nt, int kt) -> CvtSrc { return CvtSrc{W + (size_t)(kt * 64) * 1024 + nt * 32, 1024, 32, false, nullptr, 1.f}; }, scr, gw, ngw, lane); }
    }
    { const float* Wg = IN(22); const float* Wu = IN(23);
      cvt_job((bf16*)(p.ws + WS_WGU), 2 * DFF, 1024, [=](int nt, int kt) -> CvtSrc { const int n0 = nt * 32, t = n0 >> 8, r = n0 & 255;
          return CvtSrc{(r < 128 ? Wg + t * 128 + r : Wu + t * 128 + r - 128) + (size_t)(kt * 64) * DFF, DFF, 32, false, nullptr, 1.f}; }, scr, gw, ngw, lane); }
    { const float* W = IN(24);
      cvt_job((bf16*)(p.ws + WS_WD), 1024, DFF, [=](int nt, int kt) -> CvtSrc { return CvtSrc{W + (size_t)(kt * 64) * 1024 + nt * 32, 1024, 32, false, nullptr, 1.f}; }, scr, gw, ngw, lane); }
}
DEVI void ph_moew(const P& p, unsigned char* lds) {
    const int tid = otid(), wid = tid >> 6, lane = tid & 63;
    LAS float* scr = (LAS float*)(LAS unsigned char*)lds + wid * (64 * 33);
    const int gw = blockIdx.x * NWAVES + wid, ngw = gridDim.x * NWAVES;
    for (int e = 0; e < NEXP; ++e) {
        { const float* Wg = IN(26) + (size_t)e * 1024 * DFE; const float* Wu = IN(27) + (size_t)e * 1024 * DFE;
          cvt_job((bf16*)(p.ws + WS_WGUE) + (size_t)e * 2 * DFE * 1024, 2 * DFE, 1024, [=](int nt, int kt) -> CvtSrc { const int n0 = nt * 32, t = n0 >> 8, r = n0 & 255;
              return CvtSrc{(r < 128 ? Wg + t * 128 + r : Wu + t * 128 + r - 128) + (size_t)(kt * 64) * DFE, DFE, 32, false, nullptr, 1.f}; }, scr, gw, ngw, lane); }
        { const float* W = IN(28) + (size_t)e * DFE * 1024;
          cvt_job((bf16*)(p.ws + WS_WDE) + (size_t)e * 1024 * DFE, 1024, DFE, [=](int nt, int kt) -> CvtSrc { return CvtSrc{W + (size_t)(kt * 64) * 1024 + nt * 32, 1024, 32, false, nullptr, 1.f}; }, scr, gw, ngw, lane); }
    }
}

template <bool route>
DEVI void ph_norm(const P& p, int l, int which, int nrows, unsigned char* lds, int npart, int pgidx) {
    const int tid = otid(), wid = tid >> 6, lane = tid & 63;
    const bool first = (l == 0 && which == 0);
    const float* src_lat = first ? IN(0) : p.out; const float* src_ctx = (l == 0) ? IN(2) : (const float*)(p.ws + WS_XC);
    const float* w = IN(6 + which) + l * 1024; const float* modv = (const float*)(p.ws + WS_MODV) + (size_t)l * 3 * 6144;
    bf16* H = (bf16*)(p.ws + WS_HM);
    int* rt_e = (int*)(p.ws + WS_RT); float* rt_g = (float*)(p.ws + WS_RT + 128 * 1024);
    float* rl = (float*)lds;
    if (route) { __syncthreads(); const float* router = IN(25);
#pragma unroll
        for (int i = 0; i < 4; ++i) *(f32x4*)(rl + (tid + NTHREADS * i) * 4) = *(const f32x4*)(router + (tid + NTHREADS * i) * 4);
        __syncthreads(); }
    const int nw = gridDim.x * NWAVES, rpw = (NLAT + nw - 1) / nw, gw = blockIdx.x * NWAVES + wid;
    f32x4 vn[4], gsc[4], shv[4]; int rc = -1;
    for (int pass = 0; pass < (nrows > NLAT ? 2 : 1); ++pass) {
    const int row0 = pass == 0 ? gw * rpw : NLAT + gw, row1 = pass == 0 ? ((row0 + rpw < NLAT) ? row0 + rpw : NLAT) : nrows, rstep = pass == 0 ? 1 : nw;
    if (row0 < row1) { const float* x = (row0 < NLAT) ? src_lat + (size_t)row0 * D : src_ctx + (size_t)(row0 - NLAT) * D;
#pragma unroll
        for (int j = 0; j < 4; ++j) vn[j] = *(const f32x4*)(x + (j * 64 + lane) * 4); }
    for (int row = row0; row < row1; row += rstep) {
        const bool lat = row < NLAT; const int r = lat ? (row >> 13) : 2;
        if (r != rc) { rc = r; const float* sh = modv + r * 6144 + (which * 3 + 0) * 1024; const float* sc = modv + r * 6144 + (which * 3 + 1) * 1024;
#pragma unroll
            for (int j = 0; j < 4; ++j) { const int c0 = (j * 64 + lane) * 4; const f32x4 wv = *(const f32x4*)(w + c0), cv = *(const f32x4*)(sc + c0); shv[j] = *(const f32x4*)(sh + c0); gsc[j] = wv * (cv + 1.f); } }
        f32x4 v[4]; float ss = 0.f;
#pragma unroll
        for (int j = 0; j < 4; ++j) v[j] = vn[j];
        if (!lat && npart > 0) { const float* part = (const float*)(p.ws + WS_XBC) + (size_t)(row - NLAT) * D; const float* gp = modv + 2 * 6144 + pgidx * 1024; float* xc = (float*)(p.ws + WS_XC) + (size_t)(row - NLAT) * D;
#pragma unroll
            for (int j = 0; j < 4; ++j) { const int c0 = (j * 64 + lane) * 4; f32x4 acc = {0.f, 0.f, 0.f, 0.f};
#pragma unroll 2
                for (int k = 0; k < npart; ++k) acc += *(const f32x4*)(part + (size_t)k * NCTX * D + c0);
                v[j] += *(const f32x4*)(gp + c0) * acc; *(f32x4*)(xc + c0) = v[j]; } }
#pragma unroll
        for (int j = 0; j < 4; ++j) ss += v[j][0] * v[j][0] + v[j][1] * v[j][1] + v[j][2] * v[j][2] + v[j][3] * v[j][3];
        if (row + rstep < row1) { const int nrow = row + rstep; const float* x = (nrow < NLAT) ? src_lat + (size_t)nrow * D : src_ctx + (size_t)(nrow - NLAT) * D;
#pragma unroll
            for (int j = 0; j < 4; ++j) vn[j] = *(const f32x4*)(x + (j * 64 + lane) * 4); }
        ss = wave_sum(ss); const float rstd = 1.0f / sqrtf(ss * (1.f / D) + EPS);
        float lg[8];
#pragma unroll
        for (int e = 0; e < 8; ++e) lg[e] = 0.f;
#pragma unroll
        for (int j = 0; j < 4; ++j) { const int c0 = (j * 64 + lane) * 4; v[j] = v[j] * rstd * gsc[j] + shv[j]; st_bf16x4(H + (size_t)row * D + c0, v[j]); }
        if (route) {
#pragma unroll
            for (int j = 0; j < 4; ++j) { const int c0 = (j * 64 + lane) * 4;
#pragma unroll
                for (int i = 0; i < 4; ++i) { const f32x4 r0 = *(const f32x4*)(rl + (c0 + i) * 8), r1 = *(const f32x4*)(rl + (c0 + i) * 8 + 4); const float hh = v[j][i];
                    lg[0] += hh * r0[0]; lg[1] += hh * r0[1]; lg[2] += hh * r0[2]; lg[3] += hh * r0[3]; lg[4] += hh * r1[0]; lg[5] += hh * r1[1]; lg[6] += hh * r1[2]; lg[7] += hh * r1[3]; }
                asm volatile("" ::: "memory"); } }
        if (route) {
#pragma unroll
            for (int e = 0; e < 8; ++e) lg[e] = wave_sum(lg[e]);
            int i1 = 0; float v1 = lg[0];
#pragma unroll
            for (int e = 1; e < 8; ++e) if (lg[e] > v1) { v1 = lg[e]; i1 = e; }
            int i2 = -1; float v2 = -3.0e38f;
#pragma unroll
            for (int e = 0; e < 8; ++e) if (e != i1 && lg[e] > v2) { v2 = lg[e]; i2 = e; }
            const float e2 = __expf(v2 - v1), g1 = 1.f / (1.f + e2), g2 = e2 / (1.f + e2);
            if (lane == 0) { rt_e[row * 2] = i1; rt_e[row * 2 + 1] = i2; rt_g[row * 2] = g1; rt_g[row * 2 + 1] = g2; }
        }
    }
    }
}

DEVI void ph_conv(const P& p, int l) {
    const int tid = otid(), wid = tid >> 6, lane = tid & 63;
    const bf16* proj = (const bf16*)(p.ws + WS_PROJ); bf16* xbc = (bf16*)(p.ws + WS_XBC); bf16* Kb = (bf16*)(p.ws + WS_K);
    float* rq = (float*)(p.ws + WS_RQ); float* rkv = (float*)(p.ws + WS_RKV); const float* rope = (const float*)(p.ws + WS_ROPE);
    const float* cw = IN(16) + (size_t)l * 3 * 768; const float* cb = IN(17) + l * 768;
    const int nw_ = gridDim.x * NWAVES, rpw = (T + nw_ - 1) / nw_, gw = blockIdx.x * NWAVES + wid;
    const int row0 = gw * rpw, row1 = (row0 + rpw < T) ? row0 + rpw : T;
    f32x4 cw0[3], cw1[3], cw2[3], cbb[3];
#pragma unroll
    for (int j = 0; j < 3; ++j) { const int c0 = (j * 64 + lane) * 4; cw0[j] = *(const f32x4*)(cw + c0); cw1[j] = *(const f32x4*)(cw + 768 + c0); cw2[j] = *(const f32x4*)(cw + 1536 + c0); cbb[j] = *(const f32x4*)(cb + c0); }
    for (int row = row0; row < row1; ++row) {
        const bool lat = row < NLAT; const int pos = lat ? (row & (SEQ - 1)) : ((row - NLAT) & (CL - 1)); const int L = lat ? SEQ : CL;
        const bf16* pr = proj + (size_t)row * INWP;
        { const u32x2 a = *(const u32x2*)(pr + lane * 4); const unsigned b = *(const unsigned*)(pr + C_CKV + lane * 2);
          const float q0 = bf2f(a.x & 0xffff), q1 = bf2f(a.x >> 16), q2 = bf2f(a.y & 0xffff), q3 = bf2f(a.y >> 16), k0 = bf2f(b & 0xffff), k1 = bf2f(b >> 16);
          const float sq = wave_sum(q0 * q0 + q1 * q1 + q2 * q2 + q3 * q3), sk = wave_sum(k0 * k0 + k1 * k1);
          if (lane == 0) { rq[row] = 1.0f / sqrtf(sq * (1.f / 256.f) + EPS); rkv[row] = 1.0f / sqrtf(sk * (1.f / 128.f) + EPS); } }
        if (lane < 16) { const unsigned a = *(const unsigned*)(pr + C_KPE + lane * 2); float x0 = bf2f(a & 0xffff), x1 = bf2f(a >> 16);
            if (lat) { const int gr = pos >> 6, gc = pos & 63; const float* tb = (lane < 8) ? rope + (gr * 8 + lane) * 2 : rope + 2048 + (gc * 8 + (lane - 8)) * 2;
                const float c = tb[0], s = tb[1], y0 = x0 * c - x1 * s, y1 = x1 * c + x0 * s; x0 = y0; x1 = y1; }
            const unsigned o = pk2(x0, x1);
#pragma unroll
            for (int h = 0; h < 4; ++h) *(unsigned*)(Kb + (size_t)row * 384 + h * 96 + 64 + lane * 2) = o; }
#pragma unroll
        for (int j = 0; j < 3; ++j) { const int c0 = (j * 64 + lane) * 4;
            const u32x2 xm = (pos > 0) ? *(const u32x2*)(pr - INWP + C_XBC + c0) : (u32x2){0u, 0u}; const u32x2 x0 = *(const u32x2*)(pr + C_XBC + c0);
            const u32x2 xp = (pos < L - 1) ? *(const u32x2*)(pr + INWP + C_XBC + c0) : (u32x2){0u, 0u};
            const f32x4 w0 = cw0[j], w1 = cw1[j], w2 = cw2[j], bb = cbb[j];
            f32x4 am = {bf2f(xm.x & 0xffff), bf2f(xm.x >> 16), bf2f(xm.y & 0xffff), bf2f(xm.y >> 16)}, a0 = {bf2f(x0.x & 0xffff), bf2f(x0.x >> 16), bf2f(x0.y & 0xffff), bf2f(x0.y >> 16)},
                  ap = {bf2f(xp.x & 0xffff), bf2f(xp.x >> 16), bf2f(xp.y & 0xffff), bf2f(xp.y >> 16)};
            f32x4 y = w0 * am + w1 * a0 + w2 * ap + bb;
#pragma unroll
            for (int i = 0; i < 4; ++i) y[i] = siluf(y[i]);
            st_bf16x4(xbc + (size_t)row * 768 + c0, y); }
    }
}

typedef short v4i16_t __attribute__((ext_vector_type(4)));
DEVI v4i16_t lds_tr(const unsigned char* p) { return __builtin_amdgcn_ds_read_tr16_b64_v4i16((LAS v4i16_t*)(LAS unsigned char*)p); }
constexpr int A3_KLD = 208, A3_VLD = 192, A3_VOFF = 64 * A3_KLD, A3_BUF = A3_VOFF + 64 * A3_VLD;
DEVI void attn_unit(const P& p, int uidx, unsigned char* lds) {
    const int tid = otid(), wid = __builtin_amdgcn_readfirstlane(tid >> 6), lane = tid & 63, r32 = lane & 31, hi = lane >> 5;
    const bf16* Q = (const bf16*)(p.ws + WS_Q); const bf16* K = (const bf16*)(p.ws + WS_K); const bf16* V = (const bf16*)(p.ws + WS_V); bf16* MIX = (bf16*)(p.ws + WS_HM);
    int b, h, qrow0, NT;
    if (uidx < 256) { b = uidx >> 7; h = (uidx >> 5) & 3; qrow0 = b * SEQ + (uidx & 31) * 256; NT = 4 + SEQ / 64; }
    else { const int j = uidx - 256; b = j >> 2; h = j & 3; qrow0 = NLAT + b * CL; NT = 4; }
    const int qrow = qrow0 + wid * 32 + r32;
    bf16x8 qf[6];
#pragma unroll
    for (int s = 0; s < 6; ++s) qf[s] = *(const bf16x8*)(Q + (size_t)qrow * 384 + h * 96 + s * 16 + hi * 8);
    const int kk0 = tid / 12, kq0 = tid % 12, kk1 = (512 + tid) / 12, kq1 = (512 + tid) % 12, vk = tid >> 3, vq = tid & 7;
    const bf16* Kh = K + h * 96; const bf16* Vh = V + h * 64 + vq * 8;
    const int ctx0 = NLAT + b * CL, lat0 = b * SEQ;
    u32x4 krA0, krA1 = {0u, 0u, 0u, 0u}, vrA, krB0, krB1 = {0u, 0u, 0u, 0u}, vrB;
#define AT_LOAD(t, kr0, kr1, vr) do { const int kr_ = ((t) < 4) ? ctx0 + (t) * 64 : lat0 + ((t) - 4) * 64; \
        kr0 = *(const u32x4*)(Kh + (size_t)(kr_ + kk0) * 384 + kq0 * 8); if (tid < 256) kr1 = *(const u32x4*)(Kh + (size_t)(kr_ + kk1) * 384 + kq1 * 8); \
        vr = *(const u32x4*)(Vh + (size_t)(kr_ + vk) * 256); } while (0)
#define AT_STORE(bufp, kr0, kr1, vr) do { unsigned char* b_ = (bufp); *(u32x4*)(b_ + kk0 * A3_KLD + kq0 * 16) = kr0; if (tid < 256) *(u32x4*)(b_ + kk1 * A3_KLD + kq1 * 16) = kr1; \
        *(u32x4*)(b_ + A3_VOFF + vk * A3_VLD + vq * 16) = vr; } while (0)
#define AT_QK(bufp, D0, D1) do { const unsigned char* kl_ = (bufp) + r32 * A3_KLD + hi * 16; \
        _Pragma("unroll") for (int s = 0; s < 6; ++s) { const bf16x8 k0_ = *(const bf16x8*)(kl_ + s * 32), k1_ = *(const bf16x8*)(kl_ + 32 * A3_KLD + s * 32); \
            D0 = __builtin_amdgcn_mfma_f32_32x32x16_bf16(k0_, qf[s], s == 0 ? negm : D0, 0, 0, 0); D1 = __builtin_amdgcn_mfma_f32_32x32x16_bf16(k1_, qf[s], s == 0 ? negm : D1, 0, 0, 0); } } while (0)
    const int troff = (4 * hi + ((lane & 15) >> 2)) * A3_VLD + (16 * ((lane >> 4) & 1) + 4 * (lane & 3)) * 2;
    f32x16 o0, o1, negm, lacc;
#pragma unroll
    for (int r = 0; r < 16; ++r) { o0[r] = 0.f; o1[r] = 0.f; negm[r] = 0.f; lacc[r] = 0.f; }
    const bf16x8 ones = {0x3f80, 0x3f80, 0x3f80, 0x3f80, 0x3f80, 0x3f80, 0x3f80, 0x3f80};
    float mhat = 0.f, pend = 0.f;
    __syncthreads();
    AT_LOAD(0, krA0, krA1, vrA); AT_STORE(lds, krA0, krA1, vrA); AT_LOAD(1, krA0, krA1, vrA); AT_STORE(lds + A3_BUF, krA0, krA1, vrA); AT_LOAD(2, krB0, krB1, vrB);
    __syncthreads();
    f32x16 sa0, sa1, sb0, sb1;
    AT_QK(lds, sa0, sa1);
    const bool lead = true;
#define AT_SOFTMAX(S0, S1, t) do { \
        if (__any(pend != 0.f)) { _Pragma("unroll") for (int r = 0; r < 16; ++r) { S0[r] -= pend; S1[r] -= pend; } } \
        float a_ = __builtin_fmaxf(__builtin_fmaxf(S0[0], S0[1]), S1[0]), b_ = __builtin_fmaxf(__builtin_fmaxf(S0[2], S0[3]), S1[1]); a_ = __builtin_fmaxf(__builtin_fmaxf(a_, S1[2]), S1[3]); \
        _Pragma("unroll") for (int r = 4; r < 16; r += 4) { a_ = __builtin_fmaxf(__builtin_fmaxf(a_, S0[r]), S0[r + 1]); b_ = __builtin_fmaxf(__builtin_fmaxf(b_, S0[r + 2]), S0[r + 3]); a_ = __builtin_fmaxf(__builtin_fmaxf(a_, S1[r]), S1[r + 1]); b_ = __builtin_fmaxf(__builtin_fmaxf(b_, S1[r + 2]), S1[r + 3]); } \
        float mx_ = __builtin_fmaxf(a_, b_); mx_ = __builtin_fmaxf(mx_, __shfl_xor(mx_, 32)); \
        pend = 0.f; \
        if ((t) == 0 || __any(mx_ > 8.0f)) { const float dl_ = ((t) == 0) ? mx_ : __builtin_fmaxf(mx_, 0.f); mhat += dl_; pend = dl_; \
            _Pragma("unroll") for (int r = 0; r < 16; ++r) { S0[r] -= dl_; S1[r] -= dl_; negm[r] = -mhat; } \
            if ((t) != 0) { const float f_ = __builtin_amdgcn_exp2f(-dl_); _Pragma("unroll") for (int r = 0; r < 16; ++r) { o0[r] *= f_; o1[r] *= f_; lacc[r] *= f_; } } } \
        _Pragma("unroll") for (int r = 0; r < 16; ++r) { S0[r] = __builtin_amdgcn_exp2f(S0[r]); S1[r] = __builtin_amdgcn_exp2f(S1[r]); } } while (0)
#define AT_PV(S0, S1, bufp) do { const unsigned char* vl_ = (bufp) + A3_VOFF + troff; \
        _Pragma("unroll") for (int kt2 = 0; kt2 < 2; ++kt2) _Pragma("unroll") for (int s2 = 0; s2 < 2; ++s2) { \
            u32x4 pw_; if (kt2 == 0) { pw_.x = pk2(S0[8 * s2 + 0], S0[8 * s2 + 1]); pw_.y = pk2(S0[8 * s2 + 2], S0[8 * s2 + 3]); pw_.z = pk2(S0[8 * s2 + 4], S0[8 * s2 + 5]); pw_.w = pk2(S0[8 * s2 + 6], S0[8 * s2 + 7]); } \
            else { pw_.x = pk2(S1[8 * s2 + 0], S1[8 * s2 + 1]); pw_.y = pk2(S1[8 * s2 + 2], S1[8 * s2 + 3]); pw_.z = pk2(S1[8 * s2 + 4], S1[8 * s2 + 5]); pw_.w = pk2(S1[8 * s2 + 6], S1[8 * s2 + 7]); } \
            const bf16x8 pb_ = __builtin_bit_cast(bf16x8, pw_); \
            lacc = __builtin_amdgcn_mfma_f32_32x32x16_bf16(ones, pb_, lacc, 0, 0, 0); \
            _Pragma("unroll") for (int dh = 0; dh < 2; ++dh) { const unsigned char* vp_ = vl_ + (kt2 * 32 + 16 * s2) * A3_VLD + dh * 64; \
                const v4i16_t lo_ = lds_tr(vp_), hi_ = lds_tr(vp_ + 8 * A3_VLD); const bf16x8 va_ = {lo_[0], lo_[1], lo_[2], lo_[3], hi_[0], hi_[1], hi_[2], hi_[3]}; \
                if (dh == 0) o0 = __builtin_amdgcn_mfma_f32_32x32x16_bf16(va_, pb_, o0, 0, 0, 0); else o1 = __builtin_amdgcn_mfma_f32_32x32x16_bf16(va_, pb_, o1, 0, 0, 0); } } } while (0)
#define AT_STEP(C0, C1, N0, N1, t, bc_, LK0, LK1, LV, SK0, SK1, SV) do { const int b1_ = ((bc_) == 2) ? 0 : (bc_) + 1, b2_ = (b1_ == 2) ? 0 : b1_ + 1; \
        if ((t) + 3 < NT) AT_LOAD((t) + 3, LK0, LK1, LV); \
        if (lead) { if ((t) + 1 < NT) AT_QK(lds + b1_ * A3_BUF, N0, N1); AT_SOFTMAX(C0, C1, t); AT_PV(C0, C1, lds + (bc_) * A3_BUF); } \
        else { AT_SOFTMAX(C0, C1, t); AT_PV(C0, C1, lds + (bc_) * A3_BUF); if ((t) + 1 < NT) AT_QK(lds + b1_ * A3_BUF, N0, N1); } \
        if ((t) + 2 < NT) AT_STORE(lds + b2_ * A3_BUF, SK0, SK1, SV); \
        __syncthreads(); } while (0)
    int bc = 0;
    for (int t = 0; t < NT; t += 2) {
        AT_STEP(sa0, sa1, sb0, sb1, t, bc, krA0, krA1, vrA, krB0, krB1, vrB); bc = (bc == 2) ? 0 : bc + 1;
        AT_STEP(sb0, sb1, sa0, sa1, t + 1, bc, krB0, krB1, vrB, krA0, krA1, vrA); bc = (bc == 2) ? 0 : bc + 1;
    }
#undef AT_SOFTMAX
#undef AT_PV
#undef AT_STEP
#undef AT_LOAD
#undef AT_STORE
#undef AT_QK
    const float inv = 1.f / lacc[0];
    bf16* orow = MIX + (size_t)qrow * D + h * 64;
#pragma unroll
    for (int g = 0; g < 4; ++g) {
        st_bf16x4(orow + 8 * g + 4 * hi, (f32x4){o0[4 * g] * inv, o0[4 * g + 1] * inv, o0[4 * g + 2] * inv, o0[4 * g + 3] * inv});
        st_bf16x4(orow + 32 + 8 * g + 4 * hi, (f32x4){o1[4 * g] * inv, o1[4 * g + 1] * inv, o1[4 * g + 2] * inv, o1[4 * g + 3] * inv});
    }
}

constexpr int NCC = 66;
DEVI int chunk_row0(int b, int cc) { return cc < 2 ? NLAT + b * CL + cc * 128 : b * SEQ + (cc - 2) * 128; }
constexpr int SC_VEC = 0;
constexpr int SC_KT = 2048;
constexpr int SC_VF = SC_KT + 64 * 136 * 2;
constexpr int SC_VB = SC_VF + 64 * 136 * 2;
constexpr int SC_X = SC_VB + 64 * 136 * 2;
constexpr int SC_SSQ = SC_X + 2048;
constexpr int SC_END = SC_SSQ + 8192;
constexpr int TS = 136;

DEVI void scan_vectors(const P& p, int l, bool ret, int h, int row0, float* vec, int wid, int lane) {
    const float* dt = (const float*)(p.ws + WS_DT);
    if (ret) {
        if (wid == 0) { const float lf = IN(15)[l * 8 + h], lb = IN(15)[l * 8 + 4 + h];
            const float laf = -log1pf(__expf(-lf)), lab = -log1pf(__expf(-lb));
#pragma unroll
            for (int e = 0; e < 2; ++e) { const int j = lane * 2 + e; vec[j] = (float)(j + 1) * laf; vec[128 + j] = (float)(128 - j) * lab; vec[256 + j] = 1.f; vec[384 + j] = 1.f; } }
    } else if (wid < 2) {
        const int dir = wid; const size_t r = (size_t)(row0 + lane * 2);
        const float x0 = dt[r * 32 + 16 + dir * 8 + h], x1 = dt[(r + 1) * 32 + 16 + dir * 8 + h];
        vec[256 + dir * 128 + lane * 2] = dt[r * 32 + dir * 8 + h]; vec[256 + dir * 128 + lane * 2 + 1] = dt[(r + 1) * 32 + dir * 8 + h];
        float s = x0 + x1;
#pragma unroll
        for (int o = 1; o < 64; o <<= 1) { const float t = __shfl_up(s, o); if (lane >= o) s += t; }
        if (dir == 0) { vec[lane * 2] = s - x1; vec[lane * 2 + 1] = s; }
        else { const float tot = __shfl(s, 63); vec[128 + lane * 2] = tot - (s - x1) + x0; vec[128 + lane * 2 + 1] = tot - s + x1; }
    }
}
DEVI void scan_ptrs(const P& p, bool ret, int h, const bf16*& qb, const bf16*& kb, const bf16*& vb, int& ld) {
    if (ret) { const bf16* proj = (const bf16*)(p.ws + WS_PROJ); qb = proj + C_RQ + h * 64; kb = proj + C_RK + h * 64; vb = proj + C_RV + h * 64; ld = INWP; }
    else { const bf16* xbc = (const bf16*)(p.ws + WS_XBC); qb = xbc + 640 + (h >> 2) * 64; kb = xbc + 512 + (h >> 2) * 64; vb = xbc + h * 64; ld = 768; }
}
template <bool SCALED>
DEVI void stage_T(const bf16* src, int ld, int row0, bf16* d0, bf16* d1, const float* vec, int tid) {
    const int part = tid >> 6, lane = tid & 63, n0 = part * 8;
#pragma unroll
    for (int i = 0; i < 2; ++i) { const int j = lane + 64 * i;
        const u32x4 v = *(const u32x4*)(src + (size_t)(row0 + j) * ld + n0);
        const unsigned w[4] = {v.x, v.y, v.z, v.w};
        if (!SCALED) {
#pragma unroll
            for (int e = 0; e < 4; ++e) { d0[(n0 + 2 * e) * TS + j] = (bf16)(w[e] & 0xffff); d0[(n0 + 2 * e + 1) * TS + j] = (bf16)(w[e] >> 16); }
        } else {
            const float sf = __expf(vec[127] - vec[j]) * vec[256 + j], sb = __expf(vec[128] - vec[128 + j]) * vec[384 + j];
#pragma unroll
            for (int e = 0; e < 4; ++e) { const float a = bf2f(w[e] & 0xffff), b = bf2f(w[e] >> 16);
                d0[(n0 + 2 * e) * TS + j] = f2bf(a * sf); d0[(n0 + 2 * e + 1) * TS + j] = f2bf(b * sf); d1[(n0 + 2 * e) * TS + j] = f2bf(a * sb); d1[(n0 + 2 * e + 1) * TS + j] = f2bf(b * sb); }
        } }
}
DEVI void scanA_unit(const P& p, int l, int uidx, unsigned char* lds) {
    const int tid = otid(), wid = __builtin_amdgcn_readfirstlane(tid >> 6), lane = tid & 63, r32 = lane & 31, hi = lane >> 5;
    const int g4 = uidx % 3, bc = uidx / 3, b = bc / NCC, cc = bc % NCC, row0 = chunk_row0(b, cc);
    const bool ret = (g4 == 0);
    float* vec = (float*)(lds + SC_VEC); bf16* Kt = (bf16*)(lds + SC_KT); bf16* Vf = (bf16*)(lds + SC_VF); bf16* Vb = (bf16*)(lds + SC_VB);
    float* ST = (float*)(p.ws + WS_ST); float* CDp = (float*)(p.ws + WS_CD);
    for (int hq = 0; hq < 4; ++hq) {
        const int h = ret ? hq : (g4 - 1) * 4 + hq, hh = ret ? hq : 4 + h; const size_t item = (size_t)(b * NCC + cc) * 12 + hh;
        const bf16 *qb, *kb, *vb; int ld; scan_ptrs(p, ret, h, qb, kb, vb, ld);
        __syncthreads();
        scan_vectors(p, l, ret, h, row0, vec, wid, lane);
        __syncthreads();
        if (ret || hq == 0) stage_T<false>(kb, ld, row0, Kt, nullptr, vec, tid);
        stage_T<true>(vb, ld, row0, Vf, Vb, vec, tid);
        if (tid == 0) { CDp[item * 2] = __expf(vec[127]); CDp[item * 2 + 1] = __expf(vec[128]); }
        if (tid < 128) { float* vg = (float*)(p.ws + WS_VEC) + item * 512; vg[tid] = vec[tid]; vg[128 + tid] = vec[128 + tid]; vg[256 + tid] = vec[tid] - __logf(vec[256 + tid]); vg[384 + tid] = vec[128 + tid] - __logf(vec[384 + tid]); }
        __syncthreads();
        const int dir = wid >> 2, nt = (wid >> 1) & 1, pt = wid & 1; const bf16* Vd = dir ? Vb : Vf;
        f32x16 acc;
#pragma unroll
        for (int r = 0; r < 16; ++r) acc[r] = 0.f;
#pragma unroll
        for (int s = 0; s < 8; ++s) { const bf16x8 a = *(const bf16x8*)(Kt + (nt * 32 + r32) * TS + s * 16 + hi * 8), bb = *(const bf16x8*)(Vd + (pt * 32 + r32) * TS + s * 16 + hi * 8);
            acc = __builtin_amdgcn_mfma_f32_32x32x16_bf16(a, bb, acc, 0, 0, 0); }
        float* o = ST + (item * 2 + dir) * 4096 + (size_t)(pt * 32 + r32) * 64 + nt * 32 + 4 * hi;
#pragma unroll
        for (int g = 0; g < 4; ++g) *(f32x4*)(o + 8 * g) = (f32x4){acc[4 * g], acc[4 * g + 1], acc[4 * g + 2], acc[4 * g + 3]};
    }
    __syncthreads();
}
DEVI void scanB_unit(const P& p, int uidx) {
    const int tid = otid(); const int bhd = uidx >> 2, dir = bhd & 1, bh = bhd >> 1, b = bh / 12, hh = bh % 12; const int e = (uidx & 3) * 1024 + tid * 2;
    const float* ST = (const float*)(p.ws + WS_ST); const float* CDp = (const float*)(p.ws + WS_CD); bf16* HT = (bf16*)(p.ws + WS_HT);
    f32x2 H = {0.f, 0.f};
    for (int base = 0; base < NCC; base += 6) {
        f32x2 s[6]; float d[6]; size_t off[6];
#pragma unroll
        for (int i = 0; i < 6; ++i) { const int step = base + i; const int cc = dir == 0 ? step : (step < 2 ? 1 - step : 67 - step);
            const size_t item = (size_t)(b * NCC + cc) * 12 + hh; off[i] = (item * 2 + dir) * 4096 + e; s[i] = *(const f32x2*)(ST + off[i]); d[i] = CDp[item * 2 + dir]; }
#pragma unroll
        for (int i = 0; i < 6; ++i) { *(unsigned*)(HT + off[i]) = pk2(H[0], H[1]); H = H * d[i] + s[i]; }
    }
}
constexpr int C3_RSV = 192, C3_RSK = 144;
constexpr int C3_V = 0, C3_K = 2 * 128 * C3_RSV, C3_H = C3_K + 2 * 128 * C3_RSK, C3_VEC = C3_H + 2 * 128 * C3_RSK, C3_X = C3_VEC + 2 * 2048, C3_END = C3_X + 1024;
DEVI void c3_stage_rows(unsigned char* dst, int rs, const bf16* src, int ld, int tid) {
#pragma unroll
    for (int i = 0; i < 2; ++i) { const int piece = tid + NTHREADS * i, row = piece >> 3, part = piece & 7; *(u32x4*)(dst + row * rs + part * 16) = *(const u32x4*)(src + (size_t)row * ld + part * 8); }
}
template <bool RET>
DEVI void scanC_unit(const P& p, int l, int bc, unsigned char* lds, int tid, int wid, int lane) {
    const int r32 = lane & 31, hi = lane >> 5;
    const int it_ = wid & 3, hsub = wid >> 2, b = bc / NCC, cc = bc % NCC, row0 = chunk_row0(b, cc);
    const bf16* HT = (const bf16*)(p.ws + WS_HT); const bf16* proj = (const bf16*)(p.ws + WS_PROJ); const bf16* xbc = (const bf16*)(p.ws + WS_XBC); bf16* MIX = (bf16*)(p.ws + WS_HM); const float* VECG = (const float*)(p.ws + WS_VEC);
    const int i = it_ * 32 + r32; const size_t rowi = (size_t)(row0 + i);
    constexpr int ld = RET ? INWP : 768;
    const unsigned char* Vl = lds + C3_V + hsub * 128 * C3_RSV; const unsigned char* Kl = lds + C3_K + hsub * 128 * C3_RSK; const unsigned char* Hl = lds + C3_H + hsub * 128 * C3_RSK; const float* vec = (const float*)(lds + C3_VEC + hsub * 2048);
    const int trq = (lane & 15) >> 2, trp = lane & 3, trg = (lane >> 4) & 1;
    const int troff = (4 * hi + trq) * C3_RSV + (16 * trg + 4 * trp) * 2;
    float ssq = 0.f;
#pragma unroll 1
    for (int step = 0; step < (RET ? 2 : 4); ++step) {
        __syncthreads();
#pragma unroll
        for (int hs = 0; hs < 2; ++hs) { const int h = RET ? hs * 2 + step : hs * 4 + step, hh = RET ? h : 4 + h; const size_t item = (size_t)(b * NCC + cc) * 12 + hh;
            const bf16* vb = RET ? proj + C_RV + h * 64 : xbc + h * 64; const bf16* kb = RET ? proj + C_RK + h * 64 : xbc + 512 + hs * 64;
            c3_stage_rows(lds + C3_V + hs * 128 * C3_RSV, C3_RSV, vb + (size_t)row0 * ld, ld, tid);
            if (RET || step == 0) c3_stage_rows(lds + C3_K + hs * 128 * C3_RSK, C3_RSK, kb + (size_t)row0 * ld, ld, tid);
            c3_stage_rows(lds + C3_H + hs * 128 * C3_RSK, C3_RSK, HT + item * 2 * 4096, 64, tid);
            if ((tid >> 7) == hs) *(u32x4*)(lds + C3_VEC + hs * 2048 + (tid & 127) * 16) = *(const u32x4*)(VECG + item * 512 + (tid & 127) * 4); }
        __syncthreads();
        const int h = RET ? hsub * 2 + step : hsub * 4 + step;
        const bf16* qb = RET ? proj + C_RQ + h * 64 : xbc + 640 + hsub * 64;
        bf16x8 qf[4];
#pragma unroll
        for (int s = 0; s < 4; ++s) qf[s] = *(const bf16x8*)(qb + rowi * ld + s * 16 + hi * 8);
        const float Afi = vec[i], Bbi = vec[128 + i];
        f32x16 y0, y1;
#pragma unroll
        for (int r = 0; r < 16; ++r) { y0[r] = 0.f; y1[r] = 0.f; }
#pragma unroll 2
        for (int jt = 0; jt < 4; ++jt) {
            f32x16 st;
#pragma unroll
            for (int r = 0; r < 16; ++r) st[r] = 0.f;
#pragma unroll
            for (int s = 0; s < 4; ++s) { const bf16x8 kf = *(const bf16x8*)(Kl + (jt * 32 + r32) * C3_RSK + (s * 16 + hi * 8) * 2); st = __builtin_amdgcn_mfma_f32_32x32x16_bf16(kf, qf[s], st, 0, 0, 0); }
#pragma unroll
            for (int g = 0; g < 4; ++g) { const int j0 = jt * 32 + 8 * g + 4 * hi;
                const f32x4 afp = *(const f32x4*)(vec + 256 + j0), bbp = *(const f32x4*)(vec + 384 + j0);
#pragma unroll
                for (int e = 0; e < 4; ++e) { const int j = j0 + e; float f;
                    if (jt < it_) f = __expf(Afi - afp[e]);
                    else if (jt > it_) f = __expf(Bbi - bbp[e]);
                    else { const float ff = (j <= i) ? __expf(Afi - afp[e]) : 0.f; const bool bm = RET ? (j > i) : (j >= i); const float fb = bm ? __expf(Bbi - bbp[e]) : 0.f; f = ff + fb; }
                    st[4 * g + e] *= f; } }
#pragma unroll
            for (int s2 = 0; s2 < 2; ++s2) {
                u32x4 pw; pw.x = pk2(st[8 * s2 + 0], st[8 * s2 + 1]); pw.y = pk2(st[8 * s2 + 2], st[8 * s2 + 3]); pw.z = pk2(st[8 * s2 + 4], st[8 * s2 + 5]); pw.w = pk2(st[8 * s2 + 6], st[8 * s2 + 7]);
                const bf16x8 pb = __builtin_bit_cast(bf16x8, pw);
#pragma unroll
                for (int pt = 0; pt < 2; ++pt) { const unsigned char* vp = Vl + (jt * 32 + 16 * s2) * C3_RSV + pt * 64 + troff;
                    const v4i16_t lo = lds_tr(vp), hi2 = lds_tr(vp + 8 * C3_RSV);
                    const bf16x8 va = {lo[0], lo[1], lo[2], lo[3], hi2[0], hi2[1], hi2[2], hi2[3]};
                    if (pt == 0) y0 = __builtin_amdgcn_mfma_f32_32x32x16_bf16(va, pb, y0, 0, 0, 0); else y1 = __builtin_amdgcn_mfma_f32_32x32x16_bf16(va, pb, y1, 0, 0, 0); }
            }
        }
        { const float ef = __expf(Afi), eb = __expf(Bbi);
#pragma unroll
          for (int pt = 0; pt < 2; ++pt) { f32x16 tf, tb;
#pragma unroll
              for (int r = 0; r < 16; ++r) { tf[r] = 0.f; tb[r] = 0.f; }
              const unsigned char* hf = Hl + (pt * 32 + r32) * C3_RSK + hi * 16;
#pragma unroll
              for (int s = 0; s < 4; ++s) { tf = __builtin_amdgcn_mfma_f32_32x32x16_bf16(*(const bf16x8*)(hf + s * 32), qf[s], tf, 0, 0, 0); tb = __builtin_amdgcn_mfma_f32_32x32x16_bf16(*(const bf16x8*)(hf + 64 * C3_RSK + s * 32), qf[s], tb, 0, 0, 0); }
#pragma unroll
              for (int r = 0; r < 16; ++r) { if (pt == 0) y0[r] += ef * tf[r] + eb * tb[r]; else y1[r] += ef * tf[r] + eb * tb[r]; } } }
        if (RET) {
            float s1 = 0.f, s2 = 0.f;
#pragma unroll
            for (int r = 0; r < 16; ++r) { y0[r] *= 0.125f; y1[r] *= 0.125f; s1 += y0[r] + y1[r]; s2 += y0[r] * y0[r] + y1[r] * y1[r]; }
            s1 += __shfl_xor(s1, 32); s2 += __shfl_xor(s2, 32);
            const float mu = s1 * (1.f / 64.f), var = fmaxf(s2 * (1.f / 64.f) - mu * mu, 0.f), rs = 1.0f / sqrtf(var + EPS);
#pragma unroll
            for (int pt = 0; pt < 2; ++pt)
#pragma unroll
                for (int g = 0; g < 4; ++g) { const int p0 = pt * 32 + 8 * g + 4 * hi; const u32x2 gg = *(const u32x2*)(proj + rowi * INWP + C_RG + h * 64 + p0);
                    const f32x4 gv = {bf2f(gg.x & 0xffff), bf2f(gg.x >> 16), bf2f(gg.y & 0xffff), bf2f(gg.y >> 16)}; f32x4 o;
#pragma unroll
                    for (int e = 0; e < 4; ++e) o[e] = ((pt ? y1[4 * g + e] : y0[4 * g + e]) - mu) * rs * siluf(gv[e]);
                    st_bf16x4(MIX + rowi * D + 256 + h * 64 + p0, o); }
        } else {
            const float dsk = IN(20)[l * 8 + h];
#pragma unroll
            for (int pt = 0; pt < 2; ++pt)
#pragma unroll
                for (int g = 0; g < 4; ++g) { const int p0 = pt * 32 + 8 * g + 4 * hi; const u32x2 xx = *(const u32x2*)(xbc + rowi * 768 + h * 64 + p0), zz = *(const u32x2*)(proj + rowi * INWP + C_Z + h * 64 + p0);
                    const f32x4 xv = {bf2f(xx.x & 0xffff), bf2f(xx.x >> 16), bf2f(xx.y & 0xffff), bf2f(xx.y >> 16)}, zv = {bf2f(zz.x & 0xffff), bf2f(zz.x >> 16), bf2f(zz.y & 0xffff), bf2f(zz.y >> 16)}; f32x4 o;
#pragma unroll
                    for (int e = 0; e < 4; ++e) { o[e] = ((pt ? y1[4 * g + e] : y0[4 * g + e]) + xv[e] * dsk) * siluf(zv[e]); ssq += o[e] * o[e]; }
                    st_bf16x4(MIX + rowi * D + 512 + h * 64 + p0, o); }
        }
    }
    if (!RET) {
        float* X = (float*)(lds + C3_X);
        ssq += __shfl_xor(ssq, 32);
        if (hi == 0) X[hsub * 128 + i] = ssq;
        asm volatile("s_waitcnt vmcnt(0)" ::: "memory");
        __syncthreads();
        const float tot = X[i] + X[128 + i];
        const float rstd = 1.0f / sqrtf(tot * (1.f / 512.f) + EPS); const float* nw = IN(21) + l * 512;
#pragma unroll 1
        for (int h = hsub * 4; h < hsub * 4 + 4; ++h)
#pragma unroll
            for (int pt = 0; pt < 2; ++pt)
#pragma unroll
                for (int g = 0; g < 4; ++g) { const int c0 = h * 64 + pt * 32 + 8 * g + 4 * hi; bf16* mp = MIX + rowi * D + 512 + c0; const u32x2 v = *(const u32x2*)mp; const f32x4 w = *(const f32x4*)(nw + c0);
                    st_bf16x4(mp, (f32x4){bf2f(v.x & 0xffff) * rstd * w[0], bf2f(v.x >> 16) * rstd * w[1], bf2f(v.y & 0xffff) * rstd * w[2], bf2f(v.y >> 16) * rstd * w[3]}); }
    }
    __syncthreads();
}
DEVI void ph_scanC(const P& p, int l, unsigned char* lds) {
    const int tid = otid(), wid = __builtin_amdgcn_readfirstlane(tid >> 6), lane = tid & 63;
    for (int u = blockIdx.x; u < 2 * 2 * NCC; u += gridDim.x) { if (u < 2 * NCC) scanC_unit<false>(p, l, u, lds, tid, wid, lane); else scanC_unit<true>(p, l, u - 2 * NCC, lds, tid, wid, lane); }
}
DEVI void ph_scanA(const P& p, int l, unsigned char* lds) { for (int u = blockIdx.x; u < 2 * NCC * 3; u += gridDim.x) scanA_unit(p, l, u, lds); }
DEVI void ph_mixer(const P& p, int l, unsigned char* lds) {
    for (int u = blockIdx.x; u < 192; u += gridDim.x) scanB_unit(p, u);
    for (int a = blockIdx.x; a < 256; a += gridDim.x) attn_unit(p, (a & 7) * 32 + (a >> 3), lds);
    if (l == 0) for (int a = blockIdx.x; a < 8; a += gridDim.x) attn_unit(p, 256 + a, lds);
}

DEVI void ph_sort(const P& p, unsigned char* lds) {
    const int tid = otid(), wid = tid >> 6, lane = tid & 63;
    const int* rt_e = (const int*)(p.ws + WS_RT); int* rt_pos = (int*)(p.ws + WS_RT + 256 * 1024); int* tab = (int*)(p.ws + WS_RT + 384 * 1024);
    const bf16* H = (const bf16*)(p.ws + WS_HM); bf16* HS = (bf16*)(p.ws + WS_HS);
    int* sh = (int*)lds;
    const int G = gridDim.x, R = (NLAT + G - 1) / G;
    for (int blk = blockIdx.x; blk * R < NLAT; blk += G) {
        const int r0 = blk * R, r1 = (r0 + R < NLAT) ? r0 + R : NLAT;
        int ct[8], cb[8];
#pragma unroll
        for (int e = 0; e < 8; ++e) { ct[e] = 0; cb[e] = 0; }
        for (int i = tid; i < NLAT * 2; i += NTHREADS) { const int e = rt_e[i]; const bool bef = (i >> 1) < r0;
#pragma unroll
            for (int x = 0; x < 8; ++x) { const int hit = (e == x) ? 1 : 0; ct[x] += hit; cb[x] += bef ? hit : 0; } }
#pragma unroll
        for (int e = 0; e < 8; ++e) {
#pragma unroll
            for (int o = 1; o < 64; o <<= 1) { ct[e] += __shfl_xor(ct[e], o); cb[e] += __shfl_xor(cb[e], o); }
        }
        __syncthreads();
        if (lane == 0) {
#pragma unroll
            for (int e = 0; e < 8; ++e) { sh[wid * 8 + e] = ct[e]; sh[64 + wid * 8 + e] = cb[e]; } }
        __syncthreads();
        if (tid == 0) { int start = 0, nt = 0;
            for (int e = 0; e < 8; ++e) { int tot = 0, bef = 0; for (int w = 0; w < 8; ++w) { tot += sh[w * 8 + e]; bef += sh[64 + w * 8 + e]; }
                sh[128 + e] = start; sh[136 + e] = start + bef; const int ntile = (tot + 255) >> 8;
                if (blk == 0) { for (int t = 0; t < ntile; ++t) tab[1 + nt + t] = e; }
                nt += ntile; start += ntile * 256; }
            if (blk == 0) tab[0] = nt; }
        __syncthreads();
        { const int n_ent = (r1 - r0) * 2; const bool valid = tid < n_ent; const int e = valid ? rt_e[r0 * 2 + tid] : -1; int rank = 0;
#pragma unroll
          for (int x = 0; x < 8; ++x) { const unsigned long long m = __ballot(e == x); if (e == x) rank = __popcll(m & ((1ull << lane) - 1ull)); if (lane == 0) sh[160 + wid * 8 + x] = __popcll(m); }
          __syncthreads();
          if (valid) { int pos = sh[136 + e] + rank; for (int w = 0; w < wid; ++w) pos += sh[160 + w * 8 + e]; sh[256 + tid] = pos; rt_pos[r0 * 2 + tid] = pos; } }
        __syncthreads();
        for (int i = wid; i < (r1 - r0) * 2; i += NWAVES) { const int row = r0 + (i >> 1), pos = sh[256 + i];
            const u32x4* s = (const u32x4*)(H + (size_t)row * D); u32x4* d = (u32x4*)(HS + (size_t)pos * D); d[lane] = s[lane]; d[lane + 64] = s[lane + 64]; }
        __syncthreads();
    }
}
DEVI void ph_final(const P& p) {
    const int tid = otid(), wid = tid >> 6, lane = tid & 63;
    const float* rt_g = (const float*)(p.ws + WS_RT + 128 * 1024); const int* rt_pos = (const int*)(p.ws + WS_RT + 256 * 1024);
    const bf16* YS = (const bf16*)(p.ws + WS_HS); const float* modv = (const float*)(p.ws + WS_MODV) + (size_t)1 * 3 * 6144; const float* fw = IN(29);
    const int nw = gridDim.x * NWAVES, rpw = (NLAT + nw - 1) / nw, gw = blockIdx.x * NWAVES + wid;
    const int row0 = gw * rpw, row1 = (row0 + rpw < NLAT) ? row0 + rpw : NLAT;
    f32x4 fwv[4], gv[4]; int rc = -1;
#pragma unroll
    for (int j = 0; j < 4; ++j) fwv[j] = *(const f32x4*)(fw + (j * 64 + lane) * 4);
    for (int row = row0; row < row1; ++row) {
        const int b = row >> 13; float* x = p.out + (size_t)row * D;
        if (b != rc) { rc = b;
#pragma unroll
            for (int j = 0; j < 4; ++j) gv[j] = *(const f32x4*)(modv + b * 6144 + 5 * 1024 + (j * 64 + lane) * 4); }
        const float g0 = rt_g[row * 2], g1 = rt_g[row * 2 + 1]; const bf16* y0 = YS + (size_t)rt_pos[row * 2] * D; const bf16* y1 = YS + (size_t)rt_pos[row * 2 + 1] * D;
        f32x4 v[4]; float ss = 0.f;
#pragma unroll
        for (int j = 0; j < 4; ++j) { const int c0 = (j * 64 + lane) * 4; const f32x4 xv = *(const f32x4*)(x + c0); const u32x2 a = *(const u32x2*)(y0 + c0), c = *(const u32x2*)(y1 + c0);
            const f32x4 ya = {bf2f(a.x & 0xffff), bf2f(a.x >> 16), bf2f(a.y & 0xffff), bf2f(a.y >> 16)}, yb = {bf2f(c.x & 0xffff), bf2f(c.x >> 16), bf2f(c.y & 0xffff), bf2f(c.y >> 16)};
            v[j] = xv + gv[j] * (ya * g0 + yb * g1); ss += v[j][0] * v[j][0] + v[j][1] * v[j][1] + v[j][2] * v[j][2] + v[j][3] * v[j][3]; }
        ss = wave_sum(ss); const float rstd = 1.0f / sqrtf(ss * (1.f / D) + EPS);
#pragma unroll
        for (int j = 0; j < 4; ++j) { const int c0 = (j * 64 + lane) * 4; *(f32x4*)(x + c0) = v[j] * rstd * fwv[j]; }
    }
}

#define XB_TMO      128
#define XB_XCNT(j)  (256  + 64 * (j))
#define XB_XSUB(j)  (1280 + 64 * (j))
#define XB_XGEN(j)  (2304 + 64 * (j))
#define XB_TOP      3328
#define XB_TOPGEN   3392
#define XCD_BAR_WORDS 3456
#define XB_SPIN_CAP (1u << 22)
DEVI unsigned xb_ld(unsigned* p)              { return __hip_atomic_load(p, __ATOMIC_RELAXED, __HIP_MEMORY_SCOPE_AGENT); }
DEVI unsigned xb_add(unsigned* p, unsigned v) { return __hip_atomic_fetch_add(p, v, __ATOMIC_RELAXED, __HIP_MEMORY_SCOPE_AGENT); }
DEVI unsigned xb_xcc_id() { return (unsigned)__builtin_amdgcn_s_getreg((3 << 11) | 20) & 0xFu; }
#define XB_SPIN(cond, bar) do { unsigned _sp = 0; while (cond) { __builtin_amdgcn_s_sleep(1); \
    if ((++_sp & 255u) == 0u) { if (xb_ld(&(bar)[XB_TMO])) break; if (_sp > XB_SPIN_CAP) { atomicAdd(&(bar)[XB_TMO], 1u); break; } } } } while (0)
struct XcdBarrier { unsigned* bar; unsigned x; volatile LAS unsigned* st; };
DEVI XcdBarrier xcd_barrier_post(unsigned* bar, volatile LAS unsigned* st) {
    XcdBarrier b; b.bar = bar; b.x = xb_xcc_id(); b.st = st;
    if (threadIdx.x == 0) (void)xb_add(&bar[XB_XCNT(b.x)], 1u);
    return b;
}
DEVI void xcd_barrier_complete(unsigned* bar, unsigned x, unsigned& nloc, unsigned& nx) {
    const unsigned G = gridDim.x * gridDim.y * gridDim.z;
    unsigned sum, cnt, mine, sp = 0u;
    for (;;) {
        sum = 0u; cnt = 0u; mine = 0u;
#pragma unroll
        for (unsigned j = 0; j < 16; ++j) { const unsigned c = xb_ld(&bar[XB_XCNT(j)]); sum += c; cnt += (c > 0u) ? 1u : 0u; mine = (j == x) ? c : mine; }
        if (sum == G) break;
        __builtin_amdgcn_s_sleep(1);
        if ((++sp & 255u) == 0u) { if (xb_ld(&bar[XB_TMO])) break; if (sp > XB_SPIN_CAP) { atomicAdd(&bar[XB_TMO], 1u); break; } }
    }
    nloc = mine > 0u ? mine : 1u; nx = cnt > 0u ? cnt : 1u;
}
DEVI void xcd_barrier(const XcdBarrier& b) {
    asm volatile("s_waitcnt vmcnt(0)" ::: "memory");
    __syncthreads();
    if (threadIdx.x == 0) {
        unsigned* bar = b.bar;
        __builtin_amdgcn_s_waitcnt(0);
        unsigned nloc = b.st[0], nx = b.st[1];
        if (nloc == 0u) { xcd_barrier_complete(bar, b.x, nloc, nx); b.st[0] = nloc; b.st[1] = nx; }
        const unsigned old = xb_add(&bar[XB_XSUB(b.x)], 1u);
        const unsigned gen = old / nloc;
        if (old + 1u == (gen + 1u) * nloc) {
            __builtin_amdgcn_fence(__ATOMIC_RELEASE, "agent");
            asm volatile("s_waitcnt vmcnt(0)" ::: "memory");
            const unsigned og = xb_add(&bar[XB_TOP], 1u);
            const unsigned tg = og / nx;
            if (og + 1u == (tg + 1u) * nx) xb_add(&bar[XB_TOPGEN], 1u);
            else XB_SPIN(xb_ld(&bar[XB_TOPGEN]) == tg, bar);
            __builtin_amdgcn_fence(__ATOMIC_ACQUIRE, "agent");
            xb_add(&bar[XB_XGEN(b.x)], 1u);
            asm volatile("s_waitcnt vmcnt(0)" ::: "memory");
        } else {
            XB_SPIN(xb_ld(&bar[XB_XGEN(b.x)]) == gen, bar);
            __builtin_amdgcn_fence(__ATOMIC_ACQUIRE, "agent");
            asm volatile("s_waitcnt vmcnt(0)" ::: "memory");
        }
    }
    __syncthreads();
}

constexpr int NPHASES = 24;
#ifndef XSYNC
#define XSYNC 0
#endif
#ifndef REP_MASK
#define REP_MASK 0u
#endif
#ifndef PH_MASK
#define PH_MASK 0xffffu
#endif
__global__ void __launch_bounds__(NTHREADS, 2) mk_fwd(P p) {
    extern __shared__ __attribute__((aligned(16))) unsigned char lds[];
    cg::grid_group grid = cg::this_grid();
    const int G = gridDim.x, c = blockIdx.x;
    if (threadIdx.x < 30) ((lds_u64*)(uintptr_t)LDS_PTRS)[threadIdx.x] = (unsigned long long)p.in[threadIdx.x];
    if (threadIdx.x < 2) ((volatile LAS unsigned*)(uintptr_t)LDS_MISC)[threadIdx.x] = 0u;
    __syncthreads();
    XcdBarrier xbar = xcd_barrier_post((unsigned*)(p.ws + WS_CTL) + 1024, (volatile LAS unsigned*)(uintptr_t)LDS_MISC);
    int nsync = 0;
#define GRID_BAR() do { if (nsync == 0) grid.sync(); else xcd_barrier(xbar); ++nsync; } while (0)
    int ph = 0;
#define RUN(kid, ...) do { if (((PH_MASK >> (kid)) & 1u) && ph >= p.ph_lo && ph < p.ph_hi) { __VA_ARGS__; if ((REP_MASK >> (kid)) & 1u) { __VA_ARGS__; } if (ph + 1 < p.ph_hi) { GRID_BAR(); for (int xs_ = 0; xs_ < XSYNC; ++xs_) GRID_BAR(); } } ++ph; } while (0)
    RUN(0, ph_pro(p, lds));
#define LAYER(l) \
        RUN(1, ph_norm<false>(p, l, 0, T, lds, l == 1 ? 11 : 0, 5)); \
        RUN(2, { Gemm g{(const bf16*)(p.ws + WS_HM), (const bf16*)(p.ws + WS_WIN) + (size_t)l * INWP * 1024, 0}; DenseSched S{T / 256, INWP / 256, G, c}; \
            EpiInProj E{(bf16*)(p.ws + WS_PROJ), (float*)(p.ws + WS_DT), IN(18) + l * 16, IN(19) + l * 16}; gemm_phase<D, 1024, 1024>(lds, g, S, E); }); \
        RUN(3, ph_conv(p, l)); \
        RUN(4, { Gemm g{(const bf16*)(p.ws + WS_PROJ), (const bf16*)(p.ws + WS_WQKV) + (size_t)l * 1024 * 384, 0}; DenseSched S{T / 256, 4, G, c}; \
            EpiMla E{(bf16*)(p.ws + WS_Q), (bf16*)(p.ws + WS_K), (bf16*)(p.ws + WS_V), (const float*)(p.ws + WS_RQ), (const float*)(p.ws + WS_RKV), (const float*)(p.ws + WS_ROPE)}; gemm_phase<INWP, 384, 384>(lds, g, S, E); ph_scanA(p, l, lds); }); \
        RUN(5, ph_mixer(p, l, lds)); \
        RUN(6, ph_scanC(p, l, lds)); \
        if (l == 1) RUN(7, ph_moew(p, lds)); \
        RUN(8, { Gemm g{(const bf16*)(p.ws + WS_HM), (const bf16*)(p.ws + WS_WOUT) + (size_t)l * 1024 * 1024, 0}; DenseSched S{NLAT / 256, 4, G, c}; \
            EpiResid E{l == 0 ? IN(0) : p.out, (const float*)(p.ws + WS_XC), p.out, (float*)(p.ws + WS_XC), (const float*)(p.ws + WS_MODV) + (size_t)l * 3 * 6144, 2}; gemm_phase<D, 1024, 1024>(lds, g, S, E); \
            if (l == 0) { CtxSplitSched S2{4, 256 * 2, G, c}; EpiPart E2{(float*)(p.ws + WS_XBC)}; gemm_phase<D, 1024, 256>(lds, g, S2, E2); } }); \
        RUN(9, ph_norm<l == 1>(p, l, 1, l == 0 ? T : NLAT, lds, l == 0 ? 4 : 0, 2)); \
        if (l == 0) { \
            RUN(10, { Gemm g{(const bf16*)(p.ws + WS_HM), (const bf16*)(p.ws + WS_WGU), 0}; DenseSched S{T / 256, 2 * DFF / 256, G, c}; \
                EpiSwiglu E{(bf16*)(p.ws + WS_PROJ), DFF}; gemm_phase<D, 1024, 1024>(lds, g, S, E); }); \
            RUN(11, { Gemm g{(const bf16*)(p.ws + WS_PROJ), (const bf16*)(p.ws + WS_WD), 0}; DenseSched S{NLAT / 256, 4, G, c}; \
                EpiResid E{p.out, (const float*)(p.ws + WS_XC), p.out, (float*)(p.ws + WS_XC), (const float*)(p.ws + WS_MODV), 5}; gemm_phase<DFF, DFF, DFF>(lds, g, S, E); \
                CtxSplitSched S2{11, 256 * 2, G, c}; EpiPart E2{(float*)(p.ws + WS_XBC)}; gemm_phase<DFF, DFF, 256>(lds, g, S2, E2); }); \
        } else { \
            RUN(12, ph_sort(p, lds)); \
            RUN(13, { Gemm g{(const bf16*)(p.ws + WS_HS), (const bf16*)(p.ws + WS_WGUE), (size_t)2 * DFE * 1024}; MoeSched S{(const int*)(p.ws + WS_RT + 384 * 1024), 2 * DFE / 256, G, c}; \
                EpiSwiglu E{(bf16*)(p.ws + WS_ACTS), DFE}; gemm_phase<D, 1024, 1024>(lds, g, S, E); }); \
            RUN(14, { Gemm g{(const bf16*)(p.ws + WS_ACTS), (const bf16*)(p.ws + WS_WDE), (size_t)1024 * DFE}; MoeSched S{(const int*)(p.ws + WS_RT + 384 * 1024), 4, G, c}; \
                EpiStore E{(bf16*)(p.ws + WS_HS), D}; gemm_phase<DFE, DFE, DFE>(lds, g, S, E); }); \
            RUN(15, ph_final(p)); \
        }
    LAYER(0)
    LAYER(1)
#undef LAYER
#undef RUN
}

#ifndef MK_ONE_LAUNCH
#define MK_ONE_LAUNCH 1
#endif
extern "C" void kernel_launch(void* const* d_in, const int* in_sizes, int n_in, void* d_out, int out_size, void* d_ws, size_t ws_size, hipStream_t stream) {
    static int grid = 0;
    if (grid == 0) {
        if (n_in != 30 || out_size != NLAT * D || ws_size < WS_END) { fprintf(stderr, "kernel_launch: unexpected problem (n_in %d out %d ws %zu, need %zu)\n", n_in, out_size, ws_size, (size_t)WS_END); grid = -1; return; }
        int dev = 0, cus = 0, per_cu = 0;
        hipGetDevice(&dev); hipDeviceGetAttribute(&cus, hipDeviceAttributeMultiprocessorCount, dev);
        if (hipFuncSetAttribute((const void*)mk_fwd, hipFuncAttributeMaxDynamicSharedMemorySize, LDS_BYTES) != hipSuccess) { fprintf(stderr, "kernel_launch: hipFuncSetAttribute failed\n"); grid = -1; return; }
        if (hipOccupancyMaxActiveBlocksPerMultiprocessor(&per_cu, (const void*)mk_fwd, NTHREADS, LDS_BYTES) != hipSuccess || per_cu < 1) { fprintf(stderr, "kernel_launch: occupancy query failed (%d)\n", per_cu); grid = -1; return; }
        grid = cus;
        fprintf(stderr, "kernel_launch: grid %d (cus %d, per_cu %d)\n", grid, cus, per_cu);
    }
    if (grid < 0) return;
    if (hipMemsetAsync((char*)d_ws + WS_CTL, 0, 65536, stream) != hipSuccess) { fprintf(stderr, "kernel_launch: memset failed\n"); return; }
    P p{};
    for (int i = 0; i < 30; ++i) p.in[i] = (const float*)d_in[i];
    p.out = (float*)d_out; p.ws = (unsigned char*)d_ws;
#if MK_ONE_LAUNCH
    p.ph_lo = 0; p.ph_hi = NPHASES;
    { void* args[] = {&p}; hipError_t e = hipLaunchCooperativeKernel((const void*)mk_fwd, dim3(grid), dim3(NTHREADS), args, LDS_BYTES, stream);
      if (e != hipSuccess) fprintf(stderr, "cooperative launch failed: %s\n", hipGetErrorString(e)); }
#else
    for (int ph = 0; ph < NPHASES; ++ph) {
        p.ph_lo = ph; p.ph_hi = ph + 1;
        void* args[] = {&p}; hipError_t e = hipLaunchCooperativeKernel((const void*)mk_fwd, dim3(grid), dim3(NTHREADS), args, LDS_BYTES, stream);
        if (e != hipSuccess) { fprintf(stderr, "cooperative launch %d failed: %s\n", ph, hipGetErrorString(e)); break; }
    }
#endif
}
```

```cpp
#include <hip/hip_runtime.h>
#include <hip/hip_cooperative_groups.h>
#include <cstdio>
#include <cstdint>
namespace cg = cooperative_groups;

#define DEVI __device__ __forceinline__
typedef unsigned short bf16;
typedef short bf16x8 __attribute__((ext_vector_type(8)));
typedef float f32x4 __attribute__((ext_vector_type(4)));
typedef float f32x2 __attribute__((ext_vector_type(2)));
typedef float f32x16 __attribute__((ext_vector_type(16)));
typedef unsigned u32x4 __attribute__((ext_vector_type(4)));
typedef unsigned u32x2 __attribute__((ext_vector_type(2)));
typedef __bf16 bf16x2_t __attribute__((ext_vector_type(2)));

constexpr int D = 1024, NB = 2, SEQ = 8192, NLAT = NB * SEQ, CL = 256, NCTX = NB * CL, T = NLAT + NCTX;
constexpr int INW = 2736, INWP = 2816;
constexpr int C_CQ = 0, C_CKV = 256, C_KPE = 384, C_RQ = 416, C_RK = 672, C_RV = 928, C_RG = 1184, C_Z = 1440, C_XBC = 1952, C_DTF = 2720, C_DTB = 2728;
constexpr int DFF = 2816, DFE = 1408, NEXP = 8;
constexpr float EPS = 1e-6f;
constexpr int MOE_MAXROWS = 34816;

constexpr size_t MiB = 1u << 20;
constexpr size_t WS_CTL = 0;
constexpr size_t WS_MODV = 1 * MiB;
constexpr size_t WS_ROPE = WS_MODV + 256 * 1024;
constexpr size_t WS_RQ = WS_MODV + 512 * 1024;
constexpr size_t WS_RKV = WS_MODV + 640 * 1024;
constexpr size_t WS_WIN = 2 * MiB;
constexpr size_t WS_WQKV = 13 * MiB;
constexpr size_t WS_WOUT = 15 * MiB;
constexpr size_t WS_WGU = 19 * MiB;
constexpr size_t WS_WD = 30 * MiB;
constexpr size_t WS_XC = 36 * MiB;
constexpr size_t WS_RT = 38 * MiB;
constexpr size_t WS_DT = 39 * MiB;
constexpr size_t DYN = 42 * MiB;
constexpr size_t WS_HM = DYN;
constexpr size_t WS_PROJ = DYN + 33 * MiB;
constexpr size_t WS_XBC = DYN + 124 * MiB;
constexpr size_t WS_Q = DYN + 149 * MiB;
constexpr size_t WS_K = DYN + 161 * MiB + 512 * 1024;
constexpr size_t WS_V = DYN + 174 * MiB;
constexpr size_t WS_ST = DYN + 182 * MiB + 512 * 1024;
constexpr size_t WS_HT = WS_ST + (size_t)1584 * 2 * 4096 * 4;
constexpr size_t WS_CD = WS_RT + 512 * 1024;
constexpr size_t WS_VEC = WS_HT + (size_t)1584 * 2 * 4096 * 2;
constexpr size_t WS_WGUE = DYN + 33 * MiB;
constexpr size_t WS_WDE = DYN + 77 * MiB;
constexpr size_t WS_HS = DYN + 99 * MiB;
constexpr size_t WS_ACTS = DYN + 167 * MiB;
constexpr size_t WS_END = DYN + 261 * MiB;
static_assert(WS_HM + (size_t)T * 1024 * 2 <= WS_PROJ && WS_PROJ + (size_t)T * 2816 * 2 <= WS_XBC && WS_XBC + (size_t)T * 768 * 2 <= WS_Q &&
              WS_Q + (size_t)T * 384 * 2 <= WS_K && WS_K + (size_t)T * 384 * 2 <= WS_V && WS_V + (size_t)T * 256 * 2 <= WS_ST && WS_VEC + (size_t)1584 * 512 * 4 <= WS_END, "ws map (mixer)");
static_assert(WS_WGUE + (size_t)8 * 2816 * 1024 * 2 <= WS_WDE && WS_WDE + (size_t)8 * 1024 * 1408 * 2 <= WS_HS && WS_HS + (size_t)MOE_MAXROWS * 1024 * 2 <= WS_ACTS &&
              WS_ACTS + (size_t)MOE_MAXROWS * 1408 * 2 <= WS_END, "ws map (moe)");
static_assert(WS_DT + (size_t)T * 32 * 4 <= DYN && WS_WD + (size_t)1024 * 2816 * 2 <= WS_XC && WS_WIN + (size_t)2 * 2816 * 1024 * 2 <= WS_WQKV, "ws map (static)");

constexpr int NTHREADS = 512, NWAVES = 8;
constexpr int LDS_BYTES = 147456;

struct P { const float* in[30]; float* out; unsigned char* ws; int ph_lo, ph_hi; };
constexpr int LDS_MISC = 147456 - 512;
constexpr int LDS_PTRS = 147456 - 256;
typedef __attribute__((address_space(3))) unsigned long long lds_u64;
DEVI const float* inptr(int i) {
    const unsigned long long v = ((lds_u64*)(uintptr_t)LDS_PTRS)[i];
    const unsigned lo = __builtin_amdgcn_readfirstlane((unsigned)v), hi = __builtin_amdgcn_readfirstlane((unsigned)(v >> 32));
    return (const float*)(((unsigned long long)hi << 32) | lo);
}
#define IN(i) inptr(i)
DEVI int otid() { int t = threadIdx.x; asm volatile("" : "+v"(t)); return t; }

DEVI float bf2f(bf16 x) { return __uint_as_float(((unsigned)x) << 16); }
DEVI unsigned pk2(float lo, float hi) { f32x2 v = {lo, hi}; bf16x2_t b = __builtin_convertvector(v, bf16x2_t); return __builtin_bit_cast(unsigned, b); }
DEVI bf16 f2bf(float x) { return (bf16)(pk2(x, 0.f) & 0xffffu); }
DEVI float wave_sum(float v) {
#pragma unroll
    for (int o = 1; o < 64; o <<= 1) v += __shfl_xor(v, o);
    return v;
}
DEVI float siluf(float x) { return x / (1.f + __expf(-x)); }
DEVI float softplusf(float x) { return fmaxf(x, 0.f) + log1pf(__expf(-fabsf(x))); }
DEVI int rope_src(int p) { const int q = p & 15, s = (q & 1) ? 8 + (q >> 1) : (q >> 1); return (p & 16) + s; }

#define LAS __attribute__((address_space(3)))
struct Unit { int pm, pn, e, koff; };
struct Gemm { const bf16* A; const bf16* Bt; size_t bstride; };
constexpr int BM = 256, BK = 64, HALF = 128, HTB = HALF * BK * 2, STAGE_BYTES = 8 * HTB, NXCD = 8, WGM = 8;
__host__ __device__ __forceinline__ int lds_byte(int r, int c) { const int st = (r >> 4) * 2 + (c >> 5), rr = r & 15, cc = c & 31, ob = rr * 64 + cc * 2; return st * 1024 + (ob ^ (((ob >> 9) & 1) << 5)); }
__host__ __device__ __forceinline__ void stage_rc(int b, int& R, int& C) { const int st = b / 1024, sb = b % 1024, swz = sb ^ (((sb >> 9) & 1) << 5); R = (st >> 1) * 16 + swz / 64; C = (st & 1) * 32 + (swz % 64) / 2; }
struct DenseSched {
    int nM, nN, G, c;
    DEVI bool next(int i, Unit& u) const {
        const int nwg = nM * nN; const long L = (long)i * G + c; if (L >= nwg) return false;
        int wgid = (int)L; { const int q = nwg / NXCD, r = nwg % NXCD, xcd = wgid % NXCD, off = wgid / NXCD; wgid = (xcd < r ? xcd * (q + 1) : r * (q + 1) + (xcd - r) * q) + off; }
        const int nig = WGM * nN, gid = wgid / nig, fm = gid * WGM, gsz = (nM - fm) < WGM ? (nM - fm) : WGM;
        u.pm = fm + ((wgid % nig) % gsz); u.pn = (wgid % nig) / gsz; u.e = 0; u.koff = 0; return true;
    }
};
struct CtxSplitSched {
    int nsplit, kbytes, G, c;
    DEVI bool next(int i, Unit& u) const { const int id = i * G + c; if (id >= 8 * nsplit) return false; const int tile = id & 7, ks = id >> 3; u.pm = 64 + (tile >> 2); u.pn = tile & 3; u.e = ks; u.koff = ks * kbytes; return true; }
};
struct MoeSched {
    const int* tab; int nN, G, c;
    DEVI bool next(int i, Unit& u) const { DenseSched d{tab[0], nN, G, c}; if (!d.next(i, u)) return false; u.e = tab[1 + u.pm]; return true; }
};
template <int LDA, int LDB, int KK, class Epi, class Sched>
DEVI void gemm_phase(unsigned char* lds_generic, const Gemm g, const Sched& S, const Epi& E) {
    LAS unsigned char* lds = (LAS unsigned char*)lds_generic;
    const int tid = otid(), wid = __builtin_amdgcn_readfirstlane(tid >> 6), lane = tid & 63, wr = wid >> 2, wc = wid & 3, fr = lane & 15, fq = lane >> 4;
    constexpr int nt = KK / BK; static_assert(KK % 128 == 0, "K must be a multiple of 128");
    unsigned voffA[2], voffB[2];
#pragma unroll
    for (int i = 0; i < 2; ++i) { int R, C; stage_rc(tid * 16 + i * 8192, R, C); voffA[i] = (unsigned)(R * LDA + C) * 2u; voffB[i] = (unsigned)(R * LDB + C) * 2u; }
    constexpr size_t kstep = (size_t)(BK * 2), hstepA = (size_t)HALF * LDA * 2, hstepB = (size_t)HALF * LDB * 2, tstepA = 2 * hstepA, tstepB = 2 * hstepB;
    const unsigned ldsw = (unsigned)wid * 1024u;
    const int aoff = lds_byte(wr * 64 + fr, fq * 8), boff = lds_byte(wc * 32 + fr, fq * 8);
#define PG8_SA(b, h) (((b) * 2 + (h)) * HTB)
#define PG8_SB(b, h) ((4 + (b) * 2 + (h)) * HTB)
#define PG8_STAGE(bufoff, gbase, voff) do { _Pragma("unroll") for (int _i = 0; _i < 2; ++_i) \
        __builtin_amdgcn_global_load_lds((const unsigned*)((const char*)(gbase) + (voff)[_i]), (LAS unsigned*)(lds + (bufoff) + ldsw + _i * 8192), 16, 0, 0); } while (0)
#define PG8_LDA(dst, b, h) do { _Pragma("unroll") for (int m = 0; m < 4; ++m) _Pragma("unroll") for (int k = 0; k < 2; ++k) dst[m][k] = *(const LAS bf16x8*)(lds + PG8_SA(b, h) + aoff + m * 2048 + k * 1024); } while (0)
#define PG8_LDB(dst, b, h) do { _Pragma("unroll") for (int n = 0; n < 2; ++n) _Pragma("unroll") for (int k = 0; k < 2; ++k) dst[n][k] = *(const LAS bf16x8*)(lds + PG8_SB(b, h) + boff + n * 2048 + k * 1024); } while (0)
#define PG8_MMA(ai, bj, At, Bt) do { __builtin_amdgcn_s_setprio(1); _Pragma("unroll") for (int m = 0; m < 4; ++m) _Pragma("unroll") for (int n = 0; n < 2; ++n) _Pragma("unroll") for (int k = 0; k < 2; ++k) \
        acc[ai][bj][m][n] = __builtin_amdgcn_mfma_f32_16x16x32_bf16(Bt[n][k], At[m][k], acc[ai][bj][m][n], 0, 0, 0); __builtin_amdgcn_s_setprio(0); } while (0)
#define PG8_WAIT_V(n) asm volatile("s_waitcnt vmcnt(" #n ")" ::: "memory")
#define PG8_WAIT_L(n) asm volatile("s_waitcnt lgkmcnt(" #n ")" ::: "memory")
#define PG8_BAR __builtin_amdgcn_s_barrier()
#define PG8_SCHED __builtin_amdgcn_sched_barrier(0)
    Unit cur, nxt; int ui = 0;
    if (!S.next(0, cur)) return;
    f32x4 acc[2][2][4][2];
#pragma unroll
    for (int a = 0; a < 2; ++a)
#pragma unroll
        for (int b = 0; b < 2; ++b)
#pragma unroll
            for (int m = 0; m < 4; ++m)
#pragma unroll
                for (int n = 0; n < 2; ++n) acc[a][b][m][n] = (f32x4){0.f, 0.f, 0.f, 0.f};
    bf16x8 At[4][2], B0[2][2], B1[2][2];
    const char* cA = (const char*)g.A + (size_t)cur.pm * tstepA + cur.koff; const char* cB = (const char*)(g.Bt + (size_t)cur.e * g.bstride) + (size_t)cur.pn * tstepB + cur.koff;
    PG8_WAIT_V(0); PG8_WAIT_L(0); __syncthreads();
    PG8_STAGE(PG8_SB(0, 0), cB, voffB); PG8_STAGE(PG8_SB(0, 1), cB + hstepB, voffB); PG8_STAGE(PG8_SA(0, 0), cA, voffA); PG8_STAGE(PG8_SA(0, 1), cA + hstepA, voffA);
    if (wr == 1) PG8_BAR;
    PG8_WAIT_V(2); PG8_BAR;
    PG8_STAGE(PG8_SB(1, 0), cB + kstep, voffB); PG8_STAGE(PG8_SA(1, 0), cA + kstep, voffA); PG8_STAGE(PG8_SB(1, 1), cB + hstepB + kstep, voffB);
    PG8_WAIT_V(6); PG8_BAR;
    for (;;) {
        const bool has_next = S.next(ui + 1, nxt);
        const char* nA = has_next ? (const char*)g.A + (size_t)nxt.pm * tstepA + nxt.koff : cA; const char* nB = has_next ? (const char*)(g.Bt + (size_t)nxt.e * g.bstride) + (size_t)nxt.pn * tstepB + nxt.koff : cB;
#pragma unroll 1
        for (int t = 0; t < nt; t += 2) {
            const bool last = (t == nt - 2);
            const char* a1 = cA + (size_t)(t + 1) * kstep;
            const char* a2 = last ? nA : cA + (size_t)(t + 2) * kstep; const char* b2 = last ? nB : cB + (size_t)(t + 2) * kstep;
            const char* a3 = a2 + kstep; const char* b3 = b2 + kstep;
            PG8_LDB(B0, 0, 0); PG8_LDB(B1, 0, 1); PG8_SCHED; PG8_LDA(At, 0, 0); PG8_STAGE(PG8_SA(1, 1), a1 + hstepA, voffA);
            PG8_WAIT_V(8); PG8_WAIT_L(0); PG8_BAR; PG8_MMA(0, 0, At, B0); PG8_MMA(0, 1, At, B1); PG8_BAR; PG8_SCHED;
            PG8_LDA(At, 0, 1); PG8_STAGE(PG8_SB(0, 0), b2, voffB); PG8_STAGE(PG8_SB(0, 1), b2 + hstepB, voffB); PG8_STAGE(PG8_SA(0, 0), a2, voffA);
            PG8_WAIT_V(8); PG8_WAIT_L(0); PG8_BAR; PG8_MMA(1, 0, At, B0); PG8_MMA(1, 1, At, B1); PG8_BAR; PG8_SCHED;
            PG8_LDB(B0, 1, 0); PG8_LDB(B1, 1, 1); PG8_SCHED; PG8_LDA(At, 1, 0); PG8_STAGE(PG8_SA(0, 1), a2 + hstepA, voffA);
            PG8_WAIT_V(8); PG8_WAIT_L(0); PG8_BAR; PG8_MMA(0, 0, At, B0); PG8_MMA(0, 1, At, B1); PG8_BAR; PG8_SCHED;
            PG8_LDA(At, 1, 1); PG8_STAGE(PG8_SB(1, 0), b3, voffB); PG8_STAGE(PG8_SB(1, 1), b3 + hstepB, voffB); PG8_STAGE(PG8_SA(1, 0), a3, voffA);
            PG8_WAIT_V(8); PG8_WAIT_L(0); PG8_BAR; PG8_MMA(1, 0, At, B0); PG8_MMA(1, 1, At, B1); PG8_BAR; PG8_SCHED;
        }
        if (wr == 0) PG8_BAR;
        E(acc, cur, wr, wc, fr, fq);
        if (!has_next) break;
#pragma unroll
        for (int a = 0; a < 2; ++a)
#pragma unroll
            for (int b = 0; b < 2; ++b)
#pragma unroll
                for (int m = 0; m < 4; ++m)
#pragma unroll
                    for (int n = 0; n < 2; ++n) acc[a][b][m][n] = (f32x4){0.f, 0.f, 0.f, 0.f};
        cur = nxt; cA = nA; cB = nB; ++ui;
        if (wr == 1) PG8_BAR;
    }
    PG8_WAIT_V(0);
    PG8_BAR;
#undef PG8_SA
#undef PG8_SB
#undef PG8_STAGE
#undef PG8_LDA
#undef PG8_LDB
#undef PG8_MMA
#undef PG8_WAIT_V
#undef PG8_WAIT_L
#undef PG8_BAR
#undef PG8_SCHED
}
#define EPI_LOOP_ROWS _Pragma("unroll") for (int ai = 0; ai < 2; ++ai) _Pragma("unroll") for (int m = 0; m < 4; ++m)
#define EPI_ROW (u.pm * 256 + ai * 128 + wr * 64 + m * 16 + fr)
#define EPI_COL(bj, n) (u.pn * 256 + (bj) * 128 + wc * 32 + (n) * 16 + fq * 4)

DEVI void st_bf16x4(bf16* p, f32x4 v) { u32x2 w; w.x = pk2(v[0], v[1]); w.y = pk2(v[2], v[3]); *(u32x2*)p = w; }

struct EpiInProj {
    bf16* proj; float* dt; const float* dt_bias; const float* a_log;
    DEVI void operator()(const f32x4 (&acc)[2][2][4][2], const Unit& u, int wr, int wc, int fr, int fq) const {
        EPI_LOOP_ROWS { const int row = EPI_ROW;
#pragma unroll
            for (int bj = 0; bj < 2; ++bj)
#pragma unroll
                for (int n = 0; n < 2; ++n) { const int col = EPI_COL(bj, n); const f32x4 v = acc[ai][bj][m][n];
                    if (col < C_DTF) st_bf16x4(proj + (size_t)row * INWP + col, v);
                    else if (col < INW) { const int j0 = col - C_DTF; f32x4 dv, lv;
#pragma unroll
                        for (int i = 0; i < 4; ++i) { const float d_ = softplusf(v[i] + dt_bias[j0 + i]); dv[i] = d_; lv[i] = -d_ * __expf(a_log[j0 + i]); }
                        *(f32x4*)(dt + (size_t)row * 32 + j0) = dv; *(f32x4*)(dt + (size_t)row * 32 + 16 + j0) = lv; } } }
    }
};
struct EpiMla {
    bf16 *Q, *K, *V; const float *rq, *rkv; const float* rope;
    DEVI void operator()(const f32x4 (&acc)[2][2][4][2], const Unit& u, int wr, int wc, int fr, int fq) const {
        EPI_LOOP_ROWS { const int row = EPI_ROW; const float sq = rq[row], skv = rkv[row];
#pragma unroll
            for (int bj = 0; bj < 2; ++bj)
#pragma unroll
                for (int n = 0; n < 2; ++n) { const int col = EPI_COL(bj, n); f32x4 v = acc[ai][bj][m][n];
                    if (col < 384) { v = v * sq; const int d = col % 96;
                        if (d >= 64 && row < NLAT) { const int pos = row & (SEQ - 1), gr = pos >> 6, gc = pos & 63, pp = (d - 64) >> 1;
#pragma unroll
                            for (int i = 0; i < 2; ++i) { const int pi = pp + i; const float* tb = (pi < 8) ? rope + (gr * 8 + pi) * 2 : rope + 2048 + (gc * 8 + (pi - 8)) * 2;
                                const float c = tb[0], s = tb[1], x0 = v[2 * i], x1 = v[2 * i + 1]; v[2 * i] = x0 * c - x1 * s; v[2 * i + 1] = x1 * c + x0 * s; } }
                        st_bf16x4(Q + (size_t)row * 384 + col, v); }
                    else if (col >= 512 && col < 768) { const int c = col - 512; st_bf16x4(K + (size_t)row * 384 + (c >> 6) * 96 + (c & 63), v * skv); }
                    else if (col >= 768) { st_bf16x4(V + (size_t)row * 256 + (col - 768), v * skv); } }
            asm volatile("" ::: "memory"); }
    }
};
struct EpiResid {
    const float* src_lat; const float* src_ctx; float* dst_lat; float* dst_ctx; const float* modv_l; int gidx;
    DEVI void operator()(const f32x4 (&acc)[2][2][4][2], const Unit& u, int wr, int wc, int fr, int fq) const {
        EPI_LOOP_ROWS { const int row = EPI_ROW; const bool lat = row < NLAT; const int r = lat ? (row >> 13) : 2;
            const float* s = lat ? src_lat + (size_t)row * D : src_ctx + (size_t)(row - NLAT) * D; float* d = lat ? dst_lat + (size_t)row * D : dst_ctx + (size_t)(row - NLAT) * D;
            const float* gp = modv_l + r * 6144 + gidx * 1024;
#pragma unroll
            for (int bj = 0; bj < 2; ++bj)
#pragma unroll
                for (int n = 0; n < 2; ++n) { const int col = EPI_COL(bj, n); const f32x4 gv = *(const f32x4*)(gp + col), sv = *(const f32x4*)(s + col);
                    *(f32x4*)(d + col) = sv + gv * acc[ai][bj][m][n]; } }
    }
};
struct EpiPart {
    float* part;
    DEVI void operator()(const f32x4 (&acc)[2][2][4][2], const Unit& u, int wr, int wc, int fr, int fq) const {
        EPI_LOOP_ROWS { const int row = EPI_ROW; float* d = part + ((size_t)u.e * NCTX + (row - NLAT)) * D;
#pragma unroll
            for (int bj = 0; bj < 2; ++bj)
#pragma unroll
                for (int n = 0; n < 2; ++n) *(f32x4*)(d + EPI_COL(bj, n)) = acc[ai][bj][m][n]; }
    }
};
struct EpiSwiglu {
    bf16* act; int ldc;
    DEVI void operator()(const f32x4 (&acc)[2][2][4][2], const Unit& u, int wr, int wc, int fr, int fq) const {
        EPI_LOOP_ROWS { const int row = EPI_ROW;
#pragma unroll
            for (int n = 0; n < 2; ++n) { const f32x4 gt = acc[ai][0][m][n], up = acc[ai][1][m][n]; f32x4 o;
#pragma unroll
                for (int i = 0; i < 4; ++i) o[i] = siluf(gt[i]) * up[i];
                st_bf16x4(act + (size_t)row * ldc + u.pn * 128 + wc * 32 + n * 16 + fq * 4, o); } }
    }
};
struct EpiStore {
    bf16* o; int ldc;
    DEVI void operator()(const f32x4 (&acc)[2][2][4][2], const Unit& u, int wr, int wc, int fr, int fq) const {
        EPI_LOOP_ROWS { const int row = EPI_ROW;
#pragma unroll
            for (int bj = 0; bj < 2; ++bj)
#pragma unroll
                for (int n = 0; n < 2; ++n) st_bf16x4(o + (size_t)row * ldc + EPI_COL(bj, n), acc[ai][bj][m][n]); }
    }
};

struct CvtSrc { const float* src; int ld; int ncols; bool perm; const float* ks; float sc; };
DEVI void cvt_tile(const CvtSrc t, bf16* dst, int Kd, int nd0, int kd0, LAS float* scr, int lane) {
    const int n = lane & 31;
    if (t.src) {
        const int nc = (n < t.ncols) ? n : t.ncols - 1; const float msk = (n < t.ncols) ? t.sc : 0.f;
        const float* sp0 = t.src + (size_t)(lane >> 5) * t.ld + nc;
        float v[32];
#pragma unroll
        for (int i = 0; i < 32; ++i) v[i] = sp0[(size_t)(2 * i) * t.ld];
        if (t.ks) {
#pragma unroll
            for (int i = 0; i < 32; ++i) v[i] *= t.ks[2 * i + (lane >> 5)];
        }
#pragma unroll
        for (int i = 0; i < 32; ++i) scr[(2 * i + (lane >> 5)) * 33 + n] = v[i] * msk;
    } else {
#pragma unroll 8
        for (int i = 0; i < 32; ++i) scr[(2 * i + (lane >> 5)) * 33 + n] = 0.f;
    }
    asm volatile("s_waitcnt lgkmcnt(0)" ::: "memory");
    const int c = lane & 7;
#pragma unroll
    for (int j = 0; j < 4; ++j) { const int nn = (lane >> 3) + 8 * j; const LAS float* sp = scr + (8 * c) * 33 + (t.perm ? rope_src(nn) : nn);
        u32x4 o; o.x = pk2(sp[0 * 33], sp[1 * 33]); o.y = pk2(sp[2 * 33], sp[3 * 33]); o.z = pk2(sp[4 * 33], sp[5 * 33]); o.w = pk2(sp[6 * 33], sp[7 * 33]);
        *(u32x4*)(dst + (size_t)(nd0 + nn) * Kd + kd0 + 8 * c) = o; }
    asm volatile("s_waitcnt lgkmcnt(0)" ::: "memory");
}
template <class F>
DEVI void cvt_job(bf16* dst, int Nd, int Kd, F f, LAS float* scr, int gw, int ngw, int lane) {
    const int ntn = Nd >> 5, ntk = Kd >> 6;
    for (int it = gw; it < ntn * ntk; it += ngw) { const int nt = it % ntn, kt = it / ntn; cvt_tile(f(nt, kt), dst, Kd, nt * 32, kt * 64, scr, lane); }
}
DEVI void ph_pro(const P& p, unsigned char* lds) {
    const int tid = otid(), wid = tid >> 6, lane = tid & 63;
    __syncthreads();
    float* modv = (float*)(p.ws + WS_MODV);
    float* red = (float*)lds;
    for (int item = blockIdx.x; item < 192; item += gridDim.x) {
        const int l = item / 96, n = (item % 96) * 64 + lane;
        const float* W = IN(4) + (size_t)l * 1024 * 6144;
        float a0 = 0.f, a1 = 0.f, a2 = 0.f;
        for (int k = wid * 128; k < wid * 128 + 128; ++k) {
            const float w = W[(size_t)k * 6144 + n];
            a0 += siluf(IN(1)[k]) * w; a1 += siluf(IN(1)[1024 + k]) * w; a2 += siluf(IN(3)[k]) * w;
        }
        red[(wid * 3 + 0) * 64 + lane] = a0; red[(wid * 3 + 1) * 64 + lane] = a1; red[(wid * 3 + 2) * 64 + lane] = a2;
        __syncthreads();
        if (tid < 192) { const int r = tid >> 6, ln = tid & 63; float s = 0.f;
            for (int w = 0; w < 8; ++w) s += red[(w * 3 + r) * 64 + ln];
            const int nn = (item % 96) * 64 + ln; modv[(l * 3 + r) * 6144 + nn] = s + IN(5)[l * 6144 + nn]; }
        __syncthreads();
    }
    if (blockIdx.x == gridDim.x - 1) {
        float* rope = (float*)(p.ws + WS_ROPE);
        for (int idx = tid; idx < 1536; idx += NTHREADS) {
            const int i = idx & 7, pos = (idx < 1024) ? (idx >> 3) : ((idx - 1024) >> 3);
            const float invf = (i == 0) ? 1.f : (i == 1) ? 0.31622776601683794f : (i == 2) ? 0.1f : (i == 3) ? 0.03162277660168379f : (i == 4) ? 0.01f : (i == 5) ? 0.003162277660168379f : (i == 6) ? 0.001f : 0.00031622776601683794f;
            const float ang = (float)pos * invf;
            double rev = (double)ang * 0.15915494309189535; rev -= __builtin_rint(rev);
            const float fr = (float)rev;
            rope[idx * 2] = __builtin_amdgcn_cosf(fr); rope[idx * 2 + 1] = __builtin_amdgcn_sinf(fr);
        }
    }
    __syncthreads();
    LAS float* scr = (LAS float*)(LAS unsigned char*)lds + wid * (64 * 33);
    const int gw = blockIdx.x * NWAVES + wid, ngw = gridDim.x * NWAVES;
    for (int l = 0; l < 2; ++l) {
        { const float* W = IN(8) + (size_t)l * 1024 * INW;
          cvt_job((bf16*)(p.ws + WS_WIN) + (size_t)l * INWP * 1024, INWP, 1024, [=](int nt, int kt) -> CvtSrc {
              const int n0 = nt * 32; if (n0 >= INW) return CvtSrc{nullptr, 0, 0, false, nullptr, 1.f};
              return CvtSrc{W + (size_t)(kt * 64) * INW + n0, INW, (INW - n0 < 32) ? INW - n0 : 32, n0 == C_KPE, nullptr, 1.f}; }, scr, gw, ngw, lane); }
        { const float* Wq = IN(11) + (size_t)l * 256 * 384; const float* qn = IN(10) + l * 256; const float* Wk = IN(13) + (size_t)l * 128 * 256; const float* Wv = IN(14) + (size_t)l * 128 * 256; const float* kn = IN(12) + l * 128;
          const float QS = 0.10206207261596577f * 1.4426950408889634f;
          cvt_job((bf16*)(p.ws + WS_WQKV) + (size_t)l * 1024 * 384, 1024, 384, [=](int nt, int kt) -> CvtSrc {
              const int n0 = nt * 32, k0 = kt * 64;
              if (n0 < 384) { if (k0 >= 256) return CvtSrc{nullptr, 0, 0, false, nullptr, 1.f}; return CvtSrc{Wq + (size_t)k0 * 384 + n0, 384, 32, (n0 % 96) == 64, qn + k0, QS}; }
              if (n0 < 512 || k0 < 256) return CvtSrc{nullptr, 0, 0, false, nullptr, 1.f};
              if (n0 < 768) return CvtSrc{Wk + (size_t)(k0 - 256) * 256 + (n0 - 512), 256, 32, false, kn + k0 - 256, 1.f};
              return CvtSrc{Wv + (size_t)(k0 - 256) * 256 + (n0 - 768), 256, 32, false, kn + k0 - 256, 1.f}; }, scr, gw, ngw, lane); }
        { const float* W = IN(9) + (size_t)l * 1024 * 1024;
          cvt_job((bf16*)(p.ws + WS_WOUT) + (size_t)l * 1024 * 1024, 1024, 1024, [=](int nt, int kt) -> CvtSrc { return CvtSrc{W + (size_t)(kt * 64) * 1024 + nt * 32, 1024, 32, false, nullptr, 1.f}; }, scr, gw, ngw, lane); }
    }
    { const float* Wg = IN(22); const float* Wu = IN(23);
      cvt_job((bf16*)(p.ws + WS_WGU), 2 * DFF, 1024, [=](int nt, int kt) -> CvtSrc { const int n0 = nt * 32, t = n0 >> 8, r = n0 & 255;
          return CvtSrc{(r < 128 ? Wg + t * 128 + r : Wu + t * 128 + r - 128) + (size_t)(kt * 64) * DFF, DFF, 32, false, nullptr, 1.f}; }, scr, gw, ngw, lane); }
    { const float* W = IN(24);
      cvt_job((bf16*)(p.ws + WS_WD), 1024, DFF, [=](int nt, int kt) -> CvtSrc { return CvtSrc{W + (size_t)(kt * 64) * 1024 + nt * 32, 1024, 32, false, nullptr, 1.f}; }, scr, gw, ngw, lane); }
}
DEVI void ph_moew(const P& p, unsigned char* lds) {
    const int tid = otid(), wid = tid >> 6, lane = tid & 63;
    LAS float* scr = (LAS float*)(LAS unsigned char*)lds + wid * (64 * 33);
    const int gw = blockIdx.x * NWAVES + wid, ngw = gridDim.x * NWAVES;
    for (int e = 0; e < NEXP; ++e) {
        { const float* Wg = IN(26) + (size_t)e * 1024 * DFE; const float* Wu = IN(27) + (size_t)e * 1024 * DFE;
          cvt_job((bf16*)(p.ws + WS_WGUE) + (size_t)e * 2 * DFE * 1024, 2 * DFE, 1024, [=](int nt, int kt) -> CvtSrc { const int n0 = nt * 32, t = n0 >> 8, r = n0 & 255;
              return CvtSrc{(r < 128 ? Wg + t * 128 + r : Wu + t * 128 + r - 128) + (size_t)(kt * 64) * DFE, DFE, 32, false, nullptr, 1.f}; }, scr, gw, ngw, lane); }
        { const float* W = IN(28) + (size_t)e * DFE * 1024;
          cvt_job((bf16*)(p.ws + WS_WDE) + (size_t)e * 1024 * DFE, 1024, DFE, [=](int nt, int kt) -> CvtSrc { return CvtSrc{W + (size_t)(kt * 64) * 1024 + nt * 32, 1024, 32, false, nullptr, 1.f}; }, scr, gw, ngw, lane); }
    }
}

template <bool route>
DEVI void ph_norm(const P& p, int l, int which, int nrows, unsigned char* lds, int npart, int pgidx) {
    const int tid = otid(), wid = tid >> 6, lane = tid & 63;
    const bool first = (l == 0 && which == 0);
    const float* src_lat = first ? IN(0) : p.out; const float* src_ctx = (l == 0) ? IN(2) : (const float*)(p.ws + WS_XC);
    const float* w = IN(6 + which) + l * 1024; const float* modv = (const float*)(p.ws + WS_MODV) + (size_t)l * 3 * 6144;
    bf16* H = (bf16*)(p.ws + WS_HM);
    int* rt_e = (int*)(p.ws + WS_RT); float* rt_g = (float*)(p.ws + WS_RT + 128 * 1024);
    float* rl = (float*)lds;
    if (route) { __syncthreads(); const float* router = IN(25);
#pragma unroll
        for (int i = 0; i < 4; ++i) *(f32x4*)(rl + (tid + NTHREADS * i) * 4) = *(const f32x4*)(router + (tid + NTHREADS * i) * 4);
        __syncthreads(); }
    const int nw = gridDim.x * NWAVES, rpw = (NLAT + nw - 1) / nw, gw = blockIdx.x * NWAVES + wid;
    f32x4 vn[4], gsc[4], shv[4]; int rc = -1;
    for (int pass = 0; pass < (nrows > NLAT ? 2 : 1); ++pass) {
    const int row0 = pass == 0 ? gw * rpw : NLAT + gw, row1 = pass == 0 ? ((row0 + rpw < NLAT) ? row0 + rpw : NLAT) : nrows, rstep = pass == 0 ? 1 : nw;
    if (row0 < row1) { const float* x = (row0 < NLAT) ? src_lat + (size_t)row0 * D : src_ctx + (size_t)(row0 - NLAT) * D;
#pragma unroll
        for (int j = 0; j < 4; ++j) vn[j] = *(const f32x4*)(x + (j * 64 + lane) * 4); }
    for (int row = row0; row < row1; row += rstep) {
        const bool lat = row < NLAT; const int r = lat ? (row >> 13) : 2;
        if (r != rc) { rc = r; const float* sh = modv + r * 6144 + (which * 3 + 0) * 1024; const float* sc = modv + r * 6144 + (which * 3 + 1) * 1024;
#pragma unroll
            for (int j = 0; j < 4; ++j) { const int c0 = (j * 64 + lane) * 4; const f32x4 wv = *(const f32x4*)(w + c0), cv = *(const f32x4*)(sc + c0); shv[j] = *(const f32x4*)(sh + c0); gsc[j] = wv * (cv + 1.f); } }
        f32x4 v[4]; float ss = 0.f;
#pragma unroll
        for (int j = 0; j < 4; ++j) v[j] = vn[j];
        if (!lat && npart > 0) { const float* part = (const float*)(p.ws + WS_XBC) + (size_t)(row - NLAT) * D; const float* gp = modv + 2 * 6144 + pgidx * 1024; float* xc = (float*)(p.ws + WS_XC) + (size_t)(row - NLAT) * D;
#pragma unroll
            for (int j = 0; j < 4; ++j) { const int c0 = (j * 64 + lane) * 4; f32x4 acc = {0.f, 0.f, 0.f, 0.f};
#pragma unroll 2
                for (int k = 0; k < npart; ++k) acc += *(const f32x4*)(part + (size_t)k * NCTX * D + c0);
                v[j] += *(const f32x4*)(gp + c0) * acc; *(f32x4*)(xc + c0) = v[j]; } }
#pragma unroll
        for (int j = 0; j < 4; ++j) ss += v[j][0] * v[j][0] + v[j][1] * v[j][1] + v[j][2] * v[j][2] + v[j][3] * v[j][3];
        if (row + rstep < row1) { const int nrow = row + rstep; const float* x = (nrow < NLAT) ? src_lat + (size_t)nrow * D : src_ctx + (size_t)(nrow - NLAT) * D;
#pragma unroll
            for (int j = 0; j < 4; ++j) vn[j] = *(const f32x4*)(x + (j * 64 + lane) * 4); }
        ss = wave_sum(ss); const float rstd = 1.0f / sqrtf(ss * (1.f / D) + EPS);
        float lg[8];
#pragma unroll
        for (int e = 0; e < 8; ++e) lg[e] = 0.f;
#pragma unroll
        for (int j = 0; j < 4; ++j) { const int c0 = (j * 64 + lane) * 4; v[j] = v[j] * rstd * gsc[j] + shv[j]; st_bf16x4(H + (size_t)row * D + c0, v[j]); }
        if (route) {
#pragma unroll
            for (int j = 0; j < 4; ++j) { const int c0 = (j * 64 + lane) * 4;
#pragma unroll
                for (int i = 0; i < 4; ++i) { const f32x4 r0 = *(const f32x4*)(rl + (c0 + i) * 8), r1 = *(const f32x4*)(rl + (c0 + i) * 8 + 4); const float hh = v[j][i];
                    lg[0] += hh * r0[0]; lg[1] += hh * r0[1]; lg[2] += hh * r0[2]; lg[3] += hh * r0[3]; lg[4] += hh * r1[0]; lg[5] += hh * r1[1]; lg[6] += hh * r1[2]; lg[7] += hh * r1[3]; }
                asm volatile("" ::: "memory"); } }
        if (route) {
#pragma unroll
            for (int e = 0; e < 8; ++e) lg[e] = wave_sum(lg[e]);
            int i1 = 0; float v1 = lg[0];
#pragma unroll
            for (int e = 1; e < 8; ++e) if (lg[e] > v1) { v1 = lg[e]; i1 = e; }
            int i2 = -1; float v2 = -3.0e38f;
#pragma unroll
            for (int e = 0; e < 8; ++e) if (e != i1 && lg[e] > v2) { v2 = lg[e]; i2 = e; }
            const float e2 = __expf(v2 - v1), g1 = 1.f / (1.f + e2), g2 = e2 / (1.f + e2);
            if (lane == 0) { rt_e[row * 2] = i1; rt_e[row * 2 + 1] = i2; rt_g[row * 2] = g1; rt_g[row * 2 + 1] = g2; }
        }
    }
    }
}

DEVI void ph_conv(const P& p, int l) {
    const int tid = otid(), wid = tid >> 6, lane = tid & 63;
    const bf16* proj = (const bf16*)(p.ws + WS_PROJ); bf16* xbc = (bf16*)(p.ws + WS_XBC); bf16* Kb = (bf16*)(p.ws + WS_K);
    float* rq = (float*)(p.ws + WS_RQ); float* rkv = (float*)(p.ws + WS_RKV); const float* rope = (const float*)(p.ws + WS_ROPE);
    const float* cw = IN(16) + (size_t)l * 3 * 768; const float* cb = IN(17) + l * 768;
    const int nw_ = gridDim.x * NWAVES, rpw = (T + nw_ - 1) / nw_, gw = blockIdx.x * NWAVES + wid;
    const int row0 = gw * rpw, row1 = (row0 + rpw < T) ? row0 + rpw : T;
    f32x4 cw0[3], cw1[3], cw2[3], cbb[3];
#pragma unroll
    for (int j = 0; j < 3; ++j) { const int c0 = (j * 64 + lane) * 4; cw0[j] = *(const f32x4*)(cw + c0); cw1[j] = *(const f32x4*)(cw + 768 + c0); cw2[j] = *(const f32x4*)(cw + 1536 + c0); cbb[j] = *(const f32x4*)(cb + c0); }
    for (int row = row0; row < row1; ++row) {
        const bool lat = row < NLAT; const int pos = lat ? (row & (SEQ - 1)) : ((row - NLAT) & (CL - 1)); const int L = lat ? SEQ : CL;
        const bf16* pr = proj + (size_t)row * INWP;
        { const u32x2 a = *(const u32x2*)(pr + lane * 4); const unsigned b = *(const unsigned*)(pr + C_CKV + lane * 2);
          const float q0 = bf2f(a.x & 0xffff), q1 = bf2f(a.x >> 16), q2 = bf2f(a.y & 0xffff), q3 = bf2f(a.y >> 16), k0 = bf2f(b & 0xffff), k1 = bf2f(b >> 16);
          const float sq = wave_sum(q0 * q0 + q1 * q1 + q2 * q2 + q3 * q3), sk = wave_sum(k0 * k0 + k1 * k1);
          if (lane == 0) { rq[row] = 1.0f / sqrtf(sq * (1.f / 256.f) + EPS); rkv[row] = 1.0f / sqrtf(sk * (1.f / 128.f) + EPS); } }
        if (lane < 16) { const unsigned a = *(const unsigned*)(pr + C_KPE + lane * 2); float x0 = bf2f(a & 0xffff), x1 = bf2f(a >> 16);
            if (lat) { const int gr = pos >> 6, gc = pos & 63; const float* tb = (lane < 8) ? rope + (gr * 8 + lane) * 2 : rope + 2048 + (gc * 8 + (lane - 8)) * 2;
                const float c = tb[0], s = tb[1], y0 = x0 * c - x1 * s, y1 = x1 * c + x0 * s; x0 = y0; x1 = y1; }
            const unsigned o = pk2(x0, x1);
#pragma unroll
            for (int h = 0; h < 4; ++h) *(unsigned*)(Kb + (size_t)row * 384 + h * 96 + 64 + lane * 2) = o; }
#pragma unroll
        for (int j = 0; j < 3; ++j) { const int c0 = (j * 64 + lane) * 4;
            const u32x2 xm = (pos > 0) ? *(const u32x2*)(pr - INWP + C_XBC + c0) : (u32x2){0u, 0u}; const u32x2 x0 = *(const u32x2*)(pr + C_XBC + c0);
            const u32x2 xp = (pos < L - 1) ? *(const u32x2*)(pr + INWP + C_XBC + c0) : (u32x2){0u, 0u};
            const f32x4 w0 = cw0[j], w1 = cw1[j], w2 = cw2[j], bb = cbb[j];
            f32x4 am = {bf2f(xm.x & 0xffff), bf2f(xm.x >> 16), bf2f(xm.y & 0xffff), bf2f(xm.y >> 16)}, a0 = {bf2f(x0.x & 0xffff), bf2f(x0.x >> 16), bf2f(x0.y & 0xffff), bf2f(x0.y >> 16)},
                  ap = {bf2f(xp.x & 0xffff), bf2f(xp.x >> 16), bf2f(xp.y & 0xffff), bf2f(xp.y >> 16)};
            f32x4 y = w0 * am + w1 * a0 + w2 * ap + bb;
#pragma unroll
            for (int i = 0; i < 4; ++i) y[i] = siluf(y[i]);
            st_bf16x4(xbc + (size_t)row * 768 + c0, y); }
    }
}

typedef short v4i16_t __attribute__((ext_vector_type(4)));
DEVI v4i16_t lds_tr(const unsigned char* p) { return __builtin_amdgcn_ds_read_tr16_b64_v4i16((LAS v4i16_t*)(LAS unsigned char*)p); }
constexpr int A3_KLD = 208, A3_VLD = 192, A3_VOFF = 64 * A3_KLD, A3_BUF = A3_VOFF + 64 * A3_VLD;
DEVI void attn_unit(const P& p, int uidx, unsigned char* lds) {
    const int tid = otid(), wid = __builtin_amdgcn_readfirstlane(tid >> 6), lane = tid & 63, r32 = lane & 31, hi = lane >> 5;
    const bf16* Q = (const bf16*)(p.ws + WS_Q); const bf16* K = (const bf16*)(p.ws + WS_K); const bf16* V = (const bf16*)(p.ws + WS_V); bf16* MIX = (bf16*)(p.ws + WS_HM);
    int b, h, qrow0, NT;
    if (uidx < 256) { b = uidx >> 7; h = (uidx >> 5) & 3; qrow0 = b * SEQ + (uidx & 31) * 256; NT = 4 + SEQ / 64; }
    else { const int j = uidx - 256; b = j >> 2; h = j & 3; qrow0 = NLAT + b * CL; NT = 4; }
    const int qrow = qrow0 + wid * 32 + r32;
    bf16x8 qf[6];
#pragma unroll
    for (int s = 0; s < 6; ++s) qf[s] = *(const bf16x8*)(Q + (size_t)qrow * 384 + h * 96 + s * 16 + hi * 8);
    const int kk0 = tid / 12, kq0 = tid % 12, kk1 = (512 + tid) / 12, kq1 = (512 + tid) % 12, vk = tid >> 3, vq = tid & 7;
    const bf16* Kh = K + h * 96; const bf16* Vh = V + h * 64 + vq * 8;
    const int ctx0 = NLAT + b * CL, lat0 = b * SEQ;
    u32x4 krA0, krA1 = {0u, 0u, 0u, 0u}, vrA;
#define AT_LOAD(t, kr0, kr1, vr) do { const int kr_ = ((t) < 4) ? ctx0 + (t) * 64 : lat0 + ((t) - 4) * 64; \
        kr0 = *(const u32x4*)(Kh + (size_t)(kr_ + kk0) * 384 + kq0 * 8); if (tid < 256) kr1 = *(const u32x4*)(Kh + (size_t)(kr_ + kk1) * 384 + kq1 * 8); \
        vr = *(const u32x4*)(Vh + (size_t)(kr_ + vk) * 256); } while (0)
#define AT_STORE(bufp, kr0, kr1, vr) do { unsigned char* b_ = (bufp); *(u32x4*)(b_ + kk0 * A3_KLD + kq0 * 16) = kr0; if (tid < 256) *(u32x4*)(b_ + kk1 * A3_KLD + kq1 * 16) = kr1; \
        *(u32x4*)(b_ + A3_VOFF + vk * A3_VLD + vq * 16) = vr; } while (0)
    const int troff = (4 * hi + ((lane & 15) >> 2)) * A3_VLD + (16 * ((lane >> 4) & 1) + 4 * (lane & 3)) * 2;
    const int koff = r32 * A3_KLD + hi * 16;
    f32x16 o0, o1, negm, lacc;
#pragma unroll
    for (int r = 0; r < 16; ++r) { o0[r] = 0.f; o1[r] = 0.f; negm[r] = 0.f; lacc[r] = 0.f; }
    const bf16x8 ones = {0x3f80, 0x3f80, 0x3f80, 0x3f80, 0x3f80, 0x3f80, 0x3f80, 0x3f80};
    float mhat = 0.f;
    __syncthreads();
    AT_LOAD(0, krA0, krA1, vrA); AT_STORE(lds, krA0, krA1, vrA); AT_LOAD(1, krA0, krA1, vrA); AT_STORE(lds + A3_BUF, krA0, krA1, vrA);
    __syncthreads();
#define SBAR() __builtin_amdgcn_sched_barrier(0)
#define KRD(bufp, half, s) (*(const bf16x8*)((bufp) + koff + (half) * 32 * A3_KLD + (s) * 32))
#define MF(a, b, c) __builtin_amdgcn_mfma_f32_32x32x16_bf16(a, b, c, 0, 0, 0)
#define EX4(S, r0) do { S[r0] = __builtin_amdgcn_exp2f(S[r0]); S[r0 + 1] = __builtin_amdgcn_exp2f(S[r0 + 1]); S[r0 + 2] = __builtin_amdgcn_exp2f(S[r0 + 2]); S[r0 + 3] = __builtin_amdgcn_exp2f(S[r0 + 3]); } while (0)
#define PK8(S, r0) __builtin_bit_cast(bf16x8, (u32x4){pk2(S[r0], S[r0 + 1]), pk2(S[r0 + 2], S[r0 + 3]), pk2(S[r0 + 4], S[r0 + 5]), pk2(S[r0 + 6], S[r0 + 7])})
#define VFR(vp) ({ const v4i16_t lo_ = lds_tr(vp), hi_ = lds_tr((vp) + 8 * A3_VLD); (bf16x8){lo_[0], lo_[1], lo_[2], lo_[3], hi_[0], hi_[1], hi_[2], hi_[3]}; })
#define MX3(a, b, c) __builtin_fmaxf(__builtin_fmaxf((a), (b)), (c))
#define AT_UPD(S0, S1, mx, FORCE) do { float mx_ = __builtin_fmaxf(mx, __shfl_xor(mx, 32)); \
        if ((FORCE) || __any(mx_ > 8.0f)) { const float dl_ = (FORCE) ? mx_ : __builtin_fmaxf(mx_, 0.f); mhat += dl_; \
            _Pragma("unroll") for (int r = 0; r < 16; ++r) { S0[r] -= dl_; S1[r] -= dl_; negm[r] = -mhat; } \
            if (!(FORCE)) { const float f_ = __builtin_amdgcn_exp2f(-dl_); _Pragma("unroll") for (int r = 0; r < 16; ++r) { o0[r] *= f_; o1[r] *= f_; lacc[r] *= f_; } } } } while (0)
    f32x16 sa0, sa1, sb0, sb1;
    { const unsigned char* kb_ = lds;
#pragma unroll
      for (int s = 0; s < 6; ++s) { sa0 = MF(KRD(kb_, 0, s), qf[s], s == 0 ? negm : sa0); sa1 = MF(KRD(kb_, 1, s), qf[s], s == 0 ? negm : sa1); }
      float a_ = MX3(sa0[0], sa0[1], sa1[0]), b_ = MX3(sa0[2], sa0[3], sa1[1]); a_ = MX3(a_, sa1[2], sa1[3]);
#pragma unroll
      for (int r = 4; r < 16; r += 4) { a_ = MX3(a_, sa0[r], sa0[r + 1]); b_ = MX3(b_, sa0[r + 2], sa0[r + 3]); a_ = MX3(a_, sa1[r], sa1[r + 1]); b_ = MX3(b_, sa1[r + 2], sa1[r + 3]); }
      AT_UPD(sa0, sa1, __builtin_fmaxf(a_, b_), true); }
#define AT_STEP(C0, C1, N0, N1, t, bc_, HAS_NEXT) do { const int b1_ = ((bc_) == 2) ? 0 : (bc_) + 1, b2_ = (b1_ == 2) ? 0 : b1_ + 1; \
        const unsigned char* kb_ = lds + b1_ * A3_BUF; const unsigned char* vb_ = lds + (bc_) * A3_BUF + A3_VOFF + troff; \
        if ((t) + 2 < NT) AT_LOAD((t) + 2, krA0, krA1, vrA); \
        bf16x8 pw0_, pw1_, pw2_, pw3_; float ma_ = -3.0e38f, mb_ = -3.0e38f; \
        if (HAS_NEXT) { \
            bf16x8 k0_ = KRD(kb_, 0, 0), k1_ = KRD(kb_, 1, 0), k2_ = KRD(kb_, 0, 1), k3_ = KRD(kb_, 1, 1); SBAR(); \
            N0 = MF(k0_, qf[0], negm); EX4(C0, 0); k0_ = KRD(kb_, 0, 2); SBAR(); \
            N1 = MF(k1_, qf[0], negm); EX4(C0, 4); k1_ = KRD(kb_, 1, 2); SBAR(); \
            N0 = MF(k2_, qf[1], N0); EX4(C0, 8); k2_ = KRD(kb_, 0, 3); SBAR(); \
            N1 = MF(k3_, qf[1], N1); EX4(C0, 12); k3_ = KRD(kb_, 1, 3); SBAR(); \
            N0 = MF(k0_, qf[2], N0); EX4(C1, 0); k0_ = KRD(kb_, 0, 4); SBAR(); \
            N1 = MF(k1_, qf[2], N1); EX4(C1, 4); k1_ = KRD(kb_, 1, 4); SBAR(); \
            N0 = MF(k2_, qf[3], N0); EX4(C1, 8); k2_ = KRD(kb_, 0, 5); SBAR(); \
            N1 = MF(k3_, qf[3], N1); EX4(C1, 12); k3_ = KRD(kb_, 1, 5); SBAR(); \
            N0 = MF(k0_, qf[4], N0); pw0_ = PK8(C0, 0); SBAR(); \
            N1 = MF(k1_, qf[4], N1); pw1_ = PK8(C0, 8); SBAR(); \
            N0 = MF(k2_, qf[5], N0); pw2_ = PK8(C1, 0); SBAR(); \
            N1 = MF(k3_, qf[5], N1); pw3_ = PK8(C1, 8); SBAR(); \
        } else { EX4(C0, 0); EX4(C0, 4); EX4(C0, 8); EX4(C0, 12); EX4(C1, 0); EX4(C1, 4); EX4(C1, 8); EX4(C1, 12); pw0_ = PK8(C0, 0); pw1_ = PK8(C0, 8); pw2_ = PK8(C1, 0); pw3_ = PK8(C1, 8); SBAR(); } \
        { bf16x8 va_ = VFR(vb_), vb2_ = VFR(vb_ + 64); SBAR(); \
          lacc = MF(ones, pw0_, lacc); bf16x8 vc_ = VFR(vb_ + 16 * A3_VLD), vd_ = VFR(vb_ + 16 * A3_VLD + 64); SBAR(); \
          o0 = MF(va_, pw0_, o0); if (HAS_NEXT) { ma_ = MX3(N0[0], N0[1], N1[0]); mb_ = MX3(N0[2], N0[3], N1[1]); } SBAR(); \
          o1 = MF(vb2_, pw0_, o1); if (HAS_NEXT) { ma_ = MX3(ma_, N1[2], N1[3]); mb_ = MX3(mb_, N0[4], N0[5]); } SBAR(); \
          lacc = MF(ones, pw1_, lacc); va_ = VFR(vb_ + 32 * A3_VLD); vb2_ = VFR(vb_ + 32 * A3_VLD + 64); SBAR(); \
          o0 = MF(vc_, pw1_, o0); if (HAS_NEXT) { ma_ = MX3(ma_, N0[6], N0[7]); mb_ = MX3(mb_, N1[4], N1[5]); } SBAR(); \
          o1 = MF(vd_, pw1_, o1); if (HAS_NEXT) { ma_ = MX3(ma_, N1[6], N1[7]); mb_ = MX3(mb_, N0[8], N0[9]); } SBAR(); \
          lacc = MF(ones, pw2_, lacc); vc_ = VFR(vb_ + 48 * A3_VLD); vd_ = VFR(vb_ + 48 * A3_VLD + 64); SBAR(); \
          o0 = MF(va_, pw2_, o0); if (HAS_NEXT) { ma_ = MX3(ma_, N0[10], N0[11]); mb_ = MX3(mb_, N1[8], N1[9]); } SBAR(); \
          o1 = MF(vb2_, pw2_, o1); if (HAS_NEXT) { ma_ = MX3(ma_, N1[10], N1[11]); mb_ = MX3(mb_, N0[12], N0[13]); } SBAR(); \
          lacc = MF(ones, pw3_, lacc); if (HAS_NEXT) { ma_ = MX3(ma_, N0[14], N0[15]); mb_ = MX3(mb_, N1[12], N1[13]); } SBAR(); \
          o0 = MF(vc_, pw3_, o0); if (HAS_NEXT) { ma_ = MX3(ma_, N1[14], N1[15]); } SBAR(); \
          o1 = MF(vd_, pw3_, o1); SBAR(); } \
        if (HAS_NEXT) AT_UPD(N0, N1, __builtin_fmaxf(ma_, mb_), false); \
        if ((t) + 2 < NT) AT_STORE(lds + b2_ * A3_BUF, krA0, krA1, vrA); \
        __syncthreads(); } while (0)
    int bc = 0, t = 0;
    for (; t + 2 < NT; t += 2) {
        AT_STEP(sa0, sa1, sb0, sb1, t, bc, true); bc = (bc == 2) ? 0 : bc + 1;
        AT_STEP(sb0, sb1, sa0, sa1, t + 1, bc, true); bc = (bc == 2) ? 0 : bc + 1;
    }
    AT_STEP(sa0, sa1, sb0, sb1, t, bc, true); bc = (bc == 2) ? 0 : bc + 1;
    AT_STEP(sb0, sb1, sa0, sa1, t + 1, bc, false);
#undef AT_LOAD
#undef AT_STORE
#undef SBAR
#undef KRD
#undef MF
#undef EX4
#undef PK8
#undef VFR
#undef MX3
#undef AT_UPD
#undef AT_STEP
    const float inv = 1.f / lacc[0];
    bf16* orow = MIX + (size_t)qrow * D + h * 64;
#pragma unroll
    for (int g = 0; g < 4; ++g) {
        st_bf16x4(orow + 8 * g + 4 * hi, (f32x4){o0[4 * g] * inv, o0[4 * g + 1] * inv, o0[4 * g + 2] * inv, o0[4 * g + 3] * inv});
        st_bf16x4(orow + 32 + 8 * g + 4 * hi, (f32x4){o1[4 * g] * inv, o1[4 * g + 1] * inv, o1[4 * g + 2] * inv, o1[4 * g + 3] * inv});
    }
}

constexpr int NCC = 66;
DEVI int chunk_row0(int b, int cc) { return cc < 2 ? NLAT + b * CL + cc * 128 : b * SEQ + (cc - 2) * 128; }
constexpr int SC_VEC = 0;
constexpr int SC_KT = 2048;
constexpr int SC_VF = SC_KT + 64 * 136 * 2;
constexpr int SC_VB = SC_VF + 64 * 136 * 2;
constexpr int SC_X = SC_VB + 64 * 136 * 2;
constexpr int SC_SSQ = SC_X + 2048;
constexpr int SC_END = SC_SSQ + 8192;
constexpr int TS = 136;

DEVI void scan_vectors(const P& p, int l, bool ret, int h, int row0, float* vec, int wid, int lane) {
    const float* dt = (const float*)(p.ws + WS_DT);
    if (ret) {
        if (wid == 0) { const float lf = IN(15)[l * 8 + h], lb = IN(15)[l * 8 + 4 + h];
            const float laf = -log1pf(__expf(-lf)), lab = -log1pf(__expf(-lb));
#pragma unroll
            for (int e = 0; e < 2; ++e) { const int j = lane * 2 + e; vec[j] = (float)(j + 1) * laf; vec[128 + j] = (float)(128 - j) * lab; vec[256 + j] = 1.f; vec[384 + j] = 1.f; } }
    } else if (wid < 2) {
        const int dir = wid; const size_t r = (size_t)(row0 + lane * 2);
        const float x0 = dt[r * 32 + 16 + dir * 8 + h], x1 = dt[(r + 1) * 32 + 16 + dir * 8 + h];
        vec[256 + dir * 128 + lane * 2] = dt[r * 32 + dir * 8 + h]; vec[256 + dir * 128 + lane * 2 + 1] = dt[(r + 1) * 32 + dir * 8 + h];
        float s = x0 + x1;
#pragma unroll
        for (int o = 1; o < 64; o <<= 1) { const float t = __shfl_up(s, o); if (lane >= o) s += t; }
        if (dir == 0) { vec[lane * 2] = s - x1; vec[lane * 2 + 1] = s; }
        else { const float tot = __shfl(s, 63); vec[128 + lane * 2] = tot - (s - x1) + x0; vec[128 + lane * 2 + 1] = tot - s + x1; }
    }
}
DEVI void scan_ptrs(const P& p, bool ret, int h, const bf16*& qb, const bf16*& kb, const bf16*& vb, int& ld) {
    if (ret) { const bf16* proj = (const bf16*)(p.ws + WS_PROJ); qb = proj + C_RQ + h * 64; kb = proj + C_RK + h * 64; vb = proj + C_RV + h * 64; ld = INWP; }
    else { const bf16* xbc = (const bf16*)(p.ws + WS_XBC); qb = xbc + 640 + (h >> 2) * 64; kb = xbc + 512 + (h >> 2) * 64; vb = xbc + h * 64; ld = 768; }
}
template <bool SCALED>
DEVI void stage_T(const bf16* src, int ld, int row0, bf16* d0, bf16* d1, const float* vec, int tid) {
    const int part = tid >> 6, lane = tid & 63, n0 = part * 8;
#pragma unroll
    for (int i = 0; i < 2; ++i) { const int j = lane + 64 * i;
        const u32x4 v = *(const u32x4*)(src + (size_t)(row0 + j) * ld + n0);
        const unsigned w[4] = {v.x, v.y, v.z, v.w};
        if (!SCALED) {
#pragma unroll
            for (int e = 0; e < 4; ++e) { d0[(n0 + 2 * e) * TS + j] = (bf16)(w[e] & 0xffff); d0[(n0 + 2 * e + 1) * TS + j] = (bf16)(w[e] >> 16); }
        } else {
            const float sf = __expf(vec[127] - vec[j]) * vec[256 + j], sb = __expf(vec[128] - vec[128 + j]) * vec[384 + j];
#pragma unroll
            for (int e = 0; e < 4; ++e) { const float a = bf2f(w[e] & 0xffff), b = bf2f(w[e] >> 16);
                d0[(n0 + 2 * e) * TS + j] = f2bf(a * sf); d0[(n0 + 2 * e + 1) * TS + j] = f2bf(b * sf); d1[(n0 + 2 * e) * TS + j] = f2bf(a * sb); d1[(n0 + 2 * e + 1) * TS + j] = f2bf(b * sb); }
        } }
}
DEVI void scanA_unit(const P& p, int l, int uidx, unsigned char* lds) {
    const int tid = otid(), wid = __builtin_amdgcn_readfirstlane(tid >> 6), lane = tid & 63, r32 = lane & 31, hi = lane >> 5;
    const int g4 = uidx % 3, bc = uidx / 3, b = bc / NCC, cc = bc % NCC, row0 = chunk_row0(b, cc);
    const bool ret = (g4 == 0);
    float* vec = (float*)(lds + SC_VEC); bf16* Kt = (bf16*)(lds + SC_KT); bf16* Vf = (bf16*)(lds + SC_VF); bf16* Vb = (bf16*)(lds + SC_VB);
    float* ST = (float*)(p.ws + WS_ST); float* CDp = (float*)(p.ws + WS_CD);
    for (int hq = 0; hq < 4; ++hq) {
        const int h = ret ? hq : (g4 - 1) * 4 + hq, hh = ret ? hq : 4 + h; const size_t item = (size_t)(b * NCC + cc) * 12 + hh;
        const bf16 *qb, *kb, *vb; int ld; scan_ptrs(p, ret, h, qb, kb, vb, ld);
        __syncthreads();
        scan_vectors(p, l, ret, h, row0, vec, wid, lane);
        __syncthreads();
        if (ret || hq == 0) stage_T<false>(kb, ld, row0, Kt, nullptr, vec, tid);
        stage_T<true>(vb, ld, row0, Vf, Vb, vec, tid);
        if (tid == 0) { CDp[item * 2] = __expf(vec[127]); CDp[item * 2 + 1] = __expf(vec[128]); }
        if (tid < 128) { float* vg = (float*)(p.ws + WS_VEC) + item * 512; vg[tid] = vec[tid]; vg[128 + tid] = vec[128 + tid]; vg[256 + tid] = vec[tid] - __logf(vec[256 + tid]); vg[384 + tid] = vec[128 + tid] - __logf(vec[384 + tid]); }
        __syncthreads();
        const int dir = wid >> 2, nt = (wid >> 1) & 1, pt = wid & 1; const bf16* Vd = dir ? Vb : Vf;
        f32x16 acc;
#pragma unroll
        for (int r = 0; r < 16; ++r) acc[r] = 0.f;
#pragma unroll
        for (int s = 0; s < 8; ++s) { const bf16x8 a = *(const bf16x8*)(Kt + (nt * 32 + r32) * TS + s * 16 + hi * 8), bb = *(const bf16x8*)(Vd + (pt * 32 + r32) * TS + s * 16 + hi * 8);
            acc = __builtin_amdgcn_mfma_f32_32x32x16_bf16(a, bb, acc, 0, 0, 0); }
        float* o = ST + (item * 2 + dir) * 4096 + (size_t)(pt * 32 + r32) * 64 + nt * 32 + 4 * hi;
#pragma unroll
        for (int g = 0; g < 4; ++g) *(f32x4*)(o + 8 * g) = (f32x4){acc[4 * g], acc[4 * g + 1], acc[4 * g + 2], acc[4 * g + 3]};
    }
    __syncthreads();
}
DEVI void scanB_unit(const P& p, int uidx) {
    const int tid = otid(); const int bhd = uidx >> 2, dir = bhd & 1, bh = bhd >> 1, b = bh / 12, hh = bh % 12; const int e = (uidx & 3) * 1024 + tid * 2;
    const float* ST = (const float*)(p.ws + WS_ST); const float* CDp = (const float*)(p.ws + WS_CD); bf16* HT = (bf16*)(p.ws + WS_HT);
    f32x2 H = {0.f, 0.f};
    for (int base = 0; base < NCC; base += 6) {
        f32x2 s[6]; float d[6]; size_t off[6];
#pragma unroll
        for (int i = 0; i < 6; ++i) { const int step = base + i; const int cc = dir == 0 ? step : (step < 2 ? 1 - step : 67 - step);
            const size_t item = (size_t)(b * NCC + cc) * 12 + hh; off[i] = (item * 2 + dir) * 4096 + e; s[i] = *(const f32x2*)(ST + off[i]); d[i] = CDp[item * 2 + dir]; }
#pragma unroll
        for (int i = 0; i < 6; ++i) { *(unsigned*)(HT + off[i]) = pk2(H[0], H[1]); H = H * d[i] + s[i]; }
    }
}
constexpr int C3_RSV = 192, C3_RSK = 144;
constexpr int C3_V = 0, C3_K = 2 * 128 * C3_RSV, C3_H = C3_K + 2 * 128 * C3_RSK, C3_VEC = C3_H + 2 * 128 * C3_RSK, C3_X = C3_VEC + 2 * 2048, C3_END = C3_X + 1024;
DEVI void c3_stage_rows(unsigned char* dst, int rs, const bf16* src, int ld, int tid) {
#pragma unroll
    for (int i = 0; i < 2; ++i) { const int piece = tid + NTHREADS * i, row = piece >> 3, part = piece & 7; *(u32x4*)(dst + row * rs + part * 16) = *(const u32x4*)(src + (size_t)row * ld + part * 8); }
}
template <bool RET>
DEVI void scanC_unit(const P& p, int l, int bc, unsigned char* lds, int tid, int wid, int lane) {
    const int r32 = lane & 31, hi = lane >> 5;
    const int it_ = wid & 3, hsub = wid >> 2, b = bc / NCC, cc = bc % NCC, row0 = chunk_row0(b, cc);
    const bf16* HT = (const bf16*)(p.ws + WS_HT); const bf16* proj = (const bf16*)(p.ws + WS_PROJ); const bf16* xbc = (const bf16*)(p.ws + WS_XBC); bf16* MIX = (bf16*)(p.ws + WS_HM); const float* VECG = (const float*)(p.ws + WS_VEC);
    const int i = it_ * 32 + r32; const size_t rowi = (size_t)(row0 + i);
    constexpr int ld = RET ? INWP : 768;
    const unsigned char* Vl = lds + C3_V + hsub * 128 * C3_RSV; const unsigned char* Kl = lds + C3_K + hsub * 128 * C3_RSK; const unsigned char* Hl = lds + C3_H + hsub * 128 * C3_RSK; const float* vec = (const float*)(lds + C3_VEC + hsub * 2048);
    const int trq = (lane & 15) >> 2, trp = lane & 3, trg = (lane >> 4) & 1;
    const int troff = (4 * hi + trq) * C3_RSV + (16 * trg + 4 * trp) * 2;
    float ssq = 0.f;
#pragma unroll 1
    for (int step = 0; step < (RET ? 2 : 4); ++step) {
        __syncthreads();
#pragma unroll
        for (int hs = 0; hs < 2; ++hs) { const int h = RET ? hs * 2 + step : hs * 4 + step, hh = RET ? h : 4 + h; const size_t item = (size_t)(b * NCC + cc) * 12 + hh;
            const bf16* vb = RET ? proj + C_RV + h * 64 : xbc + h * 64; const bf16* kb = RET ? proj + C_RK + h * 64 : xbc + 512 + hs * 64;
            c3_stage_rows(lds + C3_V + hs * 128 * C3_RSV, C3_RSV, vb + (size_t)row0 * ld, ld, tid);
            if (RET || step == 0) c3_stage_rows(lds + C3_K + hs * 128 * C3_RSK, C3_RSK, kb + (size_t)row0 * ld, ld, tid);
            c3_stage_rows(lds + C3_H + hs * 128 * C3_RSK, C3_RSK, HT + item * 2 * 4096, 64, tid);
            if ((tid >> 7) == hs) *(u32x4*)(lds + C3_VEC + hs * 2048 + (tid & 127) * 16) = *(const u32x4*)(VECG + item * 512 + (tid & 127) * 4); }
        __syncthreads();
        const int h = RET ? hsub * 2 + step : hsub * 4 + step;
        const bf16* qb = RET ? proj + C_RQ + h * 64 : xbc + 640 + hsub * 64;
        bf16x8 qf[4];
#pragma unroll
        for (int s = 0; s < 4; ++s) qf[s] = *(const bf16x8*)(qb + rowi * ld + s * 16 + hi * 8);
        const float Afi = vec[i], Bbi = vec[128 + i];
        f32x16 y0, y1;
#pragma unroll
        for (int r = 0; r < 16; ++r) { y0[r] = 0.f; y1[r] = 0.f; }
#pragma unroll 2
        for (int jt = 0; jt < 4; ++jt) {
            f32x16 st;
#pragma unroll
            for (int r = 0; r < 16; ++r) st[r] = 0.f;
#pragma unroll
            for (int s = 0; s < 4; ++s) { const bf16x8 kf = *(const bf16x8*)(Kl + (jt * 32 + r32) * C3_RSK + (s * 16 + hi * 8) * 2); st = __builtin_amdgcn_mfma_f32_32x32x16_bf16(kf, qf[s], st, 0, 0, 0); }
#pragma unroll
            for (int g = 0; g < 4; ++g) { const int j0 = jt * 32 + 8 * g + 4 * hi;
                const f32x4 afp = *(const f32x4*)(vec + 256 + j0), bbp = *(const f32x4*)(vec + 384 + j0);
#pragma unroll
                for (int e = 0; e < 4; ++e) { const int j = j0 + e; float f;
                    if (jt < it_) f = __expf(Afi - afp[e]);
                    else if (jt > it_) f = __expf(Bbi - bbp[e]);
                    else { const float ff = (j <= i) ? __expf(Afi - afp[e]) : 0.f; const bool bm = RET ? (j > i) : (j >= i); const float fb = bm ? __expf(Bbi - bbp[e]) : 0.f; f = ff + fb; }
                    st[4 * g + e] *= f; } }
#pragma unroll
            for (int s2 = 0; s2 < 2; ++s2) {
                u32x4 pw; pw.x = pk2(st[8 * s2 + 0], st[8 * s2 + 1]); pw.y = pk2(st[8 * s2 + 2], st[8 * s2 + 3]); pw.z = pk2(st[8 * s2 + 4], st[8 * s2 + 5]); pw.w = pk2(st[8 * s2 + 6], st[8 * s2 + 7]);
                const bf16x8 pb = __builtin_bit_cast(bf16x8, pw);
#pragma unroll
                for (int pt = 0; pt < 2; ++pt) { const unsigned char* vp = Vl + (jt * 32 + 16 * s2) * C3_RSV + pt * 64 + troff;
                    const v4i16_t lo = lds_tr(vp), hi2 = lds_tr(vp + 8 * C3_RSV);
                    const bf16x8 va = {lo[0], lo[1], lo[2], lo[3], hi2[0], hi2[1], hi2[2], hi2[3]};
                    if (pt == 0) y0 = __builtin_amdgcn_mfma_f32_32x32x16_bf16(va, pb, y0, 0, 0, 0); else y1 = __builtin_amdgcn_mfma_f32_32x32x16_bf16(va, pb, y1, 0, 0, 0); }
            }
        }
        { const float ef = __expf(Afi), eb = __expf(Bbi);
#pragma unroll
          for (int pt = 0; pt < 2; ++pt) { f32x16 tf, tb;
#pragma unroll
              for (int r = 0; r < 16; ++r) { tf[r] = 0.f; tb[r] = 0.f; }
              const unsigned char* hf = Hl + (pt * 32 + r32) * C3_RSK + hi * 16;
#pragma unroll
              for (int s = 0; s < 4; ++s) { tf = __builtin_amdgcn_mfma_f32_32x32x16_bf16(*(const bf16x8*)(hf + s * 32), qf[s], tf, 0, 0, 0); tb = __builtin_amdgcn_mfma_f32_32x32x16_bf16(*(const bf16x8*)(hf + 64 * C3_RSK + s * 32), qf[s], tb, 0, 0, 0); }
#pragma unroll
              for (int r = 0; r < 16; ++r) { if (pt == 0) y0[r] += ef * tf[r] + eb * tb[r]; else y1[r] += ef * tf[r] + eb * tb[r]; } } }
        if (RET) {
            float s1 = 0.f, s2 = 0.f;
#pragma unroll
            for (int r = 0; r < 16; ++r) { y0[r] *= 0.125f; y1[r] *= 0.125f; s1 += y0[r] + y1[r]; s2 += y0[r] * y0[r] + y1[r] * y1[r]; }
            s1 += __shfl_xor(s1, 32); s2 += __shfl_xor(s2, 32);
            const float mu = s1 * (1.f / 64.f), var = fmaxf(s2 * (1.f / 64.f) - mu * mu, 0.f), rs = 1.0f / sqrtf(var + EPS);
#pragma unroll
            for (int pt = 0; pt < 2; ++pt)
#pragma unroll
                for (int g = 0; g < 4; ++g) { const int p0 = pt * 32 + 8 * g + 4 * hi; const u32x2 gg = *(const u32x2*)(proj + rowi * INWP + C_RG + h * 64 + p0);
                    const f32x4 gv = {bf2f(gg.x & 0xffff), bf2f(gg.x >> 16), bf2f(gg.y & 0xffff), bf2f(gg.y >> 16)}; f32x4 o;
#pragma unroll
                    for (int e = 0; e < 4; ++e) o[e] = ((pt ? y1[4 * g + e] : y0[4 * g + e]) - mu) * rs * siluf(gv[e]);
                    st_bf16x4(MIX + rowi * D + 256 + h * 64 + p0, o); }
        } else {
            const float dsk = IN(20)[l * 8 + h];
#pragma unroll
            for (int pt = 0; pt < 2; ++pt)
#pragma unroll
                for (int g = 0; g < 4; ++g) { const int p0 = pt * 32 + 8 * g + 4 * hi; const u32x2 xx = *(const u32x2*)(xbc + rowi * 768 + h * 64 + p0), zz = *(const u32x2*)(proj + rowi * INWP + C_Z + h * 64 + p0);
                    const f32x4 xv = {bf2f(xx.x & 0xffff), bf2f(xx.x >> 16), bf2f(xx.y & 0xffff), bf2f(xx.y >> 16)}, zv = {bf2f(zz.x & 0xffff), bf2f(zz.x >> 16), bf2f(zz.y & 0xffff), bf2f(zz.y >> 16)}; f32x4 o;
#pragma unroll
                    for (int e = 0; e < 4; ++e) { o[e] = ((pt ? y1[4 * g + e] : y0[4 * g + e]) + xv[e] * dsk) * siluf(zv[e]); ssq += o[e] * o[e]; }
                    st_bf16x4(MIX + rowi * D + 512 + h * 64 + p0, o); }
        }
    }
    if (!RET) {
        float* X = (float*)(lds + C3_X);
        ssq += __shfl_xor(ssq, 32);
        if (hi == 0) X[hsub * 128 + i] = ssq;
        asm volatile("s_waitcnt vmcnt(0)" ::: "memory");
        __syncthreads();
        const float tot = X[i] + X[128 + i];
        const float rstd = 1.0f / sqrtf(tot * (1.f / 512.f) + EPS); const float* nw = IN(21) + l * 512;
#pragma unroll 1
        for (int h = hsub * 4; h < hsub * 4 + 4; ++h)
#pragma unroll
            for (int pt = 0; pt < 2; ++pt)
#pragma unroll
                for (int g = 0; g < 4; ++g) { const int c0 = h * 64 + pt * 32 + 8 * g + 4 * hi; bf16* mp = MIX + rowi * D + 512 + c0; const u32x2 v = *(const u32x2*)mp; const f32x4 w = *(const f32x4*)(nw + c0);
                    st_bf16x4(mp, (f32x4){bf2f(v.x & 0xffff) * rstd * w[0], bf2f(v.x >> 16) * rstd * w[1], bf2f(v.y & 0xffff) * rstd * w[2], bf2f(v.y >> 16) * rstd * w[3]}); }
    }
    __syncthreads();
}
DEVI void ph_scanC(const P& p, int l, unsigned char* lds) {
    const int tid = otid(), wid = __builtin_amdgcn_readfirstlane(tid >> 6), lane = tid & 63;
    const int NU = 2 * NCC;
    if (gridDim.x == 256) {
        const int c = blockIdx.x;
        if (c < NU) scanC_unit<false>(p, l, c, lds, tid, wid, lane);
        else { const int r = c - NU; scanC_unit<true>(p, l, r, lds, tid, wid, lane); if (r + 124 < NU) scanC_unit<true>(p, l, r + 124, lds, tid, wid, lane); }
    } else {
        for (int u = blockIdx.x; u < 2 * NU; u += gridDim.x) { if (u < NU) scanC_unit<false>(p, l, u, lds, tid, wid, lane); else scanC_unit<true>(p, l, u - NU, lds, tid, wid, lane); }
    }
}
DEVI void ph_scanA(const P& p, int l, unsigned char* lds) { for (int u = blockIdx.x; u < 2 * NCC * 3; u += gridDim.x) scanA_unit(p, l, u, lds); }
DEVI void ph_mixer(const P& p, int l, unsigned char* lds) {
    for (int u = blockIdx.x; u < 192; u += gridDim.x) scanB_unit(p, u);
    for (int a = blockIdx.x; a < 256; a += gridDim.x) attn_unit(p, (a & 7) * 32 + (a >> 3), lds);
    if (l == 0) for (int a = blockIdx.x; a < 8; a += gridDim.x) attn_unit(p, 256 + a, lds);
}

DEVI void ph_sort(const P& p, unsigned char* lds) {
    const int tid = otid(), wid = tid >> 6, lane = tid & 63;
    const int* rt_e = (const int*)(p.ws + WS_RT); int* rt_pos = (int*)(p.ws + WS_RT + 256 * 1024); int* tab = (int*)(p.ws + WS_RT + 384 * 1024);
    const bf16* H = (const bf16*)(p.ws + WS_HM); bf16* HS = (bf16*)(p.ws + WS_HS);
    int* sh = (int*)lds;
    const int G = gridDim.x, R = (NLAT + G - 1) / G;
    for (int blk = blockIdx.x; blk * R < NLAT; blk += G) {
        const int r0 = blk * R, r1 = (r0 + R < NLAT) ? r0 + R : NLAT;
        int ct[8], cb[8];
#pragma unroll
        for (int e = 0; e < 8; ++e) { ct[e] = 0; cb[e] = 0; }
        for (int i = tid; i < NLAT * 2; i += NTHREADS) { const int e = rt_e[i]; const bool bef = (i >> 1) < r0;
#pragma unroll
            for (int x = 0; x < 8; ++x) { const int hit = (e == x) ? 1 : 0; ct[x] += hit; cb[x] += bef ? hit : 0; } }
#pragma unroll
        for (int e = 0; e < 8; ++e) {
#pragma unroll
            for (int o = 1; o < 64; o <<= 1) { ct[e] += __shfl_xor(ct[e], o); cb[e] += __shfl_xor(cb[e], o); }
        }
        __syncthreads();
        if (lane == 0) {
#pragma unroll
            for (int e = 0; e < 8; ++e) { sh[wid * 8 + e] = ct[e]; sh[64 + wid * 8 + e] = cb[e]; } }
        __syncthreads();
        if (tid == 0) { int start = 0, nt = 0;
            for (int e = 0; e < 8; ++e) { int tot = 0, bef = 0; for (int w = 0; w < 8; ++w) { tot += sh[w * 8 + e]; bef += sh[64 + w * 8 + e]; }
                sh[128 + e] = start; sh[136 + e] = start + bef; const int ntile = (tot + 255) >> 8;
                if (blk == 0) { for (int t = 0; t < ntile; ++t) tab[1 + nt + t] = e; }
                nt += ntile; start += ntile * 256; }
            if (blk == 0) tab[0] = nt; }
        __syncthreads();
        { const int n_ent = (r1 - r0) * 2; const bool valid = tid < n_ent; const int e = valid ? rt_e[r0 * 2 + tid] : -1; int rank = 0;
#pragma unroll
          for (int x = 0; x < 8; ++x) { const unsigned long long m = __ballot(e == x); if (e == x) rank = __popcll(m & ((1ull << lane) - 1ull)); if (lane == 0) sh[160 + wid * 8 + x] = __popcll(m); }
          __syncthreads();
          if (valid) { int pos = sh[136 + e] + rank; for (int w = 0; w < wid; ++w) pos += sh[160 + w * 8 + e]; sh[256 + tid] = pos; rt_pos[r0 * 2 + tid] = pos; } }
        __syncthreads();
        for (int i = wid; i < (r1 - r0) * 2; i += NWAVES) { const int row = r0 + (i >> 1), pos = sh[256 + i];
            const u32x4* s = (const u32x4*)(H + (size_t)row * D); u32x4* d = (u32x4*)(HS + (size_t)pos * D); d[lane] = s[lane]; d[lane + 64] = s[lane + 64]; }
        __syncthreads();
    }
}
DEVI void ph_final(const P& p) {
    const int tid = otid(), wid = tid >> 6, lane = tid & 63;
    const float* rt_g = (const float*)(p.ws + WS_RT + 128 * 1024); const int* rt_pos = (const int*)(p.ws + WS_RT + 256 * 1024);
    const bf16* YS = (const bf16*)(p.ws + WS_HS); const float* modv = (const float*)(p.ws + WS_MODV) + (size_t)1 * 3 * 6144; const float* fw = IN(29);
    const int nw = gridDim.x * NWAVES, rpw = (NLAT + nw - 1) / nw, gw = blockIdx.x * NWAVES + wid;
    const int row0 = gw * rpw, row1 = (row0 + rpw < NLAT) ? row0 + rpw : NLAT;
    f32x4 fwv[4], gv[4]; int rc = -1;
#pragma unroll
    for (int j = 0; j < 4; ++j) fwv[j] = *(const f32x4*)(fw + (j * 64 + lane) * 4);
    for (int row = row0; row < row1; ++row) {
        const int b = row >> 13; float* x = p.out + (size_t)row * D;
        if (b != rc) { rc = b;
#pragma unroll
            for (int j = 0; j < 4; ++j) gv[j] = *(const f32x4*)(modv + b * 6144 + 5 * 1024 + (j * 64 + lane) * 4); }
        const float g0 = rt_g[row * 2], g1 = rt_g[row * 2 + 1]; const bf16* y0 = YS + (size_t)rt_pos[row * 2] * D; const bf16* y1 = YS + (size_t)rt_pos[row * 2 + 1] * D;
        f32x4 v[4]; float ss = 0.f;
#pragma unroll
        for (int j = 0; j < 4; ++j) { const int c0 = (j * 64 + lane) * 4; const f32x4 xv = *(const f32x4*)(x + c0); const u32x2 a = *(const u32x2*)(y0 + c0), c = *(const u32x2*)(y1 + c0);
            const f32x4 ya = {bf2f(a.x & 0xffff), bf2f(a.x >> 16), bf2f(a.y & 0xffff), bf2f(a.y >> 16)}, yb = {bf2f(c.x & 0xffff), bf2f(c.x >> 16), bf2f(c.y & 0xffff), bf2f(c.y >> 16)};
            v[j] = xv + gv[j] * (ya * g0 + yb * g1); ss += v[j][0] * v[j][0] + v[j][1] * v[j][1] + v[j][2] * v[j][2] + v[j][3] * v[j][3]; }
        ss = wave_sum(ss); const float rstd = 1.0f / sqrtf(ss * (1.f / D) + EPS);
#pragma unroll
        for (int j = 0; j < 4; ++j) { const int c0 = (j * 64 + lane) * 4; *(f32x4*)(x + c0) = v[j] * rstd * fwv[j]; }
    }
}

#define XB_TMO      128
#define XB_XCNT(j)  (256  + 64 * (j))
#define XB_XSUB(j)  (1280 + 64 * (j))
#define XB_XGEN(j)  (2304 + 64 * (j))
#define XB_TOP      3328
#define XB_TOPGEN   3392
#define XCD_BAR_WORDS 3456
#define XB_SPIN_CAP (1u << 22)
DEVI unsigned xb_ld(unsigned* p)              { return __hip_atomic_load(p, __ATOMIC_RELAXED, __HIP_MEMORY_SCOPE_AGENT); }
DEVI unsigned xb_add(unsigned* p, unsigned v) { return __hip_atomic_fetch_add(p, v, __ATOMIC_RELAXED, __HIP_MEMORY_SCOPE_AGENT); }
DEVI unsigned xb_xcc_id() { return (unsigned)__builtin_amdgcn_s_getreg((3 << 11) | 20) & 0xFu; }
#define XB_SPIN(cond, bar) do { unsigned _sp = 0; while (cond) { __builtin_amdgcn_s_sleep(1); \
    if ((++_sp & 255u) == 0u) { if (xb_ld(&(bar)[XB_TMO])) break; if (_sp > XB_SPIN_CAP) { atomicAdd(&(bar)[XB_TMO], 1u); break; } } } } while (0)
struct XcdBarrier { unsigned* bar; unsigned x; volatile LAS unsigned* st; };
DEVI XcdBarrier xcd_barrier_post(unsigned* bar, volatile LAS unsigned* st) {
    XcdBarrier b; b.bar = bar; b.x = xb_xcc_id(); b.st = st;
    if (threadIdx.x == 0) (void)xb_add(&bar[XB_XCNT(b.x)], 1u);
    return b;
}
DEVI void xcd_barrier_complete(unsigned* bar, unsigned x, unsigned& nloc, unsigned& nx) {
    const unsigned G = gridDim.x * gridDim.y * gridDim.z;
    unsigned sum, cnt, mine, sp = 0u;
    for (;;) {
        sum = 0u; cnt = 0u; mine = 0u;
#pragma unroll
        for (unsigned j = 0; j < 16; ++j) { const unsigned c = xb_ld(&bar[XB_XCNT(j)]); sum += c; cnt += (c > 0u) ? 1u : 0u; mine = (j == x) ? c : mine; }
        if (sum == G) break;
        __builtin_amdgcn_s_sleep(1);
        if ((++sp & 255u) == 0u) { if (xb_ld(&bar[XB_TMO])) break; if (sp > XB_SPIN_CAP) { atomicAdd(&bar[XB_TMO], 1u); break; } }
    }
    nloc = mine > 0u ? mine : 1u; nx = cnt > 0u ? cnt : 1u;
}
DEVI void xcd_barrier(const XcdBarrier& b) {
    asm volatile("s_waitcnt vmcnt(0)" ::: "memory");
    __syncthreads();
    if (threadIdx.x == 0) {
        unsigned* bar = b.bar;
        __builtin_amdgcn_s_waitcnt(0);
        unsigned nloc = b.st[0], nx = b.st[1];
        if (nloc == 0u) { xcd_barrier_complete(bar, b.x, nloc, nx); b.st[0] = nloc; b.st[1] = nx; }
        const unsigned old = xb_add(&bar[XB_XSUB(b.x)], 1u);
        const unsigned gen = old / nloc;
        if (old + 1u == (gen + 1u) * nloc) {
            __builtin_amdgcn_fence(__ATOMIC_RELEASE, "agent");
            asm volatile("s_waitcnt vmcnt(0)" ::: "memory");
            const unsigned og = xb_add(&bar[XB_TOP], 1u);
            const unsigned tg = og / nx;
            if (og + 1u == (tg + 1u) * nx) xb_add(&bar[XB_TOPGEN], 1u);
            else XB_SPIN(xb_ld(&bar[XB_TOPGEN]) == tg, bar);
            __builtin_amdgcn_fence(__ATOMIC_ACQUIRE, "agent");
            xb_add(&bar[XB_XGEN(b.x)], 1u);
            asm volatile("s_waitcnt vmcnt(0)" ::: "memory");
        } else {
            XB_SPIN(xb_ld(&bar[XB_XGEN(b.x)]) == gen, bar);
            __builtin_amdgcn_fence(__ATOMIC_ACQUIRE, "agent");
            asm volatile("s_waitcnt vmcnt(0)" ::: "memory");
        }
    }
    __syncthreads();
}

constexpr int NPHASES = 24;
#ifndef XSYNC
#define XSYNC 0
#endif
#ifndef REP_MASK
#define REP_MASK 0u
#endif
#ifndef PH_MASK
#define PH_MASK 0xffffu
#endif
__global__ void __launch_bounds__(NTHREADS, 2) mk_fwd(P p) {
    extern __shared__ __attribute__((aligned(16))) unsigned char lds[];
    cg::grid_group grid = cg::this_grid();
    const int G = gridDim.x, c = blockIdx.x;
    if (threadIdx.x < 30) ((lds_u64*)(uintptr_t)LDS_PTRS)[threadIdx.x] = (unsigned long long)p.in[threadIdx.x];
    if (threadIdx.x < 2) ((volatile LAS unsigned*)(uintptr_t)LDS_MISC)[threadIdx.x] = 0u;
    __syncthreads();
    XcdBarrier xbar = xcd_barrier_post((unsigned*)(p.ws + WS_CTL) + 1024, (volatile LAS unsigned*)(uintptr_t)LDS_MISC);
    int nsync = 0;
#define GRID_BAR() do { if (nsync == 0) grid.sync(); else xcd_barrier(xbar); ++nsync; } while (0)
    int ph = 0;
#define RUN(kid, ...) do { if (((PH_MASK >> (kid)) & 1u) && ph >= p.ph_lo && ph < p.ph_hi) { __VA_ARGS__; if ((REP_MASK >> (kid)) & 1u) { __VA_ARGS__; } if (ph + 1 < p.ph_hi) { GRID_BAR(); for (int xs_ = 0; xs_ < XSYNC; ++xs_) GRID_BAR(); } } ++ph; } while (0)
    RUN(0, ph_pro(p, lds));
#define LAYER(l) \
        RUN(1, ph_norm<false>(p, l, 0, T, lds, l == 1 ? 11 : 0, 5)); \
        RUN(2, { Gemm g{(const bf16*)(p.ws + WS_HM), (const bf16*)(p.ws + WS_WIN) + (size_t)l * INWP * 1024, 0}; DenseSched S{T / 256, INWP / 256, G, c}; \
            EpiInProj E{(bf16*)(p.ws + WS_PROJ), (float*)(p.ws + WS_DT), IN(18) + l * 16, IN(19) + l * 16}; gemm_phase<D, 1024, 1024>(lds, g, S, E); }); \
        RUN(3, ph_conv(p, l)); \
        RUN(4, { Gemm g{(const bf16*)(p.ws + WS_PROJ), (const bf16*)(p.ws + WS_WQKV) + (size_t)l * 1024 * 384, 0}; DenseSched S{T / 256, 4, G, c}; \
            EpiMla E{(bf16*)(p.ws + WS_Q), (bf16*)(p.ws + WS_K), (bf16*)(p.ws + WS_V), (const float*)(p.ws + WS_RQ), (const float*)(p.ws + WS_RKV), (const float*)(p.ws + WS_ROPE)}; gemm_phase<INWP, 384, 384>(lds, g, S, E); ph_scanA(p, l, lds); }); \
        RUN(5, ph_mixer(p, l, lds)); \
        RUN(6, ph_scanC(p, l, lds)); \
        if (l == 1) RUN(7, ph_moew(p, lds)); \
        RUN(8, { Gemm g{(const bf16*)(p.ws + WS_HM), (const bf16*)(p.ws + WS_WOUT) + (size_t)l * 1024 * 1024, 0}; DenseSched S{NLAT / 256, 4, G, c}; \
            EpiResid E{l == 0 ? IN(0) : p.out, (const float*)(p.ws + WS_XC), p.out, (float*)(p.ws + WS_XC), (const float*)(p.ws + WS_MODV) + (size_t)l * 3 * 6144, 2}; gemm_phase<D, 1024, 1024>(lds, g, S, E); \
            if (l == 0) { CtxSplitSched S2{4, 256 * 2, G, c}; EpiPart E2{(float*)(p.ws + WS_XBC)}; gemm_phase<D, 1024, 256>(lds, g, S2, E2); } }); \
        RUN(9, ph_norm<l == 1>(p, l, 1, l == 0 ? T : NLAT, lds, l == 0 ? 4 : 0, 2)); \
        if (l == 0) { \
            RUN(10, { Gemm g{(const bf16*)(p.ws + WS_HM), (const bf16*)(p.ws + WS_WGU), 0}; DenseSched S{T / 256, 2 * DFF / 256, G, c}; \
                EpiSwiglu E{(bf16*)(p.ws + WS_PROJ), DFF}; gemm_phase<D, 1024, 1024>(lds, g, S, E); }); \
            RUN(11, { Gemm g{(const bf16*)(p.ws + WS_PROJ), (const bf16*)(p.ws + WS_WD), 0}; DenseSched S{NLAT / 256, 4, G, c}; \
                EpiResid E{p.out, (const float*)(p.ws + WS_XC), p.out, (float*)(p.ws + WS_XC), (const float*)(p.ws + WS_MODV), 5}; gemm_phase<DFF, DFF, DFF>(lds, g, S, E); \
                CtxSplitSched S2{11, 256 * 2, G, c}; EpiPart E2{(float*)(p.ws + WS_XBC)}; gemm_phase<DFF, DFF, 256>(lds, g, S2, E2); }); \
        } else { \
            RUN(12, ph_sort(p, lds)); \
            RUN(13, { Gemm g{(const bf16*)(p.ws + WS_HS), (const bf16*)(p.ws + WS_WGUE), (size_t)2 * DFE * 1024}; MoeSched S{(const int*)(p.ws + WS_RT + 384 * 1024), 2 * DFE / 256, G, c}; \
                EpiSwiglu E{(bf16*)(p.ws + WS_ACTS), DFE}; gemm_phase<D, 1024, 1024>(lds, g, S, E); }); \
            RUN(14, { Gemm g{(const bf16*)(p.ws + WS_ACTS), (const bf16*)(p.ws + WS_WDE), (size_t)1024 * DFE}; MoeSched S{(const int*)(p.ws + WS_RT + 384 * 1024), 4, G, c}; \
                EpiStore E{(bf16*)(p.ws + WS_HS), D}; gemm_phase<DFE, DFE, DFE>(lds, g, S, E); }); \
            RUN(15, ph_final(p)); \
        }
    LAYER(0)
    LAYER(1)
#undef LAYER
#undef RUN
}

#ifndef MK_ONE_LAUNCH
#define MK_ONE_LAUNCH 1
#endif
extern "C" void kernel_launch(void* const* d_in, const int* in_sizes, int n_in, void* d_out, int out_size, void* d_ws, size_t ws_size, hipStream_t stream) {
    static int grid = 0;
    if (grid == 0) {
        if (n_in != 30 || out_size != NLAT * D || ws_size < WS_END) { fprintf(stderr, "kernel_launch: unexpected problem (n_in %d out %d ws %zu, need %zu)\n", n_in, out_size, ws_size, (size_t)WS_END); grid = -1; return; }
        int dev = 0, cus = 0, per_cu = 0;
        hipGetDevice(&dev); hipDeviceGetAttribute(&cus, hipDeviceAttributeMultiprocessorCount, dev);
        if (hipFuncSetAttribute((const void*)mk_fwd, hipFuncAttributeMaxDynamicSharedMemorySize, LDS_BYTES) != hipSuccess) { fprintf(stderr, "kernel_launch: hipFuncSetAttribute failed\n"); grid = -1; return; }
        if (hipOccupancyMaxActiveBlocksPerMultiprocessor(&per_cu, (const void*)mk_fwd, NTHREADS, LDS_BYTES) != hipSuccess || per_cu < 1) { fprintf(stderr, "kernel_launch: occupancy query failed (%d)\n", per_cu); grid = -1; return; }
        grid = cus;
        fprintf(stderr, "kernel_launch: grid %d (cus %d, per_cu %d)\n", grid, cus, per_cu);
    }
    if (grid < 0) return;
    if (hipMemsetAsync((char*)d_ws + WS_CTL, 0, 65536, stream) != hipSuccess) { fprintf(stderr, "kernel_launch: memset failed\n"); return; }
    P p{};
    for (int i = 0; i < 30; ++i) p.in[i] = (const float*)d_in[i];
    p.out = (float*)d_out; p.ws = (unsigned char*)d_ws;
#if MK_ONE_LAUNCH
    p.ph_lo = 0; p.ph_hi = NPHASES;
    { void* args[] = {&p}; hipError_t e = hipLaunchCooperativeKernel((const void*)mk_fwd, dim3(grid), dim3(NTHREADS), args, LDS_BYTES, stream);
      if (e != hipSuccess) fprintf(stderr, "cooperative launch failed: %s\n", hipGetErrorString(e)); }
#else
    for (int ph = 0; ph < NPHASES; ++ph) {
        p.ph_lo = ph; p.ph_hi = ph + 1;
        void* args[] = {&p}; hipError_t e = hipLaunchCooperativeKernel((const void*)mk_fwd, dim3(grid), dim3(NTHREADS), args, LDS_BYTES, stream);
        if (e != hipSuccess) { fprintf(stderr, "cooperative launch %d failed: %s\n", ph, hipGetErrorString(e)); break; }
    }
#endif
}
```

```cpp
#include <hip/hip_runtime.h>
#include <hip/hip_cooperative_groups.h>
#include <cstdio>
#include <cstdint>
namespace cg = cooperative_groups;
#ifndef ATTN_PROBE
#define ATTN_PROBE 0
#endif

#define DEVI __device__ __forceinline__
typedef unsigned short bf16;
typedef short bf16x8 __attribute__((ext_vector_type(8)));
typedef float f32x4 __attribute__((ext_vector_type(4)));
typedef float f32x2 __attribute__((ext_vector_type(2)));
typedef float f32x16 __attribute__((ext_vector_type(16)));
typedef unsigned u32x4 __attribute__((ext_vector_type(4)));
typedef unsigned u32x2 __attribute__((ext_vector_type(2)));
typedef __bf16 bf16x2_t __attribute__((ext_vector_type(2)));

constexpr int D = 1024, NB = 2, SEQ = 8192, NLAT = NB * SEQ, CL = 256, NCTX = NB * CL, T = NLAT + NCTX;
constexpr int INW = 2736, INWP = 2816;
constexpr int C_CQ = 0, C_CKV = 256, C_KPE = 384, C_RQ = 416, C_RK = 672, C_RV = 928, C_RG = 1184, C_Z = 1440, C_XBC = 1952, C_DTF = 2720, C_DTB = 2728;
constexpr int DFF = 2816, DFE = 1408, NEXP = 8;
constexpr float EPS = 1e-6f;
constexpr int MOE_MAXROWS = 34816;

constexpr size_t MiB = 1u << 20;
constexpr size_t WS_CTL = 0;
constexpr size_t WS_MODV = 1 * MiB;
constexpr size_t WS_ROPE = WS_MODV + 256 * 1024;
constexpr size_t WS_RQ = WS_MODV + 512 * 1024;
constexpr size_t WS_RKV = WS_MODV + 640 * 1024;
constexpr size_t WS_WIN = 2 * MiB;
constexpr size_t WS_WQKV = 13 * MiB;
constexpr size_t WS_WOUT = 15 * MiB;
constexpr size_t WS_WGU = 19 * MiB;
constexpr size_t WS_WD = 30 * MiB;
constexpr size_t WS_XC = 36 * MiB;
constexpr size_t WS_RT = 38 * MiB;
constexpr size_t WS_DT = 39 * MiB;
constexpr size_t DYN = 42 * MiB;
constexpr size_t WS_HM = DYN;
constexpr size_t WS_PROJ = DYN + 33 * MiB;
constexpr size_t WS_XBC = DYN + 124 * MiB;
constexpr size_t WS_Q = DYN + 149 * MiB;
constexpr size_t WS_K = DYN + 161 * MiB + 512 * 1024;
constexpr size_t WS_V = DYN + 174 * MiB;
constexpr size_t WS_ST = DYN + 182 * MiB + 512 * 1024;
constexpr size_t WS_HT = WS_ST + (size_t)1584 * 2 * 4096 * 4;
constexpr size_t WS_CD = WS_RT + 512 * 1024;
constexpr size_t WS_VEC = WS_HT + (size_t)1584 * 2 * 4096 * 2;
constexpr size_t WS_WGUE = DYN + 33 * MiB;
constexpr size_t WS_WDE = DYN + 77 * MiB;
constexpr size_t WS_HS = DYN + 99 * MiB;
constexpr size_t WS_ACTS = DYN + 167 * MiB;
constexpr size_t WS_END = DYN + 261 * MiB;
static_assert(WS_HM + (size_t)T * 1024 * 2 <= WS_PROJ && WS_PROJ + (size_t)T * 2816 * 2 <= WS_XBC && WS_XBC + (size_t)T * 768 * 2 <= WS_Q &&
              WS_Q + (size_t)T * 384 * 2 <= WS_K && WS_K + (size_t)T * 384 * 2 <= WS_V && WS_V + (size_t)T * 256 * 2 <= WS_ST && WS_VEC + (size_t)1584 * 512 * 4 <= WS_END, "ws map (mixer)");
static_assert(WS_WGUE + (size_t)8 * 2816 * 1024 * 2 <= WS_WDE && WS_WDE + (size_t)8 * 1024 * 1408 * 2 <= WS_HS && WS_HS + (size_t)MOE_MAXROWS * 1024 * 2 <= WS_ACTS &&
              WS_ACTS + (size_t)MOE_MAXROWS * 1408 * 2 <= WS_END, "ws map (moe)");
static_assert(WS_DT + (size_t)T * 32 * 4 <= DYN && WS_WD + (size_t)1024 * 2816 * 2 <= WS_XC && WS_WIN + (size_t)2 * 2816 * 1024 * 2 <= WS_WQKV, "ws map (static)");

constexpr int NTHREADS = 512, NWAVES = 8;
constexpr int LDS_BYTES = 147456;

struct P { const float* in[30]; float* out; unsigned char* ws; int ph_lo, ph_hi; };
constexpr int LDS_MISC = 147456 - 512;
constexpr int LDS_PTRS = 147456 - 256;
typedef __attribute__((address_space(3))) unsigned long long lds_u64;
DEVI const float* inptr(int i) {
    const unsigned long long v = ((lds_u64*)(uintptr_t)LDS_PTRS)[i];
    const unsigned lo = __builtin_amdgcn_readfirstlane((unsigned)v), hi = __builtin_amdgcn_readfirstlane((unsigned)(v >> 32));
    return (const float*)(((unsigned long long)hi << 32) | lo);
}
#define IN(i) inptr(i)
DEVI int otid() { int t = threadIdx.x; asm volatile("" : "+v"(t)); return t; }

DEVI float bf2f(bf16 x) { return __uint_as_float(((unsigned)x) << 16); }
DEVI unsigned pk2(float lo, float hi) { f32x2 v = {lo, hi}; bf16x2_t b = __builtin_convertvector(v, bf16x2_t); return __builtin_bit_cast(unsigned, b); }
DEVI bf16 f2bf(float x) { return (bf16)(pk2(x, 0.f) & 0xffffu); }
DEVI float wave_sum(float v) {
#pragma unroll
    for (int o = 1; o < 64; o <<= 1) v += __shfl_xor(v, o);
    return v;
}
DEVI float siluf(float x) { return x / (1.f + __expf(-x)); }
DEVI float softplusf(float x) { return fmaxf(x, 0.f) + log1pf(__expf(-fabsf(x))); }
DEVI int rope_src(int p) { const int q = p & 15, s = (q & 1) ? 8 + (q >> 1) : (q >> 1); return (p & 16) + s; }

#define LAS __attribute__((address_space(3)))
struct Unit { int pm, pn, e, koff; };
struct Gemm { const bf16* A; const bf16* Bt; size_t bstride; const int* rowtab; };
constexpr int BM = 256, BK = 64, HALF = 128, HTB = HALF * BK * 2, STAGE_BYTES = 8 * HTB, NXCD = 8, WGM = 8;
__host__ __device__ __forceinline__ int lds_byte(int r, int c) { const int st = (r >> 4) * 2 + (c >> 5), rr = r & 15, cc = c & 31, ob = rr * 64 + cc * 2; return st * 1024 + (ob ^ (((ob >> 9) & 1) << 5)); }
__host__ __device__ __forceinline__ void stage_rc(int b, int& R, int& C) { const int st = b / 1024, sb = b % 1024, swz = sb ^ (((sb >> 9) & 1) << 5); R = (st >> 1) * 16 + swz / 64; C = (st & 1) * 32 + (swz % 64) / 2; }
struct DenseSched {
    int nM, nN, G, c;
    DEVI bool next(int i, Unit& u) const {
        const int nwg = nM * nN; const long L = (long)i * G + c; if (L >= nwg) return false;
        int wgid = (int)L; { const int q = nwg / NXCD, r = nwg % NXCD, xcd = wgid % NXCD, off = wgid / NXCD; wgid = (xcd < r ? xcd * (q + 1) : r * (q + 1) + (xcd - r) * q) + off; }
        const int nig = WGM * nN, gid = wgid / nig, fm = gid * WGM, gsz = (nM - fm) < WGM ? (nM - fm) : WGM;
        u.pm = fm + ((wgid % nig) % gsz); u.pn = (wgid % nig) / gsz; u.e = 0; u.koff = 0; return true;
    }
};
struct CtxSplitSched {
    int nsplit, kbytes, G, c;
    DEVI bool next(int i, Unit& u) const { const int id = i * G + c; if (id >= 8 * nsplit) return false; const int tile = id & 7, ks = id >> 3; u.pm = 64 + (tile >> 2); u.pn = tile & 3; u.e = ks; u.koff = ks * kbytes; return true; }
};
struct MoeSched {
    const int* tab; int nN, G, c;
    DEVI bool next(int i, Unit& u) const { DenseSched d{tab[0], nN, G, c}; if (!d.next(i, u)) return false; u.e = tab[1 + u.pm]; return true; }
};
template <int LDA, int LDB, int KK, class Epi, class Sched, bool GATHER = false>
DEVI void gemm_phase(unsigned char* lds_generic, const Gemm g, const Sched& S, const Epi& E) {
    LAS unsigned char* lds = (LAS unsigned char*)lds_generic;
    const int tid = otid(), wid = __builtin_amdgcn_readfirstlane(tid >> 6), lane = tid & 63, wr = wid >> 2, wc = wid & 3, fr = lane & 15, fq = lane >> 4;
    constexpr int nt = KK / BK; static_assert(KK % 128 == 0, "K must be a multiple of 128");
    unsigned voffA[2], voffB[2]; int Rr[2], Cc[2];
#pragma unroll
    for (int i = 0; i < 2; ++i) { int R, C; stage_rc(tid * 16 + i * 8192, R, C); Rr[i] = R; Cc[i] = C; voffA[i] = (unsigned)(R * LDA + C) * 2u; voffB[i] = (unsigned)(R * LDB + C) * 2u; }
    unsigned cv0[2] = {voffA[0], voffA[1]}, cv1[2] = {voffA[0], voffA[1]}, nv0[2] = {voffA[0], voffA[1]}, nv1[2] = {voffA[0], voffA[1]};
#define PG8_ROWS(u, v0, v1) do { if (GATHER) { _Pragma("unroll") for (int i_ = 0; i_ < 2; ++i_) { v0[i_] = (unsigned)(g.rowtab[(u).pm * BM + Rr[i_]] * LDA + Cc[i_]) * 2u; v1[i_] = (unsigned)(g.rowtab[(u).pm * BM + HALF + Rr[i_]] * LDA + Cc[i_]) * 2u; } } } while (0)
    constexpr size_t kstep = (size_t)(BK * 2), hstepA = GATHER ? (size_t)0 : (size_t)HALF * LDA * 2, hstepB = (size_t)HALF * LDB * 2, tstepA = GATHER ? (size_t)0 : (size_t)2 * HALF * LDA * 2, tstepB = 2 * hstepB;
    const unsigned ldsw = (unsigned)wid * 1024u;
    const int aoff = lds_byte(wr * 64 + fr, fq * 8), boff = lds_byte(wc * 32 + fr, fq * 8);
#define PG8_SA(b, h) (((b) * 2 + (h)) * HTB)
#define PG8_SB(b, h) ((4 + (b) * 2 + (h)) * HTB)
#define PG8_STAGE(bufoff, gbase, voff) do { _Pragma("unroll") for (int _i = 0; _i < 2; ++_i) \
        __builtin_amdgcn_global_load_lds((const unsigned*)((const char*)(gbase) + (voff)[_i]), (LAS unsigned*)(lds + (bufoff) + ldsw + _i * 8192), 16, 0, 0); } while (0)
#define PG8_LDA(dst, b, h) do { _Pragma("unroll") for (int m = 0; m < 4; ++m) _Pragma("unroll") for (int k = 0; k < 2; ++k) dst[m][k] = *(const LAS bf16x8*)(lds + PG8_SA(b, h) + aoff + m * 2048 + k * 1024); } while (0)
#define PG8_LDB(dst, b, h) do { _Pragma("unroll") for (int n = 0; n < 2; ++n) _Pragma("unroll") for (int k = 0; k < 2; ++k) dst[n][k] = *(const LAS bf16x8*)(lds + PG8_SB(b, h) + boff + n * 2048 + k * 1024); } while (0)
#define PG8_MMA(ai, bj, At, Bt) do { __builtin_amdgcn_s_setprio(1); _Pragma("unroll") for (int m = 0; m < 4; ++m) _Pragma("unroll") for (int n = 0; n < 2; ++n) _Pragma("unroll") for (int k = 0; k < 2; ++k) \
        acc[ai][bj][m][n] = __builtin_amdgcn_mfma_f32_16x16x32_bf16(Bt[n][k], At[m][k], acc[ai][bj][m][n], 0, 0, 0); __builtin_amdgcn_s_setprio(0); } while (0)
#define PG8_WAIT_V(n) asm volatile("s_waitcnt vmcnt(" #n ")" ::: "memory")
#define PG8_WAIT_L(n) asm volatile("s_waitcnt lgkmcnt(" #n ")" ::: "memory")
#define PG8_BAR __builtin_amdgcn_s_barrier()
#define PG8_SCHED __builtin_amdgcn_sched_barrier(0)
    Unit cur, nxt; int ui = 0;
    if (!S.next(0, cur)) return;
    f32x4 acc[2][2][4][2];
#pragma unroll
    for (int a = 0; a < 2; ++a)
#pragma unroll
        for (int b = 0; b < 2; ++b)
#pragma unroll
            for (int m = 0; m < 4; ++m)
#pragma unroll
                for (int n = 0; n < 2; ++n) acc[a][b][m][n] = (f32x4){0.f, 0.f, 0.f, 0.f};
    bf16x8 At[4][2], B0[2][2], B1[2][2];
    const char* cA = (const char*)g.A + (size_t)cur.pm * tstepA + cur.koff; const char* cB = (const char*)(g.Bt + (size_t)cur.e * g.bstride) + (size_t)cur.pn * tstepB + cur.koff;
    PG8_WAIT_V(0); PG8_WAIT_L(0); __syncthreads();
    PG8_ROWS(cur, cv0, cv1);
    PG8_STAGE(PG8_SB(0, 0), cB, voffB); PG8_STAGE(PG8_SB(0, 1), cB + hstepB, voffB); PG8_STAGE(PG8_SA(0, 0), cA, cv0); PG8_STAGE(PG8_SA(0, 1), cA + hstepA, cv1);
    if (wr == 1) PG8_BAR;
    PG8_WAIT_V(2); PG8_BAR;
    PG8_STAGE(PG8_SB(1, 0), cB + kstep, voffB); PG8_STAGE(PG8_SA(1, 0), cA + kstep, cv0); PG8_STAGE(PG8_SB(1, 1), cB + hstepB + kstep, voffB);
    PG8_WAIT_V(6); PG8_BAR;
    for (;;) {
        const bool has_next = S.next(ui + 1, nxt);
        if (has_next) PG8_ROWS(nxt, nv0, nv1);
        const char* nA = has_next ? (const char*)g.A + (size_t)nxt.pm * tstepA + nxt.koff : cA; const char* nB = has_next ? (const char*)(g.Bt + (size_t)nxt.e * g.bstride) + (size_t)nxt.pn * tstepB + nxt.koff : cB;
#pragma unroll 1
        for (int t = 0; t < nt; t += 2) {
            const bool last = (t == nt - 2);
            const char* a1 = cA + (size_t)(t + 1) * kstep;
            const char* a2 = last ? nA : cA + (size_t)(t + 2) * kstep; const char* b2 = last ? nB : cB + (size_t)(t + 2) * kstep;
            const char* a3 = a2 + kstep; const char* b3 = b2 + kstep;
            unsigned s0[2] = {cv0[0], cv0[1]}, s1[2] = {cv1[0], cv1[1]};
            if (GATHER && last && has_next) { s0[0] = nv0[0]; s0[1] = nv0[1]; s1[0] = nv1[0]; s1[1] = nv1[1]; }
            PG8_LDB(B0, 0, 0); PG8_LDB(B1, 0, 1); PG8_SCHED; PG8_LDA(At, 0, 0); PG8_STAGE(PG8_SA(1, 1), a1 + hstepA, cv1);
            PG8_WAIT_V(8); PG8_WAIT_L(0); PG8_BAR; PG8_MMA(0, 0, At, B0); PG8_MMA(0, 1, At, B1); PG8_BAR; PG8_SCHED;
            PG8_LDA(At, 0, 1); PG8_STAGE(PG8_SB(0, 0), b2, voffB); PG8_STAGE(PG8_SB(0, 1), b2 + hstepB, voffB); PG8_STAGE(PG8_SA(0, 0), a2, s0);
            PG8_WAIT_V(8); PG8_WAIT_L(0); PG8_BAR; PG8_MMA(1, 0, At, B0); PG8_MMA(1, 1, At, B1); PG8_BAR; PG8_SCHED;
            PG8_LDB(B0, 1, 0); PG8_LDB(B1, 1, 1); PG8_SCHED; PG8_LDA(At, 1, 0); PG8_STAGE(PG8_SA(0, 1), a2 + hstepA, s1);
            PG8_WAIT_V(8); PG8_WAIT_L(0); PG8_BAR; PG8_MMA(0, 0, At, B0); PG8_MMA(0, 1, At, B1); PG8_BAR; PG8_SCHED;
            PG8_LDA(At, 1, 1); PG8_STAGE(PG8_SB(1, 0), b3, voffB); PG8_STAGE(PG8_SB(1, 1), b3 + hstepB, voffB); PG8_STAGE(PG8_SA(1, 0), a3, s0);
            PG8_WAIT_V(8); PG8_WAIT_L(0); PG8_BAR; PG8_MMA(1, 0, At, B0); PG8_MMA(1, 1, At, B1); PG8_BAR; PG8_SCHED;
        }
        if (wr == 0) PG8_BAR;
        E(acc, cur, wr, wc, fr, fq);
        if (!has_next) break;
#pragma unroll
        for (int a = 0; a < 2; ++a)
#pragma unroll
            for (int b = 0; b < 2; ++b)
#pragma unroll
                for (int m = 0; m < 4; ++m)
#pragma unroll
                    for (int n = 0; n < 2; ++n) acc[a][b][m][n] = (f32x4){0.f, 0.f, 0.f, 0.f};
        cur = nxt; cA = nA; cB = nB; ++ui;
        if (GATHER) { cv0[0] = nv0[0]; cv0[1] = nv0[1]; cv1[0] = nv1[0]; cv1[1] = nv1[1]; }
        if (wr == 1) PG8_BAR;
    }
    PG8_WAIT_V(0);
    PG8_BAR;
#undef PG8_ROWS
#undef PG8_SA
#undef PG8_SB
#undef PG8_STAGE
#undef PG8_LDA
#undef PG8_LDB
#undef PG8_MMA
#undef PG8_WAIT_V
#undef PG8_WAIT_L
#undef PG8_BAR
#undef PG8_SCHED
}
#define EPI_LOOP_ROWS _Pragma("unroll") for (int ai = 0; ai < 2; ++ai) _Pragma("unroll") for (int m = 0; m < 4; ++m)
#define EPI_ROW (u.pm * 256 + ai * 128 + wr * 64 + m * 16 + fr)
#define EPI_COL(bj, n) (u.pn * 256 + (bj) * 128 + wc * 32 + (n) * 16 + fq * 4)

DEVI void st_bf16x4(bf16* p, f32x4 v) { u32x2 w; w.x = pk2(v[0], v[1]); w.y = pk2(v[2], v[3]); *(u32x2*)p = w; }

struct EpiInProj {
    bf16* proj; float* dt; const float* dt_bias; const float* a_log;
    DEVI void operator()(const f32x4 (&acc)[2][2][4][2], const Unit& u, int wr, int wc, int fr, int fq) const {
        EPI_LOOP_ROWS { const int row = EPI_ROW;
#pragma unroll
            for (int bj = 0; bj < 2; ++bj)
#pragma unroll
                for (int n = 0; n < 2; ++n) { const int col = EPI_COL(bj, n); const f32x4 v = acc[ai][bj][m][n];
                    if (col < C_DTF) st_bf16x4(proj + (size_t)row * INWP + col, v);
                    else if (col < INW) { const int j0 = col - C_DTF; f32x4 dv, lv;
#pragma unroll
                        for (int i = 0; i < 4; ++i) { const float d_ = softplusf(v[i] + dt_bias[j0 + i]); dv[i] = d_; lv[i] = -d_ * __expf(a_log[j0 + i]); }
                        *(f32x4*)(dt + (size_t)row * 32 + j0) = dv; *(f32x4*)(dt + (size_t)row * 32 + 16 + j0) = lv; } } }
    }
};
struct EpiMla {
    bf16 *Q, *K, *V; const float *rq, *rkv; const float* rope;
    DEVI void operator()(const f32x4 (&acc)[2][2][4][2], const Unit& u, int wr, int wc, int fr, int fq) const {
        EPI_LOOP_ROWS { const int row = EPI_ROW; const float sq = rq[row], skv = rkv[row];
#pragma unroll
            for (int bj = 0; bj < 2; ++bj)
#pragma unroll
                for (int n = 0; n < 2; ++n) { const int col = EPI_COL(bj, n); f32x4 v = acc[ai][bj][m][n];
                    if (col < 384) { v = v * sq; const int d = col % 96;
                        if (d >= 64 && row < NLAT) { const int pos = row & (SEQ - 1), gr = pos >> 6, gc = pos & 63, pp = (d - 64) >> 1;
#pragma unroll
                            for (int i = 0; i < 2; ++i) { const int pi = pp + i; const float* tb = (pi < 8) ? rope + (gr * 8 + pi) * 2 : rope + 2048 + (gc * 8 + (pi - 8)) * 2;
                                const float c = tb[0], s = tb[1], x0 = v[2 * i], x1 = v[2 * i + 1]; v[2 * i] = x0 * c - x1 * s; v[2 * i + 1] = x1 * c + x0 * s; } }
                        st_bf16x4(Q + (size_t)row * 384 + col, v); }
                    else if (col >= 512 && col < 768) { const int c = col - 512; st_bf16x4(K + (size_t)row * 384 + (c >> 6) * 96 + (c & 63), v * skv); }
                    else if (col >= 768) { st_bf16x4(V + (size_t)row * 256 + (col - 768), v * skv); } }
            asm volatile("" ::: "memory"); }
    }
};
struct EpiResid {
    const float* src_lat; const float* src_ctx; float* dst_lat; float* dst_ctx; const float* modv_l; int gidx;
    DEVI void operator()(const f32x4 (&acc)[2][2][4][2], const Unit& u, int wr, int wc, int fr, int fq) const {
        EPI_LOOP_ROWS { const int row = EPI_ROW; const bool lat = row < NLAT; const int r = lat ? (row >> 13) : 2;
            const float* s = lat ? src_lat + (size_t)row * D : src_ctx + (size_t)(row - NLAT) * D; float* d = lat ? dst_lat + (size_t)row * D : dst_ctx + (size_t)(row - NLAT) * D;
            const float* gp = modv_l + r * 6144 + gidx * 1024;
#pragma unroll
            for (int bj = 0; bj < 2; ++bj)
#pragma unroll
                for (int n = 0; n < 2; ++n) { const int col = EPI_COL(bj, n); const f32x4 gv = *(const f32x4*)(gp + col), sv = *(const f32x4*)(s + col);
                    *(f32x4*)(d + col) = sv + gv * acc[ai][bj][m][n]; } }
    }
};
struct EpiPart {
    float* part;
    DEVI void operator()(const f32x4 (&acc)[2][2][4][2], const Unit& u, int wr, int wc, int fr, int fq) const {
        EPI_LOOP_ROWS { const int row = EPI_ROW; float* d = part + ((size_t)u.e * NCTX + (row - NLAT)) * D;
#pragma unroll
            for (int bj = 0; bj < 2; ++bj)
#pragma unroll
                for (int n = 0; n < 2; ++n) *(f32x4*)(d + EPI_COL(bj, n)) = acc[ai][bj][m][n]; }
    }
};
struct EpiSwiglu {
    bf16* act; int ldc;
    DEVI void operator()(const f32x4 (&acc)[2][2][4][2], const Unit& u, int wr, int wc, int fr, int fq) const {
        EPI_LOOP_ROWS { const int row = EPI_ROW;
#pragma unroll
            for (int n = 0; n < 2; ++n) { const f32x4 gt = acc[ai][0][m][n], up = acc[ai][1][m][n]; f32x4 o;
#pragma unroll
                for (int i = 0; i < 4; ++i) o[i] = siluf(gt[i]) * up[i];
                st_bf16x4(act + (size_t)row * ldc + u.pn * 128 + wc * 32 + n * 16 + fq * 4, o); } }
    }
};
struct EpiStore {
    bf16* o; int ldc;
    DEVI void operator()(const f32x4 (&acc)[2][2][4][2], const Unit& u, int wr, int wc, int fr, int fq) const {
        EPI_LOOP_ROWS { const int row = EPI_ROW;
#pragma unroll
            for (int bj = 0; bj < 2; ++bj)
#pragma unroll
                for (int n = 0; n < 2; ++n) st_bf16x4(o + (size_t)row * ldc + EPI_COL(bj, n), acc[ai][bj][m][n]); }
    }
};

struct CvtSrc { const float* src; int ld; int ncols; bool perm; const float* ks; float sc; };
DEVI void cvt_tile(const CvtSrc t, bf16* dst, int Kd, int nd0, int kd0, LAS float* scr, int lane) {
    const int n = lane & 31;
    if (t.src) {
        const int nc = (n < t.ncols) ? n : t.ncols - 1; const float msk = (n < t.ncols) ? t.sc : 0.f;
        const float* sp0 = t.src + (size_t)(lane >> 5) * t.ld + nc;
        float v[32];
#pragma unroll
        for (int i = 0; i < 32; ++i) v[i] = sp0[(size_t)(2 * i) * t.ld];
        if (t.ks) {
#pragma unroll
            for (int i = 0; i < 32; ++i) v[i] *= t.ks[2 * i + (lane >> 5)];
        }
#pragma unroll
        for (int i = 0; i < 32; ++i) scr[(2 * i + (lane >> 5)) * 33 + n] = v[i] * msk;
    } else {
#pragma unroll 8
        for (int i = 0; i < 32; ++i) scr[(2 * i + (lane >> 5)) * 33 + n] = 0.f;
    }
    asm volatile("s_waitcnt lgkmcnt(0)" ::: "memory");
    const int c = lane & 7;
#pragma unroll
    for (int j = 0; j < 4; ++j) { const int nn = (lane >> 3) + 8 * j; const LAS float* sp = scr + (8 * c) * 33 + (t.perm ? rope_src(nn) : nn);
        u32x4 o; o.x = pk2(sp[0 * 33], sp[1 * 33]); o.y = pk2(sp[2 * 33], sp[3 * 33]); o.z = pk2(sp[4 * 33], sp[5 * 33]); o.w = pk2(sp[6 * 33], sp[7 * 33]);
        *(u32x4*)(dst + (size_t)(nd0 + nn) * Kd + kd0 + 8 * c) = o; }
    asm volatile("s_waitcnt lgkmcnt(0)" ::: "memory");
}
template <class F>
DEVI void cvt_job(bf16* dst, int Nd, int Kd, F f, LAS float* scr, int gw, int ngw, int lane) {
    const int ntn = Nd >> 5, ntk = Kd >> 6;
    for (int it = gw; it < ntn * ntk; it += ngw) { const int nt = it % ntn, kt = it / ntn; cvt_tile(f(nt, kt), dst, Kd, nt * 32, kt * 64, scr, lane); }
}
DEVI void ph_pro(const P& p, unsigned char* lds) {
    const int tid = otid(), wid = tid >> 6, lane = tid & 63;
    __syncthreads();
    float* modv = (float*)(p.ws + WS_MODV);
    float* red = (float*)lds;
    for (int item = blockIdx.x; item < 192; item += gridDim.x) {
        const int l = item / 96, n = (item % 96) * 64 + lane;
        const float* W = IN(4) + (size_t)l * 1024 * 6144;
        float a0 = 0.f, a1 = 0.f, a2 = 0.f;
        for (int k = wid * 128; k < wid * 128 + 128; ++k) {
            const float w = W[(size_t)k * 6144 + n];
            a0 += siluf(IN(1)[k]) * w; a1 += siluf(IN(1)[1024 + k]) * w; a2 += siluf(IN(3)[k]) * w;
        }
        red[(wid * 3 + 0) * 64 + lane] = a0; red[(wid * 3 + 1) * 64 + lane] = a1; red[(wid * 3 + 2) * 64 + lane] = a2;
        __syncthreads();
        if (tid < 192) { const int r = tid >> 6, ln = tid & 63; float s = 0.f;
            for (int w = 0; w < 8; ++w) s += red[(w * 3 + r) * 64 + ln];
            const int nn = (item % 96) * 64 + ln; modv[(l * 3 + r) * 6144 + nn] = s + IN(5)[l * 6144 + nn]; }
        __syncthreads();
    }
    if (blockIdx.x == gridDim.x - 1) {
        float* rope = (float*)(p.ws + WS_ROPE);
        for (int idx = tid; idx < 1536; idx += NTHREADS) {
            const int i = idx & 7, pos = (idx < 1024) ? (idx >> 3) : ((idx - 1024) >> 3);
            const float invf = (i == 0) ? 1.f : (i == 1) ? 0.31622776601683794f : (i == 2) ? 0.1f : (i == 3) ? 0.03162277660168379f : (i == 4) ? 0.01f : (i == 5) ? 0.003162277660168379f : (i == 6) ? 0.001f : 0.00031622776601683794f;
            const float ang = (float)pos * invf;
            double rev = (double)ang * 0.15915494309189535; rev -= __builtin_rint(rev);
            const float fr = (float)rev;
            rope[idx * 2] = __builtin_amdgcn_cosf(fr); rope[idx * 2 + 1] = __builtin_amdgcn_sinf(fr);
        }
    }
    __syncthreads();
    LAS float* scr = (LAS float*)(LAS unsigned char*)lds + wid * (64 * 33);
    const int gw = blockIdx.x * NWAVES + wid, ngw = gridDim.x * NWAVES;
    for (int l = 0; l < 2; ++l) {
        { const float* W = IN(8) + (size_t)l * 1024 * INW;
          cvt_job((bf16*)(p.ws + WS_WIN) + (size_t)l * INWP * 1024, INWP, 1024, [=](int nt, int kt) -> CvtSrc {
              const int n0 = nt * 32; if (n0 >= INW) return CvtSrc{nullptr, 0, 0, false, nullptr, 1.f};
              return CvtSrc{W + (size_t)(kt * 64) * INW + n0, INW, (INW - n0 < 32) ? INW - n0 : 32, n0 == C_KPE, nullptr, 1.f}; }, scr, gw, ngw, lane); }
        { const float* Wq = IN(11) + (size_t)l * 256 * 384; const float* qn = IN(10) + l * 256; const float* Wk = IN(13) + (size_t)l * 128 * 256; const float* Wv = IN(14) + (size_t)l * 128 * 256; const float* kn = IN(12) + l * 128;
          const float QS = 0.10206207261596577f * 1.4426950408889634f;
          cvt_job((bf16*)(p.ws + WS_WQKV) + (size_t)l * 1024 * 384, 1024, 384, [=](int nt, int kt) -> CvtSrc {
              const int n0 = nt * 32, k0 = kt * 64;
              if (n0 < 384) { if (k0 >= 256) return CvtSrc{nullptr, 0, 0, false, nullptr, 1.f}; return CvtSrc{Wq + (size_t)k0 * 384 + n0, 384, 32, (n0 % 96) == 64, qn + k0, QS}; }
              if (n0 < 512 || k0 < 256) return CvtSrc{nullptr, 0, 0, false, nullptr, 1.f};
              if (n0 < 768) return CvtSrc{Wk + (size_t)(k0 - 256) * 256 + (n0 - 512), 256, 32, false, kn + k0 - 256, 1.f};
              return CvtSrc{Wv + (size_t)(k0 - 256) * 256 + (n0 - 768), 256, 32, false, kn + k0 - 256, 1.f}; }, scr, gw, ngw, lane); }
        { const float* W = IN(9) + (size_t)l * 1024 * 1024;
          cvt_job((bf16*)(p.ws + WS_WOUT) + (size_t)l * 1024 * 1024, 1024, 1024, [=](int nt, int kt) -> CvtSrc { return CvtSrc{W + (size_t)(kt * 64) * 1024 + nt * 32, 1024, 32, false, nullptr, 1.f}; }, scr, gw, ngw, lane); }
    }
    { const float* Wg = IN(22); const float* Wu = IN(23);
      cvt_job((bf16*)(p.ws + WS_WGU), 2 * DFF, 1024, [=](int nt, int kt) -> CvtSrc { const int n0 = nt * 32, t = n0 >> 8, r = n0 & 255;
          return CvtSrc{(r < 128 ? Wg + t * 128 + r : Wu + t * 128 + r - 128) + (size_t)(kt * 64) * DFF, DFF, 32, false, nullptr, 1.f}; }, scr, gw, ngw, lane); }
    { const float* W = IN(24);
      cvt_job((bf16*)(p.ws + WS_WD), 1024, DFF, [=](int nt, int kt) -> CvtSrc { return CvtSrc{W + (size_t)(kt * 64) * 1024 + nt * 32, 1024, 32, false, nullptr, 1.f}; }, scr, gw, ngw, lane); }
}
DEVI void ph_moew(const P& p, unsigned char* lds) {
    const int tid = otid(), wid = tid >> 6, lane = tid & 63;
    LAS float* scr = (LAS float*)(LAS unsigned char*)lds + wid * (64 * 33);
    const int gw = blockIdx.x * NWAVES + wid, ngw = gridDim.x * NWAVES;
    for (int e = 0; e < NEXP; ++e) {
        { const float* Wg = IN(26) + (size_t)e * 1024 * DFE; const float* Wu = IN(27) + (size_t)e * 1024 * DFE;
          cvt_job((bf16*)(p.ws + WS_WGUE) + (size_t)e * 2 * DFE * 1024, 2 * DFE, 1024, [=](int nt, int kt) -> CvtSrc { const int n0 = nt * 32, t = n0 >> 8, r = n0 & 255;
              return CvtSrc{(r < 128 ? Wg + t * 128 + r : Wu + t * 128 + r - 128) + (size_t)(kt * 64) * DFE, DFE, 32, false, nullptr, 1.f}; }, scr, gw, ngw, lane); }
        { const float* W = IN(28) + (size_t)e * DFE * 1024;
          cvt_job((bf16*)(p.ws + WS_WDE) + (size_t)e * 1024 * DFE, 1024, DFE, [=](int nt, int kt) -> CvtSrc { return CvtSrc{W + (size_t)(kt * 64) * 1024 + nt * 32, 1024, 32, false, nullptr, 1.f}; }, scr, gw, ngw, lane); }
    }
}

template <bool route>
DEVI void ph_norm(const P& p, int l, int which, int nrows, unsigned char* lds, int npart, int pgidx) {
    const int tid = otid(), wid = tid >> 6, lane = tid & 63;
    const bool first = (l == 0 && which == 0);
    const float* src_lat = first ? IN(0) : p.out; const float* src_ctx = (l == 0) ? IN(2) : (const float*)(p.ws + WS_XC);
    const float* w = IN(6 + which) + l * 1024; const float* modv = (const float*)(p.ws + WS_MODV) + (size_t)l * 3 * 6144;
    bf16* H = (bf16*)(p.ws + WS_HM);
    int* rt_e = (int*)(p.ws + WS_RT); float* rt_g = (float*)(p.ws + WS_RT + 128 * 1024);
    float* rl = (float*)lds;
    if (route) { __syncthreads(); const float* router = IN(25);
#pragma unroll
        for (int i = 0; i < 4; ++i) *(f32x4*)(rl + (tid + NTHREADS * i) * 4) = *(const f32x4*)(router + (tid + NTHREADS * i) * 4);
        __syncthreads(); }
    const int nw = gridDim.x * NWAVES, rpw = (NLAT + nw - 1) / nw, gw = blockIdx.x * NWAVES + wid;
    f32x4 vn[4], gsc[4], shv[4]; int rc = -1;
    for (int pass = 0; pass < (nrows > NLAT ? 2 : 1); ++pass) {
    const int row0 = pass == 0 ? gw * rpw : NLAT + gw, row1 = pass == 0 ? ((row0 + rpw < NLAT) ? row0 + rpw : NLAT) : nrows, rstep = pass == 0 ? 1 : nw;
    if (row0 < row1) { const float* x = (row0 < NLAT) ? src_lat + (size_t)row0 * D : src_ctx + (size_t)(row0 - NLAT) * D;
#pragma unroll
        for (int j = 0; j < 4; ++j) vn[j] = *(const f32x4*)(x + (j * 64 + lane) * 4); }
    for (int row = row0; row < row1; row += rstep) {
        const bool lat = row < NLAT; const int r = lat ? (row >> 13) : 2;
        if (r != rc) { rc = r; const float* sh = modv + r * 6144 + (which * 3 + 0) * 1024; const float* sc = modv + r * 6144 + (which * 3 + 1) * 1024;
#pragma unroll
            for (int j = 0; j < 4; ++j) { const int c0 = (j * 64 + lane) * 4; const f32x4 wv = *(const f32x4*)(w + c0), cv = *(const f32x4*)(sc + c0); shv[j] = *(const f32x4*)(sh + c0); gsc[j] = wv * (cv + 1.f); } }
        f32x4 v[4]; float ss = 0.f;
#pragma unroll
        for (int j = 0; j < 4; ++j) v[j] = vn[j];
        if (!lat && npart > 0) { const float* part = (const float*)(p.ws + WS_XBC) + (size_t)(row - NLAT) * D; const float* gp = modv + 2 * 6144 + pgidx * 1024; float* xc = (float*)(p.ws + WS_XC) + (size_t)(row - NLAT) * D;
#pragma unroll
            for (int j = 0; j < 4; ++j) { const int c0 = (j * 64 + lane) * 4; f32x4 acc = {0.f, 0.f, 0.f, 0.f};
#pragma unroll 2
                for (int k = 0; k < npart; ++k) acc += *(const f32x4*)(part + (size_t)k * NCTX * D + c0);
                v[j] += *(const f32x4*)(gp + c0) * acc; *(f32x4*)(xc + c0) = v[j]; } }
#pragma unroll
        for (int j = 0; j < 4; ++j) ss += v[j][0] * v[j][0] + v[j][1] * v[j][1] + v[j][2] * v[j][2] + v[j][3] * v[j][3];
        if (row + rstep < row1) { const int nrow = row + rstep; const float* x = (nrow < NLAT) ? src_lat + (size_t)nrow * D : src_ctx + (size_t)(nrow - NLAT) * D;
#pragma unroll
            for (int j = 0; j < 4; ++j) vn[j] = *(const f32x4*)(x + (j * 64 + lane) * 4); }
        ss = wave_sum(ss); const float rstd = 1.0f / sqrtf(ss * (1.f / D) + EPS);
        float lg[8];
#pragma unroll
        for (int e = 0; e < 8; ++e) lg[e] = 0.f;
#pragma unroll
        for (int j = 0; j < 4; ++j) { const int c0 = (j * 64 + lane) * 4; v[j] = v[j] * rstd * gsc[j] + shv[j]; st_bf16x4(H + (size_t)row * D + c0, v[j]); }
        if (route) {
#pragma unroll
            for (int j = 0; j < 4; ++j) { const int c0 = (j * 64 + lane) * 4;
#pragma unroll
                for (int i = 0; i < 4; ++i) { const f32x4 r0 = *(const f32x4*)(rl + (c0 + i) * 8), r1 = *(const f32x4*)(rl + (c0 + i) * 8 + 4); const float hh = v[j][i];
                    lg[0] += hh * r0[0]; lg[1] += hh * r0[1]; lg[2] += hh * r0[2]; lg[3] += hh * r0[3]; lg[4] += hh * r1[0]; lg[5] += hh * r1[1]; lg[6] += hh * r1[2]; lg[7] += hh * r1[3]; }
                asm volatile("" ::: "memory"); } }
        if (route) {
#pragma unroll
            for (int e = 0; e < 8; ++e) lg[e] = wave_sum(lg[e]);
            int i1 = 0; float v1 = lg[0];
#pragma unroll
            for (int e = 1; e < 8; ++e) if (lg[e] > v1) { v1 = lg[e]; i1 = e; }
            int i2 = -1; float v2 = -3.0e38f;
#pragma unroll
            for (int e = 0; e < 8; ++e) if (e != i1 && lg[e] > v2) { v2 = lg[e]; i2 = e; }
            const float e2 = __expf(v2 - v1), g1 = 1.f / (1.f + e2), g2 = e2 / (1.f + e2);
            if (lane == 0) { rt_e[row * 2] = i1; rt_e[row * 2 + 1] = i2; rt_g[row * 2] = g1; rt_g[row * 2 + 1] = g2; }
        }
    }
    }
}

DEVI void ph_conv(const P& p, int l) {
    const int tid = otid(), wid = tid >> 6, lane = tid & 63;
    const bf16* proj = (const bf16*)(p.ws + WS_PROJ); bf16* xbc = (bf16*)(p.ws + WS_XBC); bf16* Kb = (bf16*)(p.ws + WS_K);
    float* rq = (float*)(p.ws + WS_RQ); float* rkv = (float*)(p.ws + WS_RKV); const float* rope = (const float*)(p.ws + WS_ROPE);
    const float* cw = IN(16) + (size_t)l * 3 * 768; const float* cb = IN(17) + l * 768;
    const int nw_ = gridDim.x * NWAVES, rpw = (T + nw_ - 1) / nw_, gw = blockIdx.x * NWAVES + wid;
    const int row0 = gw * rpw, row1 = (row0 + rpw < T) ? row0 + rpw : T;
    f32x4 cw0[3], cw1[3], cw2[3], cbb[3];
#pragma unroll
    for (int j = 0; j < 3; ++j) { const int c0 = (j * 64 + lane) * 4; cw0[j] = *(const f32x4*)(cw + c0); cw1[j] = *(const f32x4*)(cw + 768 + c0); cw2[j] = *(const f32x4*)(cw + 1536 + c0); cbb[j] = *(const f32x4*)(cb + c0); }
    for (int row = row0; row < row1; ++row) {
        const bool lat = row < NLAT; const int pos = lat ? (row & (SEQ - 1)) : ((row - NLAT) & (CL - 1)); const int L = lat ? SEQ : CL;
        const bf16* pr = proj + (size_t)row * INWP;
        { const u32x2 a = *(const u32x2*)(pr + lane * 4); const unsigned b = *(const unsigned*)(pr + C_CKV + lane * 2);
          const float q0 = bf2f(a.x & 0xffff), q1 = bf2f(a.x >> 16), q2 = bf2f(a.y & 0xffff), q3 = bf2f(a.y >> 16), k0 = bf2f(b & 0xffff), k1 = bf2f(b >> 16);
          const float sq = wave_sum(q0 * q0 + q1 * q1 + q2 * q2 + q3 * q3), sk = wave_sum(k0 * k0 + k1 * k1);
          if (lane == 0) { rq[row] = 1.0f / sqrtf(sq * (1.f / 256.f) + EPS); rkv[row] = 1.0f / sqrtf(sk * (1.f / 128.f) + EPS); } }
        if (lane < 16) { const unsigned a = *(const unsigned*)(pr + C_KPE + lane * 2); float x0 = bf2f(a & 0xffff), x1 = bf2f(a >> 16);
            if (lat) { const int gr = pos >> 6, gc = pos & 63; const float* tb = (lane < 8) ? rope + (gr * 8 + lane) * 2 : rope + 2048 + (gc * 8 + (lane - 8)) * 2;
                const float c = tb[0], s = tb[1], y0 = x0 * c - x1 * s, y1 = x1 * c + x0 * s; x0 = y0; x1 = y1; }
            const unsigned o = pk2(x0, x1);
#pragma unroll
            for (int h = 0; h < 4; ++h) *(unsigned*)(Kb + (size_t)row * 384 + h * 96 + 64 + lane * 2) = o; }
#pragma unroll
        for (int j = 0; j < 3; ++j) { const int c0 = (j * 64 + lane) * 4;
            const u32x2 xm = (pos > 0) ? *(const u32x2*)(pr - INWP + C_XBC + c0) : (u32x2){0u, 0u}; const u32x2 x0 = *(const u32x2*)(pr + C_XBC + c0);
            const u32x2 xp = (pos < L - 1) ? *(const u32x2*)(pr + INWP + C_XBC + c0) : (u32x2){0u, 0u};
            const f32x4 w0 = cw0[j], w1 = cw1[j], w2 = cw2[j], bb = cbb[j];
            f32x4 am = {bf2f(xm.x & 0xffff), bf2f(xm.x >> 16), bf2f(xm.y & 0xffff), bf2f(xm.y >> 16)}, a0 = {bf2f(x0.x & 0xffff), bf2f(x0.x >> 16), bf2f(x0.y & 0xffff), bf2f(x0.y >> 16)},
                  ap = {bf2f(xp.x & 0xffff), bf2f(xp.x >> 16), bf2f(xp.y & 0xffff), bf2f(xp.y >> 16)};
            f32x4 y = w0 * am + w1 * a0 + w2 * ap + bb;
#pragma unroll
            for (int i = 0; i < 4; ++i) y[i] = siluf(y[i]);
            st_bf16x4(xbc + (size_t)row * 768 + c0, y); }
    }
}

typedef short v4i16_t __attribute__((ext_vector_type(4)));
DEVI v4i16_t lds_tr(const unsigned char* p) { return __builtin_amdgcn_ds_read_tr16_b64_v4i16((LAS v4i16_t*)(LAS unsigned char*)p); }
constexpr int A3_KLD = 208, A3_VLD = 192, A3_VOFF = 64 * A3_KLD, A3_BUF = A3_VOFF + 64 * A3_VLD;
template <int VAR>
DEVI void attn_unit(const P& p, int uidx, unsigned char* lds, bf16* outp) {
    const int tid = otid(), wid = __builtin_amdgcn_readfirstlane(tid >> 6), lane = tid & 63, r32 = lane & 31, hi = lane >> 5;
    const bf16* Q = (const bf16*)(p.ws + WS_Q); const bf16* K = (const bf16*)(p.ws + WS_K); const bf16* V = (const bf16*)(p.ws + WS_V); bf16* MIX = outp;
    int b, h, qrow0, NT;
    if (uidx < 256) { b = uidx >> 7; h = (uidx >> 5) & 3; qrow0 = b * SEQ + (uidx & 31) * 256; NT = 4 + SEQ / 64; }
    else { const int j = uidx - 256; b = j >> 2; h = j & 3; qrow0 = NLAT + b * CL; NT = 4; }
    const int qrow = qrow0 + wid * 32 + r32;
    bf16x8 qf[6];
#pragma unroll
    for (int s = 0; s < 6; ++s) qf[s] = *(const bf16x8*)(Q + (size_t)qrow * 384 + h * 96 + s * 16 + hi * 8);
    const int kk0 = tid / 12, kq0 = tid % 12, kk1 = (512 + tid) / 12, kq1 = (512 + tid) % 12, vk = tid >> 3, vq = tid & 7;
    const bf16* Kh = K + h * 96; const bf16* Vh = V + h * 64 + vq * 8;
    const int ctx0 = NLAT + b * CL, lat0 = b * SEQ;
    u32x4 krA0, krA1 = {0u, 0u, 0u, 0u}, vrA;
#define AT_LOAD(t, kr0, kr1, vr) do { const int kr_ = ((t) < 4) ? ctx0 + (t) * 64 : lat0 + ((t) - 4) * 64; \
        kr0 = *(const u32x4*)(Kh + (size_t)(kr_ + kk0) * 384 + kq0 * 8); if (tid < 256) kr1 = *(const u32x4*)(Kh + (size_t)(kr_ + kk1) * 384 + kq1 * 8); \
        vr = *(const u32x4*)(Vh + (size_t)(kr_ + vk) * 256); } while (0)
#define AT_STORE(bufp, kr0, kr1, vr) do { unsigned char* b_ = (bufp); *(u32x4*)(b_ + kk0 * A3_KLD + kq0 * 16) = kr0; if (tid < 256) *(u32x4*)(b_ + kk1 * A3_KLD + kq1 * 16) = kr1; \
        *(u32x4*)(b_ + A3_VOFF + vk * A3_VLD + vq * 16) = vr; } while (0)
    const int troff = (4 * hi + ((lane & 15) >> 2)) * A3_VLD + (16 * ((lane >> 4) & 1) + 4 * (lane & 3)) * 2;
    const int koff = r32 * A3_KLD + hi * 16;
    f32x16 o0, o1, negm;
#pragma unroll
    for (int r = 0; r < 16; ++r) { o0[r] = 0.f; o1[r] = 0.f; negm[r] = 0.f; }
    float mhat = 0.f, lsum = 0.f;
    __syncthreads();
    AT_LOAD(0, krA0, krA1, vrA); AT_STORE(lds, krA0, krA1, vrA); AT_LOAD(1, krA0, krA1, vrA); AT_STORE(lds + A3_BUF, krA0, krA1, vrA);
    __syncthreads();
#define SBAR() __builtin_amdgcn_sched_barrier(0)
#define KRD(bufp, half, s) (*(const bf16x8*)((bufp) + koff + (half) * 32 * A3_KLD + (s) * 32))
#define MF(a, b, c) __builtin_amdgcn_mfma_f32_32x32x16_bf16(a, b, c, 0, 0, 0)
#define MFQ(a, b, c) ((VAR == 3) ? (c) : MF(a, b, c))
#define MFP(a, b, c) ((VAR == 2) ? (c) : MF(a, b, c))
#define EX4(S, r0) do { if (VAR == 1) { S[r0] *= 0.001f; S[r0 + 1] *= 0.001f; S[r0 + 2] *= 0.001f; S[r0 + 3] *= 0.001f; break; } S[r0] = __builtin_amdgcn_exp2f(S[r0]); S[r0 + 1] = __builtin_amdgcn_exp2f(S[r0 + 1]); S[r0 + 2] = __builtin_amdgcn_exp2f(S[r0 + 2]); S[r0 + 3] = __builtin_amdgcn_exp2f(S[r0 + 3]); lsum += (S[r0] + S[r0 + 1]) + (S[r0 + 2] + S[r0 + 3]); } while (0)
#define PK8(S, r0) __builtin_bit_cast(bf16x8, (u32x4){pk2(S[r0], S[r0 + 1]), pk2(S[r0 + 2], S[r0 + 3]), pk2(S[r0 + 4], S[r0 + 5]), pk2(S[r0 + 6], S[r0 + 7])})
#define VFR(vp) ({ const v4i16_t lo_ = lds_tr(vp), hi_ = lds_tr((vp) + 8 * A3_VLD); (bf16x8){lo_[0], lo_[1], lo_[2], lo_[3], hi_[0], hi_[1], hi_[2], hi_[3]}; })
#define MX3(a, b, c) __builtin_fmaxf(__builtin_fmaxf((a), (b)), (c))
#define AT_UPD(S0, S1, mx, FORCE) do { float mx_ = __builtin_fmaxf(mx, __shfl_xor(mx, 32)); \
        if ((FORCE) || __any(mx_ > 8.0f)) { const float dl_ = (FORCE) ? mx_ : __builtin_fmaxf(mx_, 0.f); mhat += dl_; \
            _Pragma("unroll") for (int r = 0; r < 16; ++r) { S0[r] -= dl_; S1[r] -= dl_; negm[r] = -mhat; } \
            if (!(FORCE)) { const float f_ = __builtin_amdgcn_exp2f(-dl_); _Pragma("unroll") for (int r = 0; r < 16; ++r) { o0[r] *= f_; o1[r] *= f_; } lsum *= f_; } } } while (0)
    f32x16 sa0, sa1, sb0, sb1;
    { const unsigned char* kb_ = lds;
#pragma unroll
      for (int s = 0; s < 6; ++s) { sa0 = MF(KRD(kb_, 0, s), qf[s], s == 0 ? negm : sa0); sa1 = MF(KRD(kb_, 1, s), qf[s], s == 0 ? negm : sa1); }
      float a_ = MX3(sa0[0], sa0[1], sa1[0]), b_ = MX3(sa0[2], sa0[3], sa1[1]); a_ = MX3(a_, sa1[2], sa1[3]);
#pragma unroll
      for (int r = 4; r < 16; r += 4) { a_ = MX3(a_, sa0[r], sa0[r + 1]); b_ = MX3(b_, sa0[r + 2], sa0[r + 3]); a_ = MX3(a_, sa1[r], sa1[r + 1]); b_ = MX3(b_, sa1[r + 2], sa1[r + 3]); }
      AT_UPD(sa0, sa1, __builtin_fmaxf(a_, b_), true); }
#define AT_STEP(C0, C1, N0, N1, t, bc_, HAS_NEXT) do { const int b1_ = ((bc_) == 2) ? 0 : (bc_) + 1, b2_ = (b1_ == 2) ? 0 : b1_ + 1; \
        const unsigned char* kb_ = lds + b1_ * A3_BUF; const unsigned char* vb_ = lds + (bc_) * A3_BUF + A3_VOFF + troff; \
        if (VAR != 4 && (t) + 2 < NT) AT_LOAD((t) + 2, krA0, krA1, vrA); \
        bf16x8 pw0_, pw1_, pw2_, pw3_; float ma_ = -3.0e38f, mb_ = -3.0e38f; \
        if (HAS_NEXT) { \
            bf16x8 k0_ = KRD(kb_, 0, 0), k1_ = KRD(kb_, 1, 0), k2_ = KRD(kb_, 0, 1), k3_ = KRD(kb_, 1, 1); SBAR(); \
            N0 = MFQ(k0_, qf[0], negm); EX4(C0, 0); k0_ = KRD(kb_, 0, 2); SBAR(); \
            N1 = MFQ(k1_, qf[0], negm); EX4(C0, 4); k1_ = KRD(kb_, 1, 2); SBAR(); \
            N0 = MFQ(k2_, qf[1], N0); EX4(C0, 8); k2_ = KRD(kb_, 0, 3); SBAR(); \
            N1 = MFQ(k3_, qf[1], N1); EX4(C0, 12); k3_ = KRD(kb_, 1, 3); SBAR(); \
            N0 = MFQ(k0_, qf[2], N0); EX4(C1, 0); k0_ = KRD(kb_, 0, 4); SBAR(); \
            N1 = MFQ(k1_, qf[2], N1); EX4(C1, 4); k1_ = KRD(kb_, 1, 4); SBAR(); \
            N0 = MFQ(k2_, qf[3], N0); EX4(C1, 8); k2_ = KRD(kb_, 0, 5); SBAR(); \
            N1 = MFQ(k3_, qf[3], N1); EX4(C1, 12); k3_ = KRD(kb_, 1, 5); SBAR(); \
            N0 = MFQ(k0_, qf[4], N0); pw0_ = PK8(C0, 0); SBAR(); \
            N1 = MFQ(k1_, qf[4], N1); pw1_ = PK8(C0, 8); SBAR(); \
            N0 = MFQ(k2_, qf[5], N0); pw2_ = PK8(C1, 0); SBAR(); \
            N1 = MFQ(k3_, qf[5], N1); pw3_ = PK8(C1, 8); SBAR(); \
        } else { EX4(C0, 0); EX4(C0, 4); EX4(C0, 8); EX4(C0, 12); EX4(C1, 0); EX4(C1, 4); EX4(C1, 8); EX4(C1, 12); pw0_ = PK8(C0, 0); pw1_ = PK8(C0, 8); pw2_ = PK8(C1, 0); pw3_ = PK8(C1, 8); SBAR(); } \
        { bf16x8 va_ = VFR(vb_), vb2_ = VFR(vb_ + 64); SBAR(); \
          bf16x8 vc_ = VFR(vb_ + 16 * A3_VLD), vd_ = VFR(vb_ + 16 * A3_VLD + 64); SBAR(); \
          o0 = MFP(va_, pw0_, o0); if (HAS_NEXT) { ma_ = MX3(N0[0], N0[1], N1[0]); mb_ = MX3(N0[2], N0[3], N1[1]); } SBAR(); \
          o1 = MFP(vb2_, pw0_, o1); if (HAS_NEXT) { ma_ = MX3(ma_, N1[2], N1[3]); mb_ = MX3(mb_, N0[4], N0[5]); } SBAR(); \
          va_ = VFR(vb_ + 32 * A3_VLD); vb2_ = VFR(vb_ + 32 * A3_VLD + 64); SBAR(); \
          o0 = MFP(vc_, pw1_, o0); if (HAS_NEXT) { ma_ = MX3(ma_, N0[6], N0[7]); mb_ = MX3(mb_, N1[4], N1[5]); } SBAR(); \
          o1 = MFP(vd_, pw1_, o1); if (HAS_NEXT) { ma_ = MX3(ma_, N1[6], N1[7]); mb_ = MX3(mb_, N0[8], N0[9]); } SBAR(); \
          vc_ = VFR(vb_ + 48 * A3_VLD); vd_ = VFR(vb_ + 48 * A3_VLD + 64); SBAR(); \
          o0 = MFP(va_, pw2_, o0); if (HAS_NEXT) { ma_ = MX3(ma_, N0[10], N0[11]); mb_ = MX3(mb_, N1[8], N1[9]); } SBAR(); \
          o1 = MFP(vb2_, pw2_, o1); if (HAS_NEXT) { ma_ = MX3(ma_, N1[10], N1[11]); mb_ = MX3(mb_, N0[12], N0[13]); } SBAR(); \
          if (HAS_NEXT) { ma_ = MX3(ma_, N0[14], N0[15]); mb_ = MX3(mb_, N1[12], N1[13]); } SBAR(); \
          o0 = MFP(vc_, pw3_, o0); if (HAS_NEXT) { ma_ = MX3(ma_, N1[14], N1[15]); } SBAR(); \
          o1 = MFP(vd_, pw3_, o1); SBAR(); } \
        if (HAS_NEXT) AT_UPD(N0, N1, __builtin_fmaxf(ma_, mb_), false); \
        if (VAR != 4 && (t) + 2 < NT) AT_STORE(lds + b2_ * A3_BUF, krA0, krA1, vrA); \
        if (VAR != 4) __syncthreads(); } while (0)
    int bc = 0, t = 0;
    for (; t + 2 < NT; t += 2) {
        AT_STEP(sa0, sa1, sb0, sb1, t, bc, true); bc = (bc == 2) ? 0 : bc + 1;
        AT_STEP(sb0, sb1, sa0, sa1, t + 1, bc, true); bc = (bc == 2) ? 0 : bc + 1;
    }
    AT_STEP(sa0, sa1, sb0, sb1, t, bc, true); bc = (bc == 2) ? 0 : bc + 1;
    AT_STEP(sb0, sb1, sa0, sa1, t + 1, bc, false);
#undef AT_LOAD
#undef AT_STORE
#undef SBAR
#undef KRD
#undef MF
#undef MFQ
#undef MFP
#undef EX4
#undef PK8
#undef VFR
#undef MX3
#undef AT_UPD
#undef AT_STEP
    lsum += __shfl_xor(lsum, 32);
    const float inv = 1.f / lsum;
    bf16* orow = MIX + (size_t)qrow * D + h * 64;
#pragma unroll
    for (int g = 0; g < 4; ++g) {
        st_bf16x4(orow + 8 * g + 4 * hi, (f32x4){o0[4 * g] * inv, o0[4 * g + 1] * inv, o0[4 * g + 2] * inv, o0[4 * g + 3] * inv});
        st_bf16x4(orow + 32 + 8 * g + 4 * hi, (f32x4){o1[4 * g] * inv, o1[4 * g + 1] * inv, o1[4 * g + 2] * inv, o1[4 * g + 3] * inv});
    }
}

constexpr int NCC = 66;
DEVI int chunk_row0(int b, int cc) { return cc < 2 ? NLAT + b * CL + cc * 128 : b * SEQ + (cc - 2) * 128; }
constexpr int SC_VEC = 0;
constexpr int SC_KT = 2048;
constexpr int SC_VF = SC_KT + 64 * 136 * 2;
constexpr int SC_VB = SC_VF + 64 * 136 * 2;
constexpr int SC_X = SC_VB + 64 * 136 * 2;
constexpr int SC_SSQ = SC_X + 2048;
constexpr int SC_END = SC_SSQ + 8192;
constexpr int TS = 136;

DEVI void scan_vectors(const P& p, int l, bool ret, int h, int row0, float* vec, int wid, int lane) {
    const float* dt = (const float*)(p.ws + WS_DT);
    if (ret) {
        if (wid == 0) { const float lf = IN(15)[l * 8 + h], lb = IN(15)[l * 8 + 4 + h];
            const float laf = -log1pf(__expf(-lf)), lab = -log1pf(__expf(-lb));
#pragma unroll
            for (int e = 0; e < 2; ++e) { const int j = lane * 2 + e; vec[j] = (float)(j + 1) * laf; vec[128 + j] = (float)(128 - j) * lab; vec[256 + j] = 1.f; vec[384 + j] = 1.f; } }
    } else if (wid < 2) {
        const int dir = wid; const size_t r = (size_t)(row0 + lane * 2);
        const float x0 = dt[r * 32 + 16 + dir * 8 + h], x1 = dt[(r + 1) * 32 + 16 + dir * 8 + h];
        vec[256 + dir * 128 + lane * 2] = dt[r * 32 + dir * 8 + h]; vec[256 + dir * 128 + lane * 2 + 1] = dt[(r + 1) * 32 + dir * 8 + h];
        float s = x0 + x1;
#pragma unroll
        for (int o = 1; o < 64; o <<= 1) { const float t = __shfl_up(s, o); if (lane >= o) s += t; }
        if (dir == 0) { vec[lane * 2] = s - x1; vec[lane * 2 + 1] = s; }
        else { const float tot = __shfl(s, 63); vec[128 + lane * 2] = tot - (s - x1) + x0; vec[128 + lane * 2 + 1] = tot - s + x1; }
    }
}
DEVI void scan_ptrs(const P& p, bool ret, int h, const bf16*& qb, const bf16*& kb, const bf16*& vb, int& ld) {
    if (ret) { const bf16* proj = (const bf16*)(p.ws + WS_PROJ); qb = proj + C_RQ + h * 64; kb = proj + C_RK + h * 64; vb = proj + C_RV + h * 64; ld = INWP; }
    else { const bf16* xbc = (const bf16*)(p.ws + WS_XBC); qb = xbc + 640 + (h >> 2) * 64; kb = xbc + 512 + (h >> 2) * 64; vb = xbc + h * 64; ld = 768; }
}
template <bool SCALED>
DEVI void stage_T(const bf16* src, int ld, int row0, bf16* d0, bf16* d1, const float* vec, int tid) {
    const int part = tid >> 6, lane = tid & 63, n0 = part * 8;
#pragma unroll
    for (int i = 0; i < 2; ++i) { const int j = lane + 64 * i;
        const u32x4 v = *(const u32x4*)(src + (size_t)(row0 + j) * ld + n0);
        const unsigned w[4] = {v.x, v.y, v.z, v.w};
        if (!SCALED) {
#pragma unroll
            for (int e = 0; e < 4; ++e) { d0[(n0 + 2 * e) * TS + j] = (bf16)(w[e] & 0xffff); d0[(n0 + 2 * e + 1) * TS + j] = (bf16)(w[e] >> 16); }
        } else {
            const float sf = __expf(vec[127] - vec[j]) * vec[256 + j], sb = __expf(vec[128] - vec[128 + j]) * vec[384 + j];
#pragma unroll
            for (int e = 0; e < 4; ++e) { const float a = bf2f(w[e] & 0xffff), b = bf2f(w[e] >> 16);
                d0[(n0 + 2 * e) * TS + j] = f2bf(a * sf); d0[(n0 + 2 * e + 1) * TS + j] = f2bf(b * sf); d1[(n0 + 2 * e) * TS + j] = f2bf(a * sb); d1[(n0 + 2 * e + 1) * TS + j] = f2bf(b * sb); }
        } }
}
DEVI void c3_stage_rows(unsigned char* dst, int rs, const bf16* src, int ld, int tid) {
#pragma unroll
    for (int i = 0; i < 2; ++i) { const int piece = tid + NTHREADS * i, row = piece >> 3, part = piece & 7; *(u32x4*)(dst + row * rs + part * 16) = *(const u32x4*)(src + (size_t)row * ld + part * 8); }
}
constexpr int SA_RS = 192, SA_K = 2048, SA_VF = SA_K + 128 * SA_RS, SA_VB = SA_VF + 128 * SA_RS, SA_END = SA_VB + 128 * SA_RS;
DEVI void scanA_unit(const P& p, int l, int uidx, unsigned char* lds) {
    const int tid = otid(), wid = __builtin_amdgcn_readfirstlane(tid >> 6), lane = tid & 63, r32 = lane & 31, hi = lane >> 5;
    const int g4 = uidx % 3, bc = uidx / 3, b = bc / NCC, cc = bc % NCC, row0 = chunk_row0(b, cc);
    const bool ret = (g4 == 0);
    float* vec = (float*)(lds + SC_VEC);
    float* ST = (float*)(p.ws + WS_ST); float* CDp = (float*)(p.ws + WS_CD);
    const int troff = (4 * hi + ((lane & 15) >> 2)) * SA_RS + (16 * ((lane >> 4) & 1) + 4 * (lane & 3)) * 2;
    for (int hq = 0; hq < 4; ++hq) {
        const int h = ret ? hq : (g4 - 1) * 4 + hq, hh = ret ? hq : 4 + h; const size_t item = (size_t)(b * NCC + cc) * 12 + hh;
        const bf16 *qb, *kb, *vb; int ld; scan_ptrs(p, ret, h, qb, kb, vb, ld);
        __syncthreads();
        scan_vectors(p, l, ret, h, row0, vec, wid, lane);
        __syncthreads();
        if (ret || hq == 0) c3_stage_rows(lds + SA_K, SA_RS, kb + (size_t)row0 * ld, ld, tid);
#pragma unroll
        for (int i = 0; i < 2; ++i) { const int piece = tid + NTHREADS * i, j = piece >> 3, part = piece & 7; const u32x4 v = *(const u32x4*)(vb + (size_t)(row0 + j) * ld + part * 8);
            const float sf = __expf(vec[127] - vec[j]) * vec[256 + j], sb = __expf(vec[128] - vec[128 + j]) * vec[384 + j];
            const float x0 = bf2f(v.x & 0xffff), x1 = bf2f(v.x >> 16), x2 = bf2f(v.y & 0xffff), x3 = bf2f(v.y >> 16), x4 = bf2f(v.z & 0xffff), x5 = bf2f(v.z >> 16), x6 = bf2f(v.w & 0xffff), x7 = bf2f(v.w >> 16);
            *(u32x4*)(lds + SA_VF + j * SA_RS + part * 16) = (u32x4){pk2(x0 * sf, x1 * sf), pk2(x2 * sf, x3 * sf), pk2(x4 * sf, x5 * sf), pk2(x6 * sf, x7 * sf)};
            *(u32x4*)(lds + SA_VB + j * SA_RS + part * 16) = (u32x4){pk2(x0 * sb, x1 * sb), pk2(x2 * sb, x3 * sb), pk2(x4 * sb, x5 * sb), pk2(x6 * sb, x7 * sb)}; }
        if (tid == 0) { CDp[item * 2] = __expf(vec[127]); CDp[item * 2 + 1] = __expf(vec[128]); }
        if (tid < 128) { float* vg = (float*)(p.ws + WS_VEC) + item * 512; vg[tid] = vec[tid]; vg[128 + tid] = vec[128 + tid]; vg[256 + tid] = vec[tid] - __logf(vec[256 + tid]); vg[384 + tid] = vec[128 + tid] - __logf(vec[384 + tid]); }
        __syncthreads();
        const int dir = wid >> 2, nt = (wid >> 1) & 1, pt = wid & 1;
        const unsigned char* ka = lds + SA_K + nt * 64 + troff; const unsigned char* va = lds + (dir ? SA_VB : SA_VF) + pt * 64 + troff;
        f32x16 acc;
#pragma unroll
        for (int r = 0; r < 16; ++r) acc[r] = 0.f;
#pragma unroll
        for (int s = 0; s < 8; ++s) { const v4i16_t al = lds_tr(ka + (16 * s) * SA_RS), ah = lds_tr(ka + (16 * s + 8) * SA_RS), bl = lds_tr(va + (16 * s) * SA_RS), bh = lds_tr(va + (16 * s + 8) * SA_RS);
            const bf16x8 af = {al[0], al[1], al[2], al[3], ah[0], ah[1], ah[2], ah[3]}, bf = {bl[0], bl[1], bl[2], bl[3], bh[0], bh[1], bh[2], bh[3]};
            acc = __builtin_amdgcn_mfma_f32_32x32x16_bf16(af, bf, acc, 0, 0, 0); }
        float* o = ST + (item * 2 + dir) * 4096 + (size_t)(pt * 32 + r32) * 64 + nt * 32 + 4 * hi;
#pragma unroll
        for (int g = 0; g < 4; ++g) *(f32x4*)(o + 8 * g) = (f32x4){acc[4 * g], acc[4 * g + 1], acc[4 * g + 2], acc[4 * g + 3]};
    }
    __syncthreads();
}
DEVI void scanB_slab(const P& p, int slab, int nthr, int epb) {
    const int tid = otid(); if (tid >= nthr) return;
    const int f = slab * epb + tid * 2; const int bhd = f >> 12, e = f & 4095, dir = bhd & 1, bh = bhd >> 1, b = bh / 12, hh = bh % 12;
    const float* ST = (const float*)(p.ws + WS_ST); const float* CDp = (const float*)(p.ws + WS_CD); bf16* HT = (bf16*)(p.ws + WS_HT);
    f32x2 H = {0.f, 0.f};
    for (int base = 0; base < NCC; base += 6) {
        f32x2 s[6]; float d[6]; size_t off[6];
#pragma unroll
        for (int i = 0; i < 6; ++i) { const int step = base + i; const int cc = dir == 0 ? step : (step < 2 ? 1 - step : 67 - step);
            const size_t item = (size_t)(b * NCC + cc) * 12 + hh; off[i] = (item * 2 + dir) * 4096 + e; s[i] = *(const f32x2*)(ST + off[i]); d[i] = CDp[item * 2 + dir]; }
#pragma unroll
        for (int i = 0; i < 6; ++i) { *(unsigned*)(HT + off[i]) = pk2(H[0], H[1]); H = H * d[i] + s[i]; }
    }
}
constexpr int C3_RSV = 192, C3_RSK = 144;
constexpr int C3_V = 0, C3_K = 2 * 128 * C3_RSV, C3_H = C3_K + 2 * 128 * C3_RSK, C3_VEC = C3_H + 2 * 128 * C3_RSK, C3_X = C3_VEC + 2 * 2048, C3_END = C3_X + 1024;
template <bool RET>
DEVI void scanC_unit(const P& p, int l, int bc, unsigned char* lds, int tid, int wid, int lane) {
    const int r32 = lane & 31, hi = lane >> 5;
    const int it_ = wid & 3, hsub = wid >> 2, b = bc / NCC, cc = bc % NCC, row0 = chunk_row0(b, cc);
    const bf16* HT = (const bf16*)(p.ws + WS_HT); const bf16* proj = (const bf16*)(p.ws + WS_PROJ); const bf16* xbc = (const bf16*)(p.ws + WS_XBC); bf16* MIX = (bf16*)(p.ws + WS_HM); const float* VECG = (const float*)(p.ws + WS_VEC);
    const int i = it_ * 32 + r32; const size_t rowi = (size_t)(row0 + i);
    constexpr int ld = RET ? INWP : 768;
    const unsigned char* Vl = lds + C3_V + hsub * 128 * C3_RSV; const unsigned char* Kl = lds + C3_K + hsub * 128 * C3_RSK; const unsigned char* Hl = lds + C3_H + hsub * 128 * C3_RSK; const float* vec = (const float*)(lds + C3_VEC + hsub * 2048);
    const int trq = (lane & 15) >> 2, trp = lane & 3, trg = (lane >> 4) & 1;
    const int troff = (4 * hi + trq) * C3_RSV + (16 * trg + 4 * trp) * 2;
    float ssq = 0.f;
#pragma unroll 1
    for (int step = 0; step < (RET ? 2 : 4); ++step) {
        __syncthreads();
#pragma unroll
        for (int hs = 0; hs < 2; ++hs) { const int h = RET ? hs * 2 + step : hs * 4 + step, hh = RET ? h : 4 + h; const size_t item = (size_t)(b * NCC + cc) * 12 + hh;
            const bf16* vb = RET ? proj + C_RV + h * 64 : xbc + h * 64; const bf16* kb = RET ? proj + C_RK + h * 64 : xbc + 512 + hs * 64;
            c3_stage_rows(lds + C3_V + hs * 128 * C3_RSV, C3_RSV, vb + (size_t)row0 * ld, ld, tid);
            if (RET || step == 0) c3_stage_rows(lds + C3_K + hs * 128 * C3_RSK, C3_RSK, kb + (size_t)row0 * ld, ld, tid);
            c3_stage_rows(lds + C3_H + hs * 128 * C3_RSK, C3_RSK, HT + item * 2 * 4096, 64, tid);
            if ((tid >> 7) == hs) *(u32x4*)(lds + C3_VEC + hs * 2048 + (tid & 127) * 16) = *(const u32x4*)(VECG + item * 512 + (tid & 127) * 4); }
        __syncthreads();
        const int h = RET ? hsub * 2 + step : hsub * 4 + step;
        const bf16* qb = RET ? proj + C_RQ + h * 64 : xbc + 640 + hsub * 64;
        bf16x8 qf[4];
#pragma unroll
        for (int s = 0; s < 4; ++s) qf[s] = *(const bf16x8*)(qb + rowi * ld + s * 16 + hi * 8);
        const float Afi = vec[i], Bbi = vec[128 + i];
        f32x16 y0, y1;
#pragma unroll
        for (int r = 0; r < 16; ++r) { y0[r] = 0.f; y1[r] = 0.f; }
#pragma unroll 2
        for (int jt = 0; jt < 4; ++jt) {
            f32x16 st;
#pragma unroll
            for (int r = 0; r < 16; ++r) st[r] = 0.f;
#pragma unroll
            for (int s = 0; s < 4; ++s) { const bf16x8 kf = *(const bf16x8*)(Kl + (jt * 32 + r32) * C3_RSK + (s * 16 + hi * 8) * 2); st = __builtin_amdgcn_mfma_f32_32x32x16_bf16(kf, qf[s], st, 0, 0, 0); }
#pragma unroll
            for (int g = 0; g < 4; ++g) { const int j0 = jt * 32 + 8 * g + 4 * hi;
                const f32x4 afp = *(const f32x4*)(vec + 256 + j0), bbp = *(const f32x4*)(vec + 384 + j0);
#pragma unroll
                for (int e = 0; e < 4; ++e) { const int j = j0 + e; float f;
                    if (jt < it_) f = __expf(Afi - afp[e]);
                    else if (jt > it_) f = __expf(Bbi - bbp[e]);
                    else { const float ff = (j <= i) ? __expf(Afi - afp[e]) : 0.f; const bool bm = RET ? (j > i) : (j >= i); const float fb = bm ? __expf(Bbi - bbp[e]) : 0.f; f = ff + fb; }
                    st[4 * g + e] *= f; } }
#pragma unroll
            for (int s2 = 0; s2 < 2; ++s2) {
                u32x4 pw; pw.x = pk2(st[8 * s2 + 0], st[8 * s2 + 1]); pw.y = pk2(st[8 * s2 + 2], st[8 * s2 + 3]); pw.z = pk2(st[8 * s2 + 4], st[8 * s2 + 5]); pw.w = pk2(st[8 * s2 + 6], st[8 * s2 + 7]);
                const bf16x8 pb = __builtin_bit_cast(bf16x8, pw);
#pragma unroll
                for (int pt = 0; pt < 2; ++pt) { const unsigned char* vp = Vl + (jt * 32 + 16 * s2) * C3_RSV + pt * 64 + troff;
                    const v4i16_t lo = lds_tr(vp), hi2 = lds_tr(vp + 8 * C3_RSV);
                    const bf16x8 va = {lo[0], lo[1], lo[2], lo[3], hi2[0], hi2[1], hi2[2], hi2[3]};
                    if (pt == 0) y0 = __builtin_amdgcn_mfma_f32_32x32x16_bf16(va, pb, y0, 0, 0, 0); else y1 = __builtin_amdgcn_mfma_f32_32x32x16_bf16(va, pb, y1, 0, 0, 0); }
            }
        }
        { const float ef = __expf(Afi), eb = __expf(Bbi);
#pragma unroll
          for (int pt = 0; pt < 2; ++pt) { f32x16 tf, tb;
#pragma unroll
              for (int r = 0; r < 16; ++r) { tf[r] = 0.f; tb[r] = 0.f; }
              const unsigned char* hf = Hl + (pt * 32 + r32) * C3_RSK + hi * 16;
#pragma unroll
              for (int s = 0; s < 4; ++s) { tf = __builtin_amdgcn_mfma_f32_32x32x16_bf16(*(const bf16x8*)(hf + s * 32), qf[s], tf, 0, 0, 0); tb = __builtin_amdgcn_mfma_f32_32x32x16_bf16(*(const bf16x8*)(hf + 64 * C3_RSK + s * 32), qf[s], tb, 0, 0, 0); }
#pragma unroll
              for (int r = 0; r < 16; ++r) { if (pt == 0) y0[r] += ef * tf[r] + eb * tb[r]; else y1[r] += ef * tf[r] + eb * tb[r]; } } }
        if (RET) {
            float s1 = 0.f, s2 = 0.f;
#pragma unroll
            for (int r = 0; r < 16; ++r) { y0[r] *= 0.125f; y1[r] *= 0.125f; s1 += y0[r] + y1[r]; s2 += y0[r] * y0[r] + y1[r] * y1[r]; }
            s1 += __shfl_xor(s1, 32); s2 += __shfl_xor(s2, 32);
            const float mu = s1 * (1.f / 64.f), var = fmaxf(s2 * (1.f / 64.f) - mu * mu, 0.f), rs = 1.0f / sqrtf(var + EPS);
#pragma unroll
            for (int pt = 0; pt < 2; ++pt)
#pragma unroll
                for (int g = 0; g < 4; ++g) { const int p0 = pt * 32 + 8 * g + 4 * hi; const u32x2 gg = *(const u32x2*)(proj + rowi * INWP + C_RG + h * 64 + p0);
                    const f32x4 gv = {bf2f(gg.x & 0xffff), bf2f(gg.x >> 16), bf2f(gg.y & 0xffff), bf2f(gg.y >> 16)}; f32x4 o;
#pragma unroll
                    for (int e = 0; e < 4; ++e) o[e] = ((pt ? y1[4 * g + e] : y0[4 * g + e]) - mu) * rs * siluf(gv[e]);
                    st_bf16x4(MIX + rowi * D + 256 + h * 64 + p0, o); }
        } else {
            const float dsk = IN(20)[l * 8 + h];
#pragma unroll
            for (int pt = 0; pt < 2; ++pt)
#pragma unroll
                for (int g = 0; g < 4; ++g) { const int p0 = pt * 32 + 8 * g + 4 * hi; const u32x2 xx = *(const u32x2*)(xbc + rowi * 768 + h * 64 + p0), zz = *(const u32x2*)(proj + rowi * INWP + C_Z + h * 64 + p0);
                    const f32x4 xv = {bf2f(xx.x & 0xffff), bf2f(xx.x >> 16), bf2f(xx.y & 0xffff), bf2f(xx.y >> 16)}, zv = {bf2f(zz.x & 0xffff), bf2f(zz.x >> 16), bf2f(zz.y & 0xffff), bf2f(zz.y >> 16)}; f32x4 o;
#pragma unroll
                    for (int e = 0; e < 4; ++e) { o[e] = ((pt ? y1[4 * g + e] : y0[4 * g + e]) + xv[e] * dsk) * siluf(zv[e]); ssq += o[e] * o[e]; }
                    st_bf16x4(MIX + rowi * D + 512 + h * 64 + p0, o); }
        }
    }
    if (!RET) {
        float* X = (float*)(lds + C3_X);
        ssq += __shfl_xor(ssq, 32);
        if (hi == 0) X[hsub * 128 + i] = ssq;
        asm volatile("s_waitcnt vmcnt(0)" ::: "memory");
        __syncthreads();
        const float tot = X[i] + X[128 + i];
        const float rstd = 1.0f / sqrtf(tot * (1.f / 512.f) + EPS); const float* nw = IN(21) + l * 512;
#pragma unroll 1
        for (int h = hsub * 4; h < hsub * 4 + 4; ++h)
#pragma unroll
            for (int pt = 0; pt < 2; ++pt)
#pragma unroll
                for (int g = 0; g < 4; ++g) { const int c0 = h * 64 + pt * 32 + 8 * g + 4 * hi; bf16* mp = MIX + rowi * D + 512 + c0; const u32x2 v = *(const u32x2*)mp; const f32x4 w = *(const f32x4*)(nw + c0);
                    st_bf16x4(mp, (f32x4){bf2f(v.x & 0xffff) * rstd * w[0], bf2f(v.x >> 16) * rstd * w[1], bf2f(v.y & 0xffff) * rstd * w[2], bf2f(v.y >> 16) * rstd * w[3]}); }
    }
    __syncthreads();
}
DEVI void ph_scanC(const P& p, int l, unsigned char* lds) {
    const int tid = otid(), wid = __builtin_amdgcn_readfirstlane(tid >> 6), lane = tid & 63;
    const int NU = 2 * NCC;
    if (gridDim.x == 256) {
        const int c = blockIdx.x;
        if (c < NU) scanC_unit<false>(p, l, c, lds, tid, wid, lane);
        else { const int r = c - NU; scanC_unit<true>(p, l, r, lds, tid, wid, lane); if (r + 124 < NU) scanC_unit<true>(p, l, r + 124, lds, tid, wid, lane); }
    } else {
        for (int u = blockIdx.x; u < 2 * NU; u += gridDim.x) { if (u < NU) scanC_unit<false>(p, l, u, lds, tid, wid, lane); else scanC_unit<true>(p, l, u - NU, lds, tid, wid, lane); }
    }
}
DEVI void ph_scanA(const P& p, int l, unsigned char* lds) { for (int u = blockIdx.x; u < 2 * NCC * 3; u += gridDim.x) scanA_unit(p, l, u, lds); }
DEVI void ph_mixer(const P& p, int l, unsigned char* lds) {
    for (int u = blockIdx.x; u < 256; u += gridDim.x) scanB_slab(p, u, 384, 768);
    for (int a = blockIdx.x; a < 256; a += gridDim.x) attn_unit<0>(p, (a & 7) * 32 + (a >> 3), lds, (bf16*)(p.ws + WS_HM));
#if ATTN_PROBE
    if (l == 0) { __syncthreads(); for (int a = blockIdx.x; a < 256; a += gridDim.x) attn_unit<ATTN_PROBE>(p, (a & 7) * 32 + (a >> 3), lds, (bf16*)p.out); }
#endif
    if (l == 0) for (int a = blockIdx.x; a < 8; a += gridDim.x) attn_unit<0>(p, 256 + a, lds, (bf16*)(p.ws + WS_HM));
}

DEVI void ph_sort(const P& p, unsigned char* lds) {
    const int tid = otid(), wid = tid >> 6, lane = tid & 63;
    const int* rt_e = (const int*)(p.ws + WS_RT); int* rt_pos = (int*)(p.ws + WS_RT + 256 * 1024); int* tab = (int*)(p.ws + WS_RT + 384 * 1024); int* rt_tok = (int*)(p.ws + WS_RT + 640 * 1024);
    int* sh = (int*)lds;
    const int G = gridDim.x, R = (NLAT + G - 1) / G;
    for (int blk = blockIdx.x; blk * R < NLAT; blk += G) {
        const int r0 = blk * R, r1 = (r0 + R < NLAT) ? r0 + R : NLAT;
        int ct[8], cb[8];
#pragma unroll
        for (int e = 0; e < 8; ++e) { ct[e] = 0; cb[e] = 0; }
        for (int i = tid; i < NLAT * 2; i += NTHREADS) { const int e = rt_e[i]; const bool bef = (i >> 1) < r0;
#pragma unroll
            for (int x = 0; x < 8; ++x) { const int hit = (e == x) ? 1 : 0; ct[x] += hit; cb[x] += bef ? hit : 0; } }
#pragma unroll
        for (int e = 0; e < 8; ++e) {
#pragma unroll
            for (int o = 1; o < 64; o <<= 1) { ct[e] += __shfl_xor(ct[e], o); cb[e] += __shfl_xor(cb[e], o); }
        }
        __syncthreads();
        if (lane == 0) {
#pragma unroll
            for (int e = 0; e < 8; ++e) { sh[wid * 8 + e] = ct[e]; sh[64 + wid * 8 + e] = cb[e]; } }
        __syncthreads();
        if (tid == 0) { int start = 0, nt = 0;
            for (int e = 0; e < 8; ++e) { int tot = 0, bef = 0; for (int w = 0; w < 8; ++w) { tot += sh[w * 8 + e]; bef += sh[64 + w * 8 + e]; }
                sh[128 + e] = start; sh[136 + e] = start + bef; sh[144 + e] = tot; const int ntile = (tot + 255) >> 8;
                if (blk == 0) { for (int t = 0; t < ntile; ++t) tab[1 + nt + t] = e; }
                nt += ntile; start += ntile * 256; }
            if (blk == 0) tab[0] = nt; }
        __syncthreads();
        { const int n_ent = (r1 - r0) * 2; const bool valid = tid < n_ent; const int e = valid ? rt_e[r0 * 2 + tid] : -1; int rank = 0;
#pragma unroll
          for (int x = 0; x < 8; ++x) { const unsigned long long m = __ballot(e == x); if (e == x) rank = __popcll(m & ((1ull << lane) - 1ull)); if (lane == 0) sh[160 + wid * 8 + x] = __popcll(m); }
          __syncthreads();
          if (valid) { int pos = sh[136 + e] + rank; for (int w = 0; w < wid; ++w) pos += sh[160 + w * 8 + e]; sh[256 + tid] = pos; rt_pos[r0 * 2 + tid] = pos; } }
        __syncthreads();
        { const int n_ent = (r1 - r0) * 2; if (tid < n_ent) rt_tok[sh[256 + tid]] = r0 + (tid >> 1); }
        if (blk == 0) { for (int e = 0; e < 8; ++e) { const int tot = sh[144 + e], beg = sh[128 + e] + tot, end = sh[128 + e] + ((tot + 255) & ~255); for (int i = beg + tid; i < end; i += NTHREADS) rt_tok[i] = 0; } }
        __syncthreads();
    }
}
DEVI void ph_final(const P& p) {
    const int tid = otid(), wid = tid >> 6, lane = tid & 63;
    const float* rt_g = (const float*)(p.ws + WS_RT + 128 * 1024); const int* rt_pos = (const int*)(p.ws + WS_RT + 256 * 1024);
    const bf16* YS = (const bf16*)(p.ws + WS_HS); const float* modv = (const float*)(p.ws + WS_MODV) + (size_t)1 * 3 * 6144; const float* fw = IN(29);
    const int nw = gridDim.x * NWAVES, rpw = (NLAT + nw - 1) / nw, gw = blockIdx.x * NWAVES + wid;
    const int row0 = gw * rpw, row1 = (row0 + rpw < NLAT) ? row0 + rpw : NLAT;
    f32x4 fwv[4], gv[4]; int rc = -1;
#pragma unroll
    for (int j = 0; j < 4; ++j) fwv[j] = *(const f32x4*)(fw + (j * 64 + lane) * 4);
    for (int row = row0; row < row1; ++row) {
        const int b = row >> 13; float* x = p.out + (size_t)row * D;
        if (b != rc) { rc = b;
#pragma unroll
            for (int j = 0; j < 4; ++j) gv[j] = *(const f32x4*)(modv + b * 6144 + 5 * 1024 + (j * 64 + lane) * 4); }
        const float g0 = rt_g[row * 2], g1 = rt_g[row * 2 + 1]; const bf16* y0 = YS + (size_t)rt_pos[row * 2] * D; const bf16* y1 = YS + (size_t)rt_pos[row * 2 + 1] * D;
        f32x4 v[4]; float ss = 0.f;
#pragma unroll
        for (int j = 0; j < 4; ++j) { const int c0 = (j * 64 + lane) * 4; const f32x4 xv = *(const f32x4*)(x + c0); const u32x2 a = *(const u32x2*)(y0 + c0), c = *(const u32x2*)(y1 + c0);
            const f32x4 ya = {bf2f(a.x & 0xffff), bf2f(a.x >> 16), bf2f(a.y & 0xffff), bf2f(a.y >> 16)}, yb = {bf2f(c.x & 0xffff), bf2f(c.x >> 16), bf2f(c.y & 0xffff), bf2f(c.y >> 16)};
            v[j] = xv + gv[j] * (ya * g0 + yb * g1); ss += v[j][0] * v[j][0] + v[j][1] * v[j][1] + v[j][2] * v[j][2] + v[j][3] * v[j][3]; }
        ss = wave_sum(ss); const float rstd = 1.0f / sqrtf(ss * (1.f / D) + EPS);
#pragma unroll
        for (int j = 0; j < 4; ++j) { const int c0 = (j * 64 + lane) * 4; *(f32x4*)(x + c0) = v[j] * rstd * fwv[j]; }
    }
}

#define XB_TMO      128
#define XB_XCNT(j)  (256  + 64 * (j))
#define XB_XSUB(j)  (1280 + 64 * (j))
#define XB_XGEN(j)  (2304 + 64 * (j))
#define XB_TOP      3328
#define XB_TOPGEN   3392
#define XCD_BAR_WORDS 3456
#define XB_SPIN_CAP (1u << 22)
DEVI unsigned xb_ld(unsigned* p)              { return __hip_atomic_load(p, __ATOMIC_RELAXED, __HIP_MEMORY_SCOPE_AGENT); }
DEVI unsigned xb_add(unsigned* p, unsigned v) { return __hip_atomic_fetch_add(p, v, __ATOMIC_RELAXED, __HIP_MEMORY_SCOPE_AGENT); }
DEVI unsigned xb_xcc_id() { return (unsigned)__builtin_amdgcn_s_getreg((3 << 11) | 20) & 0xFu; }
#define XB_SPIN(cond, bar) do { unsigned _sp = 0; while (cond) { __builtin_amdgcn_s_sleep(1); \
    if ((++_sp & 255u) == 0u) { if (xb_ld(&(bar)[XB_TMO])) break; if (_sp > XB_SPIN_CAP) { atomicAdd(&(bar)[XB_TMO], 1u); break; } } } } while (0)
struct XcdBarrier { unsigned* bar; unsigned x; volatile LAS unsigned* st; };
DEVI XcdBarrier xcd_barrier_post(unsigned* bar, volatile LAS unsigned* st) {
    XcdBarrier b; b.bar = bar; b.x = xb_xcc_id(); b.st = st;
    if (threadIdx.x == 0) (void)xb_add(&bar[XB_XCNT(b.x)], 1u);
    return b;
}
DEVI void xcd_barrier_complete(unsigned* bar, unsigned x, unsigned& nloc, unsigned& nx) {
    const unsigned G = gridDim.x * gridDim.y * gridDim.z;
    unsigned sum, cnt, mine, sp = 0u;
    for (;;) {
        sum = 0u; cnt = 0u; mine = 0u;
#pragma unroll
        for (unsigned j = 0; j < 16; ++j) { const unsigned c = xb_ld(&bar[XB_XCNT(j)]); sum += c; cnt += (c > 0u) ? 1u : 0u; mine = (j == x) ? c : mine; }
        if (sum == G) break;
        __builtin_amdgcn_s_sleep(1);
        if ((++sp & 255u) == 0u) { if (xb_ld(&bar[XB_TMO])) break; if (sp > XB_SPIN_CAP) { atomicAdd(&bar[XB_TMO], 1u); break; } }
    }
    nloc = mine > 0u ? mine : 1u; nx = cnt > 0u ? cnt : 1u;
}
DEVI void xcd_barrier(const XcdBarrier& b) {
    asm volatile("s_waitcnt vmcnt(0)" ::: "memory");
    __syncthreads();
    if (threadIdx.x == 0) {
        unsigned* bar = b.bar;
        __builtin_amdgcn_s_waitcnt(0);
        unsigned nloc = b.st[0], nx = b.st[1];
        if (nloc == 0u) { xcd_barrier_complete(bar, b.x, nloc, nx); b.st[0] = nloc; b.st[1] = nx; }
        const unsigned old = xb_add(&bar[XB_XSUB(b.x)], 1u);
        const unsigned gen = old / nloc;
        if (old + 1u == (gen + 1u) * nloc) {
            __builtin_amdgcn_fence(__ATOMIC_RELEASE, "agent");
            asm volatile("s_waitcnt vmcnt(0)" ::: "memory");
            const unsigned og = xb_add(&bar[XB_TOP], 1u);
            const unsigned tg = og / nx;
            if (og + 1u == (tg + 1u) * nx) xb_add(&bar[XB_TOPGEN], 1u);
            else XB_SPIN(xb_ld(&bar[XB_TOPGEN]) == tg, bar);
            __builtin_amdgcn_fence(__ATOMIC_ACQUIRE, "agent");
            xb_add(&bar[XB_XGEN(b.x)], 1u);
            asm volatile("s_waitcnt vmcnt(0)" ::: "memory");
        } else {
            XB_SPIN(xb_ld(&bar[XB_XGEN(b.x)]) == gen, bar);
            __builtin_amdgcn_fence(__ATOMIC_ACQUIRE, "agent");
            asm volatile("s_waitcnt vmcnt(0)" ::: "memory");
        }
    }
    __syncthreads();
}

constexpr int NPHASES = 24;
#ifndef XSYNC
#define XSYNC 0
#endif
#ifndef REP_MASK
#define REP_MASK 0u
#endif
#ifndef PH_MASK
#define PH_MASK 0xffffu
#endif
__global__ void __launch_bounds__(NTHREADS, 2) mk_fwd(P p) {
    extern __shared__ __attribute__((aligned(16))) unsigned char lds[];
    cg::grid_group grid = cg::this_grid();
    const int G = gridDim.x, c = blockIdx.x;
    if (threadIdx.x < 30) ((lds_u64*)(uintptr_t)LDS_PTRS)[threadIdx.x] = (unsigned long long)p.in[threadIdx.x];
    if (threadIdx.x < 2) ((volatile LAS unsigned*)(uintptr_t)LDS_MISC)[threadIdx.x] = 0u;
    __syncthreads();
    XcdBarrier xbar = xcd_barrier_post((unsigned*)(p.ws + WS_CTL) + 1024, (volatile LAS unsigned*)(uintptr_t)LDS_MISC);
    int nsync = 0;
#define GRID_BAR() do { if (nsync == 0) grid.sync(); else xcd_barrier(xbar); ++nsync; } while (0)
    int ph = 0;
#define RUN(kid, ...) do { if (((PH_MASK >> (kid)) & 1u) && ph >= p.ph_lo && ph < p.ph_hi) { __VA_ARGS__; if ((REP_MASK >> (kid)) & 1u) { __VA_ARGS__; } if (ph + 1 < p.ph_hi) { GRID_BAR(); for (int xs_ = 0; xs_ < XSYNC; ++xs_) GRID_BAR(); } } ++ph; } while (0)
    RUN(0, ph_pro(p, lds));
#define LAYER(l) \
        RUN(1, ph_norm<false>(p, l, 0, T, lds, l == 1 ? 11 : 0, 5)); \
        RUN(2, { Gemm g{(const bf16*)(p.ws + WS_HM), (const bf16*)(p.ws + WS_WIN) + (size_t)l * INWP * 1024, 0, nullptr}; DenseSched S{T / 256, INWP / 256, G, c}; \
            EpiInProj E{(bf16*)(p.ws + WS_PROJ), (float*)(p.ws + WS_DT), IN(18) + l * 16, IN(19) + l * 16}; gemm_phase<D, 1024, 1024>(lds, g, S, E); }); \
        RUN(3, ph_conv(p, l)); \
        RUN(4, { Gemm g{(const bf16*)(p.ws + WS_PROJ), (const bf16*)(p.ws + WS_WQKV) + (size_t)l * 1024 * 384, 0, nullptr}; DenseSched S{T / 256, 4, G, c}; \
            EpiMla E{(bf16*)(p.ws + WS_Q), (bf16*)(p.ws + WS_K), (bf16*)(p.ws + WS_V), (const float*)(p.ws + WS_RQ), (const float*)(p.ws + WS_RKV), (const float*)(p.ws + WS_ROPE)}; gemm_phase<INWP, 384, 384>(lds, g, S, E); ph_scanA(p, l, lds); }); \
        RUN(5, ph_mixer(p, l, lds)); \
        RUN(6, ph_scanC(p, l, lds)); \
        if (l == 1) RUN(7, ph_moew(p, lds)); \
        RUN(8, { Gemm g{(const bf16*)(p.ws + WS_HM), (const bf16*)(p.ws + WS_WOUT) + (size_t)l * 1024 * 1024, 0, nullptr}; DenseSched S{NLAT / 256, 4, G, c}; \
            EpiResid E{l == 0 ? IN(0) : p.out, (const float*)(p.ws + WS_XC), p.out, (float*)(p.ws + WS_XC), (const float*)(p.ws + WS_MODV) + (size_t)l * 3 * 6144, 2}; gemm_phase<D, 1024, 1024>(lds, g, S, E); \
            if (l == 0) { CtxSplitSched S2{4, 256 * 2, G, c}; EpiPart E2{(float*)(p.ws + WS_XBC)}; gemm_phase<D, 1024, 256>(lds, g, S2, E2); } }); \
        RUN(9, ph_norm<l == 1>(p, l, 1, l == 0 ? T : NLAT, lds, l == 0 ? 4 : 0, 2)); \
        if (l == 0) { \
            RUN(10, { Gemm g{(const bf16*)(p.ws + WS_HM), (const bf16*)(p.ws + WS_WGU), 0, nullptr}; DenseSched S{T / 256, 2 * DFF / 256, G, c}; \
                EpiSwiglu E{(bf16*)(p.ws + WS_PROJ), DFF}; gemm_phase<D, 1024, 1024>(lds, g, S, E); }); \
            RUN(11, { Gemm g{(const bf16*)(p.ws + WS_PROJ), (const bf16*)(p.ws + WS_WD), 0, nullptr}; DenseSched S{NLAT / 256, 4, G, c}; \
                EpiResid E{p.out, (const float*)(p.ws + WS_XC), p.out, (float*)(p.ws + WS_XC), (const float*)(p.ws + WS_MODV), 5}; gemm_phase<DFF, DFF, DFF>(lds, g, S, E); \
                CtxSplitSched S2{11, 256 * 2, G, c}; EpiPart E2{(float*)(p.ws + WS_XBC)}; gemm_phase<DFF, DFF, 256>(lds, g, S2, E2); }); \
        } else { \
            RUN(12, ph_sort(p, lds)); \
            RUN(13, { Gemm g{(const bf16*)(p.ws + WS_HM), (const bf16*)(p.ws + WS_WGUE), (size_t)2 * DFE * 1024, (const int*)(p.ws + WS_RT + 640 * 1024)}; MoeSched S{(const int*)(p.ws + WS_RT + 384 * 1024), 2 * DFE / 256, G, c}; \
                EpiSwiglu E{(bf16*)(p.ws + WS_ACTS), DFE}; gemm_phase<D, 1024, 1024, EpiSwiglu, MoeSched, true>(lds, g, S, E); }); \
            RUN(14, { Gemm g{(const bf16*)(p.ws + WS_ACTS), (const bf16*)(p.ws + WS_WDE), (size_t)1024 * DFE, nullptr}; MoeSched S{(const int*)(p.ws + WS_RT + 384 * 1024), 4, G, c}; \
                EpiStore E{(bf16*)(p.ws + WS_HS), D}; gemm_phase<DFE, DFE, DFE>(lds, g, S, E); }); \
            RUN(15, ph_final(p)); \
        }
    LAYER(0)
    LAYER(1)
#undef LAYER
#undef RUN
}

#ifndef MK_ONE_LAUNCH
#define MK_ONE_LAUNCH 1
#endif
extern "C" void kernel_launch(void* const* d_in, const int* in_sizes, int n_in, void* d_out, int out_size, void* d_ws, size_t ws_size, hipStream_t stream) {
    static int grid = 0;
    if (grid == 0) {
        if (n_in != 30 || out_size != NLAT * D || ws_size < WS_END) { fprintf(stderr, "kernel_launch: unexpected problem (n_in %d out %d ws %zu, need %zu)\n", n_in, out_size, ws_size, (size_t)WS_END); grid = -1; return; }
        int dev = 0, cus = 0, per_cu = 0;
        hipGetDevice(&dev); hipDeviceGetAttribute(&cus, hipDeviceAttributeMultiprocessorCount, dev);
        if (hipFuncSetAttribute((const void*)mk_fwd, hipFuncAttributeMaxDynamicSharedMemorySize, LDS_BYTES) != hipSuccess) { fprintf(stderr, "kernel_launch: hipFuncSetAttribute failed\n"); grid = -1; return; }
        if (hipOccupancyMaxActiveBlocksPerMultiprocessor(&per_cu, (const void*)mk_fwd, NTHREADS, LDS_BYTES) != hipSuccess || per_cu < 1) { fprintf(stderr, "kernel_launch: occupancy query failed (%d)\n", per_cu); grid = -1; return; }
        grid = cus;
        fprintf(stderr, "kernel_launch: grid %d (cus %d, per_cu %d)\n", grid, cus, per_cu);
    }
    if (grid < 0) return;
    if (hipMemsetAsync((char*)d_ws + WS_CTL, 0, 65536, stream) != hipSuccess) { fprintf(stderr, "kernel_launch: memset failed\n"); return; }
    P p{};
    for (int i = 0; i < 30; ++i) p.in[i] = (const float*)d_in[i];
    p.out = (float*)d_out; p.ws = (unsigned char*)d_ws;
#if MK_ONE_LAUNCH
    p.ph_lo = 0; p.ph_hi = NPHASES;
    { void* args[] = {&p}; hipError_t e = hipLaunchCooperativeKernel((const void*)mk_fwd, dim3(grid), dim3(NTHREADS), args, LDS_BYTES, stream);
      if (e != hipSuccess) fprintf(stderr, "cooperative launch failed: %s\n", hipGetErrorString(e)); }
#else
    for (int ph = 0; ph < NPHASES; ++ph) {
        p.ph_lo = ph; p.ph_hi = ph + 1;
        void* args[] = {&p}; hipError_t e = hipLaunchCooperativeKernel((const void*)mk_fwd, dim3(grid), dim3(NTHREADS), args, LDS_BYTES, stream);
        if (e != hipSuccess) { fprintf(stderr, "cooperative launch %d failed: %s\n", ph, hipGetErrorString(e)); break; }
    }
#endif
}
```

```cpp
#include <hip/hip_runtime.h>
#include <hip/hip_cooperative_groups.h>
#include <cstdio>
#include <cstdint>
namespace cg = cooperative_groups;
#ifndef ATTN_PROBE
#define ATTN_PROBE 0
#endif

#define DEVI __device__ __forceinline__
typedef unsigned short bf16;
typedef short bf16x8 __attribute__((ext_vector_type(8)));
typedef float f32x4 __attribute__((ext_vector_type(4)));
typedef float f32x2 __attribute__((ext_vector_type(2)));
typedef float f32x16 __attribute__((ext_vector_type(16)));
typedef unsigned u32x4 __attribute__((ext_vector_type(4)));
typedef unsigned u32x2 __attribute__((ext_vector_type(2)));
typedef __bf16 bf16x2_t __attribute__((ext_vector_type(2)));

constexpr int D = 1024, NB = 2, SEQ = 8192, NLAT = NB * SEQ, CL = 256, NCTX = NB * CL, T = NLAT + NCTX;
constexpr int INW = 2736, INWP = 2816;
constexpr int C_CQ = 0, C_CKV = 256, C_KPE = 384, C_RQ = 416, C_RK = 672, C_RV = 928, C_RG = 1184, C_Z = 1440, C_XBC = 1952, C_DTF = 2720, C_DTB = 2728;
constexpr int DFF = 2816, DFE = 1408, NEXP = 8;
constexpr float EPS = 1e-6f;
constexpr int MOE_MAXROWS = 34816;

constexpr size_t MiB = 1u << 20;
constexpr size_t WS_CTL = 0;
constexpr size_t WS_MODV = 1 * MiB;
constexpr size_t WS_ROPE = WS_MODV + 256 * 1024;
constexpr size_t WS_RQ = WS_MODV + 512 * 1024;
constexpr size_t WS_RKV = WS_MODV + 640 * 1024;
constexpr size_t WS_WIN = 2 * MiB;
constexpr size_t WS_WQKV = 13 * MiB;
constexpr size_t WS_WOUT = 15 * MiB;
constexpr size_t WS_WGU = 19 * MiB;
constexpr size_t WS_WD = 30 * MiB;
constexpr size_t WS_XC = 36 * MiB;
constexpr size_t WS_RT = 38 * MiB;
constexpr size_t WS_DT = 39 * MiB;
constexpr size_t WS_RQP = 41 * MiB + 128 * 1024;
constexpr size_t WS_RKVP = 41 * MiB + 512 * 1024;
constexpr size_t DYN = 42 * MiB;
constexpr size_t WS_HM = DYN;
constexpr size_t WS_PROJ = DYN + 33 * MiB;
constexpr size_t WS_XBC = DYN + 124 * MiB;
constexpr size_t WS_Q = DYN + 149 * MiB;
constexpr size_t WS_K = DYN + 161 * MiB + 512 * 1024;
constexpr size_t WS_V = DYN + 174 * MiB;
constexpr size_t WS_ST = DYN + 182 * MiB + 512 * 1024;
constexpr size_t WS_HT = WS_ST + (size_t)1584 * 2 * 4096 * 4;
constexpr size_t WS_CD = WS_RT + 512 * 1024;
constexpr size_t WS_VEC = WS_HT + (size_t)1584 * 2 * 4096 * 2;
constexpr size_t WS_WGUE = DYN + 33 * MiB;
constexpr size_t WS_WDE = DYN + 77 * MiB;
constexpr size_t WS_HS = DYN + 99 * MiB;
constexpr size_t WS_ACTS = DYN + 167 * MiB;
constexpr size_t WS_END = DYN + 261 * MiB;
static_assert(WS_HM + (size_t)T * 1024 * 2 <= WS_PROJ && WS_PROJ + (size_t)T * 2816 * 2 <= WS_XBC && WS_XBC + (size_t)T * 768 * 2 <= WS_Q &&
              WS_Q + (size_t)T * 384 * 2 <= WS_K && WS_K + (size_t)T * 384 * 2 <= WS_V && WS_V + (size_t)T * 256 * 2 <= WS_ST && WS_VEC + (size_t)1584 * 512 * 4 <= WS_END, "ws map (mixer)");
static_assert(WS_WGUE + (size_t)8 * 2816 * 1024 * 2 <= WS_WDE && WS_WDE + (size_t)8 * 1024 * 1408 * 2 <= WS_HS && WS_HS + (size_t)MOE_MAXROWS * 1024 * 2 <= WS_ACTS &&
              WS_ACTS + (size_t)MOE_MAXROWS * 1408 * 2 <= WS_END, "ws map (moe)");
static_assert(WS_DT + (size_t)T * 32 * 4 <= DYN && WS_WD + (size_t)1024 * 2816 * 2 <= WS_XC && WS_WIN + (size_t)2 * 2816 * 1024 * 2 <= WS_WQKV, "ws map (static)");

constexpr int NTHREADS = 512, NWAVES = 8;
constexpr int LDS_BYTES = 147456;

struct P { const float* in[30]; float* out; unsigned char* ws; int ph_lo, ph_hi; };
constexpr int LDS_MISC = 147456 - 512;
constexpr int LDS_PTRS = 147456 - 256;
typedef __attribute__((address_space(3))) unsigned long long lds_u64;
DEVI const float* inptr(int i) {
    const unsigned long long v = ((lds_u64*)(uintptr_t)LDS_PTRS)[i];
    const unsigned lo = __builtin_amdgcn_readfirstlane((unsigned)v), hi = __builtin_amdgcn_readfirstlane((unsigned)(v >> 32));
    return (const float*)(((unsigned long long)hi << 32) | lo);
}
#define IN(i) inptr(i)
DEVI int otid() { int t = threadIdx.x; asm volatile("" : "+v"(t)); return t; }

DEVI float bf2f(bf16 x) { return __uint_as_float(((unsigned)x) << 16); }
DEVI unsigned pk2(float lo, float hi) { f32x2 v = {lo, hi}; bf16x2_t b = __builtin_convertvector(v, bf16x2_t); return __builtin_bit_cast(unsigned, b); }
DEVI bf16 f2bf(float x) { return (bf16)(pk2(x, 0.f) & 0xffffu); }
DEVI float wave_sum(float v) {
#pragma unroll
    for (int o = 1; o < 64; o <<= 1) v += __shfl_xor(v, o);
    return v;
}
DEVI float siluf(float x) { return x / (1.f + __expf(-x)); }
DEVI float softplusf(float x) { return fmaxf(x, 0.f) + log1pf(__expf(-fabsf(x))); }
DEVI int rope_src(int p) { const int q = p & 15, s = (q & 1) ? 8 + (q >> 1) : (q >> 1); return (p & 16) + s; }

#define LAS __attribute__((address_space(3)))
struct Unit { int pm, pn, e, koff; };
struct Gemm { const bf16* A; const bf16* Bt; size_t bstride; const int* rowtab; };
constexpr int BM = 256, BK = 64, HALF = 128, HTB = HALF * BK * 2, STAGE_BYTES = 8 * HTB, NXCD = 8, WGM = 8;
__host__ __device__ __forceinline__ int lds_byte(int r, int c) { const int st = (r >> 4) * 2 + (c >> 5), rr = r & 15, cc = c & 31, ob = rr * 64 + cc * 2; return st * 1024 + (ob ^ (((ob >> 9) & 1) << 5)); }
__host__ __device__ __forceinline__ void stage_rc(int b, int& R, int& C) { const int st = b / 1024, sb = b % 1024, swz = sb ^ (((sb >> 9) & 1) << 5); R = (st >> 1) * 16 + swz / 64; C = (st & 1) * 32 + (swz % 64) / 2; }
struct DenseSched {
    int nM, nN, G, c;
    DEVI bool next(int i, Unit& u) const {
        const int nwg = nM * nN; const long L = (long)i * G + c; if (L >= nwg) return false;
        int wgid = (int)L; { const int q = nwg / NXCD, r = nwg % NXCD, xcd = wgid % NXCD, off = wgid / NXCD; wgid = (xcd < r ? xcd * (q + 1) : r * (q + 1) + (xcd - r) * q) + off; }
        const int nig = WGM * nN, gid = wgid / nig, fm = gid * WGM, gsz = (nM - fm) < WGM ? (nM - fm) : WGM;
        u.pm = fm + ((wgid % nig) % gsz); u.pn = (wgid % nig) / gsz; u.e = 0; u.koff = 0; return true;
    }
};
struct CtxSplitSched {
    int nsplit, kbytes, G, c;
    DEVI bool next(int i, Unit& u) const { const int id = i * G + c; if (id >= 8 * nsplit) return false; const int tile = id & 7, ks = id >> 3; u.pm = 64 + (tile >> 2); u.pn = tile & 3; u.e = ks; u.koff = ks * kbytes; return true; }
};
struct MoeSched {
    const int* tab; int nN, G, c;
    DEVI bool next(int i, Unit& u) const { DenseSched d{tab[0], nN, G, c}; if (!d.next(i, u)) return false; u.e = tab[1 + u.pm]; return true; }
};
template <int LDA, int LDB, int KK, class Epi, class Sched, bool GATHER = false>
DEVI void gemm_phase(unsigned char* lds_generic, const Gemm g, const Sched& S, const Epi& E) {
    LAS unsigned char* lds = (LAS unsigned char*)lds_generic;
    const int tid = otid(), wid = __builtin_amdgcn_readfirstlane(tid >> 6), lane = tid & 63, wr = wid >> 2, wc = wid & 3, fr = lane & 15, fq = lane >> 4;
    constexpr int nt = KK / BK; static_assert(KK % 128 == 0, "K must be a multiple of 128");
    unsigned voffA[2], voffB[2]; int Rr[2], Cc[2];
#pragma unroll
    for (int i = 0; i < 2; ++i) { int R, C; stage_rc(tid * 16 + i * 8192, R, C); Rr[i] = R; Cc[i] = C; voffA[i] = (unsigned)(R * LDA + C) * 2u; voffB[i] = (unsigned)(R * LDB + C) * 2u; }
    unsigned cv0[2] = {voffA[0], voffA[1]}, cv1[2] = {voffA[0], voffA[1]}, nv0[2] = {voffA[0], voffA[1]}, nv1[2] = {voffA[0], voffA[1]};
#define PG8_ROWS(u, v0, v1) do { if (GATHER) { _Pragma("unroll") for (int i_ = 0; i_ < 2; ++i_) { v0[i_] = (unsigned)(g.rowtab[(u).pm * BM + Rr[i_]] * LDA + Cc[i_]) * 2u; v1[i_] = (unsigned)(g.rowtab[(u).pm * BM + HALF + Rr[i_]] * LDA + Cc[i_]) * 2u; } } } while (0)
    constexpr size_t kstep = (size_t)(BK * 2), hstepA = GATHER ? (size_t)0 : (size_t)HALF * LDA * 2, hstepB = (size_t)HALF * LDB * 2, tstepA = GATHER ? (size_t)0 : (size_t)2 * HALF * LDA * 2, tstepB = 2 * hstepB;
    const unsigned ldsw = (unsigned)wid * 1024u;
    const int aoff = lds_byte(wr * 64 + fr, fq * 8), boff = lds_byte(wc * 32 + fr, fq * 8);
#define PG8_SA(b, h) (((b) * 2 + (h)) * HTB)
#define PG8_SB(b, h) ((4 + (b) * 2 + (h)) * HTB)
#define PG8_STAGE(bufoff, gbase, voff) do { _Pragma("unroll") for (int _i = 0; _i < 2; ++_i) \
        __builtin_amdgcn_global_load_lds((const unsigned*)((const char*)(gbase) + (voff)[_i]), (LAS unsigned*)(lds + (bufoff) + ldsw + _i * 8192), 16, 0, 0); } while (0)
#define PG8_LDA(dst, b, h) do { _Pragma("unroll") for (int m = 0; m < 4; ++m) _Pragma("unroll") for (int k = 0; k < 2; ++k) dst[m][k] = *(const LAS bf16x8*)(lds + PG8_SA(b, h) + aoff + m * 2048 + k * 1024); } while (0)
#define PG8_LDB(dst, b, h) do { _Pragma("unroll") for (int n = 0; n < 2; ++n) _Pragma("unroll") for (int k = 0; k < 2; ++k) dst[n][k] = *(const LAS bf16x8*)(lds + PG8_SB(b, h) + boff + n * 2048 + k * 1024); } while (0)
#define PG8_MMA(ai, bj, At, Bt) do { __builtin_amdgcn_s_setprio(1); _Pragma("unroll") for (int m = 0; m < 4; ++m) _Pragma("unroll") for (int n = 0; n < 2; ++n) _Pragma("unroll") for (int k = 0; k < 2; ++k) \
        acc[ai][bj][m][n] = __builtin_amdgcn_mfma_f32_16x16x32_bf16(Bt[n][k], At[m][k], acc[ai][bj][m][n], 0, 0, 0); __builtin_amdgcn_s_setprio(0); } while (0)
#define PG8_WAIT_V(n) asm volatile("s_waitcnt vmcnt(" #n ")" ::: "memory")
#define PG8_WAIT_L(n) asm volatile("s_waitcnt lgkmcnt(" #n ")" ::: "memory")
#define PG8_BAR __builtin_amdgcn_s_barrier()
#define PG8_SCHED __builtin_amdgcn_sched_barrier(0)
    Unit cur, nxt; int ui = 0;
    if (!S.next(0, cur)) return;
    f32x4 acc[2][2][4][2];
#pragma unroll
    for (int a = 0; a < 2; ++a)
#pragma unroll
        for (int b = 0; b < 2; ++b)
#pragma unroll
            for (int m = 0; m < 4; ++m)
#pragma unroll
                for (int n = 0; n < 2; ++n) acc[a][b][m][n] = (f32x4){0.f, 0.f, 0.f, 0.f};
    bf16x8 At[4][2], B0[2][2], B1[2][2];
    const char* cA = (const char*)g.A + (size_t)cur.pm * tstepA + cur.koff; const char* cB = (const char*)(g.Bt + (size_t)cur.e * g.bstride) + (size_t)cur.pn * tstepB + cur.koff;
    PG8_WAIT_V(0); PG8_WAIT_L(0); __syncthreads();
    PG8_ROWS(cur, cv0, cv1);
    PG8_STAGE(PG8_SB(0, 0), cB, voffB); PG8_STAGE(PG8_SB(0, 1), cB + hstepB, voffB); PG8_STAGE(PG8_SA(0, 0), cA, cv0); PG8_STAGE(PG8_SA(0, 1), cA + hstepA, cv1);
    if (wr == 1) PG8_BAR;
    PG8_WAIT_V(2); PG8_BAR;
    PG8_STAGE(PG8_SB(1, 0), cB + kstep, voffB); PG8_STAGE(PG8_SA(1, 0), cA + kstep, cv0); PG8_STAGE(PG8_SB(1, 1), cB + hstepB + kstep, voffB);
    PG8_WAIT_V(6); PG8_BAR;
    for (;;) {
        const bool has_next = S.next(ui + 1, nxt);
        if (has_next) PG8_ROWS(nxt, nv0, nv1);
        const char* nA = has_next ? (const char*)g.A + (size_t)nxt.pm * tstepA + nxt.koff : cA; const char* nB = has_next ? (const char*)(g.Bt + (size_t)nxt.e * g.bstride) + (size_t)nxt.pn * tstepB + nxt.koff : cB;
#pragma unroll 1
        for (int t = 0; t < nt; t += 2) {
            const bool last = (t == nt - 2);
            const char* a1 = cA + (size_t)(t + 1) * kstep;
            const char* a2 = last ? nA : cA + (size_t)(t + 2) * kstep; const char* b2 = last ? nB : cB + (size_t)(t + 2) * kstep;
            const char* a3 = a2 + kstep; const char* b3 = b2 + kstep;
            unsigned s0[2] = {cv0[0], cv0[1]}, s1[2] = {cv1[0], cv1[1]};
            if (GATHER && last && has_next) { s0[0] = nv0[0]; s0[1] = nv0[1]; s1[0] = nv1[0]; s1[1] = nv1[1]; }
            PG8_LDB(B0, 0, 0); PG8_LDB(B1, 0, 1); PG8_SCHED; PG8_LDA(At, 0, 0); PG8_STAGE(PG8_SA(1, 1), a1 + hstepA, cv1);
            PG8_WAIT_V(8); PG8_WAIT_L(0); PG8_BAR; PG8_MMA(0, 0, At, B0); PG8_MMA(0, 1, At, B1); PG8_BAR; PG8_SCHED;
            PG8_LDA(At, 0, 1); PG8_STAGE(PG8_SB(0, 0), b2, voffB); PG8_STAGE(PG8_SB(0, 1), b2 + hstepB, voffB); PG8_STAGE(PG8_SA(0, 0), a2, s0);
            PG8_WAIT_V(8); PG8_WAIT_L(0); PG8_BAR; PG8_MMA(1, 0, At, B0); PG8_MMA(1, 1, At, B1); PG8_BAR; PG8_SCHED;
            PG8_LDB(B0, 1, 0); PG8_LDB(B1, 1, 1); PG8_SCHED; PG8_LDA(At, 1, 0); PG8_STAGE(PG8_SA(0, 1), a2 + hstepA, s1);
            PG8_WAIT_V(8); PG8_WAIT_L(0); PG8_BAR; PG8_MMA(0, 0, At, B0); PG8_MMA(0, 1, At, B1); PG8_BAR; PG8_SCHED;
            PG8_LDA(At, 1, 1); PG8_STAGE(PG8_SB(1, 0), b3, voffB); PG8_STAGE(PG8_SB(1, 1), b3 + hstepB, voffB); PG8_STAGE(PG8_SA(1, 0), a3, s0);
            PG8_WAIT_V(8); PG8_WAIT_L(0); PG8_BAR; PG8_MMA(1, 0, At, B0); PG8_MMA(1, 1, At, B1); PG8_BAR; PG8_SCHED;
        }
        if (wr == 0) PG8_BAR;
        E(acc, cur, wr, wc, fr, fq);
        if (!has_next) break;
#pragma unroll
        for (int a = 0; a < 2; ++a)
#pragma unroll
            for (int b = 0; b < 2; ++b)
#pragma unroll
                for (int m = 0; m < 4; ++m)
#pragma unroll
                    for (int n = 0; n < 2; ++n) acc[a][b][m][n] = (f32x4){0.f, 0.f, 0.f, 0.f};
        cur = nxt; cA = nA; cB = nB; ++ui;
        if (GATHER) { cv0[0] = nv0[0]; cv0[1] = nv0[1]; cv1[0] = nv1[0]; cv1[1] = nv1[1]; }
        if (wr == 1) PG8_BAR;
    }
    PG8_WAIT_V(0);
    PG8_BAR;
#undef PG8_ROWS
#undef PG8_SA
#undef PG8_SB
#undef PG8_STAGE
#undef PG8_LDA
#undef PG8_LDB
#undef PG8_MMA
#undef PG8_WAIT_V
#undef PG8_WAIT_L
#undef PG8_BAR
#undef PG8_SCHED
}
#define EPI_LOOP_ROWS _Pragma("unroll") for (int ai = 0; ai < 2; ++ai) _Pragma("unroll") for (int m = 0; m < 4; ++m)
#define EPI_ROW (u.pm * 256 + ai * 128 + wr * 64 + m * 16 + fr)
#define EPI_COL(bj, n) (u.pn * 256 + (bj) * 128 + wc * 32 + (n) * 16 + fq * 4)

DEVI void st_bf16x4(bf16* p, f32x4 v) { u32x2 w; w.x = pk2(v[0], v[1]); w.y = pk2(v[2], v[3]); *(u32x2*)p = w; }

struct EpiInProj {
    bf16* proj; float* dt; const float* dt_bias; const float* a_log; float* rqp; float* rkvp;
    DEVI void operator()(const f32x4 (&acc)[2][2][4][2], const Unit& u, int wr, int wc, int fr, int fq) const {
        EPI_LOOP_ROWS { const int row = EPI_ROW;
            if (u.pn <= 1) { float ssq = 0.f;
#pragma unroll
                for (int bj = 0; bj < 2; ++bj) if (u.pn == 0 || bj == 0) {
#pragma unroll
                    for (int n = 0; n < 2; ++n) { const f32x4 v = acc[ai][bj][m][n]; ssq += (v[0] * v[0] + v[1] * v[1]) + (v[2] * v[2] + v[3] * v[3]); } }
                ssq += __shfl_xor(ssq, 16); ssq += __shfl_xor(ssq, 32);
                if (fq == 0) (u.pn == 0 ? rqp : rkvp)[(size_t)row * 4 + wc] = ssq; }
#pragma unroll
            for (int bj = 0; bj < 2; ++bj)
#pragma unroll
                for (int n = 0; n < 2; ++n) { const int col = EPI_COL(bj, n); const f32x4 v = acc[ai][bj][m][n];
                    if (col < C_DTF) st_bf16x4(proj + (size_t)row * INWP + col, v);
                    else if (col < INW) { const int j0 = col - C_DTF; f32x4 dv, lv;
#pragma unroll
                        for (int i = 0; i < 4; ++i) { const float d_ = softplusf(v[i] + dt_bias[j0 + i]); dv[i] = d_; lv[i] = -d_ * __expf(a_log[j0 + i]); }
                        *(f32x4*)(dt + (size_t)row * 32 + j0) = dv; *(f32x4*)(dt + (size_t)row * 32 + 16 + j0) = lv; } } }
    }
};
struct EpiMla {
    bf16 *Q, *K, *V; const float *rqp, *rkvp; const float* rope; const bf16* proj;
    DEVI void operator()(const f32x4 (&acc)[2][2][4][2], const Unit& u, int wr, int wc, int fr, int fq) const {
        EPI_LOOP_ROWS { const int row = EPI_ROW; float sq = 0.f, skv = 0.f;
            if (u.pn <= 1) { const f32x4 pq = *(const f32x4*)(rqp + (size_t)row * 4); sq = 1.0f / sqrtf(((pq[0] + pq[1]) + (pq[2] + pq[3])) * (1.f / 256.f) + EPS); }
            if (u.pn >= 2) { const f32x4 pk = *(const f32x4*)(rkvp + (size_t)row * 4); skv = 1.0f / sqrtf(((pk[0] + pk[1]) + (pk[2] + pk[3])) * (1.f / 128.f) + EPS); }
            const int pos = row & (SEQ - 1), gr = pos >> 6, gc = pos & 63;
#pragma unroll
            for (int bj = 0; bj < 2; ++bj)
#pragma unroll
                for (int n = 0; n < 2; ++n) { const int col = EPI_COL(bj, n); f32x4 v = acc[ai][bj][m][n];
                    if (col < 384) { v = v * sq; const int d = col % 96;
                        if (d >= 64 && row < NLAT) { const int pp = (d - 64) >> 1;
#pragma unroll
                            for (int i = 0; i < 2; ++i) { const int pi = pp + i; const float* tb = (pi < 8) ? rope + (gr * 8 + pi) * 2 : rope + 2048 + (gc * 8 + (pi - 8)) * 2;
                                const float c = tb[0], s = tb[1], x0 = v[2 * i], x1 = v[2 * i + 1]; v[2 * i] = x0 * c - x1 * s; v[2 * i + 1] = x1 * c + x0 * s; } }
                        st_bf16x4(Q + (size_t)row * 384 + col, v); }
                    else if (col < 416) { const int d0 = col - 384, pp = d0 >> 1; const u32x2 raw = *(const u32x2*)(proj + (size_t)row * INWP + C_KPE + d0);
                        f32x4 x = {bf2f(raw.x & 0xffff), bf2f(raw.x >> 16), bf2f(raw.y & 0xffff), bf2f(raw.y >> 16)};
                        if (row < NLAT) {
#pragma unroll
                            for (int i = 0; i < 2; ++i) { const int pi = pp + i; const float* tb = (pi < 8) ? rope + (gr * 8 + pi) * 2 : rope + 2048 + (gc * 8 + (pi - 8)) * 2;
                                const float c = tb[0], s = tb[1], x0 = x[2 * i], x1 = x[2 * i + 1]; x[2 * i] = x0 * c - x1 * s; x[2 * i + 1] = x1 * c + x0 * s; } }
#pragma unroll
                        for (int h = 0; h < 4; ++h) st_bf16x4(K + (size_t)row * 384 + h * 96 + 64 + d0, x); }
                    else if (col >= 512 && col < 768) { const int c = col - 512; st_bf16x4(K + (size_t)row * 384 + (c >> 6) * 96 + (c & 63), v * skv); }
                    else if (col >= 768) { st_bf16x4(V + (size_t)row * 256 + (col - 768), v * skv); } }
            asm volatile("" ::: "memory"); }
    }
};
struct EpiResid {
    const float* src_lat; const float* src_ctx; float* dst_lat; float* dst_ctx; const float* modv_l; int gidx;
    DEVI void operator()(const f32x4 (&acc)[2][2][4][2], const Unit& u, int wr, int wc, int fr, int fq) const {
        EPI_LOOP_ROWS { const int row = EPI_ROW; const bool lat = row < NLAT; const int r = lat ? (row >> 13) : 2;
            const float* s = lat ? src_lat + (size_t)row * D : src_ctx + (size_t)(row - NLAT) * D; float* d = lat ? dst_lat + (size_t)row * D : dst_ctx + (size_t)(row - NLAT) * D;
            const float* gp = modv_l + r * 6144 + gidx * 1024;
#pragma unroll
            for (int bj = 0; bj < 2; ++bj)
#pragma unroll
                for (int n = 0; n < 2; ++n) { const int col = EPI_COL(bj, n); const f32x4 gv = *(const f32x4*)(gp + col), sv = *(const f32x4*)(s + col);
                    *(f32x4*)(d + col) = sv + gv * acc[ai][bj][m][n]; } }
    }
};
struct EpiPart {
    float* part;
    DEVI void operator()(const f32x4 (&acc)[2][2][4][2], const Unit& u, int wr, int wc, int fr, int fq) const {
        EPI_LOOP_ROWS { const int row = EPI_ROW; float* d = part + ((size_t)u.e * NCTX + (row - NLAT)) * D;
#pragma unroll
            for (int bj = 0; bj < 2; ++bj)
#pragma unroll
                for (int n = 0; n < 2; ++n) *(f32x4*)(d + EPI_COL(bj, n)) = acc[ai][bj][m][n]; }
    }
};
struct EpiSwiglu {
    bf16* act; int ldc;
    DEVI void operator()(const f32x4 (&acc)[2][2][4][2], const Unit& u, int wr, int wc, int fr, int fq) const {
        EPI_LOOP_ROWS { const int row = EPI_ROW;
#pragma unroll
            for (int n = 0; n < 2; ++n) { const f32x4 gt = acc[ai][0][m][n], up = acc[ai][1][m][n]; f32x4 o;
#pragma unroll
                for (int i = 0; i < 4; ++i) o[i] = siluf(gt[i]) * up[i];
                st_bf16x4(act + (size_t)row * ldc + u.pn * 128 + wc * 32 + n * 16 + fq * 4, o); } }
    }
};
struct EpiStore {
    bf16* o; int ldc;
    DEVI void operator()(const f32x4 (&acc)[2][2][4][2], const Unit& u, int wr, int wc, int fr, int fq) const {
        EPI_LOOP_ROWS { const int row = EPI_ROW;
#pragma unroll
            for (int bj = 0; bj < 2; ++bj)
#pragma unroll
                for (int n = 0; n < 2; ++n) st_bf16x4(o + (size_t)row * ldc + EPI_COL(bj, n), acc[ai][bj][m][n]); }
    }
};

struct CvtSrc { const float* src; int ld; int ncols; bool perm; const float* ks; float sc; };
DEVI void cvt_tile(const CvtSrc t, bf16* dst, int Kd, int nd0, int kd0, LAS float* scr, int lane) {
    const int n = lane & 31;
    if (t.src) {
        const int nc = (n < t.ncols) ? n : t.ncols - 1; const float msk = (n < t.ncols) ? t.sc : 0.f;
        const float* sp0 = t.src + (size_t)(lane >> 5) * t.ld + nc;
        float v[32];
#pragma unroll
        for (int i = 0; i < 32; ++i) v[i] = sp0[(size_t)(2 * i) * t.ld];
        if (t.ks) {
#pragma unroll
            for (int i = 0; i < 32; ++i) v[i] *= t.ks[2 * i + (lane >> 5)];
        }
#pragma unroll
        for (int i = 0; i < 32; ++i) scr[(2 * i + (lane >> 5)) * 33 + n] = v[i] * msk;
    } else {
#pragma unroll 8
        for (int i = 0; i < 32; ++i) scr[(2 * i + (lane >> 5)) * 33 + n] = 0.f;
    }
    asm volatile("s_waitcnt lgkmcnt(0)" ::: "memory");
    const int c = lane & 7;
#pragma unroll
    for (int j = 0; j < 4; ++j) { const int nn = (lane >> 3) + 8 * j; const LAS float* sp = scr + (8 * c) * 33 + (t.perm ? rope_src(nn) : nn);
        u32x4 o; o.x = pk2(sp[0 * 33], sp[1 * 33]); o.y = pk2(sp[2 * 33], sp[3 * 33]); o.z = pk2(sp[4 * 33], sp[5 * 33]); o.w = pk2(sp[6 * 33], sp[7 * 33]);
        *(u32x4*)(dst + (size_t)(nd0 + nn) * Kd + kd0 + 8 * c) = o; }
    asm volatile("s_waitcnt lgkmcnt(0)" ::: "memory");
}
template <class F>
DEVI void cvt_job(bf16* dst, int Nd, int Kd, F f, LAS float* scr, int gw, int ngw, int lane) {
    const int ntn = Nd >> 5, ntk = Kd >> 6;
    for (int it = gw; it < ntn * ntk; it += ngw) { const int nt = it % ntn, kt = it / ntn; cvt_tile(f(nt, kt), dst, Kd, nt * 32, kt * 64, scr, lane); }
}
DEVI void ph_pro(const P& p, unsigned char* lds) {
    const int tid = otid(), wid = tid >> 6, lane = tid & 63;
    __syncthreads();
    float* modv = (float*)(p.ws + WS_MODV);
    float* red = (float*)lds;
    for (int item = blockIdx.x; item < 192; item += gridDim.x) {
        const int l = item / 96, n = (item % 96) * 64 + lane;
        const float* W = IN(4) + (size_t)l * 1024 * 6144;
        float a0 = 0.f, a1 = 0.f, a2 = 0.f;
        for (int k = wid * 128; k < wid * 128 + 128; ++k) {
            const float w = W[(size_t)k * 6144 + n];
            a0 += siluf(IN(1)[k]) * w; a1 += siluf(IN(1)[1024 + k]) * w; a2 += siluf(IN(3)[k]) * w;
        }
        red[(wid * 3 + 0) * 64 + lane] = a0; red[(wid * 3 + 1) * 64 + lane] = a1; red[(wid * 3 + 2) * 64 + lane] = a2;
        __syncthreads();
        if (tid < 192) { const int r = tid >> 6, ln = tid & 63; float s = 0.f;
            for (int w = 0; w < 8; ++w) s += red[(w * 3 + r) * 64 + ln];
            const int nn = (item % 96) * 64 + ln; modv[(l * 3 + r) * 6144 + nn] = s + IN(5)[l * 6144 + nn]; }
        __syncthreads();
    }
    if (blockIdx.x == gridDim.x - 1) {
        float* rope = (float*)(p.ws + WS_ROPE);
        for (int idx = tid; idx < 1536; idx += NTHREADS) {
            const int i = idx & 7, pos = (idx < 1024) ? (idx >> 3) : ((idx - 1024) >> 3);
            const float invf = (i == 0) ? 1.f : (i == 1) ? 0.31622776601683794f : (i == 2) ? 0.1f : (i == 3) ? 0.03162277660168379f : (i == 4) ? 0.01f : (i == 5) ? 0.003162277660168379f : (i == 6) ? 0.001f : 0.00031622776601683794f;
            const float ang = (float)pos * invf;
            double rev = (double)ang * 0.15915494309189535; rev -= __builtin_rint(rev);
            const float fr = (float)rev;
            rope[idx * 2] = __builtin_amdgcn_cosf(fr); rope[idx * 2 + 1] = __builtin_amdgcn_sinf(fr);
        }
    }
    __syncthreads();
    LAS float* scr = (LAS float*)(LAS unsigned char*)lds + wid * (64 * 33);
    const int gw = blockIdx.x * NWAVES + wid, ngw = gridDim.x * NWAVES;
    for (int l = 0; l < 2; ++l) {
        { const float* W = IN(8) + (size_t)l * 1024 * INW;
          cvt_job((bf16*)(p.ws + WS_WIN) + (size_t)l * INWP * 1024, INWP, 1024, [=](int nt, int kt) -> CvtSrc {
              const int n0 = nt * 32; if (n0 >= INW) return CvtSrc{nullptr, 0, 0, false, nullptr, 1.f};
              return CvtSrc{W + (size_t)(kt * 64) * INW + n0, INW, (INW - n0 < 32) ? INW - n0 : 32, n0 == C_KPE, nullptr, 1.f}; }, scr, gw, ngw, lane); }
        { const float* Wq = IN(11) + (size_t)l * 256 * 384; const float* qn = IN(10) + l * 256; const float* Wk = IN(13) + (size_t)l * 128 * 256; const float* Wv = IN(14) + (size_t)l * 128 * 256; const float* kn = IN(12) + l * 128;
          const float QS = 0.10206207261596577f * 1.4426950408889634f;
          cvt_job((bf16*)(p.ws + WS_WQKV) + (size_t)l * 1024 * 384, 1024, 384, [=](int nt, int kt) -> CvtSrc {
              const int n0 = nt * 32, k0 = kt * 64;
              if (n0 < 384) { if (k0 >= 256) return CvtSrc{nullptr, 0, 0, false, nullptr, 1.f}; return CvtSrc{Wq + (size_t)k0 * 384 + n0, 384, 32, (n0 % 96) == 64, qn + k0, QS}; }
              if (n0 < 512 || k0 < 256) return CvtSrc{nullptr, 0, 0, false, nullptr, 1.f};
              if (n0 < 768) return CvtSrc{Wk + (size_t)(k0 - 256) * 256 + (n0 - 512), 256, 32, false, kn + k0 - 256, 1.f};
              return CvtSrc{Wv + (size_t)(k0 - 256) * 256 + (n0 - 768), 256, 32, false, kn + k0 - 256, 1.f}; }, scr, gw, ngw, lane); }
        { const float* W = IN(9) + (size_t)l * 1024 * 1024;
          cvt_job((bf16*)(p.ws + WS_WOUT) + (size_t)l * 1024 * 1024, 1024, 1024, [=](int nt, int kt) -> CvtSrc { return CvtSrc{W + (size_t)(kt * 64) * 1024 + nt * 32, 1024, 32, false, nullptr, 1.f}; }, scr, gw, ngw, lane); }
    }
    { const float* Wg = IN(22); const float* Wu = IN(23);
      cvt_job((bf16*)(p.ws + WS_WGU), 2 * DFF, 1024, [=](int nt, int kt) -> CvtSrc { const int n0 = nt * 32, t = n0 >> 8, r = n0 & 255;
          return CvtSrc{(r < 128 ? Wg + t * 128 + r : Wu + t * 128 + r - 128) + (size_t)(kt * 64) * DFF, DFF, 32, false, nullptr, 1.f}; }, scr, gw, ngw, lane); }
    { const float* W = IN(24);
      cvt_job((bf16*)(p.ws + WS_WD), 1024, DFF, [=](int nt, int kt) -> CvtSrc { return CvtSrc{W + (size_t)(kt * 64) * 1024 + nt * 32, 1024, 32, false, nullptr, 1.f}; }, scr, gw, ngw, lane); }
}
DEVI void ph_moew(const P& p, unsigned char* lds) {
    const int tid = otid(), wid = tid >> 6, lane = tid & 63;
    LAS float* scr = (LAS float*)(LAS unsigned char*)lds + wid * (64 * 33);
    const int gw = blockIdx.x * NWAVES + wid, ngw = gridDim.x * NWAVES;
    for (int e = 0; e < NEXP; ++e) {
        { const float* Wg = IN(26) + (size_t)e * 1024 * DFE; const float* Wu = IN(27) + (size_t)e * 1024 * DFE;
          cvt_job((bf16*)(p.ws + WS_WGUE) + (size_t)e * 2 * DFE * 1024, 2 * DFE, 1024, [=](int nt, int kt) -> CvtSrc { const int n0 = nt * 32, t = n0 >> 8, r = n0 & 255;
              return CvtSrc{(r < 128 ? Wg + t * 128 + r : Wu + t * 128 + r - 128) + (size_t)(kt * 64) * DFE, DFE, 32, false, nullptr, 1.f}; }, scr, gw, ngw, lane); }
        { const float* W = IN(28) + (size_t)e * DFE * 1024;
          cvt_job((bf16*)(p.ws + WS_WDE) + (size_t)e * 1024 * DFE, 1024, DFE, [=](int nt, int kt) -> CvtSrc { return CvtSrc{W + (size_t)(kt * 64) * 1024 + nt * 32, 1024, 32, false, nullptr, 1.f}; }, scr, gw, ngw, lane); }
    }
}

template <bool route>
DEVI void ph_norm(const P& p, int l, int which, int nrows, unsigned char* lds, int npart, int pgidx) {
    const int tid = otid(), wid = tid >> 6, lane = tid & 63;
    const bool first = (l == 0 && which == 0);
    const float* src_lat = first ? IN(0) : p.out; const float* src_ctx = (l == 0) ? IN(2) : (const float*)(p.ws + WS_XC);
    const float* w = IN(6 + which) + l * 1024; const float* modv = (const float*)(p.ws + WS_MODV) + (size_t)l * 3 * 6144;
    bf16* H = (bf16*)(p.ws + WS_HM);
    int* rt_e = (int*)(p.ws + WS_RT); float* rt_g = (float*)(p.ws + WS_RT + 128 * 1024);
    float* rl = (float*)lds;
    if (route) { __syncthreads(); const float* router = IN(25);
#pragma unroll
        for (int i = 0; i < 4; ++i) *(f32x4*)(rl + (tid + NTHREADS * i) * 4) = *(const f32x4*)(router + (tid + NTHREADS * i) * 4);
        __syncthreads(); }
    const int nw = gridDim.x * NWAVES, rpw = (NLAT + nw - 1) / nw, gw = blockIdx.x * NWAVES + wid;
    f32x4 vn[4], gsc[4], shv[4]; int rc = -1;
    for (int pass = 0; pass < (nrows > NLAT ? 2 : 1); ++pass) {
    const int row0 = pass == 0 ? gw * rpw : NLAT + gw, row1 = pass == 0 ? ((row0 + rpw < NLAT) ? row0 + rpw : NLAT) : nrows, rstep = pass == 0 ? 1 : nw;
    if (row0 < row1) { const float* x = (row0 < NLAT) ? src_lat + (size_t)row0 * D : src_ctx + (size_t)(row0 - NLAT) * D;
#pragma unroll
        for (int j = 0; j < 4; ++j) vn[j] = *(const f32x4*)(x + (j * 64 + lane) * 4); }
    for (int row = row0; row < row1; row += rstep) {
        const bool lat = row < NLAT; const int r = lat ? (row >> 13) : 2;
        if (r != rc) { rc = r; const float* sh = modv + r * 6144 + (which * 3 + 0) * 1024; const float* sc = modv + r * 6144 + (which * 3 + 1) * 1024;
#pragma unroll
            for (int j = 0; j < 4; ++j) { const int c0 = (j * 64 + lane) * 4; const f32x4 wv = *(const f32x4*)(w + c0), cv = *(const f32x4*)(sc + c0); shv[j] = *(const f32x4*)(sh + c0); gsc[j] = wv * (cv + 1.f); } }
        f32x4 v[4]; float ss = 0.f;
#pragma unroll
        for (int j = 0; j < 4; ++j) v[j] = vn[j];
        if (!lat && npart > 0) { const float* part = (const float*)(p.ws + WS_XBC) + (size_t)(row - NLAT) * D; const float* gp = modv + 2 * 6144 + pgidx * 1024; float* xc = (float*)(p.ws + WS_XC) + (size_t)(row - NLAT) * D;
#pragma unroll
            for (int j = 0; j < 4; ++j) { const int c0 = (j * 64 + lane) * 4; f32x4 acc = {0.f, 0.f, 0.f, 0.f};
#pragma unroll 2
                for (int k = 0; k < npart; ++k) acc += *(const f32x4*)(part + (size_t)k * NCTX * D + c0);
                v[j] += *(const f32x4*)(gp + c0) * acc; *(f32x4*)(xc + c0) = v[j]; } }
#pragma unroll
        for (int j = 0; j < 4; ++j) ss += v[j][0] * v[j][0] + v[j][1] * v[j][1] + v[j][2] * v[j][2] + v[j][3] * v[j][3];
        if (row + rstep < row1) { const int nrow = row + rstep; const float* x = (nrow < NLAT) ? src_lat + (size_t)nrow * D : src_ctx + (size_t)(nrow - NLAT) * D;
#pragma unroll
            for (int j = 0; j < 4; ++j) vn[j] = *(const f32x4*)(x + (j * 64 + lane) * 4); }
        ss = wave_sum(ss); const float rstd = 1.0f / sqrtf(ss * (1.f / D) + EPS);
        float lg[8];
#pragma unroll
        for (int e = 0; e < 8; ++e) lg[e] = 0.f;
#pragma unroll
        for (int j = 0; j < 4; ++j) { const int c0 = (j * 64 + lane) * 4; v[j] = v[j] * rstd * gsc[j] + shv[j]; st_bf16x4(H + (size_t)row * D + c0, v[j]); }
        if (route) {
#pragma unroll
            for (int j = 0; j < 4; ++j) { const int c0 = (j * 64 + lane) * 4;
#pragma unroll
                for (int i = 0; i < 4; ++i) { const f32x4 r0 = *(const f32x4*)(rl + (c0 + i) * 8), r1 = *(const f32x4*)(rl + (c0 + i) * 8 + 4); const float hh = v[j][i];
                    lg[0] += hh * r0[0]; lg[1] += hh * r0[1]; lg[2] += hh * r0[2]; lg[3] += hh * r0[3]; lg[4] += hh * r1[0]; lg[5] += hh * r1[1]; lg[6] += hh * r1[2]; lg[7] += hh * r1[3]; }
                asm volatile("" ::: "memory"); } }
        if (route) {
#pragma unroll
            for (int e = 0; e < 8; ++e) lg[e] = wave_sum(lg[e]);
            int i1 = 0; float v1 = lg[0];
#pragma unroll
            for (int e = 1; e < 8; ++e) if (lg[e] > v1) { v1 = lg[e]; i1 = e; }
            int i2 = -1; float v2 = -3.0e38f;
#pragma unroll
            for (int e = 0; e < 8; ++e) if (e != i1 && lg[e] > v2) { v2 = lg[e]; i2 = e; }
            const float e2 = __expf(v2 - v1), g1 = 1.f / (1.f + e2), g2 = e2 / (1.f + e2);
            if (lane == 0) { rt_e[row * 2] = i1; rt_e[row * 2 + 1] = i2; rt_g[row * 2] = g1; rt_g[row * 2 + 1] = g2; }
        }
    }
    }
}

typedef short v4i16_t __attribute__((ext_vector_type(4)));
DEVI v4i16_t lds_tr(const unsigned char* p) { return __builtin_amdgcn_ds_read_tr16_b64_v4i16((LAS v4i16_t*)(LAS unsigned char*)p); }
constexpr int A3_KLD = 208, A3_VLD = 192, A3_VOFF = 64 * A3_KLD, A3_BUF = A3_VOFF + 64 * A3_VLD;
template <int VAR>
DEVI void attn_unit(const P& p, int uidx, unsigned char* lds, bf16* outp) {
    const int tid = otid(), wid = __builtin_amdgcn_readfirstlane(tid >> 6), lane = tid & 63, r32 = lane & 31, hi = lane >> 5;
    const bf16* Q = (const bf16*)(p.ws + WS_Q); const bf16* K = (const bf16*)(p.ws + WS_K); const bf16* V = (const bf16*)(p.ws + WS_V); bf16* MIX = outp;
    int b, h, qrow0, NT;
    if (uidx < 256) { b = uidx >> 7; h = (uidx >> 5) & 3; qrow0 = b * SEQ + (uidx & 31) * 256; NT = 4 + SEQ / 64; }
    else { const int j = uidx - 256; b = j >> 2; h = j & 3; qrow0 = NLAT + b * CL; NT = 4; }
    const int qrow = qrow0 + wid * 32 + r32;
    bf16x8 qf[6];
#pragma unroll
    for (int s = 0; s < 6; ++s) qf[s] = *(const bf16x8*)(Q + (size_t)qrow * 384 + h * 96 + s * 16 + hi * 8);
    const int kk0 = tid / 12, kq0 = tid % 12, kk1 = (512 + tid) / 12, kq1 = (512 + tid) % 12, vk = tid >> 3, vq = tid & 7;
    const bf16* Kh = K + h * 96; const bf16* Vh = V + h * 64 + vq * 8;
    const int ctx0 = NLAT + b * CL, lat0 = b * SEQ;
    u32x4 krA0, krA1 = {0u, 0u, 0u, 0u}, vrA;
#define AT_LOAD(t, kr0, kr1, vr) do { const int kr_ = ((t) < 4) ? ctx0 + (t) * 64 : lat0 + ((t) - 4) * 64; \
        kr0 = *(const u32x4*)(Kh + (size_t)(kr_ + kk0) * 384 + kq0 * 8); if (tid < 256) kr1 = *(const u32x4*)(Kh + (size_t)(kr_ + kk1) * 384 + kq1 * 8); \
        vr = *(const u32x4*)(Vh + (size_t)(kr_ + vk) * 256); } while (0)
#define AT_STORE(bufp, kr0, kr1, vr) do { unsigned char* b_ = (bufp); *(u32x4*)(b_ + kk0 * A3_KLD + kq0 * 16) = kr0; if (tid < 256) *(u32x4*)(b_ + kk1 * A3_KLD + kq1 * 16) = kr1; \
        *(u32x4*)(b_ + A3_VOFF + vk * A3_VLD + vq * 16) = vr; } while (0)
    const int troff = (4 * hi + ((lane & 15) >> 2)) * A3_VLD + (16 * ((lane >> 4) & 1) + 4 * (lane & 3)) * 2;
    const int koff = r32 * A3_KLD + hi * 16;
    f32x16 o0, o1, negm;
#pragma unroll
    for (int r = 0; r < 16; ++r) { o0[r] = 0.f; o1[r] = 0.f; negm[r] = 0.f; }
    float mhat = 0.f, lsum = 0.f;
    __syncthreads();
    AT_LOAD(0, krA0, krA1, vrA); AT_STORE(lds, krA0, krA1, vrA); AT_LOAD(1, krA0, krA1, vrA); AT_STORE(lds + A3_BUF, krA0, krA1, vrA);
    __syncthreads();
#define SBAR() __builtin_amdgcn_sched_barrier(0)
#define KRD(bufp, half, s) (*(const bf16x8*)((bufp) + koff + (half) * 32 * A3_KLD + (s) * 32))
#define MF(a, b, c) __builtin_amdgcn_mfma_f32_32x32x16_bf16(a, b, c, 0, 0, 0)
#define MFQ(a, b, c) ((VAR == 3) ? (c) : MF(a, b, c))
#define MFP(a, b, c) ((VAR == 2) ? (c) : MF(a, b, c))
#define EX4(S, r0) do { if (VAR == 1) { S[r0] *= 0.001f; S[r0 + 1] *= 0.001f; S[r0 + 2] *= 0.001f; S[r0 + 3] *= 0.001f; break; } S[r0] = __builtin_amdgcn_exp2f(S[r0]); S[r0 + 1] = __builtin_amdgcn_exp2f(S[r0 + 1]); S[r0 + 2] = __builtin_amdgcn_exp2f(S[r0 + 2]); S[r0 + 3] = __builtin_amdgcn_exp2f(S[r0 + 3]); lsum += (S[r0] + S[r0 + 1]) + (S[r0 + 2] + S[r0 + 3]); } while (0)
#define PK8(S, r0) __builtin_bit_cast(bf16x8, (u32x4){pk2(S[r0], S[r0 + 1]), pk2(S[r0 + 2], S[r0 + 3]), pk2(S[r0 + 4], S[r0 + 5]), pk2(S[r0 + 6], S[r0 + 7])})
#define VFR(vp) ({ const v4i16_t lo_ = lds_tr(vp), hi_ = lds_tr((vp) + 8 * A3_VLD); (bf16x8){lo_[0], lo_[1], lo_[2], lo_[3], hi_[0], hi_[1], hi_[2], hi_[3]}; })
#define MX3(a, b, c) __builtin_fmaxf(__builtin_fmaxf((a), (b)), (c))
#define AT_UPD(S0, S1, mx, FORCE) do { float mx_ = __builtin_fmaxf(mx, __shfl_xor(mx, 32)); \
        if ((FORCE) || __any(mx_ > 8.0f)) { const float dl_ = (FORCE) ? mx_ : __builtin_fmaxf(mx_, 0.f); mhat += dl_; \
            _Pragma("unroll") for (int r = 0; r < 16; ++r) { S0[r] -= dl_; S1[r] -= dl_; negm[r] = -mhat; } \
            if (!(FORCE)) { const float f_ = __builtin_amdgcn_exp2f(-dl_); _Pragma("unroll") for (int r = 0; r < 16; ++r) { o0[r] *= f_; o1[r] *= f_; } lsum *= f_; } } } while (0)
    f32x16 sa0, sa1, sb0, sb1;
    { const unsigned char* kb_ = lds;
#pragma unroll
      for (int s = 0; s < 6; ++s) { sa0 = MF(KRD(kb_, 0, s), qf[s], s == 0 ? negm : sa0); sa1 = MF(KRD(kb_, 1, s), qf[s], s == 0 ? negm : sa1); }
      float a_ = MX3(sa0[0], sa0[1], sa1[0]), b_ = MX3(sa0[2], sa0[3], sa1[1]); a_ = MX3(a_, sa1[2], sa1[3]);
#pragma unroll
      for (int r = 4; r < 16; r += 4) { a_ = MX3(a_, sa0[r], sa0[r + 1]); b_ = MX3(b_, sa0[r + 2], sa0[r + 3]); a_ = MX3(a_, sa1[r], sa1[r + 1]); b_ = MX3(b_, sa1[r + 2], sa1[r + 3]); }
      AT_UPD(sa0, sa1, __builtin_fmaxf(a_, b_), true); }
#define AT_STEP(C0, C1, N0, N1, t, bc_, HAS_NEXT) do { const int b1_ = ((bc_) == 2) ? 0 : (bc_) + 1, b2_ = (b1_ == 2) ? 0 : b1_ + 1; \
        const unsigned char* kb_ = lds + b1_ * A3_BUF; const unsigned char* vb_ = lds + (bc_) * A3_BUF + A3_VOFF + troff; \
        if (VAR != 4 && (t) + 2 < NT) AT_LOAD((t) + 2, krA0, krA1, vrA); \
        bf16x8 pw0_, pw1_, pw2_, pw3_; float ma_ = -3.0e38f, mb_ = -3.0e38f; \
        if (HAS_NEXT) { \
            bf16x8 k0_ = KRD(kb_, 0, 0), k1_ = KRD(kb_, 1, 0), k2_ = KRD(kb_, 0, 1), k3_ = KRD(kb_, 1, 1); SBAR(); \
            N0 = MFQ(k0_, qf[0], negm); EX4(C0, 0); k0_ = KRD(kb_, 0, 2); SBAR(); \
            N1 = MFQ(k1_, qf[0], negm); EX4(C0, 4); k1_ = KRD(kb_, 1, 2); SBAR(); \
            N0 = MFQ(k2_, qf[1], N0); EX4(C0, 8); k2_ = KRD(kb_, 0, 3); SBAR(); \
            N1 = MFQ(k3_, qf[1], N1); EX4(C0, 12); k3_ = KRD(kb_, 1, 3); SBAR(); \
            N0 = MFQ(k0_, qf[2], N0); EX4(C1, 0); k0_ = KRD(kb_, 0, 4); SBAR(); \
            N1 = MFQ(k1_, qf[2], N1); EX4(C1, 4); k1_ = KRD(kb_, 1, 4); SBAR(); \
            N0 = MFQ(k2_, qf[3], N0); EX4(C1, 8); k2_ = KRD(kb_, 0, 5); SBAR(); \
            N1 = MFQ(k3_, qf[3], N1); EX4(C1, 12); k3_ = KRD(kb_, 1, 5); SBAR(); \
            N0 = MFQ(k0_, qf[4], N0); pw0_ = PK8(C0, 0); SBAR(); \
            N1 = MFQ(k1_, qf[4], N1); pw1_ = PK8(C0, 8); SBAR(); \
            N0 = MFQ(k2_, qf[5], N0); pw2_ = PK8(C1, 0); SBAR(); \
            N1 = MFQ(k3_, qf[5], N1); pw3_ = PK8(C1, 8); SBAR(); \
        } else { EX4(C0, 0); EX4(C0, 4); EX4(C0, 8); EX4(C0, 12); EX4(C1, 0); EX4(C1, 4); EX4(C1, 8); EX4(C1, 12); pw0_ = PK8(C0, 0); pw1_ = PK8(C0, 8); pw2_ = PK8(C1, 0); pw3_ = PK8(C1, 8); SBAR(); } \
        { bf16x8 va_ = VFR(vb_), vb2_ = VFR(vb_ + 64); SBAR(); \
          bf16x8 vc_ = VFR(vb_ + 16 * A3_VLD), vd_ = VFR(vb_ + 16 * A3_VLD + 64); SBAR(); \
          o0 = MFP(va_, pw0_, o0); if (HAS_NEXT) { ma_ = MX3(N0[0], N0[1], N1[0]); mb_ = MX3(N0[2], N0[3], N1[1]); } SBAR(); \
          o1 = MFP(vb2_, pw0_, o1); if (HAS_NEXT) { ma_ = MX3(ma_, N1[2], N1[3]); mb_ = MX3(mb_, N0[4], N0[5]); } SBAR(); \
          va_ = VFR(vb_ + 32 * A3_VLD); vb2_ = VFR(vb_ + 32 * A3_VLD + 64); SBAR(); \
          o0 = MFP(vc_, pw1_, o0); if (HAS_NEXT) { ma_ = MX3(ma_, N0[6], N0[7]); mb_ = MX3(mb_, N1[4], N1[5]); } SBAR(); \
          o1 = MFP(vd_, pw1_, o1); if (HAS_NEXT) { ma_ = MX3(ma_, N1[6], N1[7]); mb_ = MX3(mb_, N0[8], N0[9]); } SBAR(); \
          vc_ = VFR(vb_ + 48 * A3_VLD); vd_ = VFR(vb_ + 48 * A3_VLD + 64); SBAR(); \
          o0 = MFP(va_, pw2_, o0); if (HAS_NEXT) { ma_ = MX3(ma_, N0[10], N0[11]); mb_ = MX3(mb_, N1[8], N1[9]); } SBAR(); \
          o1 = MFP(vb2_, pw2_, o1); if (HAS_NEXT) { ma_ = MX3(ma_, N1[10], N1[11]); mb_ = MX3(mb_, N0[12], N0[13]); } SBAR(); \
          if (HAS_NEXT) { ma_ = MX3(ma_, N0[14], N0[15]); mb_ = MX3(mb_, N1[12], N1[13]); } SBAR(); \
          o0 = MFP(vc_, pw3_, o0); if (HAS_NEXT) { ma_ = MX3(ma_, N1[14], N1[15]); } SBAR(); \
          o1 = MFP(vd_, pw3_, o1); SBAR(); } \
        if (HAS_NEXT) AT_UPD(N0, N1, __builtin_fmaxf(ma_, mb_), false); \
        if (VAR != 4 && (t) + 2 < NT) AT_STORE(lds + b2_ * A3_BUF, krA0, krA1, vrA); \
        if (VAR != 4) __syncthreads(); } while (0)
    int bc = 0, t = 0;
    for (; t + 2 < NT; t += 2) {
        AT_STEP(sa0, sa1, sb0, sb1, t, bc, true); bc = (bc == 2) ? 0 : bc + 1;
        AT_STEP(sb0, sb1, sa0, sa1, t + 1, bc, true); bc = (bc == 2) ? 0 : bc + 1;
    }
    AT_STEP(sa0, sa1, sb0, sb1, t, bc, true); bc = (bc == 2) ? 0 : bc + 1;
    AT_STEP(sb0, sb1, sa0, sa1, t + 1, bc, false);
#undef AT_LOAD
#undef AT_STORE
#undef SBAR
#undef KRD
#undef MF
#undef MFQ
#undef MFP
#undef EX4
#undef PK8
#undef VFR
#undef MX3
#undef AT_UPD
#undef AT_STEP
    lsum += __shfl_xor(lsum, 32);
    const float inv = 1.f / lsum;
    bf16* orow = MIX + (size_t)qrow * D + h * 64;
#pragma unroll
    for (int g = 0; g < 4; ++g) {
        st_bf16x4(orow + 8 * g + 4 * hi, (f32x4){o0[4 * g] * inv, o0[4 * g + 1] * inv, o0[4 * g + 2] * inv, o0[4 * g + 3] * inv});
        st_bf16x4(orow + 32 + 8 * g + 4 * hi, (f32x4){o1[4 * g] * inv, o1[4 * g + 1] * inv, o1[4 * g + 2] * inv, o1[4 * g + 3] * inv});
    }
}

constexpr int NCC = 66;
DEVI int chunk_row0(int b, int cc) { return cc < 2 ? NLAT + b * CL + cc * 128 : b * SEQ + (cc - 2) * 128; }
constexpr int SC_VEC = 0;
constexpr int SC_KT = 2048;
constexpr int SC_VF = SC_KT + 64 * 136 * 2;
constexpr int SC_VB = SC_VF + 64 * 136 * 2;
constexpr int SC_X = SC_VB + 64 * 136 * 2;
constexpr int SC_SSQ = SC_X + 2048;
constexpr int SC_END = SC_SSQ + 8192;
constexpr int TS = 136;

DEVI void scan_vectors(const P& p, int l, bool ret, int h, int row0, float* vec, int wid, int lane) {
    const float* dt = (const float*)(p.ws + WS_DT);
    if (ret) {
        if (wid == 0) { const float lf = IN(15)[l * 8 + h], lb = IN(15)[l * 8 + 4 + h];
            const float laf = -log1pf(__expf(-lf)), lab = -log1pf(__expf(-lb));
#pragma unroll
            for (int e = 0; e < 2; ++e) { const int j = lane * 2 + e; vec[j] = (float)(j + 1) * laf; vec[128 + j] = (float)(128 - j) * lab; vec[256 + j] = 1.f; vec[384 + j] = 1.f; } }
    } else if (wid < 2) {
        const int dir = wid; const size_t r = (size_t)(row0 + lane * 2);
        const float x0 = dt[r * 32 + 16 + dir * 8 + h], x1 = dt[(r + 1) * 32 + 16 + dir * 8 + h];
        vec[256 + dir * 128 + lane * 2] = dt[r * 32 + dir * 8 + h]; vec[256 + dir * 128 + lane * 2 + 1] = dt[(r + 1) * 32 + dir * 8 + h];
        float s = x0 + x1;
#pragma unroll
        for (int o = 1; o < 64; o <<= 1) { const float t = __shfl_up(s, o); if (lane >= o) s += t; }
        if (dir == 0) { vec[lane * 2] = s - x1; vec[lane * 2 + 1] = s; }
        else { const float tot = __shfl(s, 63); vec[128 + lane * 2] = tot - (s - x1) + x0; vec[128 + lane * 2 + 1] = tot - s + x1; }
    }
}
DEVI void scan_ptrs(const P& p, bool ret, int h, const bf16*& qb, const bf16*& kb, const bf16*& vb, int& ld) {
    if (ret) { const bf16* proj = (const bf16*)(p.ws + WS_PROJ); qb = proj + C_RQ + h * 64; kb = proj + C_RK + h * 64; vb = proj + C_RV + h * 64; ld = INWP; }
    else { const bf16* xbc = (const bf16*)(p.ws + WS_XBC); qb = xbc + 640 + (h >> 2) * 64; kb = xbc + 512 + (h >> 2) * 64; vb = xbc + h * 64; ld = 768; }
}
DEVI void c3_stage_rows(unsigned char* dst, int rs, const bf16* src, int ld, int tid) {
#pragma unroll
    for (int i = 0; i < 2; ++i) { const int piece = tid + NTHREADS * i, row = piece >> 3, part = piece & 7; *(u32x4*)(dst + row * rs + part * 16) = *(const u32x4*)(src + (size_t)row * ld + part * 8); }
}
struct ConvW { f32x4 w0[2], w1[2], w2[2], b[2]; };
DEVI ConvW conv_w(const float* cw, const float* cb, int c0) { ConvW w;
#pragma unroll
    for (int k = 0; k < 2; ++k) { w.w0[k] = *(const f32x4*)(cw + c0 + 4 * k); w.w1[k] = *(const f32x4*)(cw + 768 + c0 + 4 * k); w.w2[k] = *(const f32x4*)(cw + 1536 + c0 + 4 * k); w.b[k] = *(const f32x4*)(cb + c0 + 4 * k); }
    return w; }
DEVI void unpack8(const u32x4 v, f32x4 (&x)[2]) { x[0] = (f32x4){bf2f(v.x & 0xffff), bf2f(v.x >> 16), bf2f(v.y & 0xffff), bf2f(v.y >> 16)}; x[1] = (f32x4){bf2f(v.z & 0xffff), bf2f(v.z >> 16), bf2f(v.w & 0xffff), bf2f(v.w >> 16)}; }
DEVI void conv8(const bf16* proj, size_t row, bool has_prev, bool has_next, int c0, const ConvW& w, f32x4 (&y)[2]) {
    const bf16* pr = proj + row * INWP + C_XBC + c0; const u32x4 z = {0u, 0u, 0u, 0u};
    const u32x4 r0 = *(const u32x4*)pr, rm = has_prev ? *(const u32x4*)(pr - INWP) : z, rp = has_next ? *(const u32x4*)(pr + INWP) : z;
    f32x4 x0[2], xm[2], xp[2]; unpack8(r0, x0); unpack8(rm, xm); unpack8(rp, xp);
#pragma unroll
    for (int k = 0; k < 2; ++k) { y[k] = w.w0[k] * xm[k] + w.w1[k] * x0[k] + w.w2[k] * xp[k] + w.b[k];
#pragma unroll
        for (int i = 0; i < 4; ++i) y[k][i] = siluf(y[k][i]); }
}
DEVI u32x4 pack8(const f32x4 (&y)[2], float sc) { return (u32x4){pk2(y[0][0] * sc, y[0][1] * sc), pk2(y[0][2] * sc, y[0][3] * sc), pk2(y[1][0] * sc, y[1][1] * sc), pk2(y[1][2] * sc, y[1][3] * sc)}; }
constexpr int SA_RS = 192, SA_K = 2048, SA_VF = SA_K + 128 * SA_RS, SA_VB = SA_VF + 128 * SA_RS, SA_END = SA_VB + 128 * SA_RS;
DEVI void scanA_unit(const P& p, int l, int uidx, unsigned char* lds) {
    const int tid = otid(), wid = __builtin_amdgcn_readfirstlane(tid >> 6), lane = tid & 63, r32 = lane & 31, hi = lane >> 5;
    const int g4 = uidx % 3, bc = uidx / 3, b = bc / NCC, cc = bc % NCC, row0 = chunk_row0(b, cc);
    const bool ret = (g4 == 0);
    float* vec = (float*)(lds + SC_VEC);
    float* ST = (float*)(p.ws + WS_ST); float* CDp = (float*)(p.ws + WS_CD);
    const bf16* proj = (const bf16*)(p.ws + WS_PROJ); bf16* xbcw = (bf16*)(p.ws + WS_XBC); const float* cw = IN(16) + (size_t)l * 3 * 768; const float* cb = IN(17) + l * 768;
    const int troff = (4 * hi + ((lane & 15) >> 2)) * SA_RS + (16 * ((lane >> 4) & 1) + 4 * (lane & 3)) * 2;
    for (int hq = 0; hq < 4; ++hq) {
        const int h = ret ? hq : (g4 - 1) * 4 + hq, hh = ret ? hq : 4 + h; const size_t item = (size_t)(b * NCC + cc) * 12 + hh;
        const bf16 *qb, *kb, *vb; int ld; scan_ptrs(p, ret, h, qb, kb, vb, ld);
        __syncthreads();
        scan_vectors(p, l, ret, h, row0, vec, wid, lane);
        __syncthreads();
        if (ret) {
            c3_stage_rows(lds + SA_K, SA_RS, kb + (size_t)row0 * ld, ld, tid);
#pragma unroll
            for (int i = 0; i < 2; ++i) { const int piece = tid + NTHREADS * i, j = piece >> 3, part = piece & 7; const u32x4 v = *(const u32x4*)(vb + (size_t)(row0 + j) * ld + part * 8);
                const float sf = __expf(vec[127] - vec[j]) * vec[256 + j], sb = __expf(vec[128] - vec[128 + j]) * vec[384 + j];
                f32x4 x[2]; unpack8(v, x);
                *(u32x4*)(lds + SA_VF + j * SA_RS + part * 16) = pack8(x, sf); *(u32x4*)(lds + SA_VB + j * SA_RS + part * 16) = pack8(x, sb); }
        } else {
            const int g = g4 - 1, part = tid & 7; const int pos0 = (cc < 2) ? cc * 128 : (cc - 2) * 128, Ls = (cc < 2) ? CL : SEQ;
            if (hq == 0) {
#pragma unroll 1
                for (int which = 0; which < 2; ++which) { const int c0 = (which == 0 ? 512 : 640) + g * 64 + part * 8; const ConvW w = conv_w(cw, cb, c0);
#pragma unroll
                    for (int i = 0; i < 2; ++i) { const int j = (tid + NTHREADS * i) >> 3; f32x4 y[2]; conv8(proj, (size_t)(row0 + j), pos0 + j > 0, pos0 + j < Ls - 1, c0, w, y);
                        const u32x4 o = pack8(y, 1.f); *(u32x4*)(xbcw + (size_t)(row0 + j) * 768 + c0) = o; if (which == 0) *(u32x4*)(lds + SA_K + j * SA_RS + part * 16) = o; } } }
            { const int c0 = h * 64 + part * 8; const ConvW w = conv_w(cw, cb, c0);
#pragma unroll
              for (int i = 0; i < 2; ++i) { const int j = (tid + NTHREADS * i) >> 3; f32x4 y[2]; conv8(proj, (size_t)(row0 + j), pos0 + j > 0, pos0 + j < Ls - 1, c0, w, y);
                  const float sf = __expf(vec[127] - vec[j]) * vec[256 + j], sb = __expf(vec[128] - vec[128 + j]) * vec[384 + j];
                  *(u32x4*)(xbcw + (size_t)(row0 + j) * 768 + c0) = pack8(y, 1.f);
                  *(u32x4*)(lds + SA_VF + j * SA_RS + part * 16) = pack8(y, sf); *(u32x4*)(lds + SA_VB + j * SA_RS + part * 16) = pack8(y, sb); } }
        }
        if (tid == 0) { CDp[item * 2] = __expf(vec[127]); CDp[item * 2 + 1] = __expf(vec[128]); }
        if (tid < 128) { float* vg = (float*)(p.ws + WS_VEC) + item * 512; vg[tid] = vec[tid]; vg[128 + tid] = vec[128 + tid]; vg[256 + tid] = vec[tid] - __logf(vec[256 + tid]); vg[384 + tid] = vec[128 + tid] - __logf(vec[384 + tid]); }
        __syncthreads();
        const int dir = wid >> 2, nt = (wid >> 1) & 1, pt = wid & 1;
        const unsigned char* ka = lds + SA_K + nt * 64 + troff; const unsigned char* va = lds + (dir ? SA_VB : SA_VF) + pt * 64 + troff;
        f32x16 acc;
#pragma unroll
        for (int r = 0; r < 16; ++r) acc[r] = 0.f;
#pragma unroll
        for (int s = 0; s < 8; ++s) { const v4i16_t al = lds_tr(ka + (16 * s) * SA_RS), ah = lds_tr(ka + (16 * s + 8) * SA_RS), bl = lds_tr(va + (16 * s) * SA_RS), bh = lds_tr(va + (16 * s + 8) * SA_RS);
            const bf16x8 af = {al[0], al[1], al[2], al[3], ah[0], ah[1], ah[2], ah[3]}, bf = {bl[0], bl[1], bl[2], bl[3], bh[0], bh[1], bh[2], bh[3]};
            acc = __builtin_amdgcn_mfma_f32_32x32x16_bf16(af, bf, acc, 0, 0, 0); }
        float* o = ST + (item * 2 + dir) * 4096 + (size_t)(pt * 32 + r32) * 64 + nt * 32 + 4 * hi;
#pragma unroll
        for (int g = 0; g < 4; ++g) *(f32x4*)(o + 8 * g) = (f32x4){acc[4 * g], acc[4 * g + 1], acc[4 * g + 2], acc[4 * g + 3]};
    }
    __syncthreads();
}
DEVI void scanB_slab(const P& p, int slab, int nthr, int epb) {
    const int tid = otid(); if (tid >= nthr) return;
    const int f = slab * epb + tid * 2; const int bhd = f >> 12, e = f & 4095, dir = bhd & 1, bh = bhd >> 1, b = bh / 12, hh = bh % 12;
    const float* ST = (const float*)(p.ws + WS_ST); const float* CDp = (const float*)(p.ws + WS_CD); bf16* HT = (bf16*)(p.ws + WS_HT);
    f32x2 H = {0.f, 0.f};
    for (int base = 0; base < NCC; base += 6) {
        f32x2 s[6]; float d[6]; size_t off[6];
#pragma unroll
        for (int i = 0; i < 6; ++i) { const int step = base + i; const int cc = dir == 0 ? step : (step < 2 ? 1 - step : 67 - step);
            const size_t item = (size_t)(b * NCC + cc) * 12 + hh; off[i] = (item * 2 + dir) * 4096 + e; s[i] = *(const f32x2*)(ST + off[i]); d[i] = CDp[item * 2 + dir]; }
#pragma unroll
        for (int i = 0; i < 6; ++i) { *(unsigned*)(HT + off[i]) = pk2(H[0], H[1]); H = H * d[i] + s[i]; }
    }
}
constexpr int C3_RSV = 192, C3_RSK = 144;
constexpr int C3_V = 0, C3_K = 2 * 128 * C3_RSV, C3_H = C3_K + 2 * 128 * C3_RSK, C3_VEC = C3_H + 2 * 128 * C3_RSK, C3_X = C3_VEC + 2 * 2048, C3_END = C3_X + 1024;
template <bool RET>
DEVI void scanC_unit(const P& p, int l, int bc, unsigned char* lds, int tid, int wid, int lane) {
    const int r32 = lane & 31, hi = lane >> 5;
    const int it_ = wid & 3, hsub = wid >> 2, b = bc / NCC, cc = bc % NCC, row0 = chunk_row0(b, cc);
    const bf16* HT = (const bf16*)(p.ws + WS_HT); const bf16* proj = (const bf16*)(p.ws + WS_PROJ); const bf16* xbc = (const bf16*)(p.ws + WS_XBC); bf16* MIX = (bf16*)(p.ws + WS_HM); const float* VECG = (const float*)(p.ws + WS_VEC);
    const int i = it_ * 32 + r32; const size_t rowi = (size_t)(row0 + i);
    constexpr int ld = RET ? INWP : 768;
    const unsigned char* Vl = lds + C3_V + hsub * 128 * C3_RSV; const unsigned char* Kl = lds + C3_K + hsub * 128 * C3_RSK; const unsigned char* Hl = lds + C3_H + hsub * 128 * C3_RSK; const float* vec = (const float*)(lds + C3_VEC + hsub * 2048);
    const int trq = (lane & 15) >> 2, trp = lane & 3, trg = (lane >> 4) & 1;
    const int troff = (4 * hi + trq) * C3_RSV + (16 * trg + 4 * trp) * 2;
    float ssq = 0.f;
#pragma unroll 1
    for (int step = 0; step < (RET ? 2 : 4); ++step) {
        __syncthreads();
#pragma unroll
        for (int hs = 0; hs < 2; ++hs) { const int h = RET ? hs * 2 + step : hs * 4 + step, hh = RET ? h : 4 + h; const size_t item = (size_t)(b * NCC + cc) * 12 + hh;
            const bf16* vb = RET ? proj + C_RV + h * 64 : xbc + h * 64; const bf16* kb = RET ? proj + C_RK + h * 64 : xbc + 512 + hs * 64;
            c3_stage_rows(lds + C3_V + hs * 128 * C3_RSV, C3_RSV, vb + (size_t)row0 * ld, ld, tid);
            if (RET || step == 0) c3_stage_rows(lds + C3_K + hs * 128 * C3_RSK, C3_RSK, kb + (size_t)row0 * ld, ld, tid);
            c3_stage_rows(lds + C3_H + hs * 128 * C3_RSK, C3_RSK, HT + item * 2 * 4096, 64, tid);
            if ((tid >> 7) == hs) *(u32x4*)(lds + C3_VEC + hs * 2048 + (tid & 127) * 16) = *(const u32x4*)(VECG + item * 512 + (tid & 127) * 4); }
        __syncthreads();
        const int h = RET ? hsub * 2 + step : hsub * 4 + step;
        const bf16* qb = RET ? proj + C_RQ + h * 64 : xbc + 640 + hsub * 64;
        bf16x8 qf[4];
#pragma unroll
        for (int s = 0; s < 4; ++s) qf[s] = *(const bf16x8*)(qb + rowi * ld + s * 16 + hi * 8);
        const float Afi = vec[i], Bbi = vec[128 + i];
        f32x16 y0, y1;
#pragma unroll
        for (int r = 0; r < 16; ++r) { y0[r] = 0.f; y1[r] = 0.f; }
#pragma unroll 2
        for (int jt = 0; jt < 4; ++jt) {
            f32x16 st;
#pragma unroll
            for (int r = 0; r < 16; ++r) st[r] = 0.f;
#pragma unroll
            for (int s = 0; s < 4; ++s) { const bf16x8 kf = *(const bf16x8*)(Kl + (jt * 32 + r32) * C3_RSK + (s * 16 + hi * 8) * 2); st = __builtin_amdgcn_mfma_f32_32x32x16_bf16(kf, qf[s], st, 0, 0, 0); }
#pragma unroll
            for (int g = 0; g < 4; ++g) { const int j0 = jt * 32 + 8 * g + 4 * hi;
                const f32x4 afp = *(const f32x4*)(vec + 256 + j0), bbp = *(const f32x4*)(vec + 384 + j0);
#pragma unroll
                for (int e = 0; e < 4; ++e) { const int j = j0 + e; float f;
                    if (jt < it_) f = __expf(Afi - afp[e]);
                    else if (jt > it_) f = __expf(Bbi - bbp[e]);
                    else { const float ff = (j <= i) ? __expf(Afi - afp[e]) : 0.f; const bool bm = RET ? (j > i) : (j >= i); const float fb = bm ? __expf(Bbi - bbp[e]) : 0.f; f = ff + fb; }
                    st[4 * g + e] *= f; } }
#pragma unroll
            for (int s2 = 0; s2 < 2; ++s2) {
                u32x4 pw; pw.x = pk2(st[8 * s2 + 0], st[8 * s2 + 1]); pw.y = pk2(st[8 * s2 + 2], st[8 * s2 + 3]); pw.z = pk2(st[8 * s2 + 4], st[8 * s2 + 5]); pw.w = pk2(st[8 * s2 + 6], st[8 * s2 + 7]);
                const bf16x8 pb = __builtin_bit_cast(bf16x8, pw);
#pragma unroll
                for (int pt = 0; pt < 2; ++pt) { const unsigned char* vp = Vl + (jt * 32 + 16 * s2) * C3_RSV + pt * 64 + troff;
                    const v4i16_t lo = lds_tr(vp), hi2 = lds_tr(vp + 8 * C3_RSV);
                    const bf16x8 va = {lo[0], lo[1], lo[2], lo[3], hi2[0], hi2[1], hi2[2], hi2[3]};
                    if (pt == 0) y0 = __builtin_amdgcn_mfma_f32_32x32x16_bf16(va, pb, y0, 0, 0, 0); else y1 = __builtin_amdgcn_mfma_f32_32x32x16_bf16(va, pb, y1, 0, 0, 0); }
            }
        }
        { const float ef = __expf(Afi), eb = __expf(Bbi);
#pragma unroll
          for (int pt = 0; pt < 2; ++pt) { f32x16 tf, tb;
#pragma unroll
              for (int r = 0; r < 16; ++r) { tf[r] = 0.f; tb[r] = 0.f; }
              const unsigned char* hf = Hl + (pt * 32 + r32) * C3_RSK + hi * 16;
#pragma unroll
              for (int s = 0; s < 4; ++s) { tf = __builtin_amdgcn_mfma_f32_32x32x16_bf16(*(const bf16x8*)(hf + s * 32), qf[s], tf, 0, 0, 0); tb = __builtin_amdgcn_mfma_f32_32x32x16_bf16(*(const bf16x8*)(hf + 64 * C3_RSK + s * 32), qf[s], tb, 0, 0, 0); }
#pragma unroll
              for (int r = 0; r < 16; ++r) { if (pt == 0) y0[r] += ef * tf[r] + eb * tb[r]; else y1[r] += ef * tf[r] + eb * tb[r]; } } }
        if (RET) {
            float s1 = 0.f, s2 = 0.f;
#pragma unroll
            for (int r = 0; r < 16; ++r) { y0[r] *= 0.125f; y1[r] *= 0.125f; s1 += y0[r] + y1[r]; s2 += y0[r] * y0[r] + y1[r] * y1[r]; }
            s1 += __shfl_xor(s1, 32); s2 += __shfl_xor(s2, 32);
            const float mu = s1 * (1.f / 64.f), var = fmaxf(s2 * (1.f / 64.f) - mu * mu, 0.f), rs = 1.0f / sqrtf(var + EPS);
#pragma unroll
            for (int pt = 0; pt < 2; ++pt)
#pragma unroll
                for (int g = 0; g < 4; ++g) { const int p0 = pt * 32 + 8 * g + 4 * hi; const u32x2 gg = *(const u32x2*)(proj + rowi * INWP + C_RG + h * 64 + p0);
                    const f32x4 gv = {bf2f(gg.x & 0xffff), bf2f(gg.x >> 16), bf2f(gg.y & 0xffff), bf2f(gg.y >> 16)}; f32x4 o;
#pragma unroll
                    for (int e = 0; e < 4; ++e) o[e] = ((pt ? y1[4 * g + e] : y0[4 * g + e]) - mu) * rs * siluf(gv[e]);
                    st_bf16x4(MIX + rowi * D + 256 + h * 64 + p0, o); }
        } else {
            const float dsk = IN(20)[l * 8 + h];
#pragma unroll
            for (int pt = 0; pt < 2; ++pt)
#pragma unroll
                for (int g = 0; g < 4; ++g) { const int p0 = pt * 32 + 8 * g + 4 * hi; const u32x2 xx = *(const u32x2*)(xbc + rowi * 768 + h * 64 + p0), zz = *(const u32x2*)(proj + rowi * INWP + C_Z + h * 64 + p0);
                    const f32x4 xv = {bf2f(xx.x & 0xffff), bf2f(xx.x >> 16), bf2f(xx.y & 0xffff), bf2f(xx.y >> 16)}, zv = {bf2f(zz.x & 0xffff), bf2f(zz.x >> 16), bf2f(zz.y & 0xffff), bf2f(zz.y >> 16)}; f32x4 o;
#pragma unroll
                    for (int e = 0; e < 4; ++e) { o[e] = ((pt ? y1[4 * g + e] : y0[4 * g + e]) + xv[e] * dsk) * siluf(zv[e]); ssq += o[e] * o[e]; }
                    st_bf16x4(MIX + rowi * D + 512 + h * 64 + p0, o); }
        }
    }
    if (!RET) {
        float* X = (float*)(lds + C3_X);
        ssq += __shfl_xor(ssq, 32);
        if (hi == 0) X[hsub * 128 + i] = ssq;
        asm volatile("s_waitcnt vmcnt(0)" ::: "memory");
        __syncthreads();
        const float tot = X[i] + X[128 + i];
        const float rstd = 1.0f / sqrtf(tot * (1.f / 512.f) + EPS); const float* nw = IN(21) + l * 512;
#pragma unroll 1
        for (int h = hsub * 4; h < hsub * 4 + 4; ++h)
#pragma unroll
            for (int pt = 0; pt < 2; ++pt)
#pragma unroll
                for (int g = 0; g < 4; ++g) { const int c0 = h * 64 + pt * 32 + 8 * g + 4 * hi; bf16* mp = MIX + rowi * D + 512 + c0; const u32x2 v = *(const u32x2*)mp; const f32x4 w = *(const f32x4*)(nw + c0);
                    st_bf16x4(mp, (f32x4){bf2f(v.x & 0xffff) * rstd * w[0], bf2f(v.x >> 16) * rstd * w[1], bf2f(v.y & 0xffff) * rstd * w[2], bf2f(v.y >> 16) * rstd * w[3]}); }
    }
    __syncthreads();
}
DEVI void ph_scanC(const P& p, int l, unsigned char* lds) {
    const int tid = otid(), wid = __builtin_amdgcn_readfirstlane(tid >> 6), lane = tid & 63;
    const int NU = 2 * NCC;
    if (gridDim.x == 256) {
        const int c = blockIdx.x;
        if (c < NU) scanC_unit<false>(p, l, c, lds, tid, wid, lane);
        else { const int r = c - NU; scanC_unit<true>(p, l, r, lds, tid, wid, lane); if (r + 124 < NU) scanC_unit<true>(p, l, r + 124, lds, tid, wid, lane); }
    } else {
        for (int u = blockIdx.x; u < 2 * NU; u += gridDim.x) { if (u < NU) scanC_unit<false>(p, l, u, lds, tid, wid, lane); else scanC_unit<true>(p, l, u - NU, lds, tid, wid, lane); }
    }
}
DEVI void ph_scanA(const P& p, int l, unsigned char* lds) { for (int u = blockIdx.x; u < 2 * NCC * 3; u += gridDim.x) scanA_unit(p, l, u, lds); }
DEVI void ph_mixer(const P& p, int l, unsigned char* lds) {
    for (int u = blockIdx.x; u < 256; u += gridDim.x) scanB_slab(p, u, 384, 768);
    for (int a = blockIdx.x; a < 256; a += gridDim.x) attn_unit<0>(p, (a & 7) * 32 + (a >> 3), lds, (bf16*)(p.ws + WS_HM));
#if ATTN_PROBE
    if (l == 0) { __syncthreads(); for (int a = blockIdx.x; a < 256; a += gridDim.x) attn_unit<ATTN_PROBE>(p, (a & 7) * 32 + (a >> 3), lds, (bf16*)p.out); }
#endif
    if (l == 0) for (int a = blockIdx.x; a < 8; a += gridDim.x) attn_unit<0>(p, 256 + a, lds, (bf16*)(p.ws + WS_HM));
}

DEVI void ph_sort(const P& p, unsigned char* lds) {
    const int tid = otid(), wid = tid >> 6, lane = tid & 63;
    const int* rt_e = (const int*)(p.ws + WS_RT); int* rt_pos = (int*)(p.ws + WS_RT + 256 * 1024); int* tab = (int*)(p.ws + WS_RT + 384 * 1024); int* rt_tok = (int*)(p.ws + WS_RT + 640 * 1024);
    int* sh = (int*)lds;
    const int G = gridDim.x, R = (NLAT + G - 1) / G;
    for (int blk = blockIdx.x; blk * R < NLAT; blk += G) {
        const int r0 = blk * R, r1 = (r0 + R < NLAT) ? r0 + R : NLAT;
        int ct[8], cb[8];
#pragma unroll
        for (int e = 0; e < 8; ++e) { ct[e] = 0; cb[e] = 0; }
        for (int i = tid; i < NLAT * 2; i += NTHREADS) { const int e = rt_e[i]; const bool bef = (i >> 1) < r0;
#pragma unroll
            for (int x = 0; x < 8; ++x) { const int hit = (e == x) ? 1 : 0; ct[x] += hit; cb[x] += bef ? hit : 0; } }
#pragma unroll
        for (int e = 0; e < 8; ++e) {
#pragma unroll
            for (int o = 1; o < 64; o <<= 1) { ct[e] += __shfl_xor(ct[e], o); cb[e] += __shfl_xor(cb[e], o); }
        }
        __syncthreads();
        if (lane == 0) {
#pragma unroll
            for (int e = 0; e < 8; ++e) { sh[wid * 8 + e] = ct[e]; sh[64 + wid * 8 + e] = cb[e]; } }
        __syncthreads();
        if (tid == 0) { int start = 0, nt = 0;
            for (int e = 0; e < 8; ++e) { int tot = 0, bef = 0; for (int w = 0; w < 8; ++w) { tot += sh[w * 8 + e]; bef += sh[64 + w * 8 + e]; }
                sh[128 + e] = start; sh[136 + e] = start + bef; sh[144 + e] = tot; const int ntile = (tot + 255) >> 8;
                if (blk == 0) { for (int t = 0; t < ntile; ++t) tab[1 + nt + t] = e; }
                nt += ntile; start += ntile * 256; }
            if (blk == 0) tab[0] = nt; }
        __syncthreads();
        { const int n_ent = (r1 - r0) * 2; const bool valid = tid < n_ent; const int e = valid ? rt_e[r0 * 2 + tid] : -1; int rank = 0;
#pragma unroll
          for (int x = 0; x < 8; ++x) { const unsigned long long m = __ballot(e == x); if (e == x) rank = __popcll(m & ((1ull << lane) - 1ull)); if (lane == 0) sh[160 + wid * 8 + x] = __popcll(m); }
          __syncthreads();
          if (valid) { int pos = sh[136 + e] + rank; for (int w = 0; w < wid; ++w) pos += sh[160 + w * 8 + e]; sh[256 + tid] = pos; rt_pos[r0 * 2 + tid] = pos; } }
        __syncthreads();
        { const int n_ent = (r1 - r0) * 2; if (tid < n_ent) rt_tok[sh[256 + tid]] = r0 + (tid >> 1); }
        if (blk == 0) { for (int e = 0; e < 8; ++e) { const int tot = sh[144 + e], beg = sh[128 + e] + tot, end = sh[128 + e] + ((tot + 255) & ~255); for (int i = beg + tid; i < end; i += NTHREADS) rt_tok[i] = 0; } }
        __syncthreads();
    }
}
DEVI void ph_final(const P& p) {
    const int tid = otid(), wid = tid >> 6, lane = tid & 63;
    const float* rt_g = (const float*)(p.ws + WS_RT + 128 * 1024); const int* rt_pos = (const int*)(p.ws + WS_RT + 256 * 1024);
    const bf16* YS = (const bf16*)(p.ws + WS_HS); const float* modv = (const float*)(p.ws + WS_MODV) + (size_t)1 * 3 * 6144; const float* fw = IN(29);
    const int nw = gridDim.x * NWAVES, rpw = (NLAT + nw - 1) / nw, gw = blockIdx.x * NWAVES + wid;
    const int row0 = gw * rpw, row1 = (row0 + rpw < NLAT) ? row0 + rpw : NLAT;
    f32x4 fwv[4], gv[4]; int rc = -1;
#pragma unroll
    for (int j = 0; j < 4; ++j) fwv[j] = *(const f32x4*)(fw + (j * 64 + lane) * 4);
    for (int row = row0; row < row1; ++row) {
        const int b = row >> 13; float* x = p.out + (size_t)row * D;
        if (b != rc) { rc = b;
#pragma unroll
            for (int j = 0; j < 4; ++j) gv[j] = *(const f32x4*)(modv + b * 6144 + 5 * 1024 + (j * 64 + lane) * 4); }
        const float g0 = rt_g[row * 2], g1 = rt_g[row * 2 + 1]; const bf16* y0 = YS + (size_t)rt_pos[row * 2] * D; const bf16* y1 = YS + (size_t)rt_pos[row * 2 + 1] * D;
        f32x4 v[4]; float ss = 0.f;
#pragma unroll
        for (int j = 0; j < 4; ++j) { const int c0 = (j * 64 + lane) * 4; const f32x4 xv = *(const f32x4*)(x + c0); const u32x2 a = *(const u32x2*)(y0 + c0), c = *(const u32x2*)(y1 + c0);
            const f32x4 ya = {bf2f(a.x & 0xffff), bf2f(a.x >> 16), bf2f(a.y & 0xffff), bf2f(a.y >> 16)}, yb = {bf2f(c.x & 0xffff), bf2f(c.x >> 16), bf2f(c.y & 0xffff), bf2f(c.y >> 16)};
            v[j] = xv + gv[j] * (ya * g0 + yb * g1); ss += v[j][0] * v[j][0] + v[j][1] * v[j][1] + v[j][2] * v[j][2] + v[j][3] * v[j][3]; }
        ss = wave_sum(ss); const float rstd = 1.0f / sqrtf(ss * (1.f / D) + EPS);
#pragma unroll
        for (int j = 0; j < 4; ++j) { const int c0 = (j * 64 + lane) * 4; *(f32x4*)(x + c0) = v[j] * rstd * fwv[j]; }
    }
}

#define XB_TMO      128
#define XB_XCNT(j)  (256  + 64 * (j))
#define XB_XSUB(j)  (1280 + 64 * (j))
#define XB_XGEN(j)  (2304 + 64 * (j))
#define XB_TOP      3328
#define XB_TOPGEN   3392
#define XCD_BAR_WORDS 3456
#define XB_SPIN_CAP (1u << 22)
DEVI unsigned xb_ld(unsigned* p)              { return __hip_atomic_load(p, __ATOMIC_RELAXED, __HIP_MEMORY_SCOPE_AGENT); }
DEVI unsigned xb_add(unsigned* p, unsigned v) { return __hip_atomic_fetch_add(p, v, __ATOMIC_RELAXED, __HIP_MEMORY_SCOPE_AGENT); }
DEVI unsigned xb_xcc_id() { return (unsigned)__builtin_amdgcn_s_getreg((3 << 11) | 20) & 0xFu; }
#define XB_SPIN(cond, bar) do { unsigned _sp = 0; while (cond) { __builtin_amdgcn_s_sleep(1); \
    if ((++_sp & 255u) == 0u) { if (xb_ld(&(bar)[XB_TMO])) break; if (_sp > XB_SPIN_CAP) { atomicAdd(&(bar)[XB_TMO], 1u); break; } } } } while (0)
struct XcdBarrier { unsigned* bar; unsigned x; volatile LAS unsigned* st; };
DEVI XcdBarrier xcd_barrier_post(unsigned* bar, volatile LAS unsigned* st) {
    XcdBarrier b; b.bar = bar; b.x = xb_xcc_id(); b.st = st;
    if (threadIdx.x == 0) (void)xb_add(&bar[XB_XCNT(b.x)], 1u);
    return b;
}
DEVI void xcd_barrier_complete(unsigned* bar, unsigned x, unsigned& nloc, unsigned& nx) {
    const unsigned G = gridDim.x * gridDim.y * gridDim.z;
    unsigned sum, cnt, mine, sp = 0u;
    for (;;) {
        sum = 0u; cnt = 0u; mine = 0u;
#pragma unroll
        for (unsigned j = 0; j < 16; ++j) { const unsigned c = xb_ld(&bar[XB_XCNT(j)]); sum += c; cnt += (c > 0u) ? 1u : 0u; mine = (j == x) ? c : mine; }
        if (sum == G) break;
        __builtin_amdgcn_s_sleep(1);
        if ((++sp & 255u) == 0u) { if (xb_ld(&bar[XB_TMO])) break; if (sp > XB_SPIN_CAP) { atomicAdd(&bar[XB_TMO], 1u); break; } }
    }
    nloc = mine > 0u ? mine : 1u; nx = cnt > 0u ? cnt : 1u;
}
DEVI void xcd_barrier(const XcdBarrier& b) {
    asm volatile("s_waitcnt vmcnt(0)" ::: "memory");
    __syncthreads();
    if (threadIdx.x == 0) {
        unsigned* bar = b.bar;
        __builtin_amdgcn_s_waitcnt(0);
        unsigned nloc = b.st[0], nx = b.st[1];
        if (nloc == 0u) { xcd_barrier_complete(bar, b.x, nloc, nx); b.st[0] = nloc; b.st[1] = nx; }
        const unsigned old = xb_add(&bar[XB_XSUB(b.x)], 1u);
        const unsigned gen = old / nloc;
        if (old + 1u == (gen + 1u) * nloc) {
            __builtin_amdgcn_fence(__ATOMIC_RELEASE, "agent");
            asm volatile("s_waitcnt vmcnt(0)" ::: "memory");
            const unsigned og = xb_add(&bar[XB_TOP], 1u);
            const unsigned tg = og / nx;
            if (og + 1u == (tg + 1u) * nx) xb_add(&bar[XB_TOPGEN], 1u);
            else XB_SPIN(xb_ld(&bar[XB_TOPGEN]) == tg, bar);
            __builtin_amdgcn_fence(__ATOMIC_ACQUIRE, "agent");
            xb_add(&bar[XB_XGEN(b.x)], 1u);
            asm volatile("s_waitcnt vmcnt(0)" ::: "memory");
        } else {
            XB_SPIN(xb_ld(&bar[XB_XGEN(b.x)]) == gen, bar);
            __builtin_amdgcn_fence(__ATOMIC_ACQUIRE, "agent");
            asm volatile("s_waitcnt vmcnt(0)" ::: "memory");
        }
    }
    __syncthreads();
}

constexpr int NPHASES = 21;
#ifndef XSYNC
#define XSYNC 0
#endif
#ifndef REP_MASK
#define REP_MASK 0u
#endif
#ifndef PH_MASK
#define PH_MASK 0xffffu
#endif
__global__ void __launch_bounds__(NTHREADS, 2) mk_fwd(P p) {
    extern __shared__ __attribute__((aligned(16))) unsigned char lds[];
    cg::grid_group grid = cg::this_grid();
    const int G = gridDim.x, c = blockIdx.x;
    if (threadIdx.x < 30) ((lds_u64*)(uintptr_t)LDS_PTRS)[threadIdx.x] = (unsigned long long)p.in[threadIdx.x];
    if (threadIdx.x < 2) ((volatile LAS unsigned*)(uintptr_t)LDS_MISC)[threadIdx.x] = 0u;
    __syncthreads();
    XcdBarrier xbar = xcd_barrier_post((unsigned*)(p.ws + WS_CTL) + 1024, (volatile LAS unsigned*)(uintptr_t)LDS_MISC);
    int nsync = 0;
#define GRID_BAR() do { if (nsync == 0) grid.sync(); else xcd_barrier(xbar); ++nsync; } while (0)
    int ph = 0;
#define RUN(kid, ...) do { if (((PH_MASK >> (kid)) & 1u) && ph >= p.ph_lo && ph < p.ph_hi) { __VA_ARGS__; if ((REP_MASK >> (kid)) & 1u) { __VA_ARGS__; } if (ph + 1 < p.ph_hi) { GRID_BAR(); for (int xs_ = 0; xs_ < XSYNC; ++xs_) GRID_BAR(); } } ++ph; } while (0)
    RUN(0, ph_pro(p, lds));
#define LAYER(l) \
        RUN(1, ph_norm<false>(p, l, 0, T, lds, l == 1 ? 11 : 0, 5)); \
        RUN(2, { Gemm g{(const bf16*)(p.ws + WS_HM), (const bf16*)(p.ws + WS_WIN) + (size_t)l * INWP * 1024, 0, nullptr}; DenseSched S{T / 256, INWP / 256, G, c}; \
            EpiInProj E{(bf16*)(p.ws + WS_PROJ), (float*)(p.ws + WS_DT), IN(18) + l * 16, IN(19) + l * 16, (float*)(p.ws + WS_RQP), (float*)(p.ws + WS_RKVP)}; gemm_phase<D, 1024, 1024>(lds, g, S, E); }); \
        RUN(4, { Gemm g{(const bf16*)(p.ws + WS_PROJ), (const bf16*)(p.ws + WS_WQKV) + (size_t)l * 1024 * 384, 0, nullptr}; DenseSched S{T / 256, 4, G, c}; \
            EpiMla E{(bf16*)(p.ws + WS_Q), (bf16*)(p.ws + WS_K), (bf16*)(p.ws + WS_V), (const float*)(p.ws + WS_RQP), (const float*)(p.ws + WS_RKVP), (const float*)(p.ws + WS_ROPE), (const bf16*)(p.ws + WS_PROJ)}; gemm_phase<INWP, 384, 384>(lds, g, S, E); ph_scanA(p, l, lds); }); \
        RUN(5, ph_mixer(p, l, lds)); \
        RUN(6, ph_scanC(p, l, lds)); \
        RUN(8, { Gemm g{(const bf16*)(p.ws + WS_HM), (const bf16*)(p.ws + WS_WOUT) + (size_t)l * 1024 * 1024, 0, nullptr}; DenseSched S{NLAT / 256, 4, G, c}; \
            EpiResid E{l == 0 ? IN(0) : p.out, (const float*)(p.ws + WS_XC), p.out, (float*)(p.ws + WS_XC), (const float*)(p.ws + WS_MODV) + (size_t)l * 3 * 6144, 2}; gemm_phase<D, 1024, 1024>(lds, g, S, E); \
            if (l == 0) { CtxSplitSched S2{4, 256 * 2, G, c}; EpiPart E2{(float*)(p.ws + WS_XBC)}; gemm_phase<D, 1024, 256>(lds, g, S2, E2); } }); \
        RUN(9, ph_norm<l == 1>(p, l, 1, l == 0 ? T : NLAT, lds, l == 0 ? 4 : 0, 2)); \
        if (l == 0) { \
            RUN(10, { Gemm g{(const bf16*)(p.ws + WS_HM), (const bf16*)(p.ws + WS_WGU), 0, nullptr}; DenseSched S{T / 256, 2 * DFF / 256, G, c}; \
                EpiSwiglu E{(bf16*)(p.ws + WS_PROJ), DFF}; gemm_phase<D, 1024, 1024>(lds, g, S, E); }); \
            RUN(11, { Gemm g{(const bf16*)(p.ws + WS_PROJ), (const bf16*)(p.ws + WS_WD), 0, nullptr}; DenseSched S{NLAT / 256, 4, G, c}; \
                EpiResid E{p.out, (const float*)(p.ws + WS_XC), p.out, (float*)(p.ws + WS_XC), (const float*)(p.ws + WS_MODV), 5}; gemm_phase<DFF, DFF, DFF>(lds, g, S, E); \
                CtxSplitSched S2{11, 256 * 2, G, c}; EpiPart E2{(float*)(p.ws + WS_XBC)}; gemm_phase<DFF, DFF, 256>(lds, g, S2, E2); }); \
        } else { \
            RUN(12, { ph_sort(p, lds); __syncthreads(); ph_moew(p, lds); }); \
            RUN(13, { Gemm g{(const bf16*)(p.ws + WS_HM), (const bf16*)(p.ws + WS_WGUE), (size_t)2 * DFE * 1024, (const int*)(p.ws + WS_RT + 640 * 1024)}; MoeSched S{(const int*)(p.ws + WS_RT + 384 * 1024), 2 * DFE / 256, G, c}; \
                EpiSwiglu E{(bf16*)(p.ws + WS_ACTS), DFE}; gemm_phase<D, 1024, 1024, EpiSwiglu, MoeSched, true>(lds, g, S, E); }); \
            RUN(14, { Gemm g{(const bf16*)(p.ws + WS_ACTS), (const bf16*)(p.ws + WS_WDE), (size_t)1024 * DFE, nullptr}; MoeSched S{(const int*)(p.ws + WS_RT + 384 * 1024), 4, G, c}; \
                EpiStore E{(bf16*)(p.ws + WS_HS), D}; gemm_phase<DFE, DFE, DFE>(lds, g, S, E); }); \
            RUN(15, ph_final(p)); \
        }
    LAYER(0)
    LAYER(1)
#undef LAYER
#undef RUN
}

#ifndef MK_ONE_LAUNCH
#define MK_ONE_LAUNCH 1
#endif
extern "C" void kernel_launch(void* const* d_in, const int* in_sizes, int n_in, void* d_out, int out_size, void* d_ws, size_t ws_size, hipStream_t stream) {
    static int grid = 0;
    if (grid == 0) {
        if (n_in != 30 || out_size != NLAT * D || ws_size < WS_END) { fprintf(stderr, "kernel_launch: unexpected problem (n_in %d out %d ws %zu, need %zu)\n", n_in, out_size, ws_size, (size_t)WS_END); grid = -1; return; }
        int dev = 0, cus = 0, per_cu = 0;
        hipGetDevice(&dev); hipDeviceGetAttribute(&cus, hipDeviceAttributeMultiprocessorCount, dev);
        if (hipFuncSetAttribute((const void*)mk_fwd, hipFuncAttributeMaxDynamicSharedMemorySize, LDS_BYTES) != hipSuccess) { fprintf(stderr, "kernel_launch: hipFuncSetAttribute failed\n"); grid = -1; return; }
        if (hipOccupancyMaxActiveBlocksPerMultiprocessor(&per_cu, (const void*)mk_fwd, NTHREADS, LDS_BYTES) != hipSuccess || per_cu < 1) { fprintf(stderr, "kernel_launch: occupancy query failed (%d)\n", per_cu); grid = -1; return; }
        grid = cus;
        fprintf(stderr, "kernel_launch: grid %d (cus %d, per_cu %d)\n", grid, cus, per_cu);
    }
    if (grid < 0) return;
    if (hipMemsetAsync((char*)d_ws + WS_CTL, 0, 65536, stream) != hipSuccess) { fprintf(stderr, "kernel_launch: memset failed\n"); return; }
    P p{};
    for (int i = 0; i < 30; ++i) p.in[i] = (const float*)d_in[i];
    p.out = (float*)d_out; p.ws = (unsigned char*)d_ws;
#if MK_ONE_LAUNCH
    p.ph_lo = 0; p.ph_hi = NPHASES;
    { void* args[] = {&p}; hipError_t e = hipLaunchCooperativeKernel((const void*)mk_fwd, dim3(grid), dim3(NTHREADS), args, LDS_BYTES, stream);
      if (e != hipSuccess) fprintf(stderr, "cooperative launch failed: %s\n", hipGetErrorString(e)); }
#else
    for (int ph = 0; ph < NPHASES; ++ph) {
        p.ph_lo = ph; p.ph_hi = ph + 1;
        void* args[] = {&p}; hipError_t e = hipLaunchCooperativeKernel((const void*)mk_fwd, dim3(grid), dim3(NTHREADS), args, LDS_BYTES, stream);
        if (e != hipSuccess) { fprintf(stderr, "cooperative launch %d failed: %s\n", ph, hipGetErrorString(e)); break; }
    }
#endif
}
```

```cpp
#include <hip/hip_runtime.h>
#include <hip/hip_cooperative_groups.h>
#include <cstdio>
#include <cstdint>
namespace cg = cooperative_groups;
#ifndef ATTN_PROBE
#define ATTN_PROBE 0
#endif

#define DEVI __device__ __forceinline__
typedef unsigned short bf16;
typedef short bf16x8 __attribute__((ext_vector_type(8)));
typedef float f32x4 __attribute__((ext_vector_type(4)));
typedef float f32x2 __attribute__((ext_vector_type(2)));
typedef float f32x16 __attribute__((ext_vector_type(16)));
typedef unsigned u32x4 __attribute__((ext_vector_type(4)));
typedef unsigned u32x2 __attribute__((ext_vector_type(2)));
typedef __bf16 bf16x2_t __attribute__((ext_vector_type(2)));

constexpr int D = 1024, NB = 2, SEQ = 8192, NLAT = NB * SEQ, CL = 256, NCTX = NB * CL, T = NLAT + NCTX;
constexpr int INW = 2736, INWP = 2816;
constexpr int C_CQ = 0, C_CKV = 256, C_KPE = 384, C_RQ = 416, C_RK = 672, C_RV = 928, C_RG = 1184, C_Z = 1440, C_XBC = 1952, C_DTF = 2720, C_DTB = 2728;
constexpr int DFF = 2816, DFE = 1408, NEXP = 8;
constexpr float EPS = 1e-6f;
constexpr int MOE_MAXROWS = 34816;

constexpr size_t MiB = 1u << 20;
constexpr size_t WS_CTL = 0;
constexpr size_t WS_MODV = 1 * MiB;
constexpr size_t WS_ROPE = WS_MODV + 256 * 1024;
constexpr size_t WS_RQ = WS_MODV + 512 * 1024;
constexpr size_t WS_RKV = WS_MODV + 640 * 1024;
constexpr size_t WS_WIN = 2 * MiB;
constexpr size_t WS_WQKV = 13 * MiB;
constexpr size_t WS_WOUT = 15 * MiB;
constexpr size_t WS_WGU = 19 * MiB;
constexpr size_t WS_WD = 30 * MiB;
constexpr size_t WS_XC = 36 * MiB;
constexpr size_t WS_RT = 38 * MiB;
constexpr size_t WS_DT = 39 * MiB;
constexpr size_t WS_RQP = 41 * MiB + 128 * 1024;
constexpr size_t WS_RKVP = 41 * MiB + 512 * 1024;
constexpr size_t DYN = 42 * MiB;
constexpr size_t WS_HM = DYN;
constexpr size_t WS_PROJ = DYN + 33 * MiB;
constexpr size_t WS_XBC = DYN + 124 * MiB;
constexpr size_t WS_Q = DYN + 149 * MiB;
constexpr size_t WS_K = DYN + 161 * MiB + 512 * 1024;
constexpr size_t WS_V = DYN + 174 * MiB;
constexpr size_t WS_ST = DYN + 182 * MiB + 512 * 1024;
constexpr size_t WS_HT = WS_ST + (size_t)1584 * 2 * 4096 * 4;
constexpr size_t WS_CD = WS_RT + 512 * 1024;
constexpr size_t WS_VEC = WS_HT + (size_t)1584 * 2 * 4096 * 2;
constexpr size_t WS_WGUE = DYN + 33 * MiB;
constexpr size_t WS_WDE = DYN + 77 * MiB;
constexpr size_t WS_HS = DYN + 99 * MiB;
constexpr size_t WS_ACTS = DYN + 167 * MiB;
constexpr size_t WS_END = DYN + 261 * MiB;
static_assert(WS_HM + (size_t)T * 1024 * 2 <= WS_PROJ && WS_PROJ + (size_t)T * 2816 * 2 <= WS_XBC && WS_XBC + (size_t)T * 768 * 2 <= WS_Q &&
              WS_Q + (size_t)T * 384 * 2 <= WS_K && WS_K + (size_t)T * 384 * 2 <= WS_V && WS_V + (size_t)T * 256 * 2 <= WS_ST && WS_VEC + (size_t)1584 * 512 * 4 <= WS_END, "ws map (mixer)");
static_assert(WS_WGUE + (size_t)8 * 2816 * 1024 * 2 <= WS_WDE && WS_WDE + (size_t)8 * 1024 * 1408 * 2 <= WS_HS && WS_HS + (size_t)MOE_MAXROWS * 1024 * 2 <= WS_ACTS &&
              WS_ACTS + (size_t)MOE_MAXROWS * 1408 * 2 <= WS_END, "ws map (moe)");
static_assert(WS_DT + (size_t)T * 32 * 4 <= DYN && WS_WD + (size_t)1024 * 2816 * 2 <= WS_XC && WS_WIN + (size_t)2 * 2816 * 1024 * 2 <= WS_WQKV, "ws map (static)");

constexpr int NTHREADS = 512, NWAVES = 8;
constexpr int LDS_BYTES = 147456;

struct P { const float* in[30]; float* out; unsigned char* ws; int ph_lo, ph_hi; };
constexpr int LDS_MISC = 147456 - 512;
constexpr int LDS_PTRS = 147456 - 256;
typedef __attribute__((address_space(3))) unsigned long long lds_u64;
DEVI const float* inptr(int i) {
    const unsigned long long v = ((lds_u64*)(uintptr_t)LDS_PTRS)[i];
    const unsigned lo = __builtin_amdgcn_readfirstlane((unsigned)v), hi = __builtin_amdgcn_readfirstlane((unsigned)(v >> 32));
    return (const float*)(((unsigned long long)hi << 32) | lo);
}
#define IN(i) inptr(i)
DEVI int otid() { int t = threadIdx.x; asm volatile("" : "+v"(t)); return t; }

DEVI float bf2f(bf16 x) { return __uint_as_float(((unsigned)x) << 16); }
DEVI unsigned pk2(float lo, float hi) { f32x2 v = {lo, hi}; bf16x2_t b = __builtin_convertvector(v, bf16x2_t); return __builtin_bit_cast(unsigned, b); }
DEVI bf16 f2bf(float x) { return (bf16)(pk2(x, 0.f) & 0xffffu); }
DEVI float wave_sum(float v) {
#pragma unroll
    for (int o = 1; o < 64; o <<= 1) v += __shfl_xor(v, o);
    return v;
}
DEVI float siluf(float x) { return x * __builtin_amdgcn_rcpf(1.f + __builtin_amdgcn_exp2f(-1.4426950408889634f * x)); }
DEVI float softplusf(float x) { return fmaxf(x, 0.f) + log1pf(__expf(-fabsf(x))); }
DEVI int rope_src(int p) { const int q = p & 15, s = (q & 1) ? 8 + (q >> 1) : (q >> 1); return (p & 16) + s; }

#define LAS __attribute__((address_space(3)))
struct Unit { int pm, pn, e, koff; };
struct Gemm { const bf16* A; const bf16* Bt; size_t bstride; const int* rowtab; };
constexpr int BM = 256, BK = 64, HALF = 128, HTB = HALF * BK * 2, STAGE_BYTES = 8 * HTB, NXCD = 8, WGM = 8;
__host__ __device__ __forceinline__ int lds_byte(int r, int c) { const int st = (r >> 4) * 2 + (c >> 5), rr = r & 15, cc = c & 31, ob = rr * 64 + cc * 2; return st * 1024 + (ob ^ (((ob >> 9) & 1) << 5)); }
__host__ __device__ __forceinline__ void stage_rc(int b, int& R, int& C) { const int st = b / 1024, sb = b % 1024, swz = sb ^ (((sb >> 9) & 1) << 5); R = (st >> 1) * 16 + swz / 64; C = (st & 1) * 32 + (swz % 64) / 2; }
struct DenseSched {
    int nM, nN, G, c;
    DEVI bool next(int i, Unit& u) const {
        const int nwg = nM * nN; const long L = (long)i * G + c; if (L >= nwg) return false;
        int wgid = (int)L; { const int q = nwg / NXCD, r = nwg % NXCD, xcd = wgid % NXCD, off = wgid / NXCD; wgid = (xcd < r ? xcd * (q + 1) : r * (q + 1) + (xcd - r) * q) + off; }
        const int nig = WGM * nN, gid = wgid / nig, fm = gid * WGM, gsz = (nM - fm) < WGM ? (nM - fm) : WGM;
        u.pm = fm + ((wgid % nig) % gsz); u.pn = (wgid % nig) / gsz; u.e = 0; u.koff = 0; return true;
    }
};
struct CtxSplitSched {
    int nsplit, kbytes, G, c;
    DEVI bool next(int i, Unit& u) const { const int id = i * G + c; if (id >= 8 * nsplit) return false; const int tile = id & 7, ks = id >> 3; u.pm = 64 + (tile >> 2); u.pn = tile & 3; u.e = ks; u.koff = ks * kbytes; return true; }
};
struct MoeSched {
    const int* tab; int nN, G, c;
    DEVI bool next(int i, Unit& u) const { DenseSched d{tab[0], nN, G, c}; if (!d.next(i, u)) return false; u.e = tab[1 + u.pm]; return true; }
};
template <int LDA, int LDB, int KK, class Epi, class Sched, bool GATHER = false>
DEVI void gemm_phase(unsigned char* lds_generic, const Gemm g, const Sched& S, const Epi& E) {
    LAS unsigned char* lds = (LAS unsigned char*)lds_generic;
    const int tid = otid(), wid = __builtin_amdgcn_readfirstlane(tid >> 6), lane = tid & 63, wr = wid >> 2, wc = wid & 3, fr = lane & 15, fq = lane >> 4;
    constexpr int nt = KK / BK; static_assert(KK % 128 == 0, "K must be a multiple of 128");
    unsigned voffA[2], voffB[2]; int Rr[2], Cc[2];
#pragma unroll
    for (int i = 0; i < 2; ++i) { int R, C; stage_rc(tid * 16 + i * 8192, R, C); Rr[i] = R; Cc[i] = C; voffA[i] = (unsigned)(R * LDA + C) * 2u; voffB[i] = (unsigned)(R * LDB + C) * 2u; }
    unsigned cv0[2] = {voffA[0], voffA[1]}, cv1[2] = {voffA[0], voffA[1]}, nv0[2] = {voffA[0], voffA[1]}, nv1[2] = {voffA[0], voffA[1]};
#define PG8_ROWS(u, v0, v1) do { if (GATHER) { _Pragma("unroll") for (int i_ = 0; i_ < 2; ++i_) { v0[i_] = (unsigned)(g.rowtab[(u).pm * BM + Rr[i_]] * LDA + Cc[i_]) * 2u; v1[i_] = (unsigned)(g.rowtab[(u).pm * BM + HALF + Rr[i_]] * LDA + Cc[i_]) * 2u; } } } while (0)
    constexpr size_t kstep = (size_t)(BK * 2), hstepA = GATHER ? (size_t)0 : (size_t)HALF * LDA * 2, hstepB = (size_t)HALF * LDB * 2, tstepA = GATHER ? (size_t)0 : (size_t)2 * HALF * LDA * 2, tstepB = 2 * hstepB;
    const unsigned ldsw = (unsigned)wid * 1024u;
    const int aoff = lds_byte(wr * 64 + fr, fq * 8), boff = lds_byte(wc * 32 + fr, fq * 8);
#define PG8_SA(b, h) (((b) * 2 + (h)) * HTB)
#define PG8_SB(b, h) ((4 + (b) * 2 + (h)) * HTB)
#define PG8_STAGE(bufoff, gbase, voff) do { _Pragma("unroll") for (int _i = 0; _i < 2; ++_i) \
        __builtin_amdgcn_global_load_lds((const unsigned*)((const char*)(gbase) + (voff)[_i]), (LAS unsigned*)(lds + (bufoff) + ldsw + _i * 8192), 16, 0, 0); } while (0)
#define PG8_LDA(dst, b, h) do { _Pragma("unroll") for (int m = 0; m < 4; ++m) _Pragma("unroll") for (int k = 0; k < 2; ++k) dst[m][k] = *(const LAS bf16x8*)(lds + PG8_SA(b, h) + aoff + m * 2048 + k * 1024); } while (0)
#define PG8_LDB(dst, b, h) do { _Pragma("unroll") for (int n = 0; n < 2; ++n) _Pragma("unroll") for (int k = 0; k < 2; ++k) dst[n][k] = *(const LAS bf16x8*)(lds + PG8_SB(b, h) + boff + n * 2048 + k * 1024); } while (0)
#define PG8_MMA(ai, bj, At, Bt) do { __builtin_amdgcn_s_setprio(1); _Pragma("unroll") for (int m = 0; m < 4; ++m) _Pragma("unroll") for (int n = 0; n < 2; ++n) _Pragma("unroll") for (int k = 0; k < 2; ++k) \
        acc[ai][bj][m][n] = __builtin_amdgcn_mfma_f32_16x16x32_bf16(Bt[n][k], At[m][k], acc[ai][bj][m][n], 0, 0, 0); __builtin_amdgcn_s_setprio(0); } while (0)
#define PG8_WAIT_V(n) asm volatile("s_waitcnt vmcnt(" #n ")" ::: "memory")
#define PG8_WAIT_L(n) asm volatile("s_waitcnt lgkmcnt(" #n ")" ::: "memory")
#define PG8_BAR __builtin_amdgcn_s_barrier()
#define PG8_SCHED __builtin_amdgcn_sched_barrier(0)
    Unit cur, nxt; int ui = 0;
    if (!S.next(0, cur)) return;
    f32x4 acc[2][2][4][2];
#pragma unroll
    for (int a = 0; a < 2; ++a)
#pragma unroll
        for (int b = 0; b < 2; ++b)
#pragma unroll
            for (int m = 0; m < 4; ++m)
#pragma unroll
                for (int n = 0; n < 2; ++n) acc[a][b][m][n] = (f32x4){0.f, 0.f, 0.f, 0.f};
    bf16x8 At[4][2], B0[2][2], B1[2][2];
    const char* cA = (const char*)g.A + (size_t)cur.pm * tstepA + cur.koff; const char* cB = (const char*)(g.Bt + (size_t)cur.e * g.bstride) + (size_t)cur.pn * tstepB + cur.koff;
    PG8_WAIT_V(0); PG8_WAIT_L(0); __syncthreads();
    PG8_ROWS(cur, cv0, cv1);
    PG8_STAGE(PG8_SB(0, 0), cB, voffB); PG8_STAGE(PG8_SB(0, 1), cB + hstepB, voffB); PG8_STAGE(PG8_SA(0, 0), cA, cv0); PG8_STAGE(PG8_SA(0, 1), cA + hstepA, cv1);
    if (wr == 1) PG8_BAR;
    PG8_WAIT_V(2); PG8_BAR;
    PG8_STAGE(PG8_SB(1, 0), cB + kstep, voffB); PG8_STAGE(PG8_SA(1, 0), cA + kstep, cv0); PG8_STAGE(PG8_SB(1, 1), cB + hstepB + kstep, voffB);
    PG8_WAIT_V(6); PG8_BAR;
    for (;;) {
        const bool has_next = S.next(ui + 1, nxt);
        if (has_next) PG8_ROWS(nxt, nv0, nv1);
        const char* nA = has_next ? (const char*)g.A + (size_t)nxt.pm * tstepA + nxt.koff : cA; const char* nB = has_next ? (const char*)(g.Bt + (size_t)nxt.e * g.bstride) + (size_t)nxt.pn * tstepB + nxt.koff : cB;
#pragma unroll 1
        for (int t = 0; t < nt; t += 2) {
            const bool last = (t == nt - 2);
            const char* a1 = cA + (size_t)(t + 1) * kstep;
            const char* a2 = last ? nA : cA + (size_t)(t + 2) * kstep; const char* b2 = last ? nB : cB + (size_t)(t + 2) * kstep;
            const char* a3 = a2 + kstep; const char* b3 = b2 + kstep;
            unsigned s0[2] = {cv0[0], cv0[1]}, s1[2] = {cv1[0], cv1[1]};
            if (GATHER && last && has_next) { s0[0] = nv0[0]; s0[1] = nv0[1]; s1[0] = nv1[0]; s1[1] = nv1[1]; }
            PG8_LDB(B0, 0, 0); PG8_LDB(B1, 0, 1); PG8_SCHED; PG8_LDA(At, 0, 0); PG8_STAGE(PG8_SA(1, 1), a1 + hstepA, cv1);
            PG8_WAIT_V(8); PG8_WAIT_L(0); PG8_BAR; PG8_MMA(0, 0, At, B0); PG8_MMA(0, 1, At, B1); PG8_BAR; PG8_SCHED;
            PG8_LDA(At, 0, 1); PG8_STAGE(PG8_SB(0, 0), b2, voffB); PG8_STAGE(PG8_SB(0, 1), b2 + hstepB, voffB); PG8_STAGE(PG8_SA(0, 0), a2, s0);
            PG8_WAIT_V(8); PG8_WAIT_L(0); PG8_BAR; PG8_MMA(1, 0, At, B0); PG8_MMA(1, 1, At, B1); PG8_BAR; PG8_SCHED;
            PG8_LDB(B0, 1, 0); PG8_LDB(B1, 1, 1); PG8_SCHED; PG8_LDA(At, 1, 0); PG8_STAGE(PG8_SA(0, 1), a2 + hstepA, s1);
            PG8_WAIT_V(8); PG8_WAIT_L(0); PG8_BAR; PG8_MMA(0, 0, At, B0); PG8_MMA(0, 1, At, B1); PG8_BAR; PG8_SCHED;
            PG8_LDA(At, 1, 1); PG8_STAGE(PG8_SB(1, 0), b3, voffB); PG8_STAGE(PG8_SB(1, 1), b3 + hstepB, voffB); PG8_STAGE(PG8_SA(1, 0), a3, s0);
            PG8_WAIT_V(8); PG8_WAIT_L(0); PG8_BAR; PG8_MMA(1, 0, At, B0); PG8_MMA(1, 1, At, B1); PG8_BAR; PG8_SCHED;
        }
        if (wr == 0) PG8_BAR;
        E(acc, cur, wr, wc, fr, fq);
        if (!has_next) break;
#pragma unroll
        for (int a = 0; a < 2; ++a)
#pragma unroll
            for (int b = 0; b < 2; ++b)
#pragma unroll
                for (int m = 0; m < 4; ++m)
#pragma unroll
                    for (int n = 0; n < 2; ++n) acc[a][b][m][n] = (f32x4){0.f, 0.f, 0.f, 0.f};
        cur = nxt; cA = nA; cB = nB; ++ui;
        if (GATHER) { cv0[0] = nv0[0]; cv0[1] = nv0[1]; cv1[0] = nv1[0]; cv1[1] = nv1[1]; }
        if (wr == 1) PG8_BAR;
    }
    PG8_WAIT_V(0);
    PG8_BAR;
#undef PG8_ROWS
#undef PG8_SA
#undef PG8_SB
#undef PG8_STAGE
#undef PG8_LDA
#undef PG8_LDB
#undef PG8_MMA
#undef PG8_WAIT_V
#undef PG8_WAIT_L
#undef PG8_BAR
#undef PG8_SCHED
}
#define EPI_LOOP_ROWS _Pragma("unroll") for (int ai = 0; ai < 2; ++ai) _Pragma("unroll") for (int m = 0; m < 4; ++m)
#define EPI_ROW (u.pm * 256 + ai * 128 + wr * 64 + m * 16 + fr)
#define EPI_COL(bj, n) (u.pn * 256 + (bj) * 128 + wc * 32 + (n) * 16 + fq * 4)

DEVI void st_bf16x4(bf16* p, f32x4 v) { u32x2 w; w.x = pk2(v[0], v[1]); w.y = pk2(v[2], v[3]); *(u32x2*)p = w; }

struct EpiInProj {
    bf16* proj; float* dt; const float* dt_bias; const float* a_log; float* rqp; float* rkvp;
    DEVI void operator()(const f32x4 (&acc)[2][2][4][2], const Unit& u, int wr, int wc, int fr, int fq) const {
        EPI_LOOP_ROWS { const int row = EPI_ROW;
            if (u.pn <= 1) { float ssq = 0.f;
#pragma unroll
                for (int bj = 0; bj < 2; ++bj) if (u.pn == 0 || bj == 0) {
#pragma unroll
                    for (int n = 0; n < 2; ++n) { const f32x4 v = acc[ai][bj][m][n]; ssq += (v[0] * v[0] + v[1] * v[1]) + (v[2] * v[2] + v[3] * v[3]); } }
                ssq += __shfl_xor(ssq, 16); ssq += __shfl_xor(ssq, 32);
                if (fq == 0) (u.pn == 0 ? rqp : rkvp)[(size_t)row * 4 + wc] = ssq; }
#pragma unroll
            for (int bj = 0; bj < 2; ++bj)
#pragma unroll
                for (int n = 0; n < 2; ++n) { const int col = EPI_COL(bj, n); const f32x4 v = acc[ai][bj][m][n];
                    if (col < C_DTF) st_bf16x4(proj + (size_t)row * INWP + col, v);
                    else if (col < INW) { const int j0 = col - C_DTF; f32x4 dv, lv;
#pragma unroll
                        for (int i = 0; i < 4; ++i) { const float d_ = softplusf(v[i] + dt_bias[j0 + i]); dv[i] = d_; lv[i] = -d_ * __expf(a_log[j0 + i]); }
                        *(f32x4*)(dt + (size_t)row * 32 + j0) = dv; *(f32x4*)(dt + (size_t)row * 32 + 16 + j0) = lv; } } }
    }
};
struct EpiMla {
    bf16 *Q, *K, *V; const float *rqp, *rkvp; const float* rope; const bf16* proj;
    DEVI void operator()(const f32x4 (&acc)[2][2][4][2], const Unit& u, int wr, int wc, int fr, int fq) const {
        EPI_LOOP_ROWS { const int row = EPI_ROW; float sq = 0.f, skv = 0.f;
            if (u.pn <= 1) { const f32x4 pq = *(const f32x4*)(rqp + (size_t)row * 4); sq = 1.0f / sqrtf(((pq[0] + pq[1]) + (pq[2] + pq[3])) * (1.f / 256.f) + EPS); }
            if (u.pn >= 2) { const f32x4 pk = *(const f32x4*)(rkvp + (size_t)row * 4); skv = 1.0f / sqrtf(((pk[0] + pk[1]) + (pk[2] + pk[3])) * (1.f / 128.f) + EPS); }
            const int pos = row & (SEQ - 1), gr = pos >> 6, gc = pos & 63;
#pragma unroll
            for (int bj = 0; bj < 2; ++bj)
#pragma unroll
                for (int n = 0; n < 2; ++n) { const int col = EPI_COL(bj, n); f32x4 v = acc[ai][bj][m][n];
                    if (col < 384) { v = v * sq; const int d = col % 96;
                        if (d >= 64 && row < NLAT) { const int pp = (d - 64) >> 1;
#pragma unroll
                            for (int i = 0; i < 2; ++i) { const int pi = pp + i; const float* tb = (pi < 8) ? rope + (gr * 8 + pi) * 2 : rope + 2048 + (gc * 8 + (pi - 8)) * 2;
                                const float c = tb[0], s = tb[1], x0 = v[2 * i], x1 = v[2 * i + 1]; v[2 * i] = x0 * c - x1 * s; v[2 * i + 1] = x1 * c + x0 * s; } }
                        st_bf16x4(Q + (size_t)row * 384 + col, v); }
                    else if (col < 416) { const int d0 = col - 384, pp = d0 >> 1; const u32x2 raw = *(const u32x2*)(proj + (size_t)row * INWP + C_KPE + d0);
                        f32x4 x = {bf2f(raw.x & 0xffff), bf2f(raw.x >> 16), bf2f(raw.y & 0xffff), bf2f(raw.y >> 16)};
                        if (row < NLAT) {
#pragma unroll
                            for (int i = 0; i < 2; ++i) { const int pi = pp + i; const float* tb = (pi < 8) ? rope + (gr * 8 + pi) * 2 : rope + 2048 + (gc * 8 + (pi - 8)) * 2;
                                const float c = tb[0], s = tb[1], x0 = x[2 * i], x1 = x[2 * i + 1]; x[2 * i] = x0 * c - x1 * s; x[2 * i + 1] = x1 * c + x0 * s; } }
#pragma unroll
                        for (int h = 0; h < 4; ++h) st_bf16x4(K + (size_t)row * 384 + h * 96 + 64 + d0, x); }
                    else if (col >= 512 && col < 768) { const int c = col - 512; st_bf16x4(K + (size_t)row * 384 + (c >> 6) * 96 + (c & 63), v * skv); }
                    else if (col >= 768) { st_bf16x4(V + (size_t)row * 256 + (col - 768), v * skv); } }
            asm volatile("" ::: "memory"); }
    }
};
struct EpiResid {
    const float* src_lat; const float* src_ctx; float* dst_lat; float* dst_ctx; const float* modv_l; int gidx;
    DEVI void operator()(const f32x4 (&acc)[2][2][4][2], const Unit& u, int wr, int wc, int fr, int fq) const {
        EPI_LOOP_ROWS { const int row = EPI_ROW; const bool lat = row < NLAT; const int r = lat ? (row >> 13) : 2;
            const float* s = lat ? src_lat + (size_t)row * D : src_ctx + (size_t)(row - NLAT) * D; float* d = lat ? dst_lat + (size_t)row * D : dst_ctx + (size_t)(row - NLAT) * D;
            const float* gp = modv_l + r * 6144 + gidx * 1024;
#pragma unroll
            for (int bj = 0; bj < 2; ++bj)
#pragma unroll
                for (int n = 0; n < 2; ++n) { const int col = EPI_COL(bj, n); const f32x4 gv = *(const f32x4*)(gp + col), sv = *(const f32x4*)(s + col);
                    *(f32x4*)(d + col) = sv + gv * acc[ai][bj][m][n]; } }
    }
};
struct EpiPart {
    float* part;
    DEVI void operator()(const f32x4 (&acc)[2][2][4][2], const Unit& u, int wr, int wc, int fr, int fq) const {
        EPI_LOOP_ROWS { const int row = EPI_ROW; float* d = part + ((size_t)u.e * NCTX + (row - NLAT)) * D;
#pragma unroll
            for (int bj = 0; bj < 2; ++bj)
#pragma unroll
                for (int n = 0; n < 2; ++n) *(f32x4*)(d + EPI_COL(bj, n)) = acc[ai][bj][m][n]; }
    }
};
struct EpiSwiglu {
    bf16* act; int ldc;
    DEVI void operator()(const f32x4 (&acc)[2][2][4][2], const Unit& u, int wr, int wc, int fr, int fq) const {
        EPI_LOOP_ROWS { const int row = EPI_ROW;
#pragma unroll
            for (int n = 0; n < 2; ++n) { const f32x4 gt = acc[ai][0][m][n], up = acc[ai][1][m][n]; f32x4 o;
#pragma unroll
                for (int i = 0; i < 4; ++i) o[i] = siluf(gt[i]) * up[i];
                st_bf16x4(act + (size_t)row * ldc + u.pn * 128 + wc * 32 + n * 16 + fq * 4, o); } }
    }
};
struct EpiStore {
    bf16* o; int ldc;
    DEVI void operator()(const f32x4 (&acc)[2][2][4][2], const Unit& u, int wr, int wc, int fr, int fq) const {
        EPI_LOOP_ROWS { const int row = EPI_ROW;
#pragma unroll
            for (int bj = 0; bj < 2; ++bj)
#pragma unroll
                for (int n = 0; n < 2; ++n) st_bf16x4(o + (size_t)row * ldc + EPI_COL(bj, n), acc[ai][bj][m][n]); }
    }
};

struct CvtSrc { const float* src; int ld; int ncols; bool perm; const float* ks; float sc; };
DEVI void cvt_tile(const CvtSrc t, bf16* dst, int Kd, int nd0, int kd0, LAS float* scr, int lane) {
    const int n = lane & 31;
    if (t.src) {
        const int nc = (n < t.ncols) ? n : t.ncols - 1; const float msk = (n < t.ncols) ? t.sc : 0.f;
        const float* sp0 = t.src + (size_t)(lane >> 5) * t.ld + nc;
        float v[32];
#pragma unroll
        for (int i = 0; i < 32; ++i) v[i] = sp0[(size_t)(2 * i) * t.ld];
        if (t.ks) {
#pragma unroll
            for (int i = 0; i < 32; ++i) v[i] *= t.ks[2 * i + (lane >> 5)];
        }
#pragma unroll
        for (int i = 0; i < 32; ++i) scr[(2 * i + (lane >> 5)) * 33 + n] = v[i] * msk;
    } else {
#pragma unroll 8
        for (int i = 0; i < 32; ++i) scr[(2 * i + (lane >> 5)) * 33 + n] = 0.f;
    }
    asm volatile("s_waitcnt lgkmcnt(0)" ::: "memory");
    const int c = lane & 7;
#pragma unroll
    for (int j = 0; j < 4; ++j) { const int nn = (lane >> 3) + 8 * j; const LAS float* sp = scr + (8 * c) * 33 + (t.perm ? rope_src(nn) : nn);
        u32x4 o; o.x = pk2(sp[0 * 33], sp[1 * 33]); o.y = pk2(sp[2 * 33], sp[3 * 33]); o.z = pk2(sp[4 * 33], sp[5 * 33]); o.w = pk2(sp[6 * 33], sp[7 * 33]);
        *(u32x4*)(dst + (size_t)(nd0 + nn) * Kd + kd0 + 8 * c) = o; }
    asm volatile("s_waitcnt lgkmcnt(0)" ::: "memory");
}
template <class F>
DEVI void cvt_job(bf16* dst, int Nd, int Kd, F f, LAS float* scr, int gw, int ngw, int lane) {
    const int ntn = Nd >> 5, ntk = Kd >> 6;
    for (int it = gw; it < ntn * ntk; it += ngw) { const int nt = it % ntn, kt = it / ntn; cvt_tile(f(nt, kt), dst, Kd, nt * 32, kt * 64, scr, lane); }
}
DEVI void ph_pro(const P& p, unsigned char* lds) {
    const int tid = otid(), wid = tid >> 6, lane = tid & 63;
    __syncthreads();
    float* modv = (float*)(p.ws + WS_MODV);
    float* red = (float*)lds;
    for (int item = blockIdx.x; item < 192; item += gridDim.x) {
        const int l = item / 96, n = (item % 96) * 64 + lane;
        const float* W = IN(4) + (size_t)l * 1024 * 6144;
        float a0 = 0.f, a1 = 0.f, a2 = 0.f;
        for (int k = wid * 128; k < wid * 128 + 128; ++k) {
            const float w = W[(size_t)k * 6144 + n];
            a0 += siluf(IN(1)[k]) * w; a1 += siluf(IN(1)[1024 + k]) * w; a2 += siluf(IN(3)[k]) * w;
        }
        red[(wid * 3 + 0) * 64 + lane] = a0; red[(wid * 3 + 1) * 64 + lane] = a1; red[(wid * 3 + 2) * 64 + lane] = a2;
        __syncthreads();
        if (tid < 192) { const int r = tid >> 6, ln = tid & 63; float s = 0.f;
            for (int w = 0; w < 8; ++w) s += red[(w * 3 + r) * 64 + ln];
            const int nn = (item % 96) * 64 + ln; modv[(l * 3 + r) * 6144 + nn] = s + IN(5)[l * 6144 + nn]; }
        __syncthreads();
    }
    if (blockIdx.x == gridDim.x - 1) {
        float* rope = (float*)(p.ws + WS_ROPE);
        for (int idx = tid; idx < 1536; idx += NTHREADS) {
            const int i = idx & 7, pos = (idx < 1024) ? (idx >> 3) : ((idx - 1024) >> 3);
            const float invf = (i == 0) ? 1.f : (i == 1) ? 0.31622776601683794f : (i == 2) ? 0.1f : (i == 3) ? 0.03162277660168379f : (i == 4) ? 0.01f : (i == 5) ? 0.003162277660168379f : (i == 6) ? 0.001f : 0.00031622776601683794f;
            const float ang = (float)pos * invf;
            double rev = (double)ang * 0.15915494309189535; rev -= __builtin_rint(rev);
            const float fr = (float)rev;
            rope[idx * 2] = __builtin_amdgcn_cosf(fr); rope[idx * 2 + 1] = __builtin_amdgcn_sinf(fr);
        }
    }
    __syncthreads();
    LAS float* scr = (LAS float*)(LAS unsigned char*)lds + wid * (64 * 33);
    const int gw = blockIdx.x * NWAVES + wid, ngw = gridDim.x * NWAVES;
    for (int l = 0; l < 2; ++l) {
        { const float* W = IN(8) + (size_t)l * 1024 * INW;
          cvt_job((bf16*)(p.ws + WS_WIN) + (size_t)l * INWP * 1024, INWP, 1024, [=](int nt, int kt) -> CvtSrc {
              const int n0 = nt * 32; if (n0 >= INW) return CvtSrc{nullptr, 0, 0, false, nullptr, 1.f};
              return CvtSrc{W + (size_t)(kt * 64) * INW + n0, INW, (INW - n0 < 32) ? INW - n0 : 32, n0 == C_KPE, nullptr, 1.f}; }, scr, gw, ngw, lane); }
        { const float* Wq = IN(11) + (size_t)l * 256 * 384; const float* qn = IN(10) + l * 256; const float* Wk = IN(13) + (size_t)l * 128 * 256; const float* Wv = IN(14) + (size_t)l * 128 * 256; const float* kn = IN(12) + l * 128;
          const float QS = 0.10206207261596577f * 1.4426950408889634f;
          cvt_job((bf16*)(p.ws + WS_WQKV) + (size_t)l * 1024 * 384, 1024, 384, [=](int nt, int kt) -> CvtSrc {
              const int n0 = nt * 32, k0 = kt * 64;
              if (n0 < 384) { if (k0 >= 256) return CvtSrc{nullptr, 0, 0, false, nullptr, 1.f}; return CvtSrc{Wq + (size_t)k0 * 384 + n0, 384, 32, (n0 % 96) == 64, qn + k0, QS}; }
              if (n0 < 512 || k0 < 256) return CvtSrc{nullptr, 0, 0, false, nullptr, 1.f};
              if (n0 < 768) return CvtSrc{Wk + (size_t)(k0 - 256) * 256 + (n0 - 512), 256, 32, false, kn + k0 - 256, 1.f};
              return CvtSrc{Wv + (size_t)(k0 - 256) * 256 + (n0 - 768), 256, 32, false, kn + k0 - 256, 1.f}; }, scr, gw, ngw, lane); }
        { const float* W = IN(9) + (size_t)l * 1024 * 1024;
          cvt_job((bf16*)(p.ws + WS_WOUT) + (size_t)l * 1024 * 1024, 1024, 1024, [=](int nt, int kt) -> CvtSrc { return CvtSrc{W + (size_t)(kt * 64) * 1024 + nt * 32, 1024, 32, false, nullptr, 1.f}; }, scr, gw, ngw, lane); }
    }
    { const float* Wg = IN(22); const float* Wu = IN(23);
      cvt_job((bf16*)(p.ws + WS_WGU), 2 * DFF, 1024, [=](int nt, int kt) -> CvtSrc { const int n0 = nt * 32, t = n0 >> 8, r = n0 & 255;
          return CvtSrc{(r < 128 ? Wg + t * 128 + r : Wu + t * 128 + r - 128) + (size_t)(kt * 64) * DFF, DFF, 32, false, nullptr, 1.f}; }, scr, gw, ngw, lane); }
    { const float* W = IN(24);
      cvt_job((bf16*)(p.ws + WS_WD), 1024, DFF, [=](int nt, int kt) -> CvtSrc { return CvtSrc{W + (size_t)(kt * 64) * 1024 + nt * 32, 1024, 32, false, nullptr, 1.f}; }, scr, gw, ngw, lane); }
}
DEVI void ph_moew(const P& p, unsigned char* lds) {
    const int tid = otid(), wid = tid >> 6, lane = tid & 63;
    LAS float* scr = (LAS float*)(LAS unsigned char*)lds + wid * (64 * 33);
    const int gw = blockIdx.x * NWAVES + wid, ngw = gridDim.x * NWAVES;
    for (int e = 0; e < NEXP; ++e) {
        { const float* Wg = IN(26) + (size_t)e * 1024 * DFE; const float* Wu = IN(27) + (size_t)e * 1024 * DFE;
          cvt_job((bf16*)(p.ws + WS_WGUE) + (size_t)e * 2 * DFE * 1024, 2 * DFE, 1024, [=](int nt, int kt) -> CvtSrc { const int n0 = nt * 32, t = n0 >> 8, r = n0 & 255;
              return CvtSrc{(r < 128 ? Wg + t * 128 + r : Wu + t * 128 + r - 128) + (size_t)(kt * 64) * DFE, DFE, 32, false, nullptr, 1.f}; }, scr, gw, ngw, lane); }
        { const float* W = IN(28) + (size_t)e * DFE * 1024;
          cvt_job((bf16*)(p.ws + WS_WDE) + (size_t)e * 1024 * DFE, 1024, DFE, [=](int nt, int kt) -> CvtSrc { return CvtSrc{W + (size_t)(kt * 64) * 1024 + nt * 32, 1024, 32, false, nullptr, 1.f}; }, scr, gw, ngw, lane); }
    }
}

template <bool route>
DEVI void ph_norm(const P& p, int l, int which, int nrows, unsigned char* lds, int npart, int pgidx) {
    const int tid = otid(), wid = tid >> 6, lane = tid & 63;
    const bool first = (l == 0 && which == 0);
    const float* src_lat = first ? IN(0) : p.out; const float* src_ctx = (l == 0) ? IN(2) : (const float*)(p.ws + WS_XC);
    const float* w = IN(6 + which) + l * 1024; const float* modv = (const float*)(p.ws + WS_MODV) + (size_t)l * 3 * 6144;
    bf16* H = (bf16*)(p.ws + WS_HM);
    int* rt_e = (int*)(p.ws + WS_RT); float* rt_g = (float*)(p.ws + WS_RT + 128 * 1024);
    float* rl = (float*)lds;
    if (route) { __syncthreads(); const float* router = IN(25);
#pragma unroll
        for (int i = 0; i < 4; ++i) *(f32x4*)(rl + (tid + NTHREADS * i) * 4) = *(const f32x4*)(router + (tid + NTHREADS * i) * 4);
        __syncthreads(); }
    const int nw = gridDim.x * NWAVES, rpw = (NLAT + nw - 1) / nw, gw = blockIdx.x * NWAVES + wid;
    f32x4 vn[4], gsc[4], shv[4]; int rc = -1;
    for (int pass = 0; pass < (nrows > NLAT ? 2 : 1); ++pass) {
    const int row0 = pass == 0 ? gw * rpw : NLAT + gw, row1 = pass == 0 ? ((row0 + rpw < NLAT) ? row0 + rpw : NLAT) : nrows, rstep = pass == 0 ? 1 : nw;
    if (row0 < row1) { const float* x = (row0 < NLAT) ? src_lat + (size_t)row0 * D : src_ctx + (size_t)(row0 - NLAT) * D;
#pragma unroll
        for (int j = 0; j < 4; ++j) vn[j] = *(const f32x4*)(x + (j * 64 + lane) * 4); }
    for (int row = row0; row < row1; row += rstep) {
        const bool lat = row < NLAT; const int r = lat ? (row >> 13) : 2;
        if (r != rc) { rc = r; const float* sh = modv + r * 6144 + (which * 3 + 0) * 1024; const float* sc = modv + r * 6144 + (which * 3 + 1) * 1024;
#pragma unroll
            for (int j = 0; j < 4; ++j) { const int c0 = (j * 64 + lane) * 4; const f32x4 wv = *(const f32x4*)(w + c0), cv = *(const f32x4*)(sc + c0); shv[j] = *(const f32x4*)(sh + c0); gsc[j] = wv * (cv + 1.f); } }
        f32x4 v[4]; float ss = 0.f;
#pragma unroll
        for (int j = 0; j < 4; ++j) v[j] = vn[j];
        if (!lat && npart > 0) { const float* part = (const float*)(p.ws + WS_XBC) + (size_t)(row - NLAT) * D; const float* gp = modv + 2 * 6144 + pgidx * 1024; float* xc = (float*)(p.ws + WS_XC) + (size_t)(row - NLAT) * D;
#pragma unroll
            for (int j = 0; j < 4; ++j) { const int c0 = (j * 64 + lane) * 4; f32x4 acc = {0.f, 0.f, 0.f, 0.f};
#pragma unroll 2
                for (int k = 0; k < npart; ++k) acc += *(const f32x4*)(part + (size_t)k * NCTX * D + c0);
                v[j] += *(const f32x4*)(gp + c0) * acc; *(f32x4*)(xc + c0) = v[j]; } }
#pragma unroll
        for (int j = 0; j < 4; ++j) ss += v[j][0] * v[j][0] + v[j][1] * v[j][1] + v[j][2] * v[j][2] + v[j][3] * v[j][3];
        if (row + rstep < row1) { const int nrow = row + rstep; const float* x = (nrow < NLAT) ? src_lat + (size_t)nrow * D : src_ctx + (size_t)(nrow - NLAT) * D;
#pragma unroll
            for (int j = 0; j < 4; ++j) vn[j] = *(const f32x4*)(x + (j * 64 + lane) * 4); }
        ss = wave_sum(ss); const float rstd = 1.0f / sqrtf(ss * (1.f / D) + EPS);
        float lg[8];
#pragma unroll
        for (int e = 0; e < 8; ++e) lg[e] = 0.f;
#pragma unroll
        for (int j = 0; j < 4; ++j) { const int c0 = (j * 64 + lane) * 4; v[j] = v[j] * rstd * gsc[j] + shv[j]; st_bf16x4(H + (size_t)row * D + c0, v[j]); }
        if (route) {
#pragma unroll
            for (int j = 0; j < 4; ++j) { const int c0 = (j * 64 + lane) * 4;
#pragma unroll
                for (int i = 0; i < 4; ++i) { const f32x4 r0 = *(const f32x4*)(rl + (c0 + i) * 8), r1 = *(const f32x4*)(rl + (c0 + i) * 8 + 4); const float hh = v[j][i];
                    lg[0] += hh * r0[0]; lg[1] += hh * r0[1]; lg[2] += hh * r0[2]; lg[3] += hh * r0[3]; lg[4] += hh * r1[0]; lg[5] += hh * r1[1]; lg[6] += hh * r1[2]; lg[7] += hh * r1[3]; }
                asm volatile("" ::: "memory"); } }
        if (route) {
#pragma unroll
            for (int e = 0; e < 8; ++e) lg[e] = wave_sum(lg[e]);
            int i1 = 0; float v1 = lg[0];
#pragma unroll
            for (int e = 1; e < 8; ++e) if (lg[e] > v1) { v1 = lg[e]; i1 = e; }
            int i2 = -1; float v2 = -3.0e38f;
#pragma unroll
            for (int e = 0; e < 8; ++e) if (e != i1 && lg[e] > v2) { v2 = lg[e]; i2 = e; }
            const float e2 = __expf(v2 - v1), g1 = 1.f / (1.f + e2), g2 = e2 / (1.f + e2);
            if (lane == 0) { rt_e[row * 2] = i1; rt_e[row * 2 + 1] = i2; rt_g[row * 2] = g1; rt_g[row * 2 + 1] = g2; }
        }
    }
    }
}

typedef short v4i16_t __attribute__((ext_vector_type(4)));
DEVI v4i16_t lds_tr(const unsigned char* p) { return __builtin_amdgcn_ds_read_tr16_b64_v4i16((LAS v4i16_t*)(LAS unsigned char*)p); }
constexpr int A3_KLD = 208, A3_VLD = 192, A3_VOFF = 64 * A3_KLD, A3_BUF = A3_VOFF + 64 * A3_VLD;
template <int VAR>
DEVI void attn_unit(const P& p, int uidx, unsigned char* lds, bf16* outp) {
    const int tid = otid(), wid = __builtin_amdgcn_readfirstlane(tid >> 6), lane = tid & 63, r32 = lane & 31, hi = lane >> 5;
    const bf16* Q = (const bf16*)(p.ws + WS_Q); const bf16* K = (const bf16*)(p.ws + WS_K); const bf16* V = (const bf16*)(p.ws + WS_V); bf16* MIX = outp;
    int b, h, qrow0, NT;
    if (uidx < 256) { b = uidx >> 7; h = (uidx >> 5) & 3; qrow0 = b * SEQ + (uidx & 31) * 256; NT = 4 + SEQ / 64; }
    else { const int j = uidx - 256; b = j >> 2; h = j & 3; qrow0 = NLAT + b * CL; NT = 4; }
    const int qrow = qrow0 + wid * 32 + r32;
    bf16x8 qf[6];
#pragma unroll
    for (int s = 0; s < 6; ++s) qf[s] = *(const bf16x8*)(Q + (size_t)qrow * 384 + h * 96 + s * 16 + hi * 8);
    const int kk0 = tid / 12, kq0 = tid % 12, kk1 = (512 + tid) / 12, kq1 = (512 + tid) % 12, vk = tid >> 3, vq = tid & 7;
    const bf16* Kh = K + h * 96; const bf16* Vh = V + h * 64 + vq * 8;
    const int ctx0 = NLAT + b * CL, lat0 = b * SEQ;
    u32x4 krA0, krA1 = {0u, 0u, 0u, 0u}, vrA;
#define AT_LOAD(t, kr0, kr1, vr) do { const int kr_ = ((t) < 4) ? ctx0 + (t) * 64 : lat0 + ((t) - 4) * 64; \
        kr0 = *(const u32x4*)(Kh + (size_t)(kr_ + kk0) * 384 + kq0 * 8); if (tid < 256) kr1 = *(const u32x4*)(Kh + (size_t)(kr_ + kk1) * 384 + kq1 * 8); \
        vr = *(const u32x4*)(Vh + (size_t)(kr_ + vk) * 256); } while (0)
#define AT_STORE(bufp, kr0, kr1, vr) do { unsigned char* b_ = (bufp); *(u32x4*)(b_ + kk0 * A3_KLD + kq0 * 16) = kr0; if (tid < 256) *(u32x4*)(b_ + kk1 * A3_KLD + kq1 * 16) = kr1; \
        *(u32x4*)(b_ + A3_VOFF + vk * A3_VLD + vq * 16) = vr; } while (0)
    const int troff = (4 * hi + ((lane & 15) >> 2)) * A3_VLD + (16 * ((lane >> 4) & 1) + 4 * (lane & 3)) * 2;
    const int koff = r32 * A3_KLD + hi * 16;
    f32x16 o0, o1, negm;
#pragma unroll
    for (int r = 0; r < 16; ++r) { o0[r] = 0.f; o1[r] = 0.f; negm[r] = 0.f; }
    float mhat = 0.f, lsum = 0.f;
    __syncthreads();
    AT_LOAD(0, krA0, krA1, vrA); AT_STORE(lds, krA0, krA1, vrA); AT_LOAD(1, krA0, krA1, vrA); AT_STORE(lds + A3_BUF, krA0, krA1, vrA);
    __syncthreads();
#define SBAR() __builtin_amdgcn_sched_barrier(0)
#define KRD(bufp, half, s) (*(const bf16x8*)((bufp) + koff + (half) * 32 * A3_KLD + (s) * 32))
#define MF(a, b, c) __builtin_amdgcn_mfma_f32_32x32x16_bf16(a, b, c, 0, 0, 0)
#define MFQ(a, b, c) ((VAR == 3) ? (c) : MF(a, b, c))
#define MFP(a, b, c) ((VAR == 2) ? (c) : MF(a, b, c))
#define EX4(S, r0) do { if (VAR == 1) { S[r0] *= 0.001f; S[r0 + 1] *= 0.001f; S[r0 + 2] *= 0.001f; S[r0 + 3] *= 0.001f; break; } S[r0] = __builtin_amdgcn_exp2f(S[r0]); S[r0 + 1] = __builtin_amdgcn_exp2f(S[r0 + 1]); S[r0 + 2] = __builtin_amdgcn_exp2f(S[r0 + 2]); S[r0 + 3] = __builtin_amdgcn_exp2f(S[r0 + 3]); lsum += (S[r0] + S[r0 + 1]) + (S[r0 + 2] + S[r0 + 3]); } while (0)
#define PK8(S, r0) __builtin_bit_cast(bf16x8, (u32x4){pk2(S[r0], S[r0 + 1]), pk2(S[r0 + 2], S[r0 + 3]), pk2(S[r0 + 4], S[r0 + 5]), pk2(S[r0 + 6], S[r0 + 7])})
#define VFR(vp) ({ const v4i16_t lo_ = lds_tr(vp), hi_ = lds_tr((vp) + 8 * A3_VLD); (bf16x8){lo_[0], lo_[1], lo_[2], lo_[3], hi_[0], hi_[1], hi_[2], hi_[3]}; })
#define MX3(a, b, c) __builtin_fmaxf(__builtin_fmaxf((a), (b)), (c))
#define AT_UPD(S0, S1, mx, FORCE) do { float mx_ = __builtin_fmaxf(mx, __shfl_xor(mx, 32)); \
        if ((FORCE) || __any(mx_ > 8.0f)) { const float dl_ = (FORCE) ? mx_ : __builtin_fmaxf(mx_, 0.f); mhat += dl_; \
            _Pragma("unroll") for (int r = 0; r < 16; ++r) { S0[r] -= dl_; S1[r] -= dl_; negm[r] = -mhat; } \
            if (!(FORCE)) { const float f_ = __builtin_amdgcn_exp2f(-dl_); _Pragma("unroll") for (int r = 0; r < 16; ++r) { o0[r] *= f_; o1[r] *= f_; } lsum *= f_; } } } while (0)
    f32x16 sa0, sa1, sb0, sb1;
    { const unsigned char* kb_ = lds;
#pragma unroll
      for (int s = 0; s < 6; ++s) { sa0 = MF(KRD(kb_, 0, s), qf[s], s == 0 ? negm : sa0); sa1 = MF(KRD(kb_, 1, s), qf[s], s == 0 ? negm : sa1); }
      float a_ = MX3(sa0[0], sa0[1], sa1[0]), b_ = MX3(sa0[2], sa0[3], sa1[1]); a_ = MX3(a_, sa1[2], sa1[3]);
#pragma unroll
      for (int r = 4; r < 16; r += 4) { a_ = MX3(a_, sa0[r], sa0[r + 1]); b_ = MX3(b_, sa0[r + 2], sa0[r + 3]); a_ = MX3(a_, sa1[r], sa1[r + 1]); b_ = MX3(b_, sa1[r + 2], sa1[r + 3]); }
      AT_UPD(sa0, sa1, __builtin_fmaxf(a_, b_), true); }
#define AT_STEP(C0, C1, N0, N1, t, bc_, HAS_NEXT) do { const int b1_ = ((bc_) == 2) ? 0 : (bc_) + 1, b2_ = (b1_ == 2) ? 0 : b1_ + 1; \
        const unsigned char* kb_ = lds + b1_ * A3_BUF; const unsigned char* vb_ = lds + (bc_) * A3_BUF + A3_VOFF + troff; \
        if (VAR != 4 && (t) + 2 < NT) AT_LOAD((t) + 2, krA0, krA1, vrA); \
        bf16x8 pw0_, pw1_, pw2_, pw3_; float ma_ = -3.0e38f, mb_ = -3.0e38f; \
        if (HAS_NEXT) { \
            bf16x8 k0_ = KRD(kb_, 0, 0), k1_ = KRD(kb_, 1, 0), k2_ = KRD(kb_, 0, 1), k3_ = KRD(kb_, 1, 1); SBAR(); \
            N0 = MFQ(k0_, qf[0], negm); EX4(C0, 0); k0_ = KRD(kb_, 0, 2); SBAR(); \
            N1 = MFQ(k1_, qf[0], negm); EX4(C0, 4); k1_ = KRD(kb_, 1, 2); SBAR(); \
            N0 = MFQ(k2_, qf[1], N0); EX4(C0, 8); k2_ = KRD(kb_, 0, 3); SBAR(); \
            N1 = MFQ(k3_, qf[1], N1); EX4(C0, 12); k3_ = KRD(kb_, 1, 3); SBAR(); \
            N0 = MFQ(k0_, qf[2], N0); EX4(C1, 0); k0_ = KRD(kb_, 0, 4); SBAR(); \
            N1 = MFQ(k1_, qf[2], N1); EX4(C1, 4); k1_ = KRD(kb_, 1, 4); SBAR(); \
            N0 = MFQ(k2_, qf[3], N0); EX4(C1, 8); k2_ = KRD(kb_, 0, 5); SBAR(); \
            N1 = MFQ(k3_, qf[3], N1); EX4(C1, 12); k3_ = KRD(kb_, 1, 5); SBAR(); \
            N0 = MFQ(k0_, qf[4], N0); pw0_ = PK8(C0, 0); SBAR(); \
            N1 = MFQ(k1_, qf[4], N1); pw1_ = PK8(C0, 8); SBAR(); \
            N0 = MFQ(k2_, qf[5], N0); pw2_ = PK8(C1, 0); SBAR(); \
            N1 = MFQ(k3_, qf[5], N1); pw3_ = PK8(C1, 8); SBAR(); \
        } else { EX4(C0, 0); EX4(C0, 4); EX4(C0, 8); EX4(C0, 12); EX4(C1, 0); EX4(C1, 4); EX4(C1, 8); EX4(C1, 12); pw0_ = PK8(C0, 0); pw1_ = PK8(C0, 8); pw2_ = PK8(C1, 0); pw3_ = PK8(C1, 8); SBAR(); } \
        { bf16x8 va_ = VFR(vb_), vb2_ = VFR(vb_ + 64); SBAR(); \
          bf16x8 vc_ = VFR(vb_ + 16 * A3_VLD), vd_ = VFR(vb_ + 16 * A3_VLD + 64); SBAR(); \
          o0 = MFP(va_, pw0_, o0); if (HAS_NEXT) { ma_ = MX3(N0[0], N0[1], N1[0]); mb_ = MX3(N0[2], N0[3], N1[1]); } SBAR(); \
          o1 = MFP(vb2_, pw0_, o1); if (HAS_NEXT) { ma_ = MX3(ma_, N1[2], N1[3]); mb_ = MX3(mb_, N0[4], N0[5]); } SBAR(); \
          va_ = VFR(vb_ + 32 * A3_VLD); vb2_ = VFR(vb_ + 32 * A3_VLD + 64); SBAR(); \
          o0 = MFP(vc_, pw1_, o0); if (HAS_NEXT) { ma_ = MX3(ma_, N0[6], N0[7]); mb_ = MX3(mb_, N1[4], N1[5]); } SBAR(); \
          o1 = MFP(vd_, pw1_, o1); if (HAS_NEXT) { ma_ = MX3(ma_, N1[6], N1[7]); mb_ = MX3(mb_, N0[8], N0[9]); } SBAR(); \
          vc_ = VFR(vb_ + 48 * A3_VLD); vd_ = VFR(vb_ + 48 * A3_VLD + 64); SBAR(); \
          o0 = MFP(va_, pw2_, o0); if (HAS_NEXT) { ma_ = MX3(ma_, N0[10], N0[11]); mb_ = MX3(mb_, N1[8], N1[9]); } SBAR(); \
          o1 = MFP(vb2_, pw2_, o1); if (HAS_NEXT) { ma_ = MX3(ma_, N1[10], N1[11]); mb_ = MX3(mb_, N0[12], N0[13]); } SBAR(); \
          if (HAS_NEXT) { ma_ = MX3(ma_, N0[14], N0[15]); mb_ = MX3(mb_, N1[12], N1[13]); } SBAR(); \
          o0 = MFP(vc_, pw3_, o0); if (HAS_NEXT) { ma_ = MX3(ma_, N1[14], N1[15]); } SBAR(); \
          o1 = MFP(vd_, pw3_, o1); SBAR(); } \
        if (HAS_NEXT) AT_UPD(N0, N1, __builtin_fmaxf(ma_, mb_), false); \
        if (VAR != 4 && (t) + 2 < NT) AT_STORE(lds + b2_ * A3_BUF, krA0, krA1, vrA); \
        if (VAR != 4) __syncthreads(); } while (0)
    int bc = 0, t = 0;
    for (; t + 2 < NT; t += 2) {
        AT_STEP(sa0, sa1, sb0, sb1, t, bc, true); bc = (bc == 2) ? 0 : bc + 1;
        AT_STEP(sb0, sb1, sa0, sa1, t + 1, bc, true); bc = (bc == 2) ? 0 : bc + 1;
    }
    AT_STEP(sa0, sa1, sb0, sb1, t, bc, true); bc = (bc == 2) ? 0 : bc + 1;
    AT_STEP(sb0, sb1, sa0, sa1, t + 1, bc, false);
#undef AT_LOAD
#undef AT_STORE
#undef SBAR
#undef KRD
#undef MF
#undef MFQ
#undef MFP
#undef EX4
#undef PK8
#undef VFR
#undef MX3
#undef AT_UPD
#undef AT_STEP
    lsum += __shfl_xor(lsum, 32);
    const float inv = 1.f / lsum;
    bf16* orow = MIX + (size_t)qrow * D + h * 64;
#pragma unroll
    for (int g = 0; g < 4; ++g) {
        st_bf16x4(orow + 8 * g + 4 * hi, (f32x4){o0[4 * g] * inv, o0[4 * g + 1] * inv, o0[4 * g + 2] * inv, o0[4 * g + 3] * inv});
        st_bf16x4(orow + 32 + 8 * g + 4 * hi, (f32x4){o1[4 * g] * inv, o1[4 * g + 1] * inv, o1[4 * g + 2] * inv, o1[4 * g + 3] * inv});
    }
}

constexpr int NCC = 66;
DEVI int chunk_row0(int b, int cc) { return cc < 2 ? NLAT + b * CL + cc * 128 : b * SEQ + (cc - 2) * 128; }
constexpr int SC_VEC = 0;
constexpr int SC_KT = 2048;
constexpr int SC_VF = SC_KT + 64 * 136 * 2;
constexpr int SC_VB = SC_VF + 64 * 136 * 2;
constexpr int SC_X = SC_VB + 64 * 136 * 2;
constexpr int SC_SSQ = SC_X + 2048;
constexpr int SC_END = SC_SSQ + 8192;
constexpr int TS = 136;

DEVI void scan_vectors(const P& p, int l, bool ret, int h, int row0, float* vec, int wid, int lane) {
    const float* dt = (const float*)(p.ws + WS_DT);
    if (ret) {
        if (wid == 0) { const float lf = IN(15)[l * 8 + h], lb = IN(15)[l * 8 + 4 + h];
            const float laf = -log1pf(__expf(-lf)), lab = -log1pf(__expf(-lb));
#pragma unroll
            for (int e = 0; e < 2; ++e) { const int j = lane * 2 + e; vec[j] = (float)(j + 1) * laf; vec[128 + j] = (float)(128 - j) * lab; vec[256 + j] = 1.f; vec[384 + j] = 1.f; } }
    } else if (wid < 2) {
        const int dir = wid; const size_t r = (size_t)(row0 + lane * 2);
        const float x0 = dt[r * 32 + 16 + dir * 8 + h], x1 = dt[(r + 1) * 32 + 16 + dir * 8 + h];
        vec[256 + dir * 128 + lane * 2] = dt[r * 32 + dir * 8 + h]; vec[256 + dir * 128 + lane * 2 + 1] = dt[(r + 1) * 32 + dir * 8 + h];
        float s = x0 + x1;
#pragma unroll
        for (int o = 1; o < 64; o <<= 1) { const float t = __shfl_up(s, o); if (lane >= o) s += t; }
        if (dir == 0) { vec[lane * 2] = s - x1; vec[lane * 2 + 1] = s; }
        else { const float tot = __shfl(s, 63); vec[128 + lane * 2] = tot - (s - x1) + x0; vec[128 + lane * 2 + 1] = tot - s + x1; }
    }
}
DEVI void scan_ptrs(const P& p, bool ret, int h, const bf16*& qb, const bf16*& kb, const bf16*& vb, int& ld) {
    if (ret) { const bf16* proj = (const bf16*)(p.ws + WS_PROJ); qb = proj + C_RQ + h * 64; kb = proj + C_RK + h * 64; vb = proj + C_RV + h * 64; ld = INWP; }
    else { const bf16* xbc = (const bf16*)(p.ws + WS_XBC); qb = xbc + 640 + (h >> 2) * 64; kb = xbc + 512 + (h >> 2) * 64; vb = xbc + h * 64; ld = 768; }
}
DEVI void c3_stage_rows(unsigned char* dst, int rs, const bf16* src, int ld, int tid) {
#pragma unroll
    for (int i = 0; i < 2; ++i) { const int piece = tid + NTHREADS * i, row = piece >> 3, part = piece & 7; *(u32x4*)(dst + row * rs + part * 16) = *(const u32x4*)(src + (size_t)row * ld + part * 8); }
}
struct ConvW { f32x4 w0[2], w1[2], w2[2], b[2]; };
DEVI ConvW conv_w(const float* cw, const float* cb, int c0) { ConvW w;
#pragma unroll
    for (int k = 0; k < 2; ++k) { w.w0[k] = *(const f32x4*)(cw + c0 + 4 * k); w.w1[k] = *(const f32x4*)(cw + 768 + c0 + 4 * k); w.w2[k] = *(const f32x4*)(cw + 1536 + c0 + 4 * k); w.b[k] = *(const f32x4*)(cb + c0 + 4 * k); }
    return w; }
DEVI void unpack8(const u32x4 v, f32x4 (&x)[2]) { x[0] = (f32x4){bf2f(v.x & 0xffff), bf2f(v.x >> 16), bf2f(v.y & 0xffff), bf2f(v.y >> 16)}; x[1] = (f32x4){bf2f(v.z & 0xffff), bf2f(v.z >> 16), bf2f(v.w & 0xffff), bf2f(v.w >> 16)}; }
DEVI void conv8(const bf16* proj, size_t row, bool has_prev, bool has_next, int c0, const ConvW& w, f32x4 (&y)[2]) {
    const bf16* pr = proj + row * INWP + C_XBC + c0; const u32x4 z = {0u, 0u, 0u, 0u};
    const u32x4 r0 = *(const u32x4*)pr, rm = has_prev ? *(const u32x4*)(pr - INWP) : z, rp = has_next ? *(const u32x4*)(pr + INWP) : z;
    f32x4 x0[2], xm[2], xp[2]; unpack8(r0, x0); unpack8(rm, xm); unpack8(rp, xp);
#pragma unroll
    for (int k = 0; k < 2; ++k) { y[k] = w.w0[k] * xm[k] + w.w1[k] * x0[k] + w.w2[k] * xp[k] + w.b[k];
#pragma unroll
        for (int i = 0; i < 4; ++i) y[k][i] = siluf(y[k][i]); }
}
DEVI u32x4 pack8(const f32x4 (&y)[2], float sc) { return (u32x4){pk2(y[0][0] * sc, y[0][1] * sc), pk2(y[0][2] * sc, y[0][3] * sc), pk2(y[1][0] * sc, y[1][1] * sc), pk2(y[1][2] * sc, y[1][3] * sc)}; }
constexpr int SA_RS = 192, SA_K = 8192, SA_VF = SA_K + 128 * SA_RS, SA_VB = SA_VF + 128 * SA_RS, SA_END = SA_VB + 128 * SA_RS;
DEVI void scanA_unit(const P& p, int l, int uidx, unsigned char* lds) {
    const int tid = otid(), wid = __builtin_amdgcn_readfirstlane(tid >> 6), lane = tid & 63, r32 = lane & 31, hi = lane >> 5;
    const int g4 = uidx % 3, bc = uidx / 3, b = bc / NCC, cc = bc % NCC, row0 = chunk_row0(b, cc);
    const bool ret = (g4 == 0);
    float* vec4 = (float*)(lds + SC_VEC);
    float* ST = (float*)(p.ws + WS_ST); float* CDp = (float*)(p.ws + WS_CD);
    const bf16* proj = (const bf16*)(p.ws + WS_PROJ); bf16* xbcw = (bf16*)(p.ws + WS_XBC); const float* cw = IN(16) + (size_t)l * 3 * 768; const float* cb = IN(17) + l * 768;
    const int troff = (4 * hi + ((lane & 15) >> 2)) * SA_RS + (16 * ((lane >> 4) & 1) + 4 * (lane & 3)) * 2;
    __syncthreads();
    { const int hq = wid >> 1, h = ret ? hq : (g4 - 1) * 4 + hq; scan_vectors(p, l, ret, h, row0, vec4 + hq * 512, wid & 1, lane); }
    __syncthreads();
    { const int hq = tid >> 7, t = tid & 127, h = ret ? hq : (g4 - 1) * 4 + hq, hh = ret ? hq : 4 + h; const size_t item = (size_t)(b * NCC + cc) * 12 + hh; const float* vv = vec4 + hq * 512;
      float* vg = (float*)(p.ws + WS_VEC) + item * 512; vg[t] = vv[t]; vg[128 + t] = vv[128 + t]; vg[256 + t] = vv[t] - __logf(vv[256 + t]); vg[384 + t] = vv[128 + t] - __logf(vv[384 + t]);
      if (t == 0) { CDp[item * 2] = __expf(vv[127]); CDp[item * 2 + 1] = __expf(vv[128]); } }
    for (int hq = 0; hq < 4; ++hq) {
        const int h = ret ? hq : (g4 - 1) * 4 + hq, hh = ret ? hq : 4 + h; const size_t item = (size_t)(b * NCC + cc) * 12 + hh;
        const bf16 *qb, *kb, *vb; int ld; scan_ptrs(p, ret, h, qb, kb, vb, ld);
        const float* vec = vec4 + hq * 512;
        if (hq > 0) __syncthreads();
        if (ret) {
            c3_stage_rows(lds + SA_K, SA_RS, kb + (size_t)row0 * ld, ld, tid);
#pragma unroll
            for (int i = 0; i < 2; ++i) { const int piece = tid + NTHREADS * i, j = piece >> 3, part = piece & 7; const u32x4 v = *(const u32x4*)(vb + (size_t)(row0 + j) * ld + part * 8);
                const float sf = __expf(vec[127] - vec[j]) * vec[256 + j], sb = __expf(vec[128] - vec[128 + j]) * vec[384 + j];
                f32x4 x[2]; unpack8(v, x);
                *(u32x4*)(lds + SA_VF + j * SA_RS + part * 16) = pack8(x, sf); *(u32x4*)(lds + SA_VB + j * SA_RS + part * 16) = pack8(x, sb); }
        } else {
            const int g = g4 - 1, part = tid & 7; const int pos0 = (cc < 2) ? cc * 128 : (cc - 2) * 128, Ls = (cc < 2) ? CL : SEQ;
            if (hq == 0) {
#pragma unroll 1
                for (int which = 0; which < 2; ++which) { const int c0 = (which == 0 ? 512 : 640) + g * 64 + part * 8; const ConvW w = conv_w(cw, cb, c0);
#pragma unroll
                    for (int i = 0; i < 2; ++i) { const int j = (tid + NTHREADS * i) >> 3; f32x4 y[2]; conv8(proj, (size_t)(row0 + j), pos0 + j > 0, pos0 + j < Ls - 1, c0, w, y);
                        const u32x4 o = pack8(y, 1.f); *(u32x4*)(xbcw + (size_t)(row0 + j) * 768 + c0) = o; if (which == 0) *(u32x4*)(lds + SA_K + j * SA_RS + part * 16) = o; } } }
            { const int c0 = h * 64 + part * 8; const ConvW w = conv_w(cw, cb, c0);
#pragma unroll
              for (int i = 0; i < 2; ++i) { const int j = (tid + NTHREADS * i) >> 3; f32x4 y[2]; conv8(proj, (size_t)(row0 + j), pos0 + j > 0, pos0 + j < Ls - 1, c0, w, y);
                  const float sf = __expf(vec[127] - vec[j]) * vec[256 + j], sb = __expf(vec[128] - vec[128 + j]) * vec[384 + j];
                  *(u32x4*)(xbcw + (size_t)(row0 + j) * 768 + c0) = pack8(y, 1.f);
                  *(u32x4*)(lds + SA_VF + j * SA_RS + part * 16) = pack8(y, sf); *(u32x4*)(lds + SA_VB + j * SA_RS + part * 16) = pack8(y, sb); } }
        }
        __syncthreads();
        const int dir = wid >> 2, nt = (wid >> 1) & 1, pt = wid & 1;
        const unsigned char* ka = lds + SA_K + nt * 64 + troff; const unsigned char* va = lds + (dir ? SA_VB : SA_VF) + pt * 64 + troff;
        f32x16 acc;
#pragma unroll
        for (int r = 0; r < 16; ++r) acc[r] = 0.f;
#pragma unroll
        for (int s = 0; s < 8; ++s) { const v4i16_t al = lds_tr(ka + (16 * s) * SA_RS), ah = lds_tr(ka + (16 * s + 8) * SA_RS), bl = lds_tr(va + (16 * s) * SA_RS), bh = lds_tr(va + (16 * s + 8) * SA_RS);
            const bf16x8 af = {al[0], al[1], al[2], al[3], ah[0], ah[1], ah[2], ah[3]}, bf = {bl[0], bl[1], bl[2], bl[3], bh[0], bh[1], bh[2], bh[3]};
            acc = __builtin_amdgcn_mfma_f32_32x32x16_bf16(af, bf, acc, 0, 0, 0); }
        float* o = ST + (item * 2 + dir) * 4096 + (size_t)(pt * 32 + r32) * 64 + nt * 32 + 4 * hi;
#pragma unroll
        for (int g = 0; g < 4; ++g) *(f32x4*)(o + 8 * g) = (f32x4){acc[4 * g], acc[4 * g + 1], acc[4 * g + 2], acc[4 * g + 3]};
    }
    __syncthreads();
}
DEVI void scanB_slab(const P& p, int slab, int nthr, int epb) {
    const int tid = otid(); if (tid >= nthr) return;
    const int f = slab * epb + tid * 2; const int bhd = f >> 12, e = f & 4095, dir = bhd & 1, bh = bhd >> 1, b = bh / 12, hh = bh % 12;
    const float* ST = (const float*)(p.ws + WS_ST); const float* CDp = (const float*)(p.ws + WS_CD); bf16* HT = (bf16*)(p.ws + WS_HT);
    f32x2 H = {0.f, 0.f};
    for (int base = 0; base < NCC; base += 6) {
        f32x2 s[6]; float d[6]; size_t off[6];
#pragma unroll
        for (int i = 0; i < 6; ++i) { const int step = base + i; const int cc = dir == 0 ? step : (step < 2 ? 1 - step : 67 - step);
            const size_t item = (size_t)(b * NCC + cc) * 12 + hh; off[i] = (item * 2 + dir) * 4096 + e; s[i] = *(const f32x2*)(ST + off[i]); d[i] = CDp[item * 2 + dir]; }
#pragma unroll
        for (int i = 0; i < 6; ++i) { *(unsigned*)(HT + off[i]) = pk2(H[0], H[1]); H = H * d[i] + s[i]; }
    }
}
constexpr int C3_RSV = 192, C3_RSK = 144;
constexpr int C3_V = 0, C3_K = 2 * 128 * C3_RSV, C3_H = C3_K + 2 * 128 * C3_RSK, C3_VEC = C3_H + 2 * 128 * C3_RSK, C3_X = C3_VEC + 2 * 2048, C3_END = C3_X + 1024;
template <bool RET>
DEVI void scanC_unit(const P& p, int l, int bc, unsigned char* lds, int tid, int wid, int lane) {
    const int r32 = lane & 31, hi = lane >> 5;
    const int it_ = wid & 3, hsub = wid >> 2, b = bc / NCC, cc = bc % NCC, row0 = chunk_row0(b, cc);
    const bf16* HT = (const bf16*)(p.ws + WS_HT); const bf16* proj = (const bf16*)(p.ws + WS_PROJ); const bf16* xbc = (const bf16*)(p.ws + WS_XBC); bf16* MIX = (bf16*)(p.ws + WS_HM); const float* VECG = (const float*)(p.ws + WS_VEC);
    const int i = it_ * 32 + r32; const size_t rowi = (size_t)(row0 + i);
    constexpr int ld = RET ? INWP : 768;
    const unsigned char* Vl = lds + C3_V + hsub * 128 * C3_RSV; const unsigned char* Kl = lds + C3_K + hsub * 128 * C3_RSK; const unsigned char* Hl = lds + C3_H + hsub * 128 * C3_RSK; const float* vec = (const float*)(lds + C3_VEC + hsub * 2048);
    const int trq = (lane & 15) >> 2, trp = lane & 3, trg = (lane >> 4) & 1;
    const int troff = (4 * hi + trq) * C3_RSV + (16 * trg + 4 * trp) * 2;
    float ssqk[4] = {0.f, 0.f, 0.f, 0.f};
#pragma unroll 1
    for (int step = 0; step < (RET ? 2 : 4); ++step) {
        __syncthreads();
#pragma unroll
        for (int hs = 0; hs < 2; ++hs) { const int h = RET ? hs * 2 + step : hs * 4 + step, hh = RET ? h : 4 + h; const size_t item = (size_t)(b * NCC + cc) * 12 + hh;
            const bf16* vb = RET ? proj + C_RV + h * 64 : xbc + h * 64; const bf16* kb = RET ? proj + C_RK + h * 64 : xbc + 512 + hs * 64;
            c3_stage_rows(lds + C3_V + hs * 128 * C3_RSV, C3_RSV, vb + (size_t)row0 * ld, ld, tid);
            if (RET || step == 0) c3_stage_rows(lds + C3_K + hs * 128 * C3_RSK, C3_RSK, kb + (size_t)row0 * ld, ld, tid);
            c3_stage_rows(lds + C3_H + hs * 128 * C3_RSK, C3_RSK, HT + item * 2 * 4096, 64, tid);
            if ((tid >> 7) == hs) *(u32x4*)(lds + C3_VEC + hs * 2048 + (tid & 127) * 16) = *(const u32x4*)(VECG + item * 512 + (tid & 127) * 4); }
        __syncthreads();
        const int h = RET ? hsub * 2 + step : hsub * 4 + step;
        const bf16* qb = RET ? proj + C_RQ + h * 64 : xbc + 640 + hsub * 64;
        bf16x8 qf[4];
#pragma unroll
        for (int s = 0; s < 4; ++s) qf[s] = *(const bf16x8*)(qb + rowi * ld + s * 16 + hi * 8);
        const float Afi = vec[i], Bbi = vec[128 + i];
        f32x16 y0, y1;
#pragma unroll
        for (int r = 0; r < 16; ++r) { y0[r] = 0.f; y1[r] = 0.f; }
#pragma unroll 2
        for (int jt = 0; jt < 4; ++jt) {
            f32x16 st;
#pragma unroll
            for (int r = 0; r < 16; ++r) st[r] = 0.f;
#pragma unroll
            for (int s = 0; s < 4; ++s) { const bf16x8 kf = *(const bf16x8*)(Kl + (jt * 32 + r32) * C3_RSK + (s * 16 + hi * 8) * 2); st = __builtin_amdgcn_mfma_f32_32x32x16_bf16(kf, qf[s], st, 0, 0, 0); }
#pragma unroll
            for (int g = 0; g < 4; ++g) { const int j0 = jt * 32 + 8 * g + 4 * hi;
                const f32x4 afp = *(const f32x4*)(vec + 256 + j0), bbp = *(const f32x4*)(vec + 384 + j0);
#pragma unroll
                for (int e = 0; e < 4; ++e) { const int j = j0 + e; float f;
                    if (jt < it_) f = __expf(Afi - afp[e]);
                    else if (jt > it_) f = __expf(Bbi - bbp[e]);
                    else { const float ff = (j <= i) ? __expf(Afi - afp[e]) : 0.f; const bool bm = RET ? (j > i) : (j >= i); const float fb = bm ? __expf(Bbi - bbp[e]) : 0.f; f = ff + fb; }
                    st[4 * g + e] *= f; } }
#pragma unroll
            for (int s2 = 0; s2 < 2; ++s2) {
                u32x4 pw; pw.x = pk2(st[8 * s2 + 0], st[8 * s2 + 1]); pw.y = pk2(st[8 * s2 + 2], st[8 * s2 + 3]); pw.z = pk2(st[8 * s2 + 4], st[8 * s2 + 5]); pw.w = pk2(st[8 * s2 + 6], st[8 * s2 + 7]);
                const bf16x8 pb = __builtin_bit_cast(bf16x8, pw);
#pragma unroll
                for (int pt = 0; pt < 2; ++pt) { const unsigned char* vp = Vl + (jt * 32 + 16 * s2) * C3_RSV + pt * 64 + troff;
                    const v4i16_t lo = lds_tr(vp), hi2 = lds_tr(vp + 8 * C3_RSV);
                    const bf16x8 va = {lo[0], lo[1], lo[2], lo[3], hi2[0], hi2[1], hi2[2], hi2[3]};
                    if (pt == 0) y0 = __builtin_amdgcn_mfma_f32_32x32x16_bf16(va, pb, y0, 0, 0, 0); else y1 = __builtin_amdgcn_mfma_f32_32x32x16_bf16(va, pb, y1, 0, 0, 0); }
            }
        }
        { const float ef = __expf(Afi), eb = __expf(Bbi);
#pragma unroll
          for (int pt = 0; pt < 2; ++pt) { f32x16 tf, tb;
#pragma unroll
              for (int r = 0; r < 16; ++r) { tf[r] = 0.f; tb[r] = 0.f; }
              const unsigned char* hf = Hl + (pt * 32 + r32) * C3_RSK + hi * 16;
#pragma unroll
              for (int s = 0; s < 4; ++s) { tf = __builtin_amdgcn_mfma_f32_32x32x16_bf16(*(const bf16x8*)(hf + s * 32), qf[s], tf, 0, 0, 0); tb = __builtin_amdgcn_mfma_f32_32x32x16_bf16(*(const bf16x8*)(hf + 64 * C3_RSK + s * 32), qf[s], tb, 0, 0, 0); }
#pragma unroll
              for (int r = 0; r < 16; ++r) { if (pt == 0) y0[r] += ef * tf[r] + eb * tb[r]; else y1[r] += ef * tf[r] + eb * tb[r]; } } }
        float* Tw = (float*)(lds + (wid < 5 ? C3_V + wid * 8704 : C3_H + (wid - 5) * 8704));
        __syncthreads();
        if (RET) {
            float s1 = 0.f, s2 = 0.f;
#pragma unroll
            for (int r = 0; r < 16; ++r) { y0[r] *= 0.125f; y1[r] *= 0.125f; s1 += y0[r] + y1[r]; s2 += y0[r] * y0[r] + y1[r] * y1[r]; }
            s1 += __shfl_xor(s1, 32); s2 += __shfl_xor(s2, 32);
            const float mu = s1 * (1.f / 64.f), var = fmaxf(s2 * (1.f / 64.f) - mu * mu, 0.f), rs = 1.0f / sqrtf(var + EPS);
#pragma unroll
            for (int r = 0; r < 16; ++r) { y0[r] = (y0[r] - mu) * rs; y1[r] = (y1[r] - mu) * rs; }
        }
#pragma unroll
        for (int g = 0; g < 4; ++g) { *(f32x4*)(Tw + r32 * 68 + 8 * g + 4 * hi) = (f32x4){y0[4 * g], y0[4 * g + 1], y0[4 * g + 2], y0[4 * g + 3]}; *(f32x4*)(Tw + r32 * 68 + 32 + 8 * g + 4 * hi) = (f32x4){y1[4 * g], y1[4 * g + 1], y1[4 * g + 2], y1[4 * g + 3]}; }
        asm volatile("s_waitcnt lgkmcnt(0)" ::: "memory");
        { const int ch = lane & 7; const float dsk = RET ? 0.f : IN(20)[l * 8 + h];
#pragma unroll
          for (int k = 0; k < 4; ++k) { const int tr = (lane >> 3) + 8 * k; const size_t rowt = (size_t)(row0 + it_ * 32 + tr);
              f32x4 ya[2] = {*(const f32x4*)(Tw + tr * 68 + ch * 8), *(const f32x4*)(Tw + tr * 68 + ch * 8 + 4)};
              if (RET) { f32x4 gv[2]; unpack8(*(const u32x4*)(proj + rowt * INWP + C_RG + h * 64 + ch * 8), gv);
#pragma unroll
                  for (int q = 0; q < 2; ++q)
#pragma unroll
                      for (int e = 0; e < 4; ++e) ya[q][e] *= siluf(gv[q][e]);
                  *(u32x4*)(MIX + rowt * D + 256 + h * 64 + ch * 8) = pack8(ya, 1.f);
              } else { f32x4 xv[2], zv[2]; unpack8(*(const u32x4*)(xbc + rowt * 768 + h * 64 + ch * 8), xv); unpack8(*(const u32x4*)(proj + rowt * INWP + C_Z + h * 64 + ch * 8), zv); float sq = 0.f;
#pragma unroll
                  for (int q = 0; q < 2; ++q)
#pragma unroll
                      for (int e = 0; e < 4; ++e) { ya[q][e] = (ya[q][e] + xv[q][e] * dsk) * siluf(zv[q][e]); sq += ya[q][e] * ya[q][e]; }
                  *(u32x4*)(MIX + rowt * D + 512 + h * 64 + ch * 8) = pack8(ya, 1.f);
                  sq += __shfl_xor(sq, 1); sq += __shfl_xor(sq, 2); sq += __shfl_xor(sq, 4); ssqk[k] += sq; } } }
    }
    if (!RET) {
        float* X = (float*)(lds + C3_X);
#pragma unroll
        for (int k = 0; k < 4; ++k) if ((lane & 7) == 0) X[hsub * 128 + it_ * 32 + (lane >> 3) + 8 * k] = ssqk[k];
        asm volatile("s_waitcnt vmcnt(0)" ::: "memory");
        __syncthreads();
        const float* nw = IN(21) + l * 512; const int ch = lane & 7;
#pragma unroll 1
        for (int h = hsub * 4; h < hsub * 4 + 4; ++h) { f32x4 wv[2] = {*(const f32x4*)(nw + h * 64 + ch * 8), *(const f32x4*)(nw + h * 64 + ch * 8 + 4)};
#pragma unroll
            for (int k = 0; k < 4; ++k) { const int tr = it_ * 32 + (lane >> 3) + 8 * k; const float rstd = 1.0f / sqrtf((X[tr] + X[128 + tr]) * (1.f / 512.f) + EPS);
                bf16* mp = MIX + (size_t)(row0 + tr) * D + 512 + h * 64 + ch * 8; f32x4 v[2]; unpack8(*(const u32x4*)mp, v);
                v[0] = v[0] * wv[0] * rstd; v[1] = v[1] * wv[1] * rstd; *(u32x4*)mp = pack8(v, 1.f); } }
    }
    __syncthreads();
}
DEVI void ph_scanC(const P& p, int l, unsigned char* lds) {
    const int tid = otid(), wid = __builtin_amdgcn_readfirstlane(tid >> 6), lane = tid & 63;
    const int NU = 2 * NCC;
    if (gridDim.x == 256) {
        const int c = blockIdx.x;
        if (c < NU) scanC_unit<false>(p, l, c, lds, tid, wid, lane);
        else { const int r = c - NU; scanC_unit<true>(p, l, r, lds, tid, wid, lane); if (r + 124 < NU) scanC_unit<true>(p, l, r + 124, lds, tid, wid, lane); }
    } else {
        for (int u = blockIdx.x; u < 2 * NU; u += gridDim.x) { if (u < NU) scanC_unit<false>(p, l, u, lds, tid, wid, lane); else scanC_unit<true>(p, l, u - NU, lds, tid, wid, lane); }
    }
}
DEVI void ph_scanA(const P& p, int l, unsigned char* lds) { for (int u = blockIdx.x; u < 2 * NCC * 3; u += gridDim.x) scanA_unit(p, l, u, lds); }
DEVI void ph_mixer(const P& p, int l, unsigned char* lds) {
    for (int u = blockIdx.x; u < 256; u += gridDim.x) scanB_slab(p, u, 384, 768);
    for (int a = blockIdx.x; a < 256; a += gridDim.x) attn_unit<0>(p, (a & 7) * 32 + (a >> 3), lds, (bf16*)(p.ws + WS_HM));
#if ATTN_PROBE
    if (l == 0) { __syncthreads(); for (int a = blockIdx.x; a < 256; a += gridDim.x) attn_unit<ATTN_PROBE>(p, (a & 7) * 32 + (a >> 3), lds, (bf16*)p.out); }
#endif
    if (l == 0) for (int a = blockIdx.x; a < 8; a += gridDim.x) attn_unit<0>(p, 256 + a, lds, (bf16*)(p.ws + WS_HM));
}

DEVI void ph_sort(const P& p, unsigned char* lds) {
    const int tid = otid(), wid = tid >> 6, lane = tid & 63;
    const int* rt_e = (const int*)(p.ws + WS_RT); int* rt_pos = (int*)(p.ws + WS_RT + 256 * 1024); int* tab = (int*)(p.ws + WS_RT + 384 * 1024); int* rt_tok = (int*)(p.ws + WS_RT + 640 * 1024);
    int* sh = (int*)lds;
    const int G = gridDim.x, R = (NLAT + G - 1) / G;
    for (int blk = blockIdx.x; blk * R < NLAT; blk += G) {
        const int r0 = blk * R, r1 = (r0 + R < NLAT) ? r0 + R : NLAT;
        int ct[8], cb[8];
#pragma unroll
        for (int e = 0; e < 8; ++e) { ct[e] = 0; cb[e] = 0; }
        for (int i = tid; i < NLAT * 2; i += NTHREADS) { const int e = rt_e[i]; const bool bef = (i >> 1) < r0;
#pragma unroll
            for (int x = 0; x < 8; ++x) { const int hit = (e == x) ? 1 : 0; ct[x] += hit; cb[x] += bef ? hit : 0; } }
#pragma unroll
        for (int e = 0; e < 8; ++e) {
#pragma unroll
            for (int o = 1; o < 64; o <<= 1) { ct[e] += __shfl_xor(ct[e], o); cb[e] += __shfl_xor(cb[e], o); }
        }
        __syncthreads();
        if (lane == 0) {
#pragma unroll
            for (int e = 0; e < 8; ++e) { sh[wid * 8 + e] = ct[e]; sh[64 + wid * 8 + e] = cb[e]; } }
        __syncthreads();
        if (tid == 0) { int start = 0, nt = 0;
            for (int e = 0; e < 8; ++e) { int tot = 0, bef = 0; for (int w = 0; w < 8; ++w) { tot += sh[w * 8 + e]; bef += sh[64 + w * 8 + e]; }
                sh[128 + e] = start; sh[136 + e] = start + bef; sh[144 + e] = tot; const int ntile = (tot + 255) >> 8;
                if (blk == 0) { for (int t = 0; t < ntile; ++t) tab[1 + nt + t] = e; }
                nt += ntile; start += ntile * 256; }
            if (blk == 0) tab[0] = nt; }
        __syncthreads();
        { const int n_ent = (r1 - r0) * 2; const bool valid = tid < n_ent; const int e = valid ? rt_e[r0 * 2 + tid] : -1; int rank = 0;
#pragma unroll
          for (int x = 0; x < 8; ++x) { const unsigned long long m = __ballot(e == x); if (e == x) rank = __popcll(m & ((1ull << lane) - 1ull)); if (lane == 0) sh[160 + wid * 8 + x] = __popcll(m); }
          __syncthreads();
          if (valid) { int pos = sh[136 + e] + rank; for (int w = 0; w < wid; ++w) pos += sh[160 + w * 8 + e]; sh[256 + tid] = pos; rt_pos[r0 * 2 + tid] = pos; } }
        __syncthreads();
        { const int n_ent = (r1 - r0) * 2; if (tid < n_ent) rt_tok[sh[256 + tid]] = r0 + (tid >> 1); }
        if (blk == 0) { for (int e = 0; e < 8; ++e) { const int tot = sh[144 + e], beg = sh[128 + e] + tot, end = sh[128 + e] + ((tot + 255) & ~255); for (int i = beg + tid; i < end; i += NTHREADS) rt_tok[i] = 0; } }
        __syncthreads();
    }
}
DEVI void ph_final(const P& p) {
    const int tid = otid(), wid = tid >> 6, lane = tid & 63;
    const float* rt_g = (const float*)(p.ws + WS_RT + 128 * 1024); const int* rt_pos = (const int*)(p.ws + WS_RT + 256 * 1024);
    const bf16* YS = (const bf16*)(p.ws + WS_HS); const float* modv = (const float*)(p.ws + WS_MODV) + (size_t)1 * 3 * 6144; const float* fw = IN(29);
    const int nw = gridDim.x * NWAVES, rpw = (NLAT + nw - 1) / nw, gw = blockIdx.x * NWAVES + wid;
    const int row0 = gw * rpw, row1 = (row0 + rpw < NLAT) ? row0 + rpw : NLAT;
    f32x4 fwv[4], gv[4]; int rc = -1;
#pragma unroll
    for (int j = 0; j < 4; ++j) fwv[j] = *(const f32x4*)(fw + (j * 64 + lane) * 4);
    for (int row = row0; row < row1; ++row) {
        const int b = row >> 13; float* x = p.out + (size_t)row * D;
        if (b != rc) { rc = b;
#pragma unroll
            for (int j = 0; j < 4; ++j) gv[j] = *(const f32x4*)(modv + b * 6144 + 5 * 1024 + (j * 64 + lane) * 4); }
        const float g0 = rt_g[row * 2], g1 = rt_g[row * 2 + 1]; const bf16* y0 = YS + (size_t)rt_pos[row * 2] * D; const bf16* y1 = YS + (size_t)rt_pos[row * 2 + 1] * D;
        f32x4 v[4]; float ss = 0.f;
#pragma unroll
        for (int j = 0; j < 4; ++j) { const int c0 = (j * 64 + lane) * 4; const f32x4 xv = *(const f32x4*)(x + c0); const u32x2 a = *(const u32x2*)(y0 + c0), c = *(const u32x2*)(y1 + c0);
            const f32x4 ya = {bf2f(a.x & 0xffff), bf2f(a.x >> 16), bf2f(a.y & 0xffff), bf2f(a.y >> 16)}, yb = {bf2f(c.x & 0xffff), bf2f(c.x >> 16), bf2f(c.y & 0xffff), bf2f(c.y >> 16)};
            v[j] = xv + gv[j] * (ya * g0 + yb * g1); ss += v[j][0] * v[j][0] + v[j][1] * v[j][1] + v[j][2] * v[j][2] + v[j][3] * v[j][3]; }
        ss = wave_sum(ss); const float rstd = 1.0f / sqrtf(ss * (1.f / D) + EPS);
#pragma unroll
        for (int j = 0; j < 4; ++j) { const int c0 = (j * 64 + lane) * 4; *(f32x4*)(x + c0) = v[j] * rstd * fwv[j]; }
    }
}

#define XB_TMO      128
#define XB_XCNT(j)  (256  + 64 * (j))
#define XB_XSUB(j)  (1280 + 64 * (j))
#define XB_XGEN(j)  (2304 + 64 * (j))
#define XB_TOP      3328
#define XB_TOPGEN   3392
#define XCD_BAR_WORDS 3456
#define XB_SPIN_CAP (1u << 22)
DEVI unsigned xb_ld(unsigned* p)              { return __hip_atomic_load(p, __ATOMIC_RELAXED, __HIP_MEMORY_SCOPE_AGENT); }
DEVI unsigned xb_add(unsigned* p, unsigned v) { return __hip_atomic_fetch_add(p, v, __ATOMIC_RELAXED, __HIP_MEMORY_SCOPE_AGENT); }
DEVI unsigned xb_xcc_id() { return (unsigned)__builtin_amdgcn_s_getreg((3 << 11) | 20) & 0xFu; }
#define XB_SPIN(cond, bar) do { unsigned _sp = 0; while (cond) { __builtin_amdgcn_s_sleep(1); \
    if ((++_sp & 255u) == 0u) { if (xb_ld(&(bar)[XB_TMO])) break; if (_sp > XB_SPIN_CAP) { atomicAdd(&(bar)[XB_TMO], 1u); break; } } } } while (0)
struct XcdBarrier { unsigned* bar; unsigned x; volatile LAS unsigned* st; };
DEVI XcdBarrier xcd_barrier_post(unsigned* bar, volatile LAS unsigned* st) {
    XcdBarrier b; b.bar = bar; b.x = xb_xcc_id(); b.st = st;
    if (threadIdx.x == 0) (void)xb_add(&bar[XB_XCNT(b.x)], 1u);
    return b;
}
DEVI void xcd_barrier_complete(unsigned* bar, unsigned x, unsigned& nloc, unsigned& nx) {
    const unsigned G = gridDim.x * gridDim.y * gridDim.z;
    unsigned sum, cnt, mine, sp = 0u;
    for (;;) {
        sum = 0u; cnt = 0u; mine = 0u;
#pragma unroll
        for (unsigned j = 0; j < 16; ++j) { const unsigned c = xb_ld(&bar[XB_XCNT(j)]); sum += c; cnt += (c > 0u) ? 1u : 0u; mine = (j == x) ? c : mine; }
        if (sum == G) break;
        __builtin_amdgcn_s_sleep(1);
        if ((++sp & 255u) == 0u) { if (xb_ld(&bar[XB_TMO])) break; if (sp > XB_SPIN_CAP) { atomicAdd(&bar[XB_TMO], 1u); break; } }
    }
    nloc = mine > 0u ? mine : 1u; nx = cnt > 0u ? cnt : 1u;
}
DEVI void xcd_barrier(const XcdBarrier& b) {
    asm volatile("s_waitcnt vmcnt(0)" ::: "memory");
    __syncthreads();
    if (threadIdx.x == 0) {
        unsigned* bar = b.bar;
        __builtin_amdgcn_s_waitcnt(0);
        unsigned nloc = b.st[0], nx = b.st[1];
        if (nloc == 0u) { xcd_barrier_complete(bar, b.x, nloc, nx); b.st[0] = nloc; b.st[1] = nx; }
        const unsigned old = xb_add(&bar[XB_XSUB(b.x)], 1u);
        const unsigned gen = old / nloc;
        if (old + 1u == (gen + 1u) * nloc) {
            __builtin_amdgcn_fence(__ATOMIC_RELEASE, "agent");
            asm volatile("s_waitcnt vmcnt(0)" ::: "memory");
            const unsigned og = xb_add(&bar[XB_TOP], 1u);
            const unsigned tg = og / nx;
            if (og + 1u == (tg + 1u) * nx) xb_add(&bar[XB_TOPGEN], 1u);
            else XB_SPIN(xb_ld(&bar[XB_TOPGEN]) == tg, bar);
            __builtin_amdgcn_fence(__ATOMIC_ACQUIRE, "agent");
            xb_add(&bar[XB_XGEN(b.x)], 1u);
            asm volatile("s_waitcnt vmcnt(0)" ::: "memory");
        } else {
            XB_SPIN(xb_ld(&bar[XB_XGEN(b.x)]) == gen, bar);
            __builtin_amdgcn_fence(__ATOMIC_ACQUIRE, "agent");
            asm volatile("s_waitcnt vmcnt(0)" ::: "memory");
        }
    }
    __syncthreads();
}

constexpr int NPHASES = 21;
#ifndef XSYNC
#define XSYNC 0
#endif
#ifndef REP_MASK
#define REP_MASK 0u
#endif
#ifndef PH_MASK
#define PH_MASK 0xffffu
#endif
__global__ void __launch_bounds__(NTHREADS, 2) mk_fwd(P p) {
    extern __shared__ __attribute__((aligned(16))) unsigned char lds[];
    cg::grid_group grid = cg::this_grid();
    const int G = gridDim.x, c = blockIdx.x;
    if (threadIdx.x < 30) ((lds_u64*)(uintptr_t)LDS_PTRS)[threadIdx.x] = (unsigned long long)p.in[threadIdx.x];
    if (threadIdx.x < 2) ((volatile LAS unsigned*)(uintptr_t)LDS_MISC)[threadIdx.x] = 0u;
    __syncthreads();
    XcdBarrier xbar = xcd_barrier_post((unsigned*)(p.ws + WS_CTL) + 1024, (volatile LAS unsigned*)(uintptr_t)LDS_MISC);
    int nsync = 0;
#define GRID_BAR() do { if (nsync == 0) grid.sync(); else xcd_barrier(xbar); ++nsync; } while (0)
    int ph = 0;
#define RUN(kid, ...) do { if (((PH_MASK >> (kid)) & 1u) && ph >= p.ph_lo && ph < p.ph_hi) { __VA_ARGS__; if ((REP_MASK >> (kid)) & 1u) { __VA_ARGS__; } if (ph + 1 < p.ph_hi) { GRID_BAR(); for (int xs_ = 0; xs_ < XSYNC; ++xs_) GRID_BAR(); } } ++ph; } while (0)
    RUN(0, ph_pro(p, lds));
#define LAYER(l) \
        RUN(1, ph_norm<false>(p, l, 0, T, lds, l == 1 ? 11 : 0, 5)); \
        RUN(2, { Gemm g{(const bf16*)(p.ws + WS_HM), (const bf16*)(p.ws + WS_WIN) + (size_t)l * INWP * 1024, 0, nullptr}; DenseSched S{T / 256, INWP / 256, G, c}; \
            EpiInProj E{(bf16*)(p.ws + WS_PROJ), (float*)(p.ws + WS_DT), IN(18) + l * 16, IN(19) + l * 16, (float*)(p.ws + WS_RQP), (float*)(p.ws + WS_RKVP)}; gemm_phase<D, 1024, 1024>(lds, g, S, E); }); \
        RUN(4, { Gemm g{(const bf16*)(p.ws + WS_PROJ), (const bf16*)(p.ws + WS_WQKV) + (size_t)l * 1024 * 384, 0, nullptr}; DenseSched S{T / 256, 4, G, c}; \
            EpiMla E{(bf16*)(p.ws + WS_Q), (bf16*)(p.ws + WS_K), (bf16*)(p.ws + WS_V), (const float*)(p.ws + WS_RQP), (const float*)(p.ws + WS_RKVP), (const float*)(p.ws + WS_ROPE), (const bf16*)(p.ws + WS_PROJ)}; gemm_phase<INWP, 384, 384>(lds, g, S, E); ph_scanA(p, l, lds); }); \
        RUN(5, ph_mixer(p, l, lds)); \
        RUN(6, ph_scanC(p, l, lds)); \
        RUN(8, { Gemm g{(const bf16*)(p.ws + WS_HM), (const bf16*)(p.ws + WS_WOUT) + (size_t)l * 1024 * 1024, 0, nullptr}; DenseSched S{NLAT / 256, 4, G, c}; \
            EpiResid E{l == 0 ? IN(0) : p.out, (const float*)(p.ws + WS_XC), p.out, (float*)(p.ws + WS_XC), (const float*)(p.ws + WS_MODV) + (size_t)l * 3 * 6144, 2}; gemm_phase<D, 1024, 1024>(lds, g, S, E); \
            if (l == 0) { CtxSplitSched S2{4, 256 * 2, G, c}; EpiPart E2{(float*)(p.ws + WS_XBC)}; gemm_phase<D, 1024, 256>(lds, g, S2, E2); } }); \
        RUN(9, ph_norm<l == 1>(p, l, 1, l == 0 ? T : NLAT, lds, l == 0 ? 4 : 0, 2)); \
        if (l == 0) { \
            RUN(10, { Gemm g{(const bf16*)(p.ws + WS_HM), (const bf16*)(p.ws + WS_WGU), 0, nullptr}; DenseSched S{T / 256, 2 * DFF / 256, G, c}; \
                EpiSwiglu E{(bf16*)(p.ws + WS_PROJ), DFF}; gemm_phase<D, 1024, 1024>(lds, g, S, E); }); \
            RUN(11, { Gemm g{(const bf16*)(p.ws + WS_PROJ), (const bf16*)(p.ws + WS_WD), 0, nullptr}; DenseSched S{NLAT / 256, 4, G, c}; \
                EpiResid E{p.out, (const float*)(p.ws + WS_XC), p.out, (float*)(p.ws + WS_XC), (const float*)(p.ws + WS_MODV), 5}; gemm_phase<DFF, DFF, DFF>(lds, g, S, E); \
                CtxSplitSched S2{11, 256 * 2, G, c}; EpiPart E2{(float*)(p.ws + WS_XBC)}; gemm_phase<DFF, DFF, 256>(lds, g, S2, E2); }); \
        } else { \
            RUN(12, { ph_sort(p, lds); __syncthreads(); ph_moew(p, lds); }); \
            RUN(13, { Gemm g{(const bf16*)(p.ws + WS_HM), (const bf16*)(p.ws + WS_WGUE), (size_t)2 * DFE * 1024, (const int*)(p.ws + WS_RT + 640 * 1024)}; MoeSched S{(const int*)(p.ws + WS_RT + 384 * 1024), 2 * DFE / 256, G, c}; \
                EpiSwiglu E{(bf16*)(p.ws + WS_ACTS), DFE}; gemm_phase<D, 1024, 1024, EpiSwiglu, MoeSched, true>(lds, g, S, E); }); \
            RUN(14, { Gemm g{(const bf16*)(p.ws + WS_ACTS), (const bf16*)(p.ws + WS_WDE), (size_t)1024 * DFE, nullptr}; MoeSched S{(const int*)(p.ws + WS_RT + 384 * 1024), 4, G, c}; \
                EpiStore E{(bf16*)(p.ws + WS_HS), D}; gemm_phase<DFE, DFE, DFE>(lds, g, S, E); }); \
            RUN(15, ph_final(p)); \
        }
    LAYER(0)
    LAYER(1)
#undef LAYER
#undef RUN
}

#ifndef MK_ONE_LAUNCH
#define MK_ONE_LAUNCH 1
#endif
extern "C" void kernel_launch(void* const* d_in, const int* in_sizes, int n_in, void* d_out, int out_size, void* d_ws, size_t ws_size, hipStream_t stream) {
    static int grid = 0;
    if (grid == 0) {
        if (n_in != 30 || out_size != NLAT * D || ws_size < WS_END) { fprintf(stderr, "kernel_launch: unexpected problem (n_in %d out %d ws %zu, need %zu)\n", n_in, out_size, ws_size, (size_t)WS_END); grid = -1; return; }
        int dev = 0, cus = 0, per_cu = 0;
        hipGetDevice(&dev); hipDeviceGetAttribute(&cus, hipDeviceAttributeMultiprocessorCount, dev);
        if (hipFuncSetAttribute((const void*)mk_fwd, hipFuncAttributeMaxDynamicSharedMemorySize, LDS_BYTES) != hipSuccess) { fprintf(stderr, "kernel_launch: hipFuncSetAttribute failed\n"); grid = -1; return; }
        if (hipOccupancyMaxActiveBlocksPerMultiprocessor(&per_cu, (const void*)mk_fwd, NTHREADS, LDS_BYTES) != hipSuccess || per_cu < 1) { fprintf(stderr, "kernel_launch: occupancy query failed (%d)\n", per_cu); grid = -1; return; }
        grid = cus;
        fprintf(stderr, "kernel_launch: grid %d (cus %d, per_cu %d)\n", grid, cus, per_cu);
    }
    if (grid < 0) return;
    if (hipMemsetAsync((char*)d_ws + WS_CTL, 0, 65536, stream) != hipSuccess) { fprintf(stderr, "kernel_launch: memset failed\n"); return; }
    P p{};
    for (int i = 0; i < 30; ++i) p.in[i] = (const float*)d_in[i];
    p.out = (float*)d_out; p.ws = (unsigned char*)d_ws;
#if MK_ONE_LAUNCH
    p.ph_lo = 0; p.ph_hi = NPHASES;
    { void* args[] = {&p}; hipError_t e = hipLaunchCooperativeKernel((const void*)mk_fwd, dim3(grid), dim3(NTHREADS), args, LDS_BYTES, stream);
      if (e != hipSuccess) fprintf(stderr, "cooperative launch failed: %s\n", hipGetErrorString(e)); }
#else
    for (int ph = 0; ph < NPHASES; ++ph) {
        p.ph_lo = ph; p.ph_hi = ph + 1;
        void* args[] = {&p}; hipError_t e = hipLaunchCooperativeKernel((const void*)mk_fwd, dim3(grid), dim3(NTHREADS), args, LDS_BYTES, stream);
        if (e != hipSuccess) { fprintf(stderr, "cooperative launch %d failed: %s\n", ph, hipGetErrorString(e)); break; }
    }
#endif
}
```

```cpp
#include <hip/hip_runtime.h>
#include <hip/hip_cooperative_groups.h>
#include <cstdio>
#include <cstdint>
namespace cg = cooperative_groups;
#ifndef ATTN_PROBE
#define ATTN_PROBE 0
#endif

#define DEVI __device__ __forceinline__
typedef unsigned short bf16;
typedef short bf16x8 __attribute__((ext_vector_type(8)));
typedef float f32x4 __attribute__((ext_vector_type(4)));
typedef float f32x2 __attribute__((ext_vector_type(2)));
typedef float f32x16 __attribute__((ext_vector_type(16)));
typedef unsigned u32x4 __attribute__((ext_vector_type(4)));
typedef unsigned u32x2 __attribute__((ext_vector_type(2)));
typedef __bf16 bf16x2_t __attribute__((ext_vector_type(2)));

constexpr int D = 1024, NB = 2, SEQ = 8192, NLAT = NB * SEQ, CL = 256, NCTX = NB * CL, T = NLAT + NCTX;
constexpr int INW = 2736, INWP = 2816;
constexpr int C_CQ = 0, C_CKV = 256, C_KPE = 384, C_RQ = 416, C_RK = 672, C_RV = 928, C_RG = 1184, C_Z = 1440, C_XBC = 1952, C_DTF = 2720, C_DTB = 2728;
constexpr int DFF = 2816, DFE = 1408, NEXP = 8;
constexpr float EPS = 1e-6f;
constexpr int MOE_MAXROWS = 34816;

constexpr size_t MiB = 1u << 20;
constexpr size_t WS_CTL = 0;
constexpr size_t WS_MODV = 1 * MiB;
constexpr size_t WS_ROPE = WS_MODV + 256 * 1024;
constexpr size_t WS_RQ = WS_MODV + 512 * 1024;
constexpr size_t WS_RKV = WS_MODV + 640 * 1024;
constexpr size_t WS_WIN = 2 * MiB;
constexpr size_t WS_WQKV = 13 * MiB;
constexpr size_t WS_WOUT = 15 * MiB;
constexpr size_t WS_WGU = 19 * MiB;
constexpr size_t WS_WD = 30 * MiB;
constexpr size_t WS_XC = 36 * MiB;
constexpr size_t WS_RT = 38 * MiB;
constexpr size_t WS_DT = 39 * MiB;
constexpr size_t WS_RQP = 41 * MiB + 128 * 1024;
constexpr size_t WS_RKVP = 41 * MiB + 512 * 1024;
constexpr size_t DYN = 42 * MiB;
constexpr size_t WS_HM = DYN;
constexpr size_t WS_PROJ = DYN + 33 * MiB;
constexpr size_t WS_XBC = DYN + 124 * MiB;
constexpr size_t WS_Q = DYN + 149 * MiB;
constexpr size_t WS_K = DYN + 161 * MiB + 512 * 1024;
constexpr size_t WS_V = DYN + 174 * MiB;
constexpr size_t WS_ST = DYN + 182 * MiB + 512 * 1024;
constexpr size_t WS_HT = WS_ST + (size_t)1584 * 2 * 4096 * 4;
constexpr size_t WS_CD = WS_RT + 512 * 1024;
constexpr size_t WS_VEC = WS_HT + (size_t)1584 * 2 * 4096 * 2;
constexpr size_t WS_WGUE = DYN + 33 * MiB;
constexpr size_t WS_WDE = DYN + 77 * MiB;
constexpr size_t WS_HS = DYN + 99 * MiB;
constexpr size_t WS_ACTS = DYN + 167 * MiB;
constexpr size_t WS_END = DYN + 261 * MiB;
static_assert(WS_HM + (size_t)T * 1024 * 2 <= WS_PROJ && WS_PROJ + (size_t)T * 2816 * 2 <= WS_XBC && WS_XBC + (size_t)T * 768 * 2 <= WS_Q &&
              WS_Q + (size_t)T * 384 * 2 <= WS_K && WS_K + (size_t)T * 384 * 2 <= WS_V && WS_V + (size_t)T * 256 * 2 <= WS_ST && WS_VEC + (size_t)1584 * 512 * 4 <= WS_END, "ws map (mixer)");
static_assert(WS_WGUE + (size_t)8 * 2816 * 1024 * 2 <= WS_WDE && WS_WDE + (size_t)8 * 1024 * 1408 * 2 <= WS_HS && WS_HS + (size_t)MOE_MAXROWS * 1024 * 2 <= WS_ACTS &&
              WS_ACTS + (size_t)MOE_MAXROWS * 1408 * 2 <= WS_END, "ws map (moe)");
static_assert(WS_DT + (size_t)T * 32 * 4 <= DYN && WS_WD + (size_t)1024 * 2816 * 2 <= WS_XC && WS_WIN + (size_t)2 * 2816 * 1024 * 2 <= WS_WQKV, "ws map (static)");

constexpr int NTHREADS = 512, NWAVES = 8;
constexpr int LDS_BYTES = 147456;

struct P { const float* in[30]; float* out; unsigned char* ws; int ph_lo, ph_hi; };
constexpr int LDS_MISC = 147456 - 512;
constexpr int LDS_PTRS = 147456 - 256;
typedef __attribute__((address_space(3))) unsigned long long lds_u64;
DEVI const float* inptr(int i) {
    const unsigned long long v = ((lds_u64*)(uintptr_t)LDS_PTRS)[i];
    const unsigned lo = __builtin_amdgcn_readfirstlane((unsigned)v), hi = __builtin_amdgcn_readfirstlane((unsigned)(v >> 32));
    return (const float*)(((unsigned long long)hi << 32) | lo);
}
#define IN(i) inptr(i)
DEVI int otid() { int t = threadIdx.x; asm volatile("" : "+v"(t)); return t; }

DEVI float bf2f(bf16 x) { return __uint_as_float(((unsigned)x) << 16); }
DEVI unsigned pk2(float lo, float hi) { f32x2 v = {lo, hi}; bf16x2_t b = __builtin_convertvector(v, bf16x2_t); return __builtin_bit_cast(unsigned, b); }
DEVI bf16 f2bf(float x) { return (bf16)(pk2(x, 0.f) & 0xffffu); }
DEVI float wave_sum(float v) {
#pragma unroll
    for (int o = 1; o < 64; o <<= 1) v += __shfl_xor(v, o);
    return v;
}
DEVI float siluf(float x) { return x * __builtin_amdgcn_rcpf(1.f + __builtin_amdgcn_exp2f(-1.4426950408889634f * x)); }
DEVI float softplusf(float x) { return fmaxf(x, 0.f) + log1pf(__expf(-fabsf(x))); }
DEVI int rope_src(int p) { const int q = p & 15, s = (q & 1) ? 8 + (q >> 1) : (q >> 1); return (p & 16) + s; }

#define LAS __attribute__((address_space(3)))
struct Unit { int pm, pn, e, koff; };
struct Gemm { const bf16* A; const bf16* Bt; size_t bstride; const int* rowtab; };
constexpr int BM = 256, BK = 64, HALF = 128, HTB = HALF * BK * 2, STAGE_BYTES = 8 * HTB, NXCD = 8, WGM = 8;
__host__ __device__ __forceinline__ int lds_byte(int r, int c) { const int st = (r >> 4) * 2 + (c >> 5), rr = r & 15, cc = c & 31, ob = rr * 64 + cc * 2; return st * 1024 + (ob ^ (((ob >> 9) & 1) << 5)); }
__host__ __device__ __forceinline__ int perm32(int rho) { const int n = rho >> 4, i = rho & 15; return 8 * (i >> 2) + 4 * n + (i & 3); }
__host__ __device__ __forceinline__ void stage_rc(int b, int& R, int& C) { const int st = b / 1024, sb = b % 1024, swz = sb ^ (((sb >> 9) & 1) << 5); R = (st >> 1) * 16 + swz / 64; C = (st & 1) * 32 + (swz % 64) / 2; }
struct DenseSched {
    int nM, nN, G, c;
    DEVI bool next(int i, Unit& u) const {
        const int nwg = nM * nN; const long L = (long)i * G + c; if (L >= nwg) return false;
        int wgid = (int)L; { const int q = nwg / NXCD, r = nwg % NXCD, xcd = wgid % NXCD, off = wgid / NXCD; wgid = (xcd < r ? xcd * (q + 1) : r * (q + 1) + (xcd - r) * q) + off; }
        const int nig = WGM * nN, gid = wgid / nig, fm = gid * WGM, gsz = (nM - fm) < WGM ? (nM - fm) : WGM;
        u.pm = fm + ((wgid % nig) % gsz); u.pn = (wgid % nig) / gsz; u.e = 0; u.koff = 0; return true;
    }
};
struct CtxSplitSched {
    int nsplit, kbytes, G, c;
    DEVI bool next(int i, Unit& u) const { const int id = i * G + c; if (id >= 8 * nsplit) return false; const int tile = id & 7, ks = id >> 3; u.pm = 64 + (tile >> 2); u.pn = tile & 3; u.e = ks; u.koff = ks * kbytes; return true; }
};
struct MoeSched {
    const int* tab; int nN, G, c;
    DEVI bool next(int i, Unit& u) const { DenseSched d{tab[0], nN, G, c}; if (!d.next(i, u)) return false; u.e = tab[1 + u.pm]; return true; }
};
template <int LDA, int LDB, int KK, class Epi, class Sched, bool GATHER = false>
DEVI void gemm_phase(unsigned char* lds_generic, const Gemm g, const Sched& S, const Epi& E) {
    LAS unsigned char* lds = (LAS unsigned char*)lds_generic;
    const int tid = otid(), wid = __builtin_amdgcn_readfirstlane(tid >> 6), lane = tid & 63, wr = wid >> 2, wc = wid & 3, fr = lane & 15, fq = lane >> 4;
    constexpr int nt = KK / BK; static_assert(KK % 128 == 0, "K must be a multiple of 128");
    unsigned voffA[2], voffB[2]; int Rr[2], Cc[2];
#pragma unroll
    for (int i = 0; i < 2; ++i) { int R, C; stage_rc(tid * 16 + i * 8192, R, C); Rr[i] = R; Cc[i] = C; voffA[i] = (unsigned)(R * LDA + C) * 2u; const int Rb = Epi::PERM ? ((R & ~31) + perm32(R & 31)) : R; voffB[i] = (unsigned)(Rb * LDB + C) * 2u; }
    unsigned cv0[2] = {voffA[0], voffA[1]}, cv1[2] = {voffA[0], voffA[1]}, nv0[2] = {voffA[0], voffA[1]}, nv1[2] = {voffA[0], voffA[1]};
#define PG8_ROWS(u, v0, v1) do { if (GATHER) { _Pragma("unroll") for (int i_ = 0; i_ < 2; ++i_) { v0[i_] = (unsigned)(g.rowtab[(u).pm * BM + Rr[i_]] * LDA + Cc[i_]) * 2u; v1[i_] = (unsigned)(g.rowtab[(u).pm * BM + HALF + Rr[i_]] * LDA + Cc[i_]) * 2u; } } } while (0)
    constexpr size_t kstep = (size_t)(BK * 2), hstepA = GATHER ? (size_t)0 : (size_t)HALF * LDA * 2, hstepB = (size_t)HALF * LDB * 2, tstepA = GATHER ? (size_t)0 : (size_t)2 * HALF * LDA * 2, tstepB = 2 * hstepB;
    const unsigned ldsw = (unsigned)wid * 1024u;
    const int aoff = lds_byte(wr * 64 + fr, fq * 8), boff = lds_byte(wc * 32 + fr, fq * 8);
#define PG8_SA(b, h) (((b) * 2 + (h)) * HTB)
#define PG8_SB(b, h) ((4 + (b) * 2 + (h)) * HTB)
#define PG8_STAGE(bufoff, gbase, voff) do { _Pragma("unroll") for (int _i = 0; _i < 2; ++_i) \
        __builtin_amdgcn_global_load_lds((const unsigned*)((const char*)(gbase) + (voff)[_i]), (LAS unsigned*)(lds + (bufoff) + ldsw + _i * 8192), 16, 0, 0); } while (0)
#define PG8_LDA(dst, b, h) do { _Pragma("unroll") for (int m = 0; m < 4; ++m) _Pragma("unroll") for (int k = 0; k < 2; ++k) dst[m][k] = *(const LAS bf16x8*)(lds + PG8_SA(b, h) + aoff + m * 2048 + k * 1024); } while (0)
#define PG8_LDB(dst, b, h) do { _Pragma("unroll") for (int n = 0; n < 2; ++n) _Pragma("unroll") for (int k = 0; k < 2; ++k) dst[n][k] = *(const LAS bf16x8*)(lds + PG8_SB(b, h) + boff + n * 2048 + k * 1024); } while (0)
#define PG8_MMA(ai, bj, At, Bt) do { __builtin_amdgcn_s_setprio(1); _Pragma("unroll") for (int m = 0; m < 4; ++m) _Pragma("unroll") for (int n = 0; n < 2; ++n) _Pragma("unroll") for (int k = 0; k < 2; ++k) \
        acc[ai][bj][m][n] = __builtin_amdgcn_mfma_f32_16x16x32_bf16(Bt[n][k], At[m][k], acc[ai][bj][m][n], 0, 0, 0); __builtin_amdgcn_s_setprio(0); } while (0)
#define PG8_WAIT_V(n) asm volatile("s_waitcnt vmcnt(" #n ")" ::: "memory")
#define PG8_WAIT_L(n) asm volatile("s_waitcnt lgkmcnt(" #n ")" ::: "memory")
#define PG8_BAR __builtin_amdgcn_s_barrier()
#define PG8_SCHED __builtin_amdgcn_sched_barrier(0)
    Unit cur, nxt; int ui = 0;
    if (!S.next(0, cur)) return;
    f32x4 acc[2][2][4][2];
#pragma unroll
    for (int a = 0; a < 2; ++a)
#pragma unroll
        for (int b = 0; b < 2; ++b)
#pragma unroll
            for (int m = 0; m < 4; ++m)
#pragma unroll
                for (int n = 0; n < 2; ++n) acc[a][b][m][n] = (f32x4){0.f, 0.f, 0.f, 0.f};
    bf16x8 At[4][2], B0[2][2], B1[2][2];
    const char* cA = (const char*)g.A + (size_t)cur.pm * tstepA + cur.koff; const char* cB = (const char*)(g.Bt + (size_t)cur.e * g.bstride) + (size_t)cur.pn * tstepB + cur.koff;
    PG8_WAIT_V(0); PG8_WAIT_L(0); __syncthreads();
    PG8_ROWS(cur, cv0, cv1);
    PG8_STAGE(PG8_SB(0, 0), cB, voffB); PG8_STAGE(PG8_SB(0, 1), cB + hstepB, voffB); PG8_STAGE(PG8_SA(0, 0), cA, cv0); PG8_STAGE(PG8_SA(0, 1), cA + hstepA, cv1);
    if (wr == 1) PG8_BAR;
    PG8_WAIT_V(2); PG8_BAR;
    PG8_STAGE(PG8_SB(1, 0), cB + kstep, voffB); PG8_STAGE(PG8_SA(1, 0), cA + kstep, cv0); PG8_STAGE(PG8_SB(1, 1), cB + hstepB + kstep, voffB);
    PG8_WAIT_V(6); PG8_BAR;
    for (;;) {
        const bool has_next = S.next(ui + 1, nxt);
        if (has_next) PG8_ROWS(nxt, nv0, nv1);
        const char* nA = has_next ? (const char*)g.A + (size_t)nxt.pm * tstepA + nxt.koff : cA; const char* nB = has_next ? (const char*)(g.Bt + (size_t)nxt.e * g.bstride) + (size_t)nxt.pn * tstepB + nxt.koff : cB;
#pragma unroll 1
        for (int t = 0; t < nt; t += 2) {
            const bool last = (t == nt - 2);
            const char* a1 = cA + (size_t)(t + 1) * kstep;
            const char* a2 = last ? nA : cA + (size_t)(t + 2) * kstep; const char* b2 = last ? nB : cB + (size_t)(t + 2) * kstep;
            const char* a3 = a2 + kstep; const char* b3 = b2 + kstep;
            unsigned s0[2] = {cv0[0], cv0[1]}, s1[2] = {cv1[0], cv1[1]};
            if (GATHER && last && has_next) { s0[0] = nv0[0]; s0[1] = nv0[1]; s1[0] = nv1[0]; s1[1] = nv1[1]; }
            PG8_LDB(B0, 0, 0); PG8_LDB(B1, 0, 1); PG8_SCHED; PG8_LDA(At, 0, 0); PG8_STAGE(PG8_SA(1, 1), a1 + hstepA, cv1);
            PG8_WAIT_V(8); PG8_WAIT_L(0); PG8_BAR; PG8_MMA(0, 0, At, B0); PG8_MMA(0, 1, At, B1); PG8_BAR; PG8_SCHED;
            PG8_LDA(At, 0, 1); PG8_STAGE(PG8_SB(0, 0), b2, voffB); PG8_STAGE(PG8_SB(0, 1), b2 + hstepB, voffB); PG8_STAGE(PG8_SA(0, 0), a2, s0);
            PG8_WAIT_V(8); PG8_WAIT_L(0); PG8_BAR; PG8_MMA(1, 0, At, B0); PG8_MMA(1, 1, At, B1); PG8_BAR; PG8_SCHED;
            PG8_LDB(B0, 1, 0); PG8_LDB(B1, 1, 1); PG8_SCHED; PG8_LDA(At, 1, 0); PG8_STAGE(PG8_SA(0, 1), a2 + hstepA, s1);
            PG8_WAIT_V(8); PG8_WAIT_L(0); PG8_BAR; PG8_MMA(0, 0, At, B0); PG8_MMA(0, 1, At, B1); PG8_BAR; PG8_SCHED;
            PG8_LDA(At, 1, 1); PG8_STAGE(PG8_SB(1, 0), b3, voffB); PG8_STAGE(PG8_SB(1, 1), b3 + hstepB, voffB); PG8_STAGE(PG8_SA(1, 0), a3, s0);
            PG8_WAIT_V(8); PG8_WAIT_L(0); PG8_BAR; PG8_MMA(1, 0, At, B0); PG8_MMA(1, 1, At, B1); PG8_BAR; PG8_SCHED;
        }
        if (wr == 0) PG8_BAR;
        E(acc, cur, wr, wc, fr, fq);
        if (!has_next) break;
#pragma unroll
        for (int a = 0; a < 2; ++a)
#pragma unroll
            for (int b = 0; b < 2; ++b)
#pragma unroll
                for (int m = 0; m < 4; ++m)
#pragma unroll
                    for (int n = 0; n < 2; ++n) acc[a][b][m][n] = (f32x4){0.f, 0.f, 0.f, 0.f};
        cur = nxt; cA = nA; cB = nB; ++ui;
        if (GATHER) { cv0[0] = nv0[0]; cv0[1] = nv0[1]; cv1[0] = nv1[0]; cv1[1] = nv1[1]; }
        if (wr == 1) PG8_BAR;
    }
    PG8_WAIT_V(0);
    PG8_BAR;
#undef PG8_ROWS
#undef PG8_SA
#undef PG8_SB
#undef PG8_STAGE
#undef PG8_LDA
#undef PG8_LDB
#undef PG8_MMA
#undef PG8_WAIT_V
#undef PG8_WAIT_L
#undef PG8_BAR
#undef PG8_SCHED
}
#define EPI_LOOP_ROWS _Pragma("unroll") for (int ai = 0; ai < 2; ++ai) _Pragma("unroll") for (int m = 0; m < 4; ++m)
#define EPI_ROW (u.pm * 256 + ai * 128 + wr * 64 + m * 16 + fr)
#define EPI_COL(bj, n) (u.pn * 256 + (bj) * 128 + wc * 32 + (n) * 16 + fq * 4)
#define EPI_COL8(bj) (u.pn * 256 + (bj) * 128 + wc * 32 + fq * 8)
DEVI void st_bf16x8(bf16* p, f32x4 a, f32x4 b) { u32x4 w; w.x = pk2(a[0], a[1]); w.y = pk2(a[2], a[3]); w.z = pk2(b[0], b[1]); w.w = pk2(b[2], b[3]); *(u32x4*)p = w; }

DEVI void st_bf16x4(bf16* p, f32x4 v) { u32x2 w; w.x = pk2(v[0], v[1]); w.y = pk2(v[2], v[3]); *(u32x2*)p = w; }

struct EpiInProj {
    static constexpr bool PERM = true;
    bf16* proj; float* dt; const float* dt_bias; const float* a_log; float* rqp; float* rkvp;
    DEVI void operator()(const f32x4 (&acc)[2][2][4][2], const Unit& u, int wr, int wc, int fr, int fq) const {
        EPI_LOOP_ROWS { const int row = EPI_ROW;
            if (u.pn <= 1) { float ssq = 0.f;
#pragma unroll
                for (int bj = 0; bj < 2; ++bj) if (u.pn == 0 || bj == 0) {
#pragma unroll
                    for (int n = 0; n < 2; ++n) { const f32x4 v = acc[ai][bj][m][n]; ssq += (v[0] * v[0] + v[1] * v[1]) + (v[2] * v[2] + v[3] * v[3]); } }
                ssq += __shfl_xor(ssq, 16); ssq += __shfl_xor(ssq, 32);
                if (fq == 0) (u.pn == 0 ? rqp : rkvp)[(size_t)row * 4 + wc] = ssq; }
#pragma unroll
            for (int bj = 0; bj < 2; ++bj) { const int col = EPI_COL8(bj);
                if (col < C_DTF) st_bf16x8(proj + (size_t)row * INWP + col, acc[ai][bj][m][0], acc[ai][bj][m][1]);
                else if (col < INW) { const int j0 = col - C_DTF;
#pragma unroll
                    for (int n = 0; n < 2; ++n) { const f32x4 v = acc[ai][bj][m][n]; f32x4 dv, lv;
#pragma unroll
                        for (int i = 0; i < 4; ++i) { const float d_ = softplusf(v[i] + dt_bias[j0 + 4 * n + i]); dv[i] = d_; lv[i] = -d_ * __expf(a_log[j0 + 4 * n + i]); }
                        *(f32x4*)(dt + (size_t)row * 32 + j0 + 4 * n) = dv; *(f32x4*)(dt + (size_t)row * 32 + 16 + j0 + 4 * n) = lv; } } } }
    }
};
struct EpiMla {
    static constexpr bool PERM = false;
    bf16 *Q, *K, *V; const float *rqp, *rkvp; const float* rope; const bf16* proj;
    DEVI void operator()(const f32x4 (&acc)[2][2][4][2], const Unit& u, int wr, int wc, int fr, int fq) const {
        EPI_LOOP_ROWS { const int row = EPI_ROW; float sq = 0.f, skv = 0.f;
            if (u.pn <= 1) { const f32x4 pq = *(const f32x4*)(rqp + (size_t)row * 4); sq = 1.0f / sqrtf(((pq[0] + pq[1]) + (pq[2] + pq[3])) * (1.f / 256.f) + EPS); }
            if (u.pn >= 2) { const f32x4 pk = *(const f32x4*)(rkvp + (size_t)row * 4); skv = 1.0f / sqrtf(((pk[0] + pk[1]) + (pk[2] + pk[3])) * (1.f / 128.f) + EPS); }
            const int pos = row & (SEQ - 1), gr = pos >> 6, gc = pos & 63;
#pragma unroll
            for (int bj = 0; bj < 2; ++bj)
#pragma unroll
                for (int n = 0; n < 2; ++n) { const int col = EPI_COL(bj, n); f32x4 v = acc[ai][bj][m][n];
                    if (col < 384) { v = v * sq; const int d = col % 96;
                        if (d >= 64 && row < NLAT) { const int pp = (d - 64) >> 1;
#pragma unroll
                            for (int i = 0; i < 2; ++i) { const int pi = pp + i; const float* tb = (pi < 8) ? rope + (gr * 8 + pi) * 2 : rope + 2048 + (gc * 8 + (pi - 8)) * 2;
                                const float c = tb[0], s = tb[1], x0 = v[2 * i], x1 = v[2 * i + 1]; v[2 * i] = x0 * c - x1 * s; v[2 * i + 1] = x1 * c + x0 * s; } }
                        st_bf16x4(Q + (size_t)row * 384 + col, v); }
                    else if (col < 416) { const int d0 = col - 384, pp = d0 >> 1; const u32x2 raw = *(const u32x2*)(proj + (size_t)row * INWP + C_KPE + d0);
                        f32x4 x = {bf2f(raw.x & 0xffff), bf2f(raw.x >> 16), bf2f(raw.y & 0xffff), bf2f(raw.y >> 16)};
                        if (row < NLAT) {
#pragma unroll
                            for (int i = 0; i < 2; ++i) { const int pi = pp + i; const float* tb = (pi < 8) ? rope + (gr * 8 + pi) * 2 : rope + 2048 + (gc * 8 + (pi - 8)) * 2;
                                const float c = tb[0], s = tb[1], x0 = x[2 * i], x1 = x[2 * i + 1]; x[2 * i] = x0 * c - x1 * s; x[2 * i + 1] = x1 * c + x0 * s; } }
#pragma unroll
                        for (int h = 0; h < 4; ++h) st_bf16x4(K + (size_t)row * 384 + h * 96 + 64 + d0, x); }
                    else if (col >= 512 && col < 768) { const int c = col - 512; st_bf16x4(K + (size_t)row * 384 + (c >> 6) * 96 + (c & 63), v * skv); }
                    else if (col >= 768) { st_bf16x4(V + (size_t)row * 256 + (col - 768), v * skv); } }
            asm volatile("" ::: "memory"); }
    }
};
struct EpiResid {
    static constexpr bool PERM = true;
    const float* src_lat; const float* src_ctx; float* dst_lat; float* dst_ctx; const float* modv_l; int gidx;
    DEVI void operator()(const f32x4 (&acc)[2][2][4][2], const Unit& u, int wr, int wc, int fr, int fq) const {
        EPI_LOOP_ROWS { const int row = EPI_ROW; const bool lat = row < NLAT; const int r = lat ? (row >> 13) : 2;
            const float* s = lat ? src_lat + (size_t)row * D : src_ctx + (size_t)(row - NLAT) * D; float* d = lat ? dst_lat + (size_t)row * D : dst_ctx + (size_t)(row - NLAT) * D;
            const float* gp = modv_l + r * 6144 + gidx * 1024;
#pragma unroll
            for (int bj = 0; bj < 2; ++bj)
#pragma unroll
                for (int n = 0; n < 2; ++n) { const int col = EPI_COL8(bj) + 4 * n; const f32x4 gv = *(const f32x4*)(gp + col), sv = *(const f32x4*)(s + col);
                    *(f32x4*)(d + col) = sv + gv * acc[ai][bj][m][n]; } }
    }
};
struct EpiPart {
    static constexpr bool PERM = true;
    float* part;
    DEVI void operator()(const f32x4 (&acc)[2][2][4][2], const Unit& u, int wr, int wc, int fr, int fq) const {
        EPI_LOOP_ROWS { const int row = EPI_ROW; float* d = part + ((size_t)u.e * NCTX + (row - NLAT)) * D;
#pragma unroll
            for (int bj = 0; bj < 2; ++bj)
#pragma unroll
                for (int n = 0; n < 2; ++n) *(f32x4*)(d + EPI_COL8(bj) + 4 * n) = acc[ai][bj][m][n]; }
    }
};
struct EpiSwiglu {
    static constexpr bool PERM = true;
    bf16* act; int ldc;
    DEVI void operator()(const f32x4 (&acc)[2][2][4][2], const Unit& u, int wr, int wc, int fr, int fq) const {
        EPI_LOOP_ROWS { const int row = EPI_ROW; f32x4 o[2];
#pragma unroll
            for (int n = 0; n < 2; ++n) { const f32x4 gt = acc[ai][0][m][n], up = acc[ai][1][m][n];
#pragma unroll
                for (int i = 0; i < 4; ++i) o[n][i] = siluf(gt[i]) * up[i]; }
            st_bf16x8(act + (size_t)row * ldc + u.pn * 128 + wc * 32 + fq * 8, o[0], o[1]); }
    }
};
struct EpiStore {
    static constexpr bool PERM = true;
    bf16* o; int ldc;
    DEVI void operator()(const f32x4 (&acc)[2][2][4][2], const Unit& u, int wr, int wc, int fr, int fq) const {
        EPI_LOOP_ROWS { const int row = EPI_ROW;
#pragma unroll
            for (int bj = 0; bj < 2; ++bj) st_bf16x8(o + (size_t)row * ldc + EPI_COL8(bj), acc[ai][bj][m][0], acc[ai][bj][m][1]); }
    }
};

struct CvtSrc { const float* src; int ld; int ncols; bool perm; const float* ks; float sc; };
DEVI void cvt_tile(const CvtSrc t, bf16* dst, int Kd, int nd0, int kd0, LAS float* scr, int lane) {
    const int n = lane & 31;
    if (t.src) {
        const int nc = (n < t.ncols) ? n : t.ncols - 1; const float msk = (n < t.ncols) ? t.sc : 0.f;
        const float* sp0 = t.src + (size_t)(lane >> 5) * t.ld + nc;
        float v[32];
#pragma unroll
        for (int i = 0; i < 32; ++i) v[i] = sp0[(size_t)(2 * i) * t.ld];
        if (t.ks) {
#pragma unroll
            for (int i = 0; i < 32; ++i) v[i] *= t.ks[2 * i + (lane >> 5)];
        }
#pragma unroll
        for (int i = 0; i < 32; ++i) scr[(2 * i + (lane >> 5)) * 33 + n] = v[i] * msk;
    } else {
#pragma unroll 8
        for (int i = 0; i < 32; ++i) scr[(2 * i + (lane >> 5)) * 33 + n] = 0.f;
    }
    asm volatile("s_waitcnt lgkmcnt(0)" ::: "memory");
    const int c = lane & 7;
#pragma unroll
    for (int j = 0; j < 4; ++j) { const int nn = (lane >> 3) + 8 * j; const LAS float* sp = scr + (8 * c) * 33 + (t.perm ? rope_src(nn) : nn);
        u32x4 o; o.x = pk2(sp[0 * 33], sp[1 * 33]); o.y = pk2(sp[2 * 33], sp[3 * 33]); o.z = pk2(sp[4 * 33], sp[5 * 33]); o.w = pk2(sp[6 * 33], sp[7 * 33]);
        *(u32x4*)(dst + (size_t)(nd0 + nn) * Kd + kd0 + 8 * c) = o; }
    asm volatile("s_waitcnt lgkmcnt(0)" ::: "memory");
}
template <class F>
DEVI void cvt_job(bf16* dst, int Nd, int Kd, F f, LAS float* scr, int gw, int ngw, int lane) {
    const int ntn = Nd >> 5, ntk = Kd >> 6;
    for (int it = gw; it < ntn * ntk; it += ngw) { const int nt = it % ntn, kt = it / ntn; cvt_tile(f(nt, kt), dst, Kd, nt * 32, kt * 64, scr, lane); }
}
DEVI void ph_pro(const P& p, unsigned char* lds) {
    const int tid = otid(), wid = tid >> 6, lane = tid & 63;
    __syncthreads();
    float* modv = (float*)(p.ws + WS_MODV);
    float* red = (float*)lds;
    for (int item = blockIdx.x; item < 192; item += gridDim.x) {
        const int l = item / 96, n = (item % 96) * 64 + lane;
        const float* W = IN(4) + (size_t)l * 1024 * 6144;
        float a0 = 0.f, a1 = 0.f, a2 = 0.f;
        for (int k = wid * 128; k < wid * 128 + 128; ++k) {
            const float w = W[(size_t)k * 6144 + n];
            a0 += siluf(IN(1)[k]) * w; a1 += siluf(IN(1)[1024 + k]) * w; a2 += siluf(IN(3)[k]) * w;
        }
        red[(wid * 3 + 0) * 64 + lane] = a0; red[(wid * 3 + 1) * 64 + lane] = a1; red[(wid * 3 + 2) * 64 + lane] = a2;
        __syncthreads();
        if (tid < 192) { const int r = tid >> 6, ln = tid & 63; float s = 0.f;
            for (int w = 0; w < 8; ++w) s += red[(w * 3 + r) * 64 + ln];
            const int nn = (item % 96) * 64 + ln; modv[(l * 3 + r) * 6144 + nn] = s + IN(5)[l * 6144 + nn]; }
        __syncthreads();
    }
    if (blockIdx.x == gridDim.x - 1) {
        float* rope = (float*)(p.ws + WS_ROPE);
        for (int idx = tid; idx < 1536; idx += NTHREADS) {
            const int i = idx & 7, pos = (idx < 1024) ? (idx >> 3) : ((idx - 1024) >> 3);
            const float invf = (i == 0) ? 1.f : (i == 1) ? 0.31622776601683794f : (i == 2) ? 0.1f : (i == 3) ? 0.03162277660168379f : (i == 4) ? 0.01f : (i == 5) ? 0.003162277660168379f : (i == 6) ? 0.001f : 0.00031622776601683794f;
            const float ang = (float)pos * invf;
            double rev = (double)ang * 0.15915494309189535; rev -= __builtin_rint(rev);
            const float fr = (float)rev;
            rope[idx * 2] = __builtin_amdgcn_cosf(fr); rope[idx * 2 + 1] = __builtin_amdgcn_sinf(fr);
        }
    }
    __syncthreads();
    LAS float* scr = (LAS float*)(LAS unsigned char*)lds + wid * (64 * 33);
    const int gw = blockIdx.x * NWAVES + wid, ngw = gridDim.x * NWAVES;
    for (int l = 0; l < 2; ++l) {
        { const float* W = IN(8) + (size_t)l * 1024 * INW;
          cvt_job((bf16*)(p.ws + WS_WIN) + (size_t)l * INWP * 1024, INWP, 1024, [=](int nt, int kt) -> CvtSrc {
              const int n0 = nt * 32; if (n0 >= INW) return CvtSrc{nullptr, 0, 0, false, nullptr, 1.f};
              return CvtSrc{W + (size_t)(kt * 64) * INW + n0, INW, (INW - n0 < 32) ? INW - n0 : 32, n0 == C_KPE, nullptr, 1.f}; }, scr, gw, ngw, lane); }
        { const float* Wq = IN(11) + (size_t)l * 256 * 384; const float* qn = IN(10) + l * 256; const float* Wk = IN(13) + (size_t)l * 128 * 256; const float* Wv = IN(14) + (size_t)l * 128 * 256; const float* kn = IN(12) + l * 128;
          const float QS = 0.10206207261596577f * 1.4426950408889634f;
          cvt_job((bf16*)(p.ws + WS_WQKV) + (size_t)l * 1024 * 384, 1024, 384, [=](int nt, int kt) -> CvtSrc {
              const int n0 = nt * 32, k0 = kt * 64;
              if (n0 < 384) { if (k0 >= 256) return CvtSrc{nullptr, 0, 0, false, nullptr, 1.f}; return CvtSrc{Wq + (size_t)k0 * 384 + n0, 384, 32, (n0 % 96) == 64, qn + k0, QS}; }
              if (n0 < 512 || k0 < 256) return CvtSrc{nullptr, 0, 0, false, nullptr, 1.f};
              if (n0 < 768) return CvtSrc{Wk + (size_t)(k0 - 256) * 256 + (n0 - 512), 256, 32, false, kn + k0 - 256, 1.f};
              return CvtSrc{Wv + (size_t)(k0 - 256) * 256 + (n0 - 768), 256, 32, false, kn + k0 - 256, 1.f}; }, scr, gw, ngw, lane); }
        { const float* W = IN(9) + (size_t)l * 1024 * 1024;
          cvt_job((bf16*)(p.ws + WS_WOUT) + (size_t)l * 1024 * 1024, 1024, 1024, [=](int nt, int kt) -> CvtSrc { return CvtSrc{W + (size_t)(kt * 64) * 1024 + nt * 32, 1024, 32, false, nullptr, 1.f}; }, scr, gw, ngw, lane); }
    }
    { const float* Wg = IN(22); const float* Wu = IN(23);
      cvt_job((bf16*)(p.ws + WS_WGU), 2 * DFF, 1024, [=](int nt, int kt) -> CvtSrc { const int n0 = nt * 32, t = n0 >> 8, r = n0 & 255;
          return CvtSrc{(r < 128 ? Wg + t * 128 + r : Wu + t * 128 + r - 128) + (size_t)(kt * 64) * DFF, DFF, 32, false, nullptr, 1.f}; }, scr, gw, ngw, lane); }
    { const float* W = IN(24);
      cvt_job((bf16*)(p.ws + WS_WD), 1024, DFF, [=](int nt, int kt) -> CvtSrc { return CvtSrc{W + (size_t)(kt * 64) * 1024 + nt * 32, 1024, 32, false, nullptr, 1.f}; }, scr, gw, ngw, lane); }
}
DEVI void ph_moew(const P& p, unsigned char* lds) {
    const int tid = otid(), wid = tid >> 6, lane = tid & 63;
    LAS float* scr = (LAS float*)(LAS unsigned char*)lds + wid * (64 * 33);
    const int gw = blockIdx.x * NWAVES + wid, ngw = gridDim.x * NWAVES;
    for (int e = 0; e < NEXP; ++e) {
        { const float* Wg = IN(26) + (size_t)e * 1024 * DFE; const float* Wu = IN(27) + (size_t)e * 1024 * DFE;
          cvt_job((bf16*)(p.ws + WS_WGUE) + (size_t)e * 2 * DFE * 1024, 2 * DFE, 1024, [=](int nt, int kt) -> CvtSrc { const int n0 = nt * 32, t = n0 >> 8, r = n0 & 255;
              return CvtSrc{(r < 128 ? Wg + t * 128 + r : Wu + t * 128 + r - 128) + (size_t)(kt * 64) * DFE, DFE, 32, false, nullptr, 1.f}; }, scr, gw, ngw, lane); }
        { const float* W = IN(28) + (size_t)e * DFE * 1024;
          cvt_job((bf16*)(p.ws + WS_WDE) + (size_t)e * 1024 * DFE, 1024, DFE, [=](int nt, int kt) -> CvtSrc { return CvtSrc{W + (size_t)(kt * 64) * 1024 + nt * 32, 1024, 32, false, nullptr, 1.f}; }, scr, gw, ngw, lane); }
    }
}

template <bool route>
DEVI void ph_norm(const P& p, int l, int which, int nrows, unsigned char* lds, int npart, int pgidx) {
    const int tid = otid(), wid = tid >> 6, lane = tid & 63;
    const bool first = (l == 0 && which == 0);
    const float* src_lat = first ? IN(0) : p.out; const float* src_ctx = (l == 0) ? IN(2) : (const float*)(p.ws + WS_XC);
    const float* w = IN(6 + which) + l * 1024; const float* modv = (const float*)(p.ws + WS_MODV) + (size_t)l * 3 * 6144;
    bf16* H = (bf16*)(p.ws + WS_HM);
    int* rt_e = (int*)(p.ws + WS_RT); float* rt_g = (float*)(p.ws + WS_RT + 128 * 1024);
    float* rl = (float*)lds;
    if (route) { __syncthreads(); const float* router = IN(25);
#pragma unroll
        for (int i = 0; i < 4; ++i) *(f32x4*)(rl + (tid + NTHREADS * i) * 4) = *(const f32x4*)(router + (tid + NTHREADS * i) * 4);
        __syncthreads(); }
    const int nw = gridDim.x * NWAVES, rpw = (NLAT + nw - 1) / nw, gw = blockIdx.x * NWAVES + wid;
    f32x4 vn[4], gsc[4], shv[4]; int rc = -1;
    for (int pass = 0; pass < (nrows > NLAT ? 2 : 1); ++pass) {
    const int row0 = pass == 0 ? gw * rpw : NLAT + gw, row1 = pass == 0 ? ((row0 + rpw < NLAT) ? row0 + rpw : NLAT) : nrows, rstep = pass == 0 ? 1 : nw;
    if (row0 < row1) { const float* x = (row0 < NLAT) ? src_lat + (size_t)row0 * D : src_ctx + (size_t)(row0 - NLAT) * D;
#pragma unroll
        for (int j = 0; j < 4; ++j) vn[j] = *(const f32x4*)(x + (j * 64 + lane) * 4); }
    for (int row = row0; row < row1; row += rstep) {
        const bool lat = row < NLAT; const int r = lat ? (row >> 13) : 2;
        if (r != rc) { rc = r; const float* sh = modv + r * 6144 + (which * 3 + 0) * 1024; const float* sc = modv + r * 6144 + (which * 3 + 1) * 1024;
#pragma unroll
            for (int j = 0; j < 4; ++j) { const int c0 = (j * 64 + lane) * 4; const f32x4 wv = *(const f32x4*)(w + c0), cv = *(const f32x4*)(sc + c0); shv[j] = *(const f32x4*)(sh + c0); gsc[j] = wv * (cv + 1.f); } }
        f32x4 v[4]; float ss = 0.f;
#pragma unroll
        for (int j = 0; j < 4; ++j) v[j] = vn[j];
        if (!lat && npart > 0) { const float* part = (const float*)(p.ws + WS_XBC) + (size_t)(row - NLAT) * D; const float* gp = modv + 2 * 6144 + pgidx * 1024; float* xc = (float*)(p.ws + WS_XC) + (size_t)(row - NLAT) * D;
#pragma unroll
            for (int j = 0; j < 4; ++j) { const int c0 = (j * 64 + lane) * 4; f32x4 acc = {0.f, 0.f, 0.f, 0.f};
#pragma unroll 2
                for (int k = 0; k < npart; ++k) acc += *(const f32x4*)(part + (size_t)k * NCTX * D + c0);
                v[j] += *(const f32x4*)(gp + c0) * acc; *(f32x4*)(xc + c0) = v[j]; } }
#pragma unroll
        for (int j = 0; j < 4; ++j) ss += v[j][0] * v[j][0] + v[j][1] * v[j][1] + v[j][2] * v[j][2] + v[j][3] * v[j][3];
        if (row + rstep < row1) { const int nrow = row + rstep; const float* x = (nrow < NLAT) ? src_lat + (size_t)nrow * D : src_ctx + (size_t)(nrow - NLAT) * D;
#pragma unroll
            for (int j = 0; j < 4; ++j) vn[j] = *(const f32x4*)(x + (j * 64 + lane) * 4); }
        ss = wave_sum(ss); const float rstd = 1.0f / sqrtf(ss * (1.f / D) + EPS);
        float lg[8];
#pragma unroll
        for (int e = 0; e < 8; ++e) lg[e] = 0.f;
#pragma unroll
        for (int j = 0; j < 4; ++j) { const int c0 = (j * 64 + lane) * 4; v[j] = v[j] * rstd * gsc[j] + shv[j]; st_bf16x4(H + (size_t)row * D + c0, v[j]); }
        if (route) {
#pragma unroll
            for (int j = 0; j < 4; ++j) { const int c0 = (j * 64 + lane) * 4;
#pragma unroll
                for (int i = 0; i < 4; ++i) { const f32x4 r0 = *(const f32x4*)(rl + (c0 + i) * 8), r1 = *(const f32x4*)(rl + (c0 + i) * 8 + 4); const float hh = v[j][i];
                    lg[0] += hh * r0[0]; lg[1] += hh * r0[1]; lg[2] += hh * r0[2]; lg[3] += hh * r0[3]; lg[4] += hh * r1[0]; lg[5] += hh * r1[1]; lg[6] += hh * r1[2]; lg[7] += hh * r1[3]; }
                asm volatile("" ::: "memory"); } }
        if (route) {
#pragma unroll
            for (int e = 0; e < 8; ++e) lg[e] = wave_sum(lg[e]);
            int i1 = 0; float v1 = lg[0];
#pragma unroll
            for (int e = 1; e < 8; ++e) if (lg[e] > v1) { v1 = lg[e]; i1 = e; }
            int i2 = -1; float v2 = -3.0e38f;
#pragma unroll
            for (int e = 0; e < 8; ++e) if (e != i1 && lg[e] > v2) { v2 = lg[e]; i2 = e; }
            const float e2 = __expf(v2 - v1), g1 = 1.f / (1.f + e2), g2 = e2 / (1.f + e2);
            if (lane == 0) { rt_e[row * 2] = i1; rt_e[row * 2 + 1] = i2; rt_g[row * 2] = g1; rt_g[row * 2 + 1] = g2; }
        }
    }
    }
}

typedef short v4i16_t __attribute__((ext_vector_type(4)));
DEVI v4i16_t lds_tr(const unsigned char* p) { return __builtin_amdgcn_ds_read_tr16_b64_v4i16((LAS v4i16_t*)(LAS unsigned char*)p); }
constexpr int A3_KLD = 208, A3_VLD = 192, A3_VOFF = 64 * A3_KLD, A3_BUF = A3_VOFF + 64 * A3_VLD;
template <int VAR>
DEVI void attn_unit(const P& p, int uidx, unsigned char* lds, bf16* outp) {
    const int tid = otid(), wid = __builtin_amdgcn_readfirstlane(tid >> 6), lane = tid & 63, r32 = lane & 31, hi = lane >> 5;
    const bf16* Q = (const bf16*)(p.ws + WS_Q); const bf16* K = (const bf16*)(p.ws + WS_K); const bf16* V = (const bf16*)(p.ws + WS_V); bf16* MIX = outp;
    int b, h, qrow0, NT;
    if (uidx < 256) { b = uidx >> 7; h = (uidx >> 5) & 3; qrow0 = b * SEQ + (uidx & 31) * 256; NT = 4 + SEQ / 64; }
    else { const int j = uidx - 256; b = j >> 2; h = j & 3; qrow0 = NLAT + b * CL; NT = 4; }
    const int qrow = qrow0 + wid * 32 + r32;
    bf16x8 qf[6];
#pragma unroll
    for (int s = 0; s < 6; ++s) qf[s] = *(const bf16x8*)(Q + (size_t)qrow * 384 + h * 96 + s * 16 + hi * 8);
    const int kk0 = tid / 12, kq0 = tid % 12, kk1 = (512 + tid) / 12, kq1 = (512 + tid) % 12, vk = tid >> 3, vq = tid & 7;
    const bf16* Kh = K + h * 96; const bf16* Vh = V + h * 64 + vq * 8;
    const int ctx0 = NLAT + b * CL, lat0 = b * SEQ;
    u32x4 krA0, krA1 = {0u, 0u, 0u, 0u}, vrA;
#define AT_LOAD(t, kr0, kr1, vr) do { const int kr_ = ((t) < 4) ? ctx0 + (t) * 64 : lat0 + ((t) - 4) * 64; \
        kr0 = *(const u32x4*)(Kh + (size_t)(kr_ + kk0) * 384 + kq0 * 8); if (tid < 256) kr1 = *(const u32x4*)(Kh + (size_t)(kr_ + kk1) * 384 + kq1 * 8); \
        vr = *(const u32x4*)(Vh + (size_t)(kr_ + vk) * 256); } while (0)
#define AT_STORE(bufp, kr0, kr1, vr) do { unsigned char* b_ = (bufp); *(u32x4*)(b_ + kk0 * A3_KLD + kq0 * 16) = kr0; if (tid < 256) *(u32x4*)(b_ + kk1 * A3_KLD + kq1 * 16) = kr1; \
        *(u32x4*)(b_ + A3_VOFF + vk * A3_VLD + vq * 16) = vr; } while (0)
    const int troff = (4 * hi + ((lane & 15) >> 2)) * A3_VLD + (16 * ((lane >> 4) & 1) + 4 * (lane & 3)) * 2;
    const int koff = r32 * A3_KLD + hi * 16;
    f32x16 o0, o1, negm;
#pragma unroll
    for (int r = 0; r < 16; ++r) { o0[r] = 0.f; o1[r] = 0.f; negm[r] = 0.f; }
    float mhat = 0.f, lsum = 0.f;
    __syncthreads();
    AT_LOAD(0, krA0, krA1, vrA); AT_STORE(lds, krA0, krA1, vrA); AT_LOAD(1, krA0, krA1, vrA); AT_STORE(lds + A3_BUF, krA0, krA1, vrA);
    __syncthreads();
#define SBAR() __builtin_amdgcn_sched_barrier(0)
#define KRD(bufp, half, s) (*(const bf16x8*)((bufp) + koff + (half) * 32 * A3_KLD + (s) * 32))
#define MF(a, b, c) __builtin_amdgcn_mfma_f32_32x32x16_bf16(a, b, c, 0, 0, 0)
#define MFQ(a, b, c) ((VAR == 3) ? (c) : MF(a, b, c))
#define MFP(a, b, c) ((VAR == 2) ? (c) : MF(a, b, c))
#define EX4(S, r0) do { if (VAR == 1) { S[r0] *= 0.001f; S[r0 + 1] *= 0.001f; S[r0 + 2] *= 0.001f; S[r0 + 3] *= 0.001f; break; } S[r0] = __builtin_amdgcn_exp2f(S[r0]); S[r0 + 1] = __builtin_amdgcn_exp2f(S[r0 + 1]); S[r0 + 2] = __builtin_amdgcn_exp2f(S[r0 + 2]); S[r0 + 3] = __builtin_amdgcn_exp2f(S[r0 + 3]); lsum += (S[r0] + S[r0 + 1]) + (S[r0 + 2] + S[r0 + 3]); } while (0)
#define PK8(S, r0) __builtin_bit_cast(bf16x8, (u32x4){pk2(S[r0], S[r0 + 1]), pk2(S[r0 + 2], S[r0 + 3]), pk2(S[r0 + 4], S[r0 + 5]), pk2(S[r0 + 6], S[r0 + 7])})
#define VFR(vp) ({ const v4i16_t lo_ = lds_tr(vp), hi_ = lds_tr((vp) + 8 * A3_VLD); (bf16x8){lo_[0], lo_[1], lo_[2], lo_[3], hi_[0], hi_[1], hi_[2], hi_[3]}; })
#define MX3(a, b, c) __builtin_fmaxf(__builtin_fmaxf((a), (b)), (c))
#define AT_UPD(S0, S1, mx, FORCE) do { float mx_ = __builtin_fmaxf(mx, __shfl_xor(mx, 32)); \
        if ((FORCE) || __any(mx_ > 8.0f)) { const float dl_ = (FORCE) ? mx_ : __builtin_fmaxf(mx_, 0.f); mhat += dl_; \
            _Pragma("unroll") for (int r = 0; r < 16; ++r) { S0[r] -= dl_; S1[r] -= dl_; negm[r] = -mhat; } \
            if (!(FORCE)) { const float f_ = __builtin_amdgcn_exp2f(-dl_); _Pragma("unroll") for (int r = 0; r < 16; ++r) { o0[r] *= f_; o1[r] *= f_; } lsum *= f_; } } } while (0)
    f32x16 sa0, sa1, sb0, sb1;
    { const unsigned char* kb_ = lds;
#pragma unroll
      for (int s = 0; s < 6; ++s) { sa0 = MF(KRD(kb_, 0, s), qf[s], s == 0 ? negm : sa0); sa1 = MF(KRD(kb_, 1, s), qf[s], s == 0 ? negm : sa1); }
      float a_ = MX3(sa0[0], sa0[1], sa1[0]), b_ = MX3(sa0[2], sa0[3], sa1[1]); a_ = MX3(a_, sa1[2], sa1[3]);
#pragma unroll
      for (int r = 4; r < 16; r += 4) { a_ = MX3(a_, sa0[r], sa0[r + 1]); b_ = MX3(b_, sa0[r + 2], sa0[r + 3]); a_ = MX3(a_, sa1[r], sa1[r + 1]); b_ = MX3(b_, sa1[r + 2], sa1[r + 3]); }
      AT_UPD(sa0, sa1, __builtin_fmaxf(a_, b_), true); }
#define AT_STEP(C0, C1, N0, N1, t, bc_, HAS_NEXT) do { const int b1_ = ((bc_) == 2) ? 0 : (bc_) + 1, b2_ = (b1_ == 2) ? 0 : b1_ + 1; \
        const unsigned char* kb_ = lds + b1_ * A3_BUF; const unsigned char* vb_ = lds + (bc_) * A3_BUF + A3_VOFF + troff; \
        if (VAR != 4 && (t) + 2 < NT) AT_LOAD((t) + 2, krA0, krA1, vrA); \
        bf16x8 pw0_, pw1_, pw2_, pw3_; float ma_ = -3.0e38f, mb_ = -3.0e38f; \
        if (HAS_NEXT) { \
            bf16x8 k0_ = KRD(kb_, 0, 0), k1_ = KRD(kb_, 1, 0), k2_ = KRD(kb_, 0, 1), k3_ = KRD(kb_, 1, 1); SBAR(); \
            N0 = MFQ(k0_, qf[0], negm); EX4(C0, 0); k0_ = KRD(kb_, 0, 2); SBAR(); \
            N1 = MFQ(k1_, qf[0], negm); EX4(C0, 4); k1_ = KRD(kb_, 1, 2); SBAR(); \
            N0 = MFQ(k2_, qf[1], N0); EX4(C0, 8); k2_ = KRD(kb_, 0, 3); SBAR(); \
            N1 = MFQ(k3_, qf[1], N1); EX4(C0, 12); k3_ = KRD(kb_, 1, 3); SBAR(); \
            N0 = MFQ(k0_, qf[2], N0); EX4(C1, 0); k0_ = KRD(kb_, 0, 4); SBAR(); \
            N1 = MFQ(k1_, qf[2], N1); EX4(C1, 4); k1_ = KRD(kb_, 1, 4); SBAR(); \
            N0 = MFQ(k2_, qf[3], N0); EX4(C1, 8); k2_ = KRD(kb_, 0, 5); SBAR(); \
            N1 = MFQ(k3_, qf[3], N1); EX4(C1, 12); k3_ = KRD(kb_, 1, 5); SBAR(); \
            N0 = MFQ(k0_, qf[4], N0); pw0_ = PK8(C0, 0); SBAR(); \
            N1 = MFQ(k1_, qf[4], N1); pw1_ = PK8(C0, 8); SBAR(); \
            N0 = MFQ(k2_, qf[5], N0); pw2_ = PK8(C1, 0); SBAR(); \
            N1 = MFQ(k3_, qf[5], N1); pw3_ = PK8(C1, 8); SBAR(); \
        } else { EX4(C0, 0); EX4(C0, 4); EX4(C0, 8); EX4(C0, 12); EX4(C1, 0); EX4(C1, 4); EX4(C1, 8); EX4(C1, 12); pw0_ = PK8(C0, 0); pw1_ = PK8(C0, 8); pw2_ = PK8(C1, 0); pw3_ = PK8(C1, 8); SBAR(); } \
        { bf16x8 va_ = VFR(vb_), vb2_ = VFR(vb_ + 64); SBAR(); \
          bf16x8 vc_ = VFR(vb_ + 16 * A3_VLD), vd_ = VFR(vb_ + 16 * A3_VLD + 64); SBAR(); \
          o0 = MFP(va_, pw0_, o0); if (HAS_NEXT) { ma_ = MX3(N0[0], N0[1], N1[0]); mb_ = MX3(N0[2], N0[3], N1[1]); } SBAR(); \
          o1 = MFP(vb2_, pw0_, o1); if (HAS_NEXT) { ma_ = MX3(ma_, N1[2], N1[3]); mb_ = MX3(mb_, N0[4], N0[5]); } SBAR(); \
          va_ = VFR(vb_ + 32 * A3_VLD); vb2_ = VFR(vb_ + 32 * A3_VLD + 64); SBAR(); \
          o0 = MFP(vc_, pw1_, o0); if (HAS_NEXT) { ma_ = MX3(ma_, N0[6], N0[7]); mb_ = MX3(mb_, N1[4], N1[5]); } SBAR(); \
          o1 = MFP(vd_, pw1_, o1); if (HAS_NEXT) { ma_ = MX3(ma_, N1[6], N1[7]); mb_ = MX3(mb_, N0[8], N0[9]); } SBAR(); \
          vc_ = VFR(vb_ + 48 * A3_VLD); vd_ = VFR(vb_ + 48 * A3_VLD + 64); SBAR(); \
          o0 = MFP(va_, pw2_, o0); if (HAS_NEXT) { ma_ = MX3(ma_, N0[10], N0[11]); mb_ = MX3(mb_, N1[8], N1[9]); } SBAR(); \
          o1 = MFP(vb2_, pw2_, o1); if (HAS_NEXT) { ma_ = MX3(ma_, N1[10], N1[11]); mb_ = MX3(mb_, N0[12], N0[13]); } SBAR(); \
          if (HAS_NEXT) { ma_ = MX3(ma_, N0[14], N0[15]); mb_ = MX3(mb_, N1[12], N1[13]); } SBAR(); \
          o0 = MFP(vc_, pw3_, o0); if (HAS_NEXT) { ma_ = MX3(ma_, N1[14], N1[15]); } SBAR(); \
          o1 = MFP(vd_, pw3_, o1); SBAR(); } \
        if (HAS_NEXT) AT_UPD(N0, N1, __builtin_fmaxf(ma_, mb_), false); \
        if (VAR != 4 && (t) + 2 < NT) AT_STORE(lds + b2_ * A3_BUF, krA0, krA1, vrA); \
        if (VAR != 4) __syncthreads(); } while (0)
    int bc = 0, t = 0;
    for (; t + 2 < NT; t += 2) {
        AT_STEP(sa0, sa1, sb0, sb1, t, bc, true); bc = (bc == 2) ? 0 : bc + 1;
        AT_STEP(sb0, sb1, sa0, sa1, t + 1, bc, true); bc = (bc == 2) ? 0 : bc + 1;
    }
    AT_STEP(sa0, sa1, sb0, sb1, t, bc, true); bc = (bc == 2) ? 0 : bc + 1;
    AT_STEP(sb0, sb1, sa0, sa1, t + 1, bc, false);
#undef AT_LOAD
#undef AT_STORE
#undef SBAR
#undef KRD
#undef MF
#undef MFQ
#undef MFP
#undef EX4
#undef PK8
#undef VFR
#undef MX3
#undef AT_UPD
#undef AT_STEP
    lsum += __shfl_xor(lsum, 32);
    const float inv = 1.f / lsum;
    bf16* orow = MIX + (size_t)qrow * D + h * 64;
#pragma unroll
    for (int g = 0; g < 4; ++g) {
        st_bf16x4(orow + 8 * g + 4 * hi, (f32x4){o0[4 * g] * inv, o0[4 * g + 1] * inv, o0[4 * g + 2] * inv, o0[4 * g + 3] * inv});
        st_bf16x4(orow + 32 + 8 * g + 4 * hi, (f32x4){o1[4 * g] * inv, o1[4 * g + 1] * inv, o1[4 * g + 2] * inv, o1[4 * g + 3] * inv});
    }
}

constexpr int NCC = 66;
DEVI int chunk_row0(int b, int cc) { return cc < 2 ? NLAT + b * CL + cc * 128 : b * SEQ + (cc - 2) * 128; }
constexpr int SC_VEC = 0;
constexpr int SC_KT = 2048;
constexpr int SC_VF = SC_KT + 64 * 136 * 2;
constexpr int SC_VB = SC_VF + 64 * 136 * 2;
constexpr int SC_X = SC_VB + 64 * 136 * 2;
constexpr int SC_SSQ = SC_X + 2048;
constexpr int SC_END = SC_SSQ + 8192;
constexpr int TS = 136;

DEVI void scan_vectors(const P& p, int l, bool ret, int h, int row0, float* vec, int wid, int lane) {
    const float* dt = (const float*)(p.ws + WS_DT);
    if (ret) {
        if (wid == 0) { const float lf = IN(15)[l * 8 + h], lb = IN(15)[l * 8 + 4 + h];
            const float laf = -log1pf(__expf(-lf)), lab = -log1pf(__expf(-lb));
#pragma unroll
            for (int e = 0; e < 2; ++e) { const int j = lane * 2 + e; vec[j] = (float)(j + 1) * laf; vec[128 + j] = (float)(128 - j) * lab; vec[256 + j] = 1.f; vec[384 + j] = 1.f; } }
    } else if (wid < 2) {
        const int dir = wid; const size_t r = (size_t)(row0 + lane * 2);
        const float x0 = dt[r * 32 + 16 + dir * 8 + h], x1 = dt[(r + 1) * 32 + 16 + dir * 8 + h];
        vec[256 + dir * 128 + lane * 2] = dt[r * 32 + dir * 8 + h]; vec[256 + dir * 128 + lane * 2 + 1] = dt[(r + 1) * 32 + dir * 8 + h];
        float s = x0 + x1;
#pragma unroll
        for (int o = 1; o < 64; o <<= 1) { const float t = __shfl_up(s, o); if (lane >= o) s += t; }
        if (dir == 0) { vec[lane * 2] = s - x1; vec[lane * 2 + 1] = s; }
        else { const float tot = __shfl(s, 63); vec[128 + lane * 2] = tot - (s - x1) + x0; vec[128 + lane * 2 + 1] = tot - s + x1; }
    }
}
DEVI void scan_ptrs(const P& p, bool ret, int h, const bf16*& qb, const bf16*& kb, const bf16*& vb, int& ld) {
    if (ret) { const bf16* proj = (const bf16*)(p.ws + WS_PROJ); qb = proj + C_RQ + h * 64; kb = proj + C_RK + h * 64; vb = proj + C_RV + h * 64; ld = INWP; }
    else { const bf16* xbc = (const bf16*)(p.ws + WS_XBC); qb = xbc + 640 + (h >> 2) * 64; kb = xbc + 512 + (h >> 2) * 64; vb = xbc + h * 64; ld = 768; }
}
DEVI void c3_stage_rows(unsigned char* dst, int rs, const bf16* src, int ld, int tid) {
#pragma unroll
    for (int i = 0; i < 2; ++i) { const int piece = tid + NTHREADS * i, row = piece >> 3, part = piece & 7; *(u32x4*)(dst + row * rs + part * 16) = *(const u32x4*)(src + (size_t)row * ld + part * 8); }
}
struct ConvW { f32x4 w0[2], w1[2], w2[2], b[2]; };
DEVI ConvW conv_w(const float* cw, const float* cb, int c0) { ConvW w;
#pragma unroll
    for (int k = 0; k < 2; ++k) { w.w0[k] = *(const f32x4*)(cw + c0 + 4 * k); w.w1[k] = *(const f32x4*)(cw + 768 + c0 + 4 * k); w.w2[k] = *(const f32x4*)(cw + 1536 + c0 + 4 * k); w.b[k] = *(const f32x4*)(cb + c0 + 4 * k); }
    return w; }
DEVI void unpack8(const u32x4 v, f32x4 (&x)[2]) { x[0] = (f32x4){bf2f(v.x & 0xffff), bf2f(v.x >> 16), bf2f(v.y & 0xffff), bf2f(v.y >> 16)}; x[1] = (f32x4){bf2f(v.z & 0xffff), bf2f(v.z >> 16), bf2f(v.w & 0xffff), bf2f(v.w >> 16)}; }
DEVI void conv8(const bf16* proj, size_t row, bool has_prev, bool has_next, int c0, const ConvW& w, f32x4 (&y)[2]) {
    const bf16* pr = proj + row * INWP + C_XBC + c0; const u32x4 z = {0u, 0u, 0u, 0u};
    const u32x4 r0 = *(const u32x4*)pr, rm = has_prev ? *(const u32x4*)(pr - INWP) : z, rp = has_next ? *(const u32x4*)(pr + INWP) : z;
    f32x4 x0[2], xm[2], xp[2]; unpack8(r0, x0); unpack8(rm, xm); unpack8(rp, xp);
#pragma unroll
    for (int k = 0; k < 2; ++k) { y[k] = w.w0[k] * xm[k] + w.w1[k] * x0[k] + w.w2[k] * xp[k] + w.b[k];
#pragma unroll
        for (int i = 0; i < 4; ++i) y[k][i] = siluf(y[k][i]); }
}
DEVI u32x4 pack8(const f32x4 (&y)[2], float sc) { return (u32x4){pk2(y[0][0] * sc, y[0][1] * sc), pk2(y[0][2] * sc, y[0][3] * sc), pk2(y[1][0] * sc, y[1][1] * sc), pk2(y[1][2] * sc, y[1][3] * sc)}; }
constexpr int SA_RS = 192, SA_K = 8192, SA_VF = SA_K + 128 * SA_RS, SA_VB = SA_VF + 128 * SA_RS, SA_END = SA_VB + 128 * SA_RS;
DEVI void scanA_unit(const P& p, int l, int uidx, unsigned char* lds) {
    const int tid = otid(), wid = __builtin_amdgcn_readfirstlane(tid >> 6), lane = tid & 63, r32 = lane & 31, hi = lane >> 5;
    const int g4 = uidx % 3, bc = uidx / 3, b = bc / NCC, cc = bc % NCC, row0 = chunk_row0(b, cc);
    const bool ret = (g4 == 0);
    float* vec4 = (float*)(lds + SC_VEC);
    float* ST = (float*)(p.ws + WS_ST); float* CDp = (float*)(p.ws + WS_CD);
    const bf16* proj = (const bf16*)(p.ws + WS_PROJ); bf16* xbcw = (bf16*)(p.ws + WS_XBC); const float* cw = IN(16) + (size_t)l * 3 * 768; const float* cb = IN(17) + l * 768;
    const int troff = (4 * hi + ((lane & 15) >> 2)) * SA_RS + (16 * ((lane >> 4) & 1) + 4 * (lane & 3)) * 2;
    __syncthreads();
    { const int hq = wid >> 1, h = ret ? hq : (g4 - 1) * 4 + hq; scan_vectors(p, l, ret, h, row0, vec4 + hq * 512, wid & 1, lane); }
    __syncthreads();
    { const int hq = tid >> 7, t = tid & 127, h = ret ? hq : (g4 - 1) * 4 + hq, hh = ret ? hq : 4 + h; const size_t item = (size_t)(b * NCC + cc) * 12 + hh; const float* vv = vec4 + hq * 512;
      float* vg = (float*)(p.ws + WS_VEC) + item * 512; vg[t] = vv[t]; vg[128 + t] = vv[128 + t]; vg[256 + t] = vv[t] - __logf(vv[256 + t]); vg[384 + t] = vv[128 + t] - __logf(vv[384 + t]);
      if (t == 0) { CDp[item * 2] = __expf(vv[127]); CDp[item * 2 + 1] = __expf(vv[128]); } }
    for (int hq = 0; hq < 4; ++hq) {
        const int h = ret ? hq : (g4 - 1) * 4 + hq, hh = ret ? hq : 4 + h; const size_t item = (size_t)(b * NCC + cc) * 12 + hh;
        const bf16 *qb, *kb, *vb; int ld; scan_ptrs(p, ret, h, qb, kb, vb, ld);
        const float* vec = vec4 + hq * 512;
        if (hq > 0) __syncthreads();
        if (ret) {
            c3_stage_rows(lds + SA_K, SA_RS, kb + (size_t)row0 * ld, ld, tid);
#pragma unroll
            for (int i = 0; i < 2; ++i) { const int piece = tid + NTHREADS * i, j = piece >> 3, part = piece & 7; const u32x4 v = *(const u32x4*)(vb + (size_t)(row0 + j) * ld + part * 8);
                const float sf = __expf(vec[127] - vec[j]) * vec[256 + j], sb = __expf(vec[128] - vec[128 + j]) * vec[384 + j];
                f32x4 x[2]; unpack8(v, x);
                *(u32x4*)(lds + SA_VF + j * SA_RS + part * 16) = pack8(x, sf); *(u32x4*)(lds + SA_VB + j * SA_RS + part * 16) = pack8(x, sb); }
        } else {
            const int g = g4 - 1, part = tid & 7; const int pos0 = (cc < 2) ? cc * 128 : (cc - 2) * 128, Ls = (cc < 2) ? CL : SEQ;
            if (hq == 0) {
#pragma unroll 1
                for (int which = 0; which < 2; ++which) { const int c0 = (which == 0 ? 512 : 640) + g * 64 + part * 8; const ConvW w = conv_w(cw, cb, c0);
#pragma unroll
                    for (int i = 0; i < 2; ++i) { const int j = (tid + NTHREADS * i) >> 3; f32x4 y[2]; conv8(proj, (size_t)(row0 + j), pos0 + j > 0, pos0 + j < Ls - 1, c0, w, y);
                        const u32x4 o = pack8(y, 1.f); *(u32x4*)(xbcw + (size_t)(row0 + j) * 768 + c0) = o; if (which == 0) *(u32x4*)(lds + SA_K + j * SA_RS + part * 16) = o; } } }
            { const int c0 = h * 64 + part * 8; const ConvW w = conv_w(cw, cb, c0);
#pragma unroll
              for (int i = 0; i < 2; ++i) { const int j = (tid + NTHREADS * i) >> 3; f32x4 y[2]; conv8(proj, (size_t)(row0 + j), pos0 + j > 0, pos0 + j < Ls - 1, c0, w, y);
                  const float sf = __expf(vec[127] - vec[j]) * vec[256 + j], sb = __expf(vec[128] - vec[128 + j]) * vec[384 + j];
                  *(u32x4*)(xbcw + (size_t)(row0 + j) * 768 + c0) = pack8(y, 1.f);
                  *(u32x4*)(lds + SA_VF + j * SA_RS + part * 16) = pack8(y, sf); *(u32x4*)(lds + SA_VB + j * SA_RS + part * 16) = pack8(y, sb); } }
        }
        __syncthreads();
        const int dir = wid >> 2, nt = (wid >> 1) & 1, pt = wid & 1;
        const unsigned char* ka = lds + SA_K + nt * 64 + troff; const unsigned char* va = lds + (dir ? SA_VB : SA_VF) + pt * 64 + troff;
        f32x16 acc;
#pragma unroll
        for (int r = 0; r < 16; ++r) acc[r] = 0.f;
#pragma unroll
        for (int s = 0; s < 8; ++s) { const v4i16_t al = lds_tr(ka + (16 * s) * SA_RS), ah = lds_tr(ka + (16 * s + 8) * SA_RS), bl = lds_tr(va + (16 * s) * SA_RS), bh = lds_tr(va + (16 * s + 8) * SA_RS);
            const bf16x8 af = {al[0], al[1], al[2], al[3], ah[0], ah[1], ah[2], ah[3]}, bf = {bl[0], bl[1], bl[2], bl[3], bh[0], bh[1], bh[2], bh[3]};
            acc = __builtin_amdgcn_mfma_f32_32x32x16_bf16(af, bf, acc, 0, 0, 0); }
        float* o = ST + (item * 2 + dir) * 4096 + (size_t)(pt * 32 + r32) * 64 + nt * 32 + 4 * hi;
#pragma unroll
        for (int g = 0; g < 4; ++g) *(f32x4*)(o + 8 * g) = (f32x4){acc[4 * g], acc[4 * g + 1], acc[4 * g + 2], acc[4 * g + 3]};
    }
    __syncthreads();
}
DEVI void scanB_slab(const P& p, int slab, int nthr, int epb) {
    const int tid = otid(); if (tid >= nthr) return;
    const int f = slab * epb + tid * 2; const int bhd = f >> 12, e = f & 4095, dir = bhd & 1, bh = bhd >> 1, b = bh / 12, hh = bh % 12;
    const float* ST = (const float*)(p.ws + WS_ST); const float* CDp = (const float*)(p.ws + WS_CD); bf16* HT = (bf16*)(p.ws + WS_HT);
    f32x2 H = {0.f, 0.f};
    for (int base = 0; base < NCC; base += 6) {
        f32x2 s[6]; float d[6]; size_t off[6];
#pragma unroll
        for (int i = 0; i < 6; ++i) { const int step = base + i; const int cc = dir == 0 ? step : (step < 2 ? 1 - step : 67 - step);
            const size_t item = (size_t)(b * NCC + cc) * 12 + hh; off[i] = (item * 2 + dir) * 4096 + e; s[i] = *(const f32x2*)(ST + off[i]); d[i] = CDp[item * 2 + dir]; }
#pragma unroll
        for (int i = 0; i < 6; ++i) { *(unsigned*)(HT + off[i]) = pk2(H[0], H[1]); H = H * d[i] + s[i]; }
    }
}
constexpr int C3_RSV = 192, C3_RSK = 144;
constexpr int C3_V = 0, C3_K = 2 * 128 * C3_RSV, C3_H = C3_K + 2 * 128 * C3_RSK, C3_VEC = C3_H + 2 * 128 * C3_RSK, C3_X = C3_VEC + 2 * 2048, C3_END = C3_X + 1024;
template <bool RET>
DEVI void scanC_unit(const P& p, int l, int bc, unsigned char* lds, int tid, int wid, int lane) {
    const int r32 = lane & 31, hi = lane >> 5;
    const int it_ = wid & 3, hsub = wid >> 2, b = bc / NCC, cc = bc % NCC, row0 = chunk_row0(b, cc);
    const bf16* HT = (const bf16*)(p.ws + WS_HT); const bf16* proj = (const bf16*)(p.ws + WS_PROJ); const bf16* xbc = (const bf16*)(p.ws + WS_XBC); bf16* MIX = (bf16*)(p.ws + WS_HM); const float* VECG = (const float*)(p.ws + WS_VEC);
    const int i = it_ * 32 + r32; const size_t rowi = (size_t)(row0 + i);
    constexpr int ld = RET ? INWP : 768;
    const unsigned char* Vl = lds + C3_V + hsub * 128 * C3_RSV; const unsigned char* Kl = lds + C3_K + hsub * 128 * C3_RSK; const unsigned char* Hl = lds + C3_H + hsub * 128 * C3_RSK; const float* vec = (const float*)(lds + C3_VEC + hsub * 2048);
    const int trq = (lane & 15) >> 2, trp = lane & 3, trg = (lane >> 4) & 1;
    const int troff = (4 * hi + trq) * C3_RSV + (16 * trg + 4 * trp) * 2;
    float ssqk[4] = {0.f, 0.f, 0.f, 0.f};
#pragma unroll 1
    for (int step = 0; step < (RET ? 2 : 4); ++step) {
        __syncthreads();
#pragma unroll
        for (int hs = 0; hs < 2; ++hs) { const int h = RET ? hs * 2 + step : hs * 4 + step, hh = RET ? h : 4 + h; const size_t item = (size_t)(b * NCC + cc) * 12 + hh;
            const bf16* vb = RET ? proj + C_RV + h * 64 : xbc + h * 64; const bf16* kb = RET ? proj + C_RK + h * 64 : xbc + 512 + hs * 64;
            c3_stage_rows(lds + C3_V + hs * 128 * C3_RSV, C3_RSV, vb + (size_t)row0 * ld, ld, tid);
            if (RET || step == 0) c3_stage_rows(lds + C3_K + hs * 128 * C3_RSK, C3_RSK, kb + (size_t)row0 * ld, ld, tid);
            c3_stage_rows(lds + C3_H + hs * 128 * C3_RSK, C3_RSK, HT + item * 2 * 4096, 64, tid);
            if ((tid >> 7) == hs) *(u32x4*)(lds + C3_VEC + hs * 2048 + (tid & 127) * 16) = *(const u32x4*)(VECG + item * 512 + (tid & 127) * 4); }
        __syncthreads();
        const int h = RET ? hsub * 2 + step : hsub * 4 + step;
        const bf16* qb = RET ? proj + C_RQ + h * 64 : xbc + 640 + hsub * 64;
        bf16x8 qf[4];
#pragma unroll
        for (int s = 0; s < 4; ++s) qf[s] = *(const bf16x8*)(qb + rowi * ld + s * 16 + hi * 8);
        const float Afi = vec[i], Bbi = vec[128 + i];
        f32x16 y0, y1;
#pragma unroll
        for (int r = 0; r < 16; ++r) { y0[r] = 0.f; y1[r] = 0.f; }
#pragma unroll 2
        for (int jt = 0; jt < 4; ++jt) {
            f32x16 st;
#pragma unroll
            for (int r = 0; r < 16; ++r) st[r] = 0.f;
#pragma unroll
            for (int s = 0; s < 4; ++s) { const bf16x8 kf = *(const bf16x8*)(Kl + (jt * 32 + r32) * C3_RSK + (s * 16 + hi * 8) * 2); st = __builtin_amdgcn_mfma_f32_32x32x16_bf16(kf, qf[s], st, 0, 0, 0); }
#pragma unroll
            for (int g = 0; g < 4; ++g) { const int j0 = jt * 32 + 8 * g + 4 * hi;
                const f32x4 afp = *(const f32x4*)(vec + 256 + j0), bbp = *(const f32x4*)(vec + 384 + j0);
#pragma unroll
                for (int e = 0; e < 4; ++e) { const int j = j0 + e; float f;
                    if (jt < it_) f = __expf(Afi - afp[e]);
                    else if (jt > it_) f = __expf(Bbi - bbp[e]);
                    else { const float ff = (j <= i) ? __expf(Afi - afp[e]) : 0.f; const bool bm = RET ? (j > i) : (j >= i); const float fb = bm ? __expf(Bbi - bbp[e]) : 0.f; f = ff + fb; }
                    st[4 * g + e] *= f; } }
#pragma unroll
            for (int s2 = 0; s2 < 2; ++s2) {
                u32x4 pw; pw.x = pk2(st[8 * s2 + 0], st[8 * s2 + 1]); pw.y = pk2(st[8 * s2 + 2], st[8 * s2 + 3]); pw.z = pk2(st[8 * s2 + 4], st[8 * s2 + 5]); pw.w = pk2(st[8 * s2 + 6], st[8 * s2 + 7]);
                const bf16x8 pb = __builtin_bit_cast(bf16x8, pw);
#pragma unroll
                for (int pt = 0; pt < 2; ++pt) { const unsigned char* vp = Vl + (jt * 32 + 16 * s2) * C3_RSV + pt * 64 + troff;
                    const v4i16_t lo = lds_tr(vp), hi2 = lds_tr(vp + 8 * C3_RSV);
                    const bf16x8 va = {lo[0], lo[1], lo[2], lo[3], hi2[0], hi2[1], hi2[2], hi2[3]};
                    if (pt == 0) y0 = __builtin_amdgcn_mfma_f32_32x32x16_bf16(va, pb, y0, 0, 0, 0); else y1 = __builtin_amdgcn_mfma_f32_32x32x16_bf16(va, pb, y1, 0, 0, 0); }
            }
        }
        { const float ef = __expf(Afi), eb = __expf(Bbi);
#pragma unroll
          for (int pt = 0; pt < 2; ++pt) { f32x16 tf, tb;
#pragma unroll
              for (int r = 0; r < 16; ++r) { tf[r] = 0.f; tb[r] = 0.f; }
              const unsigned char* hf = Hl + (pt * 32 + r32) * C3_RSK + hi * 16;
#pragma unroll
              for (int s = 0; s < 4; ++s) { tf = __builtin_amdgcn_mfma_f32_32x32x16_bf16(*(const bf16x8*)(hf + s * 32), qf[s], tf, 0, 0, 0); tb = __builtin_amdgcn_mfma_f32_32x32x16_bf16(*(const bf16x8*)(hf + 64 * C3_RSK + s * 32), qf[s], tb, 0, 0, 0); }
#pragma unroll
              for (int r = 0; r < 16; ++r) { if (pt == 0) y0[r] += ef * tf[r] + eb * tb[r]; else y1[r] += ef * tf[r] + eb * tb[r]; } } }
        float* Tw = (float*)(lds + (wid < 5 ? C3_V + wid * 8704 : C3_H + (wid - 5) * 8704));
        __syncthreads();
        if (RET) {
            float s1 = 0.f, s2 = 0.f;
#pragma unroll
            for (int r = 0; r < 16; ++r) { y0[r] *= 0.125f; y1[r] *= 0.125f; s1 += y0[r] + y1[r]; s2 += y0[r] * y0[r] + y1[r] * y1[r]; }
            s1 += __shfl_xor(s1, 32); s2 += __shfl_xor(s2, 32);
            const float mu = s1 * (1.f / 64.f), var = fmaxf(s2 * (1.f / 64.f) - mu * mu, 0.f), rs = 1.0f / sqrtf(var + EPS);
#pragma unroll
            for (int r = 0; r < 16; ++r) { y0[r] = (y0[r] - mu) * rs; y1[r] = (y1[r] - mu) * rs; }
        }
#pragma unroll
        for (int g = 0; g < 4; ++g) { *(f32x4*)(Tw + r32 * 68 + 8 * g + 4 * hi) = (f32x4){y0[4 * g], y0[4 * g + 1], y0[4 * g + 2], y0[4 * g + 3]}; *(f32x4*)(Tw + r32 * 68 + 32 + 8 * g + 4 * hi) = (f32x4){y1[4 * g], y1[4 * g + 1], y1[4 * g + 2], y1[4 * g + 3]}; }
        asm volatile("s_waitcnt lgkmcnt(0)" ::: "memory");
        { const int ch = lane & 7; const float dsk = RET ? 0.f : IN(20)[l * 8 + h];
#pragma unroll
          for (int k = 0; k < 4; ++k) { const int tr = (lane >> 3) + 8 * k; const size_t rowt = (size_t)(row0 + it_ * 32 + tr);
              f32x4 ya[2] = {*(const f32x4*)(Tw + tr * 68 + ch * 8), *(const f32x4*)(Tw + tr * 68 + ch * 8 + 4)};
              if (RET) { f32x4 gv[2]; unpack8(*(const u32x4*)(proj + rowt * INWP + C_RG + h * 64 + ch * 8), gv);
#pragma unroll
                  for (int q = 0; q < 2; ++q)
#pragma unroll
                      for (int e = 0; e < 4; ++e) ya[q][e] *= siluf(gv[q][e]);
                  *(u32x4*)(MIX + rowt * D + 256 + h * 64 + ch * 8) = pack8(ya, 1.f);
              } else { f32x4 xv[2], zv[2]; unpack8(*(const u32x4*)(xbc + rowt * 768 + h * 64 + ch * 8), xv); unpack8(*(const u32x4*)(proj + rowt * INWP + C_Z + h * 64 + ch * 8), zv); float sq = 0.f;
#pragma unroll
                  for (int q = 0; q < 2; ++q)
#pragma unroll
                      for (int e = 0; e < 4; ++e) { ya[q][e] = (ya[q][e] + xv[q][e] * dsk) * siluf(zv[q][e]); sq += ya[q][e] * ya[q][e]; }
                  *(u32x4*)(MIX + rowt * D + 512 + h * 64 + ch * 8) = pack8(ya, 1.f);
                  sq += __shfl_xor(sq, 1); sq += __shfl_xor(sq, 2); sq += __shfl_xor(sq, 4); ssqk[k] += sq; } } }
    }
    if (!RET) {
        float* X = (float*)(lds + C3_X);
#pragma unroll
        for (int k = 0; k < 4; ++k) if ((lane & 7) == 0) X[hsub * 128 + it_ * 32 + (lane >> 3) + 8 * k] = ssqk[k];
        asm volatile("s_waitcnt vmcnt(0)" ::: "memory");
        __syncthreads();
        const float* nw = IN(21) + l * 512; const int ch = lane & 7;
#pragma unroll 1
        for (int h = hsub * 4; h < hsub * 4 + 4; ++h) { f32x4 wv[2] = {*(const f32x4*)(nw + h * 64 + ch * 8), *(const f32x4*)(nw + h * 64 + ch * 8 + 4)};
#pragma unroll
            for (int k = 0; k < 4; ++k) { const int tr = it_ * 32 + (lane >> 3) + 8 * k; const float rstd = 1.0f / sqrtf((X[tr] + X[128 + tr]) * (1.f / 512.f) + EPS);
                bf16* mp = MIX + (size_t)(row0 + tr) * D + 512 + h * 64 + ch * 8; f32x4 v[2]; unpack8(*(const u32x4*)mp, v);
                v[0] = v[0] * wv[0] * rstd; v[1] = v[1] * wv[1] * rstd; *(u32x4*)mp = pack8(v, 1.f); } }
    }
    __syncthreads();
}
DEVI void ph_scanC(const P& p, int l, unsigned char* lds) {
    const int tid = otid(), wid = __builtin_amdgcn_readfirstlane(tid >> 6), lane = tid & 63;
    const int NU = 2 * NCC;
    if (gridDim.x == 256) {
        const int c = blockIdx.x;
        if (c < NU) scanC_unit<false>(p, l, c, lds, tid, wid, lane);
        else { const int r = c - NU; scanC_unit<true>(p, l, r, lds, tid, wid, lane); if (r + 124 < NU) scanC_unit<true>(p, l, r + 124, lds, tid, wid, lane); }
    } else {
        for (int u = blockIdx.x; u < 2 * NU; u += gridDim.x) { if (u < NU) scanC_unit<false>(p, l, u, lds, tid, wid, lane); else scanC_unit<true>(p, l, u - NU, lds, tid, wid, lane); }
    }
}
DEVI void ph_scanA(const P& p, int l, unsigned char* lds) { for (int u = gridDim.x - 1 - blockIdx.x; u < 2 * NCC * 3; u += gridDim.x) scanA_unit(p, l, u, lds); }
DEVI void ph_mixer(const P& p, int l, unsigned char* lds) {
    for (int u = blockIdx.x; u < 256; u += gridDim.x) scanB_slab(p, u, 384, 768);
    for (int a = blockIdx.x; a < 256; a += gridDim.x) attn_unit<0>(p, (a & 7) * 32 + (a >> 3), lds, (bf16*)(p.ws + WS_HM));
#if ATTN_PROBE
    if (l == 0) { __syncthreads(); for (int a = blockIdx.x; a < 256; a += gridDim.x) attn_unit<ATTN_PROBE>(p, (a & 7) * 32 + (a >> 3), lds, (bf16*)p.out); }
#endif
    if (l == 0) for (int a = blockIdx.x; a < 8; a += gridDim.x) attn_unit<0>(p, 256 + a, lds, (bf16*)(p.ws + WS_HM));
}

DEVI void ph_sort(const P& p, unsigned char* lds) {
    const int tid = otid(), wid = tid >> 6, lane = tid & 63;
    const int* rt_e = (const int*)(p.ws + WS_RT); int* rt_pos = (int*)(p.ws + WS_RT + 256 * 1024); int* tab = (int*)(p.ws + WS_RT + 384 * 1024); int* rt_tok = (int*)(p.ws + WS_RT + 640 * 1024);
    int* sh = (int*)lds;
    const int G = gridDim.x, R = (NLAT + G - 1) / G;
    for (int blk = blockIdx.x; blk * R < NLAT; blk += G) {
        const int r0 = blk * R, r1 = (r0 + R < NLAT) ? r0 + R : NLAT;
        int ct[8], cb[8];
#pragma unroll
        for (int e = 0; e < 8; ++e) { ct[e] = 0; cb[e] = 0; }
        for (int i = tid; i < NLAT * 2; i += NTHREADS) { const int e = rt_e[i]; const bool bef = (i >> 1) < r0;
#pragma unroll
            for (int x = 0; x < 8; ++x) { const int hit = (e == x) ? 1 : 0; ct[x] += hit; cb[x] += bef ? hit : 0; } }
#pragma unroll
        for (int e = 0; e < 8; ++e) {
#pragma unroll
            for (int o = 1; o < 64; o <<= 1) { ct[e] += __shfl_xor(ct[e], o); cb[e] += __shfl_xor(cb[e], o); }
        }
        __syncthreads();
        if (lane == 0) {
#pragma unroll
            for (int e = 0; e < 8; ++e) { sh[wid * 8 + e] = ct[e]; sh[64 + wid * 8 + e] = cb[e]; } }
        __syncthreads();
        if (tid == 0) { int start = 0, nt = 0;
            for (int e = 0; e < 8; ++e) { int tot = 0, bef = 0; for (int w = 0; w < 8; ++w) { tot += sh[w * 8 + e]; bef += sh[64 + w * 8 + e]; }
                sh[128 + e] = start; sh[136 + e] = start + bef; sh[144 + e] = tot; const int ntile = (tot + 255) >> 8;
                if (blk == 0) { for (int t = 0; t < ntile; ++t) tab[1 + nt + t] = e; }
                nt += ntile; start += ntile * 256; }
            if (blk == 0) tab[0] = nt; }
        __syncthreads();
        { const int n_ent = (r1 - r0) * 2; const bool valid = tid < n_ent; const int e = valid ? rt_e[r0 * 2 + tid] : -1; int rank = 0;
#pragma unroll
          for (int x = 0; x < 8; ++x) { const unsigned long long m = __ballot(e == x); if (e == x) rank = __popcll(m & ((1ull << lane) - 1ull)); if (lane == 0) sh[160 + wid * 8 + x] = __popcll(m); }
          __syncthreads();
          if (valid) { int pos = sh[136 + e] + rank; for (int w = 0; w < wid; ++w) pos += sh[160 + w * 8 + e]; sh[256 + tid] = pos; rt_pos[r0 * 2 + tid] = pos; } }
        __syncthreads();
        { const int n_ent = (r1 - r0) * 2; if (tid < n_ent) rt_tok[sh[256 + tid]] = r0 + (tid >> 1); }
        if (blk == 0) { for (int e = 0; e < 8; ++e) { const int tot = sh[144 + e], beg = sh[128 + e] + tot, end = sh[128 + e] + ((tot + 255) & ~255); for (int i = beg + tid; i < end; i += NTHREADS) rt_tok[i] = 0; } }
        __syncthreads();
    }
}
DEVI void ph_final(const P& p) {
    const int tid = otid(), wid = tid >> 6, lane = tid & 63;
    const float* rt_g = (const float*)(p.ws + WS_RT + 128 * 1024); const int* rt_pos = (const int*)(p.ws + WS_RT + 256 * 1024);
    const bf16* YS = (const bf16*)(p.ws + WS_HS); const float* modv = (const float*)(p.ws + WS_MODV) + (size_t)1 * 3 * 6144; const float* fw = IN(29);
    const int nw = gridDim.x * NWAVES, rpw = (NLAT + nw - 1) / nw, gw = blockIdx.x * NWAVES + wid;
    const int row0 = gw * rpw, row1 = (row0 + rpw < NLAT) ? row0 + rpw : NLAT;
    f32x4 fwv[4], gv[4]; int rc = -1;
#pragma unroll
    for (int j = 0; j < 4; ++j) fwv[j] = *(const f32x4*)(fw + (j * 64 + lane) * 4);
    for (int row = row0; row < row1; ++row) {
        const int b = row >> 13; float* x = p.out + (size_t)row * D;
        if (b != rc) { rc = b;
#pragma unroll
            for (int j = 0; j < 4; ++j) gv[j] = *(const f32x4*)(modv + b * 6144 + 5 * 1024 + (j * 64 + lane) * 4); }
        const float g0 = rt_g[row * 2], g1 = rt_g[row * 2 + 1]; const bf16* y0 = YS + (size_t)rt_pos[row * 2] * D; const bf16* y1 = YS + (size_t)rt_pos[row * 2 + 1] * D;
        f32x4 v[4]; float ss = 0.f;
#pragma unroll
        for (int j = 0; j < 4; ++j) { const int c0 = (j * 64 + lane) * 4; const f32x4 xv = *(const f32x4*)(x + c0); const u32x2 a = *(const u32x2*)(y0 + c0), c = *(const u32x2*)(y1 + c0);
            const f32x4 ya = {bf2f(a.x & 0xffff), bf2f(a.x >> 16), bf2f(a.y & 0xffff), bf2f(a.y >> 16)}, yb = {bf2f(c.x & 0xffff), bf2f(c.x >> 16), bf2f(c.y & 0xffff), bf2f(c.y >> 16)};
            v[j] = xv + gv[j] * (ya * g0 + yb * g1); ss += v[j][0] * v[j][0] + v[j][1] * v[j][1] + v[j][2] * v[j][2] + v[j][3] * v[j][3]; }
        ss = wave_sum(ss); const float rstd = 1.0f / sqrtf(ss * (1.f / D) + EPS);
#pragma unroll
        for (int j = 0; j < 4; ++j) { const int c0 = (j * 64 + lane) * 4; *(f32x4*)(x + c0) = v[j] * rstd * fwv[j]; }
    }
}

#define XB_TMO      128
#define XB_XCNT(j)  (256  + 64 * (j))
#define XB_XSUB(j)  (1280 + 64 * (j))
#define XB_XGEN(j)  (2304 + 64 * (j))
#define XB_TOP      3328
#define XB_TOPGEN   3392
#define XCD_BAR_WORDS 3456
#define XB_SPIN_CAP (1u << 22)
DEVI unsigned xb_ld(unsigned* p)              { return __hip_atomic_load(p, __ATOMIC_RELAXED, __HIP_MEMORY_SCOPE_AGENT); }
DEVI unsigned xb_add(unsigned* p, unsigned v) { return __hip_atomic_fetch_add(p, v, __ATOMIC_RELAXED, __HIP_MEMORY_SCOPE_AGENT); }
DEVI unsigned xb_xcc_id() { return (unsigned)__builtin_amdgcn_s_getreg((3 << 11) | 20) & 0xFu; }
#define XB_SPIN(cond, bar) do { unsigned _sp = 0; while (cond) { __builtin_amdgcn_s_sleep(1); \
    if ((++_sp & 255u) == 0u) { if (xb_ld(&(bar)[XB_TMO])) break; if (_sp > XB_SPIN_CAP) { atomicAdd(&(bar)[XB_TMO], 1u); break; } } } } while (0)
struct XcdBarrier { unsigned* bar; unsigned x; volatile LAS unsigned* st; };
DEVI XcdBarrier xcd_barrier_post(unsigned* bar, volatile LAS unsigned* st) {
    XcdBarrier b; b.bar = bar; b.x = xb_xcc_id(); b.st = st;
    if (threadIdx.x == 0) (void)xb_add(&bar[XB_XCNT(b.x)], 1u);
    return b;
}
DEVI void xcd_barrier_complete(unsigned* bar, unsigned x, unsigned& nloc, unsigned& nx) {
    const unsigned G = gridDim.x * gridDim.y * gridDim.z;
    unsigned sum, cnt, mine, sp = 0u;
    for (;;) {
        sum = 0u; cnt = 0u; mine = 0u;
#pragma unroll
        for (unsigned j = 0; j < 16; ++j) { const unsigned c = xb_ld(&bar[XB_XCNT(j)]); sum += c; cnt += (c > 0u) ? 1u : 0u; mine = (j == x) ? c : mine; }
        if (sum == G) break;
        __builtin_amdgcn_s_sleep(1);
        if ((++sp & 255u) == 0u) { if (xb_ld(&bar[XB_TMO])) break; if (sp > XB_SPIN_CAP) { atomicAdd(&bar[XB_TMO], 1u); break; } }
    }
    nloc = mine > 0u ? mine : 1u; nx = cnt > 0u ? cnt : 1u;
}
DEVI void xcd_barrier(const XcdBarrier& b) {
    asm volatile("s_waitcnt vmcnt(0)" ::: "memory");
    __syncthreads();
    if (threadIdx.x == 0) {
        unsigned* bar = b.bar;
        __builtin_amdgcn_s_waitcnt(0);
        unsigned nloc = b.st[0], nx = b.st[1];
        if (nloc == 0u) { xcd_barrier_complete(bar, b.x, nloc, nx); b.st[0] = nloc; b.st[1] = nx; }
        const unsigned old = xb_add(&bar[XB_XSUB(b.x)], 1u);
        const unsigned gen = old / nloc;
        if (old + 1u == (gen + 1u) * nloc) {
            __builtin_amdgcn_fence(__ATOMIC_RELEASE, "agent");
            asm volatile("s_waitcnt vmcnt(0)" ::: "memory");
            const unsigned og = xb_add(&bar[XB_TOP], 1u);
            const unsigned tg = og / nx;
            if (og + 1u == (tg + 1u) * nx) xb_add(&bar[XB_TOPGEN], 1u);
            else XB_SPIN(xb_ld(&bar[XB_TOPGEN]) == tg, bar);
            __builtin_amdgcn_fence(__ATOMIC_ACQUIRE, "agent");
            xb_add(&bar[XB_XGEN(b.x)], 1u);
            asm volatile("s_waitcnt vmcnt(0)" ::: "memory");
        } else {
            XB_SPIN(xb_ld(&bar[XB_XGEN(b.x)]) == gen, bar);
            __builtin_amdgcn_fence(__ATOMIC_ACQUIRE, "agent");
            asm volatile("s_waitcnt vmcnt(0)" ::: "memory");
        }
    }
    __syncthreads();
}

constexpr int NPHASES = 21;
#ifndef XSYNC
#define XSYNC 0
#endif
#ifndef REP_MASK
#define REP_MASK 0u
#endif
#ifndef PH_MASK
#define PH_MASK 0xffffu
#endif
__global__ void __launch_bounds__(NTHREADS, 2) mk_fwd(P p) {
    extern __shared__ __attribute__((aligned(16))) unsigned char lds[];
    cg::grid_group grid = cg::this_grid();
    const int G = gridDim.x, c = blockIdx.x;
    if (threadIdx.x < 30) ((lds_u64*)(uintptr_t)LDS_PTRS)[threadIdx.x] = (unsigned long long)p.in[threadIdx.x];
    if (threadIdx.x < 2) ((volatile LAS unsigned*)(uintptr_t)LDS_MISC)[threadIdx.x] = 0u;
    __syncthreads();
    XcdBarrier xbar = xcd_barrier_post((unsigned*)(p.ws + WS_CTL) + 1024, (volatile LAS unsigned*)(uintptr_t)LDS_MISC);
    int nsync = 0;
#define GRID_BAR() do { if (nsync == 0) grid.sync(); else xcd_barrier(xbar); ++nsync; } while (0)
    int ph = 0;
#define RUN(kid, ...) do { if (((PH_MASK >> (kid)) & 1u) && ph >= p.ph_lo && ph < p.ph_hi) { __VA_ARGS__; if ((REP_MASK >> (kid)) & 1u) { __VA_ARGS__; } if (ph + 1 < p.ph_hi) { GRID_BAR(); for (int xs_ = 0; xs_ < XSYNC; ++xs_) GRID_BAR(); } } ++ph; } while (0)
    RUN(0, ph_pro(p, lds));
#define LAYER(l) \
        RUN(1, ph_norm<false>(p, l, 0, T, lds, l == 1 ? 11 : 0, 5)); \
        RUN(2, { Gemm g{(const bf16*)(p.ws + WS_HM), (const bf16*)(p.ws + WS_WIN) + (size_t)l * INWP * 1024, 0, nullptr}; DenseSched S{T / 256, INWP / 256, G, c}; \
            EpiInProj E{(bf16*)(p.ws + WS_PROJ), (float*)(p.ws + WS_DT), IN(18) + l * 16, IN(19) + l * 16, (float*)(p.ws + WS_RQP), (float*)(p.ws + WS_RKVP)}; gemm_phase<D, 1024, 1024>(lds, g, S, E); }); \
        RUN(4, { Gemm g{(const bf16*)(p.ws + WS_PROJ), (const bf16*)(p.ws + WS_WQKV) + (size_t)l * 1024 * 384, 0, nullptr}; DenseSched S{T / 256, 4, G, c}; \
            EpiMla E{(bf16*)(p.ws + WS_Q), (bf16*)(p.ws + WS_K), (bf16*)(p.ws + WS_V), (const float*)(p.ws + WS_RQP), (const float*)(p.ws + WS_RKVP), (const float*)(p.ws + WS_ROPE), (const bf16*)(p.ws + WS_PROJ)}; gemm_phase<INWP, 384, 384>(lds, g, S, E); ph_scanA(p, l, lds); }); \
        RUN(5, ph_mixer(p, l, lds)); \
        RUN(6, ph_scanC(p, l, lds)); \
        RUN(8, { Gemm g{(const bf16*)(p.ws + WS_HM), (const bf16*)(p.ws + WS_WOUT) + (size_t)l * 1024 * 1024, 0, nullptr}; DenseSched S{NLAT / 256, 4, G, c}; \
            EpiResid E{l == 0 ? IN(0) : p.out, (const float*)(p.ws + WS_XC), p.out, (float*)(p.ws + WS_XC), (const float*)(p.ws + WS_MODV) + (size_t)l * 3 * 6144, 2}; gemm_phase<D, 1024, 1024>(lds, g, S, E); \
            if (l == 0) { CtxSplitSched S2{4, 256 * 2, G, c}; EpiPart E2{(float*)(p.ws + WS_XBC)}; gemm_phase<D, 1024, 256>(lds, g, S2, E2); } }); \
        RUN(9, ph_norm<l == 1>(p, l, 1, l == 0 ? T : NLAT, lds, l == 0 ? 4 : 0, 2)); \
        if (l == 0) { \
            RUN(10, { Gemm g{(const bf16*)(p.ws + WS_HM), (const bf16*)(p.ws + WS_WGU), 0, nullptr}; DenseSched S{T / 256, 2 * DFF / 256, G, c}; \
                EpiSwiglu E{(bf16*)(p.ws + WS_PROJ), DFF}; gemm_phase<D, 1024, 1024>(lds, g, S, E); }); \
            RUN(11, { Gemm g{(const bf16*)(p.ws + WS_PROJ), (const bf16*)(p.ws + WS_WD), 0, nullptr}; DenseSched S{NLAT / 256, 4, G, c}; \
                EpiResid E{p.out, (const float*)(p.ws + WS_XC), p.out, (float*)(p.ws + WS_XC), (const float*)(p.ws + WS_MODV), 5}; gemm_phase<DFF, DFF, DFF>(lds, g, S, E); \
                CtxSplitSched S2{11, 256 * 2, G, c}; EpiPart E2{(float*)(p.ws + WS_XBC)}; gemm_phase<DFF, DFF, 256>(lds, g, S2, E2); }); \
        } else { \
            RUN(12, { ph_sort(p, lds); __syncthreads(); ph_moew(p, lds); }); \
            RUN(13, { Gemm g{(const bf16*)(p.ws + WS_HM), (const bf16*)(p.ws + WS_WGUE), (size_t)2 * DFE * 1024, (const int*)(p.ws + WS_RT + 640 * 1024)}; MoeSched S{(const int*)(p.ws + WS_RT + 384 * 1024), 2 * DFE / 256, G, c}; \
                EpiSwiglu E{(bf16*)(p.ws + WS_ACTS), DFE}; gemm_phase<D, 1024, 1024, EpiSwiglu, MoeSched, true>(lds, g, S, E); }); \
            RUN(14, { Gemm g{(const bf16*)(p.ws + WS_ACTS), (const bf16*)(p.ws + WS_WDE), (size_t)1024 * DFE, nullptr}; MoeSched S{(const int*)(p.ws + WS_RT + 384 * 1024), 4, G, c}; \
                EpiStore E{(bf16*)(p.ws + WS_HS), D}; gemm_phase<DFE, DFE, DFE>(lds, g, S, E); }); \
            RUN(15, ph_final(p)); \
        }
    LAYER(0)
    LAYER(1)
#undef LAYER
#undef RUN
}

#ifndef MK_ONE_LAUNCH
#define MK_ONE_LAUNCH 1
#endif
extern "C" void kernel_launch(void* const* d_in, const int* in_sizes, int n_in, void* d_out, int out_size, void* d_ws, size_t ws_size, hipStream_t stream) {
    static int grid = 0;
    if (grid == 0) {
        if (n_in != 30 || out_size != NLAT * D || ws_size < WS_END) { fprintf(stderr, "kernel_launch: unexpected problem (n_in %d out %d ws %zu, need %zu)\n", n_in, out_size, ws_size, (size_t)WS_END); grid = -1; return; }
        int dev = 0, cus = 0, per_cu = 0;
        hipGetDevice(&dev); hipDeviceGetAttribute(&cus, hipDeviceAttributeMultiprocessorCount, dev);
        if (hipFuncSetAttribute((const void*)mk_fwd, hipFuncAttributeMaxDynamicSharedMemorySize, LDS_BYTES) != hipSuccess) { fprintf(stderr, "kernel_launch: hipFuncSetAttribute failed\n"); grid = -1; return; }
        if (hipOccupancyMaxActiveBlocksPerMultiprocessor(&per_cu, (const void*)mk_fwd, NTHREADS, LDS_BYTES) != hipSuccess || per_cu < 1) { fprintf(stderr, "kernel_launch: occupancy query failed (%d)\n", per_cu); grid = -1; return; }
        grid = cus;
        fprintf(stderr, "kernel_launch: grid %d (cus %d, per_cu %d)\n", grid, cus, per_cu);
    }
    if (grid < 0) return;
    if (hipMemsetAsync((char*)d_ws + WS_CTL, 0, 65536, stream) != hipSuccess) { fprintf(stderr, "kernel_launch: memset failed\n"); return; }
    P p{};
    for (int i = 0; i < 30; ++i) p.in[i] = (const float*)d_in[i];
    p.out = (float*)d_out; p.ws = (unsigned char*)d_ws;
#if MK_ONE_LAUNCH
    p.ph_lo = 0; p.ph_hi = NPHASES;
    { void* args[] = {&p}; hipError_t e = hipLaunchCooperativeKernel((const void*)mk_fwd, dim3(grid), dim3(NTHREADS), args, LDS_BYTES, stream);
      if (e != hipSuccess) fprintf(stderr, "cooperative launch failed: %s\n", hipGetErrorString(e)); }
#else
    for (int ph = 0; ph < NPHASES; ++ph) {
        p.ph_lo = ph; p.ph_hi = ph + 1;
        void* args[] = {&p}; hipError_t e = hipLaunchCooperativeKernel((const void*)mk_fwd, dim3(grid), dim3(NTHREADS), args, LDS_BYTES, stream);
        if (e != hipSuccess) { fprintf(stderr, "cooperative launch %d failed: %s\n", ph, hipGetErrorString(e)); break; }
    }
#endif
}
```

```cpp
#include <hip/hip_runtime.h>
#include <hip/hip_cooperative_groups.h>
#include <cstdio>
#include <cstdint>
namespace cg = cooperative_groups;
#ifndef ATTN_PROBE
#define ATTN_PROBE 0
#endif

#define DEVI __device__ __forceinline__
typedef unsigned short bf16;
typedef short bf16x8 __attribute__((ext_vector_type(8)));
typedef float f32x4 __attribute__((ext_vector_type(4)));
typedef float f32x2 __attribute__((ext_vector_type(2)));
typedef float f32x16 __attribute__((ext_vector_type(16)));
typedef unsigned u32x4 __attribute__((ext_vector_type(4)));
typedef unsigned u32x2 __attribute__((ext_vector_type(2)));
typedef __bf16 bf16x2_t __attribute__((ext_vector_type(2)));

constexpr int D = 1024, NB = 2, SEQ = 8192, NLAT = NB * SEQ, CL = 256, NCTX = NB * CL, T = NLAT + NCTX;
constexpr int INW = 2736, INWP = 2816;
constexpr int C_CQ = 0, C_CKV = 256, C_KPE = 384, C_RQ = 416, C_RK = 672, C_RV = 928, C_RG = 1184, C_Z = 1440, C_XBC = 1952, C_DTF = 2720, C_DTB = 2728;
constexpr int DFF = 2816, DFE = 1408, NEXP = 8;
constexpr float EPS = 1e-6f;
constexpr int MOE_MAXROWS = 34816;

constexpr size_t MiB = 1u << 20;
constexpr size_t WS_CTL = 0;
constexpr size_t WS_MODV = 1 * MiB;
constexpr size_t WS_ROPE = WS_MODV + 256 * 1024;
constexpr size_t WS_RQ = WS_MODV + 512 * 1024;
constexpr size_t WS_RKV = WS_MODV + 640 * 1024;
constexpr size_t WS_WIN = 2 * MiB;
constexpr size_t WS_WQKV = 13 * MiB;
constexpr size_t WS_WOUT = 15 * MiB;
constexpr size_t WS_WGU = 19 * MiB;
constexpr size_t WS_WD = 30 * MiB;
constexpr size_t WS_XC = 36 * MiB;
constexpr size_t WS_RT = 38 * MiB;
constexpr size_t WS_DT = 39 * MiB;
constexpr size_t WS_RQP = 41 * MiB + 128 * 1024;
constexpr size_t WS_RKVP = 41 * MiB + 512 * 1024;
constexpr size_t DYN = 42 * MiB;
constexpr size_t WS_HM = DYN;
constexpr size_t WS_PROJ = DYN + 33 * MiB;
constexpr size_t WS_XBC = DYN + 124 * MiB;
constexpr size_t WS_Q = DYN + 149 * MiB;
constexpr size_t WS_K = DYN + 161 * MiB + 512 * 1024;
constexpr size_t WS_V = DYN + 174 * MiB;
constexpr size_t WS_ST = DYN + 182 * MiB + 512 * 1024;
constexpr size_t WS_HT = WS_ST + (size_t)1584 * 2 * 4096 * 4;
constexpr size_t WS_CD = WS_RT + 512 * 1024;
constexpr size_t WS_VEC = WS_HT + (size_t)1584 * 2 * 4096 * 2;
constexpr size_t WS_WGUE = DYN + 33 * MiB;
constexpr size_t WS_WDE = DYN + 77 * MiB;
constexpr size_t WS_HS = DYN + 99 * MiB;
constexpr size_t WS_ACTS = DYN + 167 * MiB;
constexpr size_t WS_END = DYN + 261 * MiB;
static_assert(WS_HM + (size_t)T * 1024 * 2 <= WS_PROJ && WS_PROJ + (size_t)T * 2816 * 2 <= WS_XBC && WS_XBC + (size_t)T * 768 * 2 <= WS_Q &&
              WS_Q + (size_t)T * 384 * 2 <= WS_K && WS_K + (size_t)T * 384 * 2 <= WS_V && WS_V + (size_t)T * 256 * 2 <= WS_ST && WS_VEC + (size_t)1584 * 512 * 4 <= WS_END, "ws map (mixer)");
static_assert(WS_WGUE + (size_t)8 * 2816 * 1024 * 2 <= WS_WDE && WS_WDE + (size_t)8 * 1024 * 1408 * 2 <= WS_HS && WS_HS + (size_t)MOE_MAXROWS * 1024 * 2 <= WS_ACTS &&
              WS_ACTS + (size_t)MOE_MAXROWS * 1408 * 2 <= WS_END, "ws map (moe)");
static_assert(WS_DT + (size_t)T * 32 * 4 <= DYN && WS_WD + (size_t)1024 * 2816 * 2 <= WS_XC && WS_WIN + (size_t)2 * 2816 * 1024 * 2 <= WS_WQKV, "ws map (static)");

constexpr int NTHREADS = 512, NWAVES = 8;
constexpr int LDS_BYTES = 147456;

struct P { const float* in[30]; float* out; unsigned char* ws; int ph_lo, ph_hi; };
constexpr int LDS_MISC = 147456 - 512;
constexpr int LDS_PTRS = 147456 - 256;
typedef __attribute__((address_space(3))) unsigned long long lds_u64;
DEVI const float* inptr(int i) {
    const unsigned long long v = ((lds_u64*)(uintptr_t)LDS_PTRS)[i];
    const unsigned lo = __builtin_amdgcn_readfirstlane((unsigned)v), hi = __builtin_amdgcn_readfirstlane((unsigned)(v >> 32));
    return (const float*)(((unsigned long long)hi << 32) | lo);
}
#define IN(i) inptr(i)
DEVI int otid() { int t = threadIdx.x; asm volatile("" : "+v"(t)); return t; }

DEVI float bf2f(bf16 x) { return __uint_as_float(((unsigned)x) << 16); }
DEVI unsigned pk2(float lo, float hi) { f32x2 v = {lo, hi}; bf16x2_t b = __builtin_convertvector(v, bf16x2_t); return __builtin_bit_cast(unsigned, b); }
DEVI bf16 f2bf(float x) { return (bf16)(pk2(x, 0.f) & 0xffffu); }
DEVI float wave_sum(float v) {
#pragma unroll
    for (int o = 1; o < 64; o <<= 1) v += __shfl_xor(v, o);
    return v;
}
DEVI float siluf(float x) { return x * __builtin_amdgcn_rcpf(1.f + __builtin_amdgcn_exp2f(-1.4426950408889634f * x)); }
DEVI float softplusf(float x) { const float e = __expf(-fabsf(x)); return fmaxf(x, 0.f) + (e < 1e-3f ? e * (1.f - 0.5f * e) : __logf(1.f + e)); }
DEVI int rope_src(int p) { const int q = p & 15, s = (q & 1) ? 8 + (q >> 1) : (q >> 1); return (p & 16) + s; }

#define LAS __attribute__((address_space(3)))
struct Unit { int pm, pn, e, koff; };
struct Gemm { const bf16* A; const bf16* Bt; size_t bstride; const int* rowtab; };
constexpr int BM = 256, BK = 64, HALF = 128, HTB = HALF * BK * 2, STAGE_BYTES = 8 * HTB, NXCD = 8, WGM = 8;
__host__ __device__ __forceinline__ int lds_byte(int r, int c) { const int st = (r >> 4) * 2 + (c >> 5), rr = r & 15, cc = c & 31, ob = rr * 64 + cc * 2; return st * 1024 + (ob ^ (((ob >> 9) & 1) << 5)); }
__host__ __device__ __forceinline__ int perm32(int rho) { const int n = rho >> 4, i = rho & 15; return 8 * (i >> 2) + 4 * n + (i & 3); }
__host__ __device__ __forceinline__ void stage_rc(int b, int& R, int& C) { const int st = b / 1024, sb = b % 1024, swz = sb ^ (((sb >> 9) & 1) << 5); R = (st >> 1) * 16 + swz / 64; C = (st & 1) * 32 + (swz % 64) / 2; }
struct DenseSched {
    int nM, nN, G, c;
    DEVI bool next(int i, Unit& u) const {
        const int nwg = nM * nN; const long L = (long)i * G + c; if (L >= nwg) return false;
        int wgid = (int)L; { const int q = nwg / NXCD, r = nwg % NXCD, xcd = wgid % NXCD, off = wgid / NXCD; wgid = (xcd < r ? xcd * (q + 1) : r * (q + 1) + (xcd - r) * q) + off; }
        const int nig = WGM * nN, gid = wgid / nig, fm = gid * WGM, gsz = (nM - fm) < WGM ? (nM - fm) : WGM;
        u.pm = fm + ((wgid % nig) % gsz); u.pn = (wgid % nig) / gsz; u.e = 0; u.koff = 0; return true;
    }
};
struct CtxSplitSched {
    int nsplit, kbytes, G, c;
    DEVI bool next(int i, Unit& u) const { const int id = i * G + c; if (id >= 8 * nsplit) return false; const int tile = id & 7, ks = id >> 3; u.pm = 64 + (tile >> 2); u.pn = tile & 3; u.e = ks; u.koff = ks * kbytes; return true; }
};
struct MoeSched {
    const int* tab; int nN, G, c;
    DEVI bool next(int i, Unit& u) const { DenseSched d{tab[0], nN, G, c}; if (!d.next(i, u)) return false; u.e = tab[1 + u.pm]; return true; }
};
template <int LDA, int LDB, int KK, class Epi, class Sched, bool GATHER = false>
DEVI void gemm_phase(unsigned char* lds_generic, const Gemm g, const Sched& S, const Epi& E) {
    LAS unsigned char* lds = (LAS unsigned char*)lds_generic;
    const int tid = otid(), wid = __builtin_amdgcn_readfirstlane(tid >> 6), lane = tid & 63, wr = wid >> 2, wc = wid & 3, fr = lane & 15, fq = lane >> 4;
    constexpr int nt = KK / BK; static_assert(KK % 128 == 0, "K must be a multiple of 128");
    unsigned voffA[2], voffB[2]; int Rr[2], Cc[2];
#pragma unroll
    for (int i = 0; i < 2; ++i) { int R, C; stage_rc(tid * 16 + i * 8192, R, C); Rr[i] = R; Cc[i] = C; voffA[i] = (unsigned)(R * LDA + C) * 2u; const int Rb = Epi::PERM ? ((R & ~31) + perm32(R & 31)) : R; voffB[i] = (unsigned)(Rb * LDB + C) * 2u; }
    unsigned cv0[2] = {voffA[0], voffA[1]}, cv1[2] = {voffA[0], voffA[1]}, nv0[2] = {voffA[0], voffA[1]}, nv1[2] = {voffA[0], voffA[1]};
#define PG8_ROWS(u, v0, v1) do { if (GATHER) { _Pragma("unroll") for (int i_ = 0; i_ < 2; ++i_) { v0[i_] = (unsigned)(g.rowtab[(u).pm * BM + Rr[i_]] * LDA + Cc[i_]) * 2u; v1[i_] = (unsigned)(g.rowtab[(u).pm * BM + HALF + Rr[i_]] * LDA + Cc[i_]) * 2u; } } } while (0)
    constexpr size_t kstep = (size_t)(BK * 2), hstepA = GATHER ? (size_t)0 : (size_t)HALF * LDA * 2, hstepB = (size_t)HALF * LDB * 2, tstepA = GATHER ? (size_t)0 : (size_t)2 * HALF * LDA * 2, tstepB = 2 * hstepB;
    const unsigned ldsw = (unsigned)wid * 1024u;
    const int aoff = lds_byte(wr * 64 + fr, fq * 8), boff = lds_byte(wc * 32 + fr, fq * 8);
#define PG8_SA(b, h) (((b) * 2 + (h)) * HTB)
#define PG8_SB(b, h) ((4 + (b) * 2 + (h)) * HTB)
#define PG8_STAGE(bufoff, gbase, voff) do { _Pragma("unroll") for (int _i = 0; _i < 2; ++_i) \
        __builtin_amdgcn_global_load_lds((const unsigned*)((const char*)(gbase) + (voff)[_i]), (LAS unsigned*)(lds + (bufoff) + ldsw + _i * 8192), 16, 0, 0); } while (0)
#define PG8_LDA(dst, b, h) do { _Pragma("unroll") for (int m = 0; m < 4; ++m) _Pragma("unroll") for (int k = 0; k < 2; ++k) dst[m][k] = *(const LAS bf16x8*)(lds + PG8_SA(b, h) + aoff + m * 2048 + k * 1024); } while (0)
#define PG8_LDB(dst, b, h) do { _Pragma("unroll") for (int n = 0; n < 2; ++n) _Pragma("unroll") for (int k = 0; k < 2; ++k) dst[n][k] = *(const LAS bf16x8*)(lds + PG8_SB(b, h) + boff + n * 2048 + k * 1024); } while (0)
#define PG8_MMA(ai, bj, At, Bt) do { __builtin_amdgcn_s_setprio(1); _Pragma("unroll") for (int m = 0; m < 4; ++m) _Pragma("unroll") for (int n = 0; n < 2; ++n) _Pragma("unroll") for (int k = 0; k < 2; ++k) \
        acc[ai][bj][m][n] = __builtin_amdgcn_mfma_f32_16x16x32_bf16(Bt[n][k], At[m][k], acc[ai][bj][m][n], 0, 0, 0); __builtin_amdgcn_s_setprio(0); } while (0)
#define PG8_WAIT_V(n) asm volatile("s_waitcnt vmcnt(" #n ")" ::: "memory")
#define PG8_WAIT_L(n) asm volatile("s_waitcnt lgkmcnt(" #n ")" ::: "memory")
#define PG8_BAR __builtin_amdgcn_s_barrier()
#define PG8_SCHED __builtin_amdgcn_sched_barrier(0)
    Unit cur, nxt; int ui = 0;
    if (!S.next(0, cur)) return;
    f32x4 acc[2][2][4][2];
#pragma unroll
    for (int a = 0; a < 2; ++a)
#pragma unroll
        for (int b = 0; b < 2; ++b)
#pragma unroll
            for (int m = 0; m < 4; ++m)
#pragma unroll
                for (int n = 0; n < 2; ++n) acc[a][b][m][n] = (f32x4){0.f, 0.f, 0.f, 0.f};
    bf16x8 At[4][2], B0[2][2], B1[2][2];
    const char* cA = (const char*)g.A + (size_t)cur.pm * tstepA + cur.koff; const char* cB = (const char*)(g.Bt + (size_t)cur.e * g.bstride) + (size_t)cur.pn * tstepB + cur.koff;
    PG8_WAIT_V(0); PG8_WAIT_L(0); __syncthreads();
    PG8_ROWS(cur, cv0, cv1);
    PG8_STAGE(PG8_SB(0, 0), cB, voffB); PG8_STAGE(PG8_SB(0, 1), cB + hstepB, voffB); PG8_STAGE(PG8_SA(0, 0), cA, cv0); PG8_STAGE(PG8_SA(0, 1), cA + hstepA, cv1);
    if (wr == 1) PG8_BAR;
    PG8_WAIT_V(2); PG8_BAR;
    PG8_STAGE(PG8_SB(1, 0), cB + kstep, voffB); PG8_STAGE(PG8_SA(1, 0), cA + kstep, cv0); PG8_STAGE(PG8_SB(1, 1), cB + hstepB + kstep, voffB);
    PG8_WAIT_V(6); PG8_BAR;
    for (;;) {
        const bool has_next = S.next(ui + 1, nxt);
        if (has_next) PG8_ROWS(nxt, nv0, nv1);
        const char* nA = has_next ? (const char*)g.A + (size_t)nxt.pm * tstepA + nxt.koff : cA; const char* nB = has_next ? (const char*)(g.Bt + (size_t)nxt.e * g.bstride) + (size_t)nxt.pn * tstepB + nxt.koff : cB;
#pragma unroll 1
        for (int t = 0; t < nt; t += 2) {
            const bool last = (t == nt - 2);
            const char* a1 = cA + (size_t)(t + 1) * kstep;
            const char* a2 = last ? nA : cA + (size_t)(t + 2) * kstep; const char* b2 = last ? nB : cB + (size_t)(t + 2) * kstep;
            const char* a3 = a2 + kstep; const char* b3 = b2 + kstep;
            unsigned s0[2] = {cv0[0], cv0[1]}, s1[2] = {cv1[0], cv1[1]};
            if (GATHER && last && has_next) { s0[0] = nv0[0]; s0[1] = nv0[1]; s1[0] = nv1[0]; s1[1] = nv1[1]; }
            PG8_LDB(B0, 0, 0); PG8_LDB(B1, 0, 1); PG8_SCHED; PG8_LDA(At, 0, 0); PG8_STAGE(PG8_SA(1, 1), a1 + hstepA, cv1);
            PG8_WAIT_V(8); PG8_WAIT_L(0); PG8_BAR; PG8_MMA(0, 0, At, B0); PG8_MMA(0, 1, At, B1); PG8_BAR; PG8_SCHED;
            PG8_LDA(At, 0, 1); PG8_STAGE(PG8_SB(0, 0), b2, voffB); PG8_STAGE(PG8_SB(0, 1), b2 + hstepB, voffB); PG8_STAGE(PG8_SA(0, 0), a2, s0);
            PG8_WAIT_V(8); PG8_WAIT_L(0); PG8_BAR; PG8_MMA(1, 0, At, B0); PG8_MMA(1, 1, At, B1); PG8_BAR; PG8_SCHED;
            PG8_LDB(B0, 1, 0); PG8_LDB(B1, 1, 1); PG8_SCHED; PG8_LDA(At, 1, 0); PG8_STAGE(PG8_SA(0, 1), a2 + hstepA, s1);
            PG8_WAIT_V(8); PG8_WAIT_L(0); PG8_BAR; PG8_MMA(0, 0, At, B0); PG8_MMA(0, 1, At, B1); PG8_BAR; PG8_SCHED;
            PG8_LDA(At, 1, 1); PG8_STAGE(PG8_SB(1, 0), b3, voffB); PG8_STAGE(PG8_SB(1, 1), b3 + hstepB, voffB); PG8_STAGE(PG8_SA(1, 0), a3, s0);
            PG8_WAIT_V(8); PG8_WAIT_L(0); PG8_BAR; PG8_MMA(1, 0, At, B0); PG8_MMA(1, 1, At, B1); PG8_BAR; PG8_SCHED;
        }
        if (wr == 0) PG8_BAR;
        E(acc, cur, wr, wc, fr, fq);
        if (!has_next) break;
#pragma unroll
        for (int a = 0; a < 2; ++a)
#pragma unroll
            for (int b = 0; b < 2; ++b)
#pragma unroll
                for (int m = 0; m < 4; ++m)
#pragma unroll
                    for (int n = 0; n < 2; ++n) acc[a][b][m][n] = (f32x4){0.f, 0.f, 0.f, 0.f};
        cur = nxt; cA = nA; cB = nB; ++ui;
        if (GATHER) { cv0[0] = nv0[0]; cv0[1] = nv0[1]; cv1[0] = nv1[0]; cv1[1] = nv1[1]; }
        if (wr == 1) PG8_BAR;
    }
    PG8_WAIT_V(0);
    PG8_BAR;
#undef PG8_ROWS
#undef PG8_SA
#undef PG8_SB
#undef PG8_STAGE
#undef PG8_LDA
#undef PG8_LDB
#undef PG8_MMA
#undef PG8_WAIT_V
#undef PG8_WAIT_L
#undef PG8_BAR
#undef PG8_SCHED
}
#define EPI_LOOP_ROWS _Pragma("unroll") for (int ai = 0; ai < 2; ++ai) _Pragma("unroll") for (int m = 0; m < 4; ++m)
#define EPI_ROW (u.pm * 256 + ai * 128 + wr * 64 + m * 16 + fr)
#define EPI_COL(bj, n) (u.pn * 256 + (bj) * 128 + wc * 32 + (n) * 16 + fq * 4)
#define EPI_COL8(bj) (u.pn * 256 + (bj) * 128 + wc * 32 + fq * 8)
DEVI void st_bf16x8(bf16* p, f32x4 a, f32x4 b) { u32x4 w; w.x = pk2(a[0], a[1]); w.y = pk2(a[2], a[3]); w.z = pk2(b[0], b[1]); w.w = pk2(b[2], b[3]); *(u32x4*)p = w; }

DEVI void st_bf16x4(bf16* p, f32x4 v) { u32x2 w; w.x = pk2(v[0], v[1]); w.y = pk2(v[2], v[3]); *(u32x2*)p = w; }

struct EpiInProj {
    static constexpr bool PERM = true;
    bf16* proj; float* dt; const float* dt_bias; const float* a_log; float* rqp; float* rkvp;
    DEVI void operator()(const f32x4 (&acc)[2][2][4][2], const Unit& u, int wr, int wc, int fr, int fq) const {
        EPI_LOOP_ROWS { const int row = EPI_ROW;
            if (u.pn <= 1) { float ssq = 0.f;
#pragma unroll
                for (int bj = 0; bj < 2; ++bj) if (u.pn == 0 || bj == 0) {
#pragma unroll
                    for (int n = 0; n < 2; ++n) { const f32x4 v = acc[ai][bj][m][n]; ssq += (v[0] * v[0] + v[1] * v[1]) + (v[2] * v[2] + v[3] * v[3]); } }
                ssq += __shfl_xor(ssq, 16); ssq += __shfl_xor(ssq, 32);
                if (fq == 0) (u.pn == 0 ? rqp : rkvp)[(size_t)row * 4 + wc] = ssq; }
#pragma unroll
            for (int bj = 0; bj < 2; ++bj) { const int col = EPI_COL8(bj);
                if (col < C_DTF) st_bf16x8(proj + (size_t)row * INWP + col, acc[ai][bj][m][0], acc[ai][bj][m][1]);
                else if (col < INW) { const int j0 = col - C_DTF;
#pragma unroll
                    for (int n = 0; n < 2; ++n) { const f32x4 v = acc[ai][bj][m][n]; f32x4 dv, lv;
#pragma unroll
                        for (int i = 0; i < 4; ++i) { const float d_ = softplusf(v[i] + dt_bias[j0 + 4 * n + i]); dv[i] = d_; lv[i] = -d_ * __expf(a_log[j0 + 4 * n + i]); }
                        *(f32x4*)(dt + (size_t)row * 32 + j0 + 4 * n) = dv; *(f32x4*)(dt + (size_t)row * 32 + 16 + j0 + 4 * n) = lv; } } } }
    }
};
struct EpiMla {
    static constexpr bool PERM = false;
    bf16 *Q, *K, *V; const float *rqp, *rkvp; const float* rope; const bf16* proj;
    DEVI void operator()(const f32x4 (&acc)[2][2][4][2], const Unit& u, int wr, int wc, int fr, int fq) const {
        EPI_LOOP_ROWS { const int row = EPI_ROW; float sq = 0.f, skv = 0.f;
            if (u.pn <= 1) { const f32x4 pq = *(const f32x4*)(rqp + (size_t)row * 4); sq = __builtin_amdgcn_rsqf(((pq[0] + pq[1]) + (pq[2] + pq[3])) * (1.f / 256.f) + EPS); }
            if (u.pn >= 2) { const f32x4 pk = *(const f32x4*)(rkvp + (size_t)row * 4); skv = __builtin_amdgcn_rsqf(((pk[0] + pk[1]) + (pk[2] + pk[3])) * (1.f / 128.f) + EPS); }
            const int pos = row & (SEQ - 1), gr = pos >> 6, gc = pos & 63;
#pragma unroll
            for (int bj = 0; bj < 2; ++bj)
#pragma unroll
                for (int n = 0; n < 2; ++n) { const int col = EPI_COL(bj, n); f32x4 v = acc[ai][bj][m][n];
                    if (col < 384) { v = v * sq; const int d = col % 96;
                        if (d >= 64 && row < NLAT) { const int pp = (d - 64) >> 1;
#pragma unroll
                            for (int i = 0; i < 2; ++i) { const int pi = pp + i; const float* tb = (pi < 8) ? rope + (gr * 8 + pi) * 2 : rope + 2048 + (gc * 8 + (pi - 8)) * 2;
                                const float c = tb[0], s = tb[1], x0 = v[2 * i], x1 = v[2 * i + 1]; v[2 * i] = x0 * c - x1 * s; v[2 * i + 1] = x1 * c + x0 * s; } }
                        st_bf16x4(Q + (size_t)row * 384 + col, v); }
                    else if (col < 416) { const int d0 = col - 384, pp = d0 >> 1; const u32x2 raw = *(const u32x2*)(proj + (size_t)row * INWP + C_KPE + d0);
                        f32x4 x = {bf2f(raw.x & 0xffff), bf2f(raw.x >> 16), bf2f(raw.y & 0xffff), bf2f(raw.y >> 16)};
                        if (row < NLAT) {
#pragma unroll
                            for (int i = 0; i < 2; ++i) { const int pi = pp + i; const float* tb = (pi < 8) ? rope + (gr * 8 + pi) * 2 : rope + 2048 + (gc * 8 + (pi - 8)) * 2;
                                const float c = tb[0], s = tb[1], x0 = x[2 * i], x1 = x[2 * i + 1]; x[2 * i] = x0 * c - x1 * s; x[2 * i + 1] = x1 * c + x0 * s; } }
#pragma unroll
                        for (int h = 0; h < 4; ++h) st_bf16x4(K + (size_t)row * 384 + h * 96 + 64 + d0, x); }
                    else if (col >= 512 && col < 768) { const int c = col - 512; st_bf16x4(K + (size_t)row * 384 + (c >> 6) * 96 + (c & 63), v * skv); }
                    else if (col >= 768) { st_bf16x4(V + (size_t)row * 256 + (col - 768), v * skv); } }
            asm volatile("" ::: "memory"); }
    }
};
struct EpiResid {
    static constexpr bool PERM = true;
    const float* src_lat; const float* src_ctx; float* dst_lat; float* dst_ctx; const float* modv_l; int gidx;
    DEVI void operator()(const f32x4 (&acc)[2][2][4][2], const Unit& u, int wr, int wc, int fr, int fq) const {
        EPI_LOOP_ROWS { const int row = EPI_ROW; const bool lat = row < NLAT; const int r = lat ? (row >> 13) : 2;
            const float* s = lat ? src_lat + (size_t)row * D : src_ctx + (size_t)(row - NLAT) * D; float* d = lat ? dst_lat + (size_t)row * D : dst_ctx + (size_t)(row - NLAT) * D;
            const float* gp = modv_l + r * 6144 + gidx * 1024;
#pragma unroll
            for (int bj = 0; bj < 2; ++bj)
#pragma unroll
                for (int n = 0; n < 2; ++n) { const int col = EPI_COL8(bj) + 4 * n; const f32x4 gv = *(const f32x4*)(gp + col), sv = *(const f32x4*)(s + col);
                    *(f32x4*)(d + col) = sv + gv * acc[ai][bj][m][n]; } }
    }
};
struct EpiPart {
    static constexpr bool PERM = true;
    float* part;
    DEVI void operator()(const f32x4 (&acc)[2][2][4][2], const Unit& u, int wr, int wc, int fr, int fq) const {
        EPI_LOOP_ROWS { const int row = EPI_ROW; float* d = part + ((size_t)u.e * NCTX + (row - NLAT)) * D;
#pragma unroll
            for (int bj = 0; bj < 2; ++bj)
#pragma unroll
                for (int n = 0; n < 2; ++n) *(f32x4*)(d + EPI_COL8(bj) + 4 * n) = acc[ai][bj][m][n]; }
    }
};
struct EpiSwiglu {
    static constexpr bool PERM = true;
    bf16* act; int ldc;
    DEVI void operator()(const f32x4 (&acc)[2][2][4][2], const Unit& u, int wr, int wc, int fr, int fq) const {
        EPI_LOOP_ROWS { const int row = EPI_ROW; f32x4 o[2];
#pragma unroll
            for (int n = 0; n < 2; ++n) { const f32x4 gt = acc[ai][0][m][n], up = acc[ai][1][m][n];
#pragma unroll
                for (int i = 0; i < 4; ++i) o[n][i] = siluf(gt[i]) * up[i]; }
            st_bf16x8(act + (size_t)row * ldc + u.pn * 128 + wc * 32 + fq * 8, o[0], o[1]); }
    }
};
struct EpiStore {
    static constexpr bool PERM = true;
    bf16* o; int ldc;
    DEVI void operator()(const f32x4 (&acc)[2][2][4][2], const Unit& u, int wr, int wc, int fr, int fq) const {
        EPI_LOOP_ROWS { const int row = EPI_ROW;
#pragma unroll
            for (int bj = 0; bj < 2; ++bj) st_bf16x8(o + (size_t)row * ldc + EPI_COL8(bj), acc[ai][bj][m][0], acc[ai][bj][m][1]); }
    }
};

struct CvtSrc { const float* src; int ld; int ncols; bool perm; const float* ks; float sc; };
DEVI void cvt_tile(const CvtSrc t, bf16* dst, int Kd, int nd0, int kd0, LAS float* scr, int lane) {
    const int n = lane & 31;
    if (t.src) {
        const int nc = (n < t.ncols) ? n : t.ncols - 1; const float msk = (n < t.ncols) ? t.sc : 0.f;
        const float* sp0 = t.src + (size_t)(lane >> 5) * t.ld + nc;
        float v[32];
#pragma unroll
        for (int i = 0; i < 32; ++i) v[i] = sp0[(size_t)(2 * i) * t.ld];
        if (t.ks) {
#pragma unroll
            for (int i = 0; i < 32; ++i) v[i] *= t.ks[2 * i + (lane >> 5)];
        }
#pragma unroll
        for (int i = 0; i < 32; ++i) scr[(2 * i + (lane >> 5)) * 33 + n] = v[i] * msk;
    } else {
#pragma unroll 8
        for (int i = 0; i < 32; ++i) scr[(2 * i + (lane >> 5)) * 33 + n] = 0.f;
    }
    asm volatile("s_waitcnt lgkmcnt(0)" ::: "memory");
    const int c = lane & 7;
#pragma unroll
    for (int j = 0; j < 4; ++j) { const int nn = (lane >> 3) + 8 * j; const LAS float* sp = scr + (8 * c) * 33 + (t.perm ? rope_src(nn) : nn);
        u32x4 o; o.x = pk2(sp[0 * 33], sp[1 * 33]); o.y = pk2(sp[2 * 33], sp[3 * 33]); o.z = pk2(sp[4 * 33], sp[5 * 33]); o.w = pk2(sp[6 * 33], sp[7 * 33]);
        *(u32x4*)(dst + (size_t)(nd0 + nn) * Kd + kd0 + 8 * c) = o; }
    asm volatile("s_waitcnt lgkmcnt(0)" ::: "memory");
}
template <class F>
DEVI void cvt_job(bf16* dst, int Nd, int Kd, F f, LAS float* scr, int gw, int ngw, int lane) {
    const int ntn = Nd >> 5, ntk = Kd >> 6;
    for (int it = gw; it < ntn * ntk; it += ngw) { const int nt = it % ntn, kt = it / ntn; cvt_tile(f(nt, kt), dst, Kd, nt * 32, kt * 64, scr, lane); }
}
DEVI void ph_pro(const P& p, unsigned char* lds) {
    const int tid = otid(), wid = tid >> 6, lane = tid & 63;
    __syncthreads();
    float* modv = (float*)(p.ws + WS_MODV);
    float* red = (float*)lds;
    for (int item = blockIdx.x; item < 192; item += gridDim.x) {
        const int l = item / 96, n = (item % 96) * 64 + lane;
        const float* W = IN(4) + (size_t)l * 1024 * 6144;
        float a0 = 0.f, a1 = 0.f, a2 = 0.f;
        for (int k = wid * 128; k < wid * 128 + 128; ++k) {
            const float w = W[(size_t)k * 6144 + n];
            a0 += siluf(IN(1)[k]) * w; a1 += siluf(IN(1)[1024 + k]) * w; a2 += siluf(IN(3)[k]) * w;
        }
        red[(wid * 3 + 0) * 64 + lane] = a0; red[(wid * 3 + 1) * 64 + lane] = a1; red[(wid * 3 + 2) * 64 + lane] = a2;
        __syncthreads();
        if (tid < 192) { const int r = tid >> 6, ln = tid & 63; float s = 0.f;
            for (int w = 0; w < 8; ++w) s += red[(w * 3 + r) * 64 + ln];
            const int nn = (item % 96) * 64 + ln; modv[(l * 3 + r) * 6144 + nn] = s + IN(5)[l * 6144 + nn]; }
        __syncthreads();
    }
    if (blockIdx.x == gridDim.x - 1) {
        float* rope = (float*)(p.ws + WS_ROPE);
        for (int idx = tid; idx < 1536; idx += NTHREADS) {
            const int i = idx & 7, pos = (idx < 1024) ? (idx >> 3) : ((idx - 1024) >> 3);
            const float invf = (i == 0) ? 1.f : (i == 1) ? 0.31622776601683794f : (i == 2) ? 0.1f : (i == 3) ? 0.03162277660168379f : (i == 4) ? 0.01f : (i == 5) ? 0.003162277660168379f : (i == 6) ? 0.001f : 0.00031622776601683794f;
            const float ang = (float)pos * invf;
            double rev = (double)ang * 0.15915494309189535; rev -= __builtin_rint(rev);
            const float fr = (float)rev;
            rope[idx * 2] = __builtin_amdgcn_cosf(fr); rope[idx * 2 + 1] = __builtin_amdgcn_sinf(fr);
        }
    }
    __syncthreads();
    LAS float* scr = (LAS float*)(LAS unsigned char*)lds + wid * (64 * 33);
    const int gw = blockIdx.x * NWAVES + wid, ngw = gridDim.x * NWAVES;
    for (int l = 0; l < 2; ++l) {
        { const float* W = IN(8) + (size_t)l * 1024 * INW;
          cvt_job((bf16*)(p.ws + WS_WIN) + (size_t)l * INWP * 1024, INWP, 1024, [=](int nt, int kt) -> CvtSrc {
              const int n0 = nt * 32; if (n0 >= INW) return CvtSrc{nullptr, 0, 0, false, nullptr, 1.f};
              return CvtSrc{W + (size_t)(kt * 64) * INW + n0, INW, (INW - n0 < 32) ? INW - n0 : 32, n0 == C_KPE, nullptr, 1.f}; }, scr, gw, ngw, lane); }
        { const float* Wq = IN(11) + (size_t)l * 256 * 384; const float* qn = IN(10) + l * 256; const float* Wk = IN(13) + (size_t)l * 128 * 256; const float* Wv = IN(14) + (size_t)l * 128 * 256; const float* kn = IN(12) + l * 128;
          const float QS = 0.10206207261596577f * 1.4426950408889634f;
          cvt_job((bf16*)(p.ws + WS_WQKV) + (size_t)l * 1024 * 384, 1024, 384, [=](int nt, int kt) -> CvtSrc {
              const int n0 = nt * 32, k0 = kt * 64;
              if (n0 < 384) { if (k0 >= 256) return CvtSrc{nullptr, 0, 0, false, nullptr, 1.f}; return CvtSrc{Wq + (size_t)k0 * 384 + n0, 384, 32, (n0 % 96) == 64, qn + k0, QS}; }
              if (n0 < 512 || k0 < 256) return CvtSrc{nullptr, 0, 0, false, nullptr, 1.f};
              if (n0 < 768) return CvtSrc{Wk + (size_t)(k0 - 256) * 256 + (n0 - 512), 256, 32, false, kn + k0 - 256, 1.f};
              return CvtSrc{Wv + (size_t)(k0 - 256) * 256 + (n0 - 768), 256, 32, false, kn + k0 - 256, 1.f}; }, scr, gw, ngw, lane); }
        { const float* W = IN(9) + (size_t)l * 1024 * 1024;
          cvt_job((bf16*)(p.ws + WS_WOUT) + (size_t)l * 1024 * 1024, 1024, 1024, [=](int nt, int kt) -> CvtSrc { return CvtSrc{W + (size_t)(kt * 64) * 1024 + nt * 32, 1024, 32, false, nullptr, 1.f}; }, scr, gw, ngw, lane); }
    }
    { const float* Wg = IN(22); const float* Wu = IN(23);
      cvt_job((bf16*)(p.ws + WS_WGU), 2 * DFF, 1024, [=](int nt, int kt) -> CvtSrc { const int n0 = nt * 32, t = n0 >> 8, r = n0 & 255;
          return CvtSrc{(r < 128 ? Wg + t * 128 + r : Wu + t * 128 + r - 128) + (size_t)(kt * 64) * DFF, DFF, 32, false, nullptr, 1.f}; }, scr, gw, ngw, lane); }
    { const float* W = IN(24);
      cvt_job((bf16*)(p.ws + WS_WD), 1024, DFF, [=](int nt, int kt) -> CvtSrc { return CvtSrc{W + (size_t)(kt * 64) * 1024 + nt * 32, 1024, 32, false, nullptr, 1.f}; }, scr, gw, ngw, lane); }
}
DEVI void ph_moew(const P& p, unsigned char* lds) {
    const int tid = otid(), wid = tid >> 6, lane = tid & 63;
    LAS float* scr = (LAS float*)(LAS unsigned char*)lds + wid * (64 * 33);
    const int gw = blockIdx.x * NWAVES + wid, ngw = gridDim.x * NWAVES;
    for (int e = 0; e < NEXP; ++e) {
        { const float* Wg = IN(26) + (size_t)e * 1024 * DFE; const float* Wu = IN(27) + (size_t)e * 1024 * DFE;
          cvt_job((bf16*)(p.ws + WS_WGUE) + (size_t)e * 2 * DFE * 1024, 2 * DFE, 1024, [=](int nt, int kt) -> CvtSrc { const int n0 = nt * 32, t = n0 >> 8, r = n0 & 255;
              return CvtSrc{(r < 128 ? Wg + t * 128 + r : Wu + t * 128 + r - 128) + (size_t)(kt * 64) * DFE, DFE, 32, false, nullptr, 1.f}; }, scr, gw, ngw, lane); }
        { const float* W = IN(28) + (size_t)e * DFE * 1024;
          cvt_job((bf16*)(p.ws + WS_WDE) + (size_t)e * 1024 * DFE, 1024, DFE, [=](int nt, int kt) -> CvtSrc { return CvtSrc{W + (size_t)(kt * 64) * 1024 + nt * 32, 1024, 32, false, nullptr, 1.f}; }, scr, gw, ngw, lane); }
    }
}

template <bool route>
DEVI void ph_norm(const P& p, int l, int which, int nrows, unsigned char* lds, int npart, int pgidx) {
    const int tid = otid(), wid = tid >> 6, lane = tid & 63;
    const bool first = (l == 0 && which == 0);
    const float* src_lat = first ? IN(0) : p.out; const float* src_ctx = (l == 0) ? IN(2) : (const float*)(p.ws + WS_XC);
    const float* w = IN(6 + which) + l * 1024; const float* modv = (const float*)(p.ws + WS_MODV) + (size_t)l * 3 * 6144;
    bf16* H = (bf16*)(p.ws + WS_HM);
    int* rt_e = (int*)(p.ws + WS_RT); float* rt_g = (float*)(p.ws + WS_RT + 128 * 1024);
    float* rl = (float*)lds;
    if (route) { __syncthreads(); const float* router = IN(25);
#pragma unroll
        for (int i = 0; i < 4; ++i) *(f32x4*)(rl + (tid + NTHREADS * i) * 4) = *(const f32x4*)(router + (tid + NTHREADS * i) * 4);
        __syncthreads(); }
    const int nw = gridDim.x * NWAVES, rpw = (NLAT + nw - 1) / nw, gw = blockIdx.x * NWAVES + wid;
    f32x4 vn[4], gsc[4], shv[4]; int rc = -1;
    for (int pass = 0; pass < (nrows > NLAT ? 2 : 1); ++pass) {
    const int row0 = pass == 0 ? gw * rpw : NLAT + gw, row1 = pass == 0 ? ((row0 + rpw < NLAT) ? row0 + rpw : NLAT) : nrows, rstep = pass == 0 ? 1 : nw;
    if (row0 < row1) { const float* x = (row0 < NLAT) ? src_lat + (size_t)row0 * D : src_ctx + (size_t)(row0 - NLAT) * D;
#pragma unroll
        for (int j = 0; j < 4; ++j) vn[j] = *(const f32x4*)(x + (j * 64 + lane) * 4); }
    for (int row = row0; row < row1; row += rstep) {
        const bool lat = row < NLAT; const int r = lat ? (row >> 13) : 2;
        if (r != rc) { rc = r; const float* sh = modv + r * 6144 + (which * 3 + 0) * 1024; const float* sc = modv + r * 6144 + (which * 3 + 1) * 1024;
#pragma unroll
            for (int j = 0; j < 4; ++j) { const int c0 = (j * 64 + lane) * 4; const f32x4 wv = *(const f32x4*)(w + c0), cv = *(const f32x4*)(sc + c0); shv[j] = *(const f32x4*)(sh + c0); gsc[j] = wv * (cv + 1.f); } }
        f32x4 v[4]; float ss = 0.f;
#pragma unroll
        for (int j = 0; j < 4; ++j) v[j] = vn[j];
        if (!lat && npart > 0) { const float* part = (const float*)(p.ws + WS_XBC) + (size_t)(row - NLAT) * D; const float* gp = modv + 2 * 6144 + pgidx * 1024; float* xc = (float*)(p.ws + WS_XC) + (size_t)(row - NLAT) * D;
#pragma unroll
            for (int j = 0; j < 4; ++j) { const int c0 = (j * 64 + lane) * 4; f32x4 acc = {0.f, 0.f, 0.f, 0.f};
#pragma unroll 2
                for (int k = 0; k < npart; ++k) acc += *(const f32x4*)(part + (size_t)k * NCTX * D + c0);
                v[j] += *(const f32x4*)(gp + c0) * acc; *(f32x4*)(xc + c0) = v[j]; } }
#pragma unroll
        for (int j = 0; j < 4; ++j) ss += v[j][0] * v[j][0] + v[j][1] * v[j][1] + v[j][2] * v[j][2] + v[j][3] * v[j][3];
        if (row + rstep < row1) { const int nrow = row + rstep; const float* x = (nrow < NLAT) ? src_lat + (size_t)nrow * D : src_ctx + (size_t)(nrow - NLAT) * D;
#pragma unroll
            for (int j = 0; j < 4; ++j) vn[j] = *(const f32x4*)(x + (j * 64 + lane) * 4); }
        ss = wave_sum(ss); const float rstd = __builtin_amdgcn_rsqf(ss * (1.f / D) + EPS);
        float lg[8];
#pragma unroll
        for (int e = 0; e < 8; ++e) lg[e] = 0.f;
#pragma unroll
        for (int j = 0; j < 4; ++j) { const int c0 = (j * 64 + lane) * 4; v[j] = v[j] * rstd * gsc[j] + shv[j]; st_bf16x4(H + (size_t)row * D + c0, v[j]); }
        if (route) {
#pragma unroll
            for (int j = 0; j < 4; ++j) { const int c0 = (j * 64 + lane) * 4;
#pragma unroll
                for (int i = 0; i < 4; ++i) { const f32x4 r0 = *(const f32x4*)(rl + (c0 + i) * 8), r1 = *(const f32x4*)(rl + (c0 + i) * 8 + 4); const float hh = v[j][i];
                    lg[0] += hh * r0[0]; lg[1] += hh * r0[1]; lg[2] += hh * r0[2]; lg[3] += hh * r0[3]; lg[4] += hh * r1[0]; lg[5] += hh * r1[1]; lg[6] += hh * r1[2]; lg[7] += hh * r1[3]; }
                asm volatile("" ::: "memory"); } }
        if (route) {
#pragma unroll
            for (int e = 0; e < 8; ++e) lg[e] = wave_sum(lg[e]);
            int i1 = 0; float v1 = lg[0];
#pragma unroll
            for (int e = 1; e < 8; ++e) if (lg[e] > v1) { v1 = lg[e]; i1 = e; }
            int i2 = -1; float v2 = -3.0e38f;
#pragma unroll
            for (int e = 0; e < 8; ++e) if (e != i1 && lg[e] > v2) { v2 = lg[e]; i2 = e; }
            const float e2 = __expf(v2 - v1), g1 = 1.f / (1.f + e2), g2 = e2 / (1.f + e2);
            if (lane == 0) { rt_e[row * 2] = i1; rt_e[row * 2 + 1] = i2; rt_g[row * 2] = g1; rt_g[row * 2 + 1] = g2; }
        }
    }
    }
}

typedef short v4i16_t __attribute__((ext_vector_type(4)));
DEVI v4i16_t lds_tr(const unsigned char* p) { return __builtin_amdgcn_ds_read_tr16_b64_v4i16((LAS v4i16_t*)(LAS unsigned char*)p); }
constexpr int A3_KLD = 208, A3_VLD = 192, A3_VOFF = 64 * A3_KLD, A3_BUF = A3_VOFF + 64 * A3_VLD;
template <int VAR>
DEVI void attn_unit(const P& p, int uidx, unsigned char* lds, bf16* outp) {
    const int tid = otid(), wid = __builtin_amdgcn_readfirstlane(tid >> 6), lane = tid & 63, r32 = lane & 31, hi = lane >> 5;
    const bf16* Q = (const bf16*)(p.ws + WS_Q); const bf16* K = (const bf16*)(p.ws + WS_K); const bf16* V = (const bf16*)(p.ws + WS_V); bf16* MIX = outp;
    int b, h, qrow0, NT;
    if (uidx < 256) { b = uidx >> 7; h = (uidx >> 5) & 3; qrow0 = b * SEQ + (uidx & 31) * 256; NT = 4 + SEQ / 64; }
    else { const int j = uidx - 256; b = j >> 2; h = j & 3; qrow0 = NLAT + b * CL; NT = 4; }
    const int qrow = qrow0 + wid * 32 + r32;
    bf16x8 qf[6];
#pragma unroll
    for (int s = 0; s < 6; ++s) qf[s] = *(const bf16x8*)(Q + (size_t)qrow * 384 + h * 96 + s * 16 + hi * 8);
    const int kk0 = tid / 12, kq0 = tid % 12, kk1 = (512 + tid) / 12, kq1 = (512 + tid) % 12, vk = tid >> 3, vq = tid & 7;
    const bf16* Kh = K + h * 96; const bf16* Vh = V + h * 64 + vq * 8;
    const int ctx0 = NLAT + b * CL, lat0 = b * SEQ;
    u32x4 krA0, krA1 = {0u, 0u, 0u, 0u}, vrA;
#define AT_LOAD(t, kr0, kr1, vr) do { const int kr_ = ((t) < 4) ? ctx0 + (t) * 64 : lat0 + ((t) - 4) * 64; \
        kr0 = *(const u32x4*)(Kh + (size_t)(kr_ + kk0) * 384 + kq0 * 8); if (tid < 256) kr1 = *(const u32x4*)(Kh + (size_t)(kr_ + kk1) * 384 + kq1 * 8); \
        vr = *(const u32x4*)(Vh + (size_t)(kr_ + vk) * 256); } while (0)
#define AT_STORE(bufp, kr0, kr1, vr) do { unsigned char* b_ = (bufp); *(u32x4*)(b_ + kk0 * A3_KLD + kq0 * 16) = kr0; if (tid < 256) *(u32x4*)(b_ + kk1 * A3_KLD + kq1 * 16) = kr1; \
        *(u32x4*)(b_ + A3_VOFF + vk * A3_VLD + vq * 16) = vr; } while (0)
    const int troff = (4 * hi + ((lane & 15) >> 2)) * A3_VLD + (16 * ((lane >> 4) & 1) + 4 * (lane & 3)) * 2;
    const int koff = r32 * A3_KLD + hi * 16;
    f32x16 o0, o1, negm;
#pragma unroll
    for (int r = 0; r < 16; ++r) { o0[r] = 0.f; o1[r] = 0.f; negm[r] = 0.f; }
    float mhat = 0.f, lsum = 0.f;
    __syncthreads();
    AT_LOAD(0, krA0, krA1, vrA); AT_STORE(lds, krA0, krA1, vrA); AT_LOAD(1, krA0, krA1, vrA); AT_STORE(lds + A3_BUF, krA0, krA1, vrA);
    __syncthreads();
#define SBAR() __builtin_amdgcn_sched_barrier(0)
#define KRD(bufp, half, s) (*(const bf16x8*)((bufp) + koff + (half) * 32 * A3_KLD + (s) * 32))
#define MF(a, b, c) __builtin_amdgcn_mfma_f32_32x32x16_bf16(a, b, c, 0, 0, 0)
#define MFQ(a, b, c) ((VAR == 3) ? (c) : MF(a, b, c))
#define MFP(a, b, c) ((VAR == 2) ? (c) : MF(a, b, c))
#define EX4(S, r0) do { if (VAR == 1) { S[r0] *= 0.001f; S[r0 + 1] *= 0.001f; S[r0 + 2] *= 0.001f; S[r0 + 3] *= 0.001f; break; } S[r0] = __builtin_amdgcn_exp2f(S[r0]); S[r0 + 1] = __builtin_amdgcn_exp2f(S[r0 + 1]); S[r0 + 2] = __builtin_amdgcn_exp2f(S[r0 + 2]); S[r0 + 3] = __builtin_amdgcn_exp2f(S[r0 + 3]); lsum += (S[r0] + S[r0 + 1]) + (S[r0 + 2] + S[r0 + 3]); } while (0)
#define PK8(S, r0) __builtin_bit_cast(bf16x8, (u32x4){pk2(S[r0], S[r0 + 1]), pk2(S[r0 + 2], S[r0 + 3]), pk2(S[r0 + 4], S[r0 + 5]), pk2(S[r0 + 6], S[r0 + 7])})
#define VFR(vp) ({ const v4i16_t lo_ = lds_tr(vp), hi_ = lds_tr((vp) + 8 * A3_VLD); (bf16x8){lo_[0], lo_[1], lo_[2], lo_[3], hi_[0], hi_[1], hi_[2], hi_[3]}; })
#define MX3(a, b, c) __builtin_fmaxf(__builtin_fmaxf((a), (b)), (c))
#define AT_UPD(S0, S1, mx, FORCE) do { float mx_ = __builtin_fmaxf(mx, __shfl_xor(mx, 32)); \
        if ((FORCE) || __any(mx_ > 8.0f)) { const float dl_ = (FORCE) ? mx_ : __builtin_fmaxf(mx_, 0.f); mhat += dl_; \
            _Pragma("unroll") for (int r = 0; r < 16; ++r) { S0[r] -= dl_; S1[r] -= dl_; negm[r] = -mhat; } \
            if (!(FORCE)) { const float f_ = __builtin_amdgcn_exp2f(-dl_); _Pragma("unroll") for (int r = 0; r < 16; ++r) { o0[r] *= f_; o1[r] *= f_; } lsum *= f_; } } } while (0)
    f32x16 sa0, sa1, sb0, sb1;
    { const unsigned char* kb_ = lds;
#pragma unroll
      for (int s = 0; s < 6; ++s) { sa0 = MF(KRD(kb_, 0, s), qf[s], s == 0 ? negm : sa0); sa1 = MF(KRD(kb_, 1, s), qf[s], s == 0 ? negm : sa1); }
      float a_ = MX3(sa0[0], sa0[1], sa1[0]), b_ = MX3(sa0[2], sa0[3], sa1[1]); a_ = MX3(a_, sa1[2], sa1[3]);
#pragma unroll
      for (int r = 4; r < 16; r += 4) { a_ = MX3(a_, sa0[r], sa0[r + 1]); b_ = MX3(b_, sa0[r + 2], sa0[r + 3]); a_ = MX3(a_, sa1[r], sa1[r + 1]); b_ = MX3(b_, sa1[r + 2], sa1[r + 3]); }
      AT_UPD(sa0, sa1, __builtin_fmaxf(a_, b_), true); }
#define AT_STEP(C0, C1, N0, N1, t, bc_, HAS_NEXT) do { const int b1_ = ((bc_) == 2) ? 0 : (bc_) + 1, b2_ = (b1_ == 2) ? 0 : b1_ + 1; \
        const unsigned char* kb_ = lds + b1_ * A3_BUF; const unsigned char* vb_ = lds + (bc_) * A3_BUF + A3_VOFF + troff; \
        if (VAR != 4 && (t) + 2 < NT) AT_LOAD((t) + 2, krA0, krA1, vrA); \
        bf16x8 pw0_, pw1_, pw2_, pw3_; float ma_ = -3.0e38f, mb_ = -3.0e38f; \
        if (HAS_NEXT) { \
            bf16x8 k0_ = KRD(kb_, 0, 0), k1_ = KRD(kb_, 1, 0), k2_ = KRD(kb_, 0, 1), k3_ = KRD(kb_, 1, 1); SBAR(); \
            N0 = MFQ(k0_, qf[0], negm); EX4(C0, 0); k0_ = KRD(kb_, 0, 2); SBAR(); \
            N1 = MFQ(k1_, qf[0], negm); EX4(C0, 4); k1_ = KRD(kb_, 1, 2); SBAR(); \
            N0 = MFQ(k2_, qf[1], N0); EX4(C0, 8); k2_ = KRD(kb_, 0, 3); SBAR(); \
            N1 = MFQ(k3_, qf[1], N1); EX4(C0, 12); k3_ = KRD(kb_, 1, 3); SBAR(); \
            N0 = MFQ(k0_, qf[2], N0); EX4(C1, 0); k0_ = KRD(kb_, 0, 4); SBAR(); \
            N1 = MFQ(k1_, qf[2], N1); EX4(C1, 4); k1_ = KRD(kb_, 1, 4); SBAR(); \
            N0 = MFQ(k2_, qf[3], N0); EX4(C1, 8); k2_ = KRD(kb_, 0, 5); SBAR(); \
            N1 = MFQ(k3_, qf[3], N1); EX4(C1, 12); k3_ = KRD(kb_, 1, 5); SBAR(); \
            N0 = MFQ(k0_, qf[4], N0); pw0_ = PK8(C0, 0); SBAR(); \
            N1 = MFQ(k1_, qf[4], N1); pw1_ = PK8(C0, 8); SBAR(); \
            N0 = MFQ(k2_, qf[5], N0); pw2_ = PK8(C1, 0); SBAR(); \
            N1 = MFQ(k3_, qf[5], N1); pw3_ = PK8(C1, 8); SBAR(); \
        } else { EX4(C0, 0); EX4(C0, 4); EX4(C0, 8); EX4(C0, 12); EX4(C1, 0); EX4(C1, 4); EX4(C1, 8); EX4(C1, 12); pw0_ = PK8(C0, 0); pw1_ = PK8(C0, 8); pw2_ = PK8(C1, 0); pw3_ = PK8(C1, 8); SBAR(); } \
        { bf16x8 va_ = VFR(vb_), vb2_ = VFR(vb_ + 64); SBAR(); \
          bf16x8 vc_ = VFR(vb_ + 16 * A3_VLD), vd_ = VFR(vb_ + 16 * A3_VLD + 64); SBAR(); \
          o0 = MFP(va_, pw0_, o0); if (HAS_NEXT) { ma_ = MX3(N0[0], N0[1], N1[0]); mb_ = MX3(N0[2], N0[3], N1[1]); } SBAR(); \
          o1 = MFP(vb2_, pw0_, o1); if (HAS_NEXT) { ma_ = MX3(ma_, N1[2], N1[3]); mb_ = MX3(mb_, N0[4], N0[5]); } SBAR(); \
          va_ = VFR(vb_ + 32 * A3_VLD); vb2_ = VFR(vb_ + 32 * A3_VLD + 64); SBAR(); \
          o0 = MFP(vc_, pw1_, o0); if (HAS_NEXT) { ma_ = MX3(ma_, N0[6], N0[7]); mb_ = MX3(mb_, N1[4], N1[5]); } SBAR(); \
          o1 = MFP(vd_, pw1_, o1); if (HAS_NEXT) { ma_ = MX3(ma_, N1[6], N1[7]); mb_ = MX3(mb_, N0[8], N0[9]); } SBAR(); \
          vc_ = VFR(vb_ + 48 * A3_VLD); vd_ = VFR(vb_ + 48 * A3_VLD + 64); SBAR(); \
          o0 = MFP(va_, pw2_, o0); if (HAS_NEXT) { ma_ = MX3(ma_, N0[10], N0[11]); mb_ = MX3(mb_, N1[8], N1[9]); } SBAR(); \
          o1 = MFP(vb2_, pw2_, o1); if (HAS_NEXT) { ma_ = MX3(ma_, N1[10], N1[11]); mb_ = MX3(mb_, N0[12], N0[13]); } SBAR(); \
          if (HAS_NEXT) { ma_ = MX3(ma_, N0[14], N0[15]); mb_ = MX3(mb_, N1[12], N1[13]); } SBAR(); \
          o0 = MFP(vc_, pw3_, o0); if (HAS_NEXT) { ma_ = MX3(ma_, N1[14], N1[15]); } SBAR(); \
          o1 = MFP(vd_, pw3_, o1); SBAR(); } \
        if (HAS_NEXT) AT_UPD(N0, N1, __builtin_fmaxf(ma_, mb_), false); \
        if (VAR != 4 && (t) + 2 < NT) AT_STORE(lds + b2_ * A3_BUF, krA0, krA1, vrA); \
        if (VAR != 4) __syncthreads(); } while (0)
    int bc = 0, t = 0;
    for (; t + 2 < NT; t += 2) {
        AT_STEP(sa0, sa1, sb0, sb1, t, bc, true); bc = (bc == 2) ? 0 : bc + 1;
        AT_STEP(sb0, sb1, sa0, sa1, t + 1, bc, true); bc = (bc == 2) ? 0 : bc + 1;
    }
    AT_STEP(sa0, sa1, sb0, sb1, t, bc, true); bc = (bc == 2) ? 0 : bc + 1;
    AT_STEP(sb0, sb1, sa0, sa1, t + 1, bc, false);
#undef AT_LOAD
#undef AT_STORE
#undef SBAR
#undef KRD
#undef MF
#undef MFQ
#undef MFP
#undef EX4
#undef PK8
#undef VFR
#undef MX3
#undef AT_UPD
#undef AT_STEP
    lsum += __shfl_xor(lsum, 32);
    const float inv = 1.f / lsum;
    bf16* orow = MIX + (size_t)qrow * D + h * 64;
#pragma unroll
    for (int g = 0; g < 4; ++g) {
        st_bf16x4(orow + 8 * g + 4 * hi, (f32x4){o0[4 * g] * inv, o0[4 * g + 1] * inv, o0[4 * g + 2] * inv, o0[4 * g + 3] * inv});
        st_bf16x4(orow + 32 + 8 * g + 4 * hi, (f32x4){o1[4 * g] * inv, o1[4 * g + 1] * inv, o1[4 * g + 2] * inv, o1[4 * g + 3] * inv});
    }
}

constexpr int NCC = 66;
DEVI int chunk_row0(int b, int cc) { return cc < 2 ? NLAT + b * CL + cc * 128 : b * SEQ + (cc - 2) * 128; }
constexpr int SC_VEC = 0;
constexpr int SC_KT = 2048;
constexpr int SC_VF = SC_KT + 64 * 136 * 2;
constexpr int SC_VB = SC_VF + 64 * 136 * 2;
constexpr int SC_X = SC_VB + 64 * 136 * 2;
constexpr int SC_SSQ = SC_X + 2048;
constexpr int SC_END = SC_SSQ + 8192;
constexpr int TS = 136;

DEVI void scan_vectors(const P& p, int l, bool ret, int h, int row0, float* vec, int wid, int lane) {
    const float* dt = (const float*)(p.ws + WS_DT);
    if (ret) {
        if (wid == 0) { const float lf = IN(15)[l * 8 + h], lb = IN(15)[l * 8 + 4 + h];
            const float laf = -log1pf(__expf(-lf)), lab = -log1pf(__expf(-lb));
#pragma unroll
            for (int e = 0; e < 2; ++e) { const int j = lane * 2 + e; vec[j] = (float)(j + 1) * laf; vec[128 + j] = (float)(128 - j) * lab; vec[256 + j] = 1.f; vec[384 + j] = 1.f; } }
    } else if (wid < 2) {
        const int dir = wid; const size_t r = (size_t)(row0 + lane * 2);
        const float x0 = dt[r * 32 + 16 + dir * 8 + h], x1 = dt[(r + 1) * 32 + 16 + dir * 8 + h];
        vec[256 + dir * 128 + lane * 2] = dt[r * 32 + dir * 8 + h]; vec[256 + dir * 128 + lane * 2 + 1] = dt[(r + 1) * 32 + dir * 8 + h];
        float s = x0 + x1;
#pragma unroll
        for (int o = 1; o < 64; o <<= 1) { const float t = __shfl_up(s, o); if (lane >= o) s += t; }
        if (dir == 0) { vec[lane * 2] = s - x1; vec[lane * 2 + 1] = s; }
        else { const float tot = __shfl(s, 63); vec[128 + lane * 2] = tot - (s - x1) + x0; vec[128 + lane * 2 + 1] = tot - s + x1; }
    }
}
DEVI void scan_ptrs(const P& p, bool ret, int h, const bf16*& qb, const bf16*& kb, const bf16*& vb, int& ld) {
    if (ret) { const bf16* proj = (const bf16*)(p.ws + WS_PROJ); qb = proj + C_RQ + h * 64; kb = proj + C_RK + h * 64; vb = proj + C_RV + h * 64; ld = INWP; }
    else { const bf16* xbc = (const bf16*)(p.ws + WS_XBC); qb = xbc + 640 + (h >> 2) * 64; kb = xbc + 512 + (h >> 2) * 64; vb = xbc + h * 64; ld = 768; }
}
DEVI void c3_stage_rows(unsigned char* dst, int rs, const bf16* src, int ld, int tid) {
#pragma unroll
    for (int i = 0; i < 2; ++i) { const int piece = tid + NTHREADS * i, row = piece >> 3, part = piece & 7; *(u32x4*)(dst + row * rs + part * 16) = *(const u32x4*)(src + (size_t)row * ld + part * 8); }
}
struct ConvW { f32x4 w0[2], w1[2], w2[2], b[2]; };
DEVI ConvW conv_w(const float* cw, const float* cb, int c0) { ConvW w;
#pragma unroll
    for (int k = 0; k < 2; ++k) { w.w0[k] = *(const f32x4*)(cw + c0 + 4 * k); w.w1[k] = *(const f32x4*)(cw + 768 + c0 + 4 * k); w.w2[k] = *(const f32x4*)(cw + 1536 + c0 + 4 * k); w.b[k] = *(const f32x4*)(cb + c0 + 4 * k); }
    return w; }
DEVI void unpack8(const u32x4 v, f32x4 (&x)[2]) { x[0] = (f32x4){bf2f(v.x & 0xffff), bf2f(v.x >> 16), bf2f(v.y & 0xffff), bf2f(v.y >> 16)}; x[1] = (f32x4){bf2f(v.z & 0xffff), bf2f(v.z >> 16), bf2f(v.w & 0xffff), bf2f(v.w >> 16)}; }
DEVI void conv8(const bf16* proj, size_t row, bool has_prev, bool has_next, int c0, const ConvW& w, f32x4 (&y)[2]) {
    const bf16* pr = proj + row * INWP + C_XBC + c0; const u32x4 z = {0u, 0u, 0u, 0u};
    const u32x4 r0 = *(const u32x4*)pr, rm = has_prev ? *(const u32x4*)(pr - INWP) : z, rp = has_next ? *(const u32x4*)(pr + INWP) : z;
    f32x4 x0[2], xm[2], xp[2]; unpack8(r0, x0); unpack8(rm, xm); unpack8(rp, xp);
#pragma unroll
    for (int k = 0; k < 2; ++k) { y[k] = w.w0[k] * xm[k] + w.w1[k] * x0[k] + w.w2[k] * xp[k] + w.b[k];
#pragma unroll
        for (int i = 0; i < 4; ++i) y[k][i] = siluf(y[k][i]); }
}
DEVI u32x4 pack8(const f32x4 (&y)[2], float sc) { return (u32x4){pk2(y[0][0] * sc, y[0][1] * sc), pk2(y[0][2] * sc, y[0][3] * sc), pk2(y[1][0] * sc, y[1][1] * sc), pk2(y[1][2] * sc, y[1][3] * sc)}; }
constexpr int SA_RS = 192, SA_K = 8192, SA_VF = SA_K + 128 * SA_RS, SA_VB = SA_VF + 128 * SA_RS, SA_END = SA_VB + 128 * SA_RS;
DEVI void scanA_unit(const P& p, int l, int uidx, unsigned char* lds) {
    const int tid = otid(), wid = __builtin_amdgcn_readfirstlane(tid >> 6), lane = tid & 63, r32 = lane & 31, hi = lane >> 5;
    const int g4 = uidx % 3, bc = uidx / 3, b = bc / NCC, cc = bc % NCC, row0 = chunk_row0(b, cc);
    const bool ret = (g4 == 0);
    float* vec4 = (float*)(lds + SC_VEC);
    float* ST = (float*)(p.ws + WS_ST); float* CDp = (float*)(p.ws + WS_CD);
    const bf16* proj = (const bf16*)(p.ws + WS_PROJ); bf16* xbcw = (bf16*)(p.ws + WS_XBC); const float* cw = IN(16) + (size_t)l * 3 * 768; const float* cb = IN(17) + l * 768;
    const int troff = (4 * hi + ((lane & 15) >> 2)) * SA_RS + (16 * ((lane >> 4) & 1) + 4 * (lane & 3)) * 2;
    __syncthreads();
    { const int hq = wid >> 1, h = ret ? hq : (g4 - 1) * 4 + hq; scan_vectors(p, l, ret, h, row0, vec4 + hq * 512, wid & 1, lane); }
    __syncthreads();
    { const int hq = tid >> 7, t = tid & 127, h = ret ? hq : (g4 - 1) * 4 + hq, hh = ret ? hq : 4 + h; const size_t item = (size_t)(b * NCC + cc) * 12 + hh; const float* vv = vec4 + hq * 512;
      float* vg = (float*)(p.ws + WS_VEC) + item * 512; vg[t] = vv[t]; vg[128 + t] = vv[128 + t]; vg[256 + t] = vv[t] - __logf(vv[256 + t]); vg[384 + t] = vv[128 + t] - __logf(vv[384 + t]);
      if (t == 0) { CDp[item * 2] = __expf(vv[127]); CDp[item * 2 + 1] = __expf(vv[128]); } }
    for (int hq = 0; hq < 4; ++hq) {
        const int h = ret ? hq : (g4 - 1) * 4 + hq, hh = ret ? hq : 4 + h; const size_t item = (size_t)(b * NCC + cc) * 12 + hh;
        const bf16 *qb, *kb, *vb; int ld; scan_ptrs(p, ret, h, qb, kb, vb, ld);
        const float* vec = vec4 + hq * 512;
        if (hq > 0) __syncthreads();
        if (ret) {
            c3_stage_rows(lds + SA_K, SA_RS, kb + (size_t)row0 * ld, ld, tid);
#pragma unroll
            for (int i = 0; i < 2; ++i) { const int piece = tid + NTHREADS * i, j = piece >> 3, part = piece & 7; const u32x4 v = *(const u32x4*)(vb + (size_t)(row0 + j) * ld + part * 8);
                const float sf = __expf(vec[127] - vec[j]) * vec[256 + j], sb = __expf(vec[128] - vec[128 + j]) * vec[384 + j];
                f32x4 x[2]; unpack8(v, x);
                *(u32x4*)(lds + SA_VF + j * SA_RS + part * 16) = pack8(x, sf); *(u32x4*)(lds + SA_VB + j * SA_RS + part * 16) = pack8(x, sb); }
        } else {
            const int g = g4 - 1, part = tid & 7; const int pos0 = (cc < 2) ? cc * 128 : (cc - 2) * 128, Ls = (cc < 2) ? CL : SEQ;
            if (hq == 0) {
#pragma unroll 1
                for (int which = 0; which < 2; ++which) { const int c0 = (which == 0 ? 512 : 640) + g * 64 + part * 8; const ConvW w = conv_w(cw, cb, c0);
#pragma unroll
                    for (int i = 0; i < 2; ++i) { const int j = (tid + NTHREADS * i) >> 3; f32x4 y[2]; conv8(proj, (size_t)(row0 + j), pos0 + j > 0, pos0 + j < Ls - 1, c0, w, y);
                        const u32x4 o = pack8(y, 1.f); *(u32x4*)(xbcw + (size_t)(row0 + j) * 768 + c0) = o; if (which == 0) *(u32x4*)(lds + SA_K + j * SA_RS + part * 16) = o; } } }
            { const int c0 = h * 64 + part * 8; const ConvW w = conv_w(cw, cb, c0);
#pragma unroll
              for (int i = 0; i < 2; ++i) { const int j = (tid + NTHREADS * i) >> 3; f32x4 y[2]; conv8(proj, (size_t)(row0 + j), pos0 + j > 0, pos0 + j < Ls - 1, c0, w, y);
                  const float sf = __expf(vec[127] - vec[j]) * vec[256 + j], sb = __expf(vec[128] - vec[128 + j]) * vec[384 + j];
                  *(u32x4*)(xbcw + (size_t)(row0 + j) * 768 + c0) = pack8(y, 1.f);
                  *(u32x4*)(lds + SA_VF + j * SA_RS + part * 16) = pack8(y, sf); *(u32x4*)(lds + SA_VB + j * SA_RS + part * 16) = pack8(y, sb); } }
        }
        __syncthreads();
        const int dir = wid >> 2, nt = (wid >> 1) & 1, pt = wid & 1;
        const unsigned char* ka = lds + SA_K + nt * 64 + troff; const unsigned char* va = lds + (dir ? SA_VB : SA_VF) + pt * 64 + troff;
        f32x16 acc;
#pragma unroll
        for (int r = 0; r < 16; ++r) acc[r] = 0.f;
#pragma unroll
        for (int s = 0; s < 8; ++s) { const v4i16_t al = lds_tr(ka + (16 * s) * SA_RS), ah = lds_tr(ka + (16 * s + 8) * SA_RS), bl = lds_tr(va + (16 * s) * SA_RS), bh = lds_tr(va + (16 * s + 8) * SA_RS);
            const bf16x8 af = {al[0], al[1], al[2], al[3], ah[0], ah[1], ah[2], ah[3]}, bf = {bl[0], bl[1], bl[2], bl[3], bh[0], bh[1], bh[2], bh[3]};
            acc = __builtin_amdgcn_mfma_f32_32x32x16_bf16(af, bf, acc, 0, 0, 0); }
        float* o = ST + (item * 2 + dir) * 4096 + (size_t)(pt * 32 + r32) * 64 + nt * 32 + 4 * hi;
#pragma unroll
        for (int g = 0; g < 4; ++g) *(f32x4*)(o + 8 * g) = (f32x4){acc[4 * g], acc[4 * g + 1], acc[4 * g + 2], acc[4 * g + 3]};
    }
    __syncthreads();
}
DEVI void scanB_slab(const P& p, int slab, int nthr, int epb) {
    const int tid = otid(); if (tid >= nthr) return;
    const int f = slab * epb + tid * 2; const int bhd = f >> 12, e = f & 4095, dir = bhd & 1, bh = bhd >> 1, b = bh / 12, hh = bh % 12;
    const float* ST = (const float*)(p.ws + WS_ST); const float* CDp = (const float*)(p.ws + WS_CD); bf16* HT = (bf16*)(p.ws + WS_HT);
    f32x2 H = {0.f, 0.f};
    for (int base = 0; base < NCC; base += 6) {
        f32x2 s[6]; float d[6]; size_t off[6];
#pragma unroll
        for (int i = 0; i < 6; ++i) { const int step = base + i; const int cc = dir == 0 ? step : (step < 2 ? 1 - step : 67 - step);
            const size_t item = (size_t)(b * NCC + cc) * 12 + hh; off[i] = (item * 2 + dir) * 4096 + e; s[i] = *(const f32x2*)(ST + off[i]); d[i] = CDp[item * 2 + dir]; }
#pragma unroll
        for (int i = 0; i < 6; ++i) { *(unsigned*)(HT + off[i]) = pk2(H[0], H[1]); H = H * d[i] + s[i]; }
    }
}
constexpr int C3_RSV = 192, C3_RSK = 144;
constexpr int C3_V = 0, C3_K = 2 * 128 * C3_RSV, C3_H = C3_K + 2 * 128 * C3_RSK, C3_VEC = C3_H + 2 * 128 * C3_RSK, C3_X = C3_VEC + 2 * 2048, C3_END = C3_X + 1024;
template <bool RET>
DEVI void scanC_unit(const P& p, int l, int bc, unsigned char* lds, int tid, int wid, int lane) {
    const int r32 = lane & 31, hi = lane >> 5;
    const int it_ = wid & 3, hsub = wid >> 2, b = bc / NCC, cc = bc % NCC, row0 = chunk_row0(b, cc);
    const bf16* HT = (const bf16*)(p.ws + WS_HT); const bf16* proj = (const bf16*)(p.ws + WS_PROJ); const bf16* xbc = (const bf16*)(p.ws + WS_XBC); bf16* MIX = (bf16*)(p.ws + WS_HM); const float* VECG = (const float*)(p.ws + WS_VEC);
    const int i = it_ * 32 + r32; const size_t rowi = (size_t)(row0 + i);
    constexpr int ld = RET ? INWP : 768;
    const unsigned char* Vl = lds + C3_V + hsub * 128 * C3_RSV; const unsigned char* Kl = lds + C3_K + hsub * 128 * C3_RSK; const unsigned char* Hl = lds + C3_H + hsub * 128 * C3_RSK; const float* vec = (const float*)(lds + C3_VEC + hsub * 2048);
    const int trq = (lane & 15) >> 2, trp = lane & 3, trg = (lane >> 4) & 1;
    const int troff = (4 * hi + trq) * C3_RSV + (16 * trg + 4 * trp) * 2;
    float ssqk[4] = {0.f, 0.f, 0.f, 0.f};
#pragma unroll 1
    for (int step = 0; step < (RET ? 2 : 4); ++step) {
        __syncthreads();
#pragma unroll
        for (int hs = 0; hs < 2; ++hs) { const int h = RET ? hs * 2 + step : hs * 4 + step, hh = RET ? h : 4 + h; const size_t item = (size_t)(b * NCC + cc) * 12 + hh;
            const bf16* vb = RET ? proj + C_RV + h * 64 : xbc + h * 64; const bf16* kb = RET ? proj + C_RK + h * 64 : xbc + 512 + hs * 64;
            c3_stage_rows(lds + C3_V + hs * 128 * C3_RSV, C3_RSV, vb + (size_t)row0 * ld, ld, tid);
            if (RET || step == 0) c3_stage_rows(lds + C3_K + hs * 128 * C3_RSK, C3_RSK, kb + (size_t)row0 * ld, ld, tid);
            c3_stage_rows(lds + C3_H + hs * 128 * C3_RSK, C3_RSK, HT + item * 2 * 4096, 64, tid);
            if ((tid >> 7) == hs) *(u32x4*)(lds + C3_VEC + hs * 2048 + (tid & 127) * 16) = *(const u32x4*)(VECG + item * 512 + (tid & 127) * 4); }
        __syncthreads();
        const int h = RET ? hsub * 2 + step : hsub * 4 + step;
        const bf16* qb = RET ? proj + C_RQ + h * 64 : xbc + 640 + hsub * 64;
        bf16x8 qf[4];
#pragma unroll
        for (int s = 0; s < 4; ++s) qf[s] = *(const bf16x8*)(qb + rowi * ld + s * 16 + hi * 8);
        const float Afi = vec[i], Bbi = vec[128 + i];
        f32x16 y0, y1;
#pragma unroll
        for (int r = 0; r < 16; ++r) { y0[r] = 0.f; y1[r] = 0.f; }
#pragma unroll 2
        for (int jt = 0; jt < 4; ++jt) {
            f32x16 st;
#pragma unroll
            for (int r = 0; r < 16; ++r) st[r] = 0.f;
#pragma unroll
            for (int s = 0; s < 4; ++s) { const bf16x8 kf = *(const bf16x8*)(Kl + (jt * 32 + r32) * C3_RSK + (s * 16 + hi * 8) * 2); st = __builtin_amdgcn_mfma_f32_32x32x16_bf16(kf, qf[s], st, 0, 0, 0); }
#pragma unroll
            for (int g = 0; g < 4; ++g) { const int j0 = jt * 32 + 8 * g + 4 * hi;
                const f32x4 afp = *(const f32x4*)(vec + 256 + j0), bbp = *(const f32x4*)(vec + 384 + j0);
#pragma unroll
                for (int e = 0; e < 4; ++e) { const int j = j0 + e; float f;
                    if (jt < it_) f = __expf(Afi - afp[e]);
                    else if (jt > it_) f = __expf(Bbi - bbp[e]);
                    else { const float ff = (j <= i) ? __expf(Afi - afp[e]) : 0.f; const bool bm = RET ? (j > i) : (j >= i); const float fb = bm ? __expf(Bbi - bbp[e]) : 0.f; f = ff + fb; }
                    st[4 * g + e] *= f; } }
#pragma unroll
            for (int s2 = 0; s2 < 2; ++s2) {
                u32x4 pw; pw.x = pk2(st[8 * s2 + 0], st[8 * s2 + 1]); pw.y = pk2(st[8 * s2 + 2], st[8 * s2 + 3]); pw.z = pk2(st[8 * s2 + 4], st[8 * s2 + 5]); pw.w = pk2(st[8 * s2 + 6], st[8 * s2 + 7]);
                const bf16x8 pb = __builtin_bit_cast(bf16x8, pw);
#pragma unroll
                for (int pt = 0; pt < 2; ++pt) { const unsigned char* vp = Vl + (jt * 32 + 16 * s2) * C3_RSV + pt * 64 + troff;
                    const v4i16_t lo = lds_tr(vp), hi2 = lds_tr(vp + 8 * C3_RSV);
                    const bf16x8 va = {lo[0], lo[1], lo[2], lo[3], hi2[0], hi2[1], hi2[2], hi2[3]};
                    if (pt == 0) y0 = __builtin_amdgcn_mfma_f32_32x32x16_bf16(va, pb, y0, 0, 0, 0); else y1 = __builtin_amdgcn_mfma_f32_32x32x16_bf16(va, pb, y1, 0, 0, 0); }
            }
        }
        { const float ef = __expf(Afi), eb = __expf(Bbi);
#pragma unroll
          for (int pt = 0; pt < 2; ++pt) { f32x16 tf, tb;
#pragma unroll
              for (int r = 0; r < 16; ++r) { tf[r] = 0.f; tb[r] = 0.f; }
              const unsigned char* hf = Hl + (pt * 32 + r32) * C3_RSK + hi * 16;
#pragma unroll
              for (int s = 0; s < 4; ++s) { tf = __builtin_amdgcn_mfma_f32_32x32x16_bf16(*(const bf16x8*)(hf + s * 32), qf[s], tf, 0, 0, 0); tb = __builtin_amdgcn_mfma_f32_32x32x16_bf16(*(const bf16x8*)(hf + 64 * C3_RSK + s * 32), qf[s], tb, 0, 0, 0); }
#pragma unroll
              for (int r = 0; r < 16; ++r) { if (pt == 0) y0[r] += ef * tf[r] + eb * tb[r]; else y1[r] += ef * tf[r] + eb * tb[r]; } } }
        float* Tw = (float*)(lds + (wid < 5 ? C3_V + wid * 8704 : C3_H + (wid - 5) * 8704));
        __syncthreads();
        if (RET) {
            float s1 = 0.f, s2 = 0.f;
#pragma unroll
            for (int r = 0; r < 16; ++r) { y0[r] *= 0.125f; y1[r] *= 0.125f; s1 += y0[r] + y1[r]; s2 += y0[r] * y0[r] + y1[r] * y1[r]; }
            s1 += __shfl_xor(s1, 32); s2 += __shfl_xor(s2, 32);
            const float mu = s1 * (1.f / 64.f), var = fmaxf(s2 * (1.f / 64.f) - mu * mu, 0.f), rs = __builtin_amdgcn_rsqf(var + EPS);
#pragma unroll
            for (int r = 0; r < 16; ++r) { y0[r] = (y0[r] - mu) * rs; y1[r] = (y1[r] - mu) * rs; }
        }
#pragma unroll
        for (int g = 0; g < 4; ++g) { *(f32x4*)(Tw + r32 * 68 + 8 * g + 4 * hi) = (f32x4){y0[4 * g], y0[4 * g + 1], y0[4 * g + 2], y0[4 * g + 3]}; *(f32x4*)(Tw + r32 * 68 + 32 + 8 * g + 4 * hi) = (f32x4){y1[4 * g], y1[4 * g + 1], y1[4 * g + 2], y1[4 * g + 3]}; }
        asm volatile("s_waitcnt lgkmcnt(0)" ::: "memory");
        { const int ch = lane & 7; const float dsk = RET ? 0.f : IN(20)[l * 8 + h];
#pragma unroll
          for (int k = 0; k < 4; ++k) { const int tr = (lane >> 3) + 8 * k; const size_t rowt = (size_t)(row0 + it_ * 32 + tr);
              f32x4 ya[2] = {*(const f32x4*)(Tw + tr * 68 + ch * 8), *(const f32x4*)(Tw + tr * 68 + ch * 8 + 4)};
              if (RET) { f32x4 gv[2]; unpack8(*(const u32x4*)(proj + rowt * INWP + C_RG + h * 64 + ch * 8), gv);
#pragma unroll
                  for (int q = 0; q < 2; ++q)
#pragma unroll
                      for (int e = 0; e < 4; ++e) ya[q][e] *= siluf(gv[q][e]);
                  *(u32x4*)(MIX + rowt * D + 256 + h * 64 + ch * 8) = pack8(ya, 1.f);
              } else { f32x4 xv[2], zv[2]; unpack8(*(const u32x4*)(xbc + rowt * 768 + h * 64 + ch * 8), xv); unpack8(*(const u32x4*)(proj + rowt * INWP + C_Z + h * 64 + ch * 8), zv); float sq = 0.f;
#pragma unroll
                  for (int q = 0; q < 2; ++q)
#pragma unroll
                      for (int e = 0; e < 4; ++e) { ya[q][e] = (ya[q][e] + xv[q][e] * dsk) * siluf(zv[q][e]); sq += ya[q][e] * ya[q][e]; }
                  *(u32x4*)(MIX + rowt * D + 512 + h * 64 + ch * 8) = pack8(ya, 1.f);
                  sq += __shfl_xor(sq, 1); sq += __shfl_xor(sq, 2); sq += __shfl_xor(sq, 4); ssqk[k] += sq; } } }
    }
    if (!RET) {
        float* X = (float*)(lds + C3_X);
#pragma unroll
        for (int k = 0; k < 4; ++k) if ((lane & 7) == 0) X[hsub * 128 + it_ * 32 + (lane >> 3) + 8 * k] = ssqk[k];
        asm volatile("s_waitcnt vmcnt(0)" ::: "memory");
        __syncthreads();
        const float* nw = IN(21) + l * 512; const int ch = lane & 7;
#pragma unroll 1
        for (int h = hsub * 4; h < hsub * 4 + 4; ++h) { f32x4 wv[2] = {*(const f32x4*)(nw + h * 64 + ch * 8), *(const f32x4*)(nw + h * 64 + ch * 8 + 4)};
#pragma unroll
            for (int k = 0; k < 4; ++k) { const int tr = it_ * 32 + (lane >> 3) + 8 * k; const float rstd = __builtin_amdgcn_rsqf((X[tr] + X[128 + tr]) * (1.f / 512.f) + EPS);
                bf16* mp = MIX + (size_t)(row0 + tr) * D + 512 + h * 64 + ch * 8; f32x4 v[2]; unpack8(*(const u32x4*)mp, v);
                v[0] = v[0] * wv[0] * rstd; v[1] = v[1] * wv[1] * rstd; *(u32x4*)mp = pack8(v, 1.f); } }
    }
    __syncthreads();
}
DEVI void ph_scanC(const P& p, int l, unsigned char* lds) {
    const int tid = otid(), wid = __builtin_amdgcn_readfirstlane(tid >> 6), lane = tid & 63;
    const int NU = 2 * NCC;
    if (gridDim.x == 256) {
        const int c = blockIdx.x;
        if (c < NU) scanC_unit<false>(p, l, c, lds, tid, wid, lane);
        else { const int r = c - NU; scanC_unit<true>(p, l, r, lds, tid, wid, lane); if (r + 124 < NU) scanC_unit<true>(p, l, r + 124, lds, tid, wid, lane); }
    } else {
        for (int u = blockIdx.x; u < 2 * NU; u += gridDim.x) { if (u < NU) scanC_unit<false>(p, l, u, lds, tid, wid, lane); else scanC_unit<true>(p, l, u - NU, lds, tid, wid, lane); }
    }
}
DEVI void ph_scanA(const P& p, int l, unsigned char* lds) { for (int u = gridDim.x - 1 - blockIdx.x; u < 2 * NCC * 3; u += gridDim.x) scanA_unit(p, l, u, lds); }
DEVI void ph_mixer(const P& p, int l, unsigned char* lds) {
    for (int u = blockIdx.x; u < 256; u += gridDim.x) scanB_slab(p, u, 384, 768);
    for (int a = blockIdx.x; a < 256; a += gridDim.x) attn_unit<0>(p, (a & 7) * 32 + (a >> 3), lds, (bf16*)(p.ws + WS_HM));
#if ATTN_PROBE
    if (l == 0) { __syncthreads(); for (int a = blockIdx.x; a < 256; a += gridDim.x) attn_unit<ATTN_PROBE>(p, (a & 7) * 32 + (a >> 3), lds, (bf16*)p.out); }
#endif
    if (l == 0) for (int a = blockIdx.x; a < 8; a += gridDim.x) attn_unit<0>(p, 256 + a, lds, (bf16*)(p.ws + WS_HM));
}

DEVI void ph_sort(const P& p, unsigned char* lds) {
    const int tid = otid(), wid = tid >> 6, lane = tid & 63;
    const int* rt_e = (const int*)(p.ws + WS_RT); int* rt_pos = (int*)(p.ws + WS_RT + 256 * 1024); int* tab = (int*)(p.ws + WS_RT + 384 * 1024); int* rt_tok = (int*)(p.ws + WS_RT + 640 * 1024);
    int* sh = (int*)lds;
    const int G = gridDim.x, R = (NLAT + G - 1) / G;
    for (int blk = blockIdx.x; blk * R < NLAT; blk += G) {
        const int r0 = blk * R, r1 = (r0 + R < NLAT) ? r0 + R : NLAT;
        int ct[8], cb[8];
#pragma unroll
        for (int e = 0; e < 8; ++e) { ct[e] = 0; cb[e] = 0; }
        for (int i = tid; i < NLAT * 2; i += NTHREADS) { const int e = rt_e[i]; const bool bef = (i >> 1) < r0;
#pragma unroll
            for (int x = 0; x < 8; ++x) { const int hit = (e == x) ? 1 : 0; ct[x] += hit; cb[x] += bef ? hit : 0; } }
#pragma unroll
        for (int e = 0; e < 8; ++e) {
#pragma unroll
            for (int o = 1; o < 64; o <<= 1) { ct[e] += __shfl_xor(ct[e], o); cb[e] += __shfl_xor(cb[e], o); }
        }
        __syncthreads();
        if (lane == 0) {
#pragma unroll
            for (int e = 0; e < 8; ++e) { sh[wid * 8 + e] = ct[e]; sh[64 + wid * 8 + e] = cb[e]; } }
        __syncthreads();
        if (tid == 0) { int start = 0, nt = 0;
            for (int e = 0; e < 8; ++e) { int tot = 0, bef = 0; for (int w = 0; w < 8; ++w) { tot += sh[w * 8 + e]; bef += sh[64 + w * 8 + e]; }
                sh[128 + e] = start; sh[136 + e] = start + bef; sh[144 + e] = tot; const int ntile = (tot + 255) >> 8;
                if (blk == 0) { for (int t = 0; t < ntile; ++t) tab[1 + nt + t] = e; }
                nt += ntile; start += ntile * 256; }
            if (blk == 0) tab[0] = nt; }
        __syncthreads();
        { const int n_ent = (r1 - r0) * 2; const bool valid = tid < n_ent; const int e = valid ? rt_e[r0 * 2 + tid] : -1; int rank = 0;
#pragma unroll
          for (int x = 0; x < 8; ++x) { const unsigned long long m = __ballot(e == x); if (e == x) rank = __popcll(m & ((1ull << lane) - 1ull)); if (lane == 0) sh[160 + wid * 8 + x] = __popcll(m); }
          __syncthreads();
          if (valid) { int pos = sh[136 + e] + rank; for (int w = 0; w < wid; ++w) pos += sh[160 + w * 8 + e]; sh[256 + tid] = pos; rt_pos[r0 * 2 + tid] = pos; } }
        __syncthreads();
        { const int n_ent = (r1 - r0) * 2; if (tid < n_ent) rt_tok[sh[256 + tid]] = r0 + (tid >> 1); }
        if (blk == 0) { for (int e = 0; e < 8; ++e) { const int tot = sh[144 + e], beg = sh[128 + e] + tot, end = sh[128 + e] + ((tot + 255) & ~255); for (int i = beg + tid; i < end; i += NTHREADS) rt_tok[i] = 0; } }
        __syncthreads();
    }
}
DEVI void ph_final(const P& p) {
    const int tid = otid(), wid = tid >> 6, lane = tid & 63;
    const float* rt_g = (const float*)(p.ws + WS_RT + 128 * 1024); const int* rt_pos = (const int*)(p.ws + WS_RT + 256 * 1024);
    const bf16* YS = (const bf16*)(p.ws + WS_HS); const float* modv = (const float*)(p.ws + WS_MODV) + (size_t)1 * 3 * 6144; const float* fw = IN(29);
    const int nw = gridDim.x * NWAVES, rpw = (NLAT + nw - 1) / nw, gw = blockIdx.x * NWAVES + wid;
    const int row0 = gw * rpw, row1 = (row0 + rpw < NLAT) ? row0 + rpw : NLAT;
    f32x4 fwv[4], gv[4]; int rc = -1;
#pragma unroll
    for (int j = 0; j < 4; ++j) fwv[j] = *(const f32x4*)(fw + (j * 64 + lane) * 4);
    for (int row = row0; row < row1; ++row) {
        const int b = row >> 13; float* x = p.out + (size_t)row * D;
        if (b != rc) { rc = b;
#pragma unroll
            for (int j = 0; j < 4; ++j) gv[j] = *(const f32x4*)(modv + b * 6144 + 5 * 1024 + (j * 64 + lane) * 4); }
        const float g0 = rt_g[row * 2], g1 = rt_g[row * 2 + 1]; const bf16* y0 = YS + (size_t)rt_pos[row * 2] * D; const bf16* y1 = YS + (size_t)rt_pos[row * 2 + 1] * D;
        f32x4 v[4]; float ss = 0.f;
#pragma unroll
        for (int j = 0; j < 4; ++j) { const int c0 = (j * 64 + lane) * 4; const f32x4 xv = *(const f32x4*)(x + c0); const u32x2 a = *(const u32x2*)(y0 + c0), c = *(const u32x2*)(y1 + c0);
            const f32x4 ya = {bf2f(a.x & 0xffff), bf2f(a.x >> 16), bf2f(a.y & 0xffff), bf2f(a.y >> 16)}, yb = {bf2f(c.x & 0xffff), bf2f(c.x >> 16), bf2f(c.y & 0xffff), bf2f(c.y >> 16)};
            v[j] = xv + gv[j] * (ya * g0 + yb * g1); ss += v[j][0] * v[j][0] + v[j][1] * v[j][1] + v[j][2] * v[j][2] + v[j][3] * v[j][3]; }
        ss = wave_sum(ss); const float rstd = __builtin_amdgcn_rsqf(ss * (1.f / D) + EPS);
#pragma unroll
        for (int j = 0; j < 4; ++j) { const int c0 = (j * 64 + lane) * 4; *(f32x4*)(x + c0) = v[j] * rstd * fwv[j]; }
    }
}

#define XB_TMO      128
#define XB_XCNT(j)  (256  + 64 * (j))
#define XB_XSUB(j)  (1280 + 64 * (j))
#define XB_XGEN(j)  (2304 + 64 * (j))
#define XB_TOP      3328
#define XB_TOPGEN   3392
#define XCD_BAR_WORDS 3456
#define XB_SPIN_CAP (1u << 22)
DEVI unsigned xb_ld(unsigned* p)              { return __hip_atomic_load(p, __ATOMIC_RELAXED, __HIP_MEMORY_SCOPE_AGENT); }
DEVI unsigned xb_add(unsigned* p, unsigned v) { return __hip_atomic_fetch_add(p, v, __ATOMIC_RELAXED, __HIP_MEMORY_SCOPE_AGENT); }
DEVI unsigned xb_xcc_id() { return (unsigned)__builtin_amdgcn_s_getreg((3 << 11) | 20) & 0xFu; }
#define XB_SPIN(cond, bar) do { unsigned _sp = 0; while (cond) { __builtin_amdgcn_s_sleep(1); \
    if ((++_sp & 255u) == 0u) { if (xb_ld(&(bar)[XB_TMO])) break; if (_sp > XB_SPIN_CAP) { atomicAdd(&(bar)[XB_TMO], 1u); break; } } } } while (0)
struct XcdBarrier { unsigned* bar; unsigned x; volatile LAS unsigned* st; };
DEVI XcdBarrier xcd_barrier_post(unsigned* bar, volatile LAS unsigned* st) {
    XcdBarrier b; b.bar = bar; b.x = xb_xcc_id(); b.st = st;
    if (threadIdx.x == 0) (void)xb_add(&bar[XB_XCNT(b.x)], 1u);
    return b;
}
DEVI void xcd_barrier_complete(unsigned* bar, unsigned x, unsigned& nloc, unsigned& nx) {
    const unsigned G = gridDim.x * gridDim.y * gridDim.z;
    unsigned sum, cnt, mine, sp = 0u;
    for (;;) {
        sum = 0u; cnt = 0u; mine = 0u;
#pragma unroll
        for (unsigned j = 0; j < 16; ++j) { const unsigned c = xb_ld(&bar[XB_XCNT(j)]); sum += c; cnt += (c > 0u) ? 1u : 0u; mine = (j == x) ? c : mine; }
        if (sum == G) break;
        __builtin_amdgcn_s_sleep(1);
        if ((++sp & 255u) == 0u) { if (xb_ld(&bar[XB_TMO])) break; if (sp > XB_SPIN_CAP) { atomicAdd(&bar[XB_TMO], 1u); break; } }
    }
    nloc = mine > 0u ? mine : 1u; nx = cnt > 0u ? cnt : 1u;
}
DEVI void xcd_barrier(const XcdBarrier& b) {
    asm volatile("s_waitcnt vmcnt(0)" ::: "memory");
    __syncthreads();
    if (threadIdx.x == 0) {
        unsigned* bar = b.bar;
        __builtin_amdgcn_s_waitcnt(0);
        unsigned nloc = b.st[0], nx = b.st[1];
        if (nloc == 0u) { xcd_barrier_complete(bar, b.x, nloc, nx); b.st[0] = nloc; b.st[1] = nx; }
        const unsigned old = xb_add(&bar[XB_XSUB(b.x)], 1u);
        const unsigned gen = old / nloc;
        if (old + 1u == (gen + 1u) * nloc) {
            __builtin_amdgcn_fence(__ATOMIC_RELEASE, "agent");
            asm volatile("s_waitcnt vmcnt(0)" ::: "memory");
            const unsigned og = xb_add(&bar[XB_TOP], 1u);
            const unsigned tg = og / nx;
            if (og + 1u == (tg + 1u) * nx) xb_add(&bar[XB_TOPGEN], 1u);
            else XB_SPIN(xb_ld(&bar[XB_TOPGEN]) == tg, bar);
            __builtin_amdgcn_fence(__ATOMIC_ACQUIRE, "agent");
            xb_add(&bar[XB_XGEN(b.x)], 1u);
            asm volatile("s_waitcnt vmcnt(0)" ::: "memory");
        } else {
            XB_SPIN(xb_ld(&bar[XB_XGEN(b.x)]) == gen, bar);
            __builtin_amdgcn_fence(__ATOMIC_ACQUIRE, "agent");
            asm volatile("s_waitcnt vmcnt(0)" ::: "memory");
        }
    }
    __syncthreads();
}

constexpr int NPHASES = 21;
#ifndef XSYNC
#define XSYNC 0
#endif
#ifndef REP_MASK
#define REP_MASK 0u
#endif
#ifndef PH_MASK
#define PH_MASK 0xffffu
#endif
__global__ void __launch_bounds__(NTHREADS, 2) mk_fwd(P p) {
    extern __shared__ __attribute__((aligned(16))) unsigned char lds[];
    cg::grid_group grid = cg::this_grid();
    const int G = gridDim.x, c = blockIdx.x;
    if (threadIdx.x < 30) ((lds_u64*)(uintptr_t)LDS_PTRS)[threadIdx.x] = (unsigned long long)p.in[threadIdx.x];
    if (threadIdx.x < 2) ((volatile LAS unsigned*)(uintptr_t)LDS_MISC)[threadIdx.x] = 0u;
    __syncthreads();
    XcdBarrier xbar = xcd_barrier_post((unsigned*)(p.ws + WS_CTL) + 1024, (volatile LAS unsigned*)(uintptr_t)LDS_MISC);
    int nsync = 0;
#define GRID_BAR() do { if (nsync == 0) grid.sync(); else xcd_barrier(xbar); ++nsync; } while (0)
    int ph = 0;
#define RUN(kid, ...) do { if (((PH_MASK >> (kid)) & 1u) && ph >= p.ph_lo && ph < p.ph_hi) { __VA_ARGS__; if ((REP_MASK >> (kid)) & 1u) { __VA_ARGS__; } if (ph + 1 < p.ph_hi) { GRID_BAR(); for (int xs_ = 0; xs_ < XSYNC; ++xs_) GRID_BAR(); } } ++ph; } while (0)
    RUN(0, ph_pro(p, lds));
#define LAYER(l) \
        RUN(1, ph_norm<false>(p, l, 0, T, lds, l == 1 ? 11 : 0, 5)); \
        RUN(2, { Gemm g{(const bf16*)(p.ws + WS_HM), (const bf16*)(p.ws + WS_WIN) + (size_t)l * INWP * 1024, 0, nullptr}; DenseSched S{T / 256, INWP / 256, G, c}; \
            EpiInProj E{(bf16*)(p.ws + WS_PROJ), (float*)(p.ws + WS_DT), IN(18) + l * 16, IN(19) + l * 16, (float*)(p.ws + WS_RQP), (float*)(p.ws + WS_RKVP)}; gemm_phase<D, 1024, 1024>(lds, g, S, E); }); \
        RUN(4, { Gemm g{(const bf16*)(p.ws + WS_PROJ), (const bf16*)(p.ws + WS_WQKV) + (size_t)l * 1024 * 384, 0, nullptr}; DenseSched S{T / 256, 4, G, c}; \
            EpiMla E{(bf16*)(p.ws + WS_Q), (bf16*)(p.ws + WS_K), (bf16*)(p.ws + WS_V), (const float*)(p.ws + WS_RQP), (const float*)(p.ws + WS_RKVP), (const float*)(p.ws + WS_ROPE), (const bf16*)(p.ws + WS_PROJ)}; gemm_phase<INWP, 384, 384>(lds, g, S, E); ph_scanA(p, l, lds); }); \
        RUN(5, ph_mixer(p, l, lds)); \
        RUN(6, ph_scanC(p, l, lds)); \
        RUN(8, { Gemm g{(const bf16*)(p.ws + WS_HM), (const bf16*)(p.ws + WS_WOUT) + (size_t)l * 1024 * 1024, 0, nullptr}; DenseSched S{NLAT / 256, 4, G, c}; \
            EpiResid E{l == 0 ? IN(0) : p.out, (const float*)(p.ws + WS_XC), p.out, (float*)(p.ws + WS_XC), (const float*)(p.ws + WS_MODV) + (size_t)l * 3 * 6144, 2}; gemm_phase<D, 1024, 1024>(lds, g, S, E); \
            if (l == 0) { CtxSplitSched S2{4, 256 * 2, G, c}; EpiPart E2{(float*)(p.ws + WS_XBC)}; gemm_phase<D, 1024, 256>(lds, g, S2, E2); } }); \
        RUN(9, ph_norm<l == 1>(p, l, 1, l == 0 ? T : NLAT, lds, l == 0 ? 4 : 0, 2)); \
        if (l == 0) { \
            RUN(10, { Gemm g{(const bf16*)(p.ws + WS_HM), (const bf16*)(p.ws + WS_WGU), 0, nullptr}; DenseSched S{T / 256, 2 * DFF / 256, G, c}; \
                EpiSwiglu E{(bf16*)(p.ws + WS_PROJ), DFF}; gemm_phase<D, 1024, 1024>(lds, g, S, E); }); \
            RUN(11, { Gemm g{(const bf16*)(p.ws + WS_PROJ), (const bf16*)(p.ws + WS_WD), 0, nullptr}; DenseSched S{NLAT / 256, 4, G, c}; \
                EpiResid E{p.out, (const float*)(p.ws + WS_XC), p.out, (float*)(p.ws + WS_XC), (const float*)(p.ws + WS_MODV), 5}; gemm_phase<DFF, DFF, DFF>(lds, g, S, E); \
                CtxSplitSched S2{11, 256 * 2, G, c}; EpiPart E2{(float*)(p.ws + WS_XBC)}; gemm_phase<DFF, DFF, 256>(lds, g, S2, E2); }); \
        } else { \
            RUN(12, { ph_sort(p, lds); __syncthreads(); ph_moew(p, lds); }); \
            RUN(13, { Gemm g{(const bf16*)(p.ws + WS_HM), (const bf16*)(p.ws + WS_WGUE), (size_t)2 * DFE * 1024, (const int*)(p.ws + WS_RT + 640 * 1024)}; MoeSched S{(const int*)(p.ws + WS_RT + 384 * 1024), 2 * DFE / 256, G, c}; \
                EpiSwiglu E{(bf16*)(p.ws + WS_ACTS), DFE}; gemm_phase<D, 1024, 1024, EpiSwiglu, MoeSched, true>(lds, g, S, E); }); \
            RUN(14, { Gemm g{(const bf16*)(p.ws + WS_ACTS), (const bf16*)(p.ws + WS_WDE), (size_t)1024 * DFE, nullptr}; MoeSched S{(const int*)(p.ws + WS_RT + 384 * 1024), 4, G, c}; \
                EpiStore E{(bf16*)(p.ws + WS_HS), D}; gemm_phase<DFE, DFE, DFE>(lds, g, S, E); }); \
            RUN(15, ph_final(p)); \
        }
    LAYER(0)
    LAYER(1)
#undef LAYER
#undef RUN
}

#ifndef MK_ONE_LAUNCH
#define MK_ONE_LAUNCH 1
#endif
extern "C" void kernel_launch(void* const* d_in, const int* in_sizes, int n_in, void* d_out, int out_size, void* d_ws, size_t ws_size, hipStream_t stream) {
    static int grid = 0;
    if (grid == 0) {
        if (n_in != 30 || out_size != NLAT * D || ws_size < WS_END) { fprintf(stderr, "kernel_launch: unexpected problem (n_in %d out %d ws %zu, need %zu)\n", n_in, out_size, ws_size, (size_t)WS_END); grid = -1; return; }
        int dev = 0, cus = 0, per_cu = 0;
        hipGetDevice(&dev); hipDeviceGetAttribute(&cus, hipDeviceAttributeMultiprocessorCount, dev);
        if (hipFuncSetAttribute((const void*)mk_fwd, hipFuncAttributeMaxDynamicSharedMemorySize, LDS_BYTES) != hipSuccess) { fprintf(stderr, "kernel_launch: hipFuncSetAttribute failed\n"); grid = -1; return; }
        if (hipOccupancyMaxActiveBlocksPerMultiprocessor(&per_cu, (const void*)mk_fwd, NTHREADS, LDS_BYTES) != hipSuccess || per_cu < 1) { fprintf(stderr, "kernel_launch: occupancy query failed (%d)\n", per_cu); grid = -1; return; }
        grid = cus;
        fprintf(stderr, "kernel_launch: grid %d (cus %d, per_cu %d)\n", grid, cus, per_cu);
    }
    if (grid < 0) return;
    if (hipMemsetAsync((char*)d_ws + WS_CTL, 0, 65536, stream) != hipSuccess) { fprintf(stderr, "kernel_launch: memset failed\n"); return; }
    P p{};
    for (int i = 0; i < 30; ++i) p.in[i] = (const float*)d_in[i];
    p.out = (float*)d_out; p.ws = (unsigned char*)d_ws;
#if MK_ONE_LAUNCH
    p.ph_lo = 0; p.ph_hi = NPHASES;
    { void* args[] = {&p}; hipError_t e = hipLaunchCooperativeKernel((const void*)mk_fwd, dim3(grid), dim3(NTHREADS), args, LDS_BYTES, stream);
      if (e != hipSuccess) fprintf(stderr, "cooperative launch failed: %s\n", hipGetErrorString(e)); }
#else
    for (int ph = 0; ph < NPHASES; ++ph) {
        p.ph_lo = ph; p.ph_hi = ph + 1;
        void* args[] = {&p}; hipError_t e = hipLaunchCooperativeKernel((const void*)mk_fwd, dim3(grid), dim3(NTHREADS), args, LDS_BYTES, stream);
        if (e != hipSuccess) { fprintf(stderr, "cooperative launch %d failed: %s\n", ph, hipGetErrorString(e)); break; }
    }
#endif
}
```

```cpp
#include <hip/hip_runtime.h>
#include <hip/hip_cooperative_groups.h>
#include <cstdio>
#include <cstdint>
namespace cg = cooperative_groups;
#ifndef ATTN_PROBE
#define ATTN_PROBE 0
#endif

#define DEVI __device__ __forceinline__
typedef unsigned short bf16;
typedef short bf16x8 __attribute__((ext_vector_type(8)));
typedef float f32x4 __attribute__((ext_vector_type(4)));
typedef float f32x2 __attribute__((ext_vector_type(2)));
typedef float f32x16 __attribute__((ext_vector_type(16)));
typedef unsigned u32x4 __attribute__((ext_vector_type(4)));
typedef unsigned u32x2 __attribute__((ext_vector_type(2)));
typedef __bf16 bf16x2_t __attribute__((ext_vector_type(2)));

constexpr int D = 1024, NB = 2, SEQ = 8192, NLAT = NB * SEQ, CL = 256, NCTX = NB * CL, T = NLAT + NCTX;
constexpr int INW = 2736, INWP = 2816;
constexpr int C_CQ = 0, C_CKV = 256, C_KPE = 384, C_RQ = 416, C_RK = 672, C_RV = 928, C_RG = 1184, C_Z = 1440, C_XBC = 1952, C_DTF = 2720, C_DTB = 2728;
constexpr int DFF = 2816, DFE = 1408, NEXP = 8;
constexpr float EPS = 1e-6f;
constexpr int MOE_MAXROWS = 34816;

constexpr size_t MiB = 1u << 20;
constexpr size_t WS_CTL = 0;
constexpr size_t WS_MODV = 1 * MiB;
constexpr size_t WS_ROPE = WS_MODV + 256 * 1024;
constexpr size_t WS_RQ = WS_MODV + 512 * 1024;
constexpr size_t WS_RKV = WS_MODV + 640 * 1024;
constexpr size_t WS_WIN = 2 * MiB;
constexpr size_t WS_WQKV = 13 * MiB;
constexpr size_t WS_WOUT = 15 * MiB;
constexpr size_t WS_WGU = 19 * MiB;
constexpr size_t WS_WD = 30 * MiB;
constexpr size_t WS_XC = 36 * MiB;
constexpr size_t WS_RT = 38 * MiB;
constexpr size_t WS_DT = 39 * MiB;
constexpr size_t WS_RQP = 41 * MiB + 128 * 1024;
constexpr size_t WS_RKVP = 41 * MiB + 512 * 1024;
constexpr size_t DYN = 42 * MiB;
constexpr size_t WS_HM = DYN;
constexpr size_t WS_PROJ = DYN + 33 * MiB;
constexpr size_t WS_XBC = DYN + 124 * MiB;
constexpr size_t WS_Q = DYN + 149 * MiB;
constexpr size_t WS_K = DYN + 161 * MiB + 512 * 1024;
constexpr size_t WS_V = DYN + 174 * MiB;
constexpr size_t WS_ST = DYN + 182 * MiB + 512 * 1024;
constexpr size_t WS_HT = WS_ST + (size_t)1584 * 2 * 4096 * 4;
constexpr size_t WS_CD = WS_RT + 512 * 1024;
constexpr size_t WS_VEC = WS_HT + (size_t)1584 * 2 * 4096 * 2;
constexpr size_t WS_WGUE = DYN + 33 * MiB;
constexpr size_t WS_WDE = DYN + 77 * MiB;
constexpr size_t WS_HS = DYN + 99 * MiB;
constexpr size_t WS_ACTS = DYN + 167 * MiB;
constexpr size_t WS_END = DYN + 261 * MiB;
static_assert(WS_HM + (size_t)T * 1024 * 2 <= WS_PROJ && WS_PROJ + (size_t)T * 2816 * 2 <= WS_XBC && WS_XBC + (size_t)T * 768 * 2 <= WS_Q &&
              WS_Q + (size_t)T * 384 * 2 <= WS_K && WS_K + (size_t)T * 384 * 2 <= WS_V && WS_V + (size_t)T * 256 * 2 <= WS_ST && WS_VEC + (size_t)1584 * 512 * 4 <= WS_END, "ws map (mixer)");
static_assert(WS_WGUE + (size_t)8 * 2816 * 1024 * 2 <= WS_WDE && WS_WDE + (size_t)8 * 1024 * 1408 * 2 <= WS_HS && WS_HS + (size_t)MOE_MAXROWS * 1024 * 2 <= WS_ACTS &&
              WS_ACTS + (size_t)MOE_MAXROWS * 1408 * 2 <= WS_END, "ws map (moe)");
static_assert(WS_DT + (size_t)T * 32 * 4 <= DYN && WS_WD + (size_t)1024 * 2816 * 2 <= WS_XC && WS_WIN + (size_t)2 * 2816 * 1024 * 2 <= WS_WQKV, "ws map (static)");

constexpr int NTHREADS = 512, NWAVES = 8;
constexpr int LDS_BYTES = 147456;

struct P { const float* in[30]; float* out; unsigned char* ws; int ph_lo, ph_hi; };
constexpr int LDS_MISC = 147456 - 512;
constexpr int LDS_PTRS = 147456 - 256;
typedef __attribute__((address_space(3))) unsigned long long lds_u64;
DEVI const float* inptr(int i) {
    const unsigned long long v = ((lds_u64*)(uintptr_t)LDS_PTRS)[i];
    const unsigned lo = __builtin_amdgcn_readfirstlane((unsigned)v), hi = __builtin_amdgcn_readfirstlane((unsigned)(v >> 32));
    return (const float*)(((unsigned long long)hi << 32) | lo);
}
#define IN(i) inptr(i)
DEVI int otid() { int t = threadIdx.x; asm volatile("" : "+v"(t)); return t; }

DEVI float bf2f(bf16 x) { return __uint_as_float(((unsigned)x) << 16); }
DEVI unsigned pk2(float lo, float hi) { f32x2 v = {lo, hi}; bf16x2_t b = __builtin_convertvector(v, bf16x2_t); return __builtin_bit_cast(unsigned, b); }
DEVI bf16 f2bf(float x) { return (bf16)(pk2(x, 0.f) & 0xffffu); }
DEVI float wave_sum(float v) {
#pragma unroll
    for (int o = 1; o < 64; o <<= 1) v += __shfl_xor(v, o);
    return v;
}
DEVI float siluf(float x) { return x * __builtin_amdgcn_rcpf(1.f + __builtin_amdgcn_exp2f(-1.4426950408889634f * x)); }
DEVI float softplusf(float x) { const float e = __expf(-fabsf(x)); return fmaxf(x, 0.f) + (e < 1e-3f ? e * (1.f - 0.5f * e) : __logf(1.f + e)); }
DEVI int rope_src(int p) { const int q = p & 15, s = (q & 1) ? 8 + (q >> 1) : (q >> 1); return (p & 16) + s; }

#define LAS __attribute__((address_space(3)))
struct Unit { int pm, pn, e, koff; };
struct Gemm { const bf16* A; const bf16* Bt; size_t bstride; const int* rowtab; };
constexpr int BM = 256, BK = 64, HALF = 128, HTB = HALF * BK * 2, STAGE_BYTES = 8 * HTB, NXCD = 8, WGM = 8;
__host__ __device__ __forceinline__ int lds_byte(int r, int c) { const int st = (r >> 4) * 2 + (c >> 5), rr = r & 15, cc = c & 31, ob = rr * 64 + cc * 2; return st * 1024 + (ob ^ (((ob >> 9) & 1) << 5)); }
__host__ __device__ __forceinline__ int perm32(int rho) { const int n = rho >> 4, i = rho & 15; return 8 * (i >> 2) + 4 * n + (i & 3); }
__host__ __device__ __forceinline__ void stage_rc(int b, int& R, int& C) { const int st = b / 1024, sb = b % 1024, swz = sb ^ (((sb >> 9) & 1) << 5); R = (st >> 1) * 16 + swz / 64; C = (st & 1) * 32 + (swz % 64) / 2; }
struct DenseSched {
    int nM, nN, G, c;
    DEVI bool next(int i, Unit& u) const {
        const int nwg = nM * nN; const long L = (long)i * G + c; if (L >= nwg) return false;
        int wgid = (int)L; { const int q = nwg / NXCD, r = nwg % NXCD, xcd = wgid % NXCD, off = wgid / NXCD; wgid = (xcd < r ? xcd * (q + 1) : r * (q + 1) + (xcd - r) * q) + off; }
        const int nig = WGM * nN, gid = wgid / nig, fm = gid * WGM, gsz = (nM - fm) < WGM ? (nM - fm) : WGM;
        u.pm = fm + ((wgid % nig) % gsz); u.pn = (wgid % nig) / gsz; u.e = 0; u.koff = 0; return true;
    }
};
struct CtxSplitSched {
    int nsplit, kbytes, G, c;
    DEVI bool next(int i, Unit& u) const { const int id = i * G + c; if (id >= 8 * nsplit) return false; const int tile = id & 7, ks = id >> 3; u.pm = 64 + (tile >> 2); u.pn = tile & 3; u.e = ks; u.koff = ks * kbytes; return true; }
};
struct MoeSched {
    const int* tab; int nN, G, c;
    DEVI bool next(int i, Unit& u) const { DenseSched d{tab[0], nN, G, c}; if (!d.next(i, u)) return false; u.e = tab[1 + u.pm]; return true; }
};
template <int LDA, int LDB, int KK, class Epi, class Sched, bool GATHER = false>
DEVI void gemm_phase(unsigned char* lds_generic, const Gemm g, const Sched& S, const Epi& E) {
    LAS unsigned char* lds = (LAS unsigned char*)lds_generic;
    const int tid = otid(), wid = __builtin_amdgcn_readfirstlane(tid >> 6), lane = tid & 63, wr = wid >> 2, wc = wid & 3, fr = lane & 15, fq = lane >> 4;
    constexpr int nt = KK / BK; static_assert(KK % 128 == 0, "K must be a multiple of 128");
    unsigned voffA[2], voffB[2]; int Rr[2], Cc[2];
#pragma unroll
    for (int i = 0; i < 2; ++i) { int R, C; stage_rc(tid * 16 + i * 8192, R, C); Rr[i] = R; Cc[i] = C; voffA[i] = (unsigned)(R * LDA + C) * 2u; const int Rb = Epi::PERM ? ((R & ~31) + perm32(R & 31)) : R; voffB[i] = (unsigned)(Rb * LDB + C) * 2u; }
    unsigned cv0[2] = {voffA[0], voffA[1]}, cv1[2] = {voffA[0], voffA[1]}, nv0[2] = {voffA[0], voffA[1]}, nv1[2] = {voffA[0], voffA[1]};
#define PG8_ROWS(u, v0, v1) do { if (GATHER) { _Pragma("unroll") for (int i_ = 0; i_ < 2; ++i_) { v0[i_] = (unsigned)(g.rowtab[(u).pm * BM + Rr[i_]] * LDA + Cc[i_]) * 2u; v1[i_] = (unsigned)(g.rowtab[(u).pm * BM + HALF + Rr[i_]] * LDA + Cc[i_]) * 2u; } } } while (0)
    constexpr size_t kstep = (size_t)(BK * 2), hstepA = GATHER ? (size_t)0 : (size_t)HALF * LDA * 2, hstepB = (size_t)HALF * LDB * 2, tstepA = GATHER ? (size_t)0 : (size_t)2 * HALF * LDA * 2, tstepB = 2 * hstepB;
    const unsigned ldsw = (unsigned)wid * 1024u;
    const int aoff = lds_byte(wr * 64 + fr, fq * 8), boff = lds_byte(wc * 32 + fr, fq * 8);
#define PG8_SA(b, h) (((b) * 2 + (h)) * HTB)
#define PG8_SB(b, h) ((4 + (b) * 2 + (h)) * HTB)
#define PG8_STAGE(bufoff, gbase, voff) do { _Pragma("unroll") for (int _i = 0; _i < 2; ++_i) \
        __builtin_amdgcn_global_load_lds((const unsigned*)((const char*)(gbase) + (voff)[_i]), (LAS unsigned*)(lds + (bufoff) + ldsw + _i * 8192), 16, 0, 0); } while (0)
#define PG8_LDA(dst, b, h) do { _Pragma("unroll") for (int m = 0; m < 4; ++m) _Pragma("unroll") for (int k = 0; k < 2; ++k) dst[m][k] = *(const LAS bf16x8*)(lds + PG8_SA(b, h) + aoff + m * 2048 + k * 1024); } while (0)
#define PG8_LDB(dst, b, h) do { _Pragma("unroll") for (int n = 0; n < 2; ++n) _Pragma("unroll") for (int k = 0; k < 2; ++k) dst[n][k] = *(const LAS bf16x8*)(lds + PG8_SB(b, h) + boff + n * 2048 + k * 1024); } while (0)
#define PG8_MMA(ai, bj, At, Bt) do { __builtin_amdgcn_s_setprio(1); _Pragma("unroll") for (int m = 0; m < 4; ++m) _Pragma("unroll") for (int n = 0; n < 2; ++n) _Pragma("unroll") for (int k = 0; k < 2; ++k) \
        acc[ai][bj][m][n] = __builtin_amdgcn_mfma_f32_16x16x32_bf16(Bt[n][k], At[m][k], acc[ai][bj][m][n], 0, 0, 0); __builtin_amdgcn_s_setprio(0); } while (0)
#define PG8_WAIT_V(n) asm volatile("s_waitcnt vmcnt(" #n ")" ::: "memory")
#define PG8_WAIT_L(n) asm volatile("s_waitcnt lgkmcnt(" #n ")" ::: "memory")
#define PG8_BAR __builtin_amdgcn_s_barrier()
#define PG8_SCHED __builtin_amdgcn_sched_barrier(0)
    Unit cur, nxt; int ui = 0;
    if (!S.next(0, cur)) return;
    f32x4 acc[2][2][4][2];
#pragma unroll
    for (int a = 0; a < 2; ++a)
#pragma unroll
        for (int b = 0; b < 2; ++b)
#pragma unroll
            for (int m = 0; m < 4; ++m)
#pragma unroll
                for (int n = 0; n < 2; ++n) acc[a][b][m][n] = (f32x4){0.f, 0.f, 0.f, 0.f};
    bf16x8 At[4][2], B0[2][2], B1[2][2];
    const char* cA = (const char*)g.A + (size_t)cur.pm * tstepA + cur.koff; const char* cB = (const char*)(g.Bt + (size_t)cur.e * g.bstride) + (size_t)cur.pn * tstepB + cur.koff;
    PG8_WAIT_V(0); PG8_WAIT_L(0); __syncthreads();
    PG8_ROWS(cur, cv0, cv1);
    PG8_STAGE(PG8_SB(0, 0), cB, voffB); PG8_STAGE(PG8_SB(0, 1), cB + hstepB, voffB); PG8_STAGE(PG8_SA(0, 0), cA, cv0); PG8_STAGE(PG8_SA(0, 1), cA + hstepA, cv1);
    if (wr == 1) PG8_BAR;
    PG8_WAIT_V(2); PG8_BAR;
    PG8_STAGE(PG8_SB(1, 0), cB + kstep, voffB); PG8_STAGE(PG8_SA(1, 0), cA + kstep, cv0); PG8_STAGE(PG8_SB(1, 1), cB + hstepB + kstep, voffB);
    PG8_WAIT_V(6); PG8_BAR;
    for (;;) {
        const bool has_next = S.next(ui + 1, nxt);
        if (has_next) PG8_ROWS(nxt, nv0, nv1);
        const char* nA = has_next ? (const char*)g.A + (size_t)nxt.pm * tstepA + nxt.koff : cA; const char* nB = has_next ? (const char*)(g.Bt + (size_t)nxt.e * g.bstride) + (size_t)nxt.pn * tstepB + nxt.koff : cB;
#pragma unroll 1
        for (int t = 0; t < nt; t += 2) {
            const bool last = (t == nt - 2);
            const char* a1 = cA + (size_t)(t + 1) * kstep;
            const char* a2 = last ? nA : cA + (size_t)(t + 2) * kstep; const char* b2 = last ? nB : cB + (size_t)(t + 2) * kstep;
            const char* a3 = a2 + kstep; const char* b3 = b2 + kstep;
            unsigned s0[2] = {cv0[0], cv0[1]}, s1[2] = {cv1[0], cv1[1]};
            if (GATHER && last && has_next) { s0[0] = nv0[0]; s0[1] = nv0[1]; s1[0] = nv1[0]; s1[1] = nv1[1]; }
            PG8_LDB(B0, 0, 0); PG8_LDB(B1, 0, 1); PG8_SCHED; PG8_LDA(At, 0, 0); PG8_STAGE(PG8_SA(1, 1), a1 + hstepA, cv1);
            PG8_WAIT_V(8); PG8_WAIT_L(0); PG8_BAR; PG8_MMA(0, 0, At, B0); PG8_MMA(0, 1, At, B1); PG8_BAR; PG8_SCHED;
            PG8_LDA(At, 0, 1); PG8_STAGE(PG8_SB(0, 0), b2, voffB); PG8_STAGE(PG8_SB(0, 1), b2 + hstepB, voffB); PG8_STAGE(PG8_SA(0, 0), a2, s0);
            PG8_WAIT_V(8); PG8_WAIT_L(0); PG8_BAR; PG8_MMA(1, 0, At, B0); PG8_MMA(1, 1, At, B1); PG8_BAR; PG8_SCHED;
            PG8_LDB(B0, 1, 0); PG8_LDB(B1, 1, 1); PG8_SCHED; PG8_LDA(At, 1, 0); PG8_STAGE(PG8_SA(0, 1), a2 + hstepA, s1);
            PG8_WAIT_V(8); PG8_WAIT_L(0); PG8_BAR; PG8_MMA(0, 0, At, B0); PG8_MMA(0, 1, At, B1); PG8_BAR; PG8_SCHED;
            PG8_LDA(At, 1, 1); PG8_STAGE(PG8_SB(1, 0), b3, voffB); PG8_STAGE(PG8_SB(1, 1), b3 + hstepB, voffB); PG8_STAGE(PG8_SA(1, 0), a3, s0);
            PG8_WAIT_V(8); PG8_WAIT_L(0); PG8_BAR; PG8_MMA(1, 0, At, B0); PG8_MMA(1, 1, At, B1); PG8_BAR; PG8_SCHED;
        }
        if (wr == 0) PG8_BAR;
        E(acc, cur, wr, wc, fr, fq);
        if (!has_next) break;
#pragma unroll
        for (int a = 0; a < 2; ++a)
#pragma unroll
            for (int b = 0; b < 2; ++b)
#pragma unroll
                for (int m = 0; m < 4; ++m)
#pragma unroll
                    for (int n = 0; n < 2; ++n) acc[a][b][m][n] = (f32x4){0.f, 0.f, 0.f, 0.f};
        cur = nxt; cA = nA; cB = nB; ++ui;
        if (GATHER) { cv0[0] = nv0[0]; cv0[1] = nv0[1]; cv1[0] = nv1[0]; cv1[1] = nv1[1]; }
        if (wr == 1) PG8_BAR;
    }
    PG8_WAIT_V(0);
    PG8_BAR;
#undef PG8_ROWS
#undef PG8_SA
#undef PG8_SB
#undef PG8_STAGE
#undef PG8_LDA
#undef PG8_LDB
#undef PG8_MMA
#undef PG8_WAIT_V
#undef PG8_WAIT_L
#undef PG8_BAR
#undef PG8_SCHED
}
#define EPI_LOOP_ROWS _Pragma("unroll") for (int ai = 0; ai < 2; ++ai) _Pragma("unroll") for (int m = 0; m < 4; ++m)
#define EPI_ROW (u.pm * 256 + ai * 128 + wr * 64 + m * 16 + fr)
#define EPI_COL(bj, n) (u.pn * 256 + (bj) * 128 + wc * 32 + (n) * 16 + fq * 4)
#define EPI_COL8(bj) (u.pn * 256 + (bj) * 128 + wc * 32 + fq * 8)
DEVI void st_bf16x8(bf16* p, f32x4 a, f32x4 b) { u32x4 w; w.x = pk2(a[0], a[1]); w.y = pk2(a[2], a[3]); w.z = pk2(b[0], b[1]); w.w = pk2(b[2], b[3]); *(u32x4*)p = w; }

DEVI void st_bf16x4(bf16* p, f32x4 v) { u32x2 w; w.x = pk2(v[0], v[1]); w.y = pk2(v[2], v[3]); *(u32x2*)p = w; }

struct EpiInProj {
    static constexpr bool PERM = true;
    bf16* proj; float* dt; const float* dt_bias; const float* a_log; float* rqp; float* rkvp;
    DEVI void operator()(const f32x4 (&acc)[2][2][4][2], const Unit& u, int wr, int wc, int fr, int fq) const {
        EPI_LOOP_ROWS { const int row = EPI_ROW;
            if (u.pn <= 1) { float ssq = 0.f;
#pragma unroll
                for (int bj = 0; bj < 2; ++bj) if (u.pn == 0 || bj == 0) {
#pragma unroll
                    for (int n = 0; n < 2; ++n) { const f32x4 v = acc[ai][bj][m][n]; ssq += (v[0] * v[0] + v[1] * v[1]) + (v[2] * v[2] + v[3] * v[3]); } }
                ssq += __shfl_xor(ssq, 16); ssq += __shfl_xor(ssq, 32);
                if (fq == 0) (u.pn == 0 ? rqp : rkvp)[(size_t)row * 4 + wc] = ssq; }
#pragma unroll
            for (int bj = 0; bj < 2; ++bj) { const int col = EPI_COL8(bj);
                if (col < C_DTF) st_bf16x8(proj + (size_t)row * INWP + col, acc[ai][bj][m][0], acc[ai][bj][m][1]);
                else if (col < INW) { const int j0 = col - C_DTF;
#pragma unroll
                    for (int n = 0; n < 2; ++n) { const f32x4 v = acc[ai][bj][m][n]; f32x4 dv, lv;
#pragma unroll
                        for (int i = 0; i < 4; ++i) { const float d_ = softplusf(v[i] + dt_bias[j0 + 4 * n + i]); dv[i] = d_; lv[i] = -d_ * __expf(a_log[j0 + 4 * n + i]); }
                        *(f32x4*)(dt + (size_t)row * 32 + j0 + 4 * n) = dv; *(f32x4*)(dt + (size_t)row * 32 + 16 + j0 + 4 * n) = lv; } } } }
    }
};
struct EpiMla {
    static constexpr bool PERM = false;
    bf16 *Q, *K, *V; const float *rqp, *rkvp; const float* rope; const bf16* proj;
    DEVI void operator()(const f32x4 (&acc)[2][2][4][2], const Unit& u, int wr, int wc, int fr, int fq) const {
        EPI_LOOP_ROWS { const int row = EPI_ROW; float sq = 0.f, skv = 0.f;
            if (u.pn <= 1) { const f32x4 pq = *(const f32x4*)(rqp + (size_t)row * 4); sq = __builtin_amdgcn_rsqf(((pq[0] + pq[1]) + (pq[2] + pq[3])) * (1.f / 256.f) + EPS); }
            if (u.pn >= 2) { const f32x4 pk = *(const f32x4*)(rkvp + (size_t)row * 4); skv = __builtin_amdgcn_rsqf(((pk[0] + pk[1]) + (pk[2] + pk[3])) * (1.f / 128.f) + EPS); }
            const int pos = row & (SEQ - 1), gr = pos >> 6, gc = pos & 63;
#pragma unroll
            for (int bj = 0; bj < 2; ++bj)
#pragma unroll
                for (int n = 0; n < 2; ++n) { const int col = EPI_COL(bj, n); f32x4 v = acc[ai][bj][m][n];
                    if (col < 384) { v = v * sq; const int d = col % 96;
                        if (d >= 64 && row < NLAT) { const int pp = (d - 64) >> 1;
#pragma unroll
                            for (int i = 0; i < 2; ++i) { const int pi = pp + i; const float* tb = (pi < 8) ? rope + (gr * 8 + pi) * 2 : rope + 2048 + (gc * 8 + (pi - 8)) * 2;
                                const float c = tb[0], s = tb[1], x0 = v[2 * i], x1 = v[2 * i + 1]; v[2 * i] = x0 * c - x1 * s; v[2 * i + 1] = x1 * c + x0 * s; } }
                        st_bf16x4(Q + (size_t)row * 384 + col, v); }
                    else if (col < 416) { const int d0 = col - 384, pp = d0 >> 1; const u32x2 raw = *(const u32x2*)(proj + (size_t)row * INWP + C_KPE + d0);
                        f32x4 x = {bf2f(raw.x & 0xffff), bf2f(raw.x >> 16), bf2f(raw.y & 0xffff), bf2f(raw.y >> 16)};
                        if (row < NLAT) {
#pragma unroll
                            for (int i = 0; i < 2; ++i) { const int pi = pp + i; const float* tb = (pi < 8) ? rope + (gr * 8 + pi) * 2 : rope + 2048 + (gc * 8 + (pi - 8)) * 2;
                                const float c = tb[0], s = tb[1], x0 = x[2 * i], x1 = x[2 * i + 1]; x[2 * i] = x0 * c - x1 * s; x[2 * i + 1] = x1 * c + x0 * s; } }
#pragma unroll
                        for (int h = 0; h < 4; ++h) st_bf16x4(K + (size_t)row * 384 + h * 96 + 64 + d0, x); }
                    else if (col >= 512 && col < 768) { const int c = col - 512; st_bf16x4(K + (size_t)row * 384 + (c >> 6) * 96 + (c & 63), v * skv); }
                    else if (col >= 768) { st_bf16x4(V + (size_t)row * 256 + (col - 768), v * skv); } }
            asm volatile("" ::: "memory"); }
    }
};
struct EpiResid {
    static constexpr bool PERM = true;
    const float* src_lat; const float* src_ctx; float* dst_lat; float* dst_ctx; const float* modv_l; int gidx;
    DEVI void operator()(const f32x4 (&acc)[2][2][4][2], const Unit& u, int wr, int wc, int fr, int fq) const {
        EPI_LOOP_ROWS { const int row = EPI_ROW; const bool lat = row < NLAT; const int r = lat ? (row >> 13) : 2;
            const float* s = lat ? src_lat + (size_t)row * D : src_ctx + (size_t)(row - NLAT) * D; float* d = lat ? dst_lat + (size_t)row * D : dst_ctx + (size_t)(row - NLAT) * D;
            const float* gp = modv_l + r * 6144 + gidx * 1024;
#pragma unroll
            for (int bj = 0; bj < 2; ++bj)
#pragma unroll
                for (int n = 0; n < 2; ++n) { const int col = EPI_COL8(bj) + 4 * n; const f32x4 gv = *(const f32x4*)(gp + col), sv = *(const f32x4*)(s + col);
                    *(f32x4*)(d + col) = sv + gv * acc[ai][bj][m][n]; } }
    }
};
struct EpiPart {
    static constexpr bool PERM = true;
    float* part;
    DEVI void operator()(const f32x4 (&acc)[2][2][4][2], const Unit& u, int wr, int wc, int fr, int fq) const {
        EPI_LOOP_ROWS { const int row = EPI_ROW; float* d = part + ((size_t)u.e * NCTX + (row - NLAT)) * D;
#pragma unroll
            for (int bj = 0; bj < 2; ++bj)
#pragma unroll
                for (int n = 0; n < 2; ++n) *(f32x4*)(d + EPI_COL8(bj) + 4 * n) = acc[ai][bj][m][n]; }
    }
};
struct EpiSwiglu {
    static constexpr bool PERM = true;
    bf16* act; int ldc;
    DEVI void operator()(const f32x4 (&acc)[2][2][4][2], const Unit& u, int wr, int wc, int fr, int fq) const {
        EPI_LOOP_ROWS { const int row = EPI_ROW; f32x4 o[2];
#pragma unroll
            for (int n = 0; n < 2; ++n) { const f32x4 gt = acc[ai][0][m][n], up = acc[ai][1][m][n];
#pragma unroll
                for (int i = 0; i < 4; ++i) o[n][i] = siluf(gt[i]) * up[i]; }
            st_bf16x8(act + (size_t)row * ldc + u.pn * 128 + wc * 32 + fq * 8, o[0], o[1]); }
    }
};
struct EpiStore {
    static constexpr bool PERM = true;
    bf16* o; int ldc;
    DEVI void operator()(const f32x4 (&acc)[2][2][4][2], const Unit& u, int wr, int wc, int fr, int fq) const {
        EPI_LOOP_ROWS { const int row = EPI_ROW;
#pragma unroll
            for (int bj = 0; bj < 2; ++bj) st_bf16x8(o + (size_t)row * ldc + EPI_COL8(bj), acc[ai][bj][m][0], acc[ai][bj][m][1]); }
    }
};

struct CvtSrc { const float* src; int ld; int ncols; bool perm; const float* ks; float sc; };
DEVI void cvt_tile(const CvtSrc t, bf16* dst, int Kd, int nd0, int kd0, LAS float* scr, int lane) {
    const int n = lane & 31;
    if (t.src) {
        const int nc = (n < t.ncols) ? n : t.ncols - 1; const float msk = (n < t.ncols) ? t.sc : 0.f;
        const float* sp0 = t.src + (size_t)(lane >> 5) * t.ld + nc;
        float v[32];
#pragma unroll
        for (int i = 0; i < 32; ++i) v[i] = __builtin_nontemporal_load(sp0 + (size_t)(2 * i) * t.ld);
        if (t.ks) {
#pragma unroll
            for (int i = 0; i < 32; ++i) v[i] *= t.ks[2 * i + (lane >> 5)];
        }
#pragma unroll
        for (int i = 0; i < 32; ++i) scr[(2 * i + (lane >> 5)) * 33 + n] = v[i] * msk;
    } else {
#pragma unroll 8
        for (int i = 0; i < 32; ++i) scr[(2 * i + (lane >> 5)) * 33 + n] = 0.f;
    }
    asm volatile("s_waitcnt lgkmcnt(0)" ::: "memory");
    const int c = lane & 7;
#pragma unroll
    for (int j = 0; j < 4; ++j) { const int nn = (lane >> 3) + 8 * j; const LAS float* sp = scr + (8 * c) * 33 + (t.perm ? rope_src(nn) : nn);
        u32x4 o; o.x = pk2(sp[0 * 33], sp[1 * 33]); o.y = pk2(sp[2 * 33], sp[3 * 33]); o.z = pk2(sp[4 * 33], sp[5 * 33]); o.w = pk2(sp[6 * 33], sp[7 * 33]);
        *(u32x4*)(dst + (size_t)(nd0 + nn) * Kd + kd0 + 8 * c) = o; }
    asm volatile("s_waitcnt lgkmcnt(0)" ::: "memory");
}
template <class F>
DEVI void cvt_job(bf16* dst, int Nd, int Kd, F f, LAS float* scr, int gw, int ngw, int lane) {
    const int ntn = Nd >> 5, ntk = Kd >> 6;
    for (int it = gw; it < ntn * ntk; it += ngw) { const int nt = it % ntn, kt = it / ntn; cvt_tile(f(nt, kt), dst, Kd, nt * 32, kt * 64, scr, lane); }
}
DEVI void ph_pro(const P& p, unsigned char* lds) {
    const int tid = otid(), wid = tid >> 6, lane = tid & 63;
    __syncthreads();
    float* modv = (float*)(p.ws + WS_MODV);
    float* red = (float*)lds;
    float* sc3 = (float*)(lds + 8192);
    if (blockIdx.x < 192) { for (int k = tid; k < 1024; k += NTHREADS) { sc3[k] = siluf(IN(1)[k]); sc3[1024 + k] = siluf(IN(1)[1024 + k]); sc3[2048 + k] = siluf(IN(3)[k]); } }
    __syncthreads();
    for (int item = blockIdx.x; item < 192; item += gridDim.x) {
        const int l = item / 96, n = (item % 96) * 64 + lane;
        const float* W = IN(4) + (size_t)l * 1024 * 6144;
        float a0 = 0.f, a1 = 0.f, a2 = 0.f;
#pragma unroll 16
        for (int k = wid * 128; k < wid * 128 + 128; ++k) {
            const float w = __builtin_nontemporal_load(W + (size_t)k * 6144 + n);
            a0 += sc3[k] * w; a1 += sc3[1024 + k] * w; a2 += sc3[2048 + k] * w;
        }
        red[(wid * 3 + 0) * 64 + lane] = a0; red[(wid * 3 + 1) * 64 + lane] = a1; red[(wid * 3 + 2) * 64 + lane] = a2;
        __syncthreads();
        if (tid < 192) { const int r = tid >> 6, ln = tid & 63; float s = 0.f;
            for (int w = 0; w < 8; ++w) s += red[(w * 3 + r) * 64 + ln];
            const int nn = (item % 96) * 64 + ln; modv[(l * 3 + r) * 6144 + nn] = s + IN(5)[l * 6144 + nn]; }
        __syncthreads();
    }
    if (blockIdx.x == gridDim.x - 1) {
        float* rope = (float*)(p.ws + WS_ROPE);
        for (int idx = tid; idx < 1536; idx += NTHREADS) {
            const int i = idx & 7, pos = (idx < 1024) ? (idx >> 3) : ((idx - 1024) >> 3);
            const float invf = (i == 0) ? 1.f : (i == 1) ? 0.31622776601683794f : (i == 2) ? 0.1f : (i == 3) ? 0.03162277660168379f : (i == 4) ? 0.01f : (i == 5) ? 0.003162277660168379f : (i == 6) ? 0.001f : 0.00031622776601683794f;
            const float ang = (float)pos * invf;
            double rev = (double)ang * 0.15915494309189535; rev -= __builtin_rint(rev);
            const float fr = (float)rev;
            rope[idx * 2] = __builtin_amdgcn_cosf(fr); rope[idx * 2 + 1] = __builtin_amdgcn_sinf(fr);
        }
    }
    __syncthreads();
    LAS float* scr = (LAS float*)(LAS unsigned char*)lds + wid * (64 * 33);
    const int gw = blockIdx.x * NWAVES + wid, ngw = gridDim.x * NWAVES;
    for (int l = 0; l < 2; ++l) {
        { const float* W = IN(8) + (size_t)l * 1024 * INW;
          cvt_job((bf16*)(p.ws + WS_WIN) + (size_t)l * INWP * 1024, INWP, 1024, [=](int nt, int kt) -> CvtSrc {
              const int n0 = nt * 32; if (n0 >= INW) return CvtSrc{nullptr, 0, 0, false, nullptr, 1.f};
              return CvtSrc{W + (size_t)(kt * 64) * INW + n0, INW, (INW - n0 < 32) ? INW - n0 : 32, n0 == C_KPE, nullptr, 1.f}; }, scr, gw, ngw, lane); }
        { const float* Wq = IN(11) + (size_t)l * 256 * 384; const float* qn = IN(10) + l * 256; const float* Wk = IN(13) + (size_t)l * 128 * 256; const float* Wv = IN(14) + (size_t)l * 128 * 256; const float* kn = IN(12) + l * 128;
          const float QS = 0.10206207261596577f * 1.4426950408889634f;
          cvt_job((bf16*)(p.ws + WS_WQKV) + (size_t)l * 1024 * 384, 1024, 384, [=](int nt, int kt) -> CvtSrc {
              const int n0 = nt * 32, k0 = kt * 64;
              if (n0 < 384) { if (k0 >= 256) return CvtSrc{nullptr, 0, 0, false, nullptr, 1.f}; return CvtSrc{Wq + (size_t)k0 * 384 + n0, 384, 32, (n0 % 96) == 64, qn + k0, QS}; }
              if (n0 < 512 || k0 < 256) return CvtSrc{nullptr, 0, 0, false, nullptr, 1.f};
              if (n0 < 768) return CvtSrc{Wk + (size_t)(k0 - 256) * 256 + (n0 - 512), 256, 32, false, kn + k0 - 256, 1.f};
              return CvtSrc{Wv + (size_t)(k0 - 256) * 256 + (n0 - 768), 256, 32, false, kn + k0 - 256, 1.f}; }, scr, gw, ngw, lane); }
        { const float* W = IN(9) + (size_t)l * 1024 * 1024;
          cvt_job((bf16*)(p.ws + WS_WOUT) + (size_t)l * 1024 * 1024, 1024, 1024, [=](int nt, int kt) -> CvtSrc { return CvtSrc{W + (size_t)(kt * 64) * 1024 + nt * 32, 1024, 32, false, nullptr, 1.f}; }, scr, gw, ngw, lane); }
    }
    { const float* Wg = IN(22); const float* Wu = IN(23);
      cvt_job((bf16*)(p.ws + WS_WGU), 2 * DFF, 1024, [=](int nt, int kt) -> CvtSrc { const int n0 = nt * 32, t = n0 >> 8, r = n0 & 255;
          return CvtSrc{(r < 128 ? Wg + t * 128 + r : Wu + t * 128 + r - 128) + (size_t)(kt * 64) * DFF, DFF, 32, false, nullptr, 1.f}; }, scr, gw, ngw, lane); }
    { const float* W = IN(24);
      cvt_job((bf16*)(p.ws + WS_WD), 1024, DFF, [=](int nt, int kt) -> CvtSrc { return CvtSrc{W + (size_t)(kt * 64) * 1024 + nt * 32, 1024, 32, false, nullptr, 1.f}; }, scr, gw, ngw, lane); }
}
DEVI void ph_moew(const P& p, unsigned char* lds) {
    const int tid = otid(), wid = tid >> 6, lane = tid & 63;
    LAS float* scr = (LAS float*)(LAS unsigned char*)lds + wid * (64 * 33);
    const int gw = blockIdx.x * NWAVES + wid, ngw = gridDim.x * NWAVES;
    for (int e = 0; e < NEXP; ++e) {
        { const float* Wg = IN(26) + (size_t)e * 1024 * DFE; const float* Wu = IN(27) + (size_t)e * 1024 * DFE;
          cvt_job((bf16*)(p.ws + WS_WGUE) + (size_t)e * 2 * DFE * 1024, 2 * DFE, 1024, [=](int nt, int kt) -> CvtSrc { const int n0 = nt * 32, t = n0 >> 8, r = n0 & 255;
              return CvtSrc{(r < 128 ? Wg + t * 128 + r : Wu + t * 128 + r - 128) + (size_t)(kt * 64) * DFE, DFE, 32, false, nullptr, 1.f}; }, scr, gw, ngw, lane); }
        { const float* W = IN(28) + (size_t)e * DFE * 1024;
          cvt_job((bf16*)(p.ws + WS_WDE) + (size_t)e * 1024 * DFE, 1024, DFE, [=](int nt, int kt) -> CvtSrc { return CvtSrc{W + (size_t)(kt * 64) * 1024 + nt * 32, 1024, 32, false, nullptr, 1.f}; }, scr, gw, ngw, lane); }
    }
}

template <bool route>
DEVI void ph_norm(const P& p, int l, int which, int nrows, unsigned char* lds, int npart, int pgidx) {
    const int tid = otid(), wid = tid >> 6, lane = tid & 63;
    const bool first = (l == 0 && which == 0);
    const float* src_lat = first ? IN(0) : p.out; const float* src_ctx = (l == 0) ? IN(2) : (const float*)(p.ws + WS_XC);
    const float* w = IN(6 + which) + l * 1024; const float* modv = (const float*)(p.ws + WS_MODV) + (size_t)l * 3 * 6144;
    bf16* H = (bf16*)(p.ws + WS_HM);
    int* rt_e = (int*)(p.ws + WS_RT); float* rt_g = (float*)(p.ws + WS_RT + 128 * 1024);
    float* rl = (float*)lds;
    if (route) { __syncthreads(); const float* router = IN(25);
#pragma unroll
        for (int i = 0; i < 4; ++i) *(f32x4*)(rl + (tid + NTHREADS * i) * 4) = *(const f32x4*)(router + (tid + NTHREADS * i) * 4);
        __syncthreads(); }
    const int nw = gridDim.x * NWAVES, rpw = (NLAT + nw - 1) / nw, gw = blockIdx.x * NWAVES + wid;
    f32x4 vn[4], gsc[4], shv[4]; int rc = -1;
    for (int pass = 0; pass < (nrows > NLAT ? 2 : 1); ++pass) {
    const int row0 = pass == 0 ? gw * rpw : NLAT + gw, row1 = pass == 0 ? ((row0 + rpw < NLAT) ? row0 + rpw : NLAT) : nrows, rstep = pass == 0 ? 1 : nw;
    if (row0 < row1) { const float* x = (row0 < NLAT) ? src_lat + (size_t)row0 * D : src_ctx + (size_t)(row0 - NLAT) * D;
#pragma unroll
        for (int j = 0; j < 4; ++j) vn[j] = *(const f32x4*)(x + (j * 64 + lane) * 4); }
    for (int row = row0; row < row1; row += rstep) {
        const bool lat = row < NLAT; const int r = lat ? (row >> 13) : 2;
        if (r != rc) { rc = r; const float* sh = modv + r * 6144 + (which * 3 + 0) * 1024; const float* sc = modv + r * 6144 + (which * 3 + 1) * 1024;
#pragma unroll
            for (int j = 0; j < 4; ++j) { const int c0 = (j * 64 + lane) * 4; const f32x4 wv = *(const f32x4*)(w + c0), cv = *(const f32x4*)(sc + c0); shv[j] = *(const f32x4*)(sh + c0); gsc[j] = wv * (cv + 1.f); } }
        f32x4 v[4]; float ss = 0.f;
#pragma unroll
        for (int j = 0; j < 4; ++j) v[j] = vn[j];
        if (!lat && npart > 0) { const float* part = (const float*)(p.ws + WS_XBC) + (size_t)(row - NLAT) * D; const float* gp = modv + 2 * 6144 + pgidx * 1024; float* xc = (float*)(p.ws + WS_XC) + (size_t)(row - NLAT) * D;
#pragma unroll
            for (int j = 0; j < 4; ++j) { const int c0 = (j * 64 + lane) * 4; f32x4 acc = {0.f, 0.f, 0.f, 0.f};
#pragma unroll 2
                for (int k = 0; k < npart; ++k) acc += *(const f32x4*)(part + (size_t)k * NCTX * D + c0);
                v[j] += *(const f32x4*)(gp + c0) * acc; *(f32x4*)(xc + c0) = v[j]; } }
#pragma unroll
        for (int j = 0; j < 4; ++j) ss += v[j][0] * v[j][0] + v[j][1] * v[j][1] + v[j][2] * v[j][2] + v[j][3] * v[j][3];
        if (row + rstep < row1) { const int nrow = row + rstep; const float* x = (nrow < NLAT) ? src_lat + (size_t)nrow * D : src_ctx + (size_t)(nrow - NLAT) * D;
#pragma unroll
            for (int j = 0; j < 4; ++j) vn[j] = *(const f32x4*)(x + (j * 64 + lane) * 4); }
        ss = wave_sum(ss); const float rstd = __builtin_amdgcn_rsqf(ss * (1.f / D) + EPS);
        float lg[8];
#pragma unroll
        for (int e = 0; e < 8; ++e) lg[e] = 0.f;
#pragma unroll
        for (int j = 0; j < 4; ++j) { const int c0 = (j * 64 + lane) * 4; v[j] = v[j] * rstd * gsc[j] + shv[j]; st_bf16x4(H + (size_t)row * D + c0, v[j]); }
        if (route) {
#pragma unroll
            for (int j = 0; j < 4; ++j) { const int c0 = (j * 64 + lane) * 4;
#pragma unroll
                for (int i = 0; i < 4; ++i) { const f32x4 r0 = *(const f32x4*)(rl + (c0 + i) * 8), r1 = *(const f32x4*)(rl + (c0 + i) * 8 + 4); const float hh = v[j][i];
                    lg[0] += hh * r0[0]; lg[1] += hh * r0[1]; lg[2] += hh * r0[2]; lg[3] += hh * r0[3]; lg[4] += hh * r1[0]; lg[5] += hh * r1[1]; lg[6] += hh * r1[2]; lg[7] += hh * r1[3]; }
                asm volatile("" ::: "memory"); } }
        if (route) {
#pragma unroll
            for (int e = 0; e < 8; ++e) lg[e] = wave_sum(lg[e]);
            int i1 = 0; float v1 = lg[0];
#pragma unroll
            for (int e = 1; e < 8; ++e) if (lg[e] > v1) { v1 = lg[e]; i1 = e; }
            int i2 = -1; float v2 = -3.0e38f;
#pragma unroll
            for (int e = 0; e < 8; ++e) if (e != i1 && lg[e] > v2) { v2 = lg[e]; i2 = e; }
            const float e2 = __expf(v2 - v1), g1 = 1.f / (1.f + e2), g2 = e2 / (1.f + e2);
            if (lane == 0) { rt_e[row * 2] = i1; rt_e[row * 2 + 1] = i2; rt_g[row * 2] = g1; rt_g[row * 2 + 1] = g2; }
        }
    }
    }
}

typedef short v4i16_t __attribute__((ext_vector_type(4)));
DEVI v4i16_t lds_tr(const unsigned char* p) { return __builtin_amdgcn_ds_read_tr16_b64_v4i16((LAS v4i16_t*)(LAS unsigned char*)p); }
constexpr int A3_KLD = 208, A3_VLD = 192, A3_VOFF = 64 * A3_KLD, A3_BUF = A3_VOFF + 64 * A3_VLD;
template <int VAR>
DEVI void attn_unit(const P& p, int uidx, unsigned char* lds, bf16* outp) {
    const int tid = otid(), wid = __builtin_amdgcn_readfirstlane(tid >> 6), lane = tid & 63, r32 = lane & 31, hi = lane >> 5;
    const bf16* Q = (const bf16*)(p.ws + WS_Q); const bf16* K = (const bf16*)(p.ws + WS_K); const bf16* V = (const bf16*)(p.ws + WS_V); bf16* MIX = outp;
    int b, h, qrow0, NT;
    if (uidx < 256) { b = uidx >> 7; h = (uidx >> 5) & 3; qrow0 = b * SEQ + (uidx & 31) * 256; NT = 4 + SEQ / 64; }
    else { const int j = uidx - 256; b = j >> 2; h = j & 3; qrow0 = NLAT + b * CL; NT = 4; }
    const int qrow = qrow0 + wid * 32 + r32;
    bf16x8 qf[6];
#pragma unroll
    for (int s = 0; s < 6; ++s) qf[s] = *(const bf16x8*)(Q + (size_t)qrow * 384 + h * 96 + s * 16 + hi * 8);
    const int kk0 = tid / 12, kq0 = tid % 12, kk1 = (512 + tid) / 12, kq1 = (512 + tid) % 12, vk = tid >> 3, vq = tid & 7;
    const bf16* Kh = K + h * 96; const bf16* Vh = V + h * 64 + vq * 8;
    const int ctx0 = NLAT + b * CL, lat0 = b * SEQ;
    u32x4 krA0, krA1 = {0u, 0u, 0u, 0u}, vrA;
#define AT_LOAD(t, kr0, kr1, vr) do { const int kr_ = ((t) < 4) ? ctx0 + (t) * 64 : lat0 + ((t) - 4) * 64; \
        kr0 = *(const u32x4*)(Kh + (size_t)(kr_ + kk0) * 384 + kq0 * 8); if (tid < 256) kr1 = *(const u32x4*)(Kh + (size_t)(kr_ + kk1) * 384 + kq1 * 8); \
        vr = *(const u32x4*)(Vh + (size_t)(kr_ + vk) * 256); } while (0)
#define AT_STORE(bufp, kr0, kr1, vr) do { unsigned char* b_ = (bufp); *(u32x4*)(b_ + kk0 * A3_KLD + kq0 * 16) = kr0; if (tid < 256) *(u32x4*)(b_ + kk1 * A3_KLD + kq1 * 16) = kr1; \
        *(u32x4*)(b_ + A3_VOFF + vk * A3_VLD + vq * 16) = vr; } while (0)
    const int troff = (4 * hi + ((lane & 15) >> 2)) * A3_VLD + (16 * ((lane >> 4) & 1) + 4 * (lane & 3)) * 2;
    const int koff = r32 * A3_KLD + hi * 16;
    f32x16 o0, o1, negm;
#pragma unroll
    for (int r = 0; r < 16; ++r) { o0[r] = 0.f; o1[r] = 0.f; negm[r] = 0.f; }
    float mhat = 0.f, lsum = 0.f;
    __syncthreads();
    AT_LOAD(0, krA0, krA1, vrA); AT_STORE(lds, krA0, krA1, vrA); AT_LOAD(1, krA0, krA1, vrA); AT_STORE(lds + A3_BUF, krA0, krA1, vrA);
    __syncthreads();
#define SBAR() __builtin_amdgcn_sched_barrier(0)
#define KRD(bufp, half, s) (*(const bf16x8*)((bufp) + koff + (half) * 32 * A3_KLD + (s) * 32))
#define MF(a, b, c) __builtin_amdgcn_mfma_f32_32x32x16_bf16(a, b, c, 0, 0, 0)
#define MFQ(a, b, c) ((VAR == 3) ? (c) : MF(a, b, c))
#define MFP(a, b, c) ((VAR == 2) ? (c) : MF(a, b, c))
#define EX4(S, r0) do { if (VAR == 1) { S[r0] *= 0.001f; S[r0 + 1] *= 0.001f; S[r0 + 2] *= 0.001f; S[r0 + 3] *= 0.001f; break; } S[r0] = __builtin_amdgcn_exp2f(S[r0]); S[r0 + 1] = __builtin_amdgcn_exp2f(S[r0 + 1]); S[r0 + 2] = __builtin_amdgcn_exp2f(S[r0 + 2]); S[r0 + 3] = __builtin_amdgcn_exp2f(S[r0 + 3]); lsum += (S[r0] + S[r0 + 1]) + (S[r0 + 2] + S[r0 + 3]); } while (0)
#define PK8(S, r0) __builtin_bit_cast(bf16x8, (u32x4){pk2(S[r0], S[r0 + 1]), pk2(S[r0 + 2], S[r0 + 3]), pk2(S[r0 + 4], S[r0 + 5]), pk2(S[r0 + 6], S[r0 + 7])})
#define VFR(vp) ({ const v4i16_t lo_ = lds_tr(vp), hi_ = lds_tr((vp) + 8 * A3_VLD); (bf16x8){lo_[0], lo_[1], lo_[2], lo_[3], hi_[0], hi_[1], hi_[2], hi_[3]}; })
#define MX3(a, b, c) __builtin_fmaxf(__builtin_fmaxf((a), (b)), (c))
#define AT_UPD(S0, S1, mx, FORCE) do { float mx_ = __builtin_fmaxf(mx, __shfl_xor(mx, 32)); \
        if ((FORCE) || __any(mx_ > 8.0f)) { const float dl_ = (FORCE) ? mx_ : __builtin_fmaxf(mx_, 0.f); mhat += dl_; \
            _Pragma("unroll") for (int r = 0; r < 16; ++r) { S0[r] -= dl_; S1[r] -= dl_; negm[r] = -mhat; } \
            if (!(FORCE)) { const float f_ = __builtin_amdgcn_exp2f(-dl_); _Pragma("unroll") for (int r = 0; r < 16; ++r) { o0[r] *= f_; o1[r] *= f_; } lsum *= f_; } } } while (0)
    f32x16 sa0, sa1, sb0, sb1;
    { const unsigned char* kb_ = lds;
#pragma unroll
      for (int s = 0; s < 6; ++s) { sa0 = MF(KRD(kb_, 0, s), qf[s], s == 0 ? negm : sa0); sa1 = MF(KRD(kb_, 1, s), qf[s], s == 0 ? negm : sa1); }
      float a_ = MX3(sa0[0], sa0[1], sa1[0]), b_ = MX3(sa0[2], sa0[3], sa1[1]); a_ = MX3(a_, sa1[2], sa1[3]);
#pragma unroll
      for (int r = 4; r < 16; r += 4) { a_ = MX3(a_, sa0[r], sa0[r + 1]); b_ = MX3(b_, sa0[r + 2], sa0[r + 3]); a_ = MX3(a_, sa1[r], sa1[r + 1]); b_ = MX3(b_, sa1[r + 2], sa1[r + 3]); }
      AT_UPD(sa0, sa1, __builtin_fmaxf(a_, b_), true); }
#define AT_STEP(C0, C1, N0, N1, t, bc_, HAS_NEXT) do { const int b1_ = ((bc_) == 2) ? 0 : (bc_) + 1, b2_ = (b1_ == 2) ? 0 : b1_ + 1; \
        const unsigned char* kb_ = lds + b1_ * A3_BUF; const unsigned char* vb_ = lds + (bc_) * A3_BUF + A3_VOFF + troff; \
        if (VAR != 4 && (t) + 2 < NT) AT_LOAD((t) + 2, krA0, krA1, vrA); \
        bf16x8 pw0_, pw1_, pw2_, pw3_; float ma_ = -3.0e38f, mb_ = -3.0e38f; \
        if (HAS_NEXT) { \
            bf16x8 k0_ = KRD(kb_, 0, 0), k1_ = KRD(kb_, 1, 0), k2_ = KRD(kb_, 0, 1), k3_ = KRD(kb_, 1, 1); SBAR(); \
            N0 = MFQ(k0_, qf[0], negm); EX4(C0, 0); k0_ = KRD(kb_, 0, 2); SBAR(); \
            N1 = MFQ(k1_, qf[0], negm); EX4(C0, 4); k1_ = KRD(kb_, 1, 2); SBAR(); \
            N0 = MFQ(k2_, qf[1], N0); EX4(C0, 8); k2_ = KRD(kb_, 0, 3); SBAR(); \
            N1 = MFQ(k3_, qf[1], N1); EX4(C0, 12); k3_ = KRD(kb_, 1, 3); SBAR(); \
            N0 = MFQ(k0_, qf[2], N0); EX4(C1, 0); k0_ = KRD(kb_, 0, 4); SBAR(); \
            N1 = MFQ(k1_, qf[2], N1); EX4(C1, 4); k1_ = KRD(kb_, 1, 4); SBAR(); \
            N0 = MFQ(k2_, qf[3], N0); EX4(C1, 8); k2_ = KRD(kb_, 0, 5); SBAR(); \
            N1 = MFQ(k3_, qf[3], N1); EX4(C1, 12); k3_ = KRD(kb_, 1, 5); SBAR(); \
            N0 = MFQ(k0_, qf[4], N0); pw0_ = PK8(C0, 0); SBAR(); \
            N1 = MFQ(k1_, qf[4], N1); pw1_ = PK8(C0, 8); SBAR(); \
            N0 = MFQ(k2_, qf[5], N0); pw2_ = PK8(C1, 0); SBAR(); \
            N1 = MFQ(k3_, qf[5], N1); pw3_ = PK8(C1, 8); SBAR(); \
        } else { EX4(C0, 0); EX4(C0, 4); EX4(C0, 8); EX4(C0, 12); EX4(C1, 0); EX4(C1, 4); EX4(C1, 8); EX4(C1, 12); pw0_ = PK8(C0, 0); pw1_ = PK8(C0, 8); pw2_ = PK8(C1, 0); pw3_ = PK8(C1, 8); SBAR(); } \
        { bf16x8 va_ = VFR(vb_), vb2_ = VFR(vb_ + 64); SBAR(); \
          bf16x8 vc_ = VFR(vb_ + 16 * A3_VLD), vd_ = VFR(vb_ + 16 * A3_VLD + 64); SBAR(); \
          o0 = MFP(va_, pw0_, o0); if (HAS_NEXT) { ma_ = MX3(N0[0], N0[1], N1[0]); mb_ = MX3(N0[2], N0[3], N1[1]); } SBAR(); \
          o1 = MFP(vb2_, pw0_, o1); if (HAS_NEXT) { ma_ = MX3(ma_, N1[2], N1[3]); mb_ = MX3(mb_, N0[4], N0[5]); } SBAR(); \
          va_ = VFR(vb_ + 32 * A3_VLD); vb2_ = VFR(vb_ + 32 * A3_VLD + 64); SBAR(); \
          o0 = MFP(vc_, pw1_, o0); if (HAS_NEXT) { ma_ = MX3(ma_, N0[6], N0[7]); mb_ = MX3(mb_, N1[4], N1[5]); } SBAR(); \
          o1 = MFP(vd_, pw1_, o1); if (HAS_NEXT) { ma_ = MX3(ma_, N1[6], N1[7]); mb_ = MX3(mb_, N0[8], N0[9]); } SBAR(); \
          vc_ = VFR(vb_ + 48 * A3_VLD); vd_ = VFR(vb_ + 48 * A3_VLD + 64); SBAR(); \
          o0 = MFP(va_, pw2_, o0); if (HAS_NEXT) { ma_ = MX3(ma_, N0[10], N0[11]); mb_ = MX3(mb_, N1[8], N1[9]); } SBAR(); \
          o1 = MFP(vb2_, pw2_, o1); if (HAS_NEXT) { ma_ = MX3(ma_, N1[10], N1[11]); mb_ = MX3(mb_, N0[12], N0[13]); } SBAR(); \
          if (HAS_NEXT) { ma_ = MX3(ma_, N0[14], N0[15]); mb_ = MX3(mb_, N1[12], N1[13]); } SBAR(); \
          o0 = MFP(vc_, pw3_, o0); if (HAS_NEXT) { ma_ = MX3(ma_, N1[14], N1[15]); } SBAR(); \
          o1 = MFP(vd_, pw3_, o1); SBAR(); } \
        if (HAS_NEXT) AT_UPD(N0, N1, __builtin_fmaxf(ma_, mb_), false); \
        if (VAR != 4 && (t) + 2 < NT) AT_STORE(lds + b2_ * A3_BUF, krA0, krA1, vrA); \
        if (VAR != 4) __syncthreads(); } while (0)
    int bc = 0, t = 0;
    for (; t + 2 < NT; t += 2) {
        AT_STEP(sa0, sa1, sb0, sb1, t, bc, true); bc = (bc == 2) ? 0 : bc + 1;
        AT_STEP(sb0, sb1, sa0, sa1, t + 1, bc, true); bc = (bc == 2) ? 0 : bc + 1;
    }
    AT_STEP(sa0, sa1, sb0, sb1, t, bc, true); bc = (bc == 2) ? 0 : bc + 1;
    AT_STEP(sb0, sb1, sa0, sa1, t + 1, bc, false);
#undef AT_LOAD
#undef AT_STORE
#undef SBAR
#undef KRD
#undef MF
#undef MFQ
#undef MFP
#undef EX4
#undef PK8
#undef VFR
#undef MX3
#undef AT_UPD
#undef AT_STEP
    lsum += __shfl_xor(lsum, 32);
    const float inv = 1.f / lsum;
    bf16* orow = MIX + (size_t)qrow * D + h * 64;
#pragma unroll
    for (int g = 0; g < 4; ++g) {
        st_bf16x4(orow + 8 * g + 4 * hi, (f32x4){o0[4 * g] * inv, o0[4 * g + 1] * inv, o0[4 * g + 2] * inv, o0[4 * g + 3] * inv});
        st_bf16x4(orow + 32 + 8 * g + 4 * hi, (f32x4){o1[4 * g] * inv, o1[4 * g + 1] * inv, o1[4 * g + 2] * inv, o1[4 * g + 3] * inv});
    }
}

constexpr int NCC = 66;
DEVI int chunk_row0(int b, int cc) { return cc < 2 ? NLAT + b * CL + cc * 128 : b * SEQ + (cc - 2) * 128; }
constexpr int SC_VEC = 0;
constexpr int SC_KT = 2048;
constexpr int SC_VF = SC_KT + 64 * 136 * 2;
constexpr int SC_VB = SC_VF + 64 * 136 * 2;
constexpr int SC_X = SC_VB + 64 * 136 * 2;
constexpr int SC_SSQ = SC_X + 2048;
constexpr int SC_END = SC_SSQ + 8192;
constexpr int TS = 136;

DEVI void scan_vectors(const P& p, int l, bool ret, int h, int row0, float* vec, int wid, int lane) {
    const float* dt = (const float*)(p.ws + WS_DT);
    if (ret) {
        if (wid == 0) { const float lf = IN(15)[l * 8 + h], lb = IN(15)[l * 8 + 4 + h];
            const float laf = -log1pf(__expf(-lf)), lab = -log1pf(__expf(-lb));
#pragma unroll
            for (int e = 0; e < 2; ++e) { const int j = lane * 2 + e; vec[j] = (float)(j + 1) * laf; vec[128 + j] = (float)(128 - j) * lab; vec[256 + j] = 1.f; vec[384 + j] = 1.f; } }
    } else if (wid < 2) {
        const int dir = wid; const size_t r = (size_t)(row0 + lane * 2);
        const float x0 = dt[r * 32 + 16 + dir * 8 + h], x1 = dt[(r + 1) * 32 + 16 + dir * 8 + h];
        vec[256 + dir * 128 + lane * 2] = dt[r * 32 + dir * 8 + h]; vec[256 + dir * 128 + lane * 2 + 1] = dt[(r + 1) * 32 + dir * 8 + h];
        float s = x0 + x1;
#pragma unroll
        for (int o = 1; o < 64; o <<= 1) { const float t = __shfl_up(s, o); if (lane >= o) s += t; }
        if (dir == 0) { vec[lane * 2] = s - x1; vec[lane * 2 + 1] = s; }
        else { const float tot = __shfl(s, 63); vec[128 + lane * 2] = tot - (s - x1) + x0; vec[128 + lane * 2 + 1] = tot - s + x1; }
    }
}
DEVI void scan_ptrs(const P& p, bool ret, int h, const bf16*& qb, const bf16*& kb, const bf16*& vb, int& ld) {
    if (ret) { const bf16* proj = (const bf16*)(p.ws + WS_PROJ); qb = proj + C_RQ + h * 64; kb = proj + C_RK + h * 64; vb = proj + C_RV + h * 64; ld = INWP; }
    else { const bf16* xbc = (const bf16*)(p.ws + WS_XBC); qb = xbc + 640 + (h >> 2) * 64; kb = xbc + 512 + (h >> 2) * 64; vb = xbc + h * 64; ld = 768; }
}
DEVI void c3_stage_rows(unsigned char* dst, int rs, const bf16* src, int ld, int tid) {
#pragma unroll
    for (int i = 0; i < 2; ++i) { const int piece = tid + NTHREADS * i, row = piece >> 3, part = piece & 7; *(u32x4*)(dst + row * rs + part * 16) = *(const u32x4*)(src + (size_t)row * ld + part * 8); }
}
struct ConvW { f32x4 w0[2], w1[2], w2[2], b[2]; };
DEVI ConvW conv_w(const float* cw, const float* cb, int c0) { ConvW w;
#pragma unroll
    for (int k = 0; k < 2; ++k) { w.w0[k] = *(const f32x4*)(cw + c0 + 4 * k); w.w1[k] = *(const f32x4*)(cw + 768 + c0 + 4 * k); w.w2[k] = *(const f32x4*)(cw + 1536 + c0 + 4 * k); w.b[k] = *(const f32x4*)(cb + c0 + 4 * k); }
    return w; }
DEVI void unpack8(const u32x4 v, f32x4 (&x)[2]) { x[0] = (f32x4){bf2f(v.x & 0xffff), bf2f(v.x >> 16), bf2f(v.y & 0xffff), bf2f(v.y >> 16)}; x[1] = (f32x4){bf2f(v.z & 0xffff), bf2f(v.z >> 16), bf2f(v.w & 0xffff), bf2f(v.w >> 16)}; }
DEVI void conv8(const bf16* proj, size_t row, bool has_prev, bool has_next, int c0, const ConvW& w, f32x4 (&y)[2]) {
    const bf16* pr = proj + row * INWP + C_XBC + c0; const u32x4 z = {0u, 0u, 0u, 0u};
    const u32x4 r0 = *(const u32x4*)pr, rm = has_prev ? *(const u32x4*)(pr - INWP) : z, rp = has_next ? *(const u32x4*)(pr + INWP) : z;
    f32x4 x0[2], xm[2], xp[2]; unpack8(r0, x0); unpack8(rm, xm); unpack8(rp, xp);
#pragma unroll
    for (int k = 0; k < 2; ++k) { y[k] = w.w0[k] * xm[k] + w.w1[k] * x0[k] + w.w2[k] * xp[k] + w.b[k];
#pragma unroll
        for (int i = 0; i < 4; ++i) y[k][i] = siluf(y[k][i]); }
}
DEVI u32x4 pack8(const f32x4 (&y)[2], float sc) { return (u32x4){pk2(y[0][0] * sc, y[0][1] * sc), pk2(y[0][2] * sc, y[0][3] * sc), pk2(y[1][0] * sc, y[1][1] * sc), pk2(y[1][2] * sc, y[1][3] * sc)}; }
constexpr int SA_RS = 192, SA_K = 8192, SA_VF = SA_K + 128 * SA_RS, SA_VB = SA_VF + 128 * SA_RS, SA_V2 = 2 * 128 * SA_RS  , SA_END = SA_VF + 2 * SA_V2;
DEVI void scanA_unit(const P& p, int l, int uidx, unsigned char* lds) {
    const int tid = otid(), wid = __builtin_amdgcn_readfirstlane(tid >> 6), lane = tid & 63, r32 = lane & 31, hi = lane >> 5;
    const int g4 = uidx % 3, bc = uidx / 3, b = bc / NCC, cc = bc % NCC, row0 = chunk_row0(b, cc);
    const bool ret = (g4 == 0);
    float* vec4 = (float*)(lds + SC_VEC);
    float* ST = (float*)(p.ws + WS_ST); float* CDp = (float*)(p.ws + WS_CD);
    const bf16* proj = (const bf16*)(p.ws + WS_PROJ); bf16* xbcw = (bf16*)(p.ws + WS_XBC); const float* cw = IN(16) + (size_t)l * 3 * 768; const float* cb = IN(17) + l * 768;
    const int troff = (4 * hi + ((lane & 15) >> 2)) * SA_RS + (16 * ((lane >> 4) & 1) + 4 * (lane & 3)) * 2;
    __syncthreads();
    { const int hq = wid >> 1, h = ret ? hq : (g4 - 1) * 4 + hq; scan_vectors(p, l, ret, h, row0, vec4 + hq * 512, wid & 1, lane); }
    __syncthreads();
    { const int hq = tid >> 7, t = tid & 127, h = ret ? hq : (g4 - 1) * 4 + hq, hh = ret ? hq : 4 + h; const size_t item = (size_t)(b * NCC + cc) * 12 + hh; const float* vv = vec4 + hq * 512;
      float* vg = (float*)(p.ws + WS_VEC) + item * 512; vg[t] = vv[t]; vg[128 + t] = vv[128 + t]; vg[256 + t] = vv[t] - __logf(vv[256 + t]); vg[384 + t] = vv[128 + t] - __logf(vv[384 + t]);
      if (t == 0) { CDp[item * 2] = __expf(vv[127]); CDp[item * 2 + 1] = __expf(vv[128]); } }
    const int dir = wid >> 2, nt = (wid >> 1) & 1, pt = wid & 1;
    if (ret) {
        for (int hq = 0; hq < 4; ++hq) {
            const int h = hq; const size_t item = (size_t)(b * NCC + cc) * 12 + h;
            const bf16 *qb, *kb, *vb; int ld; scan_ptrs(p, true, h, qb, kb, vb, ld);
            const float* vec = vec4 + hq * 512;
            if (hq > 0) __syncthreads();
            c3_stage_rows(lds + SA_K, SA_RS, kb + (size_t)row0 * ld, ld, tid);
#pragma unroll
            for (int i = 0; i < 2; ++i) { const int piece = tid + NTHREADS * i, j = piece >> 3, part = piece & 7; const u32x4 v = *(const u32x4*)(vb + (size_t)(row0 + j) * ld + part * 8);
                const float sf = __expf(vec[127] - vec[j]) * vec[256 + j], sb = __expf(vec[128] - vec[128 + j]) * vec[384 + j];
                f32x4 x[2]; unpack8(v, x);
                *(u32x4*)(lds + SA_VF + j * SA_RS + part * 16) = pack8(x, sf); *(u32x4*)(lds + SA_VB + j * SA_RS + part * 16) = pack8(x, sb); }
            __syncthreads();
            const unsigned char* ka = lds + SA_K + nt * 64 + troff; const unsigned char* va = lds + (dir ? SA_VB : SA_VF) + pt * 64 + troff;
            f32x16 acc;
#pragma unroll
            for (int r = 0; r < 16; ++r) acc[r] = 0.f;
#pragma unroll
            for (int s = 0; s < 8; ++s) { const v4i16_t al = lds_tr(ka + (16 * s) * SA_RS), ah = lds_tr(ka + (16 * s + 8) * SA_RS), bl = lds_tr(va + (16 * s) * SA_RS), bh = lds_tr(va + (16 * s + 8) * SA_RS);
                const bf16x8 af = {al[0], al[1], al[2], al[3], ah[0], ah[1], ah[2], ah[3]}, bf = {bl[0], bl[1], bl[2], bl[3], bh[0], bh[1], bh[2], bh[3]};
                acc = __builtin_amdgcn_mfma_f32_32x32x16_bf16(af, bf, acc, 0, 0, 0); }
            float* o = ST + (item * 2 + dir) * 4096 + (size_t)(pt * 32 + r32) * 64 + nt * 32 + 4 * hi;
#pragma unroll
            for (int g = 0; g < 4; ++g) *(f32x4*)(o + 8 * g) = (f32x4){acc[4 * g], acc[4 * g + 1], acc[4 * g + 2], acc[4 * g + 3]};
        }
    } else {
        const int g = g4 - 1, part = tid & 7; const int pos0 = (cc < 2) ? cc * 128 : (cc - 2) * 128, Ls = (cc < 2) ? CL : SEQ;
        for (int hp = 0; hp < 2; ++hp) {
            if (hp > 0) __syncthreads();
            if (hp == 0) {
#pragma unroll 1
                for (int which = 0; which < 2; ++which) { const int c0 = (which == 0 ? 512 : 640) + g * 64 + part * 8; const ConvW w = conv_w(cw, cb, c0);
#pragma unroll
                    for (int i = 0; i < 2; ++i) { const int j = (tid + NTHREADS * i) >> 3; f32x4 y[2]; conv8(proj, (size_t)(row0 + j), pos0 + j > 0, pos0 + j < Ls - 1, c0, w, y);
                        const u32x4 o = pack8(y, 1.f); *(u32x4*)(xbcw + (size_t)(row0 + j) * 768 + c0) = o; if (which == 0) *(u32x4*)(lds + SA_K + j * SA_RS + part * 16) = o; } } }
#pragma unroll
            for (int e = 0; e < 2; ++e) { const int hq = hp * 2 + e, h = g * 4 + hq; const float* vec = vec4 + hq * 512; const int c0 = h * 64 + part * 8; const ConvW w = conv_w(cw, cb, c0);
#pragma unroll
                for (int i = 0; i < 2; ++i) { const int j = (tid + NTHREADS * i) >> 3; f32x4 y[2]; conv8(proj, (size_t)(row0 + j), pos0 + j > 0, pos0 + j < Ls - 1, c0, w, y);
                    const float sf = __expf(vec[127] - vec[j]) * vec[256 + j], sb = __expf(vec[128] - vec[128 + j]) * vec[384 + j];
                    *(u32x4*)(xbcw + (size_t)(row0 + j) * 768 + c0) = pack8(y, 1.f);
                    *(u32x4*)(lds + SA_VF + e * SA_V2 + j * SA_RS + part * 16) = pack8(y, sf); *(u32x4*)(lds + SA_VB + e * SA_V2 + j * SA_RS + part * 16) = pack8(y, sb); } }
            __syncthreads();
            const unsigned char* ka = lds + SA_K + nt * 64 + troff;
            f32x16 acc0, acc1;
#pragma unroll
            for (int r = 0; r < 16; ++r) { acc0[r] = 0.f; acc1[r] = 0.f; }
            const unsigned char* va = lds + (dir ? SA_VB : SA_VF) + pt * 64 + troff;
#pragma unroll
            for (int s = 0; s < 8; ++s) { const v4i16_t al = lds_tr(ka + (16 * s) * SA_RS), ah = lds_tr(ka + (16 * s + 8) * SA_RS);
                const bf16x8 af = {al[0], al[1], al[2], al[3], ah[0], ah[1], ah[2], ah[3]};
                { const v4i16_t bl = lds_tr(va + (16 * s) * SA_RS), bh = lds_tr(va + (16 * s + 8) * SA_RS); const bf16x8 bf = {bl[0], bl[1], bl[2], bl[3], bh[0], bh[1], bh[2], bh[3]}; acc0 = __builtin_amdgcn_mfma_f32_32x32x16_bf16(af, bf, acc0, 0, 0, 0); }
                { const v4i16_t bl = lds_tr(va + SA_V2 + (16 * s) * SA_RS), bh = lds_tr(va + SA_V2 + (16 * s + 8) * SA_RS); const bf16x8 bf = {bl[0], bl[1], bl[2], bl[3], bh[0], bh[1], bh[2], bh[3]}; acc1 = __builtin_amdgcn_mfma_f32_32x32x16_bf16(af, bf, acc1, 0, 0, 0); } }
#pragma unroll
            for (int e = 0; e < 2; ++e) { const int hq = hp * 2 + e, hh = 4 + g * 4 + hq; const size_t item = (size_t)(b * NCC + cc) * 12 + hh;
                float* o = ST + (item * 2 + dir) * 4096 + (size_t)(pt * 32 + r32) * 64 + nt * 32 + 4 * hi;
#pragma unroll
                for (int gq = 0; gq < 4; ++gq) *(f32x4*)(o + 8 * gq) = e ? (f32x4){acc1[4 * gq], acc1[4 * gq + 1], acc1[4 * gq + 2], acc1[4 * gq + 3]} : (f32x4){acc0[4 * gq], acc0[4 * gq + 1], acc0[4 * gq + 2], acc0[4 * gq + 3]}; }
        }
    }
    __syncthreads();
}
DEVI void scanB_slab(const P& p, int slab, int nthr, int epb) {
    const int tid = otid(); if (tid >= nthr) return;
    const int f = slab * epb + tid * 2; const int bhd = f >> 12, e = f & 4095, dir = bhd & 1, bh = bhd >> 1, b = bh / 12, hh = bh % 12;
    const float* ST = (const float*)(p.ws + WS_ST); const float* CDp = (const float*)(p.ws + WS_CD); bf16* HT = (bf16*)(p.ws + WS_HT);
    f32x2 H = {0.f, 0.f};
    for (int base = 0; base < NCC; base += 6) {
        f32x2 s[6]; float d[6]; size_t off[6];
#pragma unroll
        for (int i = 0; i < 6; ++i) { const int step = base + i; const int cc = dir == 0 ? step : (step < 2 ? 1 - step : 67 - step);
            const size_t item = (size_t)(b * NCC + cc) * 12 + hh; off[i] = (item * 2 + dir) * 4096 + e; s[i] = *(const f32x2*)(ST + off[i]); d[i] = CDp[item * 2 + dir]; }
#pragma unroll
        for (int i = 0; i < 6; ++i) { *(unsigned*)(HT + off[i]) = pk2(H[0], H[1]); H = H * d[i] + s[i]; }
    }
}
constexpr int C3_RSV = 192, C3_RSK = 144;
constexpr int C3_V = 0, C3_K = 2 * 128 * C3_RSV, C3_H = C3_K + 2 * 128 * C3_RSK, C3_VEC = C3_H + 2 * 128 * C3_RSK, C3_X = C3_VEC + 2 * 2048, C3_END = C3_X + 1024;
template <bool RET>
DEVI void scanC_unit(const P& p, int l, int bc, unsigned char* lds, int tid, int wid, int lane) {
    const int r32 = lane & 31, hi = lane >> 5;
    const int it_ = wid & 3, hsub = wid >> 2, b = bc / NCC, cc = bc % NCC, row0 = chunk_row0(b, cc);
    const bf16* HT = (const bf16*)(p.ws + WS_HT); const bf16* proj = (const bf16*)(p.ws + WS_PROJ); const bf16* xbc = (const bf16*)(p.ws + WS_XBC); bf16* MIX = (bf16*)(p.ws + WS_HM); const float* VECG = (const float*)(p.ws + WS_VEC);
    const int i = it_ * 32 + r32; const size_t rowi = (size_t)(row0 + i);
    constexpr int ld = RET ? INWP : 768;
    const unsigned char* Vl = lds + C3_V + hsub * 128 * C3_RSV; const unsigned char* Kl = lds + C3_K + hsub * 128 * C3_RSK; const unsigned char* Hl = lds + C3_H + hsub * 128 * C3_RSK; const float* vec = (const float*)(lds + C3_VEC + hsub * 2048);
    const int trq = (lane & 15) >> 2, trp = lane & 3, trg = (lane >> 4) & 1;
    const int troff = (4 * hi + trq) * C3_RSV + (16 * trg + 4 * trp) * 2;
    float ssqk[4] = {0.f, 0.f, 0.f, 0.f};
#pragma unroll 1
    for (int step = 0; step < (RET ? 2 : 4); ++step) {
        __syncthreads();
#pragma unroll
        for (int hs = 0; hs < 2; ++hs) { const int h = RET ? hs * 2 + step : hs * 4 + step, hh = RET ? h : 4 + h; const size_t item = (size_t)(b * NCC + cc) * 12 + hh;
            const bf16* vb = RET ? proj + C_RV + h * 64 : xbc + h * 64; const bf16* kb = RET ? proj + C_RK + h * 64 : xbc + 512 + hs * 64;
            c3_stage_rows(lds + C3_V + hs * 128 * C3_RSV, C3_RSV, vb + (size_t)row0 * ld, ld, tid);
            if (RET || step == 0) c3_stage_rows(lds + C3_K + hs * 128 * C3_RSK, C3_RSK, kb + (size_t)row0 * ld, ld, tid);
            c3_stage_rows(lds + C3_H + hs * 128 * C3_RSK, C3_RSK, HT + item * 2 * 4096, 64, tid);
            if ((tid >> 7) == hs) *(u32x4*)(lds + C3_VEC + hs * 2048 + (tid & 127) * 16) = *(const u32x4*)(VECG + item * 512 + (tid & 127) * 4); }
        __syncthreads();
        const int h = RET ? hsub * 2 + step : hsub * 4 + step;
        const bf16* qb = RET ? proj + C_RQ + h * 64 : xbc + 640 + hsub * 64;
        bf16x8 qf[4];
#pragma unroll
        for (int s = 0; s < 4; ++s) qf[s] = *(const bf16x8*)(qb + rowi * ld + s * 16 + hi * 8);
        const float Afi = vec[i], Bbi = vec[128 + i];
        f32x16 y0, y1;
#pragma unroll
        for (int r = 0; r < 16; ++r) { y0[r] = 0.f; y1[r] = 0.f; }
#pragma unroll 2
        for (int jt = 0; jt < 4; ++jt) {
            f32x16 st;
#pragma unroll
            for (int r = 0; r < 16; ++r) st[r] = 0.f;
#pragma unroll
            for (int s = 0; s < 4; ++s) { const bf16x8 kf = *(const bf16x8*)(Kl + (jt * 32 + r32) * C3_RSK + (s * 16 + hi * 8) * 2); st = __builtin_amdgcn_mfma_f32_32x32x16_bf16(kf, qf[s], st, 0, 0, 0); }
#pragma unroll
            for (int g = 0; g < 4; ++g) { const int j0 = jt * 32 + 8 * g + 4 * hi;
                const f32x4 afp = *(const f32x4*)(vec + 256 + j0), bbp = *(const f32x4*)(vec + 384 + j0);
#pragma unroll
                for (int e = 0; e < 4; ++e) { const int j = j0 + e; float f;
                    if (jt < it_) f = __expf(Afi - afp[e]);
                    else if (jt > it_) f = __expf(Bbi - bbp[e]);
                    else { const float ff = (j <= i) ? __expf(Afi - afp[e]) : 0.f; const bool bm = RET ? (j > i) : (j >= i); const float fb = bm ? __expf(Bbi - bbp[e]) : 0.f; f = ff + fb; }
                    st[4 * g + e] *= f; } }
#pragma unroll
            for (int s2 = 0; s2 < 2; ++s2) {
                u32x4 pw; pw.x = pk2(st[8 * s2 + 0], st[8 * s2 + 1]); pw.y = pk2(st[8 * s2 + 2], st[8 * s2 + 3]); pw.z = pk2(st[8 * s2 + 4], st[8 * s2 + 5]); pw.w = pk2(st[8 * s2 + 6], st[8 * s2 + 7]);
                const bf16x8 pb = __builtin_bit_cast(bf16x8, pw);
#pragma unroll
                for (int pt = 0; pt < 2; ++pt) { const unsigned char* vp = Vl + (jt * 32 + 16 * s2) * C3_RSV + pt * 64 + troff;
                    const v4i16_t lo = lds_tr(vp), hi2 = lds_tr(vp + 8 * C3_RSV);
                    const bf16x8 va = {lo[0], lo[1], lo[2], lo[3], hi2[0], hi2[1], hi2[2], hi2[3]};
                    if (pt == 0) y0 = __builtin_amdgcn_mfma_f32_32x32x16_bf16(va, pb, y0, 0, 0, 0); else y1 = __builtin_amdgcn_mfma_f32_32x32x16_bf16(va, pb, y1, 0, 0, 0); }
            }
        }
        { const float ef = __expf(Afi), eb = __expf(Bbi);
#pragma unroll
          for (int pt = 0; pt < 2; ++pt) { f32x16 tf, tb;
#pragma unroll
              for (int r = 0; r < 16; ++r) { tf[r] = 0.f; tb[r] = 0.f; }
              const unsigned char* hf = Hl + (pt * 32 + r32) * C3_RSK + hi * 16;
#pragma unroll
              for (int s = 0; s < 4; ++s) { tf = __builtin_amdgcn_mfma_f32_32x32x16_bf16(*(const bf16x8*)(hf + s * 32), qf[s], tf, 0, 0, 0); tb = __builtin_amdgcn_mfma_f32_32x32x16_bf16(*(const bf16x8*)(hf + 64 * C3_RSK + s * 32), qf[s], tb, 0, 0, 0); }
#pragma unroll
              for (int r = 0; r < 16; ++r) { if (pt == 0) y0[r] += ef * tf[r] + eb * tb[r]; else y1[r] += ef * tf[r] + eb * tb[r]; } } }
        float* Tw = (float*)(lds + (wid < 5 ? C3_V + wid * 8704 : C3_H + (wid - 5) * 8704));
        __syncthreads();
        if (RET) {
            float s1 = 0.f, s2 = 0.f;
#pragma unroll
            for (int r = 0; r < 16; ++r) { y0[r] *= 0.125f; y1[r] *= 0.125f; s1 += y0[r] + y1[r]; s2 += y0[r] * y0[r] + y1[r] * y1[r]; }
            s1 += __shfl_xor(s1, 32); s2 += __shfl_xor(s2, 32);
            const float mu = s1 * (1.f / 64.f), var = fmaxf(s2 * (1.f / 64.f) - mu * mu, 0.f), rs = __builtin_amdgcn_rsqf(var + EPS);
#pragma unroll
            for (int r = 0; r < 16; ++r) { y0[r] = (y0[r] - mu) * rs; y1[r] = (y1[r] - mu) * rs; }
        }
#pragma unroll
        for (int g = 0; g < 4; ++g) { *(f32x4*)(Tw + r32 * 68 + 8 * g + 4 * hi) = (f32x4){y0[4 * g], y0[4 * g + 1], y0[4 * g + 2], y0[4 * g + 3]}; *(f32x4*)(Tw + r32 * 68 + 32 + 8 * g + 4 * hi) = (f32x4){y1[4 * g], y1[4 * g + 1], y1[4 * g + 2], y1[4 * g + 3]}; }
        asm volatile("s_waitcnt lgkmcnt(0)" ::: "memory");
        { const int ch = lane & 7; const float dsk = RET ? 0.f : IN(20)[l * 8 + h];
#pragma unroll
          for (int k = 0; k < 4; ++k) { const int tr = (lane >> 3) + 8 * k; const size_t rowt = (size_t)(row0 + it_ * 32 + tr);
              f32x4 ya[2] = {*(const f32x4*)(Tw + tr * 68 + ch * 8), *(const f32x4*)(Tw + tr * 68 + ch * 8 + 4)};
              if (RET) { f32x4 gv[2]; unpack8(*(const u32x4*)(proj + rowt * INWP + C_RG + h * 64 + ch * 8), gv);
#pragma unroll
                  for (int q = 0; q < 2; ++q)
#pragma unroll
                      for (int e = 0; e < 4; ++e) ya[q][e] *= siluf(gv[q][e]);
                  *(u32x4*)(MIX + rowt * D + 256 + h * 64 + ch * 8) = pack8(ya, 1.f);
              } else { f32x4 xv[2], zv[2]; unpack8(*(const u32x4*)(xbc + rowt * 768 + h * 64 + ch * 8), xv); unpack8(*(const u32x4*)(proj + rowt * INWP + C_Z + h * 64 + ch * 8), zv); float sq = 0.f;
#pragma unroll
                  for (int q = 0; q < 2; ++q)
#pragma unroll
                      for (int e = 0; e < 4; ++e) { ya[q][e] = (ya[q][e] + xv[q][e] * dsk) * siluf(zv[q][e]); sq += ya[q][e] * ya[q][e]; }
                  *(u32x4*)(MIX + rowt * D + 512 + h * 64 + ch * 8) = pack8(ya, 1.f);
                  sq += __shfl_xor(sq, 1); sq += __shfl_xor(sq, 2); sq += __shfl_xor(sq, 4); ssqk[k] += sq; } } }
    }
    if (!RET) {
        float* X = (float*)(lds + C3_X);
#pragma unroll
        for (int k = 0; k < 4; ++k) if ((lane & 7) == 0) X[hsub * 128 + it_ * 32 + (lane >> 3) + 8 * k] = ssqk[k];
        asm volatile("s_waitcnt vmcnt(0)" ::: "memory");
        __syncthreads();
        const float* nw = IN(21) + l * 512; const int ch = lane & 7;
#pragma unroll 1
        for (int h = hsub * 4; h < hsub * 4 + 4; ++h) { f32x4 wv[2] = {*(const f32x4*)(nw + h * 64 + ch * 8), *(const f32x4*)(nw + h * 64 + ch * 8 + 4)};
#pragma unroll
            for (int k = 0; k < 4; ++k) { const int tr = it_ * 32 + (lane >> 3) + 8 * k; const float rstd = __builtin_amdgcn_rsqf((X[tr] + X[128 + tr]) * (1.f / 512.f) + EPS);
                bf16* mp = MIX + (size_t)(row0 + tr) * D + 512 + h * 64 + ch * 8; f32x4 v[2]; unpack8(*(const u32x4*)mp, v);
                v[0] = v[0] * wv[0] * rstd; v[1] = v[1] * wv[1] * rstd; *(u32x4*)mp = pack8(v, 1.f); } }
    }
    __syncthreads();
}
DEVI void ph_scanC(const P& p, int l, unsigned char* lds) {
    const int tid = otid(), wid = __builtin_amdgcn_readfirstlane(tid >> 6), lane = tid & 63;
    const int NU = 2 * NCC;
    if (gridDim.x == 256) {
        const int c = blockIdx.x;
        if (c < NU) scanC_unit<false>(p, l, c, lds, tid, wid, lane);
        else { const int r = c - NU; scanC_unit<true>(p, l, r, lds, tid, wid, lane); if (r + 124 < NU) scanC_unit<true>(p, l, r + 124, lds, tid, wid, lane); }
    } else {
        for (int u = blockIdx.x; u < 2 * NU; u += gridDim.x) { if (u < NU) scanC_unit<false>(p, l, u, lds, tid, wid, lane); else scanC_unit<true>(p, l, u - NU, lds, tid, wid, lane); }
    }
}
DEVI void ph_scanA(const P& p, int l, unsigned char* lds) { for (int u = gridDim.x - 1 - blockIdx.x; u < 2 * NCC * 3; u += gridDim.x) scanA_unit(p, l, u, lds); }
DEVI void ph_mixer(const P& p, int l, unsigned char* lds) {
    for (int u = blockIdx.x; u < 256; u += gridDim.x) scanB_slab(p, u, 384, 768);
    for (int a = blockIdx.x; a < 256; a += gridDim.x) attn_unit<0>(p, (a & 7) * 32 + (a >> 3), lds, (bf16*)(p.ws + WS_HM));
#if ATTN_PROBE
    if (l == 0) { __syncthreads(); for (int a = blockIdx.x; a < 256; a += gridDim.x) attn_unit<ATTN_PROBE>(p, (a & 7) * 32 + (a >> 3), lds, (bf16*)p.out); }
#endif
    if (l == 0) for (int a = blockIdx.x; a < 8; a += gridDim.x) attn_unit<0>(p, 256 + a, lds, (bf16*)(p.ws + WS_HM));
}

DEVI void ph_sort(const P& p, unsigned char* lds) {
    const int tid = otid(), wid = tid >> 6, lane = tid & 63;
    const int* rt_e = (const int*)(p.ws + WS_RT); int* rt_pos = (int*)(p.ws + WS_RT + 256 * 1024); int* tab = (int*)(p.ws + WS_RT + 384 * 1024); int* rt_tok = (int*)(p.ws + WS_RT + 640 * 1024);
    int* sh = (int*)lds;
    const int G = gridDim.x, R = (NLAT + G - 1) / G;
    for (int blk = blockIdx.x; blk * R < NLAT; blk += G) {
        const int r0 = blk * R, r1 = (r0 + R < NLAT) ? r0 + R : NLAT;
        int ct[8], cb[8];
#pragma unroll
        for (int e = 0; e < 8; ++e) { ct[e] = 0; cb[e] = 0; }
        for (int i = tid; i < NLAT * 2; i += NTHREADS) { const int e = rt_e[i]; const bool bef = (i >> 1) < r0;
#pragma unroll
            for (int x = 0; x < 8; ++x) { const int hit = (e == x) ? 1 : 0; ct[x] += hit; cb[x] += bef ? hit : 0; } }
#pragma unroll
        for (int e = 0; e < 8; ++e) {
#pragma unroll
            for (int o = 1; o < 64; o <<= 1) { ct[e] += __shfl_xor(ct[e], o); cb[e] += __shfl_xor(cb[e], o); }
        }
        __syncthreads();
        if (lane == 0) {
#pragma unroll
            for (int e = 0; e < 8; ++e) { sh[wid * 8 + e] = ct[e]; sh[64 + wid * 8 + e] = cb[e]; } }
        __syncthreads();
        if (tid == 0) { int start = 0, nt = 0;
            for (int e = 0; e < 8; ++e) { int tot = 0, bef = 0; for (int w = 0; w < 8; ++w) { tot += sh[w * 8 + e]; bef += sh[64 + w * 8 + e]; }
                sh[128 + e] = start; sh[136 + e] = start + bef; sh[144 + e] = tot; const int ntile = (tot + 255) >> 8;
                if (blk == 0) { for (int t = 0; t < ntile; ++t) tab[1 + nt + t] = e; }
                nt += ntile; start += ntile * 256; }
            if (blk == 0) tab[0] = nt; }
        __syncthreads();
        { const int n_ent = (r1 - r0) * 2; const bool valid = tid < n_ent; const int e = valid ? rt_e[r0 * 2 + tid] : -1; int rank = 0;
#pragma unroll
          for (int x = 0; x < 8; ++x) { const unsigned long long m = __ballot(e == x); if (e == x) rank = __popcll(m & ((1ull << lane) - 1ull)); if (lane == 0) sh[160 + wid * 8 + x] = __popcll(m); }
          __syncthreads();
          if (valid) { int pos = sh[136 + e] + rank; for (int w = 0; w < wid; ++w) pos += sh[160 + w * 8 + e]; sh[256 + tid] = pos; rt_pos[r0 * 2 + tid] = pos; } }
        __syncthreads();
        { const int n_ent = (r1 - r0) * 2; if (tid < n_ent) rt_tok[sh[256 + tid]] = r0 + (tid >> 1); }
        if (blk == 0) { for (int e = 0; e < 8; ++e) { const int tot = sh[144 + e], beg = sh[128 + e] + tot, end = sh[128 + e] + ((tot + 255) & ~255); for (int i = beg + tid; i < end; i += NTHREADS) rt_tok[i] = 0; } }
        __syncthreads();
    }
}
DEVI void ph_final(const P& p) {
    const int tid = otid(), wid = tid >> 6, lane = tid & 63;
    const float* rt_g = (const float*)(p.ws + WS_RT + 128 * 1024); const int* rt_pos = (const int*)(p.ws + WS_RT + 256 * 1024);
    const bf16* YS = (const bf16*)(p.ws + WS_HS); const float* modv = (const float*)(p.ws + WS_MODV) + (size_t)1 * 3 * 6144; const float* fw = IN(29);
    const int nw = gridDim.x * NWAVES, rpw = (NLAT + nw - 1) / nw, gw = blockIdx.x * NWAVES + wid;
    const int row0 = gw * rpw, row1 = (row0 + rpw < NLAT) ? row0 + rpw : NLAT;
    f32x4 fwv[4], gv[4]; int rc = -1;
#pragma unroll
    for (int j = 0; j < 4; ++j) fwv[j] = *(const f32x4*)(fw + (j * 64 + lane) * 4);
    for (int row = row0; row < row1; ++row) {
        const int b = row >> 13; float* x = p.out + (size_t)row * D;
        if (b != rc) { rc = b;
#pragma unroll
            for (int j = 0; j < 4; ++j) gv[j] = *(const f32x4*)(modv + b * 6144 + 5 * 1024 + (j * 64 + lane) * 4); }
        const float g0 = rt_g[row * 2], g1 = rt_g[row * 2 + 1]; const bf16* y0 = YS + (size_t)rt_pos[row * 2] * D; const bf16* y1 = YS + (size_t)rt_pos[row * 2 + 1] * D;
        f32x4 v[4]; float ss = 0.f;
#pragma unroll
        for (int j = 0; j < 4; ++j) { const int c0 = (j * 64 + lane) * 4; const f32x4 xv = *(const f32x4*)(x + c0); const u32x2 a = *(const u32x2*)(y0 + c0), c = *(const u32x2*)(y1 + c0);
            const f32x4 ya = {bf2f(a.x & 0xffff), bf2f(a.x >> 16), bf2f(a.y & 0xffff), bf2f(a.y >> 16)}, yb = {bf2f(c.x & 0xffff), bf2f(c.x >> 16), bf2f(c.y & 0xffff), bf2f(c.y >> 16)};
            v[j] = xv + gv[j] * (ya * g0 + yb * g1); ss += v[j][0] * v[j][0] + v[j][1] * v[j][1] + v[j][2] * v[j][2] + v[j][3] * v[j][3]; }
        ss = wave_sum(ss); const float rstd = __builtin_amdgcn_rsqf(ss * (1.f / D) + EPS);
#pragma unroll
        for (int j = 0; j < 4; ++j) { const int c0 = (j * 64 + lane) * 4; *(f32x4*)(x + c0) = v[j] * rstd * fwv[j]; }
    }
}

#define XB_TMO      128
#define XB_XCNT(j)  (256  + 64 * (j))
#define XB_XSUB(j)  (1280 + 64 * (j))
#define XB_XGEN(j)  (2304 + 64 * (j))
#define XB_TOP      3328
#define XB_TOPGEN   3392
#define XCD_BAR_WORDS 3456
#define XB_SPIN_CAP (1u << 22)
DEVI unsigned xb_ld(unsigned* p)              { return __hip_atomic_load(p, __ATOMIC_RELAXED, __HIP_MEMORY_SCOPE_AGENT); }
DEVI unsigned xb_add(unsigned* p, unsigned v) { return __hip_atomic_fetch_add(p, v, __ATOMIC_RELAXED, __HIP_MEMORY_SCOPE_AGENT); }
DEVI unsigned xb_xcc_id() { return (unsigned)__builtin_amdgcn_s_getreg((3 << 11) | 20) & 0xFu; }
#define XB_SPIN(cond, bar) do { unsigned _sp = 0; while (cond) { __builtin_amdgcn_s_sleep(1); \
    if ((++_sp & 255u) == 0u) { if (xb_ld(&(bar)[XB_TMO])) break; if (_sp > XB_SPIN_CAP) { atomicAdd(&(bar)[XB_TMO], 1u); break; } } } } while (0)
struct XcdBarrier { unsigned* bar; unsigned x; volatile LAS unsigned* st; };
DEVI XcdBarrier xcd_barrier_post(unsigned* bar, volatile LAS unsigned* st) {
    XcdBarrier b; b.bar = bar; b.x = xb_xcc_id(); b.st = st;
    if (threadIdx.x == 0) (void)xb_add(&bar[XB_XCNT(b.x)], 1u);
    return b;
}
DEVI void xcd_barrier_complete(unsigned* bar, unsigned x, unsigned& nloc, unsigned& nx) {
    const unsigned G = gridDim.x * gridDim.y * gridDim.z;
    unsigned sum, cnt, mine, sp = 0u;
    for (;;) {
        sum = 0u; cnt = 0u; mine = 0u;
#pragma unroll
        for (unsigned j = 0; j < 16; ++j) { const unsigned c = xb_ld(&bar[XB_XCNT(j)]); sum += c; cnt += (c > 0u) ? 1u : 0u; mine = (j == x) ? c : mine; }
        if (sum == G) break;
        __builtin_amdgcn_s_sleep(1);
        if ((++sp & 255u) == 0u) { if (xb_ld(&bar[XB_TMO])) break; if (sp > XB_SPIN_CAP) { atomicAdd(&bar[XB_TMO], 1u); break; } }
    }
    nloc = mine > 0u ? mine : 1u; nx = cnt > 0u ? cnt : 1u;
}
DEVI void xcd_barrier(const XcdBarrier& b) {
    asm volatile("s_waitcnt vmcnt(0)" ::: "memory");
    __syncthreads();
    if (threadIdx.x == 0) {
        unsigned* bar = b.bar;
        __builtin_amdgcn_s_waitcnt(0);
        unsigned nloc = b.st[0], nx = b.st[1];
        if (nloc == 0u) { xcd_barrier_complete(bar, b.x, nloc, nx); b.st[0] = nloc; b.st[1] = nx; }
        const unsigned old = xb_add(&bar[XB_XSUB(b.x)], 1u);
        const unsigned gen = old / nloc;
        if (old + 1u == (gen + 1u) * nloc) {
            __builtin_amdgcn_fence(__ATOMIC_RELEASE, "agent");
            asm volatile("s_waitcnt vmcnt(0)" ::: "memory");
            const unsigned og = xb_add(&bar[XB_TOP], 1u);
            const unsigned tg = og / nx;
            if (og + 1u == (tg + 1u) * nx) xb_add(&bar[XB_TOPGEN], 1u);
            else XB_SPIN(xb_ld(&bar[XB_TOPGEN]) == tg, bar);
            __builtin_amdgcn_fence(__ATOMIC_ACQUIRE, "agent");
            xb_add(&bar[XB_XGEN(b.x)], 1u);
            asm volatile("s_waitcnt vmcnt(0)" ::: "memory");
        } else {
            XB_SPIN(xb_ld(&bar[XB_XGEN(b.x)]) == gen, bar);
            __builtin_amdgcn_fence(__ATOMIC_ACQUIRE, "agent");
            asm volatile("s_waitcnt vmcnt(0)" ::: "memory");
        }
    }
    __syncthreads();
}

constexpr int NPHASES = 21;
#ifndef XSYNC
#define XSYNC 0
#endif
#ifndef REP_MASK
#define REP_MASK 0u
#endif
#ifndef PH_MASK
#define PH_MASK 0xffffu
#endif
__global__ void __launch_bounds__(NTHREADS, 2) mk_fwd(P p) {
    extern __shared__ __attribute__((aligned(16))) unsigned char lds[];
    cg::grid_group grid = cg::this_grid();
    const int G = gridDim.x, c = blockIdx.x;
    if (threadIdx.x < 30) ((lds_u64*)(uintptr_t)LDS_PTRS)[threadIdx.x] = (unsigned long long)p.in[threadIdx.x];
    if (threadIdx.x < 2) ((volatile LAS unsigned*)(uintptr_t)LDS_MISC)[threadIdx.x] = 0u;
    __syncthreads();
    XcdBarrier xbar = xcd_barrier_post((unsigned*)(p.ws + WS_CTL) + 1024, (volatile LAS unsigned*)(uintptr_t)LDS_MISC);
    int nsync = 0;
#define GRID_BAR() do { if (nsync == 0) grid.sync(); else xcd_barrier(xbar); ++nsync; } while (0)
    int ph = 0;
#define RUN(kid, ...) do { if (((PH_MASK >> (kid)) & 1u) && ph >= p.ph_lo && ph < p.ph_hi) { __VA_ARGS__; if ((REP_MASK >> (kid)) & 1u) { __VA_ARGS__; } if (ph + 1 < p.ph_hi) { GRID_BAR(); for (int xs_ = 0; xs_ < XSYNC; ++xs_) GRID_BAR(); } } ++ph; } while (0)
    RUN(0, ph_pro(p, lds));
#define LAYER(l) \
        RUN(1, ph_norm<false>(p, l, 0, T, lds, l == 1 ? 11 : 0, 5)); \
        RUN(2, { Gemm g{(const bf16*)(p.ws + WS_HM), (const bf16*)(p.ws + WS_WIN) + (size_t)l * INWP * 1024, 0, nullptr}; DenseSched S{T / 256, INWP / 256, G, c}; \
            EpiInProj E{(bf16*)(p.ws + WS_PROJ), (float*)(p.ws + WS_DT), IN(18) + l * 16, IN(19) + l * 16, (float*)(p.ws + WS_RQP), (float*)(p.ws + WS_RKVP)}; gemm_phase<D, 1024, 1024>(lds, g, S, E); }); \
        RUN(4, { Gemm g{(const bf16*)(p.ws + WS_PROJ), (const bf16*)(p.ws + WS_WQKV) + (size_t)l * 1024 * 384, 0, nullptr}; DenseSched S{T / 256, 4, G, c}; \
            EpiMla E{(bf16*)(p.ws + WS_Q), (bf16*)(p.ws + WS_K), (bf16*)(p.ws + WS_V), (const float*)(p.ws + WS_RQP), (const float*)(p.ws + WS_RKVP), (const float*)(p.ws + WS_ROPE), (const bf16*)(p.ws + WS_PROJ)}; gemm_phase<INWP, 384, 384>(lds, g, S, E); ph_scanA(p, l, lds); }); \
        RUN(5, ph_mixer(p, l, lds)); \
        RUN(6, ph_scanC(p, l, lds)); \
        RUN(8, { Gemm g{(const bf16*)(p.ws + WS_HM), (const bf16*)(p.ws + WS_WOUT) + (size_t)l * 1024 * 1024, 0, nullptr}; DenseSched S{NLAT / 256, 4, G, c}; \
            EpiResid E{l == 0 ? IN(0) : p.out, (const float*)(p.ws + WS_XC), p.out, (float*)(p.ws + WS_XC), (const float*)(p.ws + WS_MODV) + (size_t)l * 3 * 6144, 2}; gemm_phase<D, 1024, 1024>(lds, g, S, E); \
            if (l == 0) { CtxSplitSched S2{4, 256 * 2, G, c}; EpiPart E2{(float*)(p.ws + WS_XBC)}; gemm_phase<D, 1024, 256>(lds, g, S2, E2); } }); \
        RUN(9, ph_norm<l == 1>(p, l, 1, l == 0 ? T : NLAT, lds, l == 0 ? 4 : 0, 2)); \
        if (l == 0) { \
            RUN(10, { Gemm g{(const bf16*)(p.ws + WS_HM), (const bf16*)(p.ws + WS_WGU), 0, nullptr}; DenseSched S{T / 256, 2 * DFF / 256, G, c}; \
                EpiSwiglu E{(bf16*)(p.ws + WS_PROJ), DFF}; gemm_phase<D, 1024, 1024>(lds, g, S, E); }); \
            RUN(11, { Gemm g{(const bf16*)(p.ws + WS_PROJ), (const bf16*)(p.ws + WS_WD), 0, nullptr}; DenseSched S{NLAT / 256, 4, G, c}; \
                EpiResid E{p.out, (const float*)(p.ws + WS_XC), p.out, (float*)(p.ws + WS_XC), (const float*)(p.ws + WS_MODV), 5}; gemm_phase<DFF, DFF, DFF>(lds, g, S, E); \
                CtxSplitSched S2{11, 256 * 2, G, c}; EpiPart E2{(float*)(p.ws + WS_XBC)}; gemm_phase<DFF, DFF, 256>(lds, g, S2, E2); }); \
        } else { \
            RUN(12, { ph_sort(p, lds); __syncthreads(); ph_moew(p, lds); }); \
            RUN(13, { Gemm g{(const bf16*)(p.ws + WS_HM), (const bf16*)(p.ws + WS_WGUE), (size_t)2 * DFE * 1024, (const int*)(p.ws + WS_RT + 640 * 1024)}; MoeSched S{(const int*)(p.ws + WS_RT + 384 * 1024), 2 * DFE / 256, G, c}; \
                EpiSwiglu E{(bf16*)(p.ws + WS_ACTS), DFE}; gemm_phase<D, 1024, 1024, EpiSwiglu, MoeSched, true>(lds, g, S, E); }); \
            RUN(14, { Gemm g{(const bf16*)(p.ws + WS_ACTS), (const bf16*)(p.ws + WS_WDE), (size_t)1024 * DFE, nullptr}; MoeSched S{(const int*)(p.ws + WS_RT + 384 * 1024), 4, G, c}; \
                EpiStore E{(bf16*)(p.ws + WS_HS), D}; gemm_phase<DFE, DFE, DFE>(lds, g, S, E); }); \
            RUN(15, ph_final(p)); \
        }
    LAYER(0)
    LAYER(1)
#undef LAYER
#undef RUN
}

#ifndef MK_ONE_LAUNCH
#define MK_ONE_LAUNCH 1
#endif
extern "C" void kernel_launch(void* const* d_in, const int* in_sizes, int n_in, void* d_out, int out_size, void* d_ws, size_t ws_size, hipStream_t stream) {
    static int grid = 0;
    if (grid == 0) {
        if (n_in != 30 || out_size != NLAT * D || ws_size < WS_END) { fprintf(stderr, "kernel_launch: unexpected problem (n_in %d out %d ws %zu, need %zu)\n", n_in, out_size, ws_size, (size_t)WS_END); grid = -1; return; }
        int dev = 0, cus = 0, per_cu = 0;
        hipGetDevice(&dev); hipDeviceGetAttribute(&cus, hipDeviceAttributeMultiprocessorCount, dev);
        if (hipFuncSetAttribute((const void*)mk_fwd, hipFuncAttributeMaxDynamicSharedMemorySize, LDS_BYTES) != hipSuccess) { fprintf(stderr, "kernel_launch: hipFuncSetAttribute failed\n"); grid = -1; return; }
        if (hipOccupancyMaxActiveBlocksPerMultiprocessor(&per_cu, (const void*)mk_fwd, NTHREADS, LDS_BYTES) != hipSuccess || per_cu < 1) { fprintf(stderr, "kernel_launch: occupancy query failed (%d)\n", per_cu); grid = -1; return; }
        grid = cus;
        fprintf(stderr, "kernel_launch: grid %d (cus %d, per_cu %d)\n", grid, cus, per_cu);
    }
    if (grid < 0) return;
    if (hipMemsetAsync((char*)d_ws + WS_CTL, 0, 65536, stream) != hipSuccess) { fprintf(stderr, "kernel_launch: memset failed\n"); return; }
    P p{};
    for (int i = 0; i < 30; ++i) p.in[i] = (const float*)d_in[i];
    p.out = (float*)d_out; p.ws = (unsigned char*)d_ws;
#if MK_ONE_LAUNCH
    p.ph_lo = 0; p.ph_hi = NPHASES;
    { void* args[] = {&p}; hipError_t e = hipLaunchCooperativeKernel((const void*)mk_fwd, dim3(grid), dim3(NTHREADS), args, LDS_BYTES, stream);
      if (e != hipSuccess) fprintf(stderr, "cooperative launch failed: %s\n", hipGetErrorString(e)); }
#else
    for (int ph = 0; ph < NPHASES; ++ph) {
        p.ph_lo = ph; p.ph_hi = ph + 1;
        void* args[] = {&p}; hipError_t e = hipLaunchCooperativeKernel((const void*)mk_fwd, dim3(grid), dim3(NTHREADS), args, LDS_BYTES, stream);
        if (e != hipSuccess) { fprintf(stderr, "cooperative launch %d failed: %s\n", ph, hipGetErrorString(e)); break; }
    }
#endif
}
```

```cpp
#include <hip/hip_runtime.h>
#include <hip/hip_cooperative_groups.h>
#include <cstdio>
#include <cstdint>
namespace cg = cooperative_groups;
#ifndef ATTN_PROBE
#define ATTN_PROBE 0
#endif

#define DEVI __device__ __forceinline__
typedef unsigned short bf16;
typedef short bf16x8 __attribute__((ext_vector_type(8)));
typedef float f32x4 __attribute__((ext_vector_type(4)));
typedef float f32x2 __attribute__((ext_vector_type(2)));
typedef float f32x16 __attribute__((ext_vector_type(16)));
typedef unsigned u32x4 __attribute__((ext_vector_type(4)));
typedef unsigned u32x2 __attribute__((ext_vector_type(2)));
typedef __bf16 bf16x2_t __attribute__((ext_vector_type(2)));

constexpr int D = 1024, NB = 2, SEQ = 8192, NLAT = NB * SEQ, CL = 256, NCTX = NB * CL, T = NLAT + NCTX;
constexpr int INW = 2736, INWP = 2816;
constexpr int C_CQ = 0, C_CKV = 256, C_KPE = 384, C_RQ = 416, C_RK = 672, C_RV = 928, C_RG = 1184, C_Z = 1440, C_XBC = 1952, C_DTF = 2720, C_DTB = 2728;
constexpr int DFF = 2816, DFE = 1408, NEXP = 8;
constexpr float EPS = 1e-6f;
constexpr int MOE_MAXROWS = 34816;

constexpr size_t MiB = 1u << 20;
constexpr size_t WS_CTL = 0;
constexpr size_t WS_MODV = 1 * MiB;
constexpr size_t WS_ROPE = WS_MODV + 256 * 1024;
constexpr size_t WS_RQ = WS_MODV + 512 * 1024;
constexpr size_t WS_RKV = WS_MODV + 640 * 1024;
constexpr size_t WS_WIN = 2 * MiB;
constexpr size_t WS_WQKV = 13 * MiB;
constexpr size_t WS_WOUT = 15 * MiB;
constexpr size_t WS_WGU = 19 * MiB;
constexpr size_t WS_WD = 30 * MiB;
constexpr size_t WS_XC = 36 * MiB;
constexpr size_t WS_RT = 38 * MiB;
constexpr size_t WS_DT = 39 * MiB;
constexpr size_t WS_RQP = 41 * MiB + 128 * 1024;
constexpr size_t WS_RKVP = 41 * MiB + 512 * 1024;
constexpr size_t DYN = 42 * MiB;
constexpr size_t WS_HM = DYN;
constexpr size_t WS_PROJ = DYN + 33 * MiB;
constexpr size_t WS_XBC = DYN + 124 * MiB;
constexpr size_t WS_Q = DYN + 149 * MiB;
constexpr size_t WS_K = DYN + 161 * MiB + 512 * 1024;
constexpr size_t WS_V = DYN + 174 * MiB;
constexpr size_t WS_ST = DYN + 182 * MiB + 512 * 1024;
constexpr size_t WS_HT = WS_ST + (size_t)1584 * 2 * 4096 * 4;
constexpr size_t WS_CD = WS_RT + 512 * 1024;
constexpr size_t WS_VEC = WS_HT + (size_t)1584 * 2 * 4096 * 2;
constexpr size_t WS_WGUE = DYN + 33 * MiB;
constexpr size_t WS_WDE = DYN + 77 * MiB;
constexpr size_t WS_HS = DYN + 99 * MiB;
constexpr size_t WS_ACTS = DYN + 167 * MiB;
constexpr size_t WS_END = DYN + 261 * MiB;
static_assert(WS_HM + (size_t)T * 1024 * 2 <= WS_PROJ && WS_PROJ + (size_t)T * 2816 * 2 <= WS_XBC && WS_XBC + (size_t)T * 768 * 2 <= WS_Q &&
              WS_Q + (size_t)T * 384 * 2 <= WS_K && WS_K + (size_t)T * 384 * 2 <= WS_V && WS_V + (size_t)T * 256 * 2 <= WS_ST && WS_VEC + (size_t)1584 * 512 * 4 <= WS_END, "ws map (mixer)");
static_assert(WS_WGUE + (size_t)8 * 2816 * 1024 * 2 <= WS_WDE && WS_WDE + (size_t)8 * 1024 * 1408 * 2 <= WS_HS && WS_HS + (size_t)MOE_MAXROWS * 1024 * 2 <= WS_ACTS &&
              WS_ACTS + (size_t)MOE_MAXROWS * 1408 * 2 <= WS_END, "ws map (moe)");
static_assert(WS_DT + (size_t)T * 32 * 4 <= DYN && WS_WD + (size_t)1024 * 2816 * 2 <= WS_XC && WS_WIN + (size_t)2 * 2816 * 1024 * 2 <= WS_WQKV, "ws map (static)");

constexpr int NTHREADS = 512, NWAVES = 8;
constexpr int LDS_BYTES = 147456;

struct P { const float* in[30]; float* out; unsigned char* ws; int ph_lo, ph_hi; };
constexpr int LDS_MISC = 147456 - 512;
constexpr int LDS_PTRS = 147456 - 256;
typedef __attribute__((address_space(3))) unsigned long long lds_u64;
DEVI const float* inptr(int i) {
    const unsigned long long v = ((lds_u64*)(uintptr_t)LDS_PTRS)[i];
    const unsigned lo = __builtin_amdgcn_readfirstlane((unsigned)v), hi = __builtin_amdgcn_readfirstlane((unsigned)(v >> 32));
    return (const float*)(((unsigned long long)hi << 32) | lo);
}
#define IN(i) inptr(i)
DEVI int otid() { int t = threadIdx.x; asm volatile("" : "+v"(t)); return t; }

DEVI float bf2f(bf16 x) { return __uint_as_float(((unsigned)x) << 16); }
DEVI unsigned pk2(float lo, float hi) { f32x2 v = {lo, hi}; bf16x2_t b = __builtin_convertvector(v, bf16x2_t); return __builtin_bit_cast(unsigned, b); }
DEVI bf16 f2bf(float x) { return (bf16)(pk2(x, 0.f) & 0xffffu); }
DEVI float wave_sum(float v) {
#pragma unroll
    for (int o = 1; o < 64; o <<= 1) v += __shfl_xor(v, o);
    return v;
}
DEVI float siluf(float x) { return x * __builtin_amdgcn_rcpf(1.f + __builtin_amdgcn_exp2f(-1.4426950408889634f * x)); }
DEVI float softplusf(float x) { const float e = __expf(-fabsf(x)); return fmaxf(x, 0.f) + (e < 1e-3f ? e * (1.f - 0.5f * e) : __logf(1.f + e)); }
DEVI int rope_src(int p) { const int q = p & 15, s = (q & 1) ? 8 + (q >> 1) : (q >> 1); return (p & 16) + s; }

#define LAS __attribute__((address_space(3)))
struct Unit { int pm, pn, e, koff; };
struct Gemm { const bf16* A; const bf16* Bt; size_t bstride; const int* rowtab; };
constexpr int BM = 256, BK = 64, HALF = 128, HTB = HALF * BK * 2, STAGE_BYTES = 8 * HTB, NXCD = 8, WGM = 8;
__host__ __device__ __forceinline__ int lds_byte(int r, int c) { const int st = (r >> 4) * 2 + (c >> 5), rr = r & 15, cc = c & 31, ob = rr * 64 + cc * 2; return st * 1024 + (ob ^ (((ob >> 9) & 1) << 5)); }
__host__ __device__ __forceinline__ int perm32(int rho) { const int n = rho >> 4, i = rho & 15; return 8 * (i >> 2) + 4 * n + (i & 3); }
__host__ __device__ __forceinline__ void stage_rc(int b, int& R, int& C) { const int st = b / 1024, sb = b % 1024, swz = sb ^ (((sb >> 9) & 1) << 5); R = (st >> 1) * 16 + swz / 64; C = (st & 1) * 32 + (swz % 64) / 2; }
struct DenseSched {
    int nM, nN, G, c;
    DEVI bool next(int i, Unit& u) const {
        const int nwg = nM * nN; const long L = (long)i * G + c; if (L >= nwg) return false;
        int wgid = (int)L; { const int q = nwg / NXCD, r = nwg % NXCD, xcd = wgid % NXCD, off = wgid / NXCD; wgid = (xcd < r ? xcd * (q + 1) : r * (q + 1) + (xcd - r) * q) + off; }
        const int nig = WGM * nN, gid = wgid / nig, fm = gid * WGM, gsz = (nM - fm) < WGM ? (nM - fm) : WGM;
        u.pm = fm + ((wgid % nig) % gsz); u.pn = (wgid % nig) / gsz; u.e = 0; u.koff = 0; return true;
    }
};
struct CtxSplitSched {
    int nsplit, kbytes, G, c;
    DEVI bool next(int i, Unit& u) const { const int id = i * G + c; if (id >= 8 * nsplit) return false; const int tile = id & 7, ks = id >> 3; u.pm = 64 + (tile >> 2); u.pn = tile & 3; u.e = ks; u.koff = ks * kbytes; return true; }
};
struct MoeSched {
    const int* tab; int nN, G, c;
    DEVI bool next(int i, Unit& u) const { DenseSched d{tab[0], nN, G, c}; if (!d.next(i, u)) return false; u.e = tab[1 + u.pm]; return true; }
};
template <int LDA, int LDB, int KK, class Epi, class Sched, bool GATHER = false>
DEVI void gemm_phase(unsigned char* lds_generic, const Gemm g, const Sched& S, const Epi& E) {
    LAS unsigned char* lds = (LAS unsigned char*)lds_generic;
    const int tid = otid(), wid = __builtin_amdgcn_readfirstlane(tid >> 6), lane = tid & 63, wr = wid >> 2, wc = wid & 3, fr = lane & 15, fq = lane >> 4;
    constexpr int nt = KK / BK; static_assert(KK % 128 == 0, "K must be a multiple of 128");
    unsigned voffA[2], voffB[2]; int Rr[2], Cc[2];
#pragma unroll
    for (int i = 0; i < 2; ++i) { int R, C; stage_rc(tid * 16 + i * 8192, R, C); Rr[i] = R; Cc[i] = C; voffA[i] = (unsigned)(R * LDA + C) * 2u; const int Rb = Epi::PERM ? ((R & ~31) + perm32(R & 31)) : R; voffB[i] = (unsigned)(Rb * LDB + C) * 2u; }
    unsigned cv0[2] = {voffA[0], voffA[1]}, cv1[2] = {voffA[0], voffA[1]}, nv0[2] = {voffA[0], voffA[1]}, nv1[2] = {voffA[0], voffA[1]};
#define PG8_ROWS(u, v0, v1) do { if (GATHER) { _Pragma("unroll") for (int i_ = 0; i_ < 2; ++i_) { v0[i_] = (unsigned)(g.rowtab[(u).pm * BM + Rr[i_]] * LDA + Cc[i_]) * 2u; v1[i_] = (unsigned)(g.rowtab[(u).pm * BM + HALF + Rr[i_]] * LDA + Cc[i_]) * 2u; } } } while (0)
    constexpr size_t kstep = (size_t)(BK * 2), hstepA = GATHER ? (size_t)0 : (size_t)HALF * LDA * 2, hstepB = (size_t)HALF * LDB * 2, tstepA = GATHER ? (size_t)0 : (size_t)2 * HALF * LDA * 2, tstepB = 2 * hstepB;
    const unsigned ldsw = (unsigned)wid * 1024u;
    const int aoff = lds_byte(wr * 64 + fr, fq * 8), boff = lds_byte(wc * 32 + fr, fq * 8);
#define PG8_SA(b, h) (((b) * 2 + (h)) * HTB)
#define PG8_SB(b, h) ((4 + (b) * 2 + (h)) * HTB)
#define PG8_STAGE(bufoff, gbase, voff) do { _Pragma("unroll") for (int _i = 0; _i < 2; ++_i) \
        __builtin_amdgcn_global_load_lds((const unsigned*)((const char*)(gbase) + (voff)[_i]), (LAS unsigned*)(lds + (bufoff) + ldsw + _i * 8192), 16, 0, 0); } while (0)
#define PG8_LDA(dst, b, h) do { _Pragma("unroll") for (int m = 0; m < 4; ++m) _Pragma("unroll") for (int k = 0; k < 2; ++k) dst[m][k] = *(const LAS bf16x8*)(lds + PG8_SA(b, h) + aoff + m * 2048 + k * 1024); } while (0)
#define PG8_LDB(dst, b, h) do { _Pragma("unroll") for (int n = 0; n < 2; ++n) _Pragma("unroll") for (int k = 0; k < 2; ++k) dst[n][k] = *(const LAS bf16x8*)(lds + PG8_SB(b, h) + boff + n * 2048 + k * 1024); } while (0)
#define PG8_MMA(ai, bj, At, Bt) do { __builtin_amdgcn_s_setprio(1); _Pragma("unroll") for (int m = 0; m < 4; ++m) _Pragma("unroll") for (int n = 0; n < 2; ++n) _Pragma("unroll") for (int k = 0; k < 2; ++k) \
        acc[ai][bj][m][n] = __builtin_amdgcn_mfma_f32_16x16x32_bf16(Bt[n][k], At[m][k], acc[ai][bj][m][n], 0, 0, 0); __builtin_amdgcn_s_setprio(0); } while (0)
#define PG8_WAIT_V(n) asm volatile("s_waitcnt vmcnt(" #n ")" ::: "memory")
#define PG8_WAIT_L(n) asm volatile("s_waitcnt lgkmcnt(" #n ")" ::: "memory")
#define PG8_BAR __builtin_amdgcn_s_barrier()
#define PG8_SCHED __builtin_amdgcn_sched_barrier(0)
    Unit cur, nxt; int ui = 0;
    if (!S.next(0, cur)) return;
    f32x4 acc[2][2][4][2];
#pragma unroll
    for (int a = 0; a < 2; ++a)
#pragma unroll
        for (int b = 0; b < 2; ++b)
#pragma unroll
            for (int m = 0; m < 4; ++m)
#pragma unroll
                for (int n = 0; n < 2; ++n) acc[a][b][m][n] = (f32x4){0.f, 0.f, 0.f, 0.f};
    bf16x8 At[4][2], B0[2][2], B1[2][2];
    const char* cA = (const char*)g.A + (size_t)cur.pm * tstepA + cur.koff; const char* cB = (const char*)(g.Bt + (size_t)cur.e * g.bstride) + (size_t)cur.pn * tstepB + cur.koff;
    PG8_WAIT_V(0); PG8_WAIT_L(0); __syncthreads();
    PG8_ROWS(cur, cv0, cv1);
    PG8_STAGE(PG8_SB(0, 0), cB, voffB); PG8_STAGE(PG8_SB(0, 1), cB + hstepB, voffB); PG8_STAGE(PG8_SA(0, 0), cA, cv0); PG8_STAGE(PG8_SA(0, 1), cA + hstepA, cv1);
    if (wr == 1) PG8_BAR;
    PG8_WAIT_V(2); PG8_BAR;
    PG8_STAGE(PG8_SB(1, 0), cB + kstep, voffB); PG8_STAGE(PG8_SA(1, 0), cA + kstep, cv0); PG8_STAGE(PG8_SB(1, 1), cB + hstepB + kstep, voffB);
    PG8_WAIT_V(6); PG8_BAR;
    for (;;) {
        const bool has_next = S.next(ui + 1, nxt);
        if (has_next) PG8_ROWS(nxt, nv0, nv1);
        const char* nA = has_next ? (const char*)g.A + (size_t)nxt.pm * tstepA + nxt.koff : cA; const char* nB = has_next ? (const char*)(g.Bt + (size_t)nxt.e * g.bstride) + (size_t)nxt.pn * tstepB + nxt.koff : cB;
#pragma unroll 1
        for (int t = 0; t < nt; t += 2) {
            const bool last = (t == nt - 2);
            const char* a1 = cA + (size_t)(t + 1) * kstep;
            const char* a2 = last ? nA : cA + (size_t)(t + 2) * kstep; const char* b2 = last ? nB : cB + (size_t)(t + 2) * kstep;
            const char* a3 = a2 + kstep; const char* b3 = b2 + kstep;
            unsigned s0[2] = {cv0[0], cv0[1]}, s1[2] = {cv1[0], cv1[1]};
            if (GATHER && last && has_next) { s0[0] = nv0[0]; s0[1] = nv0[1]; s1[0] = nv1[0]; s1[1] = nv1[1]; }
            PG8_LDB(B0, 0, 0); PG8_LDB(B1, 0, 1); PG8_SCHED; PG8_LDA(At, 0, 0); PG8_STAGE(PG8_SA(1, 1), a1 + hstepA, cv1);
            PG8_WAIT_V(8); PG8_WAIT_L(0); PG8_BAR; PG8_MMA(0, 0, At, B0); PG8_MMA(0, 1, At, B1); PG8_BAR; PG8_SCHED;
            PG8_LDA(At, 0, 1); PG8_STAGE(PG8_SB(0, 0), b2, voffB); PG8_STAGE(PG8_SB(0, 1), b2 + hstepB, voffB); PG8_STAGE(PG8_SA(0, 0), a2, s0);
            PG8_WAIT_V(8); PG8_WAIT_L(0); PG8_BAR; PG8_MMA(1, 0, At, B0); PG8_MMA(1, 1, At, B1); PG8_BAR; PG8_SCHED;
            PG8_LDB(B0, 1, 0); PG8_LDB(B1, 1, 1); PG8_SCHED; PG8_LDA(At, 1, 0); PG8_STAGE(PG8_SA(0, 1), a2 + hstepA, s1);
            PG8_WAIT_V(8); PG8_WAIT_L(0); PG8_BAR; PG8_MMA(0, 0, At, B0); PG8_MMA(0, 1, At, B1); PG8_BAR; PG8_SCHED;
            PG8_LDA(At, 1, 1); PG8_STAGE(PG8_SB(1, 0), b3, voffB); PG8_STAGE(PG8_SB(1, 1), b3 + hstepB, voffB); PG8_STAGE(PG8_SA(1, 0), a3, s0);
            PG8_WAIT_V(8); PG8_WAIT_L(0); PG8_BAR; PG8_MMA(1, 0, At, B0); PG8_MMA(1, 1, At, B1); PG8_BAR; PG8_SCHED;
        }
        if (wr == 0) PG8_BAR;
        E(acc, cur, wr, wc, fr, fq);
        if (!has_next) break;
#pragma unroll
        for (int a = 0; a < 2; ++a)
#pragma unroll
            for (int b = 0; b < 2; ++b)
#pragma unroll
                for (int m = 0; m < 4; ++m)
#pragma unroll
                    for (int n = 0; n < 2; ++n) acc[a][b][m][n] = (f32x4){0.f, 0.f, 0.f, 0.f};
        cur = nxt; cA = nA; cB = nB; ++ui;
        if (GATHER) { cv0[0] = nv0[0]; cv0[1] = nv0[1]; cv1[0] = nv1[0]; cv1[1] = nv1[1]; }
        if (wr == 1) PG8_BAR;
    }
    PG8_WAIT_V(0);
    PG8_BAR;
#undef PG8_ROWS
#undef PG8_SA
#undef PG8_SB
#undef PG8_STAGE
#undef PG8_LDA
#undef PG8_LDB
#undef PG8_MMA
#undef PG8_WAIT_V
#undef PG8_WAIT_L
#undef PG8_BAR
#undef PG8_SCHED
}
#define EPI_LOOP_ROWS _Pragma("unroll") for (int ai = 0; ai < 2; ++ai) _Pragma("unroll") for (int m = 0; m < 4; ++m)
#define EPI_ROW (u.pm * 256 + ai * 128 + wr * 64 + m * 16 + fr)
#define EPI_COL(bj, n) (u.pn * 256 + (bj) * 128 + wc * 32 + (n) * 16 + fq * 4)
#define EPI_COL8(bj) (u.pn * 256 + (bj) * 128 + wc * 32 + fq * 8)
DEVI void st_bf16x8(bf16* p, f32x4 a, f32x4 b) { u32x4 w; w.x = pk2(a[0], a[1]); w.y = pk2(a[2], a[3]); w.z = pk2(b[0], b[1]); w.w = pk2(b[2], b[3]); *(u32x4*)p = w; }

DEVI void st_bf16x4(bf16* p, f32x4 v) { u32x2 w; w.x = pk2(v[0], v[1]); w.y = pk2(v[2], v[3]); *(u32x2*)p = w; }

struct EpiInProj {
    static constexpr bool PERM = true;
    bf16* proj; float* dt; const float* dt_bias; const float* a_log; float* rqp; float* rkvp;
    DEVI void operator()(const f32x4 (&acc)[2][2][4][2], const Unit& u, int wr, int wc, int fr, int fq) const {
        EPI_LOOP_ROWS { const int row = EPI_ROW;
            if (u.pn <= 1) { float ssq = 0.f;
#pragma unroll
                for (int bj = 0; bj < 2; ++bj) if (u.pn == 0 || bj == 0) {
#pragma unroll
                    for (int n = 0; n < 2; ++n) { const f32x4 v = acc[ai][bj][m][n]; ssq += (v[0] * v[0] + v[1] * v[1]) + (v[2] * v[2] + v[3] * v[3]); } }
                ssq += __shfl_xor(ssq, 16); ssq += __shfl_xor(ssq, 32);
                if (fq == 0) (u.pn == 0 ? rqp : rkvp)[(size_t)row * 4 + wc] = ssq; }
#pragma unroll
            for (int bj = 0; bj < 2; ++bj) { const int col = EPI_COL8(bj);
                if (col < C_DTF) st_bf16x8(proj + (size_t)row * INWP + col, acc[ai][bj][m][0], acc[ai][bj][m][1]);
                else if (col < INW) { const int j0 = col - C_DTF;
#pragma unroll
                    for (int n = 0; n < 2; ++n) { const f32x4 v = acc[ai][bj][m][n]; f32x4 dv, lv;
#pragma unroll
                        for (int i = 0; i < 4; ++i) { const float d_ = softplusf(v[i] + dt_bias[j0 + 4 * n + i]); dv[i] = d_; lv[i] = -d_ * __expf(a_log[j0 + 4 * n + i]); }
                        *(f32x4*)(dt + (size_t)row * 32 + j0 + 4 * n) = dv; *(f32x4*)(dt + (size_t)row * 32 + 16 + j0 + 4 * n) = lv; } } } }
    }
};
struct EpiMla {
    static constexpr bool PERM = false;
    bf16 *Q, *K, *V; const float *rqp, *rkvp; const float* rope; const bf16* proj;
    DEVI void operator()(const f32x4 (&acc)[2][2][4][2], const Unit& u, int wr, int wc, int fr, int fq) const {
        EPI_LOOP_ROWS { const int row = EPI_ROW; float sq = 0.f, skv = 0.f;
            if (u.pn <= 1) { const f32x4 pq = *(const f32x4*)(rqp + (size_t)row * 4); sq = __builtin_amdgcn_rsqf(((pq[0] + pq[1]) + (pq[2] + pq[3])) * (1.f / 256.f) + EPS); }
            if (u.pn >= 2) { const f32x4 pk = *(const f32x4*)(rkvp + (size_t)row * 4); skv = __builtin_amdgcn_rsqf(((pk[0] + pk[1]) + (pk[2] + pk[3])) * (1.f / 128.f) + EPS); }
            const int pos = row & (SEQ - 1), gr = pos >> 6, gc = pos & 63;
#pragma unroll
            for (int bj = 0; bj < 2; ++bj)
#pragma unroll
                for (int n = 0; n < 2; ++n) { const int col = EPI_COL(bj, n); f32x4 v = acc[ai][bj][m][n];
                    if (col < 384) { v = v * sq; const int d = col % 96;
                        if (d >= 64 && row < NLAT) { const int pp = (d - 64) >> 1;
#pragma unroll
                            for (int i = 0; i < 2; ++i) { const int pi = pp + i; const float* tb = (pi < 8) ? rope + (gr * 8 + pi) * 2 : rope + 2048 + (gc * 8 + (pi - 8)) * 2;
                                const float c = tb[0], s = tb[1], x0 = v[2 * i], x1 = v[2 * i + 1]; v[2 * i] = x0 * c - x1 * s; v[2 * i + 1] = x1 * c + x0 * s; } }
                        st_bf16x4(Q + (size_t)row * 384 + col, v); }
                    else if (col < 416) { const int d0 = col - 384, pp = d0 >> 1; const u32x2 raw = *(const u32x2*)(proj + (size_t)row * INWP + C_KPE + d0);
                        f32x4 x = {bf2f(raw.x & 0xffff), bf2f(raw.x >> 16), bf2f(raw.y & 0xffff), bf2f(raw.y >> 16)};
                        if (row < NLAT) {
#pragma unroll
                            for (int i = 0; i < 2; ++i) { const int pi = pp + i; const float* tb = (pi < 8) ? rope + (gr * 8 + pi) * 2 : rope + 2048 + (gc * 8 + (pi - 8)) * 2;
                                const float c = tb[0], s = tb[1], x0 = x[2 * i], x1 = x[2 * i + 1]; x[2 * i] = x0 * c - x1 * s; x[2 * i + 1] = x1 * c + x0 * s; } }
#pragma unroll
                        for (int h = 0; h < 4; ++h) st_bf16x4(K + (size_t)row * 384 + h * 96 + 64 + d0, x); }
                    else if (col >= 512 && col < 768) { const int c = col - 512; st_bf16x4(K + (size_t)row * 384 + (c >> 6) * 96 + (c & 63), v * skv); }
                    else if (col >= 768) { st_bf16x4(V + (size_t)row * 256 + (col - 768), v * skv); } }
            asm volatile("" ::: "memory"); }
    }
};
struct EpiResid {
    static constexpr bool PERM = true;
    const float* src_lat; const float* src_ctx; float* dst_lat; float* dst_ctx; const float* modv_l; int gidx;
    DEVI void operator()(const f32x4 (&acc)[2][2][4][2], const Unit& u, int wr, int wc, int fr, int fq) const {
        EPI_LOOP_ROWS { const int row = EPI_ROW; const bool lat = row < NLAT; const int r = lat ? (row >> 13) : 2;
            const float* s = lat ? src_lat + (size_t)row * D : src_ctx + (size_t)(row - NLAT) * D; float* d = lat ? dst_lat + (size_t)row * D : dst_ctx + (size_t)(row - NLAT) * D;
            const float* gp = modv_l + r * 6144 + gidx * 1024;
#pragma unroll
            for (int bj = 0; bj < 2; ++bj)
#pragma unroll
                for (int n = 0; n < 2; ++n) { const int col = EPI_COL8(bj) + 4 * n; const f32x4 gv = *(const f32x4*)(gp + col), sv = *(const f32x4*)(s + col);
                    *(f32x4*)(d + col) = sv + gv * acc[ai][bj][m][n]; } }
    }
};
struct EpiPart {
    static constexpr bool PERM = true;
    float* part;
    DEVI void operator()(const f32x4 (&acc)[2][2][4][2], const Unit& u, int wr, int wc, int fr, int fq) const {
        EPI_LOOP_ROWS { const int row = EPI_ROW; float* d = part + ((size_t)u.e * NCTX + (row - NLAT)) * D;
#pragma unroll
            for (int bj = 0; bj < 2; ++bj)
#pragma unroll
                for (int n = 0; n < 2; ++n) *(f32x4*)(d + EPI_COL8(bj) + 4 * n) = acc[ai][bj][m][n]; }
    }
};
struct EpiSwiglu {
    static constexpr bool PERM = true;
    bf16* act; int ldc;
    DEVI void operator()(const f32x4 (&acc)[2][2][4][2], const Unit& u, int wr, int wc, int fr, int fq) const {
        EPI_LOOP_ROWS { const int row = EPI_ROW; f32x4 o[2];
#pragma unroll
            for (int n = 0; n < 2; ++n) { const f32x4 gt = acc[ai][0][m][n], up = acc[ai][1][m][n];
#pragma unroll
                for (int i = 0; i < 4; ++i) o[n][i] = siluf(gt[i]) * up[i]; }
            st_bf16x8(act + (size_t)row * ldc + u.pn * 128 + wc * 32 + fq * 8, o[0], o[1]); }
    }
};
struct EpiStore {
    static constexpr bool PERM = true;
    bf16* o; int ldc;
    DEVI void operator()(const f32x4 (&acc)[2][2][4][2], const Unit& u, int wr, int wc, int fr, int fq) const {
        EPI_LOOP_ROWS { const int row = EPI_ROW;
#pragma unroll
            for (int bj = 0; bj < 2; ++bj) st_bf16x8(o + (size_t)row * ldc + EPI_COL8(bj), acc[ai][bj][m][0], acc[ai][bj][m][1]); }
    }
};

struct CvtSrc { const float* src; int ld; int ncols; bool perm; const float* ks; float sc; };
DEVI void cvt_tile(const CvtSrc t, bf16* dst, int Kd, int nd0, int kd0, LAS float* scr, int lane) {
    const int n = lane & 31;
    if (t.src) {
        const int nc = (n < t.ncols) ? n : t.ncols - 1; const float msk = (n < t.ncols) ? t.sc : 0.f;
        const float* sp0 = t.src + (size_t)(lane >> 5) * t.ld + nc;
        float v[32];
#pragma unroll
        for (int i = 0; i < 32; ++i) v[i] = __builtin_nontemporal_load(sp0 + (size_t)(2 * i) * t.ld);
        if (t.ks) {
#pragma unroll
            for (int i = 0; i < 32; ++i) v[i] *= t.ks[2 * i + (lane >> 5)];
        }
#pragma unroll
        for (int i = 0; i < 32; ++i) scr[(2 * i + (lane >> 5)) * 33 + n] = v[i] * msk;
    } else {
#pragma unroll 8
        for (int i = 0; i < 32; ++i) scr[(2 * i + (lane >> 5)) * 33 + n] = 0.f;
    }
    asm volatile("s_waitcnt lgkmcnt(0)" ::: "memory");
    const int c = lane & 7;
#pragma unroll
    for (int j = 0; j < 4; ++j) { const int nn = (lane >> 3) + 8 * j; const LAS float* sp = scr + (8 * c) * 33 + (t.perm ? rope_src(nn) : nn);
        u32x4 o; o.x = pk2(sp[0 * 33], sp[1 * 33]); o.y = pk2(sp[2 * 33], sp[3 * 33]); o.z = pk2(sp[4 * 33], sp[5 * 33]); o.w = pk2(sp[6 * 33], sp[7 * 33]);
        *(u32x4*)(dst + (size_t)(nd0 + nn) * Kd + kd0 + 8 * c) = o; }
    asm volatile("s_waitcnt lgkmcnt(0)" ::: "memory");
}
template <class F>
DEVI void cvt_job(bf16* dst, int Nd, int Kd, F f, LAS float* scr, int gw, int ngw, int lane) {
    const int ntn = Nd >> 5, ntk = Kd >> 6;
    for (int it = gw; it < ntn * ntk; it += ngw) { const int nt = it % ntn, kt = it / ntn; cvt_tile(f(nt, kt), dst, Kd, nt * 32, kt * 64, scr, lane); }
}
DEVI void ph_pro(const P& p, unsigned char* lds) {
    const int tid = otid(), wid = tid >> 6, lane = tid & 63;
    __syncthreads();
    float* modv = (float*)(p.ws + WS_MODV);
    float* red = (float*)lds;
    float* sc3 = (float*)(lds + 8192);
    if (blockIdx.x < 192) { for (int k = tid; k < 1024; k += NTHREADS) { sc3[k] = siluf(IN(1)[k]); sc3[1024 + k] = siluf(IN(1)[1024 + k]); sc3[2048 + k] = siluf(IN(3)[k]); } }
    __syncthreads();
    for (int item = blockIdx.x; item < 192; item += gridDim.x) {
        const int l = item / 96, n = (item % 96) * 64 + lane;
        const float* W = IN(4) + (size_t)l * 1024 * 6144;
        float a0 = 0.f, a1 = 0.f, a2 = 0.f;
#pragma unroll 16
        for (int k = wid * 128; k < wid * 128 + 128; ++k) {
            const float w = __builtin_nontemporal_load(W + (size_t)k * 6144 + n);
            a0 += sc3[k] * w; a1 += sc3[1024 + k] * w; a2 += sc3[2048 + k] * w;
        }
        red[(wid * 3 + 0) * 64 + lane] = a0; red[(wid * 3 + 1) * 64 + lane] = a1; red[(wid * 3 + 2) * 64 + lane] = a2;
        __syncthreads();
        if (tid < 192) { const int r = tid >> 6, ln = tid & 63; float s = 0.f;
            for (int w = 0; w < 8; ++w) s += red[(w * 3 + r) * 64 + ln];
            const int nn = (item % 96) * 64 + ln; modv[(l * 3 + r) * 6144 + nn] = s + IN(5)[l * 6144 + nn]; }
        __syncthreads();
    }
    if (blockIdx.x == gridDim.x - 1) {
        float* rope = (float*)(p.ws + WS_ROPE);
        for (int idx = tid; idx < 1536; idx += NTHREADS) {
            const int i = idx & 7, pos = (idx < 1024) ? (idx >> 3) : ((idx - 1024) >> 3);
            const float invf = (i == 0) ? 1.f : (i == 1) ? 0.31622776601683794f : (i == 2) ? 0.1f : (i == 3) ? 0.03162277660168379f : (i == 4) ? 0.01f : (i == 5) ? 0.003162277660168379f : (i == 6) ? 0.001f : 0.00031622776601683794f;
            const float ang = (float)pos * invf;
            double rev = (double)ang * 0.15915494309189535; rev -= __builtin_rint(rev);
            const float fr = (float)rev;
            rope[idx * 2] = __builtin_amdgcn_cosf(fr); rope[idx * 2 + 1] = __builtin_amdgcn_sinf(fr);
        }
    }
    __syncthreads();
    LAS float* scr = (LAS float*)(LAS unsigned char*)lds + wid * (64 * 33);
    const int gw = blockIdx.x * NWAVES + wid, ngw = gridDim.x * NWAVES;
    for (int l = 0; l < 2; ++l) {
        { const float* W = IN(8) + (size_t)l * 1024 * INW;
          cvt_job((bf16*)(p.ws + WS_WIN) + (size_t)l * INWP * 1024, INWP, 1024, [=](int nt, int kt) -> CvtSrc {
              const int n0 = nt * 32; if (n0 >= INW) return CvtSrc{nullptr, 0, 0, false, nullptr, 1.f};
              return CvtSrc{W + (size_t)(kt * 64) * INW + n0, INW, (INW - n0 < 32) ? INW - n0 : 32, n0 == C_KPE, nullptr, 1.f}; }, scr, gw, ngw, lane); }
        { const float* Wq = IN(11) + (size_t)l * 256 * 384; const float* qn = IN(10) + l * 256; const float* Wk = IN(13) + (size_t)l * 128 * 256; const float* Wv = IN(14) + (size_t)l * 128 * 256; const float* kn = IN(12) + l * 128;
          const float QS = 0.10206207261596577f * 1.4426950408889634f;
          cvt_job((bf16*)(p.ws + WS_WQKV) + (size_t)l * 1024 * 384, 1024, 384, [=](int nt, int kt) -> CvtSrc {
              const int n0 = nt * 32, k0 = kt * 64;
              if (n0 < 384) { if (k0 >= 256) return CvtSrc{nullptr, 0, 0, false, nullptr, 1.f}; return CvtSrc{Wq + (size_t)k0 * 384 + n0, 384, 32, (n0 % 96) == 64, qn + k0, QS}; }
              if (n0 < 512 || k0 < 256) return CvtSrc{nullptr, 0, 0, false, nullptr, 1.f};
              if (n0 < 768) return CvtSrc{Wk + (size_t)(k0 - 256) * 256 + (n0 - 512), 256, 32, false, kn + k0 - 256, 1.f};
              return CvtSrc{Wv + (size_t)(k0 - 256) * 256 + (n0 - 768), 256, 32, false, kn + k0 - 256, 1.f}; }, scr, gw, ngw, lane); }
        { const float* W = IN(9) + (size_t)l * 1024 * 1024;
          cvt_job((bf16*)(p.ws + WS_WOUT) + (size_t)l * 1024 * 1024, 1024, 1024, [=](int nt, int kt) -> CvtSrc { return CvtSrc{W + (size_t)(kt * 64) * 1024 + nt * 32, 1024, 32, false, nullptr, 1.f}; }, scr, gw, ngw, lane); }
    }
    { const float* Wg = IN(22); const float* Wu = IN(23);
      cvt_job((bf16*)(p.ws + WS_WGU), 2 * DFF, 1024, [=](int nt, int kt) -> CvtSrc { const int n0 = nt * 32, t = n0 >> 8, r = n0 & 255;
          return CvtSrc{(r < 128 ? Wg + t * 128 + r : Wu + t * 128 + r - 128) + (size_t)(kt * 64) * DFF, DFF, 32, false, nullptr, 1.f}; }, scr, gw, ngw, lane); }
    { const float* W = IN(24);
      cvt_job((bf16*)(p.ws + WS_WD), 1024, DFF, [=](int nt, int kt) -> CvtSrc { return CvtSrc{W + (size_t)(kt * 64) * 1024 + nt * 32, 1024, 32, false, nullptr, 1.f}; }, scr, gw, ngw, lane); }
}
DEVI void ph_moew(const P& p, unsigned char* lds) {
    const int tid = otid(), wid = tid >> 6, lane = tid & 63;
    LAS float* scr = (LAS float*)(LAS unsigned char*)lds + wid * (64 * 33);
    const int gw = blockIdx.x * NWAVES + wid, ngw = gridDim.x * NWAVES;
    for (int e = 0; e < NEXP; ++e) {
        { const float* Wg = IN(26) + (size_t)e * 1024 * DFE; const float* Wu = IN(27) + (size_t)e * 1024 * DFE;
          cvt_job((bf16*)(p.ws + WS_WGUE) + (size_t)e * 2 * DFE * 1024, 2 * DFE, 1024, [=](int nt, int kt) -> CvtSrc { const int n0 = nt * 32, t = n0 >> 8, r = n0 & 255;
              return CvtSrc{(r < 128 ? Wg + t * 128 + r : Wu + t * 128 + r - 128) + (size_t)(kt * 64) * DFE, DFE, 32, false, nullptr, 1.f}; }, scr, gw, ngw, lane); }
        { const float* W = IN(28) + (size_t)e * DFE * 1024;
          cvt_job((bf16*)(p.ws + WS_WDE) + (size_t)e * 1024 * DFE, 1024, DFE, [=](int nt, int kt) -> CvtSrc { return CvtSrc{W + (size_t)(kt * 64) * 1024 + nt * 32, 1024, 32, false, nullptr, 1.f}; }, scr, gw, ngw, lane); }
    }
}

template <bool route>
DEVI void ph_norm(const P& p, int l, int which, int nrows, unsigned char* lds, int npart, int pgidx) {
    const int tid = otid(), wid = tid >> 6, lane = tid & 63;
    const bool first = (l == 0 && which == 0);
    const float* src_lat = first ? IN(0) : p.out; const float* src_ctx = (l == 0) ? IN(2) : (const float*)(p.ws + WS_XC);
    const float* w = IN(6 + which) + l * 1024; const float* modv = (const float*)(p.ws + WS_MODV) + (size_t)l * 3 * 6144;
    bf16* H = (bf16*)(p.ws + WS_HM);
    int* rt_e = (int*)(p.ws + WS_RT); float* rt_g = (float*)(p.ws + WS_RT + 128 * 1024);
    float* rl = (float*)lds;
    if (route) { __syncthreads(); const float* router = IN(25);
#pragma unroll
        for (int i = 0; i < 4; ++i) *(f32x4*)(rl + (tid + NTHREADS * i) * 4) = *(const f32x4*)(router + (tid + NTHREADS * i) * 4);
        __syncthreads(); }
    const int nw = gridDim.x * NWAVES, rpw = (NLAT + nw - 1) / nw, gw = blockIdx.x * NWAVES + wid;
    f32x4 vn[4], gsc[4], shv[4]; int rc = -1;
    for (int pass = 0; pass < (nrows > NLAT ? 2 : 1); ++pass) {
    const int row0 = pass == 0 ? gw * rpw : NLAT + gw, row1 = pass == 0 ? ((row0 + rpw < NLAT) ? row0 + rpw : NLAT) : nrows, rstep = pass == 0 ? 1 : nw;
    if (row0 < row1) { const float* x = (row0 < NLAT) ? src_lat + (size_t)row0 * D : src_ctx + (size_t)(row0 - NLAT) * D;
#pragma unroll
        for (int j = 0; j < 4; ++j) vn[j] = *(const f32x4*)(x + (j * 64 + lane) * 4); }
    for (int row = row0; row < row1; row += rstep) {
        const bool lat = row < NLAT; const int r = lat ? (row >> 13) : 2;
        if (r != rc) { rc = r; const float* sh = modv + r * 6144 + (which * 3 + 0) * 1024; const float* sc = modv + r * 6144 + (which * 3 + 1) * 1024;
#pragma unroll
            for (int j = 0; j < 4; ++j) { const int c0 = (j * 64 + lane) * 4; const f32x4 wv = *(const f32x4*)(w + c0), cv = *(const f32x4*)(sc + c0); shv[j] = *(const f32x4*)(sh + c0); gsc[j] = wv * (cv + 1.f); } }
        f32x4 v[4]; float ss = 0.f;
#pragma unroll
        for (int j = 0; j < 4; ++j) v[j] = vn[j];
        if (!lat && npart > 0) { const float* part = (const float*)(p.ws + WS_XBC) + (size_t)(row - NLAT) * D; const float* gp = modv + 2 * 6144 + pgidx * 1024; float* xc = (float*)(p.ws + WS_XC) + (size_t)(row - NLAT) * D;
#pragma unroll
            for (int j = 0; j < 4; ++j) { const int c0 = (j * 64 + lane) * 4; f32x4 acc = {0.f, 0.f, 0.f, 0.f};
#pragma unroll 2
                for (int k = 0; k < npart; ++k) acc += *(const f32x4*)(part + (size_t)k * NCTX * D + c0);
                v[j] += *(const f32x4*)(gp + c0) * acc; *(f32x4*)(xc + c0) = v[j]; } }
#pragma unroll
        for (int j = 0; j < 4; ++j) ss += v[j][0] * v[j][0] + v[j][1] * v[j][1] + v[j][2] * v[j][2] + v[j][3] * v[j][3];
        if (row + rstep < row1) { const int nrow = row + rstep; const float* x = (nrow < NLAT) ? src_lat + (size_t)nrow * D : src_ctx + (size_t)(nrow - NLAT) * D;
#pragma unroll
            for (int j = 0; j < 4; ++j) vn[j] = *(const f32x4*)(x + (j * 64 + lane) * 4); }
        ss = wave_sum(ss); const float rstd = __builtin_amdgcn_rsqf(ss * (1.f / D) + EPS);
        float lg[8];
#pragma unroll
        for (int e = 0; e < 8; ++e) lg[e] = 0.f;
#pragma unroll
        for (int j = 0; j < 4; ++j) { const int c0 = (j * 64 + lane) * 4; v[j] = v[j] * rstd * gsc[j] + shv[j]; st_bf16x4(H + (size_t)row * D + c0, v[j]); }
        if (route) {
#pragma unroll
            for (int j = 0; j < 4; ++j) { const int c0 = (j * 64 + lane) * 4;
#pragma unroll
                for (int i = 0; i < 4; ++i) { const f32x4 r0 = *(const f32x4*)(rl + (c0 + i) * 8), r1 = *(const f32x4*)(rl + (c0 + i) * 8 + 4); const float hh = v[j][i];
                    lg[0] += hh * r0[0]; lg[1] += hh * r0[1]; lg[2] += hh * r0[2]; lg[3] += hh * r0[3]; lg[4] += hh * r1[0]; lg[5] += hh * r1[1]; lg[6] += hh * r1[2]; lg[7] += hh * r1[3]; }
                asm volatile("" ::: "memory"); } }
        if (route) {
#pragma unroll
            for (int e = 0; e < 8; ++e) lg[e] = wave_sum(lg[e]);
            int i1 = 0; float v1 = lg[0];
#pragma unroll
            for (int e = 1; e < 8; ++e) if (lg[e] > v1) { v1 = lg[e]; i1 = e; }
            int i2 = -1; float v2 = -3.0e38f;
#pragma unroll
            for (int e = 0; e < 8; ++e) if (e != i1 && lg[e] > v2) { v2 = lg[e]; i2 = e; }
            const float e2 = __expf(v2 - v1), g1 = 1.f / (1.f + e2), g2 = e2 / (1.f + e2);
            if (lane == 0) { rt_e[row * 2] = i1; rt_e[row * 2 + 1] = i2; rt_g[row * 2] = g1; rt_g[row * 2 + 1] = g2; }
        }
    }
    }
}

typedef short v4i16_t __attribute__((ext_vector_type(4)));
DEVI v4i16_t lds_tr(const unsigned char* p) { return __builtin_amdgcn_ds_read_tr16_b64_v4i16((LAS v4i16_t*)(LAS unsigned char*)p); }
constexpr int A3_KLD = 208, A3_VLD = 192, A3_VOFF = 64 * A3_KLD, A3_BUF = A3_VOFF + 64 * A3_VLD;
template <int VAR>
DEVI void attn_unit(const P& p, int uidx, unsigned char* lds, bf16* outp) {
    const int tid = otid(), wid = __builtin_amdgcn_readfirstlane(tid >> 6), lane = tid & 63, r32 = lane & 31, hi = lane >> 5;
    const bf16* Q = (const bf16*)(p.ws + WS_Q); const bf16* K = (const bf16*)(p.ws + WS_K); const bf16* V = (const bf16*)(p.ws + WS_V); bf16* MIX = outp;
    int b, h, qrow0, NT;
    if (uidx < 256) { b = uidx >> 7; h = (uidx >> 5) & 3; qrow0 = b * SEQ + (uidx & 31) * 256; NT = 4 + SEQ / 64; }
    else { const int j = uidx - 256; b = j >> 2; h = j & 3; qrow0 = NLAT + b * CL; NT = 4; }
    const int qrow = qrow0 + wid * 32 + r32;
    bf16x8 qf[6];
#pragma unroll
    for (int s = 0; s < 6; ++s) qf[s] = *(const bf16x8*)(Q + (size_t)qrow * 384 + h * 96 + s * 16 + hi * 8);
    const int kk0 = tid / 12, kq0 = tid % 12, kk1 = (512 + tid) / 12, kq1 = (512 + tid) % 12, vk = tid >> 3, vq = tid & 7;
    const bf16* Kh = K + h * 96; const bf16* Vh = V + h * 64 + vq * 8;
    const int ctx0 = NLAT + b * CL, lat0 = b * SEQ;
    u32x4 krA0, krA1 = {0u, 0u, 0u, 0u}, vrA;
#define AT_LOAD(t, kr0, kr1, vr) do { const int kr_ = ((t) < 4) ? ctx0 + (t) * 64 : lat0 + ((t) - 4) * 64; \
        kr0 = *(const u32x4*)(Kh + (size_t)(kr_ + kk0) * 384 + kq0 * 8); if (tid < 256) kr1 = *(const u32x4*)(Kh + (size_t)(kr_ + kk1) * 384 + kq1 * 8); \
        vr = *(const u32x4*)(Vh + (size_t)(kr_ + vk) * 256); } while (0)
#define AT_STORE(bufp, kr0, kr1, vr) do { unsigned char* b_ = (bufp); *(u32x4*)(b_ + kk0 * A3_KLD + kq0 * 16) = kr0; if (tid < 256) *(u32x4*)(b_ + kk1 * A3_KLD + kq1 * 16) = kr1; \
        *(u32x4*)(b_ + A3_VOFF + vk * A3_VLD + vq * 16) = vr; } while (0)
    const int troff = (4 * hi + ((lane & 15) >> 2)) * A3_VLD + (16 * ((lane >> 4) & 1) + 4 * (lane & 3)) * 2;
    const int koff = r32 * A3_KLD + hi * 16;
    f32x16 o0, o1, negm;
#pragma unroll
    for (int r = 0; r < 16; ++r) { o0[r] = 0.f; o1[r] = 0.f; negm[r] = 0.f; }
    float mhat = 0.f, lsum = 0.f;
    __syncthreads();
    AT_LOAD(0, krA0, krA1, vrA); AT_STORE(lds, krA0, krA1, vrA); AT_LOAD(1, krA0, krA1, vrA); AT_STORE(lds + A3_BUF, krA0, krA1, vrA);
    __syncthreads();
#define SBAR() __builtin_amdgcn_sched_barrier(0)
#define KRD(bufp, half, s) (*(const bf16x8*)((bufp) + koff + (half) * 32 * A3_KLD + (s) * 32))
#define MF(a, b, c) __builtin_amdgcn_mfma_f32_32x32x16_bf16(a, b, c, 0, 0, 0)
#define MFQ(a, b, c) ((VAR == 3) ? (c) : MF(a, b, c))
#define MFP(a, b, c) ((VAR == 2) ? (c) : MF(a, b, c))
#define EX4(S, r0) do { if (VAR == 1) { S[r0] *= 0.001f; S[r0 + 1] *= 0.001f; S[r0 + 2] *= 0.001f; S[r0 + 3] *= 0.001f; break; } S[r0] = __builtin_amdgcn_exp2f(S[r0]); S[r0 + 1] = __builtin_amdgcn_exp2f(S[r0 + 1]); S[r0 + 2] = __builtin_amdgcn_exp2f(S[r0 + 2]); S[r0 + 3] = __builtin_amdgcn_exp2f(S[r0 + 3]); lsum += (S[r0] + S[r0 + 1]) + (S[r0 + 2] + S[r0 + 3]); } while (0)
#define PK8(S, r0) __builtin_bit_cast(bf16x8, (u32x4){pk2(S[r0], S[r0 + 1]), pk2(S[r0 + 2], S[r0 + 3]), pk2(S[r0 + 4], S[r0 + 5]), pk2(S[r0 + 6], S[r0 + 7])})
#define VFR(vp) ({ const v4i16_t lo_ = lds_tr(vp), hi_ = lds_tr((vp) + 8 * A3_VLD); (bf16x8){lo_[0], lo_[1], lo_[2], lo_[3], hi_[0], hi_[1], hi_[2], hi_[3]}; })
#define MX3(a, b, c) __builtin_fmaxf(__builtin_fmaxf((a), (b)), (c))
#define AT_UPD(S0, S1, mx, FORCE) do { float mx_ = __builtin_fmaxf(mx, __shfl_xor(mx, 32)); \
        if ((FORCE) || __any(mx_ > 8.0f)) { const float dl_ = (FORCE) ? mx_ : __builtin_fmaxf(mx_, 0.f); mhat += dl_; \
            _Pragma("unroll") for (int r = 0; r < 16; ++r) { S0[r] -= dl_; S1[r] -= dl_; negm[r] = -mhat; } \
            if (!(FORCE)) { const float f_ = __builtin_amdgcn_exp2f(-dl_); _Pragma("unroll") for (int r = 0; r < 16; ++r) { o0[r] *= f_; o1[r] *= f_; } lsum *= f_; } } } while (0)
    f32x16 sa0, sa1, sb0, sb1;
    { const unsigned char* kb_ = lds;
#pragma unroll
      for (int s = 0; s < 6; ++s) { sa0 = MF(KRD(kb_, 0, s), qf[s], s == 0 ? negm : sa0); sa1 = MF(KRD(kb_, 1, s), qf[s], s == 0 ? negm : sa1); }
      float a_ = MX3(sa0[0], sa0[1], sa1[0]), b_ = MX3(sa0[2], sa0[3], sa1[1]); a_ = MX3(a_, sa1[2], sa1[3]);
#pragma unroll
      for (int r = 4; r < 16; r += 4) { a_ = MX3(a_, sa0[r], sa0[r + 1]); b_ = MX3(b_, sa0[r + 2], sa0[r + 3]); a_ = MX3(a_, sa1[r], sa1[r + 1]); b_ = MX3(b_, sa1[r + 2], sa1[r + 3]); }
      AT_UPD(sa0, sa1, __builtin_fmaxf(a_, b_), true); }
#define AT_STEP(C0, C1, N0, N1, t, bc_, HAS_NEXT) do { const int b1_ = ((bc_) == 2) ? 0 : (bc_) + 1, b2_ = (b1_ == 2) ? 0 : b1_ + 1; \
        const unsigned char* kb_ = lds + b1_ * A3_BUF; const unsigned char* vb_ = lds + (bc_) * A3_BUF + A3_VOFF + troff; \
        if (VAR != 4 && (t) + 2 < NT) AT_LOAD((t) + 2, krA0, krA1, vrA); \
        bf16x8 pw0_, pw1_, pw2_, pw3_; float ma_ = -3.0e38f, mb_ = -3.0e38f; \
        if (HAS_NEXT) { \
            bf16x8 k0_ = KRD(kb_, 0, 0), k1_ = KRD(kb_, 1, 0), k2_ = KRD(kb_, 0, 1), k3_ = KRD(kb_, 1, 1); SBAR(); \
            N0 = MFQ(k0_, qf[0], negm); EX4(C0, 0); k0_ = KRD(kb_, 0, 2); SBAR(); \
            N1 = MFQ(k1_, qf[0], negm); EX4(C0, 4); k1_ = KRD(kb_, 1, 2); SBAR(); \
            N0 = MFQ(k2_, qf[1], N0); EX4(C0, 8); k2_ = KRD(kb_, 0, 3); SBAR(); \
            N1 = MFQ(k3_, qf[1], N1); EX4(C0, 12); k3_ = KRD(kb_, 1, 3); SBAR(); \
            N0 = MFQ(k0_, qf[2], N0); EX4(C1, 0); k0_ = KRD(kb_, 0, 4); SBAR(); \
            N1 = MFQ(k1_, qf[2], N1); EX4(C1, 4); k1_ = KRD(kb_, 1, 4); SBAR(); \
            N0 = MFQ(k2_, qf[3], N0); EX4(C1, 8); k2_ = KRD(kb_, 0, 5); SBAR(); \
            N1 = MFQ(k3_, qf[3], N1); EX4(C1, 12); k3_ = KRD(kb_, 1, 5); SBAR(); \
            N0 = MFQ(k0_, qf[4], N0); pw0_ = PK8(C0, 0); SBAR(); \
            N1 = MFQ(k1_, qf[4], N1); pw1_ = PK8(C0, 8); SBAR(); \
            N0 = MFQ(k2_, qf[5], N0); pw2_ = PK8(C1, 0); SBAR(); \
            N1 = MFQ(k3_, qf[5], N1); pw3_ = PK8(C1, 8); SBAR(); \
        } else { EX4(C0, 0); EX4(C0, 4); EX4(C0, 8); EX4(C0, 12); EX4(C1, 0); EX4(C1, 4); EX4(C1, 8); EX4(C1, 12); pw0_ = PK8(C0, 0); pw1_ = PK8(C0, 8); pw2_ = PK8(C1, 0); pw3_ = PK8(C1, 8); SBAR(); } \
        { bf16x8 va_ = VFR(vb_), vb2_ = VFR(vb_ + 64); SBAR(); \
          bf16x8 vc_ = VFR(vb_ + 16 * A3_VLD), vd_ = VFR(vb_ + 16 * A3_VLD + 64); SBAR(); \
          o0 = MFP(va_, pw0_, o0); if (HAS_NEXT) { ma_ = MX3(N0[0], N0[1], N1[0]); mb_ = MX3(N0[2], N0[3], N1[1]); } SBAR(); \
          o1 = MFP(vb2_, pw0_, o1); if (HAS_NEXT) { ma_ = MX3(ma_, N1[2], N1[3]); mb_ = MX3(mb_, N0[4], N0[5]); } SBAR(); \
          va_ = VFR(vb_ + 32 * A3_VLD); vb2_ = VFR(vb_ + 32 * A3_VLD + 64); SBAR(); \
          o0 = MFP(vc_, pw1_, o0); if (HAS_NEXT) { ma_ = MX3(ma_, N0[6], N0[7]); mb_ = MX3(mb_, N1[4], N1[5]); } SBAR(); \
          o1 = MFP(vd_, pw1_, o1); if (HAS_NEXT) { ma_ = MX3(ma_, N1[6], N1[7]); mb_ = MX3(mb_, N0[8], N0[9]); } SBAR(); \
          vc_ = VFR(vb_ + 48 * A3_VLD); vd_ = VFR(vb_ + 48 * A3_VLD + 64); SBAR(); \
          o0 = MFP(va_, pw2_, o0); if (HAS_NEXT) { ma_ = MX3(ma_, N0[10], N0[11]); mb_ = MX3(mb_, N1[8], N1[9]); } SBAR(); \
          o1 = MFP(vb2_, pw2_, o1); if (HAS_NEXT) { ma_ = MX3(ma_, N1[10], N1[11]); mb_ = MX3(mb_, N0[12], N0[13]); } SBAR(); \
          if (HAS_NEXT) { ma_ = MX3(ma_, N0[14], N0[15]); mb_ = MX3(mb_, N1[12], N1[13]); } SBAR(); \
          o0 = MFP(vc_, pw3_, o0); if (HAS_NEXT) { ma_ = MX3(ma_, N1[14], N1[15]); } SBAR(); \
          o1 = MFP(vd_, pw3_, o1); SBAR(); } \
        if (HAS_NEXT) AT_UPD(N0, N1, __builtin_fmaxf(ma_, mb_), false); \
        if (VAR != 4 && (t) + 2 < NT) AT_STORE(lds + b2_ * A3_BUF, krA0, krA1, vrA); \
        if (VAR != 4) __syncthreads(); } while (0)
    int bc = 0, t = 0;
    for (; t + 2 < NT; t += 2) {
        AT_STEP(sa0, sa1, sb0, sb1, t, bc, true); bc = (bc == 2) ? 0 : bc + 1;
        AT_STEP(sb0, sb1, sa0, sa1, t + 1, bc, true); bc = (bc == 2) ? 0 : bc + 1;
    }
    AT_STEP(sa0, sa1, sb0, sb1, t, bc, true); bc = (bc == 2) ? 0 : bc + 1;
    AT_STEP(sb0, sb1, sa0, sa1, t + 1, bc, false);
#undef AT_LOAD
#undef AT_STORE
#undef SBAR
#undef KRD
#undef MF
#undef MFQ
#undef MFP
#undef EX4
#undef PK8
#undef VFR
#undef MX3
#undef AT_UPD
#undef AT_STEP
    lsum += __shfl_xor(lsum, 32);
    const float inv = 1.f / lsum;
    bf16* orow = MIX + (size_t)qrow * D + h * 64;
#pragma unroll
    for (int g = 0; g < 4; ++g) {
        st_bf16x4(orow + 8 * g + 4 * hi, (f32x4){o0[4 * g] * inv, o0[4 * g + 1] * inv, o0[4 * g + 2] * inv, o0[4 * g + 3] * inv});
        st_bf16x4(orow + 32 + 8 * g + 4 * hi, (f32x4){o1[4 * g] * inv, o1[4 * g + 1] * inv, o1[4 * g + 2] * inv, o1[4 * g + 3] * inv});
    }
}

constexpr int NCC = 66;
DEVI int chunk_row0(int b, int cc) { return cc < 2 ? NLAT + b * CL + cc * 128 : b * SEQ + (cc - 2) * 128; }
constexpr int SC_VEC = 0;
constexpr int SC_KT = 2048;
constexpr int SC_VF = SC_KT + 64 * 136 * 2;
constexpr int SC_VB = SC_VF + 64 * 136 * 2;
constexpr int SC_X = SC_VB + 64 * 136 * 2;
constexpr int SC_SSQ = SC_X + 2048;
constexpr int SC_END = SC_SSQ + 8192;
constexpr int TS = 136;

DEVI void scan_vectors(const P& p, int l, bool ret, int h, int row0, float* vec, int wid, int lane) {
    const float* dt = (const float*)(p.ws + WS_DT);
    if (ret) {
        if (wid == 0) { const float lf = IN(15)[l * 8 + h], lb = IN(15)[l * 8 + 4 + h];
            const float laf = -log1pf(__expf(-lf)), lab = -log1pf(__expf(-lb));
#pragma unroll
            for (int e = 0; e < 2; ++e) { const int j = lane * 2 + e; vec[j] = (float)(j + 1) * laf; vec[128 + j] = (float)(128 - j) * lab; vec[256 + j] = 1.f; vec[384 + j] = 1.f; } }
    } else if (wid < 2) {
        const int dir = wid; const size_t r = (size_t)(row0 + lane * 2);
        const float x0 = dt[r * 32 + 16 + dir * 8 + h], x1 = dt[(r + 1) * 32 + 16 + dir * 8 + h];
        vec[256 + dir * 128 + lane * 2] = dt[r * 32 + dir * 8 + h]; vec[256 + dir * 128 + lane * 2 + 1] = dt[(r + 1) * 32 + dir * 8 + h];
        float s = x0 + x1;
#pragma unroll
        for (int o = 1; o < 64; o <<= 1) { const float t = __shfl_up(s, o); if (lane >= o) s += t; }
        if (dir == 0) { vec[lane * 2] = s - x1; vec[lane * 2 + 1] = s; }
        else { const float tot = __shfl(s, 63); vec[128 + lane * 2] = tot - (s - x1) + x0; vec[128 + lane * 2 + 1] = tot - s + x1; }
    }
}
DEVI void scan_ptrs(const P& p, bool ret, int h, const bf16*& qb, const bf16*& kb, const bf16*& vb, int& ld) {
    if (ret) { const bf16* proj = (const bf16*)(p.ws + WS_PROJ); qb = proj + C_RQ + h * 64; kb = proj + C_RK + h * 64; vb = proj + C_RV + h * 64; ld = INWP; }
    else { const bf16* xbc = (const bf16*)(p.ws + WS_XBC); qb = xbc + 640 + (h >> 2) * 64; kb = xbc + 512 + (h >> 2) * 64; vb = xbc + h * 64; ld = 768; }
}
DEVI void c3_stage_rows(unsigned char* dst, int rs, const bf16* src, int ld, int tid) {
#pragma unroll
    for (int i = 0; i < 2; ++i) { const int piece = tid + NTHREADS * i, row = piece >> 3, part = piece & 7; *(u32x4*)(dst + row * rs + part * 16) = *(const u32x4*)(src + (size_t)row * ld + part * 8); }
}
struct ConvW { f32x4 w0[2], w1[2], w2[2], b[2]; };
DEVI ConvW conv_w(const float* cw, const float* cb, int c0) { ConvW w;
#pragma unroll
    for (int k = 0; k < 2; ++k) { w.w0[k] = *(const f32x4*)(cw + c0 + 4 * k); w.w1[k] = *(const f32x4*)(cw + 768 + c0 + 4 * k); w.w2[k] = *(const f32x4*)(cw + 1536 + c0 + 4 * k); w.b[k] = *(const f32x4*)(cb + c0 + 4 * k); }
    return w; }
DEVI void unpack8(const u32x4 v, f32x4 (&x)[2]) { x[0] = (f32x4){bf2f(v.x & 0xffff), bf2f(v.x >> 16), bf2f(v.y & 0xffff), bf2f(v.y >> 16)}; x[1] = (f32x4){bf2f(v.z & 0xffff), bf2f(v.z >> 16), bf2f(v.w & 0xffff), bf2f(v.w >> 16)}; }
DEVI void conv8(const bf16* proj, size_t row, bool has_prev, bool has_next, int c0, const ConvW& w, f32x4 (&y)[2]) {
    const bf16* pr = proj + row * INWP + C_XBC + c0; const u32x4 z = {0u, 0u, 0u, 0u};
    const u32x4 r0 = *(const u32x4*)pr, rm = has_prev ? *(const u32x4*)(pr - INWP) : z, rp = has_next ? *(const u32x4*)(pr + INWP) : z;
    f32x4 x0[2], xm[2], xp[2]; unpack8(r0, x0); unpack8(rm, xm); unpack8(rp, xp);
#pragma unroll
    for (int k = 0; k < 2; ++k) { y[k] = w.w0[k] * xm[k] + w.w1[k] * x0[k] + w.w2[k] * xp[k] + w.b[k];
#pragma unroll
        for (int i = 0; i < 4; ++i) y[k][i] = siluf(y[k][i]); }
}
DEVI u32x4 pack8(const f32x4 (&y)[2], float sc) { return (u32x4){pk2(y[0][0] * sc, y[0][1] * sc), pk2(y[0][2] * sc, y[0][3] * sc), pk2(y[1][0] * sc, y[1][1] * sc), pk2(y[1][2] * sc, y[1][3] * sc)}; }
constexpr int SA_RS = 192, SA_K = 8192, SA_VF = SA_K + 128 * SA_RS, SA_VB = SA_VF + 128 * SA_RS, SA_V2 = 2 * 128 * SA_RS  , SA_END = SA_VF + 2 * SA_V2;
DEVI void scanA_unit(const P& p, int l, int uidx, unsigned char* lds) {
    const int tid = otid(), wid = __builtin_amdgcn_readfirstlane(tid >> 6), lane = tid & 63, r32 = lane & 31, hi = lane >> 5;
    const int g4 = uidx % 3, bc = uidx / 3, b = bc / NCC, cc = bc % NCC, row0 = chunk_row0(b, cc);
    const bool ret = (g4 == 0);
    float* vec4 = (float*)(lds + SC_VEC);
    float* ST = (float*)(p.ws + WS_ST); float* CDp = (float*)(p.ws + WS_CD);
    const bf16* proj = (const bf16*)(p.ws + WS_PROJ); bf16* xbcw = (bf16*)(p.ws + WS_XBC); const float* cw = IN(16) + (size_t)l * 3 * 768; const float* cb = IN(17) + l * 768;
    const int troff = (4 * hi + ((lane & 15) >> 2)) * SA_RS + (16 * ((lane >> 4) & 1) + 4 * (lane & 3)) * 2;
    __syncthreads();
    { const int hq = wid >> 1, h = ret ? hq : (g4 - 1) * 4 + hq; scan_vectors(p, l, ret, h, row0, vec4 + hq * 512, wid & 1, lane); }
    __syncthreads();
    { const int hq = tid >> 7, t = tid & 127, h = ret ? hq : (g4 - 1) * 4 + hq, hh = ret ? hq : 4 + h; const size_t item = (size_t)(b * NCC + cc) * 12 + hh; const float* vv = vec4 + hq * 512;
      float* vg = (float*)(p.ws + WS_VEC) + item * 512; vg[t] = vv[t]; vg[128 + t] = vv[128 + t]; vg[256 + t] = vv[t] - __logf(vv[256 + t]); vg[384 + t] = vv[128 + t] - __logf(vv[384 + t]);
      if (t == 0) { CDp[item * 2] = __expf(vv[127]); CDp[item * 2 + 1] = __expf(vv[128]); } }
    const int dir = wid >> 2, nt = (wid >> 1) & 1, pt = wid & 1;
    if (ret) {
        for (int hq = 0; hq < 4; ++hq) {
            const int h = hq; const size_t item = (size_t)(b * NCC + cc) * 12 + h;
            const bf16 *qb, *kb, *vb; int ld; scan_ptrs(p, true, h, qb, kb, vb, ld);
            const float* vec = vec4 + hq * 512;
            if (hq > 0) __syncthreads();
            c3_stage_rows(lds + SA_K, SA_RS, kb + (size_t)row0 * ld, ld, tid);
#pragma unroll
            for (int i = 0; i < 2; ++i) { const int piece = tid + NTHREADS * i, j = piece >> 3, part = piece & 7; const u32x4 v = *(const u32x4*)(vb + (size_t)(row0 + j) * ld + part * 8);
                const float sf = __expf(vec[127] - vec[j]) * vec[256 + j], sb = __expf(vec[128] - vec[128 + j]) * vec[384 + j];
                f32x4 x[2]; unpack8(v, x);
                *(u32x4*)(lds + SA_VF + j * SA_RS + part * 16) = pack8(x, sf); *(u32x4*)(lds + SA_VB + j * SA_RS + part * 16) = pack8(x, sb); }
            __syncthreads();
            const unsigned char* ka = lds + SA_K + nt * 64 + troff; const unsigned char* va = lds + (dir ? SA_VB : SA_VF) + pt * 64 + troff;
            f32x16 acc;
#pragma unroll
            for (int r = 0; r < 16; ++r) acc[r] = 0.f;
#pragma unroll
            for (int s = 0; s < 8; ++s) { const v4i16_t al = lds_tr(ka + (16 * s) * SA_RS), ah = lds_tr(ka + (16 * s + 8) * SA_RS), bl = lds_tr(va + (16 * s) * SA_RS), bh = lds_tr(va + (16 * s + 8) * SA_RS);
                const bf16x8 af = {al[0], al[1], al[2], al[3], ah[0], ah[1], ah[2], ah[3]}, bf = {bl[0], bl[1], bl[2], bl[3], bh[0], bh[1], bh[2], bh[3]};
                acc = __builtin_amdgcn_mfma_f32_32x32x16_bf16(af, bf, acc, 0, 0, 0); }
            float* o = ST + (item * 2 + dir) * 4096 + (size_t)(pt * 32 + r32) * 64 + nt * 32 + 4 * hi;
#pragma unroll
            for (int g = 0; g < 4; ++g) *(f32x4*)(o + 8 * g) = (f32x4){acc[4 * g], acc[4 * g + 1], acc[4 * g + 2], acc[4 * g + 3]};
        }
    } else {
        const int g = g4 - 1, part = tid & 7; const int pos0 = (cc < 2) ? cc * 128 : (cc - 2) * 128, Ls = (cc < 2) ? CL : SEQ;
        for (int hp = 0; hp < 2; ++hp) {
            if (hp > 0) __syncthreads();
            if (hp == 0) {
#pragma unroll 1
                for (int which = 0; which < 2; ++which) { const int c0 = (which == 0 ? 512 : 640) + g * 64 + part * 8; const ConvW w = conv_w(cw, cb, c0);
#pragma unroll
                    for (int i = 0; i < 2; ++i) { const int j = (tid + NTHREADS * i) >> 3; f32x4 y[2]; conv8(proj, (size_t)(row0 + j), pos0 + j > 0, pos0 + j < Ls - 1, c0, w, y);
                        const u32x4 o = pack8(y, 1.f); *(u32x4*)(xbcw + (size_t)(row0 + j) * 768 + c0) = o; if (which == 0) *(u32x4*)(lds + SA_K + j * SA_RS + part * 16) = o; } } }
#pragma unroll
            for (int e = 0; e < 2; ++e) { const int hq = hp * 2 + e, h = g * 4 + hq; const float* vec = vec4 + hq * 512; const int c0 = h * 64 + part * 8; const ConvW w = conv_w(cw, cb, c0);
#pragma unroll
                for (int i = 0; i < 2; ++i) { const int j = (tid + NTHREADS * i) >> 3; f32x4 y[2]; conv8(proj, (size_t)(row0 + j), pos0 + j > 0, pos0 + j < Ls - 1, c0, w, y);
                    const float sf = __expf(vec[127] - vec[j]) * vec[256 + j], sb = __expf(vec[128] - vec[128 + j]) * vec[384 + j];
                    *(u32x4*)(xbcw + (size_t)(row0 + j) * 768 + c0) = pack8(y, 1.f);
                    *(u32x4*)(lds + SA_VF + e * SA_V2 + j * SA_RS + part * 16) = pack8(y, sf); *(u32x4*)(lds + SA_VB + e * SA_V2 + j * SA_RS + part * 16) = pack8(y, sb); } }
            __syncthreads();
            const unsigned char* ka = lds + SA_K + nt * 64 + troff;
            f32x16 acc0, acc1;
#pragma unroll
            for (int r = 0; r < 16; ++r) { acc0[r] = 0.f; acc1[r] = 0.f; }
            const unsigned char* va = lds + (dir ? SA_VB : SA_VF) + pt * 64 + troff;
#pragma unroll
            for (int s = 0; s < 8; ++s) { const v4i16_t al = lds_tr(ka + (16 * s) * SA_RS), ah = lds_tr(ka + (16 * s + 8) * SA_RS);
                const bf16x8 af = {al[0], al[1], al[2], al[3], ah[0], ah[1], ah[2], ah[3]};
                { const v4i16_t bl = lds_tr(va + (16 * s) * SA_RS), bh = lds_tr(va + (16 * s + 8) * SA_RS); const bf16x8 bf = {bl[0], bl[1], bl[2], bl[3], bh[0], bh[1], bh[2], bh[3]}; acc0 = __builtin_amdgcn_mfma_f32_32x32x16_bf16(af, bf, acc0, 0, 0, 0); }
                { const v4i16_t bl = lds_tr(va + SA_V2 + (16 * s) * SA_RS), bh = lds_tr(va + SA_V2 + (16 * s + 8) * SA_RS); const bf16x8 bf = {bl[0], bl[1], bl[2], bl[3], bh[0], bh[1], bh[2], bh[3]}; acc1 = __builtin_amdgcn_mfma_f32_32x32x16_bf16(af, bf, acc1, 0, 0, 0); } }
#pragma unroll
            for (int e = 0; e < 2; ++e) { const int hq = hp * 2 + e, hh = 4 + g * 4 + hq; const size_t item = (size_t)(b * NCC + cc) * 12 + hh;
                float* o = ST + (item * 2 + dir) * 4096 + (size_t)(pt * 32 + r32) * 64 + nt * 32 + 4 * hi;
#pragma unroll
                for (int gq = 0; gq < 4; ++gq) *(f32x4*)(o + 8 * gq) = e ? (f32x4){acc1[4 * gq], acc1[4 * gq + 1], acc1[4 * gq + 2], acc1[4 * gq + 3]} : (f32x4){acc0[4 * gq], acc0[4 * gq + 1], acc0[4 * gq + 2], acc0[4 * gq + 3]}; }
        }
    }
    __syncthreads();
}
DEVI void scanB_slab(const P& p, int slab, int nthr, int epb) {
    const int tid = otid(); if (tid >= nthr) return;
    const int f = slab * epb + tid * 2; const int bhd = f >> 12, e = f & 4095, dir = bhd & 1, bh = bhd >> 1, b = bh / 12, hh = bh % 12;
    const float* ST = (const float*)(p.ws + WS_ST); const float* CDp = (const float*)(p.ws + WS_CD); bf16* HT = (bf16*)(p.ws + WS_HT);
    f32x2 H = {0.f, 0.f};
    for (int base = 0; base < NCC; base += 6) {
        f32x2 s[6]; float d[6]; size_t off[6];
#pragma unroll
        for (int i = 0; i < 6; ++i) { const int step = base + i; const int cc = dir == 0 ? step : (step < 2 ? 1 - step : 67 - step);
            const size_t item = (size_t)(b * NCC + cc) * 12 + hh; off[i] = (item * 2 + dir) * 4096 + e; s[i] = *(const f32x2*)(ST + off[i]); d[i] = CDp[item * 2 + dir]; }
#pragma unroll
        for (int i = 0; i < 6; ++i) { *(unsigned*)(HT + off[i]) = pk2(H[0], H[1]); H = H * d[i] + s[i]; }
    }
}
constexpr int C3_RSV = 192, C3_RSK = 144;
constexpr int C3_V = 0, C3_K = 2 * 128 * C3_RSV, C3_H = C3_K + 2 * 128 * C3_RSK, C3_VEC = C3_H + 2 * 128 * C3_RSK, C3_X = C3_VEC + 2 * 2048, C3_END = C3_X + 1024;
template <bool RET>
DEVI void scanC_unit(const P& p, int l, int bc, unsigned char* lds, int tid, int wid, int lane) {
    const int r32 = lane & 31, hi = lane >> 5;
    const int it_ = wid & 3, hsub = wid >> 2, b = bc / NCC, cc = bc % NCC, row0 = chunk_row0(b, cc);
    const bf16* HT = (const bf16*)(p.ws + WS_HT); const bf16* proj = (const bf16*)(p.ws + WS_PROJ); const bf16* xbc = (const bf16*)(p.ws + WS_XBC); bf16* MIX = (bf16*)(p.ws + WS_HM); const float* VECG = (const float*)(p.ws + WS_VEC);
    const int i = it_ * 32 + r32; const size_t rowi = (size_t)(row0 + i);
    constexpr int ld = RET ? INWP : 768;
    const unsigned char* Vl = lds + C3_V + hsub * 128 * C3_RSV; const unsigned char* Kl = lds + C3_K + hsub * 128 * C3_RSK; const unsigned char* Hl = lds + C3_H + hsub * 128 * C3_RSK; const float* vec = (const float*)(lds + C3_VEC + hsub * 2048);
    const int trq = (lane & 15) >> 2, trp = lane & 3, trg = (lane >> 4) & 1;
    const int troff = (4 * hi + trq) * C3_RSV + (16 * trg + 4 * trp) * 2;
    float ssqk[4] = {0.f, 0.f, 0.f, 0.f};
#pragma unroll 1
    for (int step = 0; step < (RET ? 2 : 4); ++step) {
        __syncthreads();
#pragma unroll
        for (int hs = 0; hs < 2; ++hs) { const int h = RET ? hs * 2 + step : hs * 4 + step, hh = RET ? h : 4 + h; const size_t item = (size_t)(b * NCC + cc) * 12 + hh;
            const bf16* vb = RET ? proj + C_RV + h * 64 : xbc + h * 64; const bf16* kb = RET ? proj + C_RK + h * 64 : xbc + 512 + hs * 64;
            c3_stage_rows(lds + C3_V + hs * 128 * C3_RSV, C3_RSV, vb + (size_t)row0 * ld, ld, tid);
            if (RET || step == 0) c3_stage_rows(lds + C3_K + hs * 128 * C3_RSK, C3_RSK, kb + (size_t)row0 * ld, ld, tid);
            c3_stage_rows(lds + C3_H + hs * 128 * C3_RSK, C3_RSK, HT + item * 2 * 4096, 64, tid);
            if ((tid >> 7) == hs) *(u32x4*)(lds + C3_VEC + hs * 2048 + (tid & 127) * 16) = *(const u32x4*)(VECG + item * 512 + (tid & 127) * 4); }
        __syncthreads();
        const int h = RET ? hsub * 2 + step : hsub * 4 + step;
        const bf16* qb = RET ? proj + C_RQ + h * 64 : xbc + 640 + hsub * 64;
        bf16x8 qf[4];
#pragma unroll
        for (int s = 0; s < 4; ++s) qf[s] = *(const bf16x8*)(qb + rowi * ld + s * 16 + hi * 8);
        const float Afi = vec[i], Bbi = vec[128 + i];
        f32x16 y0, y1;
#pragma unroll
        for (int r = 0; r < 16; ++r) { y0[r] = 0.f; y1[r] = 0.f; }
#pragma unroll 2
        for (int jt = 0; jt < 4; ++jt) {
            f32x16 st;
#pragma unroll
            for (int r = 0; r < 16; ++r) st[r] = 0.f;
#pragma unroll
            for (int s = 0; s < 4; ++s) { const bf16x8 kf = *(const bf16x8*)(Kl + (jt * 32 + r32) * C3_RSK + (s * 16 + hi * 8) * 2); st = __builtin_amdgcn_mfma_f32_32x32x16_bf16(kf, qf[s], st, 0, 0, 0); }
#pragma unroll
            for (int g = 0; g < 4; ++g) { const int j0 = jt * 32 + 8 * g + 4 * hi;
                const f32x4 afp = *(const f32x4*)(vec + 256 + j0), bbp = *(const f32x4*)(vec + 384 + j0);
#pragma unroll
                for (int e = 0; e < 4; ++e) { const int j = j0 + e; float f;
                    if (jt < it_) f = __expf(Afi - afp[e]);
                    else if (jt > it_) f = __expf(Bbi - bbp[e]);
                    else { const float ff = (j <= i) ? __expf(Afi - afp[e]) : 0.f; const bool bm = RET ? (j > i) : (j >= i); const float fb = bm ? __expf(Bbi - bbp[e]) : 0.f; f = ff + fb; }
                    st[4 * g + e] *= f; } }
#pragma unroll
            for (int s2 = 0; s2 < 2; ++s2) {
                u32x4 pw; pw.x = pk2(st[8 * s2 + 0], st[8 * s2 + 1]); pw.y = pk2(st[8 * s2 + 2], st[8 * s2 + 3]); pw.z = pk2(st[8 * s2 + 4], st[8 * s2 + 5]); pw.w = pk2(st[8 * s2 + 6], st[8 * s2 + 7]);
                const bf16x8 pb = __builtin_bit_cast(bf16x8, pw);
#pragma unroll
                for (int pt = 0; pt < 2; ++pt) { const unsigned char* vp = Vl + (jt * 32 + 16 * s2) * C3_RSV + pt * 64 + troff;
                    const v4i16_t lo = lds_tr(vp), hi2 = lds_tr(vp + 8 * C3_RSV);
                    const bf16x8 va = {lo[0], lo[1], lo[2], lo[3], hi2[0], hi2[1], hi2[2], hi2[3]};
                    if (pt == 0) y0 = __builtin_amdgcn_mfma_f32_32x32x16_bf16(va, pb, y0, 0, 0, 0); else y1 = __builtin_amdgcn_mfma_f32_32x32x16_bf16(va, pb, y1, 0, 0, 0); }
            }
        }
        { const float ef = __expf(Afi), eb = __expf(Bbi);
#pragma unroll
          for (int pt = 0; pt < 2; ++pt) { f32x16 tf, tb;
#pragma unroll
              for (int r = 0; r < 16; ++r) { tf[r] = 0.f; tb[r] = 0.f; }
              const unsigned char* hf = Hl + (pt * 32 + r32) * C3_RSK + hi * 16;
#pragma unroll
              for (int s = 0; s < 4; ++s) { tf = __builtin_amdgcn_mfma_f32_32x32x16_bf16(*(const bf16x8*)(hf + s * 32), qf[s], tf, 0, 0, 0); tb = __builtin_amdgcn_mfma_f32_32x32x16_bf16(*(const bf16x8*)(hf + 64 * C3_RSK + s * 32), qf[s], tb, 0, 0, 0); }
#pragma unroll
              for (int r = 0; r < 16; ++r) { if (pt == 0) y0[r] += ef * tf[r] + eb * tb[r]; else y1[r] += ef * tf[r] + eb * tb[r]; } } }
        float* Tw = (float*)(lds + (wid < 5 ? C3_V + wid * 8704 : C3_H + (wid - 5) * 8704));
        __syncthreads();
        if (RET) {
            float s1 = 0.f, s2 = 0.f;
#pragma unroll
            for (int r = 0; r < 16; ++r) { y0[r] *= 0.125f; y1[r] *= 0.125f; s1 += y0[r] + y1[r]; s2 += y0[r] * y0[r] + y1[r] * y1[r]; }
            s1 += __shfl_xor(s1, 32); s2 += __shfl_xor(s2, 32);
            const float mu = s1 * (1.f / 64.f), var = fmaxf(s2 * (1.f / 64.f) - mu * mu, 0.f), rs = __builtin_amdgcn_rsqf(var + EPS);
#pragma unroll
            for (int r = 0; r < 16; ++r) { y0[r] = (y0[r] - mu) * rs; y1[r] = (y1[r] - mu) * rs; }
        }
#pragma unroll
        for (int g = 0; g < 4; ++g) { *(f32x4*)(Tw + r32 * 68 + 8 * g + 4 * hi) = (f32x4){y0[4 * g], y0[4 * g + 1], y0[4 * g + 2], y0[4 * g + 3]}; *(f32x4*)(Tw + r32 * 68 + 32 + 8 * g + 4 * hi) = (f32x4){y1[4 * g], y1[4 * g + 1], y1[4 * g + 2], y1[4 * g + 3]}; }
        asm volatile("s_waitcnt lgkmcnt(0)" ::: "memory");
        { const int ch = lane & 7; const float dsk = RET ? 0.f : IN(20)[l * 8 + h];
#pragma unroll
          for (int k = 0; k < 4; ++k) { const int tr = (lane >> 3) + 8 * k; const size_t rowt = (size_t)(row0 + it_ * 32 + tr);
              f32x4 ya[2] = {*(const f32x4*)(Tw + tr * 68 + ch * 8), *(const f32x4*)(Tw + tr * 68 + ch * 8 + 4)};
              if (RET) { f32x4 gv[2]; unpack8(*(const u32x4*)(proj + rowt * INWP + C_RG + h * 64 + ch * 8), gv);
#pragma unroll
                  for (int q = 0; q < 2; ++q)
#pragma unroll
                      for (int e = 0; e < 4; ++e) ya[q][e] *= siluf(gv[q][e]);
                  *(u32x4*)(MIX + rowt * D + 256 + h * 64 + ch * 8) = pack8(ya, 1.f);
              } else { f32x4 xv[2], zv[2]; unpack8(*(const u32x4*)(xbc + rowt * 768 + h * 64 + ch * 8), xv); unpack8(*(const u32x4*)(proj + rowt * INWP + C_Z + h * 64 + ch * 8), zv); float sq = 0.f;
#pragma unroll
                  for (int q = 0; q < 2; ++q)
#pragma unroll
                      for (int e = 0; e < 4; ++e) { ya[q][e] = (ya[q][e] + xv[q][e] * dsk) * siluf(zv[q][e]); sq += ya[q][e] * ya[q][e]; }
                  *(u32x4*)(MIX + rowt * D + 512 + h * 64 + ch * 8) = pack8(ya, 1.f);
                  sq += __shfl_xor(sq, 1); sq += __shfl_xor(sq, 2); sq += __shfl_xor(sq, 4); ssqk[k] += sq; } } }
    }
    if (!RET) {
        float* X = (float*)(lds + C3_X);
#pragma unroll
        for (int k = 0; k < 4; ++k) if ((lane & 7) == 0) X[hsub * 128 + it_ * 32 + (lane >> 3) + 8 * k] = ssqk[k];
        asm volatile("s_waitcnt vmcnt(0)" ::: "memory");
        __syncthreads();
        const float* nw = IN(21) + l * 512; const int ch = lane & 7;
#pragma unroll 1
        for (int h = hsub * 4; h < hsub * 4 + 4; ++h) { f32x4 wv[2] = {*(const f32x4*)(nw + h * 64 + ch * 8), *(const f32x4*)(nw + h * 64 + ch * 8 + 4)};
#pragma unroll
            for (int k = 0; k < 4; ++k) { const int tr = it_ * 32 + (lane >> 3) + 8 * k; const float rstd = __builtin_amdgcn_rsqf((X[tr] + X[128 + tr]) * (1.f / 512.f) + EPS);
                bf16* mp = MIX + (size_t)(row0 + tr) * D + 512 + h * 64 + ch * 8; f32x4 v[2]; unpack8(*(const u32x4*)mp, v);
                v[0] = v[0] * wv[0] * rstd; v[1] = v[1] * wv[1] * rstd; *(u32x4*)mp = pack8(v, 1.f); } }
    }
    __syncthreads();
}
DEVI void ph_scanC(const P& p, int l, unsigned char* lds) {
    const int tid = otid(), wid = __builtin_amdgcn_readfirstlane(tid >> 6), lane = tid & 63;
    const int NU = 2 * NCC;
    if (gridDim.x == 256) {
        const int c = blockIdx.x;
        if (c < NU) scanC_unit<false>(p, l, c, lds, tid, wid, lane);
        else { const int r = c - NU; scanC_unit<true>(p, l, r, lds, tid, wid, lane); if (r + 124 < NU) scanC_unit<true>(p, l, r + 124, lds, tid, wid, lane); }
    } else {
        for (int u = blockIdx.x; u < 2 * NU; u += gridDim.x) { if (u < NU) scanC_unit<false>(p, l, u, lds, tid, wid, lane); else scanC_unit<true>(p, l, u - NU, lds, tid, wid, lane); }
    }
}
DEVI void ph_scanA(const P& p, int l, unsigned char* lds) { for (int u = gridDim.x - 1 - blockIdx.x; u < 2 * NCC * 3; u += gridDim.x) scanA_unit(p, l, u, lds); }
DEVI void ph_mixer(const P& p, int l, unsigned char* lds) {
    for (int u = blockIdx.x; u < 256; u += gridDim.x) scanB_slab(p, u, 384, 768);
    for (int a = blockIdx.x; a < 256; a += gridDim.x) attn_unit<0>(p, (a & 7) * 32 + (a >> 3), lds, (bf16*)(p.ws + WS_HM));
#if ATTN_PROBE
    if (l == 0) { __syncthreads(); for (int a = blockIdx.x; a < 256; a += gridDim.x) attn_unit<ATTN_PROBE>(p, (a & 7) * 32 + (a >> 3), lds, (bf16*)p.out); }
#endif
    if (l == 0) for (int a = blockIdx.x; a < 8; a += gridDim.x) attn_unit<0>(p, 256 + a, lds, (bf16*)(p.ws + WS_HM));
}

DEVI void ph_sort(const P& p, unsigned char* lds) {
    const int tid = otid(), wid = tid >> 6, lane = tid & 63;
    const int* rt_e = (const int*)(p.ws + WS_RT); int* rt_pos = (int*)(p.ws + WS_RT + 256 * 1024); int* tab = (int*)(p.ws + WS_RT + 384 * 1024); int* rt_tok = (int*)(p.ws + WS_RT + 640 * 1024);
    int* sh = (int*)lds;
    const int G = gridDim.x, R = (NLAT + G - 1) / G;
    for (int blk = blockIdx.x; blk * R < NLAT; blk += G) {
        const int r0 = blk * R, r1 = (r0 + R < NLAT) ? r0 + R : NLAT;
        int ct[8], cb[8];
#pragma unroll
        for (int e = 0; e < 8; ++e) { ct[e] = 0; cb[e] = 0; }
        for (int i = tid; i < NLAT * 2; i += NTHREADS) { const int e = rt_e[i]; const bool bef = (i >> 1) < r0;
#pragma unroll
            for (int x = 0; x < 8; ++x) { const int hit = (e == x) ? 1 : 0; ct[x] += hit; cb[x] += bef ? hit : 0; } }
#pragma unroll
        for (int e = 0; e < 8; ++e) {
#pragma unroll
            for (int o = 1; o < 64; o <<= 1) { ct[e] += __shfl_xor(ct[e], o); cb[e] += __shfl_xor(cb[e], o); }
        }
        __syncthreads();
        if (lane == 0) {
#pragma unroll
            for (int e = 0; e < 8; ++e) { sh[wid * 8 + e] = ct[e]; sh[64 + wid * 8 + e] = cb[e]; } }
        __syncthreads();
        if (tid == 0) { int start = 0, nt = 0;
            for (int e = 0; e < 8; ++e) { int tot = 0, bef = 0; for (int w = 0; w < 8; ++w) { tot += sh[w * 8 + e]; bef += sh[64 + w * 8 + e]; }
                sh[128 + e] = start; sh[136 + e] = start + bef; sh[144 + e] = tot; const int ntile = (tot + 255) >> 8;
                if (blk == 0) { for (int t = 0; t < ntile; ++t) tab[1 + nt + t] = e; }
                nt += ntile; start += ntile * 256; }
            if (blk == 0) tab[0] = nt; }
        __syncthreads();
        { const int n_ent = (r1 - r0) * 2; const bool valid = tid < n_ent; const int e = valid ? rt_e[r0 * 2 + tid] : -1; int rank = 0;
#pragma unroll
          for (int x = 0; x < 8; ++x) { const unsigned long long m = __ballot(e == x); if (e == x) rank = __popcll(m & ((1ull << lane) - 1ull)); if (lane == 0) sh[160 + wid * 8 + x] = __popcll(m); }
          __syncthreads();
          if (valid) { int pos = sh[136 + e] + rank; for (int w = 0; w < wid; ++w) pos += sh[160 + w * 8 + e]; sh[256 + tid] = pos; rt_pos[r0 * 2 + tid] = pos; } }
        __syncthreads();
        { const int n_ent = (r1 - r0) * 2; if (tid < n_ent) rt_tok[sh[256 + tid]] = r0 + (tid >> 1); }
        if (blk == 0) { for (int e = 0; e < 8; ++e) { const int tot = sh[144 + e], beg = sh[128 + e] + tot, end = sh[128 + e] + ((tot + 255) & ~255); for (int i = beg + tid; i < end; i += NTHREADS) rt_tok[i] = 0; } }
        __syncthreads();
    }
}
DEVI void ph_final(const P& p) {
    const int tid = otid(), wid = tid >> 6, lane = tid & 63;
    const float* rt_g = (const float*)(p.ws + WS_RT + 128 * 1024); const int* rt_pos = (const int*)(p.ws + WS_RT + 256 * 1024);
    const bf16* YS = (const bf16*)(p.ws + WS_HS); const float* modv = (const float*)(p.ws + WS_MODV) + (size_t)1 * 3 * 6144; const float* fw = IN(29);
    const int nw = gridDim.x * NWAVES, rpw = (NLAT + nw - 1) / nw, gw = blockIdx.x * NWAVES + wid;
    const int row0 = gw * rpw, row1 = (row0 + rpw < NLAT) ? row0 + rpw : NLAT;
    f32x4 fwv[4], gv[4]; int rc = -1;
#pragma unroll
    for (int j = 0; j < 4; ++j) fwv[j] = *(const f32x4*)(fw + (j * 64 + lane) * 4);
    for (int row = row0; row < row1; ++row) {
        const int b = row >> 13; float* x = p.out + (size_t)row * D;
        if (b != rc) { rc = b;
#pragma unroll
            for (int j = 0; j < 4; ++j) gv[j] = *(const f32x4*)(modv + b * 6144 + 5 * 1024 + (j * 64 + lane) * 4); }
        const float g0 = rt_g[row * 2], g1 = rt_g[row * 2 + 1]; const bf16* y0 = YS + (size_t)rt_pos[row * 2] * D; const bf16* y1 = YS + (size_t)rt_pos[row * 2 + 1] * D;
        f32x4 v[4]; float ss = 0.f;
#pragma unroll
        for (int j = 0; j < 4; ++j) { const int c0 = (j * 64 + lane) * 4; const f32x4 xv = *(const f32x4*)(x + c0); const u32x2 a = *(const u32x2*)(y0 + c0), c = *(const u32x2*)(y1 + c0);
            const f32x4 ya = {bf2f(a.x & 0xffff), bf2f(a.x >> 16), bf2f(a.y & 0xffff), bf2f(a.y >> 16)}, yb = {bf2f(c.x & 0xffff), bf2f(c.x >> 16), bf2f(c.y & 0xffff), bf2f(c.y >> 16)};
            v[j] = xv + gv[j] * (ya * g0 + yb * g1); ss += v[j][0] * v[j][0] + v[j][1] * v[j][1] + v[j][2] * v[j][2] + v[j][3] * v[j][3]; }
        ss = wave_sum(ss); const float rstd = __builtin_amdgcn_rsqf(ss * (1.f / D) + EPS);
#pragma unroll
        for (int j = 0; j < 4; ++j) { const int c0 = (j * 64 + lane) * 4; *(f32x4*)(x + c0) = v[j] * rstd * fwv[j]; }
    }
}

#define XB_TMO      128
#define XB_XCNT(j)  (256  + 64 * (j))
#define XB_XSUB(j)  (1280 + 64 * (j))
#define XB_XGEN(j)  (2304 + 64 * (j))
#define XB_TOP      3328
#define XB_TOPGEN   3392
#define XCD_BAR_WORDS 3456
#define XB_SPIN_CAP (1u << 22)
DEVI unsigned xb_ld(unsigned* p)              { return __hip_atomic_load(p, __ATOMIC_RELAXED, __HIP_MEMORY_SCOPE_AGENT); }
DEVI unsigned xb_add(unsigned* p, unsigned v) { return __hip_atomic_fetch_add(p, v, __ATOMIC_RELAXED, __HIP_MEMORY_SCOPE_AGENT); }
DEVI unsigned xb_xcc_id() { return (unsigned)__builtin_amdgcn_s_getreg((3 << 11) | 20) & 0xFu; }
#define XB_SPIN(cond, bar) do { unsigned _sp = 0; while (cond) { __builtin_amdgcn_s_sleep(1); \
    if ((++_sp & 255u) == 0u) { if (xb_ld(&(bar)[XB_TMO])) break; if (_sp > XB_SPIN_CAP) { atomicAdd(&(bar)[XB_TMO], 1u); break; } } } } while (0)
struct XcdBarrier { unsigned* bar; unsigned x; volatile LAS unsigned* st; };
DEVI XcdBarrier xcd_barrier_post(unsigned* bar, volatile LAS unsigned* st) {
    XcdBarrier b; b.bar = bar; b.x = xb_xcc_id(); b.st = st;
    if (threadIdx.x == 0) (void)xb_add(&bar[XB_XCNT(b.x)], 1u);
    return b;
}
DEVI void xcd_barrier_complete(unsigned* bar, unsigned x, unsigned& nloc, unsigned& nx) {
    const unsigned G = gridDim.x * gridDim.y * gridDim.z;
    unsigned sum, cnt, mine, sp = 0u;
    for (;;) {
        sum = 0u; cnt = 0u; mine = 0u;
#pragma unroll
        for (unsigned j = 0; j < 16; ++j) { const unsigned c = xb_ld(&bar[XB_XCNT(j)]); sum += c; cnt += (c > 0u) ? 1u : 0u; mine = (j == x) ? c : mine; }
        if (sum == G) break;
        __builtin_amdgcn_s_sleep(1);
        if ((++sp & 255u) == 0u) { if (xb_ld(&bar[XB_TMO])) break; if (sp > XB_SPIN_CAP) { atomicAdd(&bar[XB_TMO], 1u); break; } }
    }
    nloc = mine > 0u ? mine : 1u; nx = cnt > 0u ? cnt : 1u;
}
DEVI void xcd_barrier(const XcdBarrier& b) {
    asm volatile("s_waitcnt vmcnt(0)" ::: "memory");
    __syncthreads();
    if (threadIdx.x == 0) {
        unsigned* bar = b.bar;
        __builtin_amdgcn_s_waitcnt(0);
        unsigned nloc = b.st[0], nx = b.st[1];
        if (nloc == 0u) { xcd_barrier_complete(bar, b.x, nloc, nx); b.st[0] = nloc; b.st[1] = nx; }
        const unsigned old = xb_add(&bar[XB_XSUB(b.x)], 1u);
        const unsigned gen = old / nloc;
        if (old + 1u == (gen + 1u) * nloc) {
            __builtin_amdgcn_fence(__ATOMIC_RELEASE, "agent");
            asm volatile("s_waitcnt vmcnt(0)" ::: "memory");
            const unsigned og = xb_add(&bar[XB_TOP], 1u);
            const unsigned tg = og / nx;
            if (og + 1u == (tg + 1u) * nx) xb_add(&bar[XB_TOPGEN], 1u);
            else XB_SPIN(xb_ld(&bar[XB_TOPGEN]) == tg, bar);
            __builtin_amdgcn_fence(__ATOMIC_ACQUIRE, "agent");
            xb_add(&bar[XB_XGEN(b.x)], 1u);
            asm volatile("s_waitcnt vmcnt(0)" ::: "memory");
        } else {
            XB_SPIN(xb_ld(&bar[XB_XGEN(b.x)]) == gen, bar);
            __builtin_amdgcn_fence(__ATOMIC_ACQUIRE, "agent");
            asm volatile("s_waitcnt vmcnt(0)" ::: "memory");
        }
    }
    __syncthreads();
}

constexpr int NPHASES = 21;
#ifndef XSYNC
#define XSYNC 0
#endif
#ifndef REP_MASK
#define REP_MASK 0u
#endif
#ifndef PH_MASK
#define PH_MASK 0xffffu
#endif
__global__ void __launch_bounds__(NTHREADS, 2) mk_fwd(P p) {
    extern __shared__ __attribute__((aligned(16))) unsigned char lds[];
    cg::grid_group grid = cg::this_grid();
    const int G = gridDim.x, c = blockIdx.x;
    if (threadIdx.x < 30) ((lds_u64*)(uintptr_t)LDS_PTRS)[threadIdx.x] = (unsigned long long)p.in[threadIdx.x];
    if (threadIdx.x < 2) ((volatile LAS unsigned*)(uintptr_t)LDS_MISC)[threadIdx.x] = 0u;
    __syncthreads();
    unsigned* barw = (unsigned*)(p.ws + WS_CTL) + 1024;
    if (blockIdx.x == 0) { for (int i = threadIdx.x; i < XCD_BAR_WORDS; i += NTHREADS) barw[i] = 0u; }
    XcdBarrier xbar; xbar.bar = barw; xbar.x = 0; xbar.st = (volatile LAS unsigned*)(uintptr_t)LDS_MISC;
    int nsync = 0;
#define GRID_BAR() do { if (nsync == 0) { grid.sync(); xbar = xcd_barrier_post(barw, (volatile LAS unsigned*)(uintptr_t)LDS_MISC); } else xcd_barrier(xbar); ++nsync; } while (0)
    int ph = 0;
#define RUN(kid, ...) do { if (((PH_MASK >> (kid)) & 1u) && ph >= p.ph_lo && ph < p.ph_hi) { __VA_ARGS__; if ((REP_MASK >> (kid)) & 1u) { __VA_ARGS__; } if (ph + 1 < p.ph_hi) { GRID_BAR(); for (int xs_ = 0; xs_ < XSYNC; ++xs_) GRID_BAR(); } } ++ph; } while (0)
    RUN(0, ph_pro(p, lds));
#define LAYER(l) \
        RUN(1, ph_norm<false>(p, l, 0, T, lds, l == 1 ? 11 : 0, 5)); \
        RUN(2, { Gemm g{(const bf16*)(p.ws + WS_HM), (const bf16*)(p.ws + WS_WIN) + (size_t)l * INWP * 1024, 0, nullptr}; DenseSched S{T / 256, INWP / 256, G, c}; \
            EpiInProj E{(bf16*)(p.ws + WS_PROJ), (float*)(p.ws + WS_DT), IN(18) + l * 16, IN(19) + l * 16, (float*)(p.ws + WS_RQP), (float*)(p.ws + WS_RKVP)}; gemm_phase<D, 1024, 1024>(lds, g, S, E); }); \
        RUN(4, { Gemm g{(const bf16*)(p.ws + WS_PROJ), (const bf16*)(p.ws + WS_WQKV) + (size_t)l * 1024 * 384, 0, nullptr}; DenseSched S{T / 256, 4, G, c}; \
            EpiMla E{(bf16*)(p.ws + WS_Q), (bf16*)(p.ws + WS_K), (bf16*)(p.ws + WS_V), (const float*)(p.ws + WS_RQP), (const float*)(p.ws + WS_RKVP), (const float*)(p.ws + WS_ROPE), (const bf16*)(p.ws + WS_PROJ)}; gemm_phase<INWP, 384, 384>(lds, g, S, E); ph_scanA(p, l, lds); }); \
        RUN(5, ph_mixer(p, l, lds)); \
        RUN(6, ph_scanC(p, l, lds)); \
        RUN(8, { Gemm g{(const bf16*)(p.ws + WS_HM), (const bf16*)(p.ws + WS_WOUT) + (size_t)l * 1024 * 1024, 0, nullptr}; DenseSched S{NLAT / 256, 4, G, c}; \
            EpiResid E{l == 0 ? IN(0) : p.out, (const float*)(p.ws + WS_XC), p.out, (float*)(p.ws + WS_XC), (const float*)(p.ws + WS_MODV) + (size_t)l * 3 * 6144, 2}; gemm_phase<D, 1024, 1024>(lds, g, S, E); \
            if (l == 0) { CtxSplitSched S2{4, 256 * 2, G, c}; EpiPart E2{(float*)(p.ws + WS_XBC)}; gemm_phase<D, 1024, 256>(lds, g, S2, E2); } }); \
        RUN(9, ph_norm<l == 1>(p, l, 1, l == 0 ? T : NLAT, lds, l == 0 ? 4 : 0, 2)); \
        if (l == 0) { \
            RUN(10, { Gemm g{(const bf16*)(p.ws + WS_HM), (const bf16*)(p.ws + WS_WGU), 0, nullptr}; DenseSched S{T / 256, 2 * DFF / 256, G, c}; \
                EpiSwiglu E{(bf16*)(p.ws + WS_PROJ), DFF}; gemm_phase<D, 1024, 1024>(lds, g, S, E); }); \
            RUN(11, { Gemm g{(const bf16*)(p.ws + WS_PROJ), (const bf16*)(p.ws + WS_WD), 0, nullptr}; DenseSched S{NLAT / 256, 4, G, c}; \
                EpiResid E{p.out, (const float*)(p.ws + WS_XC), p.out, (float*)(p.ws + WS_XC), (const float*)(p.ws + WS_MODV), 5}; gemm_phase<DFF, DFF, DFF>(lds, g, S, E); \
                CtxSplitSched S2{11, 256 * 2, G, c}; EpiPart E2{(float*)(p.ws + WS_XBC)}; gemm_phase<DFF, DFF, 256>(lds, g, S2, E2); }); \
        } else { \
            RUN(12, { ph_sort(p, lds); __syncthreads(); ph_moew(p, lds); }); \
            RUN(13, { Gemm g{(const bf16*)(p.ws + WS_HM), (const bf16*)(p.ws + WS_WGUE), (size_t)2 * DFE * 1024, (const int*)(p.ws + WS_RT + 640 * 1024)}; MoeSched S{(const int*)(p.ws + WS_RT + 384 * 1024), 2 * DFE / 256, G, c}; \
                EpiSwiglu E{(bf16*)(p.ws + WS_ACTS), DFE}; gemm_phase<D, 1024, 1024, EpiSwiglu, MoeSched, true>(lds, g, S, E); }); \
            RUN(14, { Gemm g{(const bf16*)(p.ws + WS_ACTS), (const bf16*)(p.ws + WS_WDE), (size_t)1024 * DFE, nullptr}; MoeSched S{(const int*)(p.ws + WS_RT + 384 * 1024), 4, G, c}; \
                EpiStore E{(bf16*)(p.ws + WS_HS), D}; gemm_phase<DFE, DFE, DFE>(lds, g, S, E); }); \
            RUN(15, ph_final(p)); \
        }
    LAYER(0)
    LAYER(1)
#undef LAYER
#undef RUN
}

#ifndef MK_ONE_LAUNCH
#define MK_ONE_LAUNCH 1
#endif
extern "C" void kernel_launch(void* const* d_in, const int* in_sizes, int n_in, void* d_out, int out_size, void* d_ws, size_t ws_size, hipStream_t stream) {
    static int grid = 0;
    if (grid == 0) {
        if (n_in != 30 || out_size != NLAT * D || ws_size < WS_END) { fprintf(stderr, "kernel_launch: unexpected problem (n_in %d out %d ws %zu, need %zu)\n", n_in, out_size, ws_size, (size_t)WS_END); grid = -1; return; }
        int dev = 0, cus = 0, per_cu = 0;
        hipGetDevice(&dev); hipDeviceGetAttribute(&cus, hipDeviceAttributeMultiprocessorCount, dev);
        if (hipFuncSetAttribute((const void*)mk_fwd, hipFuncAttributeMaxDynamicSharedMemorySize, LDS_BYTES) != hipSuccess) { fprintf(stderr, "kernel_launch: hipFuncSetAttribute failed\n"); grid = -1; return; }
        if (hipOccupancyMaxActiveBlocksPerMultiprocessor(&per_cu, (const void*)mk_fwd, NTHREADS, LDS_BYTES) != hipSuccess || per_cu < 1) { fprintf(stderr, "kernel_launch: occupancy query failed (%d)\n", per_cu); grid = -1; return; }
        grid = cus;
        fprintf(stderr, "kernel_launch: grid %d (cus %d, per_cu %d)\n", grid, cus, per_cu);
    }
    if (grid < 0) return;
    P p{};
    for (int i = 0; i < 30; ++i) p.in[i] = (const float*)d_in[i];
    p.out = (float*)d_out; p.ws = (unsigned char*)d_ws;
#if MK_ONE_LAUNCH
    p.ph_lo = 0; p.ph_hi = NPHASES;
    { void* args[] = {&p}; hipError_t e = hipLaunchCooperativeKernel((const void*)mk_fwd, dim3(grid), dim3(NTHREADS), args, LDS_BYTES, stream);
      if (e != hipSuccess) fprintf(stderr, "cooperative launch failed: %s\n", hipGetErrorString(e)); }
#else
    for (int ph = 0; ph < NPHASES; ++ph) {
        p.ph_lo = ph; p.ph_hi = ph + 1;
        void* args[] = {&p}; hipError_t e = hipLaunchCooperativeKernel((const void*)mk_fwd, dim3(grid), dim3(NTHREADS), args, LDS_BYTES, stream);
        if (e != hipSuccess) { fprintf(stderr, "cooperative launch %d failed: %s\n", ph, hipGetErrorString(e)); break; }
    }
#endif
}
```

```cpp
#include <hip/hip_runtime.h>
#include <hip/hip_cooperative_groups.h>
#include <cstdio>
#include <cstdint>
namespace cg = cooperative_groups;
#ifndef ATTN_PROBE
#define ATTN_PROBE 0
#endif

#define DEVI __device__ __forceinline__
typedef unsigned short bf16;
typedef short bf16x8 __attribute__((ext_vector_type(8)));
typedef float f32x4 __attribute__((ext_vector_type(4)));
typedef float f32x2 __attribute__((ext_vector_type(2)));
typedef float f32x16 __attribute__((ext_vector_type(16)));
typedef unsigned u32x4 __attribute__((ext_vector_type(4)));
typedef unsigned u32x2 __attribute__((ext_vector_type(2)));
typedef __bf16 bf16x2_t __attribute__((ext_vector_type(2)));

constexpr int D = 1024, NB = 2, SEQ = 8192, NLAT = NB * SEQ, CL = 256, NCTX = NB * CL, T = NLAT + NCTX;
constexpr int INW = 2736, INWP = 2816;
constexpr int C_CQ = 0, C_CKV = 256, C_KPE = 384, C_RQ = 416, C_RK = 672, C_RV = 928, C_RG = 1184, C_Z = 1440, C_XBC = 1952, C_DTF = 2720, C_DTB = 2728;
constexpr int DFF = 2816, DFE = 1408, NEXP = 8;
constexpr float EPS = 1e-6f;
constexpr int MOE_MAXROWS = 34816;

constexpr size_t MiB = 1u << 20;
constexpr size_t WS_CTL = 0;
constexpr size_t WS_MODV = 1 * MiB;
constexpr size_t WS_ROPE = WS_MODV + 256 * 1024;
constexpr size_t WS_RQ = WS_MODV + 512 * 1024;
constexpr size_t WS_RKV = WS_MODV + 640 * 1024;
constexpr size_t WS_WQKV = 2 * MiB;
constexpr size_t WS_WOUT = 4 * MiB;
constexpr size_t WS_WIN = 8 * MiB;
constexpr size_t WS_WGU = 19 * MiB;
constexpr size_t WS_WD = 30 * MiB;
constexpr size_t WS_XC = 36 * MiB;
constexpr size_t WS_RT = 38 * MiB;
constexpr size_t WS_DT = 39 * MiB;
constexpr size_t WS_RQP = 41 * MiB + 128 * 1024;
constexpr size_t WS_RKVP = 41 * MiB + 512 * 1024;
constexpr size_t DYN = 42 * MiB;
constexpr size_t KiB = 1024;
constexpr size_t WS_HM = DYN;
constexpr size_t WS_PROJ = DYN + 33 * MiB;
constexpr size_t WS_XBC = DYN + 126720 * KiB;
constexpr size_t WS_Q = DYN + 152064 * KiB;
constexpr size_t WS_K = DYN + 164736 * KiB;
constexpr size_t WS_V = DYN + 177408 * KiB;
constexpr size_t WS_ST = DYN + 185856 * KiB;
constexpr size_t WS_HT = WS_ST + (size_t)1584 * 2 * 4096 * 2;
constexpr size_t WS_CD = WS_RT + 512 * 1024;
constexpr size_t WS_VEC = WS_HT + (size_t)1584 * 2 * 4096 * 2;
constexpr size_t WS_X16 = DYN + 239872 * KiB;
constexpr size_t WS_WGUE = DYN + 33 * MiB;
constexpr size_t WS_WDE = WS_WIN + (size_t)INWP * 1024 * 2;
constexpr size_t WS_HS = DYN;
constexpr size_t WS_ACTS = DYN + 99 * MiB;
constexpr size_t WS_END = WS_X16 + (size_t)NLAT * 1024 * 2;
static_assert(WS_HM + (size_t)T * 1024 * 2 <= WS_PROJ && WS_PROJ + (size_t)T * 2816 * 2 <= WS_XBC && WS_XBC + (size_t)T * 768 * 2 <= WS_Q &&
              WS_Q + (size_t)T * 384 * 2 <= WS_K && WS_K + (size_t)T * 384 * 2 <= WS_V && WS_V + (size_t)T * 256 * 2 <= WS_ST && WS_VEC + (size_t)1584 * 512 * 4 <= WS_X16, "ws map (mixer)");
static_assert(WS_WGUE + (size_t)8 * 2816 * 1024 * 2 <= WS_ACTS && WS_WDE + (size_t)8 * 1024 * 1408 * 2 <= WS_XC && WS_HS + (size_t)MOE_MAXROWS * 1024 * 2 <= WS_ACTS &&
              WS_ACTS + (size_t)MOE_MAXROWS * 1408 * 2 <= WS_X16 && WS_XBC + (size_t)11 * NCTX * 1024 * 4 <= WS_X16, "ws map (moe)");
static_assert(WS_DT + (size_t)T * 32 * 4 <= DYN && WS_WD + (size_t)1024 * 2816 * 2 <= WS_XC && WS_WIN + (size_t)2 * 2816 * 1024 * 2 <= WS_WGU && WS_WQKV + (size_t)2 * 1024 * 384 * 2 <= WS_WOUT && WS_WOUT + (size_t)2 * 1024 * 1024 * 2 <= WS_WIN, "ws map (static)");

constexpr int NTHREADS = 512, NWAVES = 8;
constexpr int LDS_BYTES = 147456;

struct P { const float* in[30]; float* out; unsigned char* ws; int ph_lo, ph_hi; };
constexpr int LDS_MISC = 147456 - 512;
constexpr int LDS_PTRS = 147456 - 256;
typedef __attribute__((address_space(3))) unsigned long long lds_u64;
DEVI const float* inptr(int i) {
    const unsigned long long v = ((lds_u64*)(uintptr_t)LDS_PTRS)[i];
    const unsigned lo = __builtin_amdgcn_readfirstlane((unsigned)v), hi = __builtin_amdgcn_readfirstlane((unsigned)(v >> 32));
    return (const float*)(((unsigned long long)hi << 32) | lo);
}
#define IN(i) inptr(i)
DEVI int otid() { int t = threadIdx.x; asm volatile("" : "+v"(t)); return t; }

DEVI float bf2f(bf16 x) { return __uint_as_float(((unsigned)x) << 16); }
DEVI unsigned pk2(float lo, float hi) { f32x2 v = {lo, hi}; bf16x2_t b = __builtin_convertvector(v, bf16x2_t); return __builtin_bit_cast(unsigned, b); }
DEVI bf16 f2bf(float x) { return (bf16)(pk2(x, 0.f) & 0xffffu); }
DEVI float wave_sum(float v) {
#pragma unroll
    for (int o = 1; o < 64; o <<= 1) v += __shfl_xor(v, o);
    return v;
}
DEVI float siluf(float x) { return x * __builtin_amdgcn_rcpf(1.f + __builtin_amdgcn_exp2f(-1.4426950408889634f * x)); }
DEVI float softplusf(float x) { const float e = __expf(-fabsf(x)); return fmaxf(x, 0.f) + (e < 1e-3f ? e * (1.f - 0.5f * e) : __logf(1.f + e)); }
DEVI int rope_src(int p) { const int q = p & 15, s = (q & 1) ? 8 + (q >> 1) : (q >> 1); return (p & 16) + s; }

#define LAS __attribute__((address_space(3)))
struct Unit { int pm, pn, e, koff; };
struct Gemm { const bf16* A; const bf16* Bt; size_t bstride; const int* rowtab; };
constexpr int BM = 256, BK = 64, HALF = 128, HTB = HALF * BK * 2, STAGE_BYTES = 8 * HTB, NXCD = 8, WGM = 8;
__host__ __device__ __forceinline__ int lds_byte(int r, int c) { const int st = (r >> 4) * 2 + (c >> 5), rr = r & 15, cc = c & 31, ob = rr * 64 + cc * 2; return st * 1024 + (ob ^ (((ob >> 9) & 1) << 5)); }
__host__ __device__ __forceinline__ int perm32(int rho) { const int n = rho >> 4, i = rho & 15; return 8 * (i >> 2) + 4 * n + (i & 3); }
__host__ __device__ __forceinline__ void stage_rc(int b, int& R, int& C) { const int st = b / 1024, sb = b % 1024, swz = sb ^ (((sb >> 9) & 1) << 5); R = (st >> 1) * 16 + swz / 64; C = (st & 1) * 32 + (swz % 64) / 2; }
struct DenseSched {
    int nM, nN, G, c;
    DEVI bool next(int i, Unit& u) const {
        const int nwg = nM * nN; const long L = (long)i * G + c; if (L >= nwg) return false;
        int wgid = (int)L; { const int q = nwg / NXCD, r = nwg % NXCD, xcd = wgid % NXCD, off = wgid / NXCD; wgid = (xcd < r ? xcd * (q + 1) : r * (q + 1) + (xcd - r) * q) + off; }
        const int nig = WGM * nN, gid = wgid / nig, fm = gid * WGM, gsz = (nM - fm) < WGM ? (nM - fm) : WGM;
        u.pm = fm + ((wgid % nig) % gsz); u.pn = (wgid % nig) / gsz; u.e = 0; u.koff = 0; return true;
    }
};
struct CtxSplitSched {
    int nsplit, kbytes, G, c;
    DEVI bool next(int i, Unit& u) const { const int id = i * G + c; if (id >= 8 * nsplit) return false; const int tile = id & 7, ks = id >> 3; u.pm = 64 + (tile >> 2); u.pn = tile & 3; u.e = ks; u.koff = ks * kbytes; return true; }
};
struct MoeSched {
    const int* tab; int nN, G, c;
    DEVI bool next(int i, Unit& u) const { DenseSched d{tab[0], nN, G, c}; if (!d.next(i, u)) return false; u.e = tab[1 + u.pm]; return true; }
};
template <int LDA, int LDB, int KK, class Epi, class Sched, bool GATHER = false>
DEVI void gemm_phase(unsigned char* lds_generic, const Gemm g, const Sched& S, const Epi& E) {
    LAS unsigned char* lds = (LAS unsigned char*)lds_generic;
    const int tid = otid(), wid = __builtin_amdgcn_readfirstlane(tid >> 6), lane = tid & 63, wr = wid >> 2, wc = wid & 3, fr = lane & 15, fq = lane >> 4;
    constexpr int nt = KK / BK; static_assert(KK % 128 == 0, "K must be a multiple of 128");
    unsigned voffA[2], voffB[2]; int Rr[2], Cc[2];
#pragma unroll
    for (int i = 0; i < 2; ++i) { int R, C; stage_rc(tid * 16 + i * 8192, R, C); Rr[i] = R; Cc[i] = C; voffA[i] = (unsigned)(R * LDA + C) * 2u; const int Rb = Epi::PERM ? ((R & ~31) + perm32(R & 31)) : R; voffB[i] = (unsigned)(Rb * LDB + C) * 2u; }
    unsigned cv0[2] = {voffA[0], voffA[1]}, cv1[2] = {voffA[0], voffA[1]}, nv0[2] = {voffA[0], voffA[1]}, nv1[2] = {voffA[0], voffA[1]};
#define PG8_ROWS(u, v0, v1) do { if (GATHER) { _Pragma("unroll") for (int i_ = 0; i_ < 2; ++i_) { v0[i_] = (unsigned)(g.rowtab[(u).pm * BM + Rr[i_]] * LDA + Cc[i_]) * 2u; v1[i_] = (unsigned)(g.rowtab[(u).pm * BM + HALF + Rr[i_]] * LDA + Cc[i_]) * 2u; } } } while (0)
    constexpr size_t kstep = (size_t)(BK * 2), hstepA = GATHER ? (size_t)0 : (size_t)HALF * LDA * 2, hstepB = (size_t)HALF * LDB * 2, tstepA = GATHER ? (size_t)0 : (size_t)2 * HALF * LDA * 2, tstepB = 2 * hstepB;
    const unsigned ldsw = (unsigned)wid * 1024u;
    const int aoff = lds_byte(wr * 64 + fr, fq * 8), boff = lds_byte(wc * 32 + fr, fq * 8);
#define PG8_SA(b, h) (((b) * 2 + (h)) * HTB)
#define PG8_SB(b, h) ((4 + (b) * 2 + (h)) * HTB)
#define PG8_STAGE(bufoff, gbase, voff) do { _Pragma("unroll") for (int _i = 0; _i < 2; ++_i) \
        __builtin_amdgcn_global_load_lds((const unsigned*)((const char*)(gbase) + (voff)[_i]), (LAS unsigned*)(lds + (bufoff) + ldsw + _i * 8192), 16, 0, 0); } while (0)
#define PG8_LDA(dst, b, h) do { _Pragma("unroll") for (int m = 0; m < 4; ++m) _Pragma("unroll") for (int k = 0; k < 2; ++k) dst[m][k] = *(const LAS bf16x8*)(lds + PG8_SA(b, h) + aoff + m * 2048 + k * 1024); } while (0)
#define PG8_LDB(dst, b, h) do { _Pragma("unroll") for (int n = 0; n < 2; ++n) _Pragma("unroll") for (int k = 0; k < 2; ++k) dst[n][k] = *(const LAS bf16x8*)(lds + PG8_SB(b, h) + boff + n * 2048 + k * 1024); } while (0)
#define PG8_MMA(ai, bj, At, Bt) do { __builtin_amdgcn_s_setprio(1); _Pragma("unroll") for (int m = 0; m < 4; ++m) _Pragma("unroll") for (int n = 0; n < 2; ++n) _Pragma("unroll") for (int k = 0; k < 2; ++k) \
        acc[ai][bj][m][n] = __builtin_amdgcn_mfma_f32_16x16x32_bf16(Bt[n][k], At[m][k], acc[ai][bj][m][n], 0, 0, 0); __builtin_amdgcn_s_setprio(0); } while (0)
#define PG8_WAIT_V(n) asm volatile("s_waitcnt vmcnt(" #n ")" ::: "memory")
#define PG8_WAIT_L(n) asm volatile("s_waitcnt lgkmcnt(" #n ")" ::: "memory")
#define PG8_BAR __builtin_amdgcn_s_barrier()
#define PG8_SCHED __builtin_amdgcn_sched_barrier(0)
    Unit cur, nxt; int ui = 0;
    if (!S.next(0, cur)) return;
    f32x4 acc[2][2][4][2];
#pragma unroll
    for (int a = 0; a < 2; ++a)
#pragma unroll
        for (int b = 0; b < 2; ++b)
#pragma unroll
            for (int m = 0; m < 4; ++m)
#pragma unroll
                for (int n = 0; n < 2; ++n) acc[a][b][m][n] = (f32x4){0.f, 0.f, 0.f, 0.f};
    bf16x8 At[4][2], B0[2][2], B1[2][2];
    const char* cA = (const char*)g.A + (size_t)cur.pm * tstepA + cur.koff; const char* cB = (const char*)(g.Bt + (size_t)cur.e * g.bstride) + (size_t)cur.pn * tstepB + cur.koff;
    PG8_WAIT_V(0); PG8_WAIT_L(0); __syncthreads();
    PG8_ROWS(cur, cv0, cv1);
    PG8_STAGE(PG8_SB(0, 0), cB, voffB); PG8_STAGE(PG8_SB(0, 1), cB + hstepB, voffB); PG8_STAGE(PG8_SA(0, 0), cA, cv0); PG8_STAGE(PG8_SA(0, 1), cA + hstepA, cv1);
    if (wr == 1) PG8_BAR;
    PG8_WAIT_V(2); PG8_BAR;
    PG8_STAGE(PG8_SB(1, 0), cB + kstep, voffB); PG8_STAGE(PG8_SA(1, 0), cA + kstep, cv0); PG8_STAGE(PG8_SB(1, 1), cB + hstepB + kstep, voffB);
    PG8_WAIT_V(6); PG8_BAR;
    for (;;) {
        const bool has_next = S.next(ui + 1, nxt);
        if (has_next) PG8_ROWS(nxt, nv0, nv1);
        const char* nA = has_next ? (const char*)g.A + (size_t)nxt.pm * tstepA + nxt.koff : cA; const char* nB = has_next ? (const char*)(g.Bt + (size_t)nxt.e * g.bstride) + (size_t)nxt.pn * tstepB + nxt.koff : cB;
#pragma unroll 1
        for (int t = 0; t < nt; t += 2) {
            const bool last = (t == nt - 2);
            const char* a1 = cA + (size_t)(t + 1) * kstep;
            const char* a2 = last ? nA : cA + (size_t)(t + 2) * kstep; const char* b2 = last ? nB : cB + (size_t)(t + 2) * kstep;
            const char* a3 = a2 + kstep; const char* b3 = b2 + kstep;
            unsigned s0[2] = {cv0[0], cv0[1]}, s1[2] = {cv1[0], cv1[1]};
            if (GATHER && last && has_next) { s0[0] = nv0[0]; s0[1] = nv0[1]; s1[0] = nv1[0]; s1[1] = nv1[1]; }
            PG8_LDB(B0, 0, 0); PG8_LDB(B1, 0, 1); PG8_SCHED; PG8_LDA(At, 0, 0); PG8_STAGE(PG8_SA(1, 1), a1 + hstepA, cv1);
            PG8_WAIT_V(8); PG8_WAIT_L(0); PG8_BAR; PG8_MMA(0, 0, At, B0); PG8_MMA(0, 1, At, B1); PG8_BAR; PG8_SCHED;
            PG8_LDA(At, 0, 1); PG8_STAGE(PG8_SB(0, 0), b2, voffB); PG8_STAGE(PG8_SB(0, 1), b2 + hstepB, voffB); PG8_STAGE(PG8_SA(0, 0), a2, s0);
            PG8_WAIT_V(8); PG8_WAIT_L(0); PG8_BAR; PG8_MMA(1, 0, At, B0); PG8_MMA(1, 1, At, B1); PG8_BAR; PG8_SCHED;
            PG8_LDB(B0, 1, 0); PG8_LDB(B1, 1, 1); PG8_SCHED; PG8_LDA(At, 1, 0); PG8_STAGE(PG8_SA(0, 1), a2 + hstepA, s1);
            PG8_WAIT_V(8); PG8_WAIT_L(0); PG8_BAR; PG8_MMA(0, 0, At, B0); PG8_MMA(0, 1, At, B1); PG8_BAR; PG8_SCHED;
            PG8_LDA(At, 1, 1); PG8_STAGE(PG8_SB(1, 0), b3, voffB); PG8_STAGE(PG8_SB(1, 1), b3 + hstepB, voffB); PG8_STAGE(PG8_SA(1, 0), a3, s0);
            PG8_WAIT_V(8); PG8_WAIT_L(0); PG8_BAR; PG8_MMA(1, 0, At, B0); PG8_MMA(1, 1, At, B1); PG8_BAR; PG8_SCHED;
        }
        if (wr == 0) PG8_BAR;
        E(acc, cur, wr, wc, fr, fq);
        if (!has_next) break;
#pragma unroll
        for (int a = 0; a < 2; ++a)
#pragma unroll
            for (int b = 0; b < 2; ++b)
#pragma unroll
                for (int m = 0; m < 4; ++m)
#pragma unroll
                    for (int n = 0; n < 2; ++n) acc[a][b][m][n] = (f32x4){0.f, 0.f, 0.f, 0.f};
        cur = nxt; cA = nA; cB = nB; ++ui;
        if (GATHER) { cv0[0] = nv0[0]; cv0[1] = nv0[1]; cv1[0] = nv1[0]; cv1[1] = nv1[1]; }
        if (wr == 1) PG8_BAR;
    }
    PG8_WAIT_V(0);
    PG8_BAR;
#undef PG8_ROWS
#undef PG8_SA
#undef PG8_SB
#undef PG8_STAGE
#undef PG8_LDA
#undef PG8_LDB
#undef PG8_MMA
#undef PG8_WAIT_V
#undef PG8_WAIT_L
#undef PG8_BAR
#undef PG8_SCHED
}
#define EPI_LOOP_ROWS _Pragma("unroll") for (int ai = 0; ai < 2; ++ai) _Pragma("unroll") for (int m = 0; m < 4; ++m)
#define EPI_ROW (u.pm * 256 + ai * 128 + wr * 64 + m * 16 + fr)
#define EPI_COL(bj, n) (u.pn * 256 + (bj) * 128 + wc * 32 + (n) * 16 + fq * 4)
#define EPI_COL8(bj) (u.pn * 256 + (bj) * 128 + wc * 32 + fq * 8)
DEVI void st_bf16x8(bf16* p, f32x4 a, f32x4 b) { u32x4 w; w.x = pk2(a[0], a[1]); w.y = pk2(a[2], a[3]); w.z = pk2(b[0], b[1]); w.w = pk2(b[2], b[3]); *(u32x4*)p = w; }

DEVI void ld_bf16x8(const bf16* p, f32x4& a, f32x4& b) { const u32x4 v = *(const u32x4*)p; a = (f32x4){bf2f(v.x & 0xffff), bf2f(v.x >> 16), bf2f(v.y & 0xffff), bf2f(v.y >> 16)}; b = (f32x4){bf2f(v.z & 0xffff), bf2f(v.z >> 16), bf2f(v.w & 0xffff), bf2f(v.w >> 16)}; }
DEVI void st_bf16x4(bf16* p, f32x4 v) { u32x2 w; w.x = pk2(v[0], v[1]); w.y = pk2(v[2], v[3]); *(u32x2*)p = w; }

struct EpiInProj {
    static constexpr bool PERM = true;
    bf16* proj; float* dt; const float* dt_bias; const float* a_log; float* rqp; float* rkvp;
    DEVI void operator()(const f32x4 (&acc)[2][2][4][2], const Unit& u, int wr, int wc, int fr, int fq) const {
        EPI_LOOP_ROWS { const int row = EPI_ROW;
            if (u.pn <= 1) { float ssq = 0.f;
#pragma unroll
                for (int bj = 0; bj < 2; ++bj) if (u.pn == 0 || bj == 0) {
#pragma unroll
                    for (int n = 0; n < 2; ++n) { const f32x4 v = acc[ai][bj][m][n]; ssq += (v[0] * v[0] + v[1] * v[1]) + (v[2] * v[2] + v[3] * v[3]); } }
                ssq += __shfl_xor(ssq, 16); ssq += __shfl_xor(ssq, 32);
                if (fq == 0) (u.pn == 0 ? rqp : rkvp)[(size_t)row * 4 + wc] = ssq; }
#pragma unroll
            for (int bj = 0; bj < 2; ++bj) { const int col = EPI_COL8(bj);
                if (col < C_DTF) st_bf16x8(proj + (size_t)row * INWP + col, acc[ai][bj][m][0], acc[ai][bj][m][1]);
                else if (col < INW) { const int j0 = col - C_DTF;
#pragma unroll
                    for (int n = 0; n < 2; ++n) { const f32x4 v = acc[ai][bj][m][n]; f32x4 dv, lv;
#pragma unroll
                        for (int i = 0; i < 4; ++i) { const float d_ = softplusf(v[i] + dt_bias[j0 + 4 * n + i]); dv[i] = d_; lv[i] = -d_ * __expf(a_log[j0 + 4 * n + i]); }
                        *(f32x4*)(dt + (size_t)row * 32 + j0 + 4 * n) = dv; *(f32x4*)(dt + (size_t)row * 32 + 16 + j0 + 4 * n) = lv; } } } }
    }
};
struct EpiMla {
    static constexpr bool PERM = false;
    bf16 *Q, *K, *V; const float *rqp, *rkvp; const float* rope; const bf16* proj;
    DEVI void operator()(const f32x4 (&acc)[2][2][4][2], const Unit& u, int wr, int wc, int fr, int fq) const {
        EPI_LOOP_ROWS { const int row = EPI_ROW; float sq = 0.f, skv = 0.f;
            if (u.pn <= 1) { const f32x4 pq = *(const f32x4*)(rqp + (size_t)row * 4); sq = __builtin_amdgcn_rsqf(((pq[0] + pq[1]) + (pq[2] + pq[3])) * (1.f / 256.f) + EPS); }
            if (u.pn >= 2) { const f32x4 pk = *(const f32x4*)(rkvp + (size_t)row * 4); skv = __builtin_amdgcn_rsqf(((pk[0] + pk[1]) + (pk[2] + pk[3])) * (1.f / 128.f) + EPS); }
            const int pos = row & (SEQ - 1), gr = pos >> 6, gc = pos & 63;
#pragma unroll
            for (int bj = 0; bj < 2; ++bj)
#pragma unroll
                for (int n = 0; n < 2; ++n) { const int col = EPI_COL(bj, n); f32x4 v = acc[ai][bj][m][n];
                    if (col < 384) { v = v * sq; const int d = col % 96;
                        if (d >= 64 && row < NLAT) { const int pp = (d - 64) >> 1;
#pragma unroll
                            for (int i = 0; i < 2; ++i) { const int pi = pp + i; const float* tb = (pi < 8) ? rope + (gr * 8 + pi) * 2 : rope + 2048 + (gc * 8 + (pi - 8)) * 2;
                                const float c = tb[0], s = tb[1], x0 = v[2 * i], x1 = v[2 * i + 1]; v[2 * i] = x0 * c - x1 * s; v[2 * i + 1] = x1 * c + x0 * s; } }
                        st_bf16x4(Q + (size_t)row * 384 + col, v); }
                    else if (col < 416) { const int d0 = col - 384, pp = d0 >> 1; const u32x2 raw = *(const u32x2*)(proj + (size_t)row * INWP + C_KPE + d0);
                        f32x4 x = {bf2f(raw.x & 0xffff), bf2f(raw.x >> 16), bf2f(raw.y & 0xffff), bf2f(raw.y >> 16)};
                        if (row < NLAT) {
#pragma unroll
                            for (int i = 0; i < 2; ++i) { const int pi = pp + i; const float* tb = (pi < 8) ? rope + (gr * 8 + pi) * 2 : rope + 2048 + (gc * 8 + (pi - 8)) * 2;
                                const float c = tb[0], s = tb[1], x0 = x[2 * i], x1 = x[2 * i + 1]; x[2 * i] = x0 * c - x1 * s; x[2 * i + 1] = x1 * c + x0 * s; } }
#pragma unroll
                        for (int h = 0; h < 4; ++h) st_bf16x4(K + (size_t)row * 384 + h * 96 + 64 + d0, x); }
                    else if (col >= 512 && col < 768) { const int c = col - 512; st_bf16x4(K + (size_t)row * 384 + (c >> 6) * 96 + (c & 63), v * skv); }
                    else if (col >= 768) { st_bf16x4(V + (size_t)row * 256 + (col - 768), v * skv); } }
            asm volatile("" ::: "memory"); }
    }
};
struct EpiResid {
    static constexpr bool PERM = true;
    const float* src32; const bf16* src16; bool from32; bf16* dst; const float* modv_l; int gidx;
    DEVI void operator()(const f32x4 (&acc)[2][2][4][2], const Unit& u, int wr, int wc, int fr, int fq) const {
        EPI_LOOP_ROWS { const int row = EPI_ROW; const float* gp = modv_l + (row >> 13) * 6144 + gidx * 1024;
#pragma unroll
            for (int bj = 0; bj < 2; ++bj) { const int col = EPI_COL8(bj); const f32x4 g0 = *(const f32x4*)(gp + col), g1 = *(const f32x4*)(gp + col + 4); f32x4 s0, s1;
                if (from32) { s0 = *(const f32x4*)(src32 + (size_t)row * D + col); s1 = *(const f32x4*)(src32 + (size_t)row * D + col + 4); } else ld_bf16x8(src16 + (size_t)row * D + col, s0, s1);
                st_bf16x8(dst + (size_t)row * D + col, s0 + g0 * acc[ai][bj][m][0], s1 + g1 * acc[ai][bj][m][1]); } }
    }
};
struct EpiPart {
    static constexpr bool PERM = true;
    float* part;
    DEVI void operator()(const f32x4 (&acc)[2][2][4][2], const Unit& u, int wr, int wc, int fr, int fq) const {
        EPI_LOOP_ROWS { const int row = EPI_ROW; float* d = part + ((size_t)u.e * NCTX + (row - NLAT)) * D;
#pragma unroll
            for (int bj = 0; bj < 2; ++bj)
#pragma unroll
                for (int n = 0; n < 2; ++n) *(f32x4*)(d + EPI_COL8(bj) + 4 * n) = acc[ai][bj][m][n]; }
    }
};
struct EpiSwiglu {
    static constexpr bool PERM = true;
    bf16* act; int ldc;
    DEVI void operator()(const f32x4 (&acc)[2][2][4][2], const Unit& u, int wr, int wc, int fr, int fq) const {
        EPI_LOOP_ROWS { const int row = EPI_ROW; f32x4 o[2];
#pragma unroll
            for (int n = 0; n < 2; ++n) { const f32x4 gt = acc[ai][0][m][n], up = acc[ai][1][m][n];
#pragma unroll
                for (int i = 0; i < 4; ++i) o[n][i] = siluf(gt[i]) * up[i]; }
            st_bf16x8(act + (size_t)row * ldc + u.pn * 128 + wc * 32 + fq * 8, o[0], o[1]); }
    }
};
struct EpiStore {
    static constexpr bool PERM = true;
    bf16* o; int ldc;
    DEVI void operator()(const f32x4 (&acc)[2][2][4][2], const Unit& u, int wr, int wc, int fr, int fq) const {
        EPI_LOOP_ROWS { const int row = EPI_ROW;
#pragma unroll
            for (int bj = 0; bj < 2; ++bj) st_bf16x8(o + (size_t)row * ldc + EPI_COL8(bj), acc[ai][bj][m][0], acc[ai][bj][m][1]); }
    }
};

struct CvtSrc { const float* src; int ld; int ncols; bool perm; const float* ks; float sc; };
DEVI void cvt_tile(const CvtSrc t, bf16* dst, int Kd, int nd0, int kd0, LAS float* scr, int lane) {
    const int n = lane & 31;
    if (t.src) {
        const int nc = (n < t.ncols) ? n : t.ncols - 1; const float msk = (n < t.ncols) ? t.sc : 0.f;
        const float* sp0 = t.src + (size_t)(lane >> 5) * t.ld + nc;
        float v[32];
#pragma unroll
        for (int i = 0; i < 32; ++i) v[i] = __builtin_nontemporal_load(sp0 + (size_t)(2 * i) * t.ld);
        if (t.ks) {
#pragma unroll
            for (int i = 0; i < 32; ++i) v[i] *= t.ks[2 * i + (lane >> 5)];
        }
#pragma unroll
        for (int i = 0; i < 32; ++i) scr[(2 * i + (lane >> 5)) * 33 + n] = v[i] * msk;
    } else {
#pragma unroll 8
        for (int i = 0; i < 32; ++i) scr[(2 * i + (lane >> 5)) * 33 + n] = 0.f;
    }
    asm volatile("s_waitcnt lgkmcnt(0)" ::: "memory");
    const int c = lane & 7;
#pragma unroll
    for (int j = 0; j < 4; ++j) { const int nn = (lane >> 3) + 8 * j; const LAS float* sp = scr + (8 * c) * 33 + (t.perm ? rope_src(nn) : nn);
        u32x4 o; o.x = pk2(sp[0 * 33], sp[1 * 33]); o.y = pk2(sp[2 * 33], sp[3 * 33]); o.z = pk2(sp[4 * 33], sp[5 * 33]); o.w = pk2(sp[6 * 33], sp[7 * 33]);
        *(u32x4*)(dst + (size_t)(nd0 + nn) * Kd + kd0 + 8 * c) = o; }
    asm volatile("s_waitcnt lgkmcnt(0)" ::: "memory");
}
template <class F>
DEVI void cvt_job(bf16* dst, int Nd, int Kd, F f, LAS float* scr, int gw, int ngw, int lane) {
    const int ntn = Nd >> 5, ntk = Kd >> 6;
    for (int it = gw; it < ntn * ntk; it += ngw) { const int nt = it % ntn, kt = it / ntn; cvt_tile(f(nt, kt), dst, Kd, nt * 32, kt * 64, scr, lane); }
}
DEVI void cvt_static(const P& p, unsigned char* lds, int part, int gw, int ngw, int wid, int lane) {
    LAS float* scr = (LAS float*)(LAS unsigned char*)lds + wid * (64 * 33);
    if (part != 1) { const int l = part >> 1;
        { const float* W = IN(8) + (size_t)l * 1024 * INW;
          cvt_job((bf16*)(p.ws + WS_WIN) + (size_t)l * INWP * 1024, INWP, 1024, [=](int nt, int kt) -> CvtSrc {
              const int n0 = nt * 32; if (n0 >= INW) return CvtSrc{nullptr, 0, 0, false, nullptr, 1.f};
              return CvtSrc{W + (size_t)(kt * 64) * INW + n0, INW, (INW - n0 < 32) ? INW - n0 : 32, n0 == C_KPE, nullptr, 1.f}; }, scr, gw, ngw, lane); }
        { const float* Wq = IN(11) + (size_t)l * 256 * 384; const float* qn = IN(10) + l * 256; const float* Wk = IN(13) + (size_t)l * 128 * 256; const float* Wv = IN(14) + (size_t)l * 128 * 256; const float* kn = IN(12) + l * 128;
          const float QS = 0.10206207261596577f * 1.4426950408889634f;
          cvt_job((bf16*)(p.ws + WS_WQKV) + (size_t)l * 1024 * 384, 1024, 384, [=](int nt, int kt) -> CvtSrc {
              const int n0 = nt * 32, k0 = kt * 64;
              if (n0 < 384) { if (k0 >= 256) return CvtSrc{nullptr, 0, 0, false, nullptr, 1.f}; return CvtSrc{Wq + (size_t)k0 * 384 + n0, 384, 32, (n0 % 96) == 64, qn + k0, QS}; }
              if (n0 < 512 || k0 < 256) return CvtSrc{nullptr, 0, 0, false, nullptr, 1.f};
              if (n0 < 768) return CvtSrc{Wk + (size_t)(k0 - 256) * 256 + (n0 - 512), 256, 32, false, kn + k0 - 256, 1.f};
              return CvtSrc{Wv + (size_t)(k0 - 256) * 256 + (n0 - 768), 256, 32, false, kn + k0 - 256, 1.f}; }, scr, gw, ngw, lane); }
        { const float* W = IN(9) + (size_t)l * 1024 * 1024;
          cvt_job((bf16*)(p.ws + WS_WOUT) + (size_t)l * 1024 * 1024, 1024, 1024, [=](int nt, int kt) -> CvtSrc { return CvtSrc{W + (size_t)(kt * 64) * 1024 + nt * 32, 1024, 32, false, nullptr, 1.f}; }, scr, gw, ngw, lane); }
    }
    if (part == 1) {
        { const float* Wg = IN(22); const float* Wu = IN(23);
          cvt_job((bf16*)(p.ws + WS_WGU), 2 * DFF, 1024, [=](int nt, int kt) -> CvtSrc { const int n0 = nt * 32, t = n0 >> 8, r = n0 & 255;
              return CvtSrc{(r < 128 ? Wg + t * 128 + r : Wu + t * 128 + r - 128) + (size_t)(kt * 64) * DFF, DFF, 32, false, nullptr, 1.f}; }, scr, gw, ngw, lane); }
    }
    if (part == 2) {
        { const float* W = IN(24);
          cvt_job((bf16*)(p.ws + WS_WD), 1024, DFF, [=](int nt, int kt) -> CvtSrc { return CvtSrc{W + (size_t)(kt * 64) * 1024 + nt * 32, 1024, 32, false, nullptr, 1.f}; }, scr, gw, ngw, lane); }
    }
}
DEVI void ph_pro(const P& p, unsigned char* lds) {
    const int tid = otid(), wid = tid >> 6, lane = tid & 63;
    __syncthreads();
    float* modv = (float*)(p.ws + WS_MODV);
    float* red = (float*)lds;
    float* sc3 = (float*)(lds + 8192);
    if (blockIdx.x < 192) { for (int k = tid; k < 1024; k += NTHREADS) { sc3[k] = siluf(IN(1)[k]); sc3[1024 + k] = siluf(IN(1)[1024 + k]); sc3[2048 + k] = siluf(IN(3)[k]); } }
    __syncthreads();
    for (int item = blockIdx.x; item < 192; item += gridDim.x) {
        const int l = item / 96, n = (item % 96) * 64 + lane;
        const float* W = IN(4) + (size_t)l * 1024 * 6144;
        float a0 = 0.f, a1 = 0.f, a2 = 0.f;
#pragma unroll 16
        for (int k = wid * 128; k < wid * 128 + 128; ++k) {
            const float w = __builtin_nontemporal_load(W + (size_t)k * 6144 + n);
            a0 += sc3[k] * w; a1 += sc3[1024 + k] * w; a2 += sc3[2048 + k] * w;
        }
        red[(wid * 3 + 0) * 64 + lane] = a0; red[(wid * 3 + 1) * 64 + lane] = a1; red[(wid * 3 + 2) * 64 + lane] = a2;
        __syncthreads();
        if (tid < 192) { const int r = tid >> 6, ln = tid & 63; float s = 0.f;
            for (int w = 0; w < 8; ++w) s += red[(w * 3 + r) * 64 + ln];
            const int nn = (item % 96) * 64 + ln; modv[(l * 3 + r) * 6144 + nn] = s + IN(5)[l * 6144 + nn]; }
        __syncthreads();
    }
    if (blockIdx.x == gridDim.x - 1) {
        float* rope = (float*)(p.ws + WS_ROPE);
        for (int idx = tid; idx < 1536; idx += NTHREADS) {
            const int i = idx & 7, pos = (idx < 1024) ? (idx >> 3) : ((idx - 1024) >> 3);
            const float invf = (i == 0) ? 1.f : (i == 1) ? 0.31622776601683794f : (i == 2) ? 0.1f : (i == 3) ? 0.03162277660168379f : (i == 4) ? 0.01f : (i == 5) ? 0.003162277660168379f : (i == 6) ? 0.001f : 0.00031622776601683794f;
            const float ang = (float)pos * invf;
            double rev = (double)ang * 0.15915494309189535; rev -= __builtin_rint(rev);
            const float fr = (float)rev;
            rope[idx * 2] = __builtin_amdgcn_cosf(fr); rope[idx * 2 + 1] = __builtin_amdgcn_sinf(fr);
        }
    }
    __syncthreads();
    cvt_static(p, lds, 0, blockIdx.x * NWAVES + wid, gridDim.x * NWAVES, wid, lane);
}
DEVI void ph_moew(const P& p, unsigned char* lds, int part, int gw, int ngw) {
    const int tid = otid(), wid = tid >> 6, lane = tid & 63;
    LAS float* scr = (LAS float*)(LAS unsigned char*)lds + wid * (64 * 33);
    const int e0 = part == 2 ? 4 : 0, e1 = part == 1 ? 4 : NEXP;
    for (int e = e0; e < e1; ++e) {
        if (part == 0) { const float* Wg = IN(26) + (size_t)e * 1024 * DFE; const float* Wu = IN(27) + (size_t)e * 1024 * DFE;
          cvt_job((bf16*)(p.ws + WS_WGUE) + (size_t)e * 2 * DFE * 1024, 2 * DFE, 1024, [=](int nt, int kt) -> CvtSrc { const int n0 = nt * 32, t = n0 >> 8, r = n0 & 255;
              return CvtSrc{(r < 128 ? Wg + t * 128 + r : Wu + t * 128 + r - 128) + (size_t)(kt * 64) * DFE, DFE, 32, false, nullptr, 1.f}; }, scr, gw, ngw, lane); }
        else { const float* W = IN(28) + (size_t)e * DFE * 1024;
          cvt_job((bf16*)(p.ws + WS_WDE) + (size_t)e * 1024 * DFE, 1024, DFE, [=](int nt, int kt) -> CvtSrc { return CvtSrc{W + (size_t)(kt * 64) * 1024 + nt * 32, 1024, 32, false, nullptr, 1.f}; }, scr, gw, ngw, lane); }
    }
}

template <bool route>
DEVI void ph_norm(const P& p, int l, int which, int nrows, unsigned char* lds, int npart, int pgidx) {
    const int tid = otid(), wid = tid >> 6, lane = tid & 63;
    const bool first = (l == 0 && which == 0);
    const float* src_lat = IN(0); const bf16* src16 = (const bf16*)(p.ws + WS_X16); const float* src_ctx = (l == 0) ? IN(2) : (const float*)(p.ws + WS_XC);
    const float* w = IN(6 + which) + l * 1024; const float* modv = (const float*)(p.ws + WS_MODV) + (size_t)l * 3 * 6144;
    bf16* H = (bf16*)(p.ws + WS_HM);
    int* rt_e = (int*)(p.ws + WS_RT); float* rt_g = (float*)(p.ws + WS_RT + 128 * 1024);
    float* rl = (float*)lds;
    if (route) { __syncthreads(); const float* router = IN(25);
#pragma unroll
        for (int i = 0; i < 4; ++i) *(f32x4*)(rl + (tid + NTHREADS * i) * 4) = *(const f32x4*)(router + (tid + NTHREADS * i) * 4);
        __syncthreads(); }
    const int nw = gridDim.x * NWAVES, rpw = (NLAT + nw - 1) / nw, gw = blockIdx.x * NWAVES + wid;
    f32x4 vn[4], gsc[4], shv[4]; u32x2 vb[4]; int rc = -1;
    for (int pass = 0; pass < (nrows > NLAT ? 2 : 1); ++pass) {
    const int row0 = pass == 0 ? gw * rpw : NLAT + gw, row1 = pass == 0 ? ((row0 + rpw < NLAT) ? row0 + rpw : NLAT) : nrows, rstep = pass == 0 ? 1 : nw;
#define NORM_LOAD(rw) do { if ((rw) < NLAT && !first) { const bf16* x_ = src16 + (size_t)(rw) * D; _Pragma("unroll") for (int j = 0; j < 4; ++j) vb[j] = *(const u32x2*)(x_ + (j * 64 + lane) * 4); } \
        else { const float* x_ = ((rw) < NLAT) ? src_lat + (size_t)(rw) * D : src_ctx + (size_t)((rw) - NLAT) * D; _Pragma("unroll") for (int j = 0; j < 4; ++j) vn[j] = *(const f32x4*)(x_ + (j * 64 + lane) * 4); } } while (0)
    if (row0 < row1) NORM_LOAD(row0);
    for (int row = row0; row < row1; row += rstep) {
        const bool lat = row < NLAT; const int r = lat ? (row >> 13) : 2;
        if (r != rc) { rc = r; const float* sh = modv + r * 6144 + (which * 3 + 0) * 1024; const float* sc = modv + r * 6144 + (which * 3 + 1) * 1024;
#pragma unroll
            for (int j = 0; j < 4; ++j) { const int c0 = (j * 64 + lane) * 4; const f32x4 wv = *(const f32x4*)(w + c0), cv = *(const f32x4*)(sc + c0); shv[j] = *(const f32x4*)(sh + c0); gsc[j] = wv * (cv + 1.f); } }
        f32x4 v[4]; float ss = 0.f;
        if (lat && !first) {
#pragma unroll
            for (int j = 0; j < 4; ++j) v[j] = (f32x4){bf2f(vb[j].x & 0xffff), bf2f(vb[j].x >> 16), bf2f(vb[j].y & 0xffff), bf2f(vb[j].y >> 16)};
        } else {
#pragma unroll
            for (int j = 0; j < 4; ++j) v[j] = vn[j];
        }
        if (!lat && npart > 0) { const float* part = (const float*)(p.ws + WS_XBC) + (size_t)(row - NLAT) * D; const float* gp = modv + 2 * 6144 + pgidx * 1024; float* xc = (float*)(p.ws + WS_XC) + (size_t)(row - NLAT) * D;
#pragma unroll
            for (int j = 0; j < 4; ++j) { const int c0 = (j * 64 + lane) * 4; f32x4 acc = {0.f, 0.f, 0.f, 0.f};
#pragma unroll 2
                for (int k = 0; k < npart; ++k) acc += *(const f32x4*)(part + (size_t)k * NCTX * D + c0);
                v[j] += *(const f32x4*)(gp + c0) * acc; *(f32x4*)(xc + c0) = v[j]; } }
#pragma unroll
        for (int j = 0; j < 4; ++j) ss += v[j][0] * v[j][0] + v[j][1] * v[j][1] + v[j][2] * v[j][2] + v[j][3] * v[j][3];
        if (row + rstep < row1) { const int nrow = row + rstep; NORM_LOAD(nrow); }
        ss = wave_sum(ss); const float rstd = __builtin_amdgcn_rsqf(ss * (1.f / D) + EPS);
        float lg[8];
#pragma unroll
        for (int e = 0; e < 8; ++e) lg[e] = 0.f;
#pragma unroll
        for (int j = 0; j < 4; ++j) { const int c0 = (j * 64 + lane) * 4; v[j] = v[j] * rstd * gsc[j] + shv[j]; st_bf16x4(H + (size_t)row * D + c0, v[j]); }
        if (route) {
#pragma unroll
            for (int j = 0; j < 4; ++j) { const int c0 = (j * 64 + lane) * 4;
#pragma unroll
                for (int i = 0; i < 4; ++i) { const f32x4 r0 = *(const f32x4*)(rl + (c0 + i) * 8), r1 = *(const f32x4*)(rl + (c0 + i) * 8 + 4); const float hh = v[j][i];
                    lg[0] += hh * r0[0]; lg[1] += hh * r0[1]; lg[2] += hh * r0[2]; lg[3] += hh * r0[3]; lg[4] += hh * r1[0]; lg[5] += hh * r1[1]; lg[6] += hh * r1[2]; lg[7] += hh * r1[3]; }
                asm volatile("" ::: "memory"); } }
        if (route) {
            {
                const bool b0 = lane & 1, b1 = lane & 2, b2 = lane & 4; float a4[4], a2[2], a1;
#pragma unroll
                for (int i = 0; i < 4; ++i) { const float snd = b0 ? lg[i] : lg[4 + i]; a4[i] = (b0 ? lg[4 + i] : lg[i]) + __shfl_xor(snd, 1); }
#pragma unroll
                for (int i = 0; i < 2; ++i) { const float snd = b1 ? a4[i] : a4[2 + i]; a2[i] = (b1 ? a4[2 + i] : a4[i]) + __shfl_xor(snd, 2); }
                { const float snd = b2 ? a2[0] : a2[1]; a1 = (b2 ? a2[1] : a2[0]) + __shfl_xor(snd, 4); }
                a1 += __shfl_xor(a1, 8); a1 += __shfl_xor(a1, 16); a1 += __shfl_xor(a1, 32);
#pragma unroll
                for (int e = 0; e < 8; ++e) lg[e] = __shfl(a1, ((e >> 2) & 1) | (((e >> 1) & 1) << 1) | ((e & 1) << 2)); }
            int i1 = 0; float v1 = lg[0];
#pragma unroll
            for (int e = 1; e < 8; ++e) if (lg[e] > v1) { v1 = lg[e]; i1 = e; }
            int i2 = -1; float v2 = -3.0e38f;
#pragma unroll
            for (int e = 0; e < 8; ++e) if (e != i1 && lg[e] > v2) { v2 = lg[e]; i2 = e; }
            const float e2 = __expf(v2 - v1), g1 = 1.f / (1.f + e2), g2 = e2 / (1.f + e2);
            if (lane == 0) { rt_e[row * 2] = i1; rt_e[row * 2 + 1] = i2; rt_g[row * 2] = g1; rt_g[row * 2 + 1] = g2; }
        }
    }
    }
}

typedef short v4i16_t __attribute__((ext_vector_type(4)));
DEVI v4i16_t lds_tr(const unsigned char* p) { return __builtin_amdgcn_ds_read_tr16_b64_v4i16((LAS v4i16_t*)(LAS unsigned char*)p); }
constexpr int A3_KLD = 208, A3_VLD = 192, A3_VOFF = 64 * A3_KLD, A3_BUF = A3_VOFF + 64 * A3_VLD;
template <int VAR>
DEVI void attn_unit(const P& p, int uidx, unsigned char* lds, bf16* outp) {
    const int tid = otid(), wid = __builtin_amdgcn_readfirstlane(tid >> 6), lane = tid & 63, r32 = lane & 31, hi = lane >> 5;
    const bf16* Q = (const bf16*)(p.ws + WS_Q); const bf16* K = (const bf16*)(p.ws + WS_K); const bf16* V = (const bf16*)(p.ws + WS_V); bf16* MIX = outp;
    int b, h, qrow0, NT;
    if (uidx < 256) { b = uidx >> 7; h = (uidx >> 5) & 3; qrow0 = b * SEQ + (uidx & 31) * 256; NT = 4 + SEQ / 64; }
    else { const int j = uidx - 256; b = j >> 2; h = j & 3; qrow0 = NLAT + b * CL; NT = 4; }
    const int qrow = qrow0 + wid * 32 + r32;
    bf16x8 qf[6];
#pragma unroll
    for (int s = 0; s < 6; ++s) qf[s] = *(const bf16x8*)(Q + (size_t)qrow * 384 + h * 96 + s * 16 + hi * 8);
    const int kk0 = tid / 12, kq0 = tid % 12, kk1 = (512 + tid) / 12, kq1 = (512 + tid) % 12, vk = tid >> 3, vq = tid & 7;
    const bf16* Kh = K + h * 96; const bf16* Vh = V + h * 64 + vq * 8;
    const int ctx0 = NLAT + b * CL, lat0 = b * SEQ;
    u32x4 krA0, krA1 = {0u, 0u, 0u, 0u}, vrA;
#define AT_LOAD(t, kr0, kr1, vr) do { const int kr_ = ((t) < 4) ? ctx0 + (t) * 64 : lat0 + ((t) - 4) * 64; \
        kr0 = *(const u32x4*)(Kh + (size_t)(kr_ + kk0) * 384 + kq0 * 8); if (tid < 256) kr1 = *(const u32x4*)(Kh + (size_t)(kr_ + kk1) * 384 + kq1 * 8); \
        vr = *(const u32x4*)(Vh + (size_t)(kr_ + vk) * 256); } while (0)
#define AT_STORE(bufp, kr0, kr1, vr) do { unsigned char* b_ = (bufp); *(u32x4*)(b_ + kk0 * A3_KLD + kq0 * 16) = kr0; if (tid < 256) *(u32x4*)(b_ + kk1 * A3_KLD + kq1 * 16) = kr1; \
        *(u32x4*)(b_ + A3_VOFF + vk * A3_VLD + vq * 16) = vr; } while (0)
    const int troff = (4 * hi + ((lane & 15) >> 2)) * A3_VLD + (16 * ((lane >> 4) & 1) + 4 * (lane & 3)) * 2;
    const int koff = r32 * A3_KLD + hi * 16;
    f32x16 o0, o1, negm, ls;
#pragma unroll
    for (int r = 0; r < 16; ++r) { o0[r] = 0.f; o1[r] = 0.f; negm[r] = 0.f; ls[r] = 0.f; }
    float mhat = 0.f;
    const bf16x8 ones = {0x3F80, 0x3F80, 0x3F80, 0x3F80, 0x3F80, 0x3F80, 0x3F80, 0x3F80};
    __syncthreads();
    AT_LOAD(0, krA0, krA1, vrA); AT_STORE(lds, krA0, krA1, vrA); AT_LOAD(1, krA0, krA1, vrA); AT_STORE(lds + A3_BUF, krA0, krA1, vrA);
    __syncthreads();
    AT_LOAD(2, krA0, krA1, vrA);
#define SBAR() __builtin_amdgcn_sched_barrier(0)
#define KRD(bufp, half, s) (*(const bf16x8*)((bufp) + koff + (half) * 32 * A3_KLD + (s) * 32))
#define MF(a, b, c) __builtin_amdgcn_mfma_f32_32x32x16_bf16(a, b, c, 0, 0, 0)
#define MFQ(a, b, c) ((VAR == 3) ? (c) : MF(a, b, c))
#define MFP(a, b, c) ((VAR == 2) ? (c) : MF(a, b, c))
#define EX4(S, r0) do { if (VAR == 1) { S[r0] *= 0.001f; S[r0 + 1] *= 0.001f; S[r0 + 2] *= 0.001f; S[r0 + 3] *= 0.001f; break; } S[r0] = __builtin_amdgcn_exp2f(S[r0]); S[r0 + 1] = __builtin_amdgcn_exp2f(S[r0 + 1]); S[r0 + 2] = __builtin_amdgcn_exp2f(S[r0 + 2]); S[r0 + 3] = __builtin_amdgcn_exp2f(S[r0 + 3]); } while (0)
#define PK8(S, r0) __builtin_bit_cast(bf16x8, (u32x4){pk2(S[r0], S[r0 + 1]), pk2(S[r0 + 2], S[r0 + 3]), pk2(S[r0 + 4], S[r0 + 5]), pk2(S[r0 + 6], S[r0 + 7])})
#define VFR(vp) ({ const v4i16_t lo_ = lds_tr(vp), hi_ = lds_tr((vp) + 8 * A3_VLD); (bf16x8){lo_[0], lo_[1], lo_[2], lo_[3], hi_[0], hi_[1], hi_[2], hi_[3]}; })
#define MX3(a, b, c) __builtin_fmaxf(__builtin_fmaxf((a), (b)), (c))
#define AT_UPD(S0, S1, mx, FORCE) do { float mx_ = __builtin_fmaxf(mx, __shfl_xor(mx, 32)); \
        if ((FORCE) || __any(mx_ > 8.0f)) { const float dl_ = (FORCE) ? mx_ : __builtin_fmaxf(mx_, 0.f); mhat += dl_; \
            _Pragma("unroll") for (int r = 0; r < 16; ++r) { S0[r] -= dl_; S1[r] -= dl_; negm[r] = -mhat; } \
            if (!(FORCE)) { const float f_ = __builtin_amdgcn_exp2f(-dl_); _Pragma("unroll") for (int r = 0; r < 16; ++r) { o0[r] *= f_; o1[r] *= f_; ls[r] *= f_; } } } } while (0)
    f32x16 sa0, sa1, sb0, sb1;
    { const unsigned char* kb_ = lds;
#pragma unroll
      for (int s = 0; s < 6; ++s) { sa0 = MF(KRD(kb_, 0, s), qf[s], s == 0 ? negm : sa0); sa1 = MF(KRD(kb_, 1, s), qf[s], s == 0 ? negm : sa1); }
      float a_ = MX3(sa0[0], sa0[1], sa1[0]), b_ = MX3(sa0[2], sa0[3], sa1[1]); a_ = MX3(a_, sa1[2], sa1[3]);
#pragma unroll
      for (int r = 4; r < 16; r += 4) { a_ = MX3(a_, sa0[r], sa0[r + 1]); b_ = MX3(b_, sa0[r + 2], sa0[r + 3]); a_ = MX3(a_, sa1[r], sa1[r + 1]); b_ = MX3(b_, sa1[r + 2], sa1[r + 3]); }
      AT_UPD(sa0, sa1, __builtin_fmaxf(a_, b_), true); }
#define ABAR() do { asm volatile("s_waitcnt lgkmcnt(0)" ::: "memory"); __builtin_amdgcn_s_barrier(); asm volatile("" ::: "memory"); } while (0)
#define AT_STEP(C0, C1, N0, N1, t, HAS_NEXT) do { \
        const unsigned char* kb_ = lds + (((t) + 1) & 3) * A3_BUF; const unsigned char* vb_ = lds + ((t) & 3) * A3_BUF + A3_VOFF + troff; \
        bf16x8 pw0_, pw1_, pw2_, pw3_; float ma_ = -3.0e38f, mb_ = -3.0e38f; \
        if (HAS_NEXT) { \
            bf16x8 k0_ = KRD(kb_, 0, 0), k1_ = KRD(kb_, 1, 0), k2_ = KRD(kb_, 0, 1), k3_ = KRD(kb_, 1, 1); SBAR(); \
            N0 = MFQ(k0_, qf[0], negm); EX4(C0, 0); k0_ = KRD(kb_, 0, 2); SBAR(); \
            N1 = MFQ(k1_, qf[0], negm); EX4(C0, 4); k1_ = KRD(kb_, 1, 2); SBAR(); \
            N0 = MFQ(k2_, qf[1], N0); EX4(C0, 8); k2_ = KRD(kb_, 0, 3); SBAR(); \
            N1 = MFQ(k3_, qf[1], N1); EX4(C0, 12); k3_ = KRD(kb_, 1, 3); SBAR(); \
            N0 = MFQ(k0_, qf[2], N0); EX4(C1, 0); k0_ = KRD(kb_, 0, 4); SBAR(); \
            N1 = MFQ(k1_, qf[2], N1); EX4(C1, 4); k1_ = KRD(kb_, 1, 4); SBAR(); \
            N0 = MFQ(k2_, qf[3], N0); EX4(C1, 8); k2_ = KRD(kb_, 0, 5); SBAR(); \
            N1 = MFQ(k3_, qf[3], N1); EX4(C1, 12); k3_ = KRD(kb_, 1, 5); SBAR(); \
            N0 = MFQ(k0_, qf[4], N0); pw0_ = PK8(C0, 0); SBAR(); \
            N1 = MFQ(k1_, qf[4], N1); pw1_ = PK8(C0, 8); SBAR(); \
            N0 = MFQ(k2_, qf[5], N0); pw2_ = PK8(C1, 0); SBAR(); \
            N1 = MFQ(k3_, qf[5], N1); pw3_ = PK8(C1, 8); SBAR(); \
        } else { EX4(C0, 0); EX4(C0, 4); EX4(C0, 8); EX4(C0, 12); EX4(C1, 0); EX4(C1, 4); EX4(C1, 8); EX4(C1, 12); pw0_ = PK8(C0, 0); pw1_ = PK8(C0, 8); pw2_ = PK8(C1, 0); pw3_ = PK8(C1, 8); SBAR(); } \
        if ((t) + 2 < NT) AT_STORE(lds + (((t) + 2) & 3) * A3_BUF, krA0, krA1, vrA); \
        ABAR(); \
        if ((t) + 3 < NT) AT_LOAD((t) + 3, krA0, krA1, vrA); \
        { bf16x8 va_ = VFR(vb_), vb2_ = VFR(vb_ + 64); SBAR(); \
          bf16x8 vc_ = VFR(vb_ + 16 * A3_VLD), vd_ = VFR(vb_ + 16 * A3_VLD + 64); SBAR(); \
          o0 = MFP(va_, pw0_, o0); if (HAS_NEXT) { ma_ = MX3(N0[0], N0[1], N1[0]); mb_ = MX3(N0[2], N0[3], N1[1]); } SBAR(); \
          o1 = MFP(vb2_, pw0_, o1); if (HAS_NEXT) { ma_ = MX3(ma_, N1[2], N1[3]); mb_ = MX3(mb_, N0[4], N0[5]); } SBAR(); \
          ls = MF(ones, pw0_, ls); SBAR(); \
          va_ = VFR(vb_ + 32 * A3_VLD); vb2_ = VFR(vb_ + 32 * A3_VLD + 64); SBAR(); \
          o0 = MFP(vc_, pw1_, o0); if (HAS_NEXT) { ma_ = MX3(ma_, N0[6], N0[7]); mb_ = MX3(mb_, N1[4], N1[5]); } SBAR(); \
          o1 = MFP(vd_, pw1_, o1); if (HAS_NEXT) { ma_ = MX3(ma_, N1[6], N1[7]); mb_ = MX3(mb_, N0[8], N0[9]); } SBAR(); \
          ls = MF(ones, pw1_, ls); SBAR(); \
          vc_ = VFR(vb_ + 48 * A3_VLD); vd_ = VFR(vb_ + 48 * A3_VLD + 64); SBAR(); \
          o0 = MFP(va_, pw2_, o0); if (HAS_NEXT) { ma_ = MX3(ma_, N0[10], N0[11]); mb_ = MX3(mb_, N1[8], N1[9]); } SBAR(); \
          o1 = MFP(vb2_, pw2_, o1); if (HAS_NEXT) { ma_ = MX3(ma_, N1[10], N1[11]); mb_ = MX3(mb_, N0[12], N0[13]); } SBAR(); \
          ls = MF(ones, pw2_, ls); SBAR(); \
          if (HAS_NEXT) { ma_ = MX3(ma_, N0[14], N0[15]); mb_ = MX3(mb_, N1[12], N1[13]); } SBAR(); \
          o0 = MFP(vc_, pw3_, o0); if (HAS_NEXT) { ma_ = MX3(ma_, N1[14], N1[15]); } SBAR(); \
          o1 = MFP(vd_, pw3_, o1); SBAR(); \
          ls = MF(ones, pw3_, ls); SBAR(); } \
        if (HAS_NEXT) AT_UPD(N0, N1, __builtin_fmaxf(ma_, mb_), false); \
        ABAR(); } while (0)
    if (wid >= 4) ABAR();
    int t = 0;
    for (; t + 2 < NT; t += 2) {
        AT_STEP(sa0, sa1, sb0, sb1, t, true);
        AT_STEP(sb0, sb1, sa0, sa1, t + 1, true);
    }
    AT_STEP(sa0, sa1, sb0, sb1, t, true);
    AT_STEP(sb0, sb1, sa0, sa1, t + 1, false);
    if (wid < 4) ABAR();
#undef ABAR
#undef AT_LOAD
#undef AT_STORE
#undef SBAR
#undef KRD
#undef MF
#undef MFQ
#undef MFP
#undef EX4
#undef PK8
#undef VFR
#undef MX3
#undef AT_UPD
#undef AT_STEP
    const float inv = 1.f / ls[0];
    bf16* orow = MIX + (size_t)qrow * D + h * 64;
#pragma unroll
    for (int g = 0; g < 4; ++g) {
        st_bf16x4(orow + 8 * g + 4 * hi, (f32x4){o0[4 * g] * inv, o0[4 * g + 1] * inv, o0[4 * g + 2] * inv, o0[4 * g + 3] * inv});
        st_bf16x4(orow + 32 + 8 * g + 4 * hi, (f32x4){o1[4 * g] * inv, o1[4 * g + 1] * inv, o1[4 * g + 2] * inv, o1[4 * g + 3] * inv});
    }
}

constexpr int NCC = 66;
DEVI int chunk_row0(int b, int cc) { return cc < 2 ? NLAT + b * CL + cc * 128 : b * SEQ + (cc - 2) * 128; }
constexpr int SC_VEC = 0;
constexpr int SC_KT = 2048;
constexpr int SC_VF = SC_KT + 64 * 136 * 2;
constexpr int SC_VB = SC_VF + 64 * 136 * 2;
constexpr int SC_X = SC_VB + 64 * 136 * 2;
constexpr int SC_SSQ = SC_X + 2048;
constexpr int SC_END = SC_SSQ + 8192;
constexpr int TS = 136;

DEVI void scan_vectors(const P& p, int l, bool ret, int h, int row0, float* vec, int wid, int lane) {
    const float* dt = (const float*)(p.ws + WS_DT);
    if (ret) {
        if (wid == 0) { const float lf = IN(15)[l * 8 + h], lb = IN(15)[l * 8 + 4 + h];
            const float laf = -log1pf(__expf(-lf)), lab = -log1pf(__expf(-lb));
#pragma unroll
            for (int e = 0; e < 2; ++e) { const int j = lane * 2 + e; vec[j] = (float)(j + 1) * laf; vec[128 + j] = (float)(128 - j) * lab; vec[256 + j] = 1.f; vec[384 + j] = 1.f; } }
    } else if (wid < 2) {
        const int dir = wid; const size_t r = (size_t)(row0 + lane * 2);
        const float x0 = dt[r * 32 + 16 + dir * 8 + h], x1 = dt[(r + 1) * 32 + 16 + dir * 8 + h];
        vec[256 + dir * 128 + lane * 2] = dt[r * 32 + dir * 8 + h]; vec[256 + dir * 128 + lane * 2 + 1] = dt[(r + 1) * 32 + dir * 8 + h];
        float s = x0 + x1;
#pragma unroll
        for (int o = 1; o < 64; o <<= 1) { const float t = __shfl_up(s, o); if (lane >= o) s += t; }
        if (dir == 0) { vec[lane * 2] = s - x1; vec[lane * 2 + 1] = s; }
        else { const float tot = __shfl(s, 63); vec[128 + lane * 2] = tot - (s - x1) + x0; vec[128 + lane * 2 + 1] = tot - s + x1; }
    }
}
DEVI void scan_ptrs(const P& p, bool ret, int h, const bf16*& qb, const bf16*& kb, const bf16*& vb, int& ld) {
    if (ret) { const bf16* proj = (const bf16*)(p.ws + WS_PROJ); qb = proj + C_RQ + h * 64; kb = proj + C_RK + h * 64; vb = proj + C_RV + h * 64; ld = INWP; }
    else { const bf16* xbc = (const bf16*)(p.ws + WS_XBC); qb = xbc + 640 + (h >> 2) * 64; kb = xbc + 512 + (h >> 2) * 64; vb = xbc + h * 64; ld = 768; }
}
DEVI void c3_stage_rows(unsigned char* dst, int rs, const bf16* src, int ld, int tid) {
#pragma unroll
    for (int i = 0; i < 2; ++i) { const int piece = tid + NTHREADS * i, row = piece >> 3, part = piece & 7; *(u32x4*)(dst + row * rs + part * 16) = *(const u32x4*)(src + (size_t)row * ld + part * 8); }
}
struct ConvW { f32x4 w0[2], w1[2], w2[2], b[2]; };
DEVI ConvW conv_w(const float* cw, const float* cb, int c0) { ConvW w;
#pragma unroll
    for (int k = 0; k < 2; ++k) { w.w0[k] = *(const f32x4*)(cw + c0 + 4 * k); w.w1[k] = *(const f32x4*)(cw + 768 + c0 + 4 * k); w.w2[k] = *(const f32x4*)(cw + 1536 + c0 + 4 * k); w.b[k] = *(const f32x4*)(cb + c0 + 4 * k); }
    return w; }
DEVI void unpack8(const u32x4 v, f32x4 (&x)[2]) { x[0] = (f32x4){bf2f(v.x & 0xffff), bf2f(v.x >> 16), bf2f(v.y & 0xffff), bf2f(v.y >> 16)}; x[1] = (f32x4){bf2f(v.z & 0xffff), bf2f(v.z >> 16), bf2f(v.w & 0xffff), bf2f(v.w >> 16)}; }
DEVI void conv8(const bf16* proj, size_t row, bool has_prev, bool has_next, int c0, const ConvW& w, f32x4 (&y)[2]) {
    const bf16* pr = proj + row * INWP + C_XBC + c0; const u32x4 z = {0u, 0u, 0u, 0u};
    const u32x4 r0 = *(const u32x4*)pr, rm = has_prev ? *(const u32x4*)(pr - INWP) : z, rp = has_next ? *(const u32x4*)(pr + INWP) : z;
    f32x4 x0[2], xm[2], xp[2]; unpack8(r0, x0); unpack8(rm, xm); unpack8(rp, xp);
#pragma unroll
    for (int k = 0; k < 2; ++k) { y[k] = w.w0[k] * xm[k] + w.w1[k] * x0[k] + w.w2[k] * xp[k] + w.b[k];
#pragma unroll
        for (int i = 0; i < 4; ++i) y[k][i] = siluf(y[k][i]); }
}
DEVI u32x4 pack8(const f32x4 (&y)[2], float sc) { return (u32x4){pk2(y[0][0] * sc, y[0][1] * sc), pk2(y[0][2] * sc, y[0][3] * sc), pk2(y[1][0] * sc, y[1][1] * sc), pk2(y[1][2] * sc, y[1][3] * sc)}; }
constexpr int SA_RS = 192, SA_K = 8192, SA_VF = SA_K + 128 * SA_RS, SA_VB = SA_VF + 128 * SA_RS, SA_V2 = 2 * 128 * SA_RS  , SA_END = SA_VF + 2 * SA_V2;
DEVI void scanA_unit(const P& p, int l, int uidx, unsigned char* lds) {
    const int tid = otid(), wid = __builtin_amdgcn_readfirstlane(tid >> 6), lane = tid & 63, r32 = lane & 31, hi = lane >> 5;
    const int g4 = uidx % 3, bc = uidx / 3, b = bc / NCC, cc = bc % NCC, row0 = chunk_row0(b, cc);
    const bool ret = (g4 == 0);
    float* vec4 = (float*)(lds + SC_VEC);
    bf16* ST = (bf16*)(p.ws + WS_ST); float* CDp = (float*)(p.ws + WS_CD);
    const bf16* proj = (const bf16*)(p.ws + WS_PROJ); bf16* xbcw = (bf16*)(p.ws + WS_XBC); const float* cw = IN(16) + (size_t)l * 3 * 768; const float* cb = IN(17) + l * 768;
    const int troff = (4 * hi + ((lane & 15) >> 2)) * SA_RS + (16 * ((lane >> 4) & 1) + 4 * (lane & 3)) * 2;
    __syncthreads();
    { const int hq = wid >> 1, h = ret ? hq : (g4 - 1) * 4 + hq; scan_vectors(p, l, ret, h, row0, vec4 + hq * 512, wid & 1, lane); }
    __syncthreads();
    { const int hq = tid >> 7, t = tid & 127, h = ret ? hq : (g4 - 1) * 4 + hq, hh = ret ? hq : 4 + h; const size_t item = (size_t)(b * NCC + cc) * 12 + hh; const float* vv = vec4 + hq * 512;
      float* vg = (float*)(p.ws + WS_VEC) + item * 512; vg[t] = vv[t]; vg[128 + t] = vv[128 + t]; vg[256 + t] = vv[t] - __logf(vv[256 + t]); vg[384 + t] = vv[128 + t] - __logf(vv[384 + t]);
      if (t == 0) { CDp[item * 2] = __expf(vv[127]); CDp[item * 2 + 1] = __expf(vv[128]); } }
    const int dir = wid >> 2, nt = (wid >> 1) & 1, pt = wid & 1;
    if (ret) {
        for (int hq = 0; hq < 4; ++hq) {
            const int h = hq; const size_t item = (size_t)(b * NCC + cc) * 12 + h;
            const bf16 *qb, *kb, *vb; int ld; scan_ptrs(p, true, h, qb, kb, vb, ld);
            const float* vec = vec4 + hq * 512;
            if (hq > 0) __syncthreads();
            c3_stage_rows(lds + SA_K, SA_RS, kb + (size_t)row0 * ld, ld, tid);
#pragma unroll
            for (int i = 0; i < 2; ++i) { const int piece = tid + NTHREADS * i, j = piece >> 3, part = piece & 7; const u32x4 v = *(const u32x4*)(vb + (size_t)(row0 + j) * ld + part * 8);
                const float sf = __expf(vec[127] - vec[j]) * vec[256 + j], sb = __expf(vec[128] - vec[128 + j]) * vec[384 + j];
                f32x4 x[2]; unpack8(v, x);
                *(u32x4*)(lds + SA_VF + j * SA_RS + part * 16) = pack8(x, sf); *(u32x4*)(lds + SA_VB + j * SA_RS + part * 16) = pack8(x, sb); }
            __syncthreads();
            const unsigned char* ka = lds + SA_K + nt * 64 + troff; const unsigned char* va = lds + (dir ? SA_VB : SA_VF) + pt * 64 + troff;
            f32x16 acc;
#pragma unroll
            for (int r = 0; r < 16; ++r) acc[r] = 0.f;
#pragma unroll
            for (int s = 0; s < 8; ++s) { const v4i16_t al = lds_tr(ka + (16 * s) * SA_RS), ah = lds_tr(ka + (16 * s + 8) * SA_RS), bl = lds_tr(va + (16 * s) * SA_RS), bh = lds_tr(va + (16 * s + 8) * SA_RS);
                const bf16x8 af = {al[0], al[1], al[2], al[3], ah[0], ah[1], ah[2], ah[3]}, bf = {bl[0], bl[1], bl[2], bl[3], bh[0], bh[1], bh[2], bh[3]};
                acc = __builtin_amdgcn_mfma_f32_32x32x16_bf16(af, bf, acc, 0, 0, 0); }
            bf16* o = ST + (item * 2 + dir) * 4096 + (size_t)(pt * 32 + r32) * 64 + nt * 32 + 4 * hi;
#pragma unroll
            for (int g = 0; g < 4; ++g) st_bf16x4(o + 8 * g, (f32x4){acc[4 * g], acc[4 * g + 1], acc[4 * g + 2], acc[4 * g + 3]});
        }
    } else {
        const int g = g4 - 1, part = tid & 7; const int pos0 = (cc < 2) ? cc * 128 : (cc - 2) * 128, Ls = (cc < 2) ? CL : SEQ;
        for (int hp = 0; hp < 2; ++hp) {
            if (hp > 0) __syncthreads();
            if (hp == 0) {
#pragma unroll 1
                for (int which = 0; which < 2; ++which) { const int c0 = (which == 0 ? 512 : 640) + g * 64 + part * 8; const ConvW w = conv_w(cw, cb, c0);
#pragma unroll
                    for (int i = 0; i < 2; ++i) { const int j = (tid + NTHREADS * i) >> 3; f32x4 y[2]; conv8(proj, (size_t)(row0 + j), pos0 + j > 0, pos0 + j < Ls - 1, c0, w, y);
                        const u32x4 o = pack8(y, 1.f); *(u32x4*)(xbcw + (size_t)(row0 + j) * 768 + c0) = o; if (which == 0) *(u32x4*)(lds + SA_K + j * SA_RS + part * 16) = o; } } }
#pragma unroll
            for (int e = 0; e < 2; ++e) { const int hq = hp * 2 + e, h = g * 4 + hq; const float* vec = vec4 + hq * 512; const int c0 = h * 64 + part * 8; const ConvW w = conv_w(cw, cb, c0);
#pragma unroll
                for (int i = 0; i < 2; ++i) { const int j = (tid + NTHREADS * i) >> 3; f32x4 y[2]; conv8(proj, (size_t)(row0 + j), pos0 + j > 0, pos0 + j < Ls - 1, c0, w, y);
                    const float sf = __expf(vec[127] - vec[j]) * vec[256 + j], sb = __expf(vec[128] - vec[128 + j]) * vec[384 + j];
                    *(u32x4*)(xbcw + (size_t)(row0 + j) * 768 + c0) = pack8(y, 1.f);
                    *(u32x4*)(lds + SA_VF + e * SA_V2 + j * SA_RS + part * 16) = pack8(y, sf); *(u32x4*)(lds + SA_VB + e * SA_V2 + j * SA_RS + part * 16) = pack8(y, sb); } }
            __syncthreads();
            const unsigned char* ka = lds + SA_K + nt * 64 + troff;
            f32x16 acc0, acc1;
#pragma unroll
            for (int r = 0; r < 16; ++r) { acc0[r] = 0.f; acc1[r] = 0.f; }
            const unsigned char* va = lds + (dir ? SA_VB : SA_VF) + pt * 64 + troff;
#pragma unroll
            for (int s = 0; s < 8; ++s) { const v4i16_t al = lds_tr(ka + (16 * s) * SA_RS), ah = lds_tr(ka + (16 * s + 8) * SA_RS);
                const bf16x8 af = {al[0], al[1], al[2], al[3], ah[0], ah[1], ah[2], ah[3]};
                { const v4i16_t bl = lds_tr(va + (16 * s) * SA_RS), bh = lds_tr(va + (16 * s + 8) * SA_RS); const bf16x8 bf = {bl[0], bl[1], bl[2], bl[3], bh[0], bh[1], bh[2], bh[3]}; acc0 = __builtin_amdgcn_mfma_f32_32x32x16_bf16(af, bf, acc0, 0, 0, 0); }
                { const v4i16_t bl = lds_tr(va + SA_V2 + (16 * s) * SA_RS), bh = lds_tr(va + SA_V2 + (16 * s + 8) * SA_RS); const bf16x8 bf = {bl[0], bl[1], bl[2], bl[3], bh[0], bh[1], bh[2], bh[3]}; acc1 = __builtin_amdgcn_mfma_f32_32x32x16_bf16(af, bf, acc1, 0, 0, 0); } }
#pragma unroll
            for (int e = 0; e < 2; ++e) { const int hq = hp * 2 + e, hh = 4 + g * 4 + hq; const size_t item = (size_t)(b * NCC + cc) * 12 + hh;
                bf16* o = ST + (item * 2 + dir) * 4096 + (size_t)(pt * 32 + r32) * 64 + nt * 32 + 4 * hi;
#pragma unroll
                for (int gq = 0; gq < 4; ++gq) st_bf16x4(o + 8 * gq, e ? (f32x4){acc1[4 * gq], acc1[4 * gq + 1], acc1[4 * gq + 2], acc1[4 * gq + 3]} : (f32x4){acc0[4 * gq], acc0[4 * gq + 1], acc0[4 * gq + 2], acc0[4 * gq + 3]}); }
        }
    }
    __syncthreads();
}
DEVI void scanB_slab(const P& p, int slab, int nthr, int epb) {
    const int tid = otid(); if (tid >= nthr) return;
    const int f = slab * epb + tid * 2; const int bhd = f >> 12, e = f & 4095, dir = bhd & 1, bh = bhd >> 1, b = bh / 12, hh = bh % 12;
    const bf16* ST = (const bf16*)(p.ws + WS_ST); const float* CDp = (const float*)(p.ws + WS_CD); bf16* HT = (bf16*)(p.ws + WS_HT);
    f32x2 H = {0.f, 0.f};
#pragma unroll 1
    for (int base = 0; base < NCC; base += 22) {
        f32x2 s[22]; float d[22]; unsigned off[22];
#pragma unroll
        for (int i = 0; i < 22; ++i) { const int step = base + i; const int cc = dir == 0 ? step : (step < 2 ? 1 - step : 67 - step);
            const unsigned item = (unsigned)((b * NCC + cc) * 12 + hh); off[i] = (item * 2 + dir) * 4096 + e; { const unsigned sv = *(const unsigned*)(ST + off[i]); s[i] = (f32x2){bf2f(sv & 0xffff), bf2f(sv >> 16)}; } d[i] = CDp[item * 2 + dir]; }
#pragma unroll
        for (int i = 0; i < 22; ++i) { *(unsigned*)(HT + off[i]) = pk2(H[0], H[1]); H = H * d[i] + s[i]; }
    }
}
constexpr int C3_RSV = 192, C3_RSK = 144;
constexpr int C3_V = 0, C3_K = 2 * 128 * C3_RSV, C3_H = C3_K + 2 * 128 * C3_RSK, C3_VEC = C3_H + 2 * 128 * C3_RSK, C3_X = C3_VEC + 2 * 2048, C3_END = C3_X + 1024;
template <bool RET>
DEVI void scanC_unit(const P& p, int l, int bc, unsigned char* lds, int tid, int wid, int lane) {
    const int r32 = lane & 31, hi = lane >> 5;
    const int it_ = wid & 3, hsub = wid >> 2, b = bc / NCC, cc = bc % NCC, row0 = chunk_row0(b, cc);
    const bf16* HT = (const bf16*)(p.ws + WS_HT); const bf16* proj = (const bf16*)(p.ws + WS_PROJ); const bf16* xbc = (const bf16*)(p.ws + WS_XBC); bf16* MIX = (bf16*)(p.ws + WS_HM); const float* VECG = (const float*)(p.ws + WS_VEC);
    const int i = it_ * 32 + r32; const size_t rowi = (size_t)(row0 + i);
    constexpr int ld = RET ? INWP : 768;
    const unsigned char* Vl = lds + C3_V + hsub * 128 * C3_RSV; const unsigned char* Kl = lds + C3_K + hsub * 128 * C3_RSK; const unsigned char* Hl = lds + C3_H + hsub * 128 * C3_RSK; const float* vec = (const float*)(lds + C3_VEC + hsub * 2048);
    const int trq = (lane & 15) >> 2, trp = lane & 3, trg = (lane >> 4) & 1;
    const int troff = (4 * hi + trq) * C3_RSV + (16 * trg + 4 * trp) * 2;
    float ssqk[4] = {0.f, 0.f, 0.f, 0.f};
    bf16x8 qf[4];
    if (!RET) { const bf16* qb = xbc + 640 + hsub * 64;
#pragma unroll
        for (int s = 0; s < 4; ++s) qf[s] = *(const bf16x8*)(qb + rowi * ld + s * 16 + hi * 8); }
    u32x4 pv[4], ph[4], pvec = {0u, 0u, 0u, 0u};
#define C3_PREFETCH(stp) do { _Pragma("unroll") for (int hs = 0; hs < 2; ++hs) { const int h_ = hs * 4 + (stp); const size_t item_ = (size_t)(b * NCC + cc) * 12 + 4 + h_; \
            _Pragma("unroll") for (int i_ = 0; i_ < 2; ++i_) { const int piece_ = tid + NTHREADS * i_, row_ = piece_ >> 3, part_ = piece_ & 7; \
                pv[hs * 2 + i_] = *(const u32x4*)(xbc + h_ * 64 + (size_t)(row0 + row_) * 768 + part_ * 8); ph[hs * 2 + i_] = *(const u32x4*)(HT + item_ * 2 * 4096 + row_ * 64 + part_ * 8); } \
            if ((tid >> 7) == hs) pvec = *(const u32x4*)(VECG + item_ * 512 + (tid & 127) * 4); } } while (0)
#define C3_COMMIT() do { _Pragma("unroll") for (int hs = 0; hs < 2; ++hs) _Pragma("unroll") for (int i_ = 0; i_ < 2; ++i_) { const int piece_ = tid + NTHREADS * i_, row_ = piece_ >> 3, part_ = piece_ & 7; \
            *(u32x4*)(lds + C3_V + hs * 128 * C3_RSV + row_ * C3_RSV + part_ * 16) = pv[hs * 2 + i_]; *(u32x4*)(lds + C3_H + hs * 128 * C3_RSK + row_ * C3_RSK + part_ * 16) = ph[hs * 2 + i_]; } \
        if (tid < 256) *(u32x4*)(lds + C3_VEC + (tid >> 7) * 2048 + (tid & 127) * 16) = pvec; } while (0)
    if (!RET) { C3_PREFETCH(0);
#pragma unroll
        for (int hs = 0; hs < 2; ++hs) c3_stage_rows(lds + C3_K + hs * 128 * C3_RSK, C3_RSK, xbc + 512 + hs * 64 + (size_t)row0 * ld, ld, tid); }
#pragma unroll 1
    for (int step = 0; step < (RET ? 2 : 4); ++step) {
        __syncthreads();
        if (RET) {
#pragma unroll
            for (int hs = 0; hs < 2; ++hs) { const int h = hs * 2 + step; const size_t item = (size_t)(b * NCC + cc) * 12 + h;
                c3_stage_rows(lds + C3_V + hs * 128 * C3_RSV, C3_RSV, proj + C_RV + h * 64 + (size_t)row0 * ld, ld, tid);
                c3_stage_rows(lds + C3_K + hs * 128 * C3_RSK, C3_RSK, proj + C_RK + h * 64 + (size_t)row0 * ld, ld, tid);
                c3_stage_rows(lds + C3_H + hs * 128 * C3_RSK, C3_RSK, HT + item * 2 * 4096, 64, tid);
                if ((tid >> 7) == hs) *(u32x4*)(lds + C3_VEC + hs * 2048 + (tid & 127) * 16) = *(const u32x4*)(VECG + item * 512 + (tid & 127) * 4); }
        } else C3_COMMIT();
        __syncthreads();
        if (!RET && step + 1 < 4) C3_PREFETCH(step + 1);
        const int h = RET ? hsub * 2 + step : hsub * 4 + step;
        if (RET) { const bf16* qb = proj + C_RQ + h * 64;
#pragma unroll
            for (int s = 0; s < 4; ++s) qf[s] = *(const bf16x8*)(qb + rowi * ld + s * 16 + hi * 8); }
        const float Afi = vec[i], Bbi = vec[128 + i];
        f32x16 y0, y1;
#pragma unroll
        for (int r = 0; r < 16; ++r) { y0[r] = 0.f; y1[r] = 0.f; }
#pragma unroll 2
        for (int jt = 0; jt < 4; ++jt) {
            f32x16 st;
#pragma unroll
            for (int r = 0; r < 16; ++r) st[r] = 0.f;
#pragma unroll
            for (int s = 0; s < 4; ++s) { const bf16x8 kf = *(const bf16x8*)(Kl + (jt * 32 + r32) * C3_RSK + (s * 16 + hi * 8) * 2); st = __builtin_amdgcn_mfma_f32_32x32x16_bf16(kf, qf[s], st, 0, 0, 0); }
#pragma unroll
            for (int g = 0; g < 4; ++g) { const int j0 = jt * 32 + 8 * g + 4 * hi;
                const f32x4 afp = *(const f32x4*)(vec + 256 + j0), bbp = *(const f32x4*)(vec + 384 + j0);
#pragma unroll
                for (int e = 0; e < 4; ++e) { const int j = j0 + e; float f;
                    if (jt < it_) f = __expf(Afi - afp[e]);
                    else if (jt > it_) f = __expf(Bbi - bbp[e]);
                    else { const float ff = (j <= i) ? __expf(Afi - afp[e]) : 0.f; const bool bm = RET ? (j > i) : (j >= i); const float fb = bm ? __expf(Bbi - bbp[e]) : 0.f; f = ff + fb; }
                    st[4 * g + e] *= f; } }
#pragma unroll
            for (int s2 = 0; s2 < 2; ++s2) {
                u32x4 pw; pw.x = pk2(st[8 * s2 + 0], st[8 * s2 + 1]); pw.y = pk2(st[8 * s2 + 2], st[8 * s2 + 3]); pw.z = pk2(st[8 * s2 + 4], st[8 * s2 + 5]); pw.w = pk2(st[8 * s2 + 6], st[8 * s2 + 7]);
                const bf16x8 pb = __builtin_bit_cast(bf16x8, pw);
#pragma unroll
                for (int pt = 0; pt < 2; ++pt) { const unsigned char* vp = Vl + (jt * 32 + 16 * s2) * C3_RSV + pt * 64 + troff;
                    const v4i16_t lo = lds_tr(vp), hi2 = lds_tr(vp + 8 * C3_RSV);
                    const bf16x8 va = {lo[0], lo[1], lo[2], lo[3], hi2[0], hi2[1], hi2[2], hi2[3]};
                    if (pt == 0) y0 = __builtin_amdgcn_mfma_f32_32x32x16_bf16(va, pb, y0, 0, 0, 0); else y1 = __builtin_amdgcn_mfma_f32_32x32x16_bf16(va, pb, y1, 0, 0, 0); }
            }
        }
        { const float ef = __expf(Afi), eb = __expf(Bbi);
#pragma unroll
          for (int pt = 0; pt < 2; ++pt) { f32x16 tf, tb;
#pragma unroll
              for (int r = 0; r < 16; ++r) { tf[r] = 0.f; tb[r] = 0.f; }
              const unsigned char* hf = Hl + (pt * 32 + r32) * C3_RSK + hi * 16;
#pragma unroll
              for (int s = 0; s < 4; ++s) { tf = __builtin_amdgcn_mfma_f32_32x32x16_bf16(*(const bf16x8*)(hf + s * 32), qf[s], tf, 0, 0, 0); tb = __builtin_amdgcn_mfma_f32_32x32x16_bf16(*(const bf16x8*)(hf + 64 * C3_RSK + s * 32), qf[s], tb, 0, 0, 0); }
#pragma unroll
              for (int r = 0; r < 16; ++r) { if (pt == 0) y0[r] += ef * tf[r] + eb * tb[r]; else y1[r] += ef * tf[r] + eb * tb[r]; } } }
        float* Tw = (float*)(lds + (wid < 5 ? C3_V + wid * 8704 : C3_H + (wid - 5) * 8704));
        u32x4 xsr[4] = {{0u, 0u, 0u, 0u}, {0u, 0u, 0u, 0u}, {0u, 0u, 0u, 0u}, {0u, 0u, 0u, 0u}};
        if (!RET) {
#pragma unroll
            for (int k = 0; k < 4; ++k) xsr[k] = *(const u32x4*)(Vl + (it_ * 32 + (lane >> 3) + 8 * k) * C3_RSV + (lane & 7) * 16); }
        __syncthreads();
        if (RET) {
            float s1 = 0.f, s2 = 0.f;
#pragma unroll
            for (int r = 0; r < 16; ++r) { y0[r] *= 0.125f; y1[r] *= 0.125f; s1 += y0[r] + y1[r]; s2 += y0[r] * y0[r] + y1[r] * y1[r]; }
            s1 += __shfl_xor(s1, 32); s2 += __shfl_xor(s2, 32);
            const float mu = s1 * (1.f / 64.f), var = fmaxf(s2 * (1.f / 64.f) - mu * mu, 0.f), rs = __builtin_amdgcn_rsqf(var + EPS);
#pragma unroll
            for (int r = 0; r < 16; ++r) { y0[r] = (y0[r] - mu) * rs; y1[r] = (y1[r] - mu) * rs; }
        }
#pragma unroll
        for (int g = 0; g < 4; ++g) { *(f32x4*)(Tw + r32 * 68 + 8 * g + 4 * hi) = (f32x4){y0[4 * g], y0[4 * g + 1], y0[4 * g + 2], y0[4 * g + 3]}; *(f32x4*)(Tw + r32 * 68 + 32 + 8 * g + 4 * hi) = (f32x4){y1[4 * g], y1[4 * g + 1], y1[4 * g + 2], y1[4 * g + 3]}; }
        asm volatile("s_waitcnt lgkmcnt(0)" ::: "memory");
        { const int ch = lane & 7; const float dsk = RET ? 0.f : IN(20)[l * 8 + h];
#pragma unroll
          for (int k = 0; k < 4; ++k) { const int tr = (lane >> 3) + 8 * k; const size_t rowt = (size_t)(row0 + it_ * 32 + tr);
              f32x4 ya[2] = {*(const f32x4*)(Tw + tr * 68 + ch * 8), *(const f32x4*)(Tw + tr * 68 + ch * 8 + 4)};
              if (RET) { f32x4 gv[2]; unpack8(*(const u32x4*)(proj + rowt * INWP + C_RG + h * 64 + ch * 8), gv);
#pragma unroll
                  for (int q = 0; q < 2; ++q)
#pragma unroll
                      for (int e = 0; e < 4; ++e) ya[q][e] *= siluf(gv[q][e]);
                  *(u32x4*)(MIX + rowt * D + 256 + h * 64 + ch * 8) = pack8(ya, 1.f);
              } else { f32x4 xv[2], zv[2]; unpack8(xsr[k], xv); unpack8(*(const u32x4*)(proj + rowt * INWP + C_Z + h * 64 + ch * 8), zv); float sq = 0.f;
#pragma unroll
                  for (int q = 0; q < 2; ++q)
#pragma unroll
                      for (int e = 0; e < 4; ++e) { ya[q][e] = (ya[q][e] + xv[q][e] * dsk) * siluf(zv[q][e]); sq += ya[q][e] * ya[q][e]; }
                  *(u32x4*)(MIX + rowt * D + 512 + h * 64 + ch * 8) = pack8(ya, 1.f);
                  sq += __shfl_xor(sq, 1); sq += __shfl_xor(sq, 2); sq += __shfl_xor(sq, 4); ssqk[k] += sq; } } }
    }
    if (!RET) {
        float* X = (float*)(lds + C3_X);
#pragma unroll
        for (int k = 0; k < 4; ++k) if ((lane & 7) == 0) X[hsub * 128 + it_ * 32 + (lane >> 3) + 8 * k] = ssqk[k];
        asm volatile("s_waitcnt vmcnt(0)" ::: "memory");
        __syncthreads();
        const float* nw = IN(21) + l * 512; const int ch = lane & 7;
#pragma unroll 1
        for (int h = hsub * 4; h < hsub * 4 + 4; ++h) { f32x4 wv[2] = {*(const f32x4*)(nw + h * 64 + ch * 8), *(const f32x4*)(nw + h * 64 + ch * 8 + 4)};
#pragma unroll
            for (int k = 0; k < 4; ++k) { const int tr = it_ * 32 + (lane >> 3) + 8 * k; const float rstd = __builtin_amdgcn_rsqf((X[tr] + X[128 + tr]) * (1.f / 512.f) + EPS);
                bf16* mp = MIX + (size_t)(row0 + tr) * D + 512 + h * 64 + ch * 8; f32x4 v[2]; unpack8(*(const u32x4*)mp, v);
                v[0] = v[0] * wv[0] * rstd; v[1] = v[1] * wv[1] * rstd; *(u32x4*)mp = pack8(v, 1.f); } }
    }
    __syncthreads();
}
DEVI void ph_scanC(const P& p, int l, unsigned char* lds) {
    const int tid = otid(), wid = __builtin_amdgcn_readfirstlane(tid >> 6), lane = tid & 63;
    const int NU = 2 * NCC;
    if (gridDim.x == 256) {
        const int c = blockIdx.x;
        if (c < NU) scanC_unit<false>(p, l, c, lds, tid, wid, lane);
        else { const int r = c - NU; scanC_unit<true>(p, l, r, lds, tid, wid, lane); if (r + 124 < NU) scanC_unit<true>(p, l, r + 124, lds, tid, wid, lane);
            if (l == 0 && r >= 8 && r < 16) attn_unit<0>(p, 256 + (r - 8), lds, (bf16*)(p.ws + WS_HM));
            if (r >= 8) { if (l == 0) cvt_static(p, lds, 2, (r - 8) * NWAVES + wid, 116 * NWAVES, wid, lane); else ph_moew(p, lds, 2, (r - 8) * NWAVES + wid, 116 * NWAVES); } }
    } else {
        for (int u = blockIdx.x; u < 2 * NU; u += gridDim.x) { if (u < NU) scanC_unit<false>(p, l, u, lds, tid, wid, lane); else scanC_unit<true>(p, l, u - NU, lds, tid, wid, lane); }
        const int gw = blockIdx.x * NWAVES + wid, ngw = gridDim.x * NWAVES;
        if (l == 0) { cvt_static(p, lds, 1, gw, ngw, wid, lane); cvt_static(p, lds, 2, gw, ngw, wid, lane); } else { ph_moew(p, lds, 1, gw, ngw); ph_moew(p, lds, 2, gw, ngw); }
    }
}
DEVI void ph_scanA(const P& p, int l, unsigned char* lds) { for (int u = gridDim.x - 1 - blockIdx.x; u < 2 * NCC * 3; u += gridDim.x) scanA_unit(p, l, u, lds);
    if (gridDim.x == 256 && blockIdx.x >= 8 && blockIdx.x < 116) {
        const int tid = otid(), wid = __builtin_amdgcn_readfirstlane(tid >> 6), lane = tid & 63, gw = (blockIdx.x - 8) * NWAVES + wid;
        if (l == 0) cvt_static(p, lds, 1, gw, 108 * NWAVES, wid, lane); else ph_moew(p, lds, 1, gw, 108 * NWAVES); } }
DEVI void ph_mixer(const P& p, int l, unsigned char* lds) {
    for (int u = blockIdx.x; u < 256; u += gridDim.x) scanB_slab(p, u, 384, 768);
    for (int a = blockIdx.x; a < 256; a += gridDim.x) attn_unit<0>(p, (a & 7) * 32 + (a >> 3), lds, (bf16*)(p.ws + WS_HM));
#if ATTN_PROBE
    if (l == 0) { __syncthreads(); for (int a = blockIdx.x; a < 256; a += gridDim.x) attn_unit<ATTN_PROBE>(p, (a & 7) * 32 + (a >> 3), lds, (bf16*)p.out); }
#endif
    if (l == 0 && gridDim.x != 256) for (int a = blockIdx.x; a < 8; a += gridDim.x) attn_unit<0>(p, 256 + a, lds, (bf16*)(p.ws + WS_HM));
}

DEVI void ph_sort(const P& p, unsigned char* lds) {
    const int tid = otid(), wid = tid >> 6, lane = tid & 63;
    const int* rt_e = (const int*)(p.ws + WS_RT); int* rt_pos = (int*)(p.ws + WS_RT + 256 * 1024); int* tab = (int*)(p.ws + WS_RT + 384 * 1024); int* rt_tok = (int*)(p.ws + WS_RT + 640 * 1024);
    int* sh = (int*)lds;
    const int G = gridDim.x, R = (NLAT + G - 1) / G;
    for (int blk = blockIdx.x; blk * R < NLAT; blk += G) {
        const int r0 = blk * R, r1 = (r0 + R < NLAT) ? r0 + R : NLAT;
        int ct[8], cb[8];
#pragma unroll
        for (int e = 0; e < 8; ++e) { ct[e] = 0; cb[e] = 0; }
        for (int i = tid; i < NLAT * 2; i += NTHREADS) { const int e = rt_e[i]; const bool bef = (i >> 1) < r0;
#pragma unroll
            for (int x = 0; x < 8; ++x) { const int hit = (e == x) ? 1 : 0; ct[x] += hit; cb[x] += bef ? hit : 0; } }
#pragma unroll
        for (int e = 0; e < 8; ++e) {
#pragma unroll
            for (int o = 1; o < 64; o <<= 1) { ct[e] += __shfl_xor(ct[e], o); cb[e] += __shfl_xor(cb[e], o); }
        }
        __syncthreads();
        if (lane == 0) {
#pragma unroll
            for (int e = 0; e < 8; ++e) { sh[wid * 8 + e] = ct[e]; sh[64 + wid * 8 + e] = cb[e]; } }
        __syncthreads();
        if (tid == 0) { int start = 0, nt = 0;
            for (int e = 0; e < 8; ++e) { int tot = 0, bef = 0; for (int w = 0; w < 8; ++w) { tot += sh[w * 8 + e]; bef += sh[64 + w * 8 + e]; }
                sh[128 + e] = start; sh[136 + e] = start + bef; sh[144 + e] = tot; const int ntile = (tot + 255) >> 8;
                if (blk == 0) { for (int t = 0; t < ntile; ++t) tab[1 + nt + t] = e; }
                nt += ntile; start += ntile * 256; }
            if (blk == 0) tab[0] = nt; }
        __syncthreads();
        { const int n_ent = (r1 - r0) * 2; const bool valid = tid < n_ent; const int e = valid ? rt_e[r0 * 2 + tid] : -1; int rank = 0;
#pragma unroll
          for (int x = 0; x < 8; ++x) { const unsigned long long m = __ballot(e == x); if (e == x) rank = __popcll(m & ((1ull << lane) - 1ull)); if (lane == 0) sh[160 + wid * 8 + x] = __popcll(m); }
          __syncthreads();
          if (valid) { int pos = sh[136 + e] + rank; for (int w = 0; w < wid; ++w) pos += sh[160 + w * 8 + e]; sh[256 + tid] = pos; rt_pos[r0 * 2 + tid] = pos; } }
        __syncthreads();
        { const int n_ent = (r1 - r0) * 2; if (tid < n_ent) rt_tok[sh[256 + tid]] = r0 + (tid >> 1); }
        if (blk == 0) { for (int e = 0; e < 8; ++e) { const int tot = sh[144 + e], beg = sh[128 + e] + tot, end = sh[128 + e] + ((tot + 255) & ~255); for (int i = beg + tid; i < end; i += NTHREADS) rt_tok[i] = 0; } }
        __syncthreads();
    }
}
DEVI void ph_final(const P& p) {
    const int tid = otid(), wid = tid >> 6, lane = tid & 63;
    const float* rt_g = (const float*)(p.ws + WS_RT + 128 * 1024); const int* rt_pos = (const int*)(p.ws + WS_RT + 256 * 1024);
    const bf16* YS = (const bf16*)(p.ws + WS_HS); const float* modv = (const float*)(p.ws + WS_MODV) + (size_t)1 * 3 * 6144; const float* fw = IN(29);
    const int nw = gridDim.x * NWAVES, rpw = (NLAT + nw - 1) / nw, gw = blockIdx.x * NWAVES + wid;
    const int row0 = gw * rpw, row1 = (row0 + rpw < NLAT) ? row0 + rpw : NLAT;
    f32x4 fwv[4], gv[4]; int rc = -1;
#pragma unroll
    for (int j = 0; j < 4; ++j) fwv[j] = *(const f32x4*)(fw + (j * 64 + lane) * 4);
    for (int row = row0; row < row1; ++row) {
        const int b = row >> 13; float* x = p.out + (size_t)row * D; const bf16* xr = (const bf16*)(p.ws + WS_X16) + (size_t)row * D;
        if (b != rc) { rc = b;
#pragma unroll
            for (int j = 0; j < 4; ++j) gv[j] = *(const f32x4*)(modv + b * 6144 + 5 * 1024 + (j * 64 + lane) * 4); }
        const float g0 = rt_g[row * 2], g1 = rt_g[row * 2 + 1]; const bf16* y0 = YS + (size_t)rt_pos[row * 2] * D; const bf16* y1 = YS + (size_t)rt_pos[row * 2 + 1] * D;
        f32x4 v[4]; float ss = 0.f;
#pragma unroll
        for (int j = 0; j < 4; ++j) { const int c0 = (j * 64 + lane) * 4; const u32x2 xb = *(const u32x2*)(xr + c0); const f32x4 xv = {bf2f(xb.x & 0xffff), bf2f(xb.x >> 16), bf2f(xb.y & 0xffff), bf2f(xb.y >> 16)}; const u32x2 a = *(const u32x2*)(y0 + c0), c = *(const u32x2*)(y1 + c0);
            const f32x4 ya = {bf2f(a.x & 0xffff), bf2f(a.x >> 16), bf2f(a.y & 0xffff), bf2f(a.y >> 16)}, yb = {bf2f(c.x & 0xffff), bf2f(c.x >> 16), bf2f(c.y & 0xffff), bf2f(c.y >> 16)};
            v[j] = xv + gv[j] * (ya * g0 + yb * g1); ss += v[j][0] * v[j][0] + v[j][1] * v[j][1] + v[j][2] * v[j][2] + v[j][3] * v[j][3]; }
        ss = wave_sum(ss); const float rstd = __builtin_amdgcn_rsqf(ss * (1.f / D) + EPS);
#pragma unroll
        for (int j = 0; j < 4; ++j) { const int c0 = (j * 64 + lane) * 4; *(f32x4*)(x + c0) = v[j] * rstd * fwv[j]; }
    }
}

#define XB_TMO      128
#define XB_XCNT(j)  (256  + 64 * (j))
#define XB_XSUB(j)  (1280 + 64 * (j))
#define XB_XGEN(j)  (2304 + 64 * (j))
#define XB_TOP      3328
#define XB_TOPGEN   3392
#define XCD_BAR_WORDS 3456
#define XB_SPIN_CAP (1u << 22)
DEVI unsigned xb_ld(unsigned* p)              { return __hip_atomic_load(p, __ATOMIC_RELAXED, __HIP_MEMORY_SCOPE_AGENT); }
DEVI unsigned xb_add(unsigned* p, unsigned v) { return __hip_atomic_fetch_add(p, v, __ATOMIC_RELAXED, __HIP_MEMORY_SCOPE_AGENT); }
DEVI unsigned xb_xcc_id() { return (unsigned)__builtin_amdgcn_s_getreg((3 << 11) | 20) & 0xFu; }
#define XB_SPIN(cond, bar) do { unsigned _sp = 0; while (cond) { __builtin_amdgcn_s_sleep(1); \
    if ((++_sp & 255u) == 0u) { if (xb_ld(&(bar)[XB_TMO])) break; if (_sp > XB_SPIN_CAP) { atomicAdd(&(bar)[XB_TMO], 1u); break; } } } } while (0)
struct XcdBarrier { unsigned* bar; unsigned x; volatile LAS unsigned* st; };
DEVI XcdBarrier xcd_barrier_post(unsigned* bar, volatile LAS unsigned* st) {
    XcdBarrier b; b.bar = bar; b.x = xb_xcc_id(); b.st = st;
    if (threadIdx.x == 0) (void)xb_add(&bar[XB_XCNT(b.x)], 1u);
    return b;
}
DEVI void xcd_barrier_complete(unsigned* bar, unsigned x, unsigned& nloc, unsigned& nx) {
    const unsigned G = gridDim.x * gridDim.y * gridDim.z;
    unsigned sum, cnt, mine, sp = 0u;
    for (;;) {
        sum = 0u; cnt = 0u; mine = 0u;
#pragma unroll
        for (unsigned j = 0; j < 16; ++j) { const unsigned c = xb_ld(&bar[XB_XCNT(j)]); sum += c; cnt += (c > 0u) ? 1u : 0u; mine = (j == x) ? c : mine; }
        if (sum == G) break;
        __builtin_amdgcn_s_sleep(1);
        if ((++sp & 255u) == 0u) { if (xb_ld(&bar[XB_TMO])) break; if (sp > XB_SPIN_CAP) { atomicAdd(&bar[XB_TMO], 1u); break; } }
    }
    nloc = mine > 0u ? mine : 1u; nx = cnt > 0u ? cnt : 1u;
}
DEVI void xcd_barrier(const XcdBarrier& b) {
    asm volatile("s_waitcnt vmcnt(0)" ::: "memory");
    __syncthreads();
    if (threadIdx.x == 0) {
        unsigned* bar = b.bar;
        __builtin_amdgcn_s_waitcnt(0);
        unsigned nloc = b.st[0], nx = b.st[1];
        if (nloc == 0u) { xcd_barrier_complete(bar, b.x, nloc, nx); b.st[0] = nloc; b.st[1] = nx; }
        const unsigned old = xb_add(&bar[XB_XSUB(b.x)], 1u);
        const unsigned gen = old / nloc;
        if (old + 1u == (gen + 1u) * nloc) {
            __builtin_amdgcn_fence(__ATOMIC_RELEASE, "agent");
            asm volatile("s_waitcnt vmcnt(0)" ::: "memory");
            const unsigned og = xb_add(&bar[XB_TOP], 1u);
            const unsigned tg = og / nx;
            if (og + 1u == (tg + 1u) * nx) xb_add(&bar[XB_TOPGEN], 1u);
            else XB_SPIN(xb_ld(&bar[XB_TOPGEN]) == tg, bar);
            __builtin_amdgcn_fence(__ATOMIC_ACQUIRE, "agent");
            xb_add(&bar[XB_XGEN(b.x)], 1u);
            asm volatile("s_waitcnt vmcnt(0)" ::: "memory");
        } else {
            XB_SPIN(xb_ld(&bar[XB_XGEN(b.x)]) == gen, bar);
            __builtin_amdgcn_fence(__ATOMIC_ACQUIRE, "agent");
            asm volatile("s_waitcnt vmcnt(0)" ::: "memory");
        }
    }
    __syncthreads();
}

constexpr int NPHASES = 21;
#ifndef XSYNC
#define XSYNC 0
#endif
#ifndef REP_MASK
#define REP_MASK 0u
#endif
#ifndef PH_MASK
#define PH_MASK 0xffffu
#endif
#ifndef MK_CG_FIRST
#define MK_CG_FIRST 0
#endif
__global__ void __launch_bounds__(NTHREADS, 2) mk_fwd(P p) {
    extern __shared__ __attribute__((aligned(16))) unsigned char lds[];
#if MK_CG_FIRST
    cg::grid_group grid = cg::this_grid();
#endif
    const int G = gridDim.x, c = blockIdx.x;
    if (threadIdx.x < 30) ((lds_u64*)(uintptr_t)LDS_PTRS)[threadIdx.x] = (unsigned long long)p.in[threadIdx.x];
    if (threadIdx.x < 2) ((volatile LAS unsigned*)(uintptr_t)LDS_MISC)[threadIdx.x] = 0u;
    __syncthreads();
    unsigned* barw = (unsigned*)(p.ws + WS_CTL) + 1024;
#if MK_CG_FIRST
    if (blockIdx.x == 0) { for (int i = threadIdx.x; i < XCD_BAR_WORDS; i += NTHREADS) barw[i] = 0u; }
    XcdBarrier xbar; xbar.bar = barw; xbar.x = 0; xbar.st = (volatile LAS unsigned*)(uintptr_t)LDS_MISC;
    int nsync = 0;
#define GRID_BAR() do { if (nsync == 0) { grid.sync(); xbar = xcd_barrier_post(barw, (volatile LAS unsigned*)(uintptr_t)LDS_MISC); } else xcd_barrier(xbar); ++nsync; } while (0)
#else
    const XcdBarrier xbar = xcd_barrier_post(barw, (volatile LAS unsigned*)(uintptr_t)LDS_MISC);
#define GRID_BAR() xcd_barrier(xbar)
#endif
    int ph = 0;
#define RUN(kid, ...) do { if (((PH_MASK >> (kid)) & 1u) && ph >= p.ph_lo && ph < p.ph_hi) { __VA_ARGS__; if ((REP_MASK >> (kid)) & 1u) { __VA_ARGS__; } if (ph + 1 < p.ph_hi) { GRID_BAR(); for (int xs_ = 0; xs_ < XSYNC; ++xs_) GRID_BAR(); } } ++ph; } while (0)
    RUN(0, ph_pro(p, lds));
#define LAYER(l) \
        RUN(1, ph_norm<false>(p, l, 0, T, lds, l == 1 ? 11 : 0, 5)); \
        RUN(2, { Gemm g{(const bf16*)(p.ws + WS_HM), (const bf16*)(p.ws + WS_WIN) + (size_t)l * INWP * 1024, 0, nullptr}; DenseSched S{T / 256, INWP / 256, G, c}; \
            EpiInProj E{(bf16*)(p.ws + WS_PROJ), (float*)(p.ws + WS_DT), IN(18) + l * 16, IN(19) + l * 16, (float*)(p.ws + WS_RQP), (float*)(p.ws + WS_RKVP)}; gemm_phase<D, 1024, 1024>(lds, g, S, E); }); \
        RUN(4, { Gemm g{(const bf16*)(p.ws + WS_PROJ), (const bf16*)(p.ws + WS_WQKV) + (size_t)l * 1024 * 384, 0, nullptr}; DenseSched S{T / 256, 4, G, c}; \
            EpiMla E{(bf16*)(p.ws + WS_Q), (bf16*)(p.ws + WS_K), (bf16*)(p.ws + WS_V), (const float*)(p.ws + WS_RQP), (const float*)(p.ws + WS_RKVP), (const float*)(p.ws + WS_ROPE), (const bf16*)(p.ws + WS_PROJ)}; gemm_phase<INWP, 384, 384>(lds, g, S, E); ph_scanA(p, l, lds); }); \
        RUN(5, ph_mixer(p, l, lds)); \
        RUN(6, ph_scanC(p, l, lds)); \
        RUN(8, { Gemm g{(const bf16*)(p.ws + WS_HM), (const bf16*)(p.ws + WS_WOUT) + (size_t)l * 1024 * 1024, 0, nullptr}; DenseSched S{NLAT / 256, 4, G, c}; \
            EpiResid E{IN(0), (const bf16*)(p.ws + WS_X16), l == 0, (bf16*)(p.ws + WS_X16), (const float*)(p.ws + WS_MODV) + (size_t)l * 3 * 6144, 2}; gemm_phase<D, 1024, 1024>(lds, g, S, E); \
            if (l == 0) { CtxSplitSched S2{4, 256 * 2, G, c}; EpiPart E2{(float*)(p.ws + WS_XBC)}; gemm_phase<D, 1024, 256>(lds, g, S2, E2); } }); \
        RUN(9, ph_norm<l == 1>(p, l, 1, l == 0 ? T : NLAT, lds, l == 0 ? 4 : 0, 2)); \
        if (l == 0) { \
            RUN(10, { Gemm g{(const bf16*)(p.ws + WS_HM), (const bf16*)(p.ws + WS_WGU), 0, nullptr}; DenseSched S{T / 256, 2 * DFF / 256, G, c}; \
                EpiSwiglu E{(bf16*)(p.ws + WS_PROJ), DFF}; gemm_phase<D, 1024, 1024>(lds, g, S, E); }); \
            RUN(11, { Gemm g{(const bf16*)(p.ws + WS_PROJ), (const bf16*)(p.ws + WS_WD), 0, nullptr}; DenseSched S{NLAT / 256, 4, G, c}; \
                EpiResid E{IN(0), (const bf16*)(p.ws + WS_X16), false, (bf16*)(p.ws + WS_X16), (const float*)(p.ws + WS_MODV), 5}; gemm_phase<DFF, DFF, DFF>(lds, g, S, E); \
                CtxSplitSched S2{11, 256 * 2, G, c}; EpiPart E2{(float*)(p.ws + WS_XBC)}; gemm_phase<DFF, DFF, 256>(lds, g, S2, E2); }); \
        } else { \
            RUN(12, { ph_sort(p, lds); __syncthreads(); ph_moew(p, lds, 0, blockIdx.x * NWAVES + (int)(threadIdx.x >> 6), gridDim.x * NWAVES); }); \
            RUN(13, { Gemm g{(const bf16*)(p.ws + WS_HM), (const bf16*)(p.ws + WS_WGUE), (size_t)2 * DFE * 1024, (const int*)(p.ws + WS_RT + 640 * 1024)}; MoeSched S{(const int*)(p.ws + WS_RT + 384 * 1024), 2 * DFE / 256, G, c}; \
                EpiSwiglu E{(bf16*)(p.ws + WS_ACTS), DFE}; gemm_phase<D, 1024, 1024, EpiSwiglu, MoeSched, true>(lds, g, S, E); }); \
            RUN(14, { Gemm g{(const bf16*)(p.ws + WS_ACTS), (const bf16*)(p.ws + WS_WDE), (size_t)1024 * DFE, nullptr}; MoeSched S{(const int*)(p.ws + WS_RT + 384 * 1024), 4, G, c}; \
                EpiStore E{(bf16*)(p.ws + WS_HS), D}; gemm_phase<DFE, DFE, DFE>(lds, g, S, E); }); \
            RUN(15, ph_final(p)); \
        }
    LAYER(0)
    LAYER(1)
#undef LAYER
#undef RUN
}

#ifndef MK_ONE_LAUNCH
#define MK_ONE_LAUNCH 1
#endif
extern "C" void kernel_launch(void* const* d_in, const int* in_sizes, int n_in, void* d_out, int out_size, void* d_ws, size_t ws_size, hipStream_t stream) {
    static int grid = 0;
    if (grid == 0) {
        if (n_in != 30 || out_size != NLAT * D || ws_size < WS_END) { fprintf(stderr, "kernel_launch: unexpected problem (n_in %d out %d ws %zu, need %zu)\n", n_in, out_size, ws_size, (size_t)WS_END); grid = -1; return; }
        int dev = 0, cus = 0, per_cu = 0;
        hipGetDevice(&dev); hipDeviceGetAttribute(&cus, hipDeviceAttributeMultiprocessorCount, dev);
        if (hipFuncSetAttribute((const void*)mk_fwd, hipFuncAttributeMaxDynamicSharedMemorySize, LDS_BYTES) != hipSuccess) { fprintf(stderr, "kernel_launch: hipFuncSetAttribute failed\n"); grid = -1; return; }
        if (hipOccupancyMaxActiveBlocksPerMultiprocessor(&per_cu, (const void*)mk_fwd, NTHREADS, LDS_BYTES) != hipSuccess || per_cu < 1) { fprintf(stderr, "kernel_launch: occupancy query failed (%d)\n", per_cu); grid = -1; return; }
        grid = cus;
        fprintf(stderr, "kernel_launch: grid %d (cus %d, per_cu %d)\n", grid, cus, per_cu);
    }
    if (grid < 0) return;
    P p{};
    for (int i = 0; i < 30; ++i) p.in[i] = (const float*)d_in[i];
    p.out = (float*)d_out; p.ws = (unsigned char*)d_ws;
#if !MK_CG_FIRST
    if (hipMemsetAsync((unsigned char*)d_ws + WS_CTL + 4096, 0, XCD_BAR_WORDS * sizeof(unsigned), stream) != hipSuccess) fprintf(stderr, "kernel_launch: memset failed\n");
#endif
#if MK_ONE_LAUNCH
    p.ph_lo = 0; p.ph_hi = NPHASES;
    { void* args[] = {&p}; hipError_t e = hipLaunchCooperativeKernel((const void*)mk_fwd, dim3(grid), dim3(NTHREADS), args, LDS_BYTES, stream);
      if (e != hipSuccess) fprintf(stderr, "cooperative launch failed: %s\n", hipGetErrorString(e)); }
#else
    for (int ph = 0; ph < NPHASES; ++ph) {
        p.ph_lo = ph; p.ph_hi = ph + 1;
        void* args[] = {&p}; hipError_t e = hipLaunchCooperativeKernel((const void*)mk_fwd, dim3(grid), dim3(NTHREADS), args, LDS_BYTES, stream);
        if (e != hipSuccess) { fprintf(stderr, "cooperative launch %d failed: %s\n", ph, hipGetErrorString(e)); break; }
    }
#endif
}
```

```cpp
#include <hip/hip_runtime.h>
#include <hip/hip_cooperative_groups.h>
#include <cstdio>
#include <cstdint>
namespace cg = cooperative_groups;
#ifndef ATTN_PROBE
#define ATTN_PROBE 0
#endif

#define DEVI __device__ __forceinline__
typedef unsigned short bf16;
typedef short bf16x8 __attribute__((ext_vector_type(8)));
typedef float f32x4 __attribute__((ext_vector_type(4)));
typedef float f32x2 __attribute__((ext_vector_type(2)));
typedef float f32x16 __attribute__((ext_vector_type(16)));
typedef unsigned u32x4 __attribute__((ext_vector_type(4)));
typedef unsigned u32x2 __attribute__((ext_vector_type(2)));
typedef __bf16 bf16x2_t __attribute__((ext_vector_type(2)));

constexpr int D = 1024, NB = 2, SEQ = 8192, NLAT = NB * SEQ, CL = 256, NCTX = NB * CL, T = NLAT + NCTX;
constexpr int INWS = 2736, INW = 2768, INWP = 2816;
constexpr int C_CQ = 0, C_CKV = 256, C_KPE = 384, C_GAP = 416, C_RQ = 448, C_RK = 704, C_RV = 960, C_RG = 1216, C_Z = 1472, C_XBC = 1984, C_DTF = 2752, C_DTB = 2760;
constexpr int DFF = 2816, DFE = 1408, NEXP = 8;
constexpr float EPS = 1e-6f;
constexpr int MOE_MAXROWS = 34816;

constexpr size_t MiB = 1u << 20;
constexpr size_t WS_CTL = 0;
constexpr size_t WS_MODV = 1 * MiB;
constexpr size_t WS_ROPE = WS_MODV + 256 * 1024;
constexpr size_t WS_RQ = WS_MODV + 512 * 1024;
constexpr size_t WS_RKV = WS_MODV + 640 * 1024;
constexpr size_t WS_WQKV = 2 * MiB;
constexpr size_t WS_WOUT = 4 * MiB;
constexpr size_t WS_WIN = 8 * MiB;
constexpr size_t WS_WGU = 19 * MiB;
constexpr size_t WS_WD = 30 * MiB;
constexpr size_t WS_XC = 36 * MiB;
constexpr size_t WS_RT = 38 * MiB;
constexpr size_t WS_DT = 39 * MiB;
constexpr size_t WS_RQP = 41 * MiB + 128 * 1024;
constexpr size_t WS_RKVP = 41 * MiB + 512 * 1024;
constexpr size_t WS_SSQ2 = 41 * MiB + 896 * 1024 - 8 * 1024;
constexpr size_t DYN = 42 * MiB;
constexpr size_t KiB = 1024;
constexpr size_t WS_HM = DYN;
constexpr size_t WS_PROJ = DYN + 33 * MiB;
constexpr size_t WS_XBC = DYN + 126720 * KiB;
constexpr size_t WS_Q = DYN + 152064 * KiB;
constexpr size_t WS_K = DYN + 164736 * KiB;
constexpr size_t WS_V = DYN + 177408 * KiB;
constexpr size_t WS_ST = DYN + 185856 * KiB;
constexpr size_t WS_HT = WS_ST + (size_t)1584 * 2 * 4096 * 2;
constexpr size_t WS_CD = WS_RT + 512 * 1024;
constexpr size_t WS_VEC = WS_HT + (size_t)1584 * 2 * 4096 * 2;
constexpr size_t WS_X16 = DYN + 239872 * KiB;
constexpr size_t WS_WGUE = DYN + 33 * MiB;
constexpr size_t WS_WDE = WS_WIN + (size_t)INWP * 1024 * 2;
constexpr size_t WS_HS = DYN;
constexpr size_t WS_ACTS = DYN + 99 * MiB;
constexpr size_t WS_HS2 = DYN + 68 * MiB;
constexpr size_t WS_END = WS_X16 + (size_t)NLAT * 1024 * 2;
static_assert(WS_HM + (size_t)T * 1024 * 2 <= WS_PROJ && WS_PROJ + (size_t)T * 2816 * 2 <= WS_XBC && WS_XBC + (size_t)T * 768 * 2 <= WS_Q &&
              WS_Q + (size_t)T * 384 * 2 <= WS_K && WS_K + (size_t)T * 384 * 2 <= WS_V && WS_V + (size_t)T * 256 * 2 <= WS_ST && WS_VEC + (size_t)1584 * 512 * 4 <= WS_X16, "ws map (mixer)");
static_assert(WS_WGUE + (size_t)8 * 2816 * 1024 * 2 <= WS_ACTS && WS_WDE + (size_t)8 * 1024 * 1408 * 2 <= WS_XC && WS_HS + (size_t)MOE_MAXROWS * 1024 * 2 <= WS_ACTS &&
              WS_ACTS + (size_t)MOE_MAXROWS * 1408 * 2 <= WS_X16 && WS_XBC + (size_t)11 * NCTX * 1024 * 4 <= WS_X16, "ws map (moe)");
static_assert(WS_DT + (size_t)T * 32 * 4 <= DYN && WS_WD + (size_t)1024 * 2816 * 2 <= WS_XC && WS_WIN + (size_t)2 * 2816 * 1024 * 2 <= WS_WGU && WS_WQKV + (size_t)2 * 1024 * 384 * 2 <= WS_WOUT && WS_WOUT + (size_t)2 * 1024 * 1024 * 2 <= WS_WIN, "ws map (static)");

constexpr int NTHREADS = 512, NWAVES = 8;
constexpr int LDS_BYTES = 147456;

struct P { const float* in[30]; float* out; unsigned char* ws; int ph_lo, ph_hi; };
constexpr int LDS_MISC = 147456 - 512;
constexpr int LDS_PTRS = 147456 - 256;
typedef __attribute__((address_space(3))) unsigned long long lds_u64;
DEVI const float* inptr(int i) {
    const unsigned long long v = ((lds_u64*)(uintptr_t)LDS_PTRS)[i];
    const unsigned lo = __builtin_amdgcn_readfirstlane((unsigned)v), hi = __builtin_amdgcn_readfirstlane((unsigned)(v >> 32));
    return (const float*)(((unsigned long long)hi << 32) | lo);
}
#define IN(i) inptr(i)
DEVI int otid() { int t = threadIdx.x; asm volatile("" : "+v"(t)); return t; }

DEVI float bf2f(bf16 x) { return __uint_as_float(((unsigned)x) << 16); }
DEVI unsigned pk2(float lo, float hi) { f32x2 v = {lo, hi}; bf16x2_t b = __builtin_convertvector(v, bf16x2_t); return __builtin_bit_cast(unsigned, b); }
DEVI bf16 f2bf(float x) { return (bf16)(pk2(x, 0.f) & 0xffffu); }
DEVI float wave_sum(float v) {
#pragma unroll
    for (int o = 1; o < 64; o <<= 1) v += __shfl_xor(v, o);
    return v;
}
DEVI float siluf(float x) { return x * __builtin_amdgcn_rcpf(1.f + __builtin_amdgcn_exp2f(-1.4426950408889634f * x)); }
DEVI float softplusf(float x) { const float e = __expf(-fabsf(x)); return fmaxf(x, 0.f) + (e < 1e-3f ? e * (1.f - 0.5f * e) : __logf(1.f + e)); }
DEVI int rope_src(int p) { const int q = p & 15, s = (q & 1) ? 8 + (q >> 1) : (q >> 1); return (p & 16) + s; }

#define LAS __attribute__((address_space(3)))
struct Unit { int pm, pn, e, koff; };
struct Gemm { const bf16* A; const bf16* Bt; size_t bstride; const int* rowtab; };
constexpr int BM = 256, BK = 64, HALF = 128, HTB = HALF * BK * 2, STAGE_BYTES = 8 * HTB, NXCD = 8, WGM = 4;
__host__ __device__ __forceinline__ int lds_byte(int r, int c) { const int st = (r >> 4) * 2 + (c >> 5), rr = r & 15, cc = c & 31, ob = rr * 64 + cc * 2; return st * 1024 + (ob ^ (((ob >> 9) & 1) << 5)); }
__host__ __device__ __forceinline__ int perm32(int rho) { const int n = rho >> 4, i = rho & 15; return 8 * (i >> 2) + 4 * n + (i & 3); }
__host__ __device__ __forceinline__ void stage_rc(int b, int& R, int& C) { const int st = b / 1024, sb = b % 1024, swz = sb ^ (((sb >> 9) & 1) << 5); R = (st >> 1) * 16 + swz / 64; C = (st & 1) * 32 + (swz % 64) / 2; }
struct DenseSched {
    int nM, nN, G, c; int wgm = WGM;
    DEVI bool next(int i, Unit& u) const {
        const int nwg = nM * nN; const long L = (long)i * G + c; if (L >= nwg) return false;
        int wgid = (int)L; { const int q = nwg / NXCD, r = nwg % NXCD, xcd = wgid % NXCD, off = wgid / NXCD; wgid = (xcd < r ? xcd * (q + 1) : r * (q + 1) + (xcd - r) * q) + off; }
        const int nig = wgm * nN, gid = wgid / nig, fm = gid * wgm, gsz = (nM - fm) < wgm ? (nM - fm) : wgm;
        u.pm = fm + ((wgid % nig) % gsz); u.pn = (wgid % nig) / gsz; u.e = 0; u.koff = 0; return true;
    }
};
struct CtxSplitSched {
    int nsplit, kbytes, G, c;
    DEVI bool next(int i, Unit& u) const { const int id = i * G + c; if (id >= 8 * nsplit) return false; const int tile = id & 7, ks = id >> 3; u.pm = 64 + (tile >> 2); u.pn = tile & 3; u.e = ks; u.koff = ks * kbytes; return true; }
};
struct MoeSched {
    const int* tab; int nN, G, c;
    DEVI bool next(int i, Unit& u) const { DenseSched d{tab[0], nN, G, c}; if (!d.next(i, u)) return false; u.e = tab[1 + u.pm]; return true; }
};
struct MoeMainSched {
    const int* tab; int nN, G, c;
    DEVI bool next(int i, Unit& u) const { const int nm = tab[0] < 128 ? tab[0] : 128; DenseSched d{nm, nN, G, c, 8}; if (!d.next(i, u)) return false; u.e = tab[1 + u.pm]; return true; }
};
struct MoeTailSched {
    const int* tab; int c, coff, koff;
    DEVI bool next(int i, Unit& u) const { const int ntail = (tab[0] - 128) * 4, id = c - coff; if (i > 0 || id < 0 || id >= ntail) return false;
        u.pm = 128 + (id >> 2); u.pn = id & 3; u.e = tab[1 + u.pm]; u.koff = koff; return true; }
};
template <int LDA, int LDB, int KK, class Epi, class Sched, bool GATHER = false, int HOOKT = -1>
DEVI void gemm_phase(unsigned char* lds_generic, const Gemm g, const Sched& S, const Epi& E) {
    LAS unsigned char* lds = (LAS unsigned char*)lds_generic;
    const int tid = otid(), wid = __builtin_amdgcn_readfirstlane(tid >> 6), lane = tid & 63, wr = wid >> 2, wc = wid & 3, fr = lane & 15, fq = lane >> 4;
    constexpr int nt = KK / BK; static_assert(KK % 128 == 0, "K must be a multiple of 128");
    unsigned voffA[2], voffB[2]; int Rr[2], Cc[2];
#pragma unroll
    for (int i = 0; i < 2; ++i) { int R, C; stage_rc(tid * 16 + i * 8192, R, C); Rr[i] = R; Cc[i] = C; voffA[i] = (unsigned)(R * LDA + C) * 2u; const int Rb = Epi::PERM ? ((R & ~31) + perm32(R & 31)) : R; voffB[i] = (unsigned)(Rb * LDB + C) * 2u; }
    unsigned cv0[2] = {voffA[0], voffA[1]}, cv1[2] = {voffA[0], voffA[1]}, nv0[2] = {voffA[0], voffA[1]}, nv1[2] = {voffA[0], voffA[1]};
#define PG8_ROWS(u, v0, v1) do { if (GATHER) { _Pragma("unroll") for (int i_ = 0; i_ < 2; ++i_) { v0[i_] = (unsigned)(g.rowtab[(u).pm * BM + Rr[i_]] * LDA + Cc[i_]) * 2u; v1[i_] = (unsigned)(g.rowtab[(u).pm * BM + HALF + Rr[i_]] * LDA + Cc[i_]) * 2u; } } } while (0)
    constexpr size_t kstep = (size_t)(BK * 2), hstepA = GATHER ? (size_t)0 : (size_t)HALF * LDA * 2, hstepB = (size_t)HALF * LDB * 2, tstepA = GATHER ? (size_t)0 : (size_t)2 * HALF * LDA * 2, tstepB = 2 * hstepB;
    const unsigned ldsw = (unsigned)wid * 1024u;
    const int aoff = lds_byte(wr * 64 + fr, fq * 8), boff = lds_byte(wc * 32 + fr, fq * 8);
#define PG8_SA(b, h) (((b) * 2 + (h)) * HTB)
#define PG8_SB(b, h) ((4 + (b) * 2 + (h)) * HTB)
#define PG8_STAGE(bufoff, gbase, voff) do { _Pragma("unroll") for (int _i = 0; _i < 2; ++_i) \
        __builtin_amdgcn_global_load_lds((const unsigned*)((const char*)(gbase) + (voff)[_i]), (LAS unsigned*)(lds + (bufoff) + ldsw + _i * 8192), 16, 0, 0); } while (0)
#define PG8_LDA(dst, b, h) do { _Pragma("unroll") for (int m = 0; m < 4; ++m) _Pragma("unroll") for (int k = 0; k < 2; ++k) dst[m][k] = *(const LAS bf16x8*)(lds + PG8_SA(b, h) + aoff + m * 2048 + k * 1024); } while (0)
#define PG8_LDB(dst, b, h) do { _Pragma("unroll") for (int n = 0; n < 2; ++n) _Pragma("unroll") for (int k = 0; k < 2; ++k) dst[n][k] = *(const LAS bf16x8*)(lds + PG8_SB(b, h) + boff + n * 2048 + k * 1024); } while (0)
#define PG8_MMA(ai, bj, At, Bt) do { __builtin_amdgcn_s_setprio(1); _Pragma("unroll") for (int m = 0; m < 4; ++m) _Pragma("unroll") for (int n = 0; n < 2; ++n) _Pragma("unroll") for (int k = 0; k < 2; ++k) \
        acc[ai][bj][m][n] = __builtin_amdgcn_mfma_f32_16x16x32_bf16(Bt[n][k], At[m][k], acc[ai][bj][m][n], 0, 0, 0); __builtin_amdgcn_s_setprio(0); } while (0)
#define PG8_WAIT_V(n) asm volatile("s_waitcnt vmcnt(" #n ")" ::: "memory")
#define PG8_WAIT_L(n) asm volatile("s_waitcnt lgkmcnt(" #n ")" ::: "memory")
#define PG8_BAR __builtin_amdgcn_s_barrier()
#define PG8_SCHED __builtin_amdgcn_sched_barrier(0)
    Unit cur, nxt; int ui = 0;
    if (!S.next(0, cur)) return;
    f32x4 acc[2][2][4][2];
#pragma unroll
    for (int a = 0; a < 2; ++a)
#pragma unroll
        for (int b = 0; b < 2; ++b)
#pragma unroll
            for (int m = 0; m < 4; ++m)
#pragma unroll
                for (int n = 0; n < 2; ++n) acc[a][b][m][n] = (f32x4){0.f, 0.f, 0.f, 0.f};
    bf16x8 At[4][2], B0[2][2], B1[2][2];
    const char* cA = (const char*)g.A + (size_t)cur.pm * tstepA + cur.koff; const char* cB = (const char*)(g.Bt + (size_t)cur.e * g.bstride) + (size_t)cur.pn * tstepB + cur.koff;
    PG8_WAIT_V(0); PG8_WAIT_L(0); __syncthreads();
    PG8_ROWS(cur, cv0, cv1);
    PG8_STAGE(PG8_SB(0, 0), cB, voffB); PG8_STAGE(PG8_SB(0, 1), cB + hstepB, voffB); PG8_STAGE(PG8_SA(0, 0), cA, cv0); PG8_STAGE(PG8_SA(0, 1), cA + hstepA, cv1);
    if (wr == 1) PG8_BAR;
    PG8_WAIT_V(2); PG8_BAR;
    PG8_STAGE(PG8_SB(1, 0), cB + kstep, voffB); PG8_STAGE(PG8_SA(1, 0), cA + kstep, cv0); PG8_STAGE(PG8_SB(1, 1), cB + hstepB + kstep, voffB);
    PG8_WAIT_V(6); PG8_BAR;
    for (;;) {
        const bool has_next = S.next(ui + 1, nxt);
        if (has_next) PG8_ROWS(nxt, nv0, nv1);
        const char* nA = has_next ? (const char*)g.A + (size_t)nxt.pm * tstepA + nxt.koff : cA; const char* nB = has_next ? (const char*)(g.Bt + (size_t)nxt.e * g.bstride) + (size_t)nxt.pn * tstepB + nxt.koff : cB;
#pragma unroll 1
        for (int t = 0; t < nt; t += 2) {
            const bool last = (t == nt - 2);
            if constexpr (HOOKT >= 0) { if (t == HOOKT) E.mid(acc, cur, wr, wc, fr, fq); }
            const char* a1 = cA + (size_t)(t + 1) * kstep;
            const char* a2 = last ? nA : cA + (size_t)(t + 2) * kstep; const char* b2 = last ? nB : cB + (size_t)(t + 2) * kstep;
            const char* a3 = a2 + kstep; const char* b3 = b2 + kstep;
            unsigned s0[2] = {cv0[0], cv0[1]}, s1[2] = {cv1[0], cv1[1]};
            if (GATHER && last && has_next) { s0[0] = nv0[0]; s0[1] = nv0[1]; s1[0] = nv1[0]; s1[1] = nv1[1]; }
            PG8_LDB(B0, 0, 0); PG8_LDB(B1, 0, 1); PG8_SCHED; PG8_LDA(At, 0, 0); PG8_STAGE(PG8_SA(1, 1), a1 + hstepA, cv1);
            PG8_WAIT_V(8); PG8_WAIT_L(0); PG8_BAR; PG8_MMA(0, 0, At, B0); PG8_MMA(0, 1, At, B1); PG8_BAR; PG8_SCHED;
            PG8_LDA(At, 0, 1); PG8_STAGE(PG8_SB(0, 0), b2, voffB); PG8_STAGE(PG8_SB(0, 1), b2 + hstepB, voffB); PG8_STAGE(PG8_SA(0, 0), a2, s0);
            PG8_WAIT_V(8); PG8_WAIT_L(0); PG8_BAR; PG8_MMA(1, 0, At, B0); PG8_MMA(1, 1, At, B1); PG8_BAR; PG8_SCHED;
            PG8_LDB(B0, 1, 0); PG8_LDB(B1, 1, 1); PG8_SCHED; PG8_LDA(At, 1, 0); PG8_STAGE(PG8_SA(0, 1), a2 + hstepA, s1);
            PG8_WAIT_V(8); PG8_WAIT_L(0); PG8_BAR; PG8_MMA(0, 0, At, B0); PG8_MMA(0, 1, At, B1); PG8_BAR; PG8_SCHED;
            PG8_LDA(At, 1, 1); PG8_STAGE(PG8_SB(1, 0), b3, voffB); PG8_STAGE(PG8_SB(1, 1), b3 + hstepB, voffB); PG8_STAGE(PG8_SA(1, 0), a3, s0);
            PG8_WAIT_V(8); PG8_WAIT_L(0); PG8_BAR; PG8_MMA(1, 0, At, B0); PG8_MMA(1, 1, At, B1); PG8_BAR; PG8_SCHED;
        }
        if (wr == 0) PG8_BAR;
        E(acc, cur, wr, wc, fr, fq);
        if (!has_next) break;
#pragma unroll
        for (int a = 0; a < 2; ++a)
#pragma unroll
            for (int b = 0; b < 2; ++b)
#pragma unroll
                for (int m = 0; m < 4; ++m)
#pragma unroll
                    for (int n = 0; n < 2; ++n) acc[a][b][m][n] = (f32x4){0.f, 0.f, 0.f, 0.f};
        cur = nxt; cA = nA; cB = nB; ++ui;
        if (GATHER) { cv0[0] = nv0[0]; cv0[1] = nv0[1]; cv1[0] = nv1[0]; cv1[1] = nv1[1]; }
        if (wr == 1) PG8_BAR;
    }
    PG8_WAIT_V(0);
    PG8_BAR;
#undef PG8_ROWS
#undef PG8_SA
#undef PG8_SB
#undef PG8_STAGE
#undef PG8_LDA
#undef PG8_LDB
#undef PG8_MMA
#undef PG8_WAIT_V
#undef PG8_WAIT_L
#undef PG8_BAR
#undef PG8_SCHED
}
#define EPI_LOOP_ROWS _Pragma("unroll") for (int ai = 0; ai < 2; ++ai) _Pragma("unroll") for (int m = 0; m < 4; ++m)
#define EPI_ROW (u.pm * 256 + ai * 128 + wr * 64 + m * 16 + fr)
#define EPI_COL(bj, n) (u.pn * 256 + (bj) * 128 + wc * 32 + (n) * 16 + fq * 4)
#define EPI_COL8(bj) (u.pn * 256 + (bj) * 128 + wc * 32 + fq * 8)
DEVI void st_bf16x8(bf16* p, f32x4 a, f32x4 b) { u32x4 w; w.x = pk2(a[0], a[1]); w.y = pk2(a[2], a[3]); w.z = pk2(b[0], b[1]); w.w = pk2(b[2], b[3]); *(u32x4*)p = w; }

DEVI void ld_bf16x8(const bf16* p, f32x4& a, f32x4& b) { const u32x4 v = *(const u32x4*)p; a = (f32x4){bf2f(v.x & 0xffff), bf2f(v.x >> 16), bf2f(v.y & 0xffff), bf2f(v.y >> 16)}; b = (f32x4){bf2f(v.z & 0xffff), bf2f(v.z >> 16), bf2f(v.w & 0xffff), bf2f(v.w >> 16)}; }
DEVI void st_tile32(bf16* rowp, int hi, const f32x16& acc) {
#pragma unroll
    for (int k = 0; k < 2; ++k) { const unsigned ax = pk2(acc[8 * k], acc[8 * k + 1]), ay = pk2(acc[8 * k + 2], acc[8 * k + 3]), bx = pk2(acc[8 * k + 4], acc[8 * k + 5]), by = pk2(acc[8 * k + 6], acc[8 * k + 7]);
        const u32x2 r0 = __builtin_amdgcn_permlane32_swap(ax, bx, false, false), r1 = __builtin_amdgcn_permlane32_swap(ay, by, false, false);
        *(u32x4*)(rowp + 16 * k + 8 * hi) = (u32x4){r0.x, r1.x, r0.y, r1.y}; } }
DEVI void st_bf16x4(bf16* p, f32x4 v) { u32x2 w; w.x = pk2(v[0], v[1]); w.y = pk2(v[2], v[3]); *(u32x2*)p = w; }

struct EpiInProj {
    static constexpr bool PERM = true;
    bf16* proj; float* dt; const float* dt_bias; const float* a_log; float* rqp; float* rkvp;
    DEVI void operator()(const f32x4 (&acc)[2][2][4][2], const Unit& u, int wr, int wc, int fr, int fq) const {
        EPI_LOOP_ROWS { const int row = EPI_ROW;
            if (u.pn <= 1) { float ssq = 0.f;
#pragma unroll
                for (int bj = 0; bj < 2; ++bj) if (u.pn == 0 || bj == 0) {
#pragma unroll
                    for (int n = 0; n < 2; ++n) { const f32x4 v = acc[ai][bj][m][n]; ssq += (v[0] * v[0] + v[1] * v[1]) + (v[2] * v[2] + v[3] * v[3]); } }
                ssq += __shfl_xor(ssq, 16); ssq += __shfl_xor(ssq, 32);
                if (fq == 0) (u.pn == 0 ? rqp : rkvp)[(size_t)row * 4 + wc] = ssq; }
#pragma unroll
            for (int bj = 0; bj < 2; ++bj) { const int col = EPI_COL8(bj);
                if (col < C_DTF) st_bf16x8(proj + (size_t)row * INWP + col, acc[ai][bj][m][0], acc[ai][bj][m][1]);
                else if (col < INW) { const int j0 = col - C_DTF;
#pragma unroll
                    for (int n = 0; n < 2; ++n) { const f32x4 v = acc[ai][bj][m][n]; f32x4 dv, lv;
#pragma unroll
                        for (int i = 0; i < 4; ++i) { const float d_ = softplusf(v[i] + dt_bias[j0 + 4 * n + i]); dv[i] = d_; lv[i] = -d_ * __expf(a_log[j0 + 4 * n + i]); }
                        *(f32x4*)(dt + (size_t)row * 32 + j0 + 4 * n) = dv; *(f32x4*)(dt + (size_t)row * 32 + 16 + j0 + 4 * n) = lv; } } } }
    }
};
struct EpiMla {
    static constexpr bool PERM = true;
    bf16 *Q, *K, *V; const float *rqp, *rkvp; const float* rope; const bf16* proj;
    DEVI static void rot8(f32x4& a, f32x4& b, const float* tb) { const f32x4 t0 = *(const f32x4*)tb, t1 = *(const f32x4*)(tb + 4);
        const float a0 = a[0] * t0[0] - a[1] * t0[1], a1 = a[1] * t0[0] + a[0] * t0[1], a2 = a[2] * t0[2] - a[3] * t0[3], a3 = a[3] * t0[2] + a[2] * t0[3];
        const float b0 = b[0] * t1[0] - b[1] * t1[1], b1 = b[1] * t1[0] + b[0] * t1[1], b2 = b[2] * t1[2] - b[3] * t1[3], b3 = b[3] * t1[2] + b[2] * t1[3];
        a = (f32x4){a0, a1, a2, a3}; b = (f32x4){b0, b1, b2, b3}; }
    DEVI void operator()(const f32x4 (&acc)[2][2][4][2], const Unit& u, int wr, int wc, int fr, int fq) const {
        EPI_LOOP_ROWS { const int row = EPI_ROW; float sq = 0.f, skv = 0.f;
            if (u.pn <= 1) { const f32x4 pq = *(const f32x4*)(rqp + (size_t)row * 4); sq = __builtin_amdgcn_rsqf(((pq[0] + pq[1]) + (pq[2] + pq[3])) * (1.f / 256.f) + EPS); }
            if (u.pn >= 2) { const f32x4 pk = *(const f32x4*)(rkvp + (size_t)row * 4); skv = __builtin_amdgcn_rsqf(((pk[0] + pk[1]) + (pk[2] + pk[3])) * (1.f / 128.f) + EPS); }
            const int pos = row & (SEQ - 1), gr = pos >> 6, gc = pos & 63;
#pragma unroll
            for (int bj = 0; bj < 2; ++bj) { const int col = EPI_COL8(bj); f32x4 v0 = acc[ai][bj][m][0], v1 = acc[ai][bj][m][1];
                if (col < 384) { v0 = v0 * sq; v1 = v1 * sq; const int d = col % 96;
                    if (d >= 64 && row < NLAT) { const int pp = (d - 64) >> 1; rot8(v0, v1, (pp < 8) ? rope + (gr * 8 + pp) * 2 : rope + 2048 + (gc * 8 + (pp - 8)) * 2); }
                    st_bf16x8(Q + (size_t)row * 384 + col, v0, v1); }
                else if (col < 416) { const int d0 = col - 384, pp = d0 >> 1; f32x4 x0, x1; ld_bf16x8(proj + (size_t)row * INWP + C_KPE + d0, x0, x1);
                    if (row < NLAT) rot8(x0, x1, (pp < 8) ? rope + (gr * 8 + pp) * 2 : rope + 2048 + (gc * 8 + (pp - 8)) * 2);
#pragma unroll
                    for (int h = 0; h < 4; ++h) st_bf16x8(K + (size_t)row * 384 + h * 96 + 64 + d0, x0, x1); }
                else if (col >= 512 && col < 768) { const int c = col - 512; st_bf16x8(K + (size_t)row * 384 + (c >> 6) * 96 + (c & 63), v0 * skv, v1 * skv); }
                else if (col >= 768) { st_bf16x8(V + (size_t)row * 256 + (col - 768), v0 * skv, v1 * skv); } }
            asm volatile("" ::: "memory"); }
    }
};
struct EpiResid {
    static constexpr bool PERM = true;
    const float* src32; const bf16* src16; bool from32; bf16* dst; const float* modv_l; int gidx; const float* ssq2;
    DEVI void mid(f32x4 (&acc)[2][2][4][2], const Unit& u, int wr, int wc, int fr, int fq) const {
        EPI_LOOP_ROWS { const int row = EPI_ROW; const f32x2 q = *(const f32x2*)(ssq2 + (size_t)row * 2); const float rstd = __builtin_amdgcn_rsqf((q[0] + q[1]) * (1.f / 512.f) + EPS);
#pragma unroll
            for (int bj = 0; bj < 2; ++bj)
#pragma unroll
                for (int n = 0; n < 2; ++n) acc[ai][bj][m][n] = acc[ai][bj][m][n] * rstd; }
    }
    DEVI void operator()(const f32x4 (&acc)[2][2][4][2], const Unit& u, int wr, int wc, int fr, int fq) const {
        EPI_LOOP_ROWS { const int row = EPI_ROW; const float* gp = modv_l + (row >> 13) * 6144 + gidx * 1024;
#pragma unroll
            for (int bj = 0; bj < 2; ++bj) { const int col = EPI_COL8(bj); const f32x4 g0 = *(const f32x4*)(gp + col), g1 = *(const f32x4*)(gp + col + 4); f32x4 s0, s1;
                if (from32) { s0 = *(const f32x4*)(src32 + (size_t)row * D + col); s1 = *(const f32x4*)(src32 + (size_t)row * D + col + 4); } else ld_bf16x8(src16 + (size_t)row * D + col, s0, s1);
                st_bf16x8(dst + (size_t)row * D + col, s0 + g0 * acc[ai][bj][m][0], s1 + g1 * acc[ai][bj][m][1]); } }
    }
};
struct EpiPart {
    static constexpr bool PERM = true;
    float* part; const float* ssq2; int nssd;
    DEVI void operator()(const f32x4 (&acc)[2][2][4][2], const Unit& u, int wr, int wc, int fr, int fq) const {
        EPI_LOOP_ROWS { const int row = EPI_ROW; float* d = part + ((size_t)u.e * NCTX + (row - NLAT)) * D; float sc = 1.f;
            if (u.e < nssd) { const f32x2 q = *(const f32x2*)(ssq2 + (size_t)row * 2); sc = __builtin_amdgcn_rsqf((q[0] + q[1]) * (1.f / 512.f) + EPS); }
#pragma unroll
            for (int bj = 0; bj < 2; ++bj)
#pragma unroll
                for (int n = 0; n < 2; ++n) *(f32x4*)(d + EPI_COL8(bj) + 4 * n) = acc[ai][bj][m][n] * sc; }
    }
};
struct EpiSwiglu {
    static constexpr bool PERM = true;
    bf16* act; int ldc;
    DEVI void operator()(const f32x4 (&acc)[2][2][4][2], const Unit& u, int wr, int wc, int fr, int fq) const {
        EPI_LOOP_ROWS { const int row = EPI_ROW; f32x4 o[2];
#pragma unroll
            for (int n = 0; n < 2; ++n) { const f32x4 gt = acc[ai][0][m][n], up = acc[ai][1][m][n];
#pragma unroll
                for (int i = 0; i < 4; ++i) o[n][i] = siluf(gt[i]) * up[i]; }
            st_bf16x8(act + (size_t)row * ldc + u.pn * 128 + wc * 32 + fq * 8, o[0], o[1]); }
    }
};
struct EpiStore {
    static constexpr bool PERM = true;
    bf16* o; int ldc;
    DEVI void operator()(const f32x4 (&acc)[2][2][4][2], const Unit& u, int wr, int wc, int fr, int fq) const {
        EPI_LOOP_ROWS { const int row = EPI_ROW;
#pragma unroll
            for (int bj = 0; bj < 2; ++bj) st_bf16x8(o + (size_t)row * ldc + EPI_COL8(bj), acc[ai][bj][m][0], acc[ai][bj][m][1]); }
    }
};

struct CvtSrc { const float* src; int ld; int ncols; bool perm; const float* ks; float sc; };
DEVI void cvt_tile(const CvtSrc t, bf16* dst, int Kd, int nd0, int kd0, LAS float* scr, int lane) {
    const int n = lane & 31;
    if (t.src) {
        const int nc = (n < t.ncols) ? n : t.ncols - 1; const float msk = (n < t.ncols) ? t.sc : 0.f;
        const float* sp0 = t.src + (size_t)(lane >> 5) * t.ld + nc;
        float v[32];
#pragma unroll
        for (int i = 0; i < 32; ++i) v[i] = __builtin_nontemporal_load(sp0 + (size_t)(2 * i) * t.ld);
        if (t.ks) {
#pragma unroll
            for (int i = 0; i < 32; ++i) v[i] *= t.ks[2 * i + (lane >> 5)];
        }
#pragma unroll
        for (int i = 0; i < 32; ++i) scr[(2 * i + (lane >> 5)) * 33 + n] = v[i] * msk;
    } else {
#pragma unroll 8
        for (int i = 0; i < 32; ++i) scr[(2 * i + (lane >> 5)) * 33 + n] = 0.f;
    }
    asm volatile("s_waitcnt lgkmcnt(0)" ::: "memory");
    const int c = lane & 7;
#pragma unroll
    for (int j = 0; j < 4; ++j) { const int nn = (lane >> 3) + 8 * j; const LAS float* sp = scr + (8 * c) * 33 + (t.perm ? rope_src(nn) : nn);
        u32x4 o; o.x = pk2(sp[0 * 33], sp[1 * 33]); o.y = pk2(sp[2 * 33], sp[3 * 33]); o.z = pk2(sp[4 * 33], sp[5 * 33]); o.w = pk2(sp[6 * 33], sp[7 * 33]);
        *(u32x4*)(dst + (size_t)(nd0 + nn) * Kd + kd0 + 8 * c) = o; }
    asm volatile("s_waitcnt lgkmcnt(0)" ::: "memory");
}
template <class F>
DEVI void cvt_job(bf16* dst, int Nd, int Kd, F f, LAS float* scr, int gw, int ngw, int lane) {
    const int ntn = Nd >> 5, ntk = Kd >> 6;
    for (int it = gw; it < ntn * ntk; it += ngw) { const int nt = it % ntn, kt = it / ntn; cvt_tile(f(nt, kt), dst, Kd, nt * 32, kt * 64, scr, lane); }
}
DEVI void cvt_static(const P& p, unsigned char* lds, int part, int gw, int ngw, int wid, int lane) {
    LAS float* scr = (LAS float*)(LAS unsigned char*)lds + wid * (64 * 33);
    if (part == 0 || part == 3) { const int l = part ? 1 : 0;
        { const float* W = IN(8) + (size_t)l * 1024 * INWS;
          cvt_job((bf16*)(p.ws + WS_WIN) + (size_t)l * INWP * 1024, INWP, 1024, [=](int nt, int kt) -> CvtSrc {
              const int n0 = nt * 32, sc0 = n0 < C_GAP ? n0 : n0 - 32;
              if (n0 == C_GAP || sc0 >= INWS) return CvtSrc{nullptr, 0, 0, false, nullptr, 1.f};
              return CvtSrc{W + (size_t)(kt * 64) * INWS + sc0, INWS, (INWS - sc0 < 32) ? INWS - sc0 : 32, n0 == C_KPE, nullptr, 1.f}; }, scr, gw, ngw, lane); }
        { const float* Wq = IN(11) + (size_t)l * 256 * 384; const float* qn = IN(10) + l * 256; const float* Wk = IN(13) + (size_t)l * 128 * 256; const float* Wv = IN(14) + (size_t)l * 128 * 256; const float* kn = IN(12) + l * 128;
          const float QS = 0.10206207261596577f * 1.4426950408889634f;
          cvt_job((bf16*)(p.ws + WS_WQKV) + (size_t)l * 1024 * 384, 1024, 384, [=](int nt, int kt) -> CvtSrc {
              const int n0 = nt * 32, k0 = kt * 64;
              if (n0 < 384) { if (k0 >= 256) return CvtSrc{nullptr, 0, 0, false, nullptr, 1.f}; return CvtSrc{Wq + (size_t)k0 * 384 + n0, 384, 32, (n0 % 96) == 64, qn + k0, QS}; }
              if (n0 < 512 || k0 < 256) return CvtSrc{nullptr, 0, 0, false, nullptr, 1.f};
              if (n0 < 768) return CvtSrc{Wk + (size_t)(k0 - 256) * 256 + (n0 - 512), 256, 32, false, kn + k0 - 256, 1.f};
              return CvtSrc{Wv + (size_t)(k0 - 256) * 256 + (n0 - 768), 256, 32, false, kn + k0 - 256, 1.f}; }, scr, gw, ngw, lane); }
        { const float* W = IN(9) + (size_t)l * 1024 * 1024; const float* nwv = IN(21) + l * 512;
          cvt_job((bf16*)(p.ws + WS_WOUT) + (size_t)l * 1024 * 1024, 1024, 1024, [=](int nt, int kt) -> CvtSrc { const int k0 = kt * 64;
              if (k0 < 512) return CvtSrc{W + (size_t)(512 + k0) * 1024 + nt * 32, 1024, 32, false, nwv + k0, 1.f};
              return CvtSrc{W + (size_t)(k0 - 512) * 1024 + nt * 32, 1024, 32, false, nullptr, 1.f}; }, scr, gw, ngw, lane); }
    }
    if (part == 1) {
        { const float* Wg = IN(22); const float* Wu = IN(23);
          cvt_job((bf16*)(p.ws + WS_WGU), 2 * DFF, 1024, [=](int nt, int kt) -> CvtSrc { const int n0 = nt * 32, t = n0 >> 8, r = n0 & 255;
              return CvtSrc{(r < 128 ? Wg + t * 128 + r : Wu + t * 128 + r - 128) + (size_t)(kt * 64) * DFF, DFF, 32, false, nullptr, 1.f}; }, scr, gw, ngw, lane); }
    }
    if (part == 2) {
        { const float* W = IN(24);
          cvt_job((bf16*)(p.ws + WS_WD), 1024, DFF, [=](int nt, int kt) -> CvtSrc { return CvtSrc{W + (size_t)(kt * 64) * 1024 + nt * 32, 1024, 32, false, nullptr, 1.f}; }, scr, gw, ngw, lane); }
    }
}
DEVI void ph_pro(const P& p, unsigned char* lds) {
    const int tid = otid(), wid = tid >> 6, lane = tid & 63;
    __syncthreads();
    float* modv = (float*)(p.ws + WS_MODV);
    float* red = (float*)lds;
    float* sc3 = (float*)(lds + 8192);
    if (blockIdx.x < 192) { for (int k = tid; k < 1024; k += NTHREADS) { sc3[k] = siluf(IN(1)[k]); sc3[1024 + k] = siluf(IN(1)[1024 + k]); sc3[2048 + k] = siluf(IN(3)[k]); } }
    __syncthreads();
    for (int item = blockIdx.x; item < 192; item += gridDim.x) {
        const int l = item / 96, n = (item % 96) * 64 + lane;
        const float* W = IN(4) + (size_t)l * 1024 * 6144;
        float a0 = 0.f, a1 = 0.f, a2 = 0.f;
#pragma unroll 16
        for (int k = wid * 128; k < wid * 128 + 128; ++k) {
            const float w = __builtin_nontemporal_load(W + (size_t)k * 6144 + n);
            a0 += sc3[k] * w; a1 += sc3[1024 + k] * w; a2 += sc3[2048 + k] * w;
        }
        red[(wid * 3 + 0) * 64 + lane] = a0; red[(wid * 3 + 1) * 64 + lane] = a1; red[(wid * 3 + 2) * 64 + lane] = a2;
        __syncthreads();
        if (tid < 192) { const int r = tid >> 6, ln = tid & 63; float s = 0.f;
            for (int w = 0; w < 8; ++w) s += red[(w * 3 + r) * 64 + ln];
            const int nn = (item % 96) * 64 + ln; modv[(l * 3 + r) * 6144 + nn] = s + IN(5)[l * 6144 + nn]; }
        __syncthreads();
    }
    if (blockIdx.x == gridDim.x - 1) {
        float* rope = (float*)(p.ws + WS_ROPE);
        for (int idx = tid; idx < 1536; idx += NTHREADS) {
            const int i = idx & 7, pos = (idx < 1024) ? (idx >> 3) : ((idx - 1024) >> 3);
            const float invf = (i == 0) ? 1.f : (i == 1) ? 0.31622776601683794f : (i == 2) ? 0.1f : (i == 3) ? 0.03162277660168379f : (i == 4) ? 0.01f : (i == 5) ? 0.003162277660168379f : (i == 6) ? 0.001f : 0.00031622776601683794f;
            const float ang = (float)pos * invf;
            double rev = (double)ang * 0.15915494309189535; rev -= __builtin_rint(rev);
            const float fr = (float)rev;
            rope[idx * 2] = __builtin_amdgcn_cosf(fr); rope[idx * 2 + 1] = __builtin_amdgcn_sinf(fr);
        }
    }
    __syncthreads();
    cvt_static(p, lds, 0, blockIdx.x * NWAVES + wid, gridDim.x * NWAVES, wid, lane);
}
DEVI void ph_moew(const P& p, unsigned char* lds, int part, int gw, int ngw) {
    const int tid = otid(), wid = tid >> 6, lane = tid & 63;
    LAS float* scr = (LAS float*)(LAS unsigned char*)lds + wid * (64 * 33);
    const int e0 = part == 2 ? 4 : part == 3 ? 7 : 0, e1 = part == 1 ? 4 : part == 2 ? 7 : NEXP;
    for (int e = e0; e < e1; ++e) {
        if (part == 0) { const float* Wg = IN(26) + (size_t)e * 1024 * DFE; const float* Wu = IN(27) + (size_t)e * 1024 * DFE;
          cvt_job((bf16*)(p.ws + WS_WGUE) + (size_t)e * 2 * DFE * 1024, 2 * DFE, 1024, [=](int nt, int kt) -> CvtSrc { const int n0 = nt * 32, t = n0 >> 8, r = n0 & 255;
              return CvtSrc{(r < 128 ? Wg + t * 128 + r : Wu + t * 128 + r - 128) + (size_t)(kt * 64) * DFE, DFE, 32, false, nullptr, 1.f}; }, scr, gw, ngw, lane); }
        else { const float* W = IN(28) + (size_t)e * DFE * 1024;
          cvt_job((bf16*)(p.ws + WS_WDE) + (size_t)e * 1024 * DFE, 1024, DFE, [=](int nt, int kt) -> CvtSrc { return CvtSrc{W + (size_t)(kt * 64) * 1024 + nt * 32, 1024, 32, false, nullptr, 1.f}; }, scr, gw, ngw, lane); }
    }
}

template <bool route>
DEVI void ph_norm(const P& p, int l, int which, int nrows, unsigned char* lds, int npart, int pgidx) {
    const int tid = otid(), wid = tid >> 6, lane = tid & 63;
    const bool first = (l == 0 && which == 0);
    const bool wide = !first;
#define NC0(j) (wide ? (((j) >> 1) * 64 + lane) * 8 + ((j) & 1) * 4 : ((j) * 64 + lane) * 4)
    const float* src_lat = IN(0); const bf16* src16 = (const bf16*)(p.ws + WS_X16); const float* src_ctx = (l == 0) ? IN(2) : (const float*)(p.ws + WS_XC);
    const float* w = IN(6 + which) + l * 1024; const float* modv = (const float*)(p.ws + WS_MODV) + (size_t)l * 3 * 6144;
    bf16* H = (bf16*)(p.ws + WS_HM);
    int* rt_e = (int*)(p.ws + WS_RT); float* rt_g = (float*)(p.ws + WS_RT + 128 * 1024);
    float* rl = (float*)lds;
    if (route) { __syncthreads(); const float* router = IN(25);
#pragma unroll
        for (int i = 0; i < 4; ++i) { const int q = tid + NTHREADS * i, col = q >> 1, e0 = (q & 1) * 4; const f32x4 rv = *(const f32x4*)(router + q * 4);
            rl[(e0 + 0) * 1024 + col] = rv[0]; rl[(e0 + 1) * 1024 + col] = rv[1]; rl[(e0 + 2) * 1024 + col] = rv[2]; rl[(e0 + 3) * 1024 + col] = rv[3]; }
        __syncthreads(); }
    const int nw = gridDim.x * NWAVES, rpw = (NLAT + nw - 1) / nw, gw = blockIdx.x * NWAVES + wid;
    f32x4 vn[4], gsc[4], shv[4]; u32x2 vb[4]; u32x4 vw[2]; int rc = -1;
    for (int pass = 0; pass < (nrows > NLAT ? 2 : 1); ++pass) {
    const int row0 = pass == 0 ? gw * rpw : NLAT + gw, row1 = pass == 0 ? ((row0 + rpw < NLAT) ? row0 + rpw : NLAT) : nrows, rstep = pass == 0 ? 1 : nw;
#define NORM_LOAD(rw) do { if ((rw) < NLAT && !first) { const bf16* x_ = src16 + (size_t)(rw) * D; if (wide) { _Pragma("unroll") for (int k = 0; k < 2; ++k) vw[k] = *(const u32x4*)(x_ + NC0(2 * k)); } else { _Pragma("unroll") for (int j = 0; j < 4; ++j) vb[j] = *(const u32x2*)(x_ + (j * 64 + lane) * 4); } } \
        else { const float* x_ = ((rw) < NLAT) ? src_lat + (size_t)(rw) * D : src_ctx + (size_t)((rw) - NLAT) * D; _Pragma("unroll") for (int j = 0; j < 4; ++j) vn[j] = *(const f32x4*)(x_ + NC0(j)); } } while (0)
    if (row0 < row1) NORM_LOAD(row0);
    for (int row = row0; row < row1; row += rstep) {
        const bool lat = row < NLAT; const int r = lat ? (row >> 13) : 2;
        if (r != rc) { rc = r; const float* sh = modv + r * 6144 + (which * 3 + 0) * 1024; const float* sc = modv + r * 6144 + (which * 3 + 1) * 1024;
#pragma unroll
            for (int j = 0; j < 4; ++j) { const int c0 = NC0(j); const f32x4 wv = *(const f32x4*)(w + c0), cv = *(const f32x4*)(sc + c0); shv[j] = *(const f32x4*)(sh + c0); gsc[j] = wv * (cv + 1.f); } }
        f32x4 v[4]; float ss = 0.f;
        if (lat && wide) {
#pragma unroll
            for (int k = 0; k < 2; ++k) { v[2 * k] = (f32x4){bf2f(vw[k].x & 0xffff), bf2f(vw[k].x >> 16), bf2f(vw[k].y & 0xffff), bf2f(vw[k].y >> 16)}; v[2 * k + 1] = (f32x4){bf2f(vw[k].z & 0xffff), bf2f(vw[k].z >> 16), bf2f(vw[k].w & 0xffff), bf2f(vw[k].w >> 16)}; }
        } else if (lat && !first) {
#pragma unroll
            for (int j = 0; j < 4; ++j) v[j] = (f32x4){bf2f(vb[j].x & 0xffff), bf2f(vb[j].x >> 16), bf2f(vb[j].y & 0xffff), bf2f(vb[j].y >> 16)};
        } else {
#pragma unroll
            for (int j = 0; j < 4; ++j) v[j] = vn[j];
        }
        if (!lat && npart > 0) { const float* part = (const float*)(p.ws + WS_XBC) + (size_t)(row - NLAT) * D; const float* gp = modv + 2 * 6144 + pgidx * 1024; float* xc = (float*)(p.ws + WS_XC) + (size_t)(row - NLAT) * D;
#pragma unroll
            for (int j = 0; j < 4; ++j) { const int c0 = NC0(j); f32x4 acc = {0.f, 0.f, 0.f, 0.f};
#pragma unroll 2
                for (int k = 0; k < npart; ++k) acc += *(const f32x4*)(part + (size_t)k * NCTX * D + c0);
                v[j] += *(const f32x4*)(gp + c0) * acc; *(f32x4*)(xc + c0) = v[j]; } }
#pragma unroll
        for (int j = 0; j < 4; ++j) ss += v[j][0] * v[j][0] + v[j][1] * v[j][1] + v[j][2] * v[j][2] + v[j][3] * v[j][3];
        if (row + rstep < row1) { const int nrow = row + rstep; NORM_LOAD(nrow); }
        ss = wave_sum(ss); const float rstd = __builtin_amdgcn_rsqf(ss * (1.f / D) + EPS);
        float lg[8];
#pragma unroll
        for (int e = 0; e < 8; ++e) lg[e] = 0.f;
#pragma unroll
        for (int j = 0; j < 4; ++j) v[j] = v[j] * rstd * gsc[j] + shv[j];
        if (wide) {
#pragma unroll
            for (int k = 0; k < 2; ++k) st_bf16x8(H + (size_t)row * D + NC0(2 * k), v[2 * k], v[2 * k + 1]);
        } else {
#pragma unroll
            for (int j = 0; j < 4; ++j) st_bf16x4(H + (size_t)row * D + NC0(j), v[j]);
        }
        if (route) {
#pragma unroll
            for (int j = 0; j < 4; ++j) { const int c0 = NC0(j);
#pragma unroll
                for (int e = 0; e < 8; ++e) { const f32x4 rv = *(const f32x4*)(rl + e * 1024 + c0); lg[e] += (v[j][0] * rv[0] + v[j][1] * rv[1]) + (v[j][2] * rv[2] + v[j][3] * rv[3]); }
                asm volatile("" ::: "memory"); } }
        if (route) {
            {
                const bool b0 = lane & 1, b1 = lane & 2, b2 = lane & 4; float a4[4], a2[2], a1;
#pragma unroll
                for (int i = 0; i < 4; ++i) { const float snd = b0 ? lg[i] : lg[4 + i]; a4[i] = (b0 ? lg[4 + i] : lg[i]) + __shfl_xor(snd, 1); }
#pragma unroll
                for (int i = 0; i < 2; ++i) { const float snd = b1 ? a4[i] : a4[2 + i]; a2[i] = (b1 ? a4[2 + i] : a4[i]) + __shfl_xor(snd, 2); }
                { const float snd = b2 ? a2[0] : a2[1]; a1 = (b2 ? a2[1] : a2[0]) + __shfl_xor(snd, 4); }
                a1 += __shfl_xor(a1, 8); a1 += __shfl_xor(a1, 16); a1 += __shfl_xor(a1, 32);
#pragma unroll
                for (int e = 0; e < 8; ++e) lg[e] = __shfl(a1, ((e >> 2) & 1) | (((e >> 1) & 1) << 1) | ((e & 1) << 2)); }
            int i1 = 0; float v1 = lg[0];
#pragma unroll
            for (int e = 1; e < 8; ++e) if (lg[e] > v1) { v1 = lg[e]; i1 = e; }
            int i2 = -1; float v2 = -3.0e38f;
#pragma unroll
            for (int e = 0; e < 8; ++e) if (e != i1 && lg[e] > v2) { v2 = lg[e]; i2 = e; }
            const float e2 = __expf(v2 - v1), g1 = 1.f / (1.f + e2), g2 = e2 / (1.f + e2);
            if (lane == 0) { rt_e[row * 2] = i1; rt_e[row * 2 + 1] = i2; rt_g[row * 2] = g1; rt_g[row * 2 + 1] = g2; }
        }
    }
    }
}
#undef NC0

typedef short v4i16_t __attribute__((ext_vector_type(4)));
DEVI v4i16_t lds_tr(const unsigned char* p) { return __builtin_amdgcn_ds_read_tr16_b64_v4i16((LAS v4i16_t*)(LAS unsigned char*)p); }
constexpr int A3_KLD = 208, A3_VLD = 192, A3_VOFF = 64 * A3_KLD, A3_BUF = A3_VOFF + 64 * A3_VLD;
template <int VAR>
DEVI void attn_unit(const P& p, int uidx, unsigned char* lds, bf16* outp) {
    const int tid = otid(), wid = __builtin_amdgcn_readfirstlane(tid >> 6), lane = tid & 63, r32 = lane & 31, hi = lane >> 5;
    const bf16* Q = (const bf16*)(p.ws + WS_Q); const bf16* K = (const bf16*)(p.ws + WS_K); const bf16* V = (const bf16*)(p.ws + WS_V); bf16* MIX = outp;
    int b, h, qrow0, NT;
    if (uidx < 256) { b = uidx >> 7; h = (uidx >> 5) & 3; qrow0 = b * SEQ + (uidx & 31) * 256; NT = 4 + SEQ / 64; }
    else { const int j = uidx - 256; b = j >> 2; h = j & 3; qrow0 = NLAT + b * CL; NT = 4; }
    const int qrow = qrow0 + wid * 32 + r32;
    bf16x8 qf[6];
#pragma unroll
    for (int s = 0; s < 6; ++s) qf[s] = *(const bf16x8*)(Q + (size_t)qrow * 384 + h * 96 + s * 16 + hi * 8);
    const int kk0 = tid / 12, kq0 = tid % 12, kk1 = (512 + tid) / 12, kq1 = (512 + tid) % 12, vk = tid >> 3, vq = tid & 7;
    const bf16* Kh = K + h * 96; const bf16* Vh = V + h * 64 + vq * 8;
    const int ctx0 = NLAT + b * CL, lat0 = b * SEQ;
    u32x4 krA0, krA1 = {0u, 0u, 0u, 0u}, vrA;
#define AT_LOAD(t, kr0, kr1, vr) do { const int kr_ = ((t) < 4) ? ctx0 + (t) * 64 : lat0 + ((t) - 4) * 64; \
        kr0 = *(const u32x4*)(Kh + (size_t)(kr_ + kk0) * 384 + kq0 * 8); if (tid < 256) kr1 = *(const u32x4*)(Kh + (size_t)(kr_ + kk1) * 384 + kq1 * 8); \
        vr = *(const u32x4*)(Vh + (size_t)(kr_ + vk) * 256); } while (0)
#define AT_STORE(bufp, kr0, kr1, vr) do { unsigned char* b_ = (bufp); *(u32x4*)(b_ + kk0 * A3_KLD + kq0 * 16) = kr0; if (tid < 256) *(u32x4*)(b_ + kk1 * A3_KLD + kq1 * 16) = kr1; \
        *(u32x4*)(b_ + A3_VOFF + vk * A3_VLD + vq * 16) = vr; } while (0)
    const int troff = (4 * hi + ((lane & 15) >> 2)) * A3_VLD + (16 * ((lane >> 4) & 1) + 4 * (lane & 3)) * 2;
    const int koff = r32 * A3_KLD + hi * 16;
    f32x16 o0, o1, negm;
#pragma unroll
    for (int r = 0; r < 16; ++r) { o0[r] = 0.f; o1[r] = 0.f; negm[r] = 0.f; }
    float mhat = 0.f, lsum = 0.f;
    __syncthreads();
    AT_LOAD(0, krA0, krA1, vrA); AT_STORE(lds, krA0, krA1, vrA); AT_LOAD(1, krA0, krA1, vrA); AT_STORE(lds + A3_BUF, krA0, krA1, vrA);
    __syncthreads();
#define SBAR() __builtin_amdgcn_sched_barrier(0)
#define KRD(bufp, half, s) (*(const bf16x8*)((bufp) + koff + (half) * 32 * A3_KLD + (s) * 32))
#define MF(a, b, c) __builtin_amdgcn_mfma_f32_32x32x16_bf16(a, b, c, 0, 0, 0)
#define MFQ(a, b, c) ((VAR == 3) ? (c) : MF(a, b, c))
#define MFP(a, b, c) ((VAR == 2) ? (c) : MF(a, b, c))
#define EX4(S, r0) do { if (VAR == 1) { S[r0] *= 0.001f; S[r0 + 1] *= 0.001f; S[r0 + 2] *= 0.001f; S[r0 + 3] *= 0.001f; break; } S[r0] = __builtin_amdgcn_exp2f(S[r0]); S[r0 + 1] = __builtin_amdgcn_exp2f(S[r0 + 1]); S[r0 + 2] = __builtin_amdgcn_exp2f(S[r0 + 2]); S[r0 + 3] = __builtin_amdgcn_exp2f(S[r0 + 3]); lsum += (S[r0] + S[r0 + 1]) + (S[r0 + 2] + S[r0 + 3]); } while (0)
#define PK8(S, r0) __builtin_bit_cast(bf16x8, (u32x4){pk2(S[r0], S[r0 + 1]), pk2(S[r0 + 2], S[r0 + 3]), pk2(S[r0 + 4], S[r0 + 5]), pk2(S[r0 + 6], S[r0 + 7])})
#define VFR(vp) ({ const v4i16_t lo_ = lds_tr(vp), hi_ = lds_tr((vp) + 8 * A3_VLD); (bf16x8){lo_[0], lo_[1], lo_[2], lo_[3], hi_[0], hi_[1], hi_[2], hi_[3]}; })
#define MX3(a, b, c) __builtin_fmaxf(__builtin_fmaxf((a), (b)), (c))
#define AT_UPD(S0, S1, mx, FORCE) do { float mx_ = __builtin_fmaxf(mx, __shfl_xor(mx, 32)); \
        if ((FORCE) || __any(mx_ > 8.0f)) { const float dl_ = (FORCE) ? mx_ : __builtin_fmaxf(mx_, 0.f); mhat += dl_; \
            _Pragma("unroll") for (int r = 0; r < 16; ++r) { S0[r] -= dl_; S1[r] -= dl_; negm[r] = -mhat; } \
            if (!(FORCE)) { const float f_ = __builtin_amdgcn_exp2f(-dl_); _Pragma("unroll") for (int r = 0; r < 16; ++r) { o0[r] *= f_; o1[r] *= f_; } lsum *= f_; } } } while (0)
    f32x16 sa0, sa1, sb0, sb1;
    { const unsigned char* kb_ = lds;
#pragma unroll
      for (int s = 0; s < 6; ++s) { sa0 = MF(KRD(kb_, 0, s), qf[s], s == 0 ? negm : sa0); sa1 = MF(KRD(kb_, 1, s), qf[s], s == 0 ? negm : sa1); }
      float a_ = MX3(sa0[0], sa0[1], sa1[0]), b_ = MX3(sa0[2], sa0[3], sa1[1]); a_ = MX3(a_, sa1[2], sa1[3]);
#pragma unroll
      for (int r = 4; r < 16; r += 4) { a_ = MX3(a_, sa0[r], sa0[r + 1]); b_ = MX3(b_, sa0[r + 2], sa0[r + 3]); a_ = MX3(a_, sa1[r], sa1[r + 1]); b_ = MX3(b_, sa1[r + 2], sa1[r + 3]); }
      AT_UPD(sa0, sa1, __builtin_fmaxf(a_, b_), true); }
#define AT_STEP(C0, C1, N0, N1, t, bc_, HAS_NEXT) do { const int b1_ = ((bc_) == 2) ? 0 : (bc_) + 1, b2_ = (b1_ == 2) ? 0 : b1_ + 1; \
        const unsigned char* kb_ = lds + b1_ * A3_BUF; const unsigned char* vb_ = lds + (bc_) * A3_BUF + A3_VOFF + troff; \
        if (VAR != 4 && (t) + 2 < NT) AT_LOAD((t) + 2, krA0, krA1, vrA); \
        bf16x8 pw0_, pw1_, pw2_, pw3_; float ma_ = -3.0e38f, mb_ = -3.0e38f; \
        if (HAS_NEXT) { \
            bf16x8 k0_ = KRD(kb_, 0, 0), k1_ = KRD(kb_, 1, 0), k2_ = KRD(kb_, 0, 1), k3_ = KRD(kb_, 1, 1); SBAR(); \
            N0 = MFQ(k0_, qf[0], negm); EX4(C0, 0); k0_ = KRD(kb_, 0, 2); SBAR(); \
            N1 = MFQ(k1_, qf[0], negm); EX4(C0, 4); k1_ = KRD(kb_, 1, 2); SBAR(); \
            N0 = MFQ(k2_, qf[1], N0); EX4(C0, 8); k2_ = KRD(kb_, 0, 3); SBAR(); \
            N1 = MFQ(k3_, qf[1], N1); EX4(C0, 12); k3_ = KRD(kb_, 1, 3); SBAR(); \
            N0 = MFQ(k0_, qf[2], N0); EX4(C1, 0); k0_ = KRD(kb_, 0, 4); SBAR(); \
            N1 = MFQ(k1_, qf[2], N1); EX4(C1, 4); k1_ = KRD(kb_, 1, 4); SBAR(); \
            N0 = MFQ(k2_, qf[3], N0); EX4(C1, 8); k2_ = KRD(kb_, 0, 5); SBAR(); \
            N1 = MFQ(k3_, qf[3], N1); EX4(C1, 12); k3_ = KRD(kb_, 1, 5); SBAR(); \
            N0 = MFQ(k0_, qf[4], N0); pw0_ = PK8(C0, 0); SBAR(); \
            N1 = MFQ(k1_, qf[4], N1); pw1_ = PK8(C0, 8); SBAR(); \
            N0 = MFQ(k2_, qf[5], N0); pw2_ = PK8(C1, 0); SBAR(); \
            N1 = MFQ(k3_, qf[5], N1); pw3_ = PK8(C1, 8); SBAR(); \
        } else { EX4(C0, 0); EX4(C0, 4); EX4(C0, 8); EX4(C0, 12); EX4(C1, 0); EX4(C1, 4); EX4(C1, 8); EX4(C1, 12); pw0_ = PK8(C0, 0); pw1_ = PK8(C0, 8); pw2_ = PK8(C1, 0); pw3_ = PK8(C1, 8); SBAR(); } \
        { bf16x8 va_ = VFR(vb_), vb2_ = VFR(vb_ + 64); SBAR(); \
          bf16x8 vc_ = VFR(vb_ + 16 * A3_VLD), vd_ = VFR(vb_ + 16 * A3_VLD + 64); SBAR(); \
          o0 = MFP(va_, pw0_, o0); if (HAS_NEXT) { ma_ = MX3(N0[0], N0[1], N1[0]); mb_ = MX3(N0[2], N0[3], N1[1]); } SBAR(); \
          o1 = MFP(vb2_, pw0_, o1); if (HAS_NEXT) { ma_ = MX3(ma_, N1[2], N1[3]); mb_ = MX3(mb_, N0[4], N0[5]); } SBAR(); \
          va_ = VFR(vb_ + 32 * A3_VLD); vb2_ = VFR(vb_ + 32 * A3_VLD + 64); SBAR(); \
          o0 = MFP(vc_, pw1_, o0); if (HAS_NEXT) { ma_ = MX3(ma_, N0[6], N0[7]); mb_ = MX3(mb_, N1[4], N1[5]); } SBAR(); \
          o1 = MFP(vd_, pw1_, o1); if (HAS_NEXT) { ma_ = MX3(ma_, N1[6], N1[7]); mb_ = MX3(mb_, N0[8], N0[9]); } SBAR(); \
          vc_ = VFR(vb_ + 48 * A3_VLD); vd_ = VFR(vb_ + 48 * A3_VLD + 64); SBAR(); \
          o0 = MFP(va_, pw2_, o0); if (HAS_NEXT) { ma_ = MX3(ma_, N0[10], N0[11]); mb_ = MX3(mb_, N1[8], N1[9]); } SBAR(); \
          o1 = MFP(vb2_, pw2_, o1); if (HAS_NEXT) { ma_ = MX3(ma_, N1[10], N1[11]); mb_ = MX3(mb_, N0[12], N0[13]); } SBAR(); \
          if (HAS_NEXT) { ma_ = MX3(ma_, N0[14], N0[15]); mb_ = MX3(mb_, N1[12], N1[13]); } SBAR(); \
          o0 = MFP(vc_, pw3_, o0); if (HAS_NEXT) { ma_ = MX3(ma_, N1[14], N1[15]); } SBAR(); \
          o1 = MFP(vd_, pw3_, o1); SBAR(); } \
        if (HAS_NEXT) AT_UPD(N0, N1, __builtin_fmaxf(ma_, mb_), false); \
        if (VAR != 4 && (t) + 2 < NT) AT_STORE(lds + b2_ * A3_BUF, krA0, krA1, vrA); \
        if (VAR != 4) __syncthreads(); } while (0)
    int bc = 0, t = 0;
    for (; t + 2 < NT; t += 2) {
        AT_STEP(sa0, sa1, sb0, sb1, t, bc, true); bc = (bc == 2) ? 0 : bc + 1;
        AT_STEP(sb0, sb1, sa0, sa1, t + 1, bc, true); bc = (bc == 2) ? 0 : bc + 1;
    }
    AT_STEP(sa0, sa1, sb0, sb1, t, bc, true); bc = (bc == 2) ? 0 : bc + 1;
    AT_STEP(sb0, sb1, sa0, sa1, t + 1, bc, false);
#undef AT_LOAD
#undef AT_STORE
#undef SBAR
#undef KRD
#undef MF
#undef MFQ
#undef MFP
#undef EX4
#undef PK8
#undef VFR
#undef MX3
#undef AT_UPD
#undef AT_STEP
    lsum += __shfl_xor(lsum, 32);
    const float inv = 1.f / lsum;
    bf16* orow = MIX + (size_t)qrow * D + 512 + h * 64;
    { f32x16 t0, t1;
#pragma unroll
      for (int r = 0; r < 16; ++r) { t0[r] = o0[r] * inv; t1[r] = o1[r] * inv; }
      st_tile32(orow, hi, t0); st_tile32(orow + 32, hi, t1); }
}

constexpr int NCC = 66;
DEVI int chunk_row0(int b, int cc) { return cc < 2 ? NLAT + b * CL + cc * 128 : b * SEQ + (cc - 2) * 128; }
constexpr int SC_VEC = 0;
constexpr int SC_KT = 2048;
constexpr int SC_VF = SC_KT + 64 * 136 * 2;
constexpr int SC_VB = SC_VF + 64 * 136 * 2;
constexpr int SC_X = SC_VB + 64 * 136 * 2;
constexpr int SC_SSQ = SC_X + 2048;
constexpr int SC_END = SC_SSQ + 8192;
constexpr int TS = 136;

DEVI void scan_vectors(const P& p, int l, bool ret, int h, int row0, float* vec, int wid, int lane) {
    const float* dt = (const float*)(p.ws + WS_DT);
    if (ret) {
        if (wid == 0) { const float lf = IN(15)[l * 8 + h], lb = IN(15)[l * 8 + 4 + h];
            const float laf = -log1pf(__expf(-lf)), lab = -log1pf(__expf(-lb));
#pragma unroll
            for (int e = 0; e < 2; ++e) { const int j = lane * 2 + e; vec[j] = (float)(j + 1) * laf; vec[128 + j] = (float)(128 - j) * lab; vec[256 + j] = 1.f; vec[384 + j] = 1.f; } }
    } else if (wid < 2) {
        const int dir = wid; const size_t r = (size_t)(row0 + lane * 2);
        const float x0 = dt[r * 32 + 16 + dir * 8 + h], x1 = dt[(r + 1) * 32 + 16 + dir * 8 + h];
        vec[256 + dir * 128 + lane * 2] = dt[r * 32 + dir * 8 + h]; vec[256 + dir * 128 + lane * 2 + 1] = dt[(r + 1) * 32 + dir * 8 + h];
        float s = x0 + x1;
#pragma unroll
        for (int o = 1; o < 64; o <<= 1) { const float t = __shfl_up(s, o); if (lane >= o) s += t; }
        if (dir == 0) { vec[lane * 2] = s - x1; vec[lane * 2 + 1] = s; }
        else { const float tot = __shfl(s, 63); vec[128 + lane * 2] = tot - (s - x1) + x0; vec[128 + lane * 2 + 1] = tot - s + x1; }
    }
}
DEVI void scan_ptrs(const P& p, bool ret, int h, const bf16*& qb, const bf16*& kb, const bf16*& vb, int& ld) {
    if (ret) { const bf16* proj = (const bf16*)(p.ws + WS_PROJ); qb = proj + C_RQ + h * 64; kb = proj + C_RK + h * 64; vb = proj + C_RV + h * 64; ld = INWP; }
    else { const bf16* xbc = (const bf16*)(p.ws + WS_XBC); qb = xbc + 640 + (h >> 2) * 64; kb = xbc + 512 + (h >> 2) * 64; vb = xbc + h * 64; ld = 768; }
}
DEVI void c3_stage_rows(unsigned char* dst, int rs, const bf16* src, int ld, int tid) {
#pragma unroll
    for (int i = 0; i < 2; ++i) { const int piece = tid + NTHREADS * i, row = piece >> 3, part = piece & 7; *(u32x4*)(dst + row * rs + part * 16) = *(const u32x4*)(src + (size_t)row * ld + part * 8); }
}
struct ConvW { f32x4 w0[2], w1[2], w2[2], b[2]; };
DEVI ConvW conv_w(const float* cw, const float* cb, int c0) { ConvW w;
#pragma unroll
    for (int k = 0; k < 2; ++k) { w.w0[k] = *(const f32x4*)(cw + c0 + 4 * k); w.w1[k] = *(const f32x4*)(cw + 768 + c0 + 4 * k); w.w2[k] = *(const f32x4*)(cw + 1536 + c0 + 4 * k); w.b[k] = *(const f32x4*)(cb + c0 + 4 * k); }
    return w; }
DEVI void unpack8(const u32x4 v, f32x4 (&x)[2]) { x[0] = (f32x4){bf2f(v.x & 0xffff), bf2f(v.x >> 16), bf2f(v.y & 0xffff), bf2f(v.y >> 16)}; x[1] = (f32x4){bf2f(v.z & 0xffff), bf2f(v.z >> 16), bf2f(v.w & 0xffff), bf2f(v.w >> 16)}; }
DEVI void conv8(const bf16* proj, size_t row, bool has_prev, bool has_next, int c0, const ConvW& w, f32x4 (&y)[2]) {
    const bf16* pr = proj + row * INWP + C_XBC + c0; const u32x4 z = {0u, 0u, 0u, 0u};
    const u32x4 r0 = *(const u32x4*)pr, rm = has_prev ? *(const u32x4*)(pr - INWP) : z, rp = has_next ? *(const u32x4*)(pr + INWP) : z;
    f32x4 x0[2], xm[2], xp[2]; unpack8(r0, x0); unpack8(rm, xm); unpack8(rp, xp);
#pragma unroll
    for (int k = 0; k < 2; ++k) { y[k] = w.w0[k] * xm[k] + w.w1[k] * x0[k] + w.w2[k] * xp[k] + w.b[k];
#pragma unroll
        for (int i = 0; i < 4; ++i) y[k][i] = siluf(y[k][i]); }
}
DEVI u32x4 pack8(const f32x4 (&y)[2], float sc) { return (u32x4){pk2(y[0][0] * sc, y[0][1] * sc), pk2(y[0][2] * sc, y[0][3] * sc), pk2(y[1][0] * sc, y[1][1] * sc), pk2(y[1][2] * sc, y[1][3] * sc)}; }
constexpr int SA_RS = 192, SA_K = 8192, SA_VF = SA_K + 128 * SA_RS, SA_VB = SA_VF + 128 * SA_RS, SA_V2 = 2 * 128 * SA_RS  , SA_END = SA_VF + 2 * SA_V2;
DEVI void scanA_unit(const P& p, int l, int uidx, unsigned char* lds) {
    const int tid = otid(), wid = __builtin_amdgcn_readfirstlane(tid >> 6), lane = tid & 63, r32 = lane & 31, hi = lane >> 5;
    const int g4 = uidx % 3, bc = uidx / 3, b = bc / NCC, cc = bc % NCC, row0 = chunk_row0(b, cc);
    const bool ret = (g4 == 0);
    float* vec4 = (float*)(lds + SC_VEC);
    bf16* ST = (bf16*)(p.ws + WS_ST); float* CDp = (float*)(p.ws + WS_CD);
    const bf16* proj = (const bf16*)(p.ws + WS_PROJ); bf16* xbcw = (bf16*)(p.ws + WS_XBC); const float* cw = IN(16) + (size_t)l * 3 * 768; const float* cb = IN(17) + l * 768;
    const int troff = (4 * hi + ((lane & 15) >> 2)) * SA_RS + (16 * ((lane >> 4) & 1) + 4 * (lane & 3)) * 2;
    __syncthreads();
    { const int hq = wid >> 1, h = ret ? hq : (g4 - 1) * 4 + hq; scan_vectors(p, l, ret, h, row0, vec4 + hq * 512, wid & 1, lane); }
    __syncthreads();
    { const int hq = tid >> 7, t = tid & 127, h = ret ? hq : (g4 - 1) * 4 + hq, hh = ret ? hq : 4 + h; const size_t item = (size_t)(b * NCC + cc) * 12 + hh; const float* vv = vec4 + hq * 512;
      float* vg = (float*)(p.ws + WS_VEC) + item * 512; vg[t] = vv[t]; vg[128 + t] = vv[128 + t]; vg[256 + t] = vv[t] - __logf(vv[256 + t]); vg[384 + t] = vv[128 + t] - __logf(vv[384 + t]);
      if (t == 0) { CDp[item * 2] = __expf(vv[127]); CDp[item * 2 + 1] = __expf(vv[128]); } }
    const int dir = wid >> 2, nt = (wid >> 1) & 1, pt = wid & 1;
    if (ret) {
        for (int hq = 0; hq < 4; ++hq) {
            const int h = hq; const size_t item = (size_t)(b * NCC + cc) * 12 + h;
            const bf16 *qb, *kb, *vb; int ld; scan_ptrs(p, true, h, qb, kb, vb, ld);
            const float* vec = vec4 + hq * 512;
            if (hq > 0) __syncthreads();
            c3_stage_rows(lds + SA_K, SA_RS, kb + (size_t)row0 * ld, ld, tid);
#pragma unroll
            for (int i = 0; i < 2; ++i) { const int piece = tid + NTHREADS * i, j = piece >> 3, part = piece & 7; const u32x4 v = *(const u32x4*)(vb + (size_t)(row0 + j) * ld + part * 8);
                const float sf = __expf(vec[127] - vec[j]) * vec[256 + j], sb = __expf(vec[128] - vec[128 + j]) * vec[384 + j];
                f32x4 x[2]; unpack8(v, x);
                *(u32x4*)(lds + SA_VF + j * SA_RS + part * 16) = pack8(x, sf); *(u32x4*)(lds + SA_VB + j * SA_RS + part * 16) = pack8(x, sb); }
            __syncthreads();
            const unsigned char* ka = lds + SA_K + nt * 64 + troff; const unsigned char* va = lds + (dir ? SA_VB : SA_VF) + pt * 64 + troff;
            f32x16 acc;
#pragma unroll
            for (int r = 0; r < 16; ++r) acc[r] = 0.f;
#pragma unroll
            for (int s = 0; s < 8; ++s) { const v4i16_t al = lds_tr(ka + (16 * s) * SA_RS), ah = lds_tr(ka + (16 * s + 8) * SA_RS), bl = lds_tr(va + (16 * s) * SA_RS), bh = lds_tr(va + (16 * s + 8) * SA_RS);
                const bf16x8 af = {al[0], al[1], al[2], al[3], ah[0], ah[1], ah[2], ah[3]}, bf = {bl[0], bl[1], bl[2], bl[3], bh[0], bh[1], bh[2], bh[3]};
                acc = __builtin_amdgcn_mfma_f32_32x32x16_bf16(af, bf, acc, 0, 0, 0); }
            st_tile32(ST + (item * 2 + dir) * 4096 + (size_t)(pt * 32 + r32) * 64 + nt * 32, hi, acc);
        }
    } else {
        const int g = g4 - 1, part = tid & 7; const int pos0 = (cc < 2) ? cc * 128 : (cc - 2) * 128, Ls = (cc < 2) ? CL : SEQ;
        for (int hp = 0; hp < 2; ++hp) {
            if (hp > 0) __syncthreads();
            if (hp == 0) {
#pragma unroll 1
                for (int which = 0; which < 2; ++which) { const int c0 = (which == 0 ? 512 : 640) + g * 64 + part * 8; const ConvW w = conv_w(cw, cb, c0);
#pragma unroll
                    for (int i = 0; i < 2; ++i) { const int j = (tid + NTHREADS * i) >> 3; f32x4 y[2]; conv8(proj, (size_t)(row0 + j), pos0 + j > 0, pos0 + j < Ls - 1, c0, w, y);
                        const u32x4 o = pack8(y, 1.f); *(u32x4*)(xbcw + (size_t)(row0 + j) * 768 + c0) = o; if (which == 0) *(u32x4*)(lds + SA_K + j * SA_RS + part * 16) = o; } } }
#pragma unroll
            for (int e = 0; e < 2; ++e) { const int hq = hp * 2 + e, h = g * 4 + hq; const float* vec = vec4 + hq * 512; const int c0 = h * 64 + part * 8; const ConvW w = conv_w(cw, cb, c0);
#pragma unroll
                for (int i = 0; i < 2; ++i) { const int j = (tid + NTHREADS * i) >> 3; f32x4 y[2]; conv8(proj, (size_t)(row0 + j), pos0 + j > 0, pos0 + j < Ls - 1, c0, w, y);
                    const float sf = __expf(vec[127] - vec[j]) * vec[256 + j], sb = __expf(vec[128] - vec[128 + j]) * vec[384 + j];
                    *(u32x4*)(xbcw + (size_t)(row0 + j) * 768 + c0) = pack8(y, 1.f);
                    *(u32x4*)(lds + SA_VF + e * SA_V2 + j * SA_RS + part * 16) = pack8(y, sf); *(u32x4*)(lds + SA_VB + e * SA_V2 + j * SA_RS + part * 16) = pack8(y, sb); } }
            __syncthreads();
            const unsigned char* ka = lds + SA_K + nt * 64 + troff;
            f32x16 acc0, acc1;
#pragma unroll
            for (int r = 0; r < 16; ++r) { acc0[r] = 0.f; acc1[r] = 0.f; }
            const unsigned char* va = lds + (dir ? SA_VB : SA_VF) + pt * 64 + troff;
#pragma unroll
            for (int s = 0; s < 8; ++s) { const v4i16_t al = lds_tr(ka + (16 * s) * SA_RS), ah = lds_tr(ka + (16 * s + 8) * SA_RS);
                const bf16x8 af = {al[0], al[1], al[2], al[3], ah[0], ah[1], ah[2], ah[3]};
                { const v4i16_t bl = lds_tr(va + (16 * s) * SA_RS), bh = lds_tr(va + (16 * s + 8) * SA_RS); const bf16x8 bf = {bl[0], bl[1], bl[2], bl[3], bh[0], bh[1], bh[2], bh[3]}; acc0 = __builtin_amdgcn_mfma_f32_32x32x16_bf16(af, bf, acc0, 0, 0, 0); }
                { const v4i16_t bl = lds_tr(va + SA_V2 + (16 * s) * SA_RS), bh = lds_tr(va + SA_V2 + (16 * s + 8) * SA_RS); const bf16x8 bf = {bl[0], bl[1], bl[2], bl[3], bh[0], bh[1], bh[2], bh[3]}; acc1 = __builtin_amdgcn_mfma_f32_32x32x16_bf16(af, bf, acc1, 0, 0, 0); } }
#pragma unroll
            for (int e = 0; e < 2; ++e) { const int hq = hp * 2 + e, hh = 4 + g * 4 + hq; const size_t item = (size_t)(b * NCC + cc) * 12 + hh;
                st_tile32(ST + (item * 2 + dir) * 4096 + (size_t)(pt * 32 + r32) * 64 + nt * 32, hi, e ? acc1 : acc0); }
        }
    }
    __syncthreads();
}
DEVI void scanB_slab(const P& p, int slab, int nthr, int epb) {
    const int tid = otid(); if (tid >= nthr) return;
    const int f = slab * epb + tid * 2; const int bhd = f >> 12, e = f & 4095, dir = bhd & 1, bh = bhd >> 1, b = bh / 12, hh = bh % 12;
    const bf16* ST = (const bf16*)(p.ws + WS_ST); const float* CDp = (const float*)(p.ws + WS_CD); bf16* HT = (bf16*)(p.ws + WS_HT);
    f32x2 H = {0.f, 0.f};
#pragma unroll 1
    for (int base = 0; base < NCC; base += 33) {
        unsigned raw[33]; float d[33];
#pragma unroll
        for (int i = 0; i < 33; ++i) { const int step = base + i; const int cc = dir == 0 ? step : (step < 2 ? 1 - step : 67 - step); const unsigned item = (unsigned)((b * NCC + cc) * 12 + hh);
            raw[i] = *(const unsigned*)(ST + (item * 2 + dir) * 4096 + e); d[i] = CDp[item * 2 + dir]; }
#pragma unroll
        for (int i = 0; i < 33; ++i) { const int step = base + i; const int cc = dir == 0 ? step : (step < 2 ? 1 - step : 67 - step); const unsigned item = (unsigned)((b * NCC + cc) * 12 + hh);
            *(unsigned*)(HT + (item * 2 + dir) * 4096 + e) = pk2(H[0], H[1]); H = H * d[i] + (f32x2){bf2f(raw[i] & 0xffff), bf2f(raw[i] >> 16)}; }
    }
}
constexpr int C3_RSV = 192, C3_RSK = 144;
constexpr int C3_V = 0, C3_K = 2 * 128 * C3_RSV, C3_H = C3_K + 2 * 128 * C3_RSK, C3_VEC = C3_H + 2 * 128 * C3_RSK, C3_VS = 3072, C3_X = C3_VEC + 2 * C3_VS, C3_END = C3_X + 1024;
static_assert(C3_END <= LDS_MISC, "scan stage C LDS");
template <bool RET>
DEVI void scanC_unit(const P& p, int l, int bc, unsigned char* lds, int tid, int wid, int lane) {
    const int r32 = lane & 31, hi = lane >> 5;
    const int it_ = wid & 3, hsub = wid >> 2, b = bc / NCC, cc = bc % NCC, row0 = chunk_row0(b, cc); const int its = __builtin_amdgcn_readfirstlane(it_);
    const bf16* HT = (const bf16*)(p.ws + WS_HT); const bf16* proj = (const bf16*)(p.ws + WS_PROJ); const bf16* xbc = (const bf16*)(p.ws + WS_XBC); bf16* MIX = (bf16*)(p.ws + WS_HM); const float* VECG = (const float*)(p.ws + WS_VEC);
    const int i = it_ * 32 + r32; const size_t rowi = (size_t)(row0 + i);
    constexpr int ld = RET ? INWP : 768;
    const unsigned char* Vl = lds + C3_V + hsub * 128 * C3_RSV; const unsigned char* Kl = lds + C3_K + hsub * 128 * C3_RSK; const unsigned char* Hl = lds + C3_H + hsub * 128 * C3_RSK; const float* vec = (const float*)(lds + C3_VEC + hsub * C3_VS);
    const int trq = (lane & 15) >> 2, trp = lane & 3, trg = (lane >> 4) & 1;
    const int troff = (4 * hi + trq) * C3_RSV + (16 * trg + 4 * trp) * 2;
    float ssqk[4] = {0.f, 0.f, 0.f, 0.f};
    bf16x8 qf[4];
    if (!RET) { const bf16* qb = xbc + 640 + hsub * 64;
#pragma unroll
        for (int s = 0; s < 4; ++s) qf[s] = *(const bf16x8*)(qb + rowi * ld + s * 16 + hi * 8); }
    u32x4 pv[4], ph[4], pvec = {0u, 0u, 0u, 0u};
#define C3_PREFETCH(stp) do { _Pragma("unroll") for (int hs = 0; hs < 2; ++hs) { const int h_ = hs * 4 + (stp); const size_t item_ = (size_t)(b * NCC + cc) * 12 + 4 + h_; \
            _Pragma("unroll") for (int i_ = 0; i_ < 2; ++i_) { const int piece_ = tid + NTHREADS * i_, row_ = piece_ >> 3, part_ = piece_ & 7; \
                pv[hs * 2 + i_] = *(const u32x4*)(xbc + h_ * 64 + (size_t)(row0 + row_) * 768 + part_ * 8); ph[hs * 2 + i_] = *(const u32x4*)(HT + item_ * 2 * 4096 + row_ * 64 + part_ * 8); } \
            if ((tid >> 7) == hs) pvec = *(const u32x4*)(VECG + item_ * 512 + (tid & 127) * 4); } } while (0)
#define C3_COMMIT() do { _Pragma("unroll") for (int hs = 0; hs < 2; ++hs) _Pragma("unroll") for (int i_ = 0; i_ < 2; ++i_) { const int piece_ = tid + NTHREADS * i_, row_ = piece_ >> 3, part_ = piece_ & 7; \
            *(u32x4*)(lds + C3_V + hs * 128 * C3_RSV + row_ * C3_RSV + part_ * 16) = pv[hs * 2 + i_]; *(u32x4*)(lds + C3_H + hs * 128 * C3_RSK + row_ * C3_RSK + part_ * 16) = ph[hs * 2 + i_]; } \
        if (tid < 256) *(u32x4*)(lds + C3_VEC + (tid >> 7) * C3_VS + (tid & 127) * 16) = pvec; } while (0)
    if (!RET) { C3_PREFETCH(0);
#pragma unroll
        for (int hs = 0; hs < 2; ++hs) c3_stage_rows(lds + C3_K + hs * 128 * C3_RSK, C3_RSK, xbc + 512 + hs * 64 + (size_t)row0 * ld, ld, tid); }
#pragma unroll 1
    for (int step = 0; step < (RET ? 2 : 4); ++step) {
        __syncthreads();
        if (RET) {
#pragma unroll
            for (int hs = 0; hs < 2; ++hs) { const int h = hs * 2 + step; const size_t item = (size_t)(b * NCC + cc) * 12 + h;
                c3_stage_rows(lds + C3_V + hs * 128 * C3_RSV, C3_RSV, proj + C_RV + h * 64 + (size_t)row0 * ld, ld, tid);
                c3_stage_rows(lds + C3_K + hs * 128 * C3_RSK, C3_RSK, proj + C_RK + h * 64 + (size_t)row0 * ld, ld, tid);
                c3_stage_rows(lds + C3_H + hs * 128 * C3_RSK, C3_RSK, HT + item * 2 * 4096, 64, tid);
                if ((tid >> 7) == hs) *(u32x4*)(lds + C3_VEC + hs * C3_VS + (tid & 127) * 16) = *(const u32x4*)(VECG + item * 512 + (tid & 127) * 4); }
        } else C3_COMMIT();
        __syncthreads();
        if (!RET && step + 1 < 4) C3_PREFETCH(step + 1);
        { float* vw = (float*)(lds + C3_VEC + (tid >> 8) * C3_VS); const int k_ = tid & 255, j_ = k_ & 127; const bool bw_ = k_ >= 128;
          const float val_ = vw[256 + k_], ref_ = bw_ ? vw[128 + (j_ & ~31)] : vw[j_ | 31];
          vw[512 + k_] = __expf(ref_ - val_); }
        __syncthreads();
        const int h = RET ? hsub * 2 + step : hsub * 4 + step;
        if (RET) { const bf16* qb = proj + C_RQ + h * 64;
#pragma unroll
            for (int s = 0; s < 4; ++s) qf[s] = *(const bf16x8*)(qb + rowi * ld + s * 16 + hi * 8); }
        const float Afi = vec[i], Bbi = vec[128 + i];
        f32x16 y0, y1;
#pragma unroll
        for (int r = 0; r < 16; ++r) { y0[r] = 0.f; y1[r] = 0.f; }
#pragma unroll 2
        for (int jt = 0; jt < 4; ++jt) {
            f32x16 st;
#pragma unroll
            for (int r = 0; r < 16; ++r) st[r] = 0.f;
#pragma unroll
            for (int s = 0; s < 4; ++s) { const bf16x8 kf = *(const bf16x8*)(Kl + (jt * 32 + r32) * C3_RSK + (s * 16 + hi * 8) * 2); st = __builtin_amdgcn_mfma_f32_32x32x16_bf16(kf, qf[s], st, 0, 0, 0); }
            if (jt == its) {
#pragma unroll
                for (int g = 0; g < 4; ++g) { const int j0 = jt * 32 + 8 * g + 4 * hi;
                    const f32x4 afp = *(const f32x4*)(vec + 256 + j0), bbp = *(const f32x4*)(vec + 384 + j0);
#pragma unroll
                    for (int e = 0; e < 4; ++e) { const int j = j0 + e;
                        const float ff = (j <= i) ? __expf(Afi - afp[e]) : 0.f; const bool bm = RET ? (j > i) : (j >= i); const float fb = bm ? __expf(Bbi - bbp[e]) : 0.f;
                        st[4 * g + e] *= ff + fb; } }
            } else { const bool fw = jt < its; const float EA = fw ? __expf(Afi - vec[jt * 32 + 31]) : __expf(Bbi - vec[128 + jt * 32]); const float* ebp = vec + (fw ? 512 : 640) + jt * 32 + 4 * hi;
#pragma unroll
                for (int g = 0; g < 4; ++g) { const f32x4 ebv = *(const f32x4*)(ebp + 8 * g);
#pragma unroll
                    for (int e = 0; e < 4; ++e) st[4 * g + e] *= ebv[e] * EA; } }
#pragma unroll
            for (int s2 = 0; s2 < 2; ++s2) {
                u32x4 pw; pw.x = pk2(st[8 * s2 + 0], st[8 * s2 + 1]); pw.y = pk2(st[8 * s2 + 2], st[8 * s2 + 3]); pw.z = pk2(st[8 * s2 + 4], st[8 * s2 + 5]); pw.w = pk2(st[8 * s2 + 6], st[8 * s2 + 7]);
                const bf16x8 pb = __builtin_bit_cast(bf16x8, pw);
#pragma unroll
                for (int pt = 0; pt < 2; ++pt) { const unsigned char* vp = Vl + (jt * 32 + 16 * s2) * C3_RSV + pt * 64 + troff;
                    const v4i16_t lo = lds_tr(vp), hi2 = lds_tr(vp + 8 * C3_RSV);
                    const bf16x8 va = {lo[0], lo[1], lo[2], lo[3], hi2[0], hi2[1], hi2[2], hi2[3]};
                    if (pt == 0) y0 = __builtin_amdgcn_mfma_f32_32x32x16_bf16(va, pb, y0, 0, 0, 0); else y1 = __builtin_amdgcn_mfma_f32_32x32x16_bf16(va, pb, y1, 0, 0, 0); }
            }
        }
        { const float ef = __expf(Afi), eb = __expf(Bbi);
#pragma unroll
          for (int pt = 0; pt < 2; ++pt) { f32x16 tf, tb;
#pragma unroll
              for (int r = 0; r < 16; ++r) { tf[r] = 0.f; tb[r] = 0.f; }
              const unsigned char* hf = Hl + (pt * 32 + r32) * C3_RSK + hi * 16;
#pragma unroll
              for (int s = 0; s < 4; ++s) { tf = __builtin_amdgcn_mfma_f32_32x32x16_bf16(*(const bf16x8*)(hf + s * 32), qf[s], tf, 0, 0, 0); tb = __builtin_amdgcn_mfma_f32_32x32x16_bf16(*(const bf16x8*)(hf + 64 * C3_RSK + s * 32), qf[s], tb, 0, 0, 0); }
#pragma unroll
              for (int r = 0; r < 16; ++r) { if (pt == 0) y0[r] += ef * tf[r] + eb * tb[r]; else y1[r] += ef * tf[r] + eb * tb[r]; } } }
        float* Tw = (float*)(lds + (wid < 5 ? C3_V + wid * 8704 : C3_H + (wid - 5) * 8704));
        u32x4 xsr[4] = {{0u, 0u, 0u, 0u}, {0u, 0u, 0u, 0u}, {0u, 0u, 0u, 0u}, {0u, 0u, 0u, 0u}};
        if (!RET) {
#pragma unroll
            for (int k = 0; k < 4; ++k) xsr[k] = *(const u32x4*)(Vl + (it_ * 32 + (lane >> 3) + 8 * k) * C3_RSV + (lane & 7) * 16); }
        __syncthreads();
        if (RET) {
            float s1 = 0.f, s2 = 0.f;
#pragma unroll
            for (int r = 0; r < 16; ++r) { y0[r] *= 0.125f; y1[r] *= 0.125f; s1 += y0[r] + y1[r]; s2 += y0[r] * y0[r] + y1[r] * y1[r]; }
            s1 += __shfl_xor(s1, 32); s2 += __shfl_xor(s2, 32);
            const float mu = s1 * (1.f / 64.f), var = fmaxf(s2 * (1.f / 64.f) - mu * mu, 0.f), rs = __builtin_amdgcn_rsqf(var + EPS);
#pragma unroll
            for (int r = 0; r < 16; ++r) { y0[r] = (y0[r] - mu) * rs; y1[r] = (y1[r] - mu) * rs; }
        }
#pragma unroll
        for (int g = 0; g < 4; ++g) { *(f32x4*)(Tw + r32 * 68 + 8 * g + 4 * hi) = (f32x4){y0[4 * g], y0[4 * g + 1], y0[4 * g + 2], y0[4 * g + 3]}; *(f32x4*)(Tw + r32 * 68 + 32 + 8 * g + 4 * hi) = (f32x4){y1[4 * g], y1[4 * g + 1], y1[4 * g + 2], y1[4 * g + 3]}; }
        asm volatile("s_waitcnt lgkmcnt(0)" ::: "memory");
        { const int ch = lane & 7; const float dsk = RET ? 0.f : IN(20)[l * 8 + h];
#pragma unroll
          for (int k = 0; k < 4; ++k) { const int tr = (lane >> 3) + 8 * k; const size_t rowt = (size_t)(row0 + it_ * 32 + tr);
              f32x4 ya[2] = {*(const f32x4*)(Tw + tr * 68 + ch * 8), *(const f32x4*)(Tw + tr * 68 + ch * 8 + 4)};
              if (RET) { f32x4 gv[2]; unpack8(*(const u32x4*)(proj + rowt * INWP + C_RG + h * 64 + ch * 8), gv);
#pragma unroll
                  for (int q = 0; q < 2; ++q)
#pragma unroll
                      for (int e = 0; e < 4; ++e) ya[q][e] *= siluf(gv[q][e]);
                  *(u32x4*)(MIX + rowt * D + 768 + h * 64 + ch * 8) = pack8(ya, 1.f);
              } else { f32x4 xv[2], zv[2]; unpack8(xsr[k], xv); unpack8(*(const u32x4*)(proj + rowt * INWP + C_Z + h * 64 + ch * 8), zv); float sq = 0.f;
#pragma unroll
                  for (int q = 0; q < 2; ++q)
#pragma unroll
                      for (int e = 0; e < 4; ++e) { ya[q][e] = (ya[q][e] + xv[q][e] * dsk) * siluf(zv[q][e]); sq += ya[q][e] * ya[q][e]; }
                  *(u32x4*)(MIX + rowt * D + h * 64 + ch * 8) = pack8(ya, 1.f);
                  sq += __shfl_xor(sq, 1); sq += __shfl_xor(sq, 2); sq += __shfl_xor(sq, 4); ssqk[k] += sq; } } }
    }
    if (!RET) {
        float* ssq2 = (float*)(p.ws + WS_SSQ2);
#pragma unroll
        for (int k = 0; k < 4; ++k) if ((lane & 7) == 0) ssq2[(size_t)(row0 + it_ * 32 + (lane >> 3) + 8 * k) * 2 + hsub] = ssqk[k];
    }
    __syncthreads();
}
DEVI void ph_scanC(const P& p, int l, unsigned char* lds) {
    const int tid = otid(), wid = __builtin_amdgcn_readfirstlane(tid >> 6), lane = tid & 63;
    const int NU = 2 * NCC;
    if (gridDim.x == 256) {
        const int c = blockIdx.x;
        if (c < NU) scanC_unit<false>(p, l, c, lds, tid, wid, lane);
        else { const int r = c - NU; scanC_unit<true>(p, l, r, lds, tid, wid, lane); if (r + 124 < NU) scanC_unit<true>(p, l, r + 124, lds, tid, wid, lane);
            if (l == 0 && r >= 8 && r < 16) attn_unit<0>(p, 256 + (r - 8), lds, (bf16*)(p.ws + WS_HM));
            if (r >= 8) { if (l == 0) cvt_static(p, lds, 2, (r - 8) * NWAVES + wid, 116 * NWAVES, wid, lane); else ph_moew(p, lds, 2, (r - 8) * NWAVES + wid, 116 * NWAVES); } }
    } else {
        for (int u = blockIdx.x; u < 2 * NU; u += gridDim.x) { if (u < NU) scanC_unit<false>(p, l, u, lds, tid, wid, lane); else scanC_unit<true>(p, l, u - NU, lds, tid, wid, lane); }
        const int gw = blockIdx.x * NWAVES + wid, ngw = gridDim.x * NWAVES;
        if (l == 0) { cvt_static(p, lds, 1, gw, ngw, wid, lane); cvt_static(p, lds, 2, gw, ngw, wid, lane); cvt_static(p, lds, 3, gw, ngw, wid, lane); } else { ph_moew(p, lds, 1, gw, ngw); ph_moew(p, lds, 2, gw, ngw); ph_moew(p, lds, 3, gw, ngw); }
    }
}
DEVI void ph_scanA(const P& p, int l, unsigned char* lds) { for (int u = gridDim.x - 1 - blockIdx.x; u < 2 * NCC * 3; u += gridDim.x) scanA_unit(p, l, u, lds);
    if (gridDim.x == 256 && blockIdx.x >= 8 && blockIdx.x < 116) {
        const int tid = otid(), wid = __builtin_amdgcn_readfirstlane(tid >> 6), lane = tid & 63, gw = (blockIdx.x - 8) * NWAVES + wid;
        if (l == 0) cvt_static(p, lds, 1, gw, 108 * NWAVES, wid, lane); else ph_moew(p, lds, 1, gw, 108 * NWAVES); } }
DEVI void ph_mixer(const P& p, int l, unsigned char* lds) {
    for (int u = blockIdx.x; u < 256; u += gridDim.x) scanB_slab(p, u, 384, 768);
    for (int a = blockIdx.x; a < 256; a += gridDim.x) attn_unit<0>(p, (a & 7) * 32 + (a >> 3), lds, (bf16*)(p.ws + WS_HM));
#if ATTN_PROBE
    if (l == 0) { __syncthreads(); for (int a = blockIdx.x; a < 256; a += gridDim.x) attn_unit<ATTN_PROBE>(p, (a & 7) * 32 + (a >> 3), lds, (bf16*)p.out); }
#endif
    if (l == 0 && gridDim.x != 256) for (int a = blockIdx.x; a < 8; a += gridDim.x) attn_unit<0>(p, 256 + a, lds, (bf16*)(p.ws + WS_HM));
}

DEVI void ph_sort(const P& p, unsigned char* lds) {
    const int tid = otid(), wid = tid >> 6, lane = tid & 63;
    const int* rt_e = (const int*)(p.ws + WS_RT); int* rt_pos = (int*)(p.ws + WS_RT + 256 * 1024); int* tab = (int*)(p.ws + WS_RT + 384 * 1024); int* rt_tok = (int*)(p.ws + WS_RT + 640 * 1024);
    int* sh = (int*)lds;
    const int G = gridDim.x, R = (NLAT + G - 1) / G;
    for (int blk = blockIdx.x; blk * R < NLAT; blk += G) {
        const int r0 = blk * R, r1 = (r0 + R < NLAT) ? r0 + R : NLAT;
        int ct[8], cb[8];
#pragma unroll
        for (int e = 0; e < 8; ++e) { ct[e] = 0; cb[e] = 0; }
        for (int i = tid; i < NLAT * 2; i += NTHREADS) { const int e = rt_e[i]; const bool bef = (i >> 1) < r0;
#pragma unroll
            for (int x = 0; x < 8; ++x) { const int hit = (e == x) ? 1 : 0; ct[x] += hit; cb[x] += bef ? hit : 0; } }
#pragma unroll
        for (int e = 0; e < 8; ++e) {
#pragma unroll
            for (int o = 1; o < 64; o <<= 1) { ct[e] += __shfl_xor(ct[e], o); cb[e] += __shfl_xor(cb[e], o); }
        }
        __syncthreads();
        if (lane == 0) {
#pragma unroll
            for (int e = 0; e < 8; ++e) { sh[wid * 8 + e] = ct[e]; sh[64 + wid * 8 + e] = cb[e]; } }
        __syncthreads();
        if (tid == 0) { int start = 0, nt = 0;
            for (int e = 0; e < 8; ++e) { int tot = 0, bef = 0; for (int w = 0; w < 8; ++w) { tot += sh[w * 8 + e]; bef += sh[64 + w * 8 + e]; }
                sh[128 + e] = start; sh[136 + e] = start + bef; sh[144 + e] = tot; const int ntile = (tot + 255) >> 8;
                if (blk == 0) { for (int t = 0; t < ntile; ++t) tab[1 + nt + t] = e; }
                nt += ntile; start += ntile * 256; }
            if (blk == 0) tab[0] = nt; }
        __syncthreads();
        { const int n_ent = (r1 - r0) * 2; const bool valid = tid < n_ent; const int e = valid ? rt_e[r0 * 2 + tid] : -1; int rank = 0;
#pragma unroll
          for (int x = 0; x < 8; ++x) { const unsigned long long m = __ballot(e == x); if (e == x) rank = __popcll(m & ((1ull << lane) - 1ull)); if (lane == 0) sh[160 + wid * 8 + x] = __popcll(m); }
          __syncthreads();
          if (valid) { int pos = sh[136 + e] + rank; for (int w = 0; w < wid; ++w) pos += sh[160 + w * 8 + e]; sh[256 + tid] = pos; rt_pos[r0 * 2 + tid] = pos; } }
        __syncthreads();
        { const int n_ent = (r1 - r0) * 2; if (tid < n_ent) rt_tok[sh[256 + tid]] = r0 + (tid >> 1); }
        if (blk == 0) { for (int e = 0; e < 8; ++e) { const int tot = sh[144 + e], beg = sh[128 + e] + tot, end = sh[128 + e] + ((tot + 255) & ~255); for (int i = beg + tid; i < end; i += NTHREADS) rt_tok[i] = 0; } }
        __syncthreads();
    }
}
DEVI void ph_final(const P& p, unsigned char* lds) {
    const int tid = otid(), wid = tid >> 6, lane = tid & 63;
    const float* rt_g = (const float*)(p.ws + WS_RT + 128 * 1024); const int* rt_pos = (const int*)(p.ws + WS_RT + 256 * 1024);
    const bf16* YS = (const bf16*)(p.ws + WS_HS); const bf16* YS2 = (const bf16*)(p.ws + WS_HS2); const bool split = gridDim.x == 256; const float* modv = (const float*)(p.ws + WS_MODV) + (size_t)1 * 3 * 6144; const float* fw = IN(29);
    const int nw = gridDim.x * NWAVES, rpw = (NLAT + nw - 1) / nw, gw = blockIdx.x * NWAVES + wid;
    const int row0 = gw * rpw, row1 = (row0 + rpw < NLAT) ? row0 + rpw : NLAT;
#define FW0(j) ((((j) >> 1) * 64 + lane) * 8 + ((j) & 1) * 4)
    float* rb = (float*)lds + wid * 1024;
    f32x4 fwv[4], gv[4]; int rc = -1;
#pragma unroll
    for (int j = 0; j < 4; ++j) fwv[j] = *(const f32x4*)(fw + (j * 64 + lane) * 4);
    for (int row = row0; row < row1; ++row) {
        const int b = row >> 13; float* x = p.out + (size_t)row * D; const bf16* xr = (const bf16*)(p.ws + WS_X16) + (size_t)row * D;
        if (b != rc) { rc = b;
#pragma unroll
            for (int j = 0; j < 4; ++j) gv[j] = *(const f32x4*)(modv + b * 6144 + 5 * 1024 + FW0(j)); }
        const float g0 = rt_g[row * 2], g1 = rt_g[row * 2 + 1]; const int p0 = rt_pos[row * 2], p1 = rt_pos[row * 2 + 1]; const bf16* y0 = YS + (size_t)p0 * D; const bf16* y1 = YS + (size_t)p1 * D;
        f32x4 v[4]; float ss = 0.f;
#pragma unroll
        for (int k = 0; k < 2; ++k) { const int c0 = FW0(2 * k); f32x4 xv[2], ya[2], yb[2];
            ld_bf16x8(xr + c0, xv[0], xv[1]); ld_bf16x8(y0 + c0, ya[0], ya[1]); ld_bf16x8(y1 + c0, yb[0], yb[1]);
            if (split) { f32x4 t0, t1;
                if (p0 >= 32768) { ld_bf16x8(YS2 + (size_t)(p0 - 32768) * D + c0, t0, t1); ya[0] += t0; ya[1] += t1; }
                if (p1 >= 32768) { ld_bf16x8(YS2 + (size_t)(p1 - 32768) * D + c0, t0, t1); yb[0] += t0; yb[1] += t1; } }
#pragma unroll
            for (int q = 0; q < 2; ++q) { const int j = 2 * k + q; v[j] = xv[q] + gv[j] * (ya[q] * g0 + yb[q] * g1); ss += v[j][0] * v[j][0] + v[j][1] * v[j][1] + v[j][2] * v[j][2] + v[j][3] * v[j][3]; } }
        ss = wave_sum(ss); const float rstd = __builtin_amdgcn_rsqf(ss * (1.f / D) + EPS);
#pragma unroll
        for (int j = 0; j < 4; ++j) *(f32x4*)(rb + FW0(j)) = v[j] * rstd;
        asm volatile("s_waitcnt lgkmcnt(0)" ::: "memory");
#pragma unroll
        for (int j = 0; j < 4; ++j) { const int c0 = (j * 64 + lane) * 4; *(f32x4*)(x + c0) = *(const f32x4*)(rb + c0) * fwv[j]; }
        asm volatile("s_waitcnt lgkmcnt(0)" ::: "memory");
    }
#undef FW0
}

#define XB_TMO      128
#define XB_XCNT(j)  (256  + 64 * (j))
#define XB_XSUB(j)  (1280 + 64 * (j))
#define XB_XGEN(j)  (2304 + 64 * (j))
#define XB_TOP      3328
#define XB_TOPGEN   3392
#define XCD_BAR_WORDS 3456
#define XB_SPIN_CAP (1u << 22)
DEVI unsigned xb_ld(unsigned* p)              { return __hip_atomic_load(p, __ATOMIC_RELAXED, __HIP_MEMORY_SCOPE_AGENT); }
DEVI unsigned xb_add(unsigned* p, unsigned v) { return __hip_atomic_fetch_add(p, v, __ATOMIC_RELAXED, __HIP_MEMORY_SCOPE_AGENT); }
DEVI unsigned xb_xcc_id() { return (unsigned)__builtin_amdgcn_s_getreg((3 << 11) | 20) & 0xFu; }
#define XB_SPIN(cond, bar) do { unsigned _sp = 0; while (cond) { __builtin_amdgcn_s_sleep(1); \
    if ((++_sp & 255u) == 0u) { if (xb_ld(&(bar)[XB_TMO])) break; if (_sp > XB_SPIN_CAP) { atomicAdd(&(bar)[XB_TMO], 1u); break; } } } } while (0)
struct XcdBarrier { unsigned* bar; unsigned x; volatile LAS unsigned* st; };
DEVI XcdBarrier xcd_barrier_post(unsigned* bar, volatile LAS unsigned* st) {
    XcdBarrier b; b.bar = bar; b.x = xb_xcc_id(); b.st = st;
    if (threadIdx.x == 0) (void)xb_add(&bar[XB_XCNT(b.x)], 1u);
    return b;
}
DEVI void xcd_barrier_complete(unsigned* bar, unsigned x, unsigned& nloc, unsigned& nx) {
    const unsigned G = gridDim.x * gridDim.y * gridDim.z;
    unsigned sum, cnt, mine, sp = 0u;
    for (;;) {
        sum = 0u; cnt = 0u; mine = 0u;
#pragma unroll
        for (unsigned j = 0; j < 16; ++j) { const unsigned c = xb_ld(&bar[XB_XCNT(j)]); sum += c; cnt += (c > 0u) ? 1u : 0u; mine = (j == x) ? c : mine; }
        if (sum == G) break;
        __builtin_amdgcn_s_sleep(1);
        if ((++sp & 255u) == 0u) { if (xb_ld(&bar[XB_TMO])) break; if (sp > XB_SPIN_CAP) { atomicAdd(&bar[XB_TMO], 1u); break; } }
    }
    nloc = mine > 0u ? mine : 1u; nx = cnt > 0u ? cnt : 1u;
}
DEVI void xcd_barrier(const XcdBarrier& b) {
    asm volatile("s_waitcnt vmcnt(0)" ::: "memory");
    __syncthreads();
    if (threadIdx.x == 0) {
        unsigned* bar = b.bar;
        __builtin_amdgcn_s_waitcnt(0);
        unsigned nloc = b.st[0], nx = b.st[1];
        if (nloc == 0u) { xcd_barrier_complete(bar, b.x, nloc, nx); b.st[0] = nloc; b.st[1] = nx; }
        const unsigned old = xb_add(&bar[XB_XSUB(b.x)], 1u);
        const unsigned gen = old / nloc;
        if (old + 1u == (gen + 1u) * nloc) {
            __builtin_amdgcn_fence(__ATOMIC_RELEASE, "agent");
            asm volatile("s_waitcnt vmcnt(0)" ::: "memory");
            const unsigned og = xb_add(&bar[XB_TOP], 1u);
            const unsigned tg = og / nx;
            if (og + 1u == (tg + 1u) * nx) xb_add(&bar[XB_TOPGEN], 1u);
            else XB_SPIN(xb_ld(&bar[XB_TOPGEN]) == tg, bar);
            __builtin_amdgcn_fence(__ATOMIC_ACQUIRE, "agent");
            xb_add(&bar[XB_XGEN(b.x)], 1u);
            asm volatile("s_waitcnt vmcnt(0)" ::: "memory");
        } else {
            XB_SPIN(xb_ld(&bar[XB_XGEN(b.x)]) == gen, bar);
            __builtin_amdgcn_fence(__ATOMIC_ACQUIRE, "agent");
            asm volatile("s_waitcnt vmcnt(0)" ::: "memory");
        }
    }
    __syncthreads();
}

constexpr int NPHASES = 21;
#ifndef XSYNC
#define XSYNC 0
#endif
#ifndef REP_MASK
#define REP_MASK 0u
#endif
#ifndef PH_MASK
#define PH_MASK 0xffffu
#endif
#ifndef MK_CG_FIRST
#define MK_CG_FIRST 0
#endif
__global__ void __launch_bounds__(NTHREADS, 2) mk_fwd(P p) {
    extern __shared__ __attribute__((aligned(16))) unsigned char lds[];
#if MK_CG_FIRST
    cg::grid_group grid = cg::this_grid();
#endif
    const int G = gridDim.x, c = blockIdx.x;
    if (threadIdx.x < 30) ((lds_u64*)(uintptr_t)LDS_PTRS)[threadIdx.x] = (unsigned long long)p.in[threadIdx.x];
    if (threadIdx.x < 2) ((volatile LAS unsigned*)(uintptr_t)LDS_MISC)[threadIdx.x] = 0u;
    __syncthreads();
    unsigned* barw = (unsigned*)(p.ws + WS_CTL) + 1024;
#if MK_CG_FIRST
    if (blockIdx.x == 0) { for (int i = threadIdx.x; i < XCD_BAR_WORDS; i += NTHREADS) barw[i] = 0u; }
    XcdBarrier xbar; xbar.bar = barw; xbar.x = 0; xbar.st = (volatile LAS unsigned*)(uintptr_t)LDS_MISC;
    int nsync = 0;
#define GRID_BAR() do { if (nsync == 0) { grid.sync(); xbar = xcd_barrier_post(barw, (volatile LAS unsigned*)(uintptr_t)LDS_MISC); } else xcd_barrier(xbar); ++nsync; } while (0)
#else
    const XcdBarrier xbar = xcd_barrier_post(barw, (volatile LAS unsigned*)(uintptr_t)LDS_MISC);
#define GRID_BAR() xcd_barrier(xbar)
#endif
    int ph = 0;
#define RUN(kid, ...) do { if (((PH_MASK >> (kid)) & 1u) && ph >= p.ph_lo && ph < p.ph_hi) { __VA_ARGS__; if ((REP_MASK >> (kid)) & 1u) { __VA_ARGS__; } if (ph + 1 < p.ph_hi) { GRID_BAR(); for (int xs_ = 0; xs_ < XSYNC; ++xs_) GRID_BAR(); } } ++ph; } while (0)
    RUN(0, ph_pro(p, lds));
#define LAYER(l) \
        RUN(1, ph_norm<false>(p, l, 0, T, lds, l == 1 ? 11 : 0, 5)); \
        RUN(2, { Gemm g{(const bf16*)(p.ws + WS_HM), (const bf16*)(p.ws + WS_WIN) + (size_t)l * INWP * 1024, 0, nullptr}; DenseSched S{T / 256, INWP / 256, G, c}; \
            EpiInProj E{(bf16*)(p.ws + WS_PROJ), (float*)(p.ws + WS_DT), IN(18) + l * 16, IN(19) + l * 16, (float*)(p.ws + WS_RQP), (float*)(p.ws + WS_RKVP)}; gemm_phase<D, 1024, 1024>(lds, g, S, E); \
            if (l == 1 && G == 256 && c >= 214) ph_moew(p, lds, 3, (c - 214) * NWAVES + (int)(threadIdx.x >> 6), 42 * NWAVES); }); \
        RUN(4, { Gemm g{(const bf16*)(p.ws + WS_PROJ), (const bf16*)(p.ws + WS_WQKV) + (size_t)l * 1024 * 384, 0, nullptr}; DenseSched S{T / 256, 4, G, c, 8}; \
            EpiMla E{(bf16*)(p.ws + WS_Q), (bf16*)(p.ws + WS_K), (bf16*)(p.ws + WS_V), (const float*)(p.ws + WS_RQP), (const float*)(p.ws + WS_RKVP), (const float*)(p.ws + WS_ROPE), (const bf16*)(p.ws + WS_PROJ)}; gemm_phase<INWP, 384, 384>(lds, g, S, E); ph_scanA(p, l, lds); }); \
        RUN(5, ph_mixer(p, l, lds)); \
        RUN(6, ph_scanC(p, l, lds)); \
        RUN(8, { Gemm g{(const bf16*)(p.ws + WS_HM), (const bf16*)(p.ws + WS_WOUT) + (size_t)l * 1024 * 1024, 0, nullptr}; DenseSched S{NLAT / 256, 4, G, c, 8}; \
            EpiResid E{IN(0), (const bf16*)(p.ws + WS_X16), l == 0, (bf16*)(p.ws + WS_X16), (const float*)(p.ws + WS_MODV) + (size_t)l * 3 * 6144, 2, (const float*)(p.ws + WS_SSQ2)}; gemm_phase<D, 1024, 1024, EpiResid, DenseSched, false, 8>(lds, g, S, E); \
            if (l == 0) { CtxSplitSched S2{4, 256 * 2, G, c}; EpiPart E2{(float*)(p.ws + WS_XBC), (const float*)(p.ws + WS_SSQ2), 2}; gemm_phase<D, 1024, 256>(lds, g, S2, E2); } }); \
        RUN(9, ph_norm<l == 1>(p, l, 1, l == 0 ? T : NLAT, lds, l == 0 ? 4 : 0, 2)); \
        if (l == 0) { \
            RUN(10, { Gemm g{(const bf16*)(p.ws + WS_HM), (const bf16*)(p.ws + WS_WGU), 0, nullptr}; DenseSched S{T / 256, 2 * DFF / 256, G, c}; \
                EpiSwiglu E{(bf16*)(p.ws + WS_PROJ), DFF}; gemm_phase<D, 1024, 1024>(lds, g, S, E); \
                if (G == 256 && c >= 172) { const int t_ = otid(); cvt_static(p, lds, 3, (c - 172) * NWAVES + (t_ >> 6), 84 * NWAVES, t_ >> 6, t_ & 63); } }); \
            RUN(11, { Gemm g{(const bf16*)(p.ws + WS_PROJ), (const bf16*)(p.ws + WS_WD), 0, nullptr}; DenseSched S{NLAT / 256, 4, G, c, 8}; \
                EpiResid E{IN(0), (const bf16*)(p.ws + WS_X16), false, (bf16*)(p.ws + WS_X16), (const float*)(p.ws + WS_MODV), 5, (const float*)(p.ws + WS_SSQ2)}; gemm_phase<DFF, DFF, DFF>(lds, g, S, E); \
                CtxSplitSched S2{11, 256 * 2, G, c}; EpiPart E2{(float*)(p.ws + WS_XBC), (const float*)(p.ws + WS_SSQ2), 0}; gemm_phase<DFF, DFF, 256>(lds, g, S2, E2); }); \
        } else { \
            RUN(12, { ph_sort(p, lds); __syncthreads(); ph_moew(p, lds, 0, blockIdx.x * NWAVES + (int)(threadIdx.x >> 6), gridDim.x * NWAVES); }); \
            RUN(13, { Gemm g{(const bf16*)(p.ws + WS_HM), (const bf16*)(p.ws + WS_WGUE), (size_t)2 * DFE * 1024, (const int*)(p.ws + WS_RT + 640 * 1024)}; MoeSched S{(const int*)(p.ws + WS_RT + 384 * 1024), 2 * DFE / 256, G, c}; \
                EpiSwiglu E{(bf16*)(p.ws + WS_ACTS), DFE}; gemm_phase<D, 1024, 1024, EpiSwiglu, MoeSched, true>(lds, g, S, E); }); \
            RUN(14, { Gemm g{(const bf16*)(p.ws + WS_ACTS), (const bf16*)(p.ws + WS_WDE), (size_t)1024 * DFE, nullptr}; const int* tab_ = (const int*)(p.ws + WS_RT + 384 * 1024); EpiStore E{(bf16*)(p.ws + WS_HS), D}; \
                if (G == 256) { MoeMainSched S{tab_, 4, G, c}; gemm_phase<DFE, DFE, DFE>(lds, g, S, E); \
                    MoeTailSched SA{tab_, c, 0, 0}; gemm_phase<DFE, DFE, 768>(lds, g, SA, E); \
                    MoeTailSched SB{tab_, c, 64, 768 * 2}; EpiStore E2{(bf16*)(p.ws + WS_HS2) - (size_t)32768 * D, D}; gemm_phase<DFE, DFE, 640>(lds, g, SB, E2); } \
                else { MoeSched S{tab_, 4, G, c}; gemm_phase<DFE, DFE, DFE>(lds, g, S, E); } }); \
            RUN(15, ph_final(p, lds)); \
        }
    LAYER(0)
    LAYER(1)
#undef LAYER
#undef RUN
}

#ifndef MK_ONE_LAUNCH
#define MK_ONE_LAUNCH 1
#endif
extern "C" void kernel_launch(void* const* d_in, const int* in_sizes, int n_in, void* d_out, int out_size, void* d_ws, size_t ws_size, hipStream_t stream) {
    static int grid = 0;
    if (grid == 0) {
        if (n_in != 30 || out_size != NLAT * D || ws_size < WS_END) { fprintf(stderr, "kernel_launch: unexpected problem (n_in %d out %d ws %zu, need %zu)\n", n_in, out_size, ws_size, (size_t)WS_END); grid = -1; return; }
        int dev = 0, cus = 0, per_cu = 0;
        hipGetDevice(&dev); hipDeviceGetAttribute(&cus, hipDeviceAttributeMultiprocessorCount, dev);
        if (hipFuncSetAttribute((const void*)mk_fwd, hipFuncAttributeMaxDynamicSharedMemorySize, LDS_BYTES) != hipSuccess) { fprintf(stderr, "kernel_launch: hipFuncSetAttribute failed\n"); grid = -1; return; }
        if (hipOccupancyMaxActiveBlocksPerMultiprocessor(&per_cu, (const void*)mk_fwd, NTHREADS, LDS_BYTES) != hipSuccess || per_cu < 1) { fprintf(stderr, "kernel_launch: occupancy query failed (%d)\n", per_cu); grid = -1; return; }
        grid = cus;
        fprintf(stderr, "kernel_launch: grid %d (cus %d, per_cu %d)\n", grid, cus, per_cu);
    }
    if (grid < 0) return;
    P p{};
    for (int i = 0; i < 30; ++i) p.in[i] = (const float*)d_in[i];
    p.out = (float*)d_out; p.ws = (unsigned char*)d_ws;
#if !MK_CG_FIRST
    if (hipMemsetAsync((unsigned char*)d_ws + WS_CTL + 4096, 0, XCD_BAR_WORDS * sizeof(unsigned), stream) != hipSuccess) fprintf(stderr, "kernel_launch: memset failed\n");
#endif
#if MK_ONE_LAUNCH
    p.ph_lo = 0; p.ph_hi = NPHASES;
    { void* args[] = {&p}; hipError_t e = hipLaunchCooperativeKernel((const void*)mk_fwd, dim3(grid), dim3(NTHREADS), args, LDS_BYTES, stream);
      if (e != hipSuccess) fprintf(stderr, "cooperative launch failed: %s\n", hipGetErrorString(e)); }
#else
    for (int ph = 0; ph < NPHASES; ++ph) {
        p.ph_lo = ph; p.ph_hi = ph + 1;
        void* args[] = {&p}; hipError_t e = hipLaunchCooperativeKernel((const void*)mk_fwd, dim3(grid), dim3(NTHREADS), args, LDS_BYTES, stream);
        if (e != hipSuccess) { fprintf(stderr, "cooperative launch %d failed: %s\n", ph, hipGetErrorString(e)); break; }
    }
#endif
}
```
